# Optimizing an MI355X kernel written in HIP

```python
import math
import jax
import jax.numpy as jnp
from jax import lax
import numpy as np

D_MODEL = 1024
BATCH = 2
SEQ = 8192
DEPTH = 1

CHUNK = 64
EPS = 1e-6
NEG_INF = -1e30
ATT_HEADS = 8
ATT_HEAD_DIM = 64
ATT_WIDTH = ATT_HEADS * ATT_HEAD_DIM
LEFT_CHUNKS = 8
BAND_CHUNKS = LEFT_CHUNKS + 1
BAND = BAND_CHUNKS * CHUNK
REL_MAX = 128
REL_BUCKETS = (CHUNK - 1) + REL_MAX + 1
SSM_WIDTH = D_MODEL - ATT_WIDTH
SSM_GROUP = 16
SSM_GROUPS = SSM_WIDTH // SSM_GROUP
SSM_STATE = 64
MIX_WIDTH = ATT_WIDTH + SSM_WIDTH
IN_WIDTH = 3 * ATT_WIDTH + SSM_WIDTH
MEM_LEN = 256
MEM_HEADS = 4
MEM_HEAD_DIM = D_MODEL // MEM_HEADS
PEER_HEADS = 8
PEER_KEYS = 128
PEER_EXPERTS = PEER_KEYS * PEER_KEYS
PEER_TOPK = 16
PEER_QDIM = 256
PEER_BLOCK = 128

kernel_name = 'hybrid_chunkattn_s5_peer_block'


def _rmsnorm(x, g):
    xf = x.astype(jnp.float32)
    y = xf * lax.rsqrt(jnp.mean(xf * xf, axis=-1, keepdims=True) + EPS)
    return (y * g.astype(jnp.float32)).astype(x.dtype)


def _band_bias(rel_bias):
    qi = jnp.arange(CHUNK)
    kj = jnp.arange(BAND)
    dist = LEFT_CHUNKS * CHUNK + qi[:, None] - kj[None, :]
    bucket = jnp.clip(dist, -(CHUNK - 1), REL_MAX) + (CHUNK - 1)
    return rel_bias[:, bucket]


def _chunked_attention(q, k, v, rel_bias):
    bsz, seq = q.shape[0], q.shape[1]
    nc = seq // CHUNK
    shp = (bsz, nc, CHUNK, ATT_HEADS, ATT_HEAD_DIM)
    qc = q.reshape(shp)
    pad = ((0, 0), (LEFT_CHUNKS, 0), (0, 0), (0, 0), (0, 0))
    kp = jnp.pad(k.reshape(shp), pad)
    vp = jnp.pad(v.reshape(shp), pad)
    idx = jnp.arange(nc)[:, None] + jnp.arange(BAND_CHUNKS)[None, :]
    band_shp = (bsz, nc, BAND, ATT_HEADS, ATT_HEAD_DIM)
    kb = kp[:, idx].reshape(band_shp)
    vb = vp[:, idx].reshape(band_shp)
    s = jnp.einsum('bnqhd,bnkhd->bhnqk', qc, kb).astype(jnp.float32) * (ATT_HEAD_DIM ** -0.5)
    s = s + _band_bias(rel_bias).astype(jnp.float32)[None, :, None]
    key_chunk = jnp.arange(nc)[:, None] - LEFT_CHUNKS + (jnp.arange(BAND) // CHUNK)[None, :]
    s = jnp.where((key_chunk >= 0)[None, None, :, None, :], s, NEG_INF)
    p = jax.nn.softmax(s, axis=-1).astype(v.dtype)
    o = jnp.einsum('bhnqk,bnkhd->bnqhd', p, vb)
    return o.reshape(bsz, seq, ATT_WIDTH)


def _complex_affine_combine(c1, c2):
    a1r, a1i, b1r, b1i = c1
    a2r, a2i, b2r, b2i = c2
    ar = a2r * a1r - a2i * a1i
    ai = a2r * a1i + a2i * a1r
    br = a2r * b1r - a2i * b1i + b2r
    bi = a2r * b1i + a2i * b1r + b2i
    return (ar, ai, br, bi)


def _s5_mixer(u, lam_re, lam_im, log_step, b_re, b_im, c_re, c_im, d_skip, w_glu, b_glu):
    bsz, seq = u.shape[0], u.shape[1]
    uf = u.astype(jnp.float32).reshape(bsz, seq, SSM_GROUPS, SSM_GROUP)
    step = jnp.exp(log_step.astype(jnp.float32))[:, None]
    lr = lam_re.astype(jnp.float32)
    li = lam_im.astype(jnp.float32)
    mag = jnp.exp(lr * step)
    ar = mag * jnp.cos(li * step)
    ai = mag * jnp.sin(li * step)
    zr = ar - 1.0
    den = lr * lr + li * li
    fr = (zr * lr + ai * li) / den
    fi = (ai * lr - zr * li) / den
    br = b_re.astype(jnp.float32)
    bi = b_im.astype(jnp.float32)
    bbr = fr[..., None] * br - fi[..., None] * bi
    bbi = fr[..., None] * bi + fi[..., None] * br
    bu_r = jnp.einsum('blgc,gpc->blgp', uf, bbr)
    bu_i = jnp.einsum('blgc,gpc->blgp', uf, bbi)
    a_r = jnp.broadcast_to(ar, bu_r.shape)
    a_i = jnp.broadcast_to(ai, bu_i.shape)
    _, _, xr, xi = lax.associative_scan(_complex_affine_combine, (a_r, a_i, bu_r, bu_i), axis=1)
    y = (jnp.einsum('blgp,gcp->blgc', xr, c_re.astype(jnp.float32))
         - jnp.einsum('blgp,gcp->blgc', xi, c_im.astype(jnp.float32))
         + d_skip.astype(jnp.float32) * uf)
    y = jax.nn.gelu(y.reshape(bsz, seq, SSM_WIDTH), approximate=False)
    y = y * jax.nn.sigmoid(y @ w_glu.astype(jnp.float32) + b_glu.astype(jnp.float32))
    return y.astype(u.dtype)


def _memory_attention(hn, memn, w_q, w_k, w_v, q_g, k_g, w_o):
    bsz, seq = hn.shape[0], hn.shape[1]
    m = memn.shape[1]
    q = _rmsnorm((hn @ w_q).reshape(bsz, seq, MEM_HEADS, MEM_HEAD_DIM), q_g)
    k = _rmsnorm((memn @ w_k).reshape(bsz, m, MEM_HEADS, MEM_HEAD_DIM), k_g)
    v = (memn @ w_v).reshape(bsz, m, MEM_HEADS, MEM_HEAD_DIM)
    s = jnp.einsum('blhd,bmhd->bhlm', q, k).astype(jnp.float32) * (MEM_HEAD_DIM ** -0.5)
    p = jax.nn.softmax(s, axis=-1).astype(v.dtype)
    o = jnp.einsum('bhlm,bmhd->blhd', p, v).reshape(bsz, seq, D_MODEL)
    return o @ w_o


def _peer_ffn(hn, w_q, sub_keys, u_tab, v_tab):
    bsz, seq, d = hn.shape
    tokens = hn.reshape(-1, PEER_BLOCK, d)

    def block(xb):
        q = (xb @ w_q).reshape(PEER_BLOCK, PEER_HEADS, 2, PEER_QDIM // 2)
        s = jnp.einsum('thsd,hsnd->thsn', q, sub_keys).astype(jnp.float32)
        sv, si = lax.top_k(s, PEER_TOPK)
        cand = (sv[:, :, 0, :, None] + sv[:, :, 1, None, :]).reshape(PEER_BLOCK, PEER_HEADS, -1)
        cidx = (si[:, :, 0, :, None] * PEER_KEYS + si[:, :, 1, None, :]).reshape(PEER_BLOCK, PEER_HEADS, -1)
        top, pos = lax.top_k(cand, PEER_TOPK)
        e = jnp.take_along_axis(cidx, pos, axis=-1)
        g = jax.nn.softmax(top, axis=-1)
        act = jax.nn.gelu(jnp.einsum('thkd,td->thk', u_tab[e], xb), approximate=False)
        w = (g * act).astype(xb.dtype)
        return jnp.einsum('thk,thkd->td', w, v_tab[e])

    return lax.map(block, tokens).reshape(bsz, seq, d)


def setup_inputs(seed: int = 0) -> dict:
    key = jax.random.key(seed)
    ks = iter(jax.random.split(key, 40))

    def nrm(shape, scale):
        return scale * jax.random.normal(next(ks), shape, jnp.float32)

    def gain(n):
        return 1.0 + nrm((DEPTH, n), 0.02)

    x = nrm((BATCH, SEQ, D_MODEL), 1.0)
    mem = nrm((BATCH, MEM_LEN, D_MODEL), 1.0)
    norm_mix_g = gain(D_MODEL)
    w_in = nrm((DEPTH, D_MODEL, IN_WIDTH), D_MODEL ** -0.5)
    att_q_g = gain(ATT_HEAD_DIM)
    att_k_g = gain(ATT_HEAD_DIM)
    rel_bias = nrm((DEPTH, ATT_HEADS, REL_BUCKETS), 0.5)
    ssm_lam_re = -0.5 + nrm((DEPTH, SSM_GROUPS, SSM_STATE), 0.01)
    ssm_lam_im = math.pi * jnp.arange(SSM_STATE, dtype=jnp.float32) + nrm((DEPTH, SSM_GROUPS, SSM_STATE), 0.01)
    ssm_log_step = jax.random.uniform(next(ks), (DEPTH, SSM_GROUPS), jnp.float32, math.log(1e-3), math.log(1e-1))
    ssm_b_re = nrm((DEPTH, SSM_GROUPS, SSM_STATE, SSM_GROUP), (2 * SSM_GROUP) ** -0.5)
    ssm_b_im = nrm((DEPTH, SSM_GROUPS, SSM_STATE, SSM_GROUP), (2 * SSM_GROUP) ** -0.5)
    ssm_c_re = nrm((DEPTH, SSM_GROUPS, SSM_GROUP, SSM_STATE), (2 * SSM_STATE) ** -0.5)
    ssm_c_im = nrm((DEPTH, SSM_GROUPS, SSM_GROUP, SSM_STATE), (2 * SSM_STATE) ** -0.5)
    ssm_d = nrm((DEPTH, SSM_GROUPS, SSM_GROUP), 1.0)
    ssm_w_glu = nrm((DEPTH, SSM_WIDTH, SSM_WIDTH), SSM_WIDTH ** -0.5)
    ssm_b_glu = nrm((DEPTH, SSM_WIDTH), 0.01)
    att_out_g = gain(ATT_WIDTH)
    ssm_out_g = gain(SSM_WIDTH)
    w_out = nrm((DEPTH, MIX_WIDTH, D_MODEL), MIX_WIDTH ** -0.5)
    norm_mem_g = gain(D_MODEL)
    norm_memkv_g = gain(D_MODEL)
    w_mem_q = nrm((DEPTH, D_MODEL, D_MODEL), D_MODEL ** -0.5)
    w_mem_k = nrm((DEPTH, D_MODEL, D_MODEL), D_MODEL ** -0.5)
    w_mem_v = nrm((DEPTH, D_MODEL, D_MODEL), D_MODEL ** -0.5)
    mem_q_g = gain(MEM_HEAD_DIM)
    mem_k_g = gain(MEM_HEAD_DIM)
    w_mem_o = nrm((DEPTH, D_MODEL, D_MODEL), D_MODEL ** -0.5)
    norm_peer_g = gain(D_MODEL)
    w_peer_q = nrm((DEPTH, D_MODEL, PEER_HEADS * PEER_QDIM), D_MODEL ** -0.5)
    peer_keys = nrm((DEPTH, PEER_HEADS, 2, PEER_KEYS, PEER_QDIM // 2), (PEER_QDIM // 2) ** -0.5)
    peer_u = nrm((DEPTH, PEER_EXPERTS, D_MODEL), D_MODEL ** -0.5)
    peer_v = nrm((DEPTH, PEER_EXPERTS, D_MODEL), PEER_HEADS ** -0.5)
    return {'x': x, 'mem': mem, 'norm_mix_g': norm_mix_g, 'w_in': w_in,
            'att_q_g': att_q_g, 'att_k_g': att_k_g, 'rel_bias': rel_bias,
            'ssm_lam_re': ssm_lam_re, 'ssm_lam_im': ssm_lam_im, 'ssm_log_step': ssm_log_step,
            'ssm_b_re': ssm_b_re, 'ssm_b_im': ssm_b_im, 'ssm_c_re': ssm_c_re, 'ssm_c_im': ssm_c_im,
            'ssm_d': ssm_d, 'ssm_w_glu': ssm_w_glu, 'ssm_b_glu': ssm_b_glu,
            'att_out_g': att_out_g, 'ssm_out_g': ssm_out_g, 'w_out': w_out,
            'norm_mem_g': norm_mem_g, 'norm_memkv_g': norm_memkv_g,
            'w_mem_q': w_mem_q, 'w_mem_k': w_mem_k, 'w_mem_v': w_mem_v,
            'mem_q_g': mem_q_g, 'mem_k_g': mem_k_g, 'w_mem_o': w_mem_o,
            'norm_peer_g': norm_peer_g, 'w_peer_q': w_peer_q, 'peer_keys': peer_keys,
            'peer_u': peer_u, 'peer_v': peer_v}


def reference(x, mem, norm_mix_g, w_in, att_q_g, att_k_g, rel_bias,
              ssm_lam_re, ssm_lam_im, ssm_log_step, ssm_b_re, ssm_b_im, ssm_c_re, ssm_c_im,
              ssm_d, ssm_w_glu, ssm_b_glu, att_out_g, ssm_out_g, w_out,
              norm_mem_g, norm_memkv_g, w_mem_q, w_mem_k, w_mem_v, mem_q_g, mem_k_g, w_mem_o,
              norm_peer_g, w_peer_q, peer_keys, peer_u, peer_v):
    bsz, seq = x.shape[0], x.shape[1]
    h = x
    for l in range(DEPTH):
        proj = _rmsnorm(h, norm_mix_g[l]) @ w_in[l]
        q = proj[..., :ATT_WIDTH].reshape(bsz, seq, ATT_HEADS, ATT_HEAD_DIM)
        k = proj[..., ATT_WIDTH:2 * ATT_WIDTH].reshape(bsz, seq, ATT_HEADS, ATT_HEAD_DIM)
        v = proj[..., 2 * ATT_WIDTH:3 * ATT_WIDTH].reshape(bsz, seq, ATT_HEADS, ATT_HEAD_DIM)
        u = proj[..., 3 * ATT_WIDTH:]
        att = _chunked_attention(_rmsnorm(q, att_q_g[l]), _rmsnorm(k, att_k_g[l]), v, rel_bias[l])
        ssm = _s5_mixer(u, ssm_lam_re[l], ssm_lam_im[l], ssm_log_step[l], ssm_b_re[l], ssm_b_im[l],
                        ssm_c_re[l], ssm_c_im[l], ssm_d[l], ssm_w_glu[l], ssm_b_glu[l])
        mixed = jnp.concatenate([_rmsnorm(att, att_out_g[l]), _rmsnorm(ssm, ssm_out_g[l])], axis=-1)
        h = h + mixed @ w_out[l]
        h = h + _memory_attention(_rmsnorm(h, norm_mem_g[l]), _rmsnorm(mem, norm_memkv_g[l]),
                                  w_mem_q[l], w_mem_k[l], w_mem_v[l], mem_q_g[l], mem_k_g[l], w_mem_o[l])
        h = h + _peer_ffn(_rmsnorm(h, norm_peer_g[l]), w_peer_q[l], peer_keys[l], peer_u[l], peer_v[l])
    return h
```

```cpp
#include <hip/hip_runtime.h>
#include <hip/hip_cooperative_groups.h>
#include <cstdio>
#include <cstdint>
namespace cg = cooperative_groups;

#ifndef MEGA
#define MEGA 1
#endif

typedef unsigned short bf16_t;
typedef short bf16x8 __attribute__((ext_vector_type(8)));
typedef float f32x4 __attribute__((ext_vector_type(4)));
typedef unsigned u32x4 __attribute__((ext_vector_type(4)));
#define LAS __attribute__((address_space(3)))
__device__ __forceinline__ bf16x8 as_bf(u32x4 v) { return __builtin_bit_cast(bf16x8, v); }

#define T_TOK 16384
#define SEQL 8192
#define NTHREADS 256
#define LDS_BYTES 66560
#define EPSF 1e-6f

__device__ __forceinline__ unsigned short f2bf(float f) { unsigned u = __float_as_uint(f); u += 0x7fffu + ((u >> 16) & 1u); return (unsigned short)(u >> 16); }
__device__ __forceinline__ float bf2f(unsigned short b) { return __uint_as_float(((unsigned)b) << 16); }
__device__ __forceinline__ unsigned pack2(float lo, float hi) { return (unsigned)f2bf(lo) | ((unsigned)f2bf(hi) << 16); }
__device__ __forceinline__ float gelu_f(float x) { return 0.5f * x * (1.0f + erff(x * 0.70710678118654752f)); }
__device__ __forceinline__ f32x4 mfma16(bf16x8 a, bf16x8 b, f32x4 c) { return __builtin_amdgcn_mfma_f32_16x16x32_bf16(a, b, c, 0, 0, 0); }

struct Params {
  const float *x, *mem, *norm_mix_g, *w_in, *att_q_g, *att_k_g, *rel_bias;
  const float *lam_re, *lam_im, *log_step, *b_re, *b_im, *c_re, *c_im, *d_skip, *w_glu, *b_glu;
  const float *att_out_g, *ssm_out_g, *w_out, *norm_mem_g, *norm_memkv_g, *w_mem_q, *w_mem_k, *w_mem_v;
  const float *mem_q_g, *mem_k_g, *w_mem_o, *norm_peer_g, *w_peer_q, *peer_keys, *peer_u, *peer_v;
  float* out;
  unsigned* bar;
  bf16_t *WtIn, *WtGlu, *WtOut, *WtMq, *WtMk, *WtMv, *WtMo, *WtPq, *PK, *PU, *PV;
  bf16_t *XB, *MEMB, *Qb, *Kb, *VT, *Ub, *ATT, *YG, *SSMO, *H1B, *QM, *OM, *H2B, *QP;
  bf16_t *KMB, *VMT, *WE16, *WY;
  float *rs_x, *rs_mem, *ss_att, *ss_ssm, *ss_h1, *ss_qm, *ss_km, *ss_h2, *KMraw, *ESEG;
  float *BBR, *BBI, *PWR, *PWI, *APW;
  unsigned* TOPS;
};

template <bool ASC, bool ZERO = true>
__device__ __forceinline__ void gemm_mainloop(f32x4 (&acc)[4][4], const bf16_t* __restrict__ A, int lda, const bf16_t* __restrict__ Bt, int ldb, int K,
                                              int row0, int col0, char* lds_, const float* s0, const float* s1, int ksplit) {
  LAS char* lds = (LAS char*)lds_;
  const int tid = threadIdx.x, lane = tid & 63, w = tid >> 6, wr = w >> 1, wc = w & 1, fr = lane & 15, fq = lane >> 4;
  if (ZERO) {
#pragma unroll
    for (int m = 0; m < 4; ++m)
#pragma unroll
      for (int n = 0; n < 4; ++n) acc[m][n] = (f32x4){0.f, 0.f, 0.f, 0.f};
  }
  const int sr = tid >> 3, skc = tid & 7;
  const bf16_t* gA = A + (size_t)(row0 + sr) * lda + skc * 8;
  const bf16_t* gB = Bt + (size_t)(col0 + sr) * ldb + skc * 8;
  const int soff = sr * 128 + ((skc ^ (sr & 7)) << 4);
  u32x4 ra[4], rb[4];
  const int nk = K >> 6;
#pragma unroll
  for (int i = 0; i < 4; ++i) { ra[i] = *(const u32x4*)(gA + (size_t)(32 * i) * lda); rb[i] = *(const u32x4*)(gB + (size_t)(32 * i) * ldb); }
  __syncthreads();
  {
#pragma unroll
    for (int i = 0; i < 4; ++i) {
      u32x4 va = ra[i];
      if (ASC) { const float s = (0 < ksplit) ? s0[i] : s1[i];
        va.x = pack2(__uint_as_float(va.x << 16) * s, __uint_as_float(va.x & 0xffff0000u) * s); va.y = pack2(__uint_as_float(va.y << 16) * s, __uint_as_float(va.y & 0xffff0000u) * s);
        va.z = pack2(__uint_as_float(va.z << 16) * s, __uint_as_float(va.z & 0xffff0000u) * s); va.w = pack2(__uint_as_float(va.w << 16) * s, __uint_as_float(va.w & 0xffff0000u) * s); }
      *(LAS u32x4*)(lds + soff + i * 4096) = va; *(LAS u32x4*)(lds + 16384 + soff + i * 4096) = rb[i];
    }
  }
  __syncthreads();
  for (int kt = 0; kt < nk; ++kt) {
    LAS char* cur = lds + (kt & 1) * 32768; LAS char* nxt = lds + ((kt + 1) & 1) * 32768;
    const bool more = (kt + 1 < nk);
    if (more) {
      const int k1 = (kt + 1) << 6;
#pragma unroll
      for (int i = 0; i < 4; ++i) { ra[i] = *(const u32x4*)(gA + (size_t)(32 * i) * lda + k1); rb[i] = *(const u32x4*)(gB + (size_t)(32 * i) * ldb + k1); }
    }
#pragma unroll
    for (int ks = 0; ks < 2; ++ks) {
      bf16x8 af[4], bfr[4];
      const int kc = ks * 4 + fq;
#pragma unroll
      for (int m = 0; m < 4; ++m) { const int r = wr * 64 + m * 16 + fr; af[m] = as_bf(*(const LAS u32x4*)(cur + r * 128 + ((kc ^ (r & 7)) << 4))); }
#pragma unroll
      for (int n = 0; n < 4; ++n) { const int r = wc * 64 + n * 16 + fr; bfr[n] = as_bf(*(const LAS u32x4*)(cur + 16384 + r * 128 + ((kc ^ (r & 7)) << 4))); }
#pragma unroll
      for (int m = 0; m < 4; ++m)
#pragma unroll
        for (int n = 0; n < 4; ++n) acc[m][n] = mfma16(bfr[n], af[m], acc[m][n]);
    }
    if (more) {
      const int k1 = (kt + 1) << 6;
#pragma unroll
      for (int i = 0; i < 4; ++i) {
        u32x4 va = ra[i];
        if (ASC) { const float s = (k1 < ksplit) ? s0[i] : s1[i];
          va.x = pack2(__uint_as_float(va.x << 16) * s, __uint_as_float(va.x & 0xffff0000u) * s); va.y = pack2(__uint_as_float(va.y << 16) * s, __uint_as_float(va.y & 0xffff0000u) * s);
          va.z = pack2(__uint_as_float(va.z << 16) * s, __uint_as_float(va.z & 0xffff0000u) * s); va.w = pack2(__uint_as_float(va.w << 16) * s, __uint_as_float(va.w & 0xffff0000u) * s); }
        *(LAS u32x4*)(nxt + soff + i * 4096) = va; *(LAS u32x4*)(nxt + 16384 + soff + i * 4096) = rb[i];
      }
    }
    __syncthreads();
  }
}

__device__ void transpose_tile(const float* __restrict__ src, bf16_t* __restrict__ dst, int K, int N, int tile, const float* g0, const float* g1, int split, float* tl  ) {
  const int ntn = N >> 6; const int tk = tile / ntn, tn = tile % ntn; const int k0 = tk << 6, n0 = tn << 6; const int tid = threadIdx.x;
  __syncthreads();
#pragma unroll 4
  for (int i = 0; i < 16; ++i) { const int kk = i * 4 + (tid >> 6), nn = tid & 63; const int k = k0 + kk;
    float g = 1.f; if (g0) g = (k < split) ? g0[k] : g1[k - split];
    tl[kk * 65 + nn] = src[(size_t)k * N + n0 + nn] * g; }
  __syncthreads();
  const int n = tid >> 2, kq = (tid & 3) * 16;
  unsigned o[8];
#pragma unroll
  for (int j = 0; j < 8; ++j) o[j] = pack2(tl[(kq + 2 * j) * 65 + n], tl[(kq + 2 * j + 1) * 65 + n]);
  uint4* d = (uint4*)(dst + (size_t)(n0 + n) * K + k0 + kq);
  d[0] = make_uint4(o[0], o[1], o[2], o[3]); d[1] = make_uint4(o[4], o[5], o[6], o[7]);
}

__device__ void convert_flat(const float* __restrict__ src, bf16_t* __restrict__ dst, size_t n8  , int bid, int nb) {
  for (size_t i = (size_t)bid * NTHREADS + threadIdx.x; i < n8; i += (size_t)nb * NTHREADS) {
    const float4 a = ((const float4*)src)[2 * i], b = ((const float4*)src)[2 * i + 1];
    ((uint4*)dst)[i] = make_uint4(pack2(a.x, a.y), pack2(a.z, a.w), pack2(b.x, b.y), pack2(b.z, b.w));
  }
}
__device__ void rows_bf16_rs(const float* __restrict__ src, bf16_t* __restrict__ dst, float* __restrict__ rs, int nrows, int bid, int nb) {
  const int lane = threadIdx.x & 63, w = threadIdx.x >> 6;
  for (int row = bid * 4 + w; row < nrows; row += nb * 4) {
    const float4* s = (const float4*)(src + (size_t)row * 1024);
    float ss = 0.f; uint2* d = (uint2*)(dst + (size_t)row * 1024);
#pragma unroll
    for (int i = 0; i < 4; ++i) { const float4 v = s[i * 64 + lane]; ss += v.x * v.x + v.y * v.y + v.z * v.z + v.w * v.w; d[i * 64 + lane] = make_uint2(pack2(v.x, v.y), pack2(v.z, v.w)); }
#pragma unroll
    for (int o = 32; o > 0; o >>= 1) ss += __shfl_xor(ss, o);
    if (lane == 0) rs[row] = rsqrtf(ss * (1.0f / 1024.0f) + EPSF);
  }
}

__device__ void ssm_stage1(const Params& p, int gp) {
  const int g = gp >> 6;
  const float step = expf(p.log_step[g]); const float lr = p.lam_re[gp], li = p.lam_im[gp];
  const float mag = expf(lr * step); const float ar = mag * cosf(li * step), ai = mag * sinf(li * step);
  const float zr = ar - 1.0f, den = lr * lr + li * li; const float fr = (zr * lr + ai * li) / den, fi = (ai * lr - zr * li) / den;
  for (int c = 0; c < 16; ++c) { const float br = p.b_re[gp * 16 + c], bi = p.b_im[gp * 16 + c]; p.BBR[gp * 16 + c] = fr * br - fi * bi; p.BBI[gp * 16 + c] = fr * bi + fi * br; }
  float pr = 1.f, pi = 0.f; const int st = gp & 63;
  for (int j = 0; j <= 16; ++j) { p.PWR[(g * 17 + j) * 64 + st] = pr; p.PWI[(g * 17 + j) * 64 + st] = pi; const float nr = pr * ar - pi * ai, ni = pr * ai + pi * ar; if (j < 16) { pr = nr; pi = ni; } }
  const float a16r = pr, a16i = pi; const float a32r = a16r * a16r - a16i * a16i, a32i = 2.f * a16r * a16i;
  const float a48r = a32r * a16r - a32i * a16i, a48i = a32r * a16i + a32i * a16r; const float a64r = a32r * a32r - a32i * a32i, a64i = 2.f * a32r * a32i;
  const float a128r = a64r * a64r - a64i * a64i, a128i = 2.f * a64r * a64i; const float a256r = a128r * a128r - a128i * a128i, a256i = 2.f * a128r * a128i;
  float* A = p.APW;
  A[0 * 4096 + gp] = a16r; A[0 * 4096 + 2048 + gp] = a16i; A[1 * 4096 + gp] = a32r; A[1 * 4096 + 2048 + gp] = a32i; A[2 * 4096 + gp] = a48r; A[2 * 4096 + 2048 + gp] = a48i;
  A[3 * 4096 + gp] = a64r; A[3 * 4096 + 2048 + gp] = a64i; A[4 * 4096 + gp] = a256r; A[4 * 4096 + 2048 + gp] = a256i;
}
__device__ void ssm_stage2(const Params& p, int bid, int nb) {
  const int total1 = 32 * 128 * 256, total2 = 32 * 256 * 384;
  for (int i = bid * NTHREADS + threadIdx.x; i < total1 + total2; i += nb * NTHREADS) {
    if (i < total1) {
      const int k = i & 255, sr = (i >> 8) & 127, g = i >> 15; const int st = ((sr >> 5) << 4) | (sr & 15), ri = (sr >> 4) & 1; const int s = k >> 4, ch = k & 15;
      const int gp = g * 64 + st; const float pr = p.PWR[(g * 17 + 15 - s) * 64 + st], pi = p.PWI[(g * 17 + 15 - s) * 64 + st]; const float br = p.BBR[gp * 16 + ch], bi = p.BBI[gp * 16 + ch];
      p.WE16[i] = f2bf(ri == 0 ? (pr * br - pi * bi) : (pr * bi + pi * br));
    } else {
      const int e = i - total1; const int k = e % 384, r = (e / 384) & 255, g = e / (384 * 256); const int t = r >> 4, co = r & 15; float val;
      if (k < 128) { const int st = ((k >> 5) << 4) | (k & 15), ri = (k >> 4) & 1; const float cr = p.c_re[(g * 16 + co) * 64 + st], ci = p.c_im[(g * 16 + co) * 64 + st];
        const float pr = p.PWR[(g * 17 + t + 1) * 64 + st], pi = p.PWI[(g * 17 + t + 1) * 64 + st]; val = (ri == 0) ? (cr * pr - ci * pi) : -(cr * pi + ci * pr); }
      else { const int kk = k - 128, s = kk >> 4, cin = kk & 15; val = 0.f;
        if (s <= t) { const int j = t - s; float acc = 0.f;
          for (int st = 0; st < 64; ++st) { const float cr = p.c_re[(g * 16 + co) * 64 + st], ci = p.c_im[(g * 16 + co) * 64 + st]; const float pr = p.PWR[(g * 17 + j) * 64 + st], pi = p.PWI[(g * 17 + j) * 64 + st];
            const float br = p.BBR[(g * 64 + st) * 16 + cin], bi = p.BBI[(g * 64 + st) * 16 + cin]; acc += cr * (pr * br - pi * bi) - ci * (pr * bi + pi * br); }
          val = acc; } }
      p.WY[e] = f2bf(val);
    }
  }
}

#define EPI_IDS const int tid = threadIdx.x, lane = tid & 63, w = tid >> 6, wr = w >> 1, wc = w & 1, fr = lane & 15, fq = lane >> 4; (void)wr; (void)wc; (void)fr; (void)fq;

__device__ void tile_win(const Params& p, int tile, char* lds) {
  const int rt = tile >> 4, ct = tile & 15; const int row0 = rt * 128, col0 = ct * 128;
  f32x4 acc[4][4];
  gemm_mainloop<false>(acc, p.XB, 1024, p.WtIn, 1024, 1024, row0, col0, lds, nullptr, nullptr, 0);
  EPI_IDS
  const int cw = col0 + wc * 64;
#pragma unroll
  for (int m = 0; m < 4; ++m) {
    const int row = row0 + wr * 64 + m * 16 + fr; const float rsx = p.rs_x[row];
    if (cw < 1024) {
      float ss = 0.f;
#pragma unroll
      for (int n = 0; n < 4; ++n)
#pragma unroll
        for (int j = 0; j < 4; ++j) { const float v = acc[m][n][j] * rsx; acc[m][n][j] = v; ss += v * v; }
      ss += __shfl_xor(ss, 16); ss += __shfl_xor(ss, 32);
      const float rs = rsqrtf(ss * (1.0f / 64.0f) + EPSF) * (cw < 512 ? 0.125f : 1.0f);
      const float* g = (cw < 512) ? p.att_q_g : p.att_k_g; bf16_t* dst = (cw < 512 ? p.Qb : p.Kb) + (size_t)row * 512 + (cw & 511);
#pragma unroll
      for (int n = 0; n < 4; ++n) { const int c = n * 16 + fq * 4; const float4 gg = *(const float4*)(g + c);
        *(uint2*)(dst + c) = make_uint2(pack2(acc[m][n][0] * rs * gg.x, acc[m][n][1] * rs * gg.y), pack2(acc[m][n][2] * rs * gg.z, acc[m][n][3] * rs * gg.w)); }
    } else if (cw < 1536) {
      const int head = (cw - 1024) >> 6; const int b = row >> 13, tb = row & 8191;
      bf16_t* dst = p.VT + ((size_t)(b * 8 + head) * 64) * SEQL + tb;
#pragma unroll
      for (int n = 0; n < 4; ++n)
#pragma unroll
        for (int j = 0; j < 4; ++j) dst[(size_t)(n * 16 + fq * 4 + j) * SEQL] = f2bf(acc[m][n][j] * rsx);
    } else {
      bf16_t* dst = p.Ub + (size_t)row * 512 + (cw - 1536);
#pragma unroll
      for (int n = 0; n < 4; ++n) { const int c = n * 16 + fq * 4;
        *(uint2*)(dst + c) = make_uint2(pack2(acc[m][n][0] * rsx, acc[m][n][1] * rsx), pack2(acc[m][n][2] * rsx, acc[m][n][3] * rsx)); }
    }
  }
}
__device__ void tile_memkv(const Params& p, int tile, char* lds) {
  const int which = tile >> 5, t2 = tile & 31; const int rt = t2 >> 3, ct = t2 & 7; const int row0 = rt * 128, col0 = ct * 128;
  f32x4 acc[4][4];
  gemm_mainloop<false>(acc, p.MEMB, 1024, which ? p.WtMv : p.WtMk, 1024, 1024, row0, col0, lds, nullptr, nullptr, 0);
  EPI_IDS
  const int cw = col0 + wc * 64;
#pragma unroll
  for (int m = 0; m < 4; ++m) {
    const int row = row0 + wr * 64 + m * 16 + fr; const float rsm = p.rs_mem[row];
    if (which == 0) {
      float ss = 0.f;
#pragma unroll
      for (int n = 0; n < 4; ++n) { f32x4 v = acc[m][n] * rsm; ss += v[0] * v[0] + v[1] * v[1] + v[2] * v[2] + v[3] * v[3]; *(f32x4*)(p.KMraw + (size_t)row * 1024 + cw + n * 16 + fq * 4) = v; }
      ss += __shfl_xor(ss, 16); ss += __shfl_xor(ss, 32);
      if (fq == 0) p.ss_km[row * 16 + (cw >> 6)] = ss;
    } else {
      const int b = row >> 8, key = row & 255; const int head = cw >> 8; const int d0 = (cw & 255);
      bf16_t* dst = p.VMT + ((size_t)(b * 4 + head) * 256) * 256 + key;
#pragma unroll
      for (int n = 0; n < 4; ++n)
#pragma unroll
        for (int j = 0; j < 4; ++j) dst[(size_t)(d0 + n * 16 + fq * 4 + j) * 256] = f2bf(acc[m][n][j] * rsm);
    }
  }
}
__device__ void memk_fix(const Params& p, int bid, int nb) {
  for (int i = bid * NTHREADS + threadIdx.x; i < 512 * 1024 / 4; i += nb * NTHREADS) {
    const int row = i >> 8, c4 = (i & 255) * 4; const int head = c4 >> 8, d = c4 & 255;
    const float ss = p.ss_km[row * 16 + head * 4] + p.ss_km[row * 16 + head * 4 + 1] + p.ss_km[row * 16 + head * 4 + 2] + p.ss_km[row * 16 + head * 4 + 3];
    const float rs = rsqrtf(ss * (1.0f / 256.0f) + EPSF);
    const float4 v = *(const float4*)(p.KMraw + (size_t)row * 1024 + c4); const float4 gk = *(const float4*)(p.mem_k_g + d), gq = *(const float4*)(p.mem_q_g + d);
    const int b = row >> 8, key = row & 255;
    *(uint2*)(p.KMB + ((size_t)(b * 4 + head) * 256 + key) * 256 + d) = make_uint2(pack2(v.x * rs * gk.x * gq.x, v.y * rs * gk.y * gq.y), pack2(v.z * rs * gk.z * gq.z, v.w * rs * gk.w * gq.w));
  }
}

__device__ void chunk_attn_item(const Params& p, int item, float* rb) {
  const int h = item & 7, cn = (item >> 3) & 127, b = item >> 10;
  const int tid = threadIdx.x, lane = tid & 63, w = tid >> 6, fr = lane & 15, fq = lane >> 4;
  __syncthreads();
  if (tid < 192) rb[tid] = p.rel_bias[h * 192 + tid];
  __syncthreads();
  const int iq = w * 16 + fr; const int tq = b * SEQL + cn * 64 + iq;
  bf16x8 qf[2];
  qf[0] = *(const bf16x8*)(p.Qb + (size_t)tq * 512 + h * 64 + fq * 8); qf[1] = *(const bf16x8*)(p.Qb + (size_t)tq * 512 + h * 64 + 32 + fq * 8);
  f32x4 o[4]; for (int i = 0; i < 4; ++i) o[i] = (f32x4){0.f, 0.f, 0.f, 0.f};
  float mrun = -1e30f, lrun = 0.f;
  const int cstart = (cn >= 8) ? 0 : (8 - cn);
  const bf16_t* vtb = p.VT + ((size_t)(b * 8 + h) * 64) * SEQL;
  for (int c = cstart; c <= 8; ++c) {
    const int kc0 = (cn - 8 + c) * 64;
    f32x4 st[4];
#pragma unroll
    for (int mt = 0; mt < 4; ++mt) {
      const bf16_t* kr = p.Kb + (size_t)(b * SEQL + kc0 + mt * 16 + fr) * 512 + h * 64 + fq * 8;
      const bf16x8 k0 = *(const bf16x8*)kr, k1 = *(const bf16x8*)(kr + 32);
      f32x4 s = (f32x4){0.f, 0.f, 0.f, 0.f}; s = mfma16(k0, qf[0], s); s = mfma16(k1, qf[1], s); st[mt] = s;
    }
    float tmax = -1e30f;
#pragma unroll
    for (int mt = 0; mt < 4; ++mt)
#pragma unroll
      for (int j = 0; j < 4; ++j) { const int jk = mt * 16 + fq * 4 + j; int dist = 512 - 64 * c + iq - jk; dist = dist < -63 ? -63 : (dist > 128 ? 128 : dist);
        const float s = st[mt][j] + rb[dist + 63]; st[mt][j] = s; tmax = fmaxf(tmax, s); }
    tmax = fmaxf(tmax, __shfl_xor(tmax, 16)); tmax = fmaxf(tmax, __shfl_xor(tmax, 32));
    const float mnew = fmaxf(mrun, tmax); const float alpha = __expf(mrun - mnew); mrun = mnew;
    float ls = 0.f;
#pragma unroll
    for (int mt = 0; mt < 4; ++mt)
#pragma unroll
      for (int j = 0; j < 4; ++j) { const float pv = __expf(st[mt][j] - mnew); st[mt][j] = pv; ls += pv; }
    lrun = lrun * alpha + ls;
#pragma unroll
    for (int dt = 0; dt < 4; ++dt) o[dt] *= alpha;
#pragma unroll
    for (int s2 = 0; s2 < 2; ++s2) {
      union { bf16x8 v; unsigned u[4]; } pf;
      pf.u[0] = pack2(st[2 * s2][0], st[2 * s2][1]); pf.u[1] = pack2(st[2 * s2][2], st[2 * s2][3]); pf.u[2] = pack2(st[2 * s2 + 1][0], st[2 * s2 + 1][1]); pf.u[3] = pack2(st[2 * s2 + 1][2], st[2 * s2 + 1][3]);
#pragma unroll
      for (int dt = 0; dt < 4; ++dt) {
        const bf16_t* vr = vtb + (size_t)(dt * 16 + fr) * SEQL + kc0 + s2 * 32 + fq * 4;
        union { bf16x8 v; uint2 u[2]; } vf; vf.u[0] = *(const uint2*)vr; vf.u[1] = *(const uint2*)(vr + 16);
        o[dt] = mfma16(vf.v, pf.v, o[dt]);
      }
    }
  }
  float lt = lrun; lt += __shfl_xor(lt, 16); lt += __shfl_xor(lt, 32);
  const float inv = 1.0f / lt; float ss = 0.f;
  bf16_t* dst = p.ATT + (size_t)tq * 512 + h * 64;
#pragma unroll
  for (int dt = 0; dt < 4; ++dt) { const f32x4 v = o[dt] * inv; ss += v[0] * v[0] + v[1] * v[1] + v[2] * v[2] + v[3] * v[3];
    *(uint2*)(dst + dt * 16 + fq * 4) = make_uint2(pack2(v[0], v[1]), pack2(v[2], v[3])); }
  ss += __shfl_xor(ss, 16); ss += __shfl_xor(ss, 32);
  if (fq == 0) p.ss_att[tq * 8 + h] = ss;
}

template <bool FINAL>
__device__ void ssm_item(const Params& p, int item, char* lds) {
  const int g = item & 31, seg = (item >> 5) & 31, b = item >> 10;
  const int tid = threadIdx.x, lane = tid & 63, w = tid >> 6, fr = lane & 15, fq = lane >> 4;
  const int t0 = b * SEQL + seg * 256;
  bf16x8 uf[8];
#pragma unroll
  for (int ks = 0; ks < 8; ++ks) uf[ks] = *(const bf16x8*)(p.Ub + (size_t)(t0 + fr * 16 + 2 * ks + (fq >> 1)) * 512 + g * 16 + (fq & 1) * 8);
  f32x4 er = (f32x4){0.f, 0.f, 0.f, 0.f}, ei = er;
  const bf16_t* we = p.WE16 + ((size_t)g * 128 + w * 32 + fr) * 256 + fq * 8;
#pragma unroll
  for (int ks = 0; ks < 8; ++ks) { const bf16x8 br = *(const bf16x8*)(we + ks * 32), bi = *(const bf16x8*)(we + 16 * 256 + ks * 32); er = mfma16(uf[ks], br, er); ei = mfma16(uf[ks], bi, ei); }
  const int gp = g * 64 + w * 16 + fr;
  const float a16r = p.APW[gp], a16i = p.APW[2048 + gp];
  float xr[4], xi[4];
  xr[0] = er[0]; xi[0] = ei[0];
#pragma unroll
  for (int j = 1; j < 4; ++j) { xr[j] = a16r * xr[j - 1] - a16i * xi[j - 1] + er[j]; xi[j] = a16r * xi[j - 1] + a16i * xr[j - 1] + ei[j]; }
  float cr = 0.f, ci = 0.f;
  if (FINAL) {
    const float ar = p.APW[4 * 4096 + gp], ai = p.APW[4 * 4096 + 2048 + gp];
    const float* es = p.ESEG + ((size_t)(b * 32) * 32 + g) * 128 + w * 32 + fr;
    for (int j = 0; j < seg; ++j) { const float e_r = es[(size_t)j * 32 * 128], e_i = es[(size_t)j * 32 * 128 + 16]; const float nr = ar * cr - ai * ci + e_r, ni = ar * ci + ai * cr + e_i; cr = nr; ci = ni; }
  }
  const float a64r = p.APW[3 * 4096 + gp], a64i = p.APW[3 * 4096 + 2048 + gp];
  float tr = xr[3], ti = xi[3];
#pragma unroll
  for (int r = 0; r < 4; ++r) {
    float pr_ = __shfl(tr, (lane + 48) & 63), pi_ = __shfl(ti, (lane + 48) & 63);
    if (r == 0) { pr_ = cr; pi_ = ci; }
    if (fq == r) { const float nr = xr[3] + a64r * pr_ - a64i * pi_, ni = xi[3] + a64r * pi_ + a64i * pr_; tr = nr; ti = ni; }
  }
  if (!FINAL) {
    if (fq == 3) { float* es = p.ESEG + ((size_t)(b * 32 + seg) * 32 + g) * 128 + w * 32 + fr; es[0] = tr; es[16] = ti; }
    return;
  }
  float gr = __shfl(tr, (lane + 48) & 63), gi = __shfl(ti, (lane + 48) & 63);
  if (fq == 0) { gr = cr; gi = ci; }
  float pvr[4], pvi[4];
  pvr[0] = gr; pvi[0] = gi;
#pragma unroll
  for (int j = 1; j < 4; ++j) { const float ar = p.APW[(j - 1) * 4096 + gp], ai = p.APW[(j - 1) * 4096 + 2048 + gp]; pvr[j] = xr[j - 1] + ar * gr - ai * gi; pvi[j] = xi[j - 1] + ar * gi + ai * gr; }
  bf16_t* xl = (bf16_t*)lds;
  __syncthreads();
#pragma unroll
  for (int j = 0; j < 4; ++j) { xl[(fq * 4 + j) * 136 + w * 32 + fr] = f2bf(pvr[j]); xl[(fq * 4 + j) * 136 + w * 32 + 16 + fr] = f2bf(pvi[j]); }
  __syncthreads();
  bf16x8 xf[4];
#pragma unroll
  for (int ks = 0; ks < 4; ++ks) xf[ks] = *(const bf16x8*)(xl + fr * 136 + ks * 32 + fq * 8);
#pragma unroll
  for (int mi = 0; mi < 4; ++mi) {
    const int mt = w * 4 + mi;
    const bf16_t* wy = p.WY + ((size_t)g * 256 + mt * 16 + fr) * 384 + fq * 8;
    f32x4 y = (f32x4){0.f, 0.f, 0.f, 0.f};
#pragma unroll
    for (int ks = 0; ks < 4; ++ks) y = mfma16(*(const bf16x8*)(wy + ks * 32), xf[ks], y);
#pragma unroll
    for (int ks = 0; ks < 8; ++ks) if (2 * ks <= mt) y = mfma16(*(const bf16x8*)(wy + 128 + ks * 32), uf[ks], y);
    const size_t tok = (size_t)(t0 + fr * 16 + mt);
    const uint2 uu = *(const uint2*)(p.Ub + tok * 512 + g * 16 + fq * 4);
    const float4 dd = *(const float4*)(p.d_skip + g * 16 + fq * 4);
    const float y0 = gelu_f(y[0] + dd.x * __uint_as_float(uu.x << 16)), y1 = gelu_f(y[1] + dd.y * __uint_as_float(uu.x & 0xffff0000u));
    const float y2 = gelu_f(y[2] + dd.z * __uint_as_float(uu.y << 16)), y3 = gelu_f(y[3] + dd.w * __uint_as_float(uu.y & 0xffff0000u));
    *(uint2*)(p.YG + tok * 512 + g * 16 + fq * 4) = make_uint2(pack2(y0, y1), pack2(y2, y3));
  }
}

__device__ void tile_glu(const Params& p, int tile, char* lds) {
  const int rt = tile >> 2, ct = tile & 3; const int row0 = rt * 128, col0 = ct * 128;
  f32x4 acc[4][4];
  gemm_mainloop<false>(acc, p.YG, 512, p.WtGlu, 512, 512, row0, col0, lds, nullptr, nullptr, 0);
  EPI_IDS
  const int cw = col0 + wc * 64;
#pragma unroll
  for (int m = 0; m < 4; ++m) {
    const int row = row0 + wr * 64 + m * 16 + fr; float ss = 0.f;
#pragma unroll
    for (int n = 0; n < 4; ++n) { const int c = cw + n * 16 + fq * 4; const float4 bg = *(const float4*)(p.b_glu + c); const uint2 yy = *(const uint2*)(p.YG + (size_t)row * 512 + c);
      const float y0 = __uint_as_float(yy.x << 16), y1 = __uint_as_float(yy.x & 0xffff0000u), y2 = __uint_as_float(yy.y << 16), y3 = __uint_as_float(yy.y & 0xffff0000u);
      const float o0 = y0 / (1.f + __expf(-(acc[m][n][0] + bg.x))), o1 = y1 / (1.f + __expf(-(acc[m][n][1] + bg.y))), o2 = y2 / (1.f + __expf(-(acc[m][n][2] + bg.z))), o3 = y3 / (1.f + __expf(-(acc[m][n][3] + bg.w)));
      ss += o0 * o0 + o1 * o1 + o2 * o2 + o3 * o3;
      *(uint2*)(p.SSMO + (size_t)row * 512 + c) = make_uint2(pack2(o0, o1), pack2(o2, o3)); }
    ss += __shfl_xor(ss, 16); ss += __shfl_xor(ss, 32);
    if (fq == 0) p.ss_ssm[row * 8 + (cw >> 6)] = ss;
  }
}
__device__ void tile_wout(const Params& p, int tile, char* lds) {
  const int rt = tile >> 3, ct = tile & 7; const int row0 = rt * 128, col0 = ct * 128;
  f32x4 acc[4][4];
  float s0[4], s1[4];
  { const int sr = threadIdx.x >> 3;
#pragma unroll
    for (int i = 0; i < 4; ++i) { const int row = row0 + sr + 32 * i; float a = 0.f, c = 0.f;
#pragma unroll
      for (int j = 0; j < 8; ++j) { a += p.ss_att[row * 8 + j]; c += p.ss_ssm[row * 8 + j]; }
      s0[i] = rsqrtf(a * (1.0f / 512.0f) + EPSF); s1[i] = rsqrtf(c * (1.0f / 512.0f) + EPSF); } }
  gemm_mainloop<true, true>(acc, p.ATT, 512, p.WtOut, 1024, 512, row0, col0, lds, s0, s0, 1 << 30);
  gemm_mainloop<true, false>(acc, p.SSMO, 512, p.WtOut + 512, 1024, 512, row0, col0, lds, s1, s1, 1 << 30);
  EPI_IDS
  const int cw = col0 + wc * 64;
#pragma unroll
  for (int m = 0; m < 4; ++m) {
    const int row = row0 + wr * 64 + m * 16 + fr; float ss = 0.f;
#pragma unroll
    for (int n = 0; n < 4; ++n) { const int c = cw + n * 16 + fq * 4; const f32x4 xv = *(const f32x4*)(p.x + (size_t)row * 1024 + c); const f32x4 hv = xv + acc[m][n];
      ss += hv[0] * hv[0] + hv[1] * hv[1] + hv[2] * hv[2] + hv[3] * hv[3];
      *(f32x4*)(p.out + (size_t)row * 1024 + c) = hv; *(uint2*)(p.H1B + (size_t)row * 1024 + c) = make_uint2(pack2(hv[0], hv[1]), pack2(hv[2], hv[3])); }
    ss += __shfl_xor(ss, 16); ss += __shfl_xor(ss, 32);
    if (fq == 0) p.ss_h1[row * 16 + (cw >> 6)] = ss;
  }
}
__device__ __forceinline__ float row_rs16(const float* ss, int row) { float a = 0.f;
#pragma unroll
  for (int j = 0; j < 16; ++j) a += ss[row * 16 + j];
  return rsqrtf(a * (1.0f / 1024.0f) + EPSF); }
__device__ void tile_memq(const Params& p, int tile, char* lds) {
  const int rt = tile >> 3, ct = tile & 7; const int row0 = rt * 128, col0 = ct * 128;
  f32x4 acc[4][4];
  gemm_mainloop<false>(acc, p.H1B, 1024, p.WtMq, 1024, 1024, row0, col0, lds, nullptr, nullptr, 0);
  EPI_IDS
  const int cw = col0 + wc * 64;
#pragma unroll
  for (int m = 0; m < 4; ++m) {
    const int row = row0 + wr * 64 + m * 16 + fr; const float rs = row_rs16(p.ss_h1, row); float ss = 0.f;
#pragma unroll
    for (int n = 0; n < 4; ++n) { const int c = cw + n * 16 + fq * 4; const f32x4 v = acc[m][n] * rs; ss += v[0] * v[0] + v[1] * v[1] + v[2] * v[2] + v[3] * v[3];
      *(uint2*)(p.QM + (size_t)row * 1024 + c) = make_uint2(pack2(v[0], v[1]), pack2(v[2], v[3])); }
    ss += __shfl_xor(ss, 16); ss += __shfl_xor(ss, 32);
    if (fq == 0) p.ss_qm[row * 16 + (cw >> 6)] = ss;
  }
}
__device__ void mem_attn_item(const Params& p, int item) {
  const int h = item & 3, tt = item >> 2; const int tid = threadIdx.x, lane = tid & 63, w = tid >> 6, fr = lane & 15, fq = lane >> 4;
  const int tq = tt * 64 + w * 16 + fr; const int b = tq >> 13;
  const float ssq = p.ss_qm[tq * 16 + h * 4] + p.ss_qm[tq * 16 + h * 4 + 1] + p.ss_qm[tq * 16 + h * 4 + 2] + p.ss_qm[tq * 16 + h * 4 + 3];
  const float rowscale = rsqrtf(ssq * (1.0f / 256.0f) + EPSF) * 0.0625f;
  f32x4 st[16];
  {
    bf16x8 qf[8];
#pragma unroll
    for (int ks = 0; ks < 8; ++ks) qf[ks] = *(const bf16x8*)(p.QM + (size_t)tq * 1024 + h * 256 + ks * 32 + fq * 8);
    const bf16_t* kb = p.KMB + ((size_t)(b * 4 + h) * 256 + fr) * 256 + fq * 8;
#pragma unroll
    for (int mt = 0; mt < 16; ++mt) { f32x4 s = (f32x4){0.f, 0.f, 0.f, 0.f};
#pragma unroll
      for (int ks = 0; ks < 8; ++ks) s = mfma16(*(const bf16x8*)(kb + (size_t)(mt * 16) * 256 + ks * 32), qf[ks], s);
      st[mt] = s * rowscale; }
  }
  float mx = -1e30f;
#pragma unroll
  for (int mt = 0; mt < 16; ++mt) mx = fmaxf(fmaxf(fmaxf(mx, st[mt][0]), fmaxf(st[mt][1], st[mt][2])), st[mt][3]);
  mx = fmaxf(mx, __shfl_xor(mx, 16)); mx = fmaxf(mx, __shfl_xor(mx, 32));
  float l = 0.f;
#pragma unroll
  for (int mt = 0; mt < 16; ++mt)
#pragma unroll
    for (int j = 0; j < 4; ++j) { const float e = __expf(st[mt][j] - mx); st[mt][j] = e; l += e; }
  l += __shfl_xor(l, 16); l += __shfl_xor(l, 32);
  const float inv = 1.0f / l;
  bf16x8 pf[8];
#pragma unroll
  for (int s2 = 0; s2 < 8; ++s2) { union { bf16x8 v; unsigned u[4]; } t; t.u[0] = pack2(st[2 * s2][0], st[2 * s2][1]); t.u[1] = pack2(st[2 * s2][2], st[2 * s2][3]); t.u[2] = pack2(st[2 * s2 + 1][0], st[2 * s2 + 1][1]); t.u[3] = pack2(st[2 * s2 + 1][2], st[2 * s2 + 1][3]); pf[s2] = t.v; }
  const bf16_t* vb = p.VMT + ((size_t)(b * 4 + h) * 256 + fr) * 256 + fq * 4;
  bf16_t* dst = p.OM + (size_t)tq * 1024 + h * 256;
#pragma unroll 4
  for (int dt = 0; dt < 16; ++dt) { f32x4 o = (f32x4){0.f, 0.f, 0.f, 0.f};
#pragma unroll
    for (int s2 = 0; s2 < 8; ++s2) { const bf16_t* vr = vb + (size_t)(dt * 16) * 256 + s2 * 32; union { bf16x8 v; uint2 u[2]; } vf; vf.u[0] = *(const uint2*)vr; vf.u[1] = *(const uint2*)(vr + 16); o = mfma16(vf.v, pf[s2], o); }
    o *= inv; *(uint2*)(dst + dt * 16 + fq * 4) = make_uint2(pack2(o[0], o[1]), pack2(o[2], o[3])); }
}
__device__ void tile_memo(const Params& p, int tile, char* lds) {
  const int rt = tile >> 3, ct = tile & 7; const int row0 = rt * 128, col0 = ct * 128;
  f32x4 acc[4][4];
  gemm_mainloop<false>(acc, p.OM, 1024, p.WtMo, 1024, 1024, row0, col0, lds, nullptr, nullptr, 0);
  EPI_IDS
  const int cw = col0 + wc * 64;
#pragma unroll
  for (int m = 0; m < 4; ++m) {
    const int row = row0 + wr * 64 + m * 16 + fr; float ss = 0.f;
#pragma unroll
    for (int n = 0; n < 4; ++n) { const int c = cw + n * 16 + fq * 4; float* op = p.out + (size_t)row * 1024 + c; const f32x4 hv = *(const f32x4*)op + acc[m][n];
      ss += hv[0] * hv[0] + hv[1] * hv[1] + hv[2] * hv[2] + hv[3] * hv[3];
      *(f32x4*)op = hv; *(uint2*)(p.H2B + (size_t)row * 1024 + c) = make_uint2(pack2(hv[0], hv[1]), pack2(hv[2], hv[3])); }
    ss += __shfl_xor(ss, 16); ss += __shfl_xor(ss, 32);
    if (fq == 0) p.ss_h2[row * 16 + (cw >> 6)] = ss;
  }
}
__device__ void tile_peerq(const Params& p, int tile, char* lds) {
  const int rt = tile >> 4, ct = tile & 15; const int row0 = rt * 128, col0 = ct * 128;
  f32x4 acc[4][4];
  gemm_mainloop<false>(acc, p.H2B, 1024, p.WtPq, 1024, 1024, row0, col0, lds, nullptr, nullptr, 0);
  EPI_IDS
  const int cw = col0 + wc * 64;
#pragma unroll
  for (int m = 0; m < 4; ++m) {
    const int row = row0 + wr * 64 + m * 16 + fr; const float rs = row_rs16(p.ss_h2, row);
#pragma unroll
    for (int n = 0; n < 4; ++n) { const int c = cw + n * 16 + fq * 4; const f32x4 v = acc[m][n] * rs;
      *(uint2*)(p.QP + (size_t)row * 2048 + c) = make_uint2(pack2(v[0], v[1]), pack2(v[2], v[3])); }
  }
}
__device__ __forceinline__ void ins16(float (&a)[16], float v) {
#pragma unroll
  for (int i = 0; i < 16; ++i) { const float hi = fmaxf(a[i], v), lo = fminf(a[i], v); a[i] = hi; v = lo; }
}
__device__ void tile_scores(const Params& p, int tile, char* lds) {
  const int rt = tile >> 4, hs = tile & 15; const int row0 = rt * 128;
  f32x4 acc[4][4];
  gemm_mainloop<false>(acc, p.QP + hs * 128, 2048, p.PK + (size_t)hs * 128 * 128, 128, 128, row0, 0, lds, nullptr, nullptr, 0);
  EPI_IDS
  float* tl = (float*)lds;
#pragma unroll
  for (int m = 0; m < 4; ++m)
#pragma unroll
    for (int n = 0; n < 4; ++n)
#pragma unroll
      for (int j = 0; j < 4; ++j) tl[(wr * 64 + m * 16 + fr) * 129 + wc * 64 + n * 16 + fq * 4 + j] = acc[m][n][j];
  __syncthreads();
  if (tid < 128) {
    float a[16];
#pragma unroll
    for (int i = 0; i < 16; ++i) a[i] = -__builtin_inff();
    for (int n = 0; n < 128; ++n) { const float v = __uint_as_float((__float_as_uint(tl[tid * 129 + n]) & ~127u) | (unsigned)n); ins16(a, v); }
    uint4* dst = (uint4*)(p.TOPS + ((size_t)(row0 + tid) * 16 + hs) * 16);
    dst[0] = make_uint4(__float_as_uint(a[0]), __float_as_uint(a[1]), __float_as_uint(a[2]), __float_as_uint(a[3]));
    dst[1] = make_uint4(__float_as_uint(a[4]), __float_as_uint(a[5]), __float_as_uint(a[6]), __float_as_uint(a[7]));
    dst[2] = make_uint4(__float_as_uint(a[8]), __float_as_uint(a[9]), __float_as_uint(a[10]), __float_as_uint(a[11]));
    dst[3] = make_uint4(__float_as_uint(a[12]), __float_as_uint(a[13]), __float_as_uint(a[14]), __float_as_uint(a[15]));
  }
}
__device__ void peer_gather_item(const Params& p, int item, char* lds) {
  const int tid = threadIdx.x, lane = tid & 63, w = tid >> 6;
  unsigned* LA = (unsigned*)lds;
  int* LE = (int*)(lds + 256 * 33 * 4);
  float* LG = (float*)(lds + 256 * 33 * 4 + 32 * 128 * 4);
  __syncthreads();
  {
    const int tl_ = tid >> 3, h = tid & 7; const int t = item * 32 + tl_;
    const uint4* src = (const uint4*)(p.TOPS + ((size_t)t * 16 + h * 2) * 16);
    float a[16], bq[16];
#pragma unroll
    for (int i = 0; i < 4; ++i) { const uint4 v = src[i]; a[4 * i] = __uint_as_float(v.x); a[4 * i + 1] = __uint_as_float(v.y); a[4 * i + 2] = __uint_as_float(v.z); a[4 * i + 3] = __uint_as_float(v.w); }
#pragma unroll
    for (int i = 0; i < 4; ++i) { const uint4 v = src[4 + i]; bq[4 * i] = __uint_as_float(v.x); bq[4 * i + 1] = __uint_as_float(v.y); bq[4 * i + 2] = __uint_as_float(v.z); bq[4 * i + 3] = __uint_as_float(v.w); }
#pragma unroll
    for (int i = 0; i < 16; ++i) { LA[tid * 33 + i] = __float_as_uint(a[i]); LA[tid * 33 + 16 + i] = __float_as_uint(bq[i]); }
    float c[16];
#pragma unroll
    for (int i = 0; i < 16; ++i) c[i] = -__builtin_inff();
#pragma unroll
    for (int i = 0; i < 16; ++i)
#pragma unroll
      for (int j = 0; j < 16; ++j) if ((i + 1) * (j + 1) <= 16) { const float s = a[i] + bq[j]; ins16(c, __uint_as_float((__float_as_uint(s) & ~255u) | (unsigned)(i * 16 + j))); }
    const float mx = c[0]; float e[16]; float sum = 0.f;
#pragma unroll
    for (int i = 0; i < 16; ++i) { e[i] = __expf(c[i] - mx); sum += e[i]; }
    const float inv = 1.0f / sum;
#pragma unroll
    for (int i = 0; i < 16; ++i) { const unsigned pos = __float_as_uint(c[i]) & 255u; const unsigned ia = LA[tid * 33 + (pos >> 4)] & 127u, ib = LA[tid * 33 + 16 + (pos & 15u)] & 127u;
      LE[tl_ * 128 + h * 16 + i] = (int)(ia * 128u + ib); LG[tl_ * 128 + h * 16 + i] = e[i] * inv; }
  }
  __syncthreads();
  for (int ti = 0; ti < 8; ++ti) {
    const int tl_ = w * 8 + ti; const int t = item * 32 + tl_;
    const float rs = row_rs16(p.ss_h2, t);
    float hn[16]; float* op = p.out + (size_t)t * 1024;
    { const float4 a0 = *(const float4*)(op + lane * 8), a1 = *(const float4*)(op + lane * 8 + 4), b0 = *(const float4*)(op + 512 + lane * 8), b1 = *(const float4*)(op + 512 + lane * 8 + 4);
      const float4 g0 = *(const float4*)(p.norm_peer_g + lane * 8), g1 = *(const float4*)(p.norm_peer_g + lane * 8 + 4), g2 = *(const float4*)(p.norm_peer_g + 512 + lane * 8), g3 = *(const float4*)(p.norm_peer_g + 512 + lane * 8 + 4);
      hn[0] = a0.x * rs * g0.x; hn[1] = a0.y * rs * g0.y; hn[2] = a0.z * rs * g0.z; hn[3] = a0.w * rs * g0.w; hn[4] = a1.x * rs * g1.x; hn[5] = a1.y * rs * g1.y; hn[6] = a1.z * rs * g1.z; hn[7] = a1.w * rs * g1.w;
      hn[8] = b0.x * rs * g2.x; hn[9] = b0.y * rs * g2.y; hn[10] = b0.z * rs * g2.z; hn[11] = b0.w * rs * g2.w; hn[12] = b1.x * rs * g3.x; hn[13] = b1.y * rs * g3.y; hn[14] = b1.z * rs * g3.z; hn[15] = b1.w * rs * g3.w; }
    float oa[16];
#pragma unroll
    for (int i = 0; i < 16; ++i) oa[i] = 0.f;
#pragma unroll 2
    for (int k = 0; k < 128; ++k) {
      const int e = LE[tl_ * 128 + k]; const float gg = LG[tl_ * 128 + k];
      const bf16_t* ur = p.PU + (size_t)e * 1024 + lane * 8; const uint4 ua = *(const uint4*)ur, ub = *(const uint4*)(ur + 512);
      const bf16_t* vr = p.PV + (size_t)e * 1024 + lane * 8; const uint4 va = *(const uint4*)vr, vb = *(const uint4*)(vr + 512);
      float d = 0.f;
      d += __uint_as_float(ua.x << 16) * hn[0] + __uint_as_float(ua.x & 0xffff0000u) * hn[1] + __uint_as_float(ua.y << 16) * hn[2] + __uint_as_float(ua.y & 0xffff0000u) * hn[3];
      d += __uint_as_float(ua.z << 16) * hn[4] + __uint_as_float(ua.z & 0xffff0000u) * hn[5] + __uint_as_float(ua.w << 16) * hn[6] + __uint_as_float(ua.w & 0xffff0000u) * hn[7];
      d += __uint_as_float(ub.x << 16) * hn[8] + __uint_as_float(ub.x & 0xffff0000u) * hn[9] + __uint_as_float(ub.y << 16) * hn[10] + __uint_as_float(ub.y & 0xffff0000u) * hn[11];
      d += __uint_as_float(ub.z << 16) * hn[12] + __uint_as_float(ub.z & 0xffff0000u) * hn[13] + __uint_as_float(ub.w << 16) * hn[14] + __uint_as_float(ub.w & 0xffff0000u) * hn[15];
#pragma unroll
      for (int o = 32; o > 0; o >>= 1) d += __shfl_xor(d, o);
      const float wgt = gg * gelu_f(d);
      oa[0] += wgt * __uint_as_float(va.x << 16); oa[1] += wgt * __uint_as_float(va.x & 0xffff0000u); oa[2] += wgt * __uint_as_float(va.y << 16); oa[3] += wgt * __uint_as_float(va.y & 0xffff0000u);
      oa[4] += wgt * __uint_as_float(va.z << 16); oa[5] += wgt * __uint_as_float(va.z & 0xffff0000u); oa[6] += wgt * __uint_as_float(va.w << 16); oa[7] += wgt * __uint_as_float(va.w & 0xffff0000u);
      oa[8] += wgt * __uint_as_float(vb.x << 16); oa[9] += wgt * __uint_as_float(vb.x & 0xffff0000u); oa[10] += wgt * __uint_as_float(vb.y << 16); oa[11] += wgt * __uint_as_float(vb.y & 0xffff0000u);
      oa[12] += wgt * __uint_as_float(vb.z << 16); oa[13] += wgt * __uint_as_float(vb.z & 0xffff0000u); oa[14] += wgt * __uint_as_float(vb.w << 16); oa[15] += wgt * __uint_as_float(vb.w & 0xffff0000u);
    }
    { float4 a0 = *(const float4*)(op + lane * 8), a1 = *(const float4*)(op + lane * 8 + 4), b0 = *(const float4*)(op + 512 + lane * 8), b1 = *(const float4*)(op + 512 + lane * 8 + 4);
      a0.x += oa[0]; a0.y += oa[1]; a0.z += oa[2]; a0.w += oa[3]; a1.x += oa[4]; a1.y += oa[5]; a1.z += oa[6]; a1.w += oa[7];
      b0.x += oa[8]; b0.y += oa[9]; b0.z += oa[10]; b0.w += oa[11]; b1.x += oa[12]; b1.y += oa[13]; b1.z += oa[14]; b1.w += oa[15];
      *(float4*)(op + lane * 8) = a0; *(float4*)(op + lane * 8 + 4) = a1; *(float4*)(op + 512 + lane * 8) = b0; *(float4*)(op + 512 + lane * 8 + 4) = b1; }
  }
}

template <int PH>
__device__ __forceinline__ void run_phase(const Params& p, char* lds, int bid, int nb) {
  if (PH == 0) {
    const int nt_in = 16 * 32, nt_glu = 8 * 8, nt_out = 16 * 16, nt_m = 16 * 16, nt_pq = 16 * 32;
    const int total = nt_in + nt_glu + nt_out + 4 * nt_m + nt_pq;
    for (int t = bid; t < total; t += nb) {
      int i = t; float* tl = (float*)lds;
      if (i < nt_in) { transpose_tile(p.w_in, p.WtIn, 1024, 2048, i, p.norm_mix_g, p.norm_mix_g, 1024, tl); continue; } i -= nt_in;
      if (i < nt_glu) { transpose_tile(p.w_glu, p.WtGlu, 512, 512, i, nullptr, nullptr, 0, tl); continue; } i -= nt_glu;
      if (i < nt_out) { transpose_tile(p.w_out, p.WtOut, 1024, 1024, i, p.att_out_g, p.ssm_out_g, 512, tl); continue; } i -= nt_out;
      if (i < nt_m) { transpose_tile(p.w_mem_q, p.WtMq, 1024, 1024, i, p.norm_mem_g, p.norm_mem_g, 1024, tl); continue; } i -= nt_m;
      if (i < nt_m) { transpose_tile(p.w_mem_k, p.WtMk, 1024, 1024, i, p.norm_memkv_g, p.norm_memkv_g, 1024, tl); continue; } i -= nt_m;
      if (i < nt_m) { transpose_tile(p.w_mem_v, p.WtMv, 1024, 1024, i, p.norm_memkv_g, p.norm_memkv_g, 1024, tl); continue; } i -= nt_m;
      if (i < nt_m) { transpose_tile(p.w_mem_o, p.WtMo, 1024, 1024, i, nullptr, nullptr, 0, tl); continue; } i -= nt_m;
      transpose_tile(p.w_peer_q, p.WtPq, 1024, 2048, i, p.norm_peer_g, p.norm_peer_g, 1024, tl);
    }
    convert_flat(p.peer_keys, p.PK, (size_t)16 * 128 * 128 / 8, bid, nb);
    convert_flat(p.peer_u, p.PU, (size_t)16384 * 1024 / 8, bid, nb);
    convert_flat(p.peer_v, p.PV, (size_t)16384 * 1024 / 8, bid, nb);
    rows_bf16_rs(p.x, p.XB, p.rs_x, T_TOK, bid, nb);
    rows_bf16_rs(p.mem, p.MEMB, p.rs_mem, 512, bid, nb);
    for (int i = bid * NTHREADS + threadIdx.x; i < 2048; i += nb * NTHREADS) ssm_stage1(p, i);
  } else if (PH == 1) {
    for (int t = bid; t < 2048 + 64; t += nb) { if (t < 2048) tile_win(p, t, lds); else tile_memkv(p, t - 2048, lds); }
    ssm_stage2(p, bid, nb);
  } else if (PH == 2) {
    for (int t = bid; t < 2048; t += nb) chunk_attn_item(p, t, (float*)lds);
    for (int t = bid; t < 2048; t += nb) ssm_item<false>(p, t, lds);
    memk_fix(p, bid, nb);
  } else if (PH == 3) {
    for (int t = bid; t < 2048; t += nb) ssm_item<true>(p, t, lds);
  } else if (PH == 4) {
    for (int t = bid; t < 512; t += nb) tile_glu(p, t, lds);
  } else if (PH == 5) {
    for (int t = bid; t < 1024; t += nb) tile_wout(p, t, lds);
  } else if (PH == 6) {
    for (int t = bid; t < 1024; t += nb) tile_memq(p, t, lds);
  } else if (PH == 7) {
    for (int t = bid; t < 1024; t += nb) mem_attn_item(p, t);
  } else if (PH == 8) {
    for (int t = bid; t < 1024; t += nb) tile_memo(p, t, lds);
  } else if (PH == 9) {
    for (int t = bid; t < 2048; t += nb) tile_peerq(p, t, lds);
  } else if (PH == 10) {
    for (int t = bid; t < 2048; t += nb) tile_scores(p, t, lds);
  } else if (PH == 11) {
    for (int t = bid; t < 512; t += nb) peer_gather_item(p, t, lds);
  }
}

template <int PH>
__global__ void __launch_bounds__(NTHREADS, 2) phase_kernel(Params p) {
  extern __shared__ __attribute__((aligned(16))) char lds[];
  run_phase<PH>(p, lds, blockIdx.x, gridDim.x);
}

__global__ void __launch_bounds__(NTHREADS, 2) mega_kernel(Params p) {
  extern __shared__ __attribute__((aligned(16))) char lds[];
  cg::grid_group grid = cg::this_grid();
  const int bid = blockIdx.x, nb = gridDim.x;
  run_phase<0>(p, lds, bid, nb); grid.sync();
  run_phase<1>(p, lds, bid, nb); grid.sync();
  run_phase<2>(p, lds, bid, nb); grid.sync();
  run_phase<3>(p, lds, bid, nb); grid.sync();
  run_phase<4>(p, lds, bid, nb); grid.sync();
  run_phase<5>(p, lds, bid, nb); grid.sync();
  run_phase<6>(p, lds, bid, nb); grid.sync();
  run_phase<7>(p, lds, bid, nb); grid.sync();
  run_phase<8>(p, lds, bid, nb); grid.sync();
  run_phase<9>(p, lds, bid, nb); grid.sync();
  run_phase<10>(p, lds, bid, nb); grid.sync();
  run_phase<11>(p, lds, bid, nb);
}

template <int PH> static void launch_phase(const Params& p, int grid, hipStream_t s) {
  hipFuncSetAttribute((const void*)phase_kernel<PH>, hipFuncAttributeMaxDynamicSharedMemorySize, LDS_BYTES);
  phase_kernel<PH><<<grid, NTHREADS, LDS_BYTES, s>>>(p);
}

extern "C" void kernel_launch(void* const* d_in, const int* in_sizes, int n_in, void* d_out, int out_size, void* d_ws, size_t ws_size, hipStream_t stream) {
  Params p{};
  const float** f = (const float**)&p;
  for (int i = 0; i < 33; ++i) f[i] = (const float*)d_in[i];
  p.out = (float*)d_out;
  char* ws = (char*)d_ws; size_t off = 0;
  auto take = [&](size_t bytes) { char* r = ws + off; off += (bytes + 255) & ~(size_t)255; return r; };
  const size_t MB = 1u << 20;
  p.bar = (unsigned*)take(16384);
  p.WtIn = (bf16_t*)take(4 * MB); p.WtGlu = (bf16_t*)take(MB / 2); p.WtOut = (bf16_t*)take(2 * MB);
  p.WtMq = (bf16_t*)take(2 * MB); p.WtMk = (bf16_t*)take(2 * MB); p.WtMv = (bf16_t*)take(2 * MB); p.WtMo = (bf16_t*)take(2 * MB); p.WtPq = (bf16_t*)take(4 * MB);
  p.PK = (bf16_t*)take(MB / 2); p.PU = (bf16_t*)take(32 * MB); p.PV = (bf16_t*)take(32 * MB);
  char* RA = take(64 * MB); char* RB = take(64 * MB);
  p.XB = (bf16_t*)RA; p.ATT = (bf16_t*)RA; p.YG = (bf16_t*)(RA + 16 * MB); p.QM = (bf16_t*)RA; p.H2B = (bf16_t*)RA;
  p.SSMO = (bf16_t*)(RA + 32 * MB); p.OM = (bf16_t*)(RA + 32 * MB);
  p.Qb = (bf16_t*)RB; p.Kb = (bf16_t*)(RB + 16 * MB); p.VT = (bf16_t*)(RB + 32 * MB); p.Ub = (bf16_t*)(RB + 48 * MB); p.H1B = (bf16_t*)RB; p.QP = (bf16_t*)RB;
  p.TOPS = (unsigned*)take(16 * MB);
  p.MEMB = (bf16_t*)take(MB); p.KMB = (bf16_t*)take(MB); p.VMT = (bf16_t*)take(MB); p.KMraw = (float*)take(2 * MB);
  p.WE16 = (bf16_t*)take(2 * MB); p.WY = (bf16_t*)take(6 * MB);
  p.rs_x = (float*)take(T_TOK * 4); p.rs_mem = (float*)take(512 * 4); p.ss_att = (float*)take(T_TOK * 8 * 4); p.ss_ssm = (float*)take(T_TOK * 8 * 4);
  p.ss_h1 = (float*)take(T_TOK * 16 * 4); p.ss_qm = (float*)take(T_TOK * 16 * 4); p.ss_km = (float*)take(512 * 16 * 4); p.ss_h2 = (float*)take(T_TOK * 16 * 4);
  p.ESEG = (float*)take(2 * 32 * 32 * 128 * 4);
  p.BBR = (float*)take(2048 * 16 * 4); p.BBI = (float*)take(2048 * 16 * 4); p.PWR = (float*)take(32 * 17 * 64 * 4); p.PWI = (float*)take(32 * 17 * 64 * 4); p.APW = (float*)take(5 * 4096 * 4);
  if (off > ws_size) { fprintf(stderr, "workspace too small: need %zu have %zu\n", off, ws_size); return; }
#if MEGA
  static int grid_blocks = 0;
  if (!grid_blocks) {
    int dev = 0, cus = 0, per_cu = 0; hipGetDevice(&dev); hipDeviceGetAttribute(&cus, hipDeviceAttributeMultiprocessorCount, dev);
    hipFuncSetAttribute((const void*)mega_kernel, hipFuncAttributeMaxDynamicSharedMemorySize, LDS_BYTES);
    hipOccupancyMaxActiveBlocksPerMultiprocessor(&per_cu, mega_kernel, NTHREADS, LDS_BYTES);
    if (per_cu > 2) per_cu = 2; if (per_cu < 1) per_cu = 1;
    grid_blocks = cus * per_cu;
  }
  void* args[] = {&p};
  hipError_t e = hipLaunchCooperativeKernel((void*)mega_kernel, dim3(grid_blocks), dim3(NTHREADS), args, LDS_BYTES, stream);
  if (e != hipSuccess) fprintf(stderr, "cooperative launch failed: %s (grid %d)\n", hipGetErrorString(e), grid_blocks);
#else
  const int G = 1024;
  launch_phase<0>(p, G, stream); launch_phase<1>(p, G, stream); launch_phase<2>(p, G, stream); launch_phase<3>(p, G, stream);
  launch_phase<4>(p, G, stream); launch_phase<5>(p, G, stream); launch_phase<6>(p, G, stream); launch_phase<7>(p, G, stream);
  launch_phase<8>(p, G, stream); launch_phase<9>(p, G, stream); launch_phase<10>(p, G, stream); launch_phase<11>(p, G, stream);
#endif
}
```

```cpp
#include <hip/hip_runtime.h>
#include <hip/hip_cooperative_groups.h>
#include <cstdio>
#include <cstdint>
namespace cg = cooperative_groups;

#ifndef MEGA
#define MEGA 1
#endif

typedef unsigned short bf16_t;
typedef short bf16x8 __attribute__((ext_vector_type(8)));
typedef float f32x4 __attribute__((ext_vector_type(4)));
typedef unsigned u32x4 __attribute__((ext_vector_type(4)));
#define LAS __attribute__((address_space(3)))
__device__ __forceinline__ bf16x8 as_bf(u32x4 v) { return __builtin_bit_cast(bf16x8, v); }

#define T_TOK 16384
#define SEQL 8192
#define NTHREADS 256
#define LDS_WORK 66560
#define LDS_BYTES (LDS_WORK + 16)
#define EPSF 1e-6f

__device__ __forceinline__ unsigned short f2bf(float f) { unsigned u = __float_as_uint(f); u += 0x7fffu + ((u >> 16) & 1u); return (unsigned short)(u >> 16); }
__device__ __forceinline__ float bf2f(unsigned short b) { return __uint_as_float(((unsigned)b) << 16); }
__device__ __forceinline__ unsigned pack2(float lo, float hi) { return (unsigned)f2bf(lo) | ((unsigned)f2bf(hi) << 16); }
__device__ __forceinline__ float gelu_f(float x) { return 0.5f * x * (1.0f + erff(x * 0.70710678118654752f)); }
__device__ __forceinline__ f32x4 mfma16(bf16x8 a, bf16x8 b, f32x4 c) { return __builtin_amdgcn_mfma_f32_16x16x32_bf16(a, b, c, 0, 0, 0); }


#define XB_TMO      128
#define XB_XCNT(j)  (256  + 64 * (j))
#define XB_XSUB(j)  (1280 + 64 * (j))
#define XB_XGEN(j)  (2304 + 64 * (j))
#define XB_TOP      3328
#define XB_TOPGEN   3392
#define XCD_BAR_WORDS 3456
#define XB_SPIN_CAP (1u << 18)
__device__ __forceinline__ unsigned xb_ld(unsigned* p)              { return __hip_atomic_load(p, __ATOMIC_RELAXED, __HIP_MEMORY_SCOPE_AGENT); }
__device__ __forceinline__ unsigned xb_add(unsigned* p, unsigned v) { return __hip_atomic_fetch_add(p, v, __ATOMIC_RELAXED, __HIP_MEMORY_SCOPE_AGENT); }
__device__ __forceinline__ unsigned xb_xcc_id() { return (unsigned)__builtin_amdgcn_s_getreg((3 << 11) | 20) & 0xFu; }
#define XB_SPIN(cond, bar) do { unsigned _sp = 0; while (cond) { __builtin_amdgcn_s_sleep(1); \
    if ((++_sp & 255u) == 0u) { if (xb_ld(&(bar)[XB_TMO])) break; if (_sp > XB_SPIN_CAP) { atomicAdd(&(bar)[XB_TMO], 1u); break; } } } } while (0)
struct XcdBarrier { unsigned* bar; unsigned x; volatile LAS unsigned* st; };
__device__ __forceinline__ XcdBarrier xcd_barrier_post(unsigned* bar, volatile LAS unsigned* st) {
  XcdBarrier b; b.bar = bar; b.x = xb_xcc_id(); b.st = st;
  if (threadIdx.x == 0) (void)xb_add(&bar[XB_XCNT(b.x)], 1u);
  return b;
}
__device__ __forceinline__ void xcd_barrier_complete(unsigned* bar, unsigned x, unsigned& nloc, unsigned& nx) {
  const unsigned G = gridDim.x * gridDim.y * gridDim.z;
  unsigned sum, cnt, mine, sp = 0u;
  for (;;) {
    sum = 0u; cnt = 0u; mine = 0u;
#pragma unroll
    for (unsigned j = 0; j < 16; ++j) { const unsigned c = xb_ld(&bar[XB_XCNT(j)]); sum += c; cnt += (c > 0u) ? 1u : 0u; mine = (j == x) ? c : mine; }
    if (sum == G) break;
    __builtin_amdgcn_s_sleep(1);
    if ((++sp & 255u) == 0u) { if (xb_ld(&bar[XB_TMO])) break; if (sp > XB_SPIN_CAP) { atomicAdd(&bar[XB_TMO], 1u); break; } }
  }
  nloc = mine > 0u ? mine : 1u; nx = cnt > 0u ? cnt : 1u;
}
__device__ __forceinline__ void xcd_barrier(const XcdBarrier& b) {
  asm volatile("s_waitcnt vmcnt(0)" ::: "memory");
  __syncthreads();
  if (threadIdx.x == 0) {
    unsigned* bar = b.bar;
    __builtin_amdgcn_s_waitcnt(0);
    unsigned nloc = b.st[0], nx = b.st[1];
    if (nloc == 0u) { xcd_barrier_complete(bar, b.x, nloc, nx); b.st[0] = nloc; b.st[1] = nx; }
    const unsigned old = xb_add(&bar[XB_XSUB(b.x)], 1u);
    const unsigned gen = old / nloc;
    if (old + 1u == (gen + 1u) * nloc) {
      __builtin_amdgcn_fence(__ATOMIC_RELEASE, "agent");
      asm volatile("s_waitcnt vmcnt(0)" ::: "memory");
      const unsigned og = xb_add(&bar[XB_TOP], 1u);
      const unsigned tg = og / nx;
      if (og + 1u == (tg + 1u) * nx) xb_add(&bar[XB_TOPGEN], 1u);
      else XB_SPIN(xb_ld(&bar[XB_TOPGEN]) == tg, bar);
      __builtin_amdgcn_fence(__ATOMIC_ACQUIRE, "agent");
      xb_add(&bar[XB_XGEN(b.x)], 1u);
      asm volatile("s_waitcnt vmcnt(0)" ::: "memory");
    } else {
      XB_SPIN(xb_ld(&bar[XB_XGEN(b.x)]) == gen, bar);
      __builtin_amdgcn_fence(__ATOMIC_ACQUIRE, "agent");
      asm volatile("s_waitcnt vmcnt(0)" ::: "memory");
    }
  }
  __syncthreads();
}

struct Params {
  const float *x, *mem, *norm_mix_g, *w_in, *att_q_g, *att_k_g, *rel_bias;
  const float *lam_re, *lam_im, *log_step, *b_re, *b_im, *c_re, *c_im, *d_skip, *w_glu, *b_glu;
  const float *att_out_g, *ssm_out_g, *w_out, *norm_mem_g, *norm_memkv_g, *w_mem_q, *w_mem_k, *w_mem_v;
  const float *mem_q_g, *mem_k_g, *w_mem_o, *norm_peer_g, *w_peer_q, *peer_keys, *peer_u, *peer_v;
  float* out;
  unsigned* bar;
  bf16_t *WtIn, *WtGlu, *WtOut, *WtMq, *WtMk, *WtMv, *WtMo, *WtPq, *PK, *PU, *PV;
  bf16_t *XB, *MEMB, *Qb, *Kb, *VT, *Ub, *ATT, *YG, *SSMO, *H1B, *QM, *OM, *H2B, *QP;
  bf16_t *KMB, *VMT, *WE16, *WY;
  float *rs_x, *rs_mem, *ss_att, *ss_ssm, *ss_h1, *ss_qm, *ss_km, *ss_h2, *KMraw, *ESEG;
  float *BBR, *BBI, *PWR, *PWI, *APW;
  unsigned* TOPS;
};

template <bool ASC, bool ZERO = true>
__device__ __forceinline__ void gemm_mainloop(f32x4 (&acc)[4][4], const bf16_t* __restrict__ A, int lda, const bf16_t* __restrict__ Bt, int ldb, int K,
                                              int row0, int col0, char* lds_, const float* s0, const float* s1, int ksplit) {
  LAS char* lds = (LAS char*)lds_;
  const int tid = threadIdx.x, lane = tid & 63, w = tid >> 6, wr = w >> 1, wc = w & 1, fr = lane & 15, fq = lane >> 4;
  if (ZERO) {
#pragma unroll
    for (int m = 0; m < 4; ++m)
#pragma unroll
      for (int n = 0; n < 4; ++n) acc[m][n] = (f32x4){0.f, 0.f, 0.f, 0.f};
  }
  const int sr = tid >> 3, skc = tid & 7;
  const bf16_t* gA = A + (size_t)(row0 + sr) * lda + skc * 8;
  const bf16_t* gB = Bt + (size_t)(col0 + sr) * ldb + skc * 8;
  const int soff = sr * 128 + ((skc ^ (sr & 7)) << 4);
  u32x4 ra[4], rb[4];
  const int nk = K >> 6;
#pragma unroll
  for (int i = 0; i < 4; ++i) { ra[i] = *(const u32x4*)(gA + (size_t)(32 * i) * lda); rb[i] = *(const u32x4*)(gB + (size_t)(32 * i) * ldb); }
  __syncthreads();
  {
#pragma unroll
    for (int i = 0; i < 4; ++i) {
      u32x4 va = ra[i];
      if (ASC) { const float s = (0 < ksplit) ? s0[i] : s1[i];
        va.x = pack2(__uint_as_float(va.x << 16) * s, __uint_as_float(va.x & 0xffff0000u) * s); va.y = pack2(__uint_as_float(va.y << 16) * s, __uint_as_float(va.y & 0xffff0000u) * s);
        va.z = pack2(__uint_as_float(va.z << 16) * s, __uint_as_float(va.z & 0xffff0000u) * s); va.w = pack2(__uint_as_float(va.w << 16) * s, __uint_as_float(va.w & 0xffff0000u) * s); }
      *(LAS u32x4*)(lds + soff + i * 4096) = va; *(LAS u32x4*)(lds + 16384 + soff + i * 4096) = rb[i];
    }
  }
  __syncthreads();
  for (int kt = 0; kt < nk; ++kt) {
    LAS char* cur = lds + (kt & 1) * 32768; LAS char* nxt = lds + ((kt + 1) & 1) * 32768;
    const bool more = (kt + 1 < nk);
    if (more) {
      const int k1 = (kt + 1) << 6;
#pragma unroll
      for (int i = 0; i < 4; ++i) { ra[i] = *(const u32x4*)(gA + (size_t)(32 * i) * lda + k1); rb[i] = *(const u32x4*)(gB + (size_t)(32 * i) * ldb + k1); }
    }
#pragma unroll
    for (int ks = 0; ks < 2; ++ks) {
      bf16x8 af[4], bfr[4];
      const int kc = ks * 4 + fq;
#pragma unroll
      for (int m = 0; m < 4; ++m) { const int r = wr * 64 + m * 16 + fr; af[m] = as_bf(*(const LAS u32x4*)(cur + r * 128 + ((kc ^ (r & 7)) << 4))); }
#pragma unroll
      for (int n = 0; n < 4; ++n) { const int r = wc * 64 + n * 16 + fr; bfr[n] = as_bf(*(const LAS u32x4*)(cur + 16384 + r * 128 + ((kc ^ (r & 7)) << 4))); }
#pragma unroll
      for (int m = 0; m < 4; ++m)
#pragma unroll
        for (int n = 0; n < 4; ++n) acc[m][n] = mfma16(bfr[n], af[m], acc[m][n]);
    }
    if (more) {
      const int k1 = (kt + 1) << 6;
#pragma unroll
      for (int i = 0; i < 4; ++i) {
        u32x4 va = ra[i];
        if (ASC) { const float s = (k1 < ksplit) ? s0[i] : s1[i];
          va.x = pack2(__uint_as_float(va.x << 16) * s, __uint_as_float(va.x & 0xffff0000u) * s); va.y = pack2(__uint_as_float(va.y << 16) * s, __uint_as_float(va.y & 0xffff0000u) * s);
          va.z = pack2(__uint_as_float(va.z << 16) * s, __uint_as_float(va.z & 0xffff0000u) * s); va.w = pack2(__uint_as_float(va.w << 16) * s, __uint_as_float(va.w & 0xffff0000u) * s); }
        *(LAS u32x4*)(nxt + soff + i * 4096) = va; *(LAS u32x4*)(nxt + 16384 + soff + i * 4096) = rb[i];
      }
    }
    __syncthreads();
  }
}

__device__ void transpose_tile(const float* __restrict__ src, bf16_t* __restrict__ dst, int K, int N, int tile, const float* g0, const float* g1, int split, float* tl  ) {
  const int ntn = N >> 6; const int tk = tile / ntn, tn = tile % ntn; const int k0 = tk << 6, n0 = tn << 6; const int tid = threadIdx.x;
  __syncthreads();
#pragma unroll 4
  for (int i = 0; i < 16; ++i) { const int kk = i * 4 + (tid >> 6), nn = tid & 63; const int k = k0 + kk;
    float g = 1.f; if (g0) g = (k < split) ? g0[k] : g1[k - split];
    tl[kk * 65 + nn] = src[(size_t)k * N + n0 + nn] * g; }
  __syncthreads();
  const int n = tid >> 2, kq = (tid & 3) * 16;
  unsigned o[8];
#pragma unroll
  for (int j = 0; j < 8; ++j) o[j] = pack2(tl[(kq + 2 * j) * 65 + n], tl[(kq + 2 * j + 1) * 65 + n]);
  uint4* d = (uint4*)(dst + (size_t)(n0 + n) * K + k0 + kq);
  d[0] = make_uint4(o[0], o[1], o[2], o[3]); d[1] = make_uint4(o[4], o[5], o[6], o[7]);
}

__device__ void convert_flat(const float* __restrict__ src, bf16_t* __restrict__ dst, size_t n8  , int bid, int nb) {
  for (size_t i = (size_t)bid * NTHREADS + threadIdx.x; i < n8; i += (size_t)nb * NTHREADS) {
    const float4 a = ((const float4*)src)[2 * i], b = ((const float4*)src)[2 * i + 1];
    ((uint4*)dst)[i] = make_uint4(pack2(a.x, a.y), pack2(a.z, a.w), pack2(b.x, b.y), pack2(b.z, b.w));
  }
}
__device__ void rows_bf16_rs(const float* __restrict__ src, bf16_t* __restrict__ dst, float* __restrict__ rs, int nrows, int bid, int nb) {
  const int lane = threadIdx.x & 63, w = threadIdx.x >> 6;
  for (int row = bid * 4 + w; row < nrows; row += nb * 4) {
    const float4* s = (const float4*)(src + (size_t)row * 1024);
    float ss = 0.f; uint2* d = (uint2*)(dst + (size_t)row * 1024);
#pragma unroll
    for (int i = 0; i < 4; ++i) { const float4 v = s[i * 64 + lane]; ss += v.x * v.x + v.y * v.y + v.z * v.z + v.w * v.w; d[i * 64 + lane] = make_uint2(pack2(v.x, v.y), pack2(v.z, v.w)); }
#pragma unroll
    for (int o = 32; o > 0; o >>= 1) ss += __shfl_xor(ss, o);
    if (lane == 0) rs[row] = rsqrtf(ss * (1.0f / 1024.0f) + EPSF);
  }
}

__device__ void ssm_stage1(const Params& p, int gp) {
  const int g = gp >> 6;
  const float step = expf(p.log_step[g]); const float lr = p.lam_re[gp], li = p.lam_im[gp];
  const float mag = expf(lr * step); const float ar = mag * cosf(li * step), ai = mag * sinf(li * step);
  const float zr = ar - 1.0f, den = lr * lr + li * li; const float fr = (zr * lr + ai * li) / den, fi = (ai * lr - zr * li) / den;
  for (int c = 0; c < 16; ++c) { const float br = p.b_re[gp * 16 + c], bi = p.b_im[gp * 16 + c]; p.BBR[gp * 16 + c] = fr * br - fi * bi; p.BBI[gp * 16 + c] = fr * bi + fi * br; }
  float pr = 1.f, pi = 0.f; const int st = gp & 63;
  for (int j = 0; j <= 16; ++j) { p.PWR[(g * 17 + j) * 64 + st] = pr; p.PWI[(g * 17 + j) * 64 + st] = pi; const float nr = pr * ar - pi * ai, ni = pr * ai + pi * ar; if (j < 16) { pr = nr; pi = ni; } }
  const float a16r = pr, a16i = pi; const float a32r = a16r * a16r - a16i * a16i, a32i = 2.f * a16r * a16i;
  const float a48r = a32r * a16r - a32i * a16i, a48i = a32r * a16i + a32i * a16r; const float a64r = a32r * a32r - a32i * a32i, a64i = 2.f * a32r * a32i;
  const float a128r = a64r * a64r - a64i * a64i, a128i = 2.f * a64r * a64i; const float a256r = a128r * a128r - a128i * a128i, a256i = 2.f * a128r * a128i;
  float* A = p.APW;
  A[0 * 4096 + gp] = a16r; A[0 * 4096 + 2048 + gp] = a16i; A[1 * 4096 + gp] = a32r; A[1 * 4096 + 2048 + gp] = a32i; A[2 * 4096 + gp] = a48r; A[2 * 4096 + 2048 + gp] = a48i;
  A[3 * 4096 + gp] = a64r; A[3 * 4096 + 2048 + gp] = a64i; A[4 * 4096 + gp] = a256r; A[4 * 4096 + 2048 + gp] = a256i;
}
__device__ void ssm_stage2(const Params& p, int bid, int nb) {
  const int total1 = 32 * 128 * 256, total2 = 32 * 256 * 384;
  for (int i = bid * NTHREADS + threadIdx.x; i < total1 + total2; i += nb * NTHREADS) {
    if (i < total1) {
      const int k = i & 255, sr = (i >> 8) & 127, g = i >> 15; const int st = ((sr >> 5) << 4) | (sr & 15), ri = (sr >> 4) & 1; const int s = k >> 4, ch = k & 15;
      const int gp = g * 64 + st; const float pr = p.PWR[(g * 17 + 15 - s) * 64 + st], pi = p.PWI[(g * 17 + 15 - s) * 64 + st]; const float br = p.BBR[gp * 16 + ch], bi = p.BBI[gp * 16 + ch];
      p.WE16[i] = f2bf(ri == 0 ? (pr * br - pi * bi) : (pr * bi + pi * br));
    } else {
      const int e = i - total1; const int k = e % 384, r = (e / 384) & 255, g = e / (384 * 256); const int t = r >> 4, co = r & 15; float val;
      if (k < 128) { const int st = ((k >> 5) << 4) | (k & 15), ri = (k >> 4) & 1; const float cr = p.c_re[(g * 16 + co) * 64 + st], ci = p.c_im[(g * 16 + co) * 64 + st];
        const float pr = p.PWR[(g * 17 + t + 1) * 64 + st], pi = p.PWI[(g * 17 + t + 1) * 64 + st]; val = (ri == 0) ? (cr * pr - ci * pi) : -(cr * pi + ci * pr); }
      else { const int kk = k - 128, s = kk >> 4, cin = kk & 15; val = 0.f;
        if (s <= t) { const int j = t - s; float acc = 0.f;
          for (int st = 0; st < 64; ++st) { const float cr = p.c_re[(g * 16 + co) * 64 + st], ci = p.c_im[(g * 16 + co) * 64 + st]; const float pr = p.PWR[(g * 17 + j) * 64 + st], pi = p.PWI[(g * 17 + j) * 64 + st];
            const float br = p.BBR[(g * 64 + st) * 16 + cin], bi = p.BBI[(g * 64 + st) * 16 + cin]; acc += cr * (pr * br - pi * bi) - ci * (pr * bi + pi * br); }
          val = acc; } }
      p.WY[e] = f2bf(val);
    }
  }
}

#define EPI_IDS const int tid = threadIdx.x, lane = tid & 63, w = tid >> 6, wr = w >> 1, wc = w & 1, fr = lane & 15, fq = lane >> 4; (void)wr; (void)wc; (void)fr; (void)fq;

__device__ void tile_win(const Params& p, int tile, char* lds) {
  const int rt = tile >> 4, ct = tile & 15; const int row0 = rt * 128, col0 = ct * 128;
  f32x4 acc[4][4];
  gemm_mainloop<false>(acc, p.XB, 1024, p.WtIn, 1024, 1024, row0, col0, lds, nullptr, nullptr, 0);
  EPI_IDS
  const int cw = col0 + wc * 64;
#pragma unroll
  for (int m = 0; m < 4; ++m) {
    const int row = row0 + wr * 64 + m * 16 + fr; const float rsx = p.rs_x[row];
    if (cw < 1024) {
      float ss = 0.f;
#pragma unroll
      for (int n = 0; n < 4; ++n)
#pragma unroll
        for (int j = 0; j < 4; ++j) { const float v = acc[m][n][j] * rsx; acc[m][n][j] = v; ss += v * v; }
      ss += __shfl_xor(ss, 16); ss += __shfl_xor(ss, 32);
      const float rs = rsqrtf(ss * (1.0f / 64.0f) + EPSF) * (cw < 512 ? 0.125f : 1.0f);
      const float* g = (cw < 512) ? p.att_q_g : p.att_k_g; bf16_t* dst = (cw < 512 ? p.Qb : p.Kb) + (size_t)row * 512 + (cw & 511);
#pragma unroll
      for (int n = 0; n < 4; ++n) { const int c = n * 16 + fq * 4; const float4 gg = *(const float4*)(g + c);
        *(uint2*)(dst + c) = make_uint2(pack2(acc[m][n][0] * rs * gg.x, acc[m][n][1] * rs * gg.y), pack2(acc[m][n][2] * rs * gg.z, acc[m][n][3] * rs * gg.w)); }
    } else if (cw < 1536) {
      const int head = (cw - 1024) >> 6; const int b = row >> 13, tb = row & 8191;
      bf16_t* dst = p.VT + ((size_t)(b * 8 + head) * 64) * SEQL + tb;
#pragma unroll
      for (int n = 0; n < 4; ++n)
#pragma unroll
        for (int j = 0; j < 4; ++j) dst[(size_t)(n * 16 + fq * 4 + j) * SEQL] = f2bf(acc[m][n][j] * rsx);
    } else {
      bf16_t* dst = p.Ub + (size_t)row * 512 + (cw - 1536);
#pragma unroll
      for (int n = 0; n < 4; ++n) { const int c = n * 16 + fq * 4;
        *(uint2*)(dst + c) = make_uint2(pack2(acc[m][n][0] * rsx, acc[m][n][1] * rsx), pack2(acc[m][n][2] * rsx, acc[m][n][3] * rsx)); }
    }
  }
}
__device__ void tile_memkv(const Params& p, int tile, char* lds) {
  const int which = tile >> 5, t2 = tile & 31; const int rt = t2 >> 3, ct = t2 & 7; const int row0 = rt * 128, col0 = ct * 128;
  f32x4 acc[4][4];
  gemm_mainloop<false>(acc, p.MEMB, 1024, which ? p.WtMv : p.WtMk, 1024, 1024, row0, col0, lds, nullptr, nullptr, 0);
  EPI_IDS
  const int cw = col0 + wc * 64;
#pragma unroll
  for (int m = 0; m < 4; ++m) {
    const int row = row0 + wr * 64 + m * 16 + fr; const float rsm = p.rs_mem[row];
    if (which == 0) {
      float ss = 0.f;
#pragma unroll
      for (int n = 0; n < 4; ++n) { f32x4 v = acc[m][n] * rsm; ss += v[0] * v[0] + v[1] * v[1] + v[2] * v[2] + v[3] * v[3]; *(f32x4*)(p.KMraw + (size_t)row * 1024 + cw + n * 16 + fq * 4) = v; }
      ss += __shfl_xor(ss, 16); ss += __shfl_xor(ss, 32);
      if (fq == 0) p.ss_km[row * 16 + (cw >> 6)] = ss;
    } else {
      const int b = row >> 8, key = row & 255; const int head = cw >> 8; const int d0 = (cw & 255);
      bf16_t* dst = p.VMT + ((size_t)(b * 4 + head) * 256) * 256 + key;
#pragma unroll
      for (int n = 0; n < 4; ++n)
#pragma unroll
        for (int j = 0; j < 4; ++j) dst[(size_t)(d0 + n * 16 + fq * 4 + j) * 256] = f2bf(acc[m][n][j] * rsm);
    }
  }
}
__device__ void memk_fix(const Params& p, int bid, int nb) {
  for (int i = bid * NTHREADS + threadIdx.x; i < 512 * 1024 / 4; i += nb * NTHREADS) {
    const int row = i >> 8, c4 = (i & 255) * 4; const int head = c4 >> 8, d = c4 & 255;
    const float ss = p.ss_km[row * 16 + head * 4] + p.ss_km[row * 16 + head * 4 + 1] + p.ss_km[row * 16 + head * 4 + 2] + p.ss_km[row * 16 + head * 4 + 3];
    const float rs = rsqrtf(ss * (1.0f / 256.0f) + EPSF);
    const float4 v = *(const float4*)(p.KMraw + (size_t)row * 1024 + c4); const float4 gk = *(const float4*)(p.mem_k_g + d), gq = *(const float4*)(p.mem_q_g + d);
    const int b = row >> 8, key = row & 255;
    *(uint2*)(p.KMB + ((size_t)(b * 4 + head) * 256 + key) * 256 + d) = make_uint2(pack2(v.x * rs * gk.x * gq.x, v.y * rs * gk.y * gq.y), pack2(v.z * rs * gk.z * gq.z, v.w * rs * gk.w * gq.w));
  }
}

__device__ void chunk_attn_item(const Params& p, int item, float* rb) {
  const int h = item & 7, cn = (item >> 3) & 127, b = item >> 10;
  const int tid = threadIdx.x, lane = tid & 63, w = tid >> 6, fr = lane & 15, fq = lane >> 4;
  __syncthreads();
  if (tid < 192) rb[tid] = p.rel_bias[h * 192 + tid];
  __syncthreads();
  const int iq = w * 16 + fr; const int tq = b * SEQL + cn * 64 + iq;
  bf16x8 qf[2];
  qf[0] = *(const bf16x8*)(p.Qb + (size_t)tq * 512 + h * 64 + fq * 8); qf[1] = *(const bf16x8*)(p.Qb + (size_t)tq * 512 + h * 64 + 32 + fq * 8);
  f32x4 o[4]; for (int i = 0; i < 4; ++i) o[i] = (f32x4){0.f, 0.f, 0.f, 0.f};
  float mrun = -1e30f, lrun = 0.f;
  const int cstart = (cn >= 8) ? 0 : (8 - cn);
  const bf16_t* vtb = p.VT + ((size_t)(b * 8 + h) * 64) * SEQL;
  for (int c = cstart; c <= 8; ++c) {
    const int kc0 = (cn - 8 + c) * 64;
    f32x4 st[4];
#pragma unroll
    for (int mt = 0; mt < 4; ++mt) {
      const bf16_t* kr = p.Kb + (size_t)(b * SEQL + kc0 + mt * 16 + fr) * 512 + h * 64 + fq * 8;
      const bf16x8 k0 = *(const bf16x8*)kr, k1 = *(const bf16x8*)(kr + 32);
      f32x4 s = (f32x4){0.f, 0.f, 0.f, 0.f}; s = mfma16(k0, qf[0], s); s = mfma16(k1, qf[1], s); st[mt] = s;
    }
    float tmax = -1e30f;
#pragma unroll
    for (int mt = 0; mt < 4; ++mt)
#pragma unroll
      for (int j = 0; j < 4; ++j) { const int jk = mt * 16 + fq * 4 + j; int dist = 512 - 64 * c + iq - jk; dist = dist < -63 ? -63 : (dist > 128 ? 128 : dist);
        const float s = st[mt][j] + rb[dist + 63]; st[mt][j] = s; tmax = fmaxf(tmax, s); }
    tmax = fmaxf(tmax, __shfl_xor(tmax, 16)); tmax = fmaxf(tmax, __shfl_xor(tmax, 32));
    const float mnew = fmaxf(mrun, tmax); const float alpha = __expf(mrun - mnew); mrun = mnew;
    float ls = 0.f;
#pragma unroll
    for (int mt = 0; mt < 4; ++mt)
#pragma unroll
      for (int j = 0; j < 4; ++j) { const float pv = __expf(st[mt][j] - mnew); st[mt][j] = pv; ls += pv; }
    lrun = lrun * alpha + ls;
#pragma unroll
    for (int dt = 0; dt < 4; ++dt) o[dt] *= alpha;
#pragma unroll
    for (int s2 = 0; s2 < 2; ++s2) {
      union { bf16x8 v; unsigned u[4]; } pf;
      pf.u[0] = pack2(st[2 * s2][0], st[2 * s2][1]); pf.u[1] = pack2(st[2 * s2][2], st[2 * s2][3]); pf.u[2] = pack2(st[2 * s2 + 1][0], st[2 * s2 + 1][1]); pf.u[3] = pack2(st[2 * s2 + 1][2], st[2 * s2 + 1][3]);
#pragma unroll
      for (int dt = 0; dt < 4; ++dt) {
        const bf16_t* vr = vtb + (size_t)(dt * 16 + fr) * SEQL + kc0 + s2 * 32 + fq * 4;
        union { bf16x8 v; uint2 u[2]; } vf; vf.u[0] = *(const uint2*)vr; vf.u[1] = *(const uint2*)(vr + 16);
        o[dt] = mfma16(vf.v, pf.v, o[dt]);
      }
    }
  }
  float lt = lrun; lt += __shfl_xor(lt, 16); lt += __shfl_xor(lt, 32);
  const float inv = 1.0f / lt; float ss = 0.f;
  bf16_t* dst = p.ATT + (size_t)tq * 512 + h * 64;
#pragma unroll
  for (int dt = 0; dt < 4; ++dt) { const f32x4 v = o[dt] * inv; ss += v[0] * v[0] + v[1] * v[1] + v[2] * v[2] + v[3] * v[3];
    *(uint2*)(dst + dt * 16 + fq * 4) = make_uint2(pack2(v[0], v[1]), pack2(v[2], v[3])); }
  ss += __shfl_xor(ss, 16); ss += __shfl_xor(ss, 32);
  if (fq == 0) p.ss_att[tq * 8 + h] = ss;
}

template <bool FINAL>
__device__ void ssm_item(const Params& p, int item, char* lds) {
  const int g = item & 31, seg = (item >> 5) & 31, b = item >> 10;
  const int tid = threadIdx.x, lane = tid & 63, w = tid >> 6, fr = lane & 15, fq = lane >> 4;
  const int t0 = b * SEQL + seg * 256;
  bf16x8 uf[8];
#pragma unroll
  for (int ks = 0; ks < 8; ++ks) uf[ks] = *(const bf16x8*)(p.Ub + (size_t)(t0 + fr * 16 + 2 * ks + (fq >> 1)) * 512 + g * 16 + (fq & 1) * 8);
  f32x4 er = (f32x4){0.f, 0.f, 0.f, 0.f}, ei = er;
  const bf16_t* we = p.WE16 + ((size_t)g * 128 + w * 32 + fr) * 256 + fq * 8;
#pragma unroll
  for (int ks = 0; ks < 8; ++ks) { const bf16x8 br = *(const bf16x8*)(we + ks * 32), bi = *(const bf16x8*)(we + 16 * 256 + ks * 32); er = mfma16(uf[ks], br, er); ei = mfma16(uf[ks], bi, ei); }
  const int gp = g * 64 + w * 16 + fr;
  const float a16r = p.APW[gp], a16i = p.APW[2048 + gp];
  float xr[4], xi[4];
  xr[0] = er[0]; xi[0] = ei[0];
#pragma unroll
  for (int j = 1; j < 4; ++j) { xr[j] = a16r * xr[j - 1] - a16i * xi[j - 1] + er[j]; xi[j] = a16r * xi[j - 1] + a16i * xr[j - 1] + ei[j]; }
  float cr = 0.f, ci = 0.f;
  if (FINAL) {
    const float ar = p.APW[4 * 4096 + gp], ai = p.APW[4 * 4096 + 2048 + gp];
    const float* es = p.ESEG + ((size_t)(b * 32) * 32 + g) * 128 + w * 32 + fr;
    for (int j = 0; j < seg; ++j) { const float e_r = es[(size_t)j * 32 * 128], e_i = es[(size_t)j * 32 * 128 + 16]; const float nr = ar * cr - ai * ci + e_r, ni = ar * ci + ai * cr + e_i; cr = nr; ci = ni; }
  }
  const float a64r = p.APW[3 * 4096 + gp], a64i = p.APW[3 * 4096 + 2048 + gp];
  float tr = xr[3], ti = xi[3];
#pragma unroll
  for (int r = 0; r < 4; ++r) {
    float pr_ = __shfl(tr, (lane + 48) & 63), pi_ = __shfl(ti, (lane + 48) & 63);
    if (r == 0) { pr_ = cr; pi_ = ci; }
    if (fq == r) { const float nr = xr[3] + a64r * pr_ - a64i * pi_, ni = xi[3] + a64r * pi_ + a64i * pr_; tr = nr; ti = ni; }
  }
  if (!FINAL) {
    if (fq == 3) { float* es = p.ESEG + ((size_t)(b * 32 + seg) * 32 + g) * 128 + w * 32 + fr; es[0] = tr; es[16] = ti; }
    return;
  }
  float gr = __shfl(tr, (lane + 48) & 63), gi = __shfl(ti, (lane + 48) & 63);
  if (fq == 0) { gr = cr; gi = ci; }
  float pvr[4], pvi[4];
  pvr[0] = gr; pvi[0] = gi;
#pragma unroll
  for (int j = 1; j < 4; ++j) { const float ar = p.APW[(j - 1) * 4096 + gp], ai = p.APW[(j - 1) * 4096 + 2048 + gp]; pvr[j] = xr[j - 1] + ar * gr - ai * gi; pvi[j] = xi[j - 1] + ar * gi + ai * gr; }
  bf16_t* xl = (bf16_t*)lds;
  __syncthreads();
#pragma unroll
  for (int j = 0; j < 4; ++j) { xl[(fq * 4 + j) * 136 + w * 32 + fr] = f2bf(pvr[j]); xl[(fq * 4 + j) * 136 + w * 32 + 16 + fr] = f2bf(pvi[j]); }
  __syncthreads();
  bf16x8 xf[4];
#pragma unroll
  for (int ks = 0; ks < 4; ++ks) xf[ks] = *(const bf16x8*)(xl + fr * 136 + ks * 32 + fq * 8);
#pragma unroll
  for (int mi = 0; mi < 4; ++mi) {
    const int mt = w * 4 + mi;
    const bf16_t* wy = p.WY + ((size_t)g * 256 + mt * 16 + fr) * 384 + fq * 8;
    f32x4 y = (f32x4){0.f, 0.f, 0.f, 0.f};
#pragma unroll
    for (int ks = 0; ks < 4; ++ks) y = mfma16(*(const bf16x8*)(wy + ks * 32), xf[ks], y);
#pragma unroll
    for (int ks = 0; ks < 8; ++ks) if (2 * ks <= mt) y = mfma16(*(const bf16x8*)(wy + 128 + ks * 32), uf[ks], y);
    const size_t tok = (size_t)(t0 + fr * 16 + mt);
    const uint2 uu = *(const uint2*)(p.Ub + tok * 512 + g * 16 + fq * 4);
    const float4 dd = *(const float4*)(p.d_skip + g * 16 + fq * 4);
    const float y0 = gelu_f(y[0] + dd.x * __uint_as_float(uu.x << 16)), y1 = gelu_f(y[1] + dd.y * __uint_as_float(uu.x & 0xffff0000u));
    const float y2 = gelu_f(y[2] + dd.z * __uint_as_float(uu.y << 16)), y3 = gelu_f(y[3] + dd.w * __uint_as_float(uu.y & 0xffff0000u));
    *(uint2*)(p.YG + tok * 512 + g * 16 + fq * 4) = make_uint2(pack2(y0, y1), pack2(y2, y3));
  }
}

__device__ void tile_glu(const Params& p, int tile, char* lds) {
  const int rt = tile >> 2, ct = tile & 3; const int row0 = rt * 128, col0 = ct * 128;
  f32x4 acc[4][4];
  gemm_mainloop<false>(acc, p.YG, 512, p.WtGlu, 512, 512, row0, col0, lds, nullptr, nullptr, 0);
  EPI_IDS
  const int cw = col0 + wc * 64;
#pragma unroll
  for (int m = 0; m < 4; ++m) {
    const int row = row0 + wr * 64 + m * 16 + fr; float ss = 0.f;
#pragma unroll
    for (int n = 0; n < 4; ++n) { const int c = cw + n * 16 + fq * 4; const float4 bg = *(const float4*)(p.b_glu + c); const uint2 yy = *(const uint2*)(p.YG + (size_t)row * 512 + c);
      const float y0 = __uint_as_float(yy.x << 16), y1 = __uint_as_float(yy.x & 0xffff0000u), y2 = __uint_as_float(yy.y << 16), y3 = __uint_as_float(yy.y & 0xffff0000u);
      const float o0 = y0 / (1.f + __expf(-(acc[m][n][0] + bg.x))), o1 = y1 / (1.f + __expf(-(acc[m][n][1] + bg.y))), o2 = y2 / (1.f + __expf(-(acc[m][n][2] + bg.z))), o3 = y3 / (1.f + __expf(-(acc[m][n][3] + bg.w)));
      ss += o0 * o0 + o1 * o1 + o2 * o2 + o3 * o3;
      *(uint2*)(p.SSMO + (size_t)row * 512 + c) = make_uint2(pack2(o0, o1), pack2(o2, o3)); }
    ss += __shfl_xor(ss, 16); ss += __shfl_xor(ss, 32);
    if (fq == 0) p.ss_ssm[row * 8 + (cw >> 6)] = ss;
  }
}
__device__ void tile_wout(const Params& p, int tile, char* lds) {
  const int rt = tile >> 3, ct = tile & 7; const int row0 = rt * 128, col0 = ct * 128;
  f32x4 acc[4][4];
  float s0[4], s1[4];
  { const int sr = threadIdx.x >> 3;
#pragma unroll
    for (int i = 0; i < 4; ++i) { const int row = row0 + sr + 32 * i; float a = 0.f, c = 0.f;
#pragma unroll
      for (int j = 0; j < 8; ++j) { a += p.ss_att[row * 8 + j]; c += p.ss_ssm[row * 8 + j]; }
      s0[i] = rsqrtf(a * (1.0f / 512.0f) + EPSF); s1[i] = rsqrtf(c * (1.0f / 512.0f) + EPSF); } }
  gemm_mainloop<true, true>(acc, p.ATT, 512, p.WtOut, 1024, 512, row0, col0, lds, s0, s0, 1 << 30);
  gemm_mainloop<true, false>(acc, p.SSMO, 512, p.WtOut + 512, 1024, 512, row0, col0, lds, s1, s1, 1 << 30);
  EPI_IDS
  const int cw = col0 + wc * 64;
#pragma unroll
  for (int m = 0; m < 4; ++m) {
    const int row = row0 + wr * 64 + m * 16 + fr; float ss = 0.f;
#pragma unroll
    for (int n = 0; n < 4; ++n) { const int c = cw + n * 16 + fq * 4; const f32x4 xv = *(const f32x4*)(p.x + (size_t)row * 1024 + c); const f32x4 hv = xv + acc[m][n];
      ss += hv[0] * hv[0] + hv[1] * hv[1] + hv[2] * hv[2] + hv[3] * hv[3];
      *(uint2*)(p.H1B + (size_t)row * 1024 + c) = make_uint2(pack2(hv[0], hv[1]), pack2(hv[2], hv[3])); }
    ss += __shfl_xor(ss, 16); ss += __shfl_xor(ss, 32);
    if (fq == 0) p.ss_h1[row * 16 + (cw >> 6)] = ss;
  }
}
__device__ __forceinline__ float row_rs16(const float* ss, int row) { float a = 0.f;
#pragma unroll
  for (int j = 0; j < 16; ++j) a += ss[row * 16 + j];
  return rsqrtf(a * (1.0f / 1024.0f) + EPSF); }
__device__ void tile_memq(const Params& p, int tile, char* lds) {
  const int rt = tile >> 3, ct = tile & 7; const int row0 = rt * 128, col0 = ct * 128;
  f32x4 acc[4][4];
  gemm_mainloop<false>(acc, p.H1B, 1024, p.WtMq, 1024, 1024, row0, col0, lds, nullptr, nullptr, 0);
  EPI_IDS
  const int cw = col0 + wc * 64;
#pragma unroll
  for (int m = 0; m < 4; ++m) {
    const int row = row0 + wr * 64 + m * 16 + fr; const float rs = row_rs16(p.ss_h1, row); float ss = 0.f;
#pragma unroll
    for (int n = 0; n < 4; ++n) { const int c = cw + n * 16 + fq * 4; const f32x4 v = acc[m][n] * rs; ss += v[0] * v[0] + v[1] * v[1] + v[2] * v[2] + v[3] * v[3];
      *(uint2*)(p.QM + (size_t)row * 1024 + c) = make_uint2(pack2(v[0], v[1]), pack2(v[2], v[3])); }
    ss += __shfl_xor(ss, 16); ss += __shfl_xor(ss, 32);
    if (fq == 0) p.ss_qm[row * 16 + (cw >> 6)] = ss;
  }
}
__device__ void mem_attn_item(const Params& p, int item) {
  const int h = item & 3, tt = item >> 2; const int tid = threadIdx.x, lane = tid & 63, w = tid >> 6, fr = lane & 15, fq = lane >> 4;
  const int tq = tt * 64 + w * 16 + fr; const int b = tq >> 13;
  const float ssq = p.ss_qm[tq * 16 + h * 4] + p.ss_qm[tq * 16 + h * 4 + 1] + p.ss_qm[tq * 16 + h * 4 + 2] + p.ss_qm[tq * 16 + h * 4 + 3];
  const float rowscale = rsqrtf(ssq * (1.0f / 256.0f) + EPSF) * 0.0625f;
  f32x4 st[16];
  {
    bf16x8 qf[8];
#pragma unroll
    for (int ks = 0; ks < 8; ++ks) qf[ks] = *(const bf16x8*)(p.QM + (size_t)tq * 1024 + h * 256 + ks * 32 + fq * 8);
    const bf16_t* kb = p.KMB + ((size_t)(b * 4 + h) * 256 + fr) * 256 + fq * 8;
#pragma unroll
    for (int mt = 0; mt < 16; ++mt) { f32x4 s = (f32x4){0.f, 0.f, 0.f, 0.f};
#pragma unroll
      for (int ks = 0; ks < 8; ++ks) s = mfma16(*(const bf16x8*)(kb + (size_t)(mt * 16) * 256 + ks * 32), qf[ks], s);
      st[mt] = s * rowscale; }
  }
  float mx = -1e30f;
#pragma unroll
  for (int mt = 0; mt < 16; ++mt) mx = fmaxf(fmaxf(fmaxf(mx, st[mt][0]), fmaxf(st[mt][1], st[mt][2])), st[mt][3]);
  mx = fmaxf(mx, __shfl_xor(mx, 16)); mx = fmaxf(mx, __shfl_xor(mx, 32));
  float l = 0.f;
#pragma unroll
  for (int mt = 0; mt < 16; ++mt)
#pragma unroll
    for (int j = 0; j < 4; ++j) { const float e = __expf(st[mt][j] - mx); st[mt][j] = e; l += e; }
  l += __shfl_xor(l, 16); l += __shfl_xor(l, 32);
  const float inv = 1.0f / l;
  bf16x8 pf[8];
#pragma unroll
  for (int s2 = 0; s2 < 8; ++s2) { union { bf16x8 v; unsigned u[4]; } t; t.u[0] = pack2(st[2 * s2][0], st[2 * s2][1]); t.u[1] = pack2(st[2 * s2][2], st[2 * s2][3]); t.u[2] = pack2(st[2 * s2 + 1][0], st[2 * s2 + 1][1]); t.u[3] = pack2(st[2 * s2 + 1][2], st[2 * s2 + 1][3]); pf[s2] = t.v; }
  const bf16_t* vb = p.VMT + ((size_t)(b * 4 + h) * 256 + fr) * 256 + fq * 4;
  bf16_t* dst = p.OM + (size_t)tq * 1024 + h * 256;
#pragma unroll 4
  for (int dt = 0; dt < 16; ++dt) { f32x4 o = (f32x4){0.f, 0.f, 0.f, 0.f};
#pragma unroll
    for (int s2 = 0; s2 < 8; ++s2) { const bf16_t* vr = vb + (size_t)(dt * 16) * 256 + s2 * 32; union { bf16x8 v; uint2 u[2]; } vf; vf.u[0] = *(const uint2*)vr; vf.u[1] = *(const uint2*)(vr + 16); o = mfma16(vf.v, pf[s2], o); }
    o *= inv; *(uint2*)(dst + dt * 16 + fq * 4) = make_uint2(pack2(o[0], o[1]), pack2(o[2], o[3])); }
}
__device__ void tile_memo(const Params& p, int tile, char* lds) {
  const int rt = tile >> 3, ct = tile & 7; const int row0 = rt * 128, col0 = ct * 128;
  f32x4 acc[4][4];
  gemm_mainloop<false>(acc, p.OM, 1024, p.WtMo, 1024, 1024, row0, col0, lds, nullptr, nullptr, 0);
  EPI_IDS
  const int cw = col0 + wc * 64;
#pragma unroll
  for (int m = 0; m < 4; ++m) {
    const int row = row0 + wr * 64 + m * 16 + fr; float ss = 0.f;
#pragma unroll
    for (int n = 0; n < 4; ++n) { const int c = cw + n * 16 + fq * 4; const uint2 hb = *(const uint2*)(p.H1B + (size_t)row * 1024 + c);
      const f32x4 hv = (f32x4){__uint_as_float(hb.x << 16), __uint_as_float(hb.x & 0xffff0000u), __uint_as_float(hb.y << 16), __uint_as_float(hb.y & 0xffff0000u)} + acc[m][n];
      ss += hv[0] * hv[0] + hv[1] * hv[1] + hv[2] * hv[2] + hv[3] * hv[3];
      *(uint2*)(p.H2B + (size_t)row * 1024 + c) = make_uint2(pack2(hv[0], hv[1]), pack2(hv[2], hv[3])); }
    ss += __shfl_xor(ss, 16); ss += __shfl_xor(ss, 32);
    if (fq == 0) p.ss_h2[row * 16 + (cw >> 6)] = ss;
  }
}
__device__ void tile_peerq(const Params& p, int tile, char* lds) {
  const int rt = tile >> 4, ct = tile & 15; const int row0 = rt * 128, col0 = ct * 128;
  f32x4 acc[4][4];
  gemm_mainloop<false>(acc, p.H2B, 1024, p.WtPq, 1024, 1024, row0, col0, lds, nullptr, nullptr, 0);
  EPI_IDS
  const int cw = col0 + wc * 64;
#pragma unroll
  for (int m = 0; m < 4; ++m) {
    const int row = row0 + wr * 64 + m * 16 + fr; const float rs = row_rs16(p.ss_h2, row);
#pragma unroll
    for (int n = 0; n < 4; ++n) { const int c = cw + n * 16 + fq * 4; const f32x4 v = acc[m][n] * rs;
      *(uint2*)(p.QP + (size_t)row * 2048 + c) = make_uint2(pack2(v[0], v[1]), pack2(v[2], v[3])); }
  }
}
__device__ __forceinline__ void ins16(float (&a)[16], float v) {
#pragma unroll
  for (int i = 0; i < 16; ++i) { const float hi = fmaxf(a[i], v), lo = fminf(a[i], v); a[i] = hi; v = lo; }
}
__device__ void tile_scores(const Params& p, int tile, char* lds) {
  const int rt = tile >> 4, hs = tile & 15; const int row0 = rt * 128;
  f32x4 acc[4][4];
  gemm_mainloop<false>(acc, p.QP + hs * 128, 2048, p.PK + (size_t)hs * 128 * 128, 128, 128, row0, 0, lds, nullptr, nullptr, 0);
  EPI_IDS
  float* tl = (float*)lds;
#pragma unroll
  for (int m = 0; m < 4; ++m)
#pragma unroll
    for (int n = 0; n < 4; ++n)
#pragma unroll
      for (int j = 0; j < 4; ++j) tl[(wr * 64 + m * 16 + fr) * 129 + wc * 64 + n * 16 + fq * 4 + j] = acc[m][n][j];
  __syncthreads();
  if (tid < 128) {
    float a[16];
#pragma unroll
    for (int i = 0; i < 16; ++i) a[i] = -__builtin_inff();
    for (int n = 0; n < 128; ++n) { const float v = __uint_as_float((__float_as_uint(tl[tid * 129 + n]) & ~127u) | (unsigned)n); ins16(a, v); }
    uint4* dst = (uint4*)(p.TOPS + ((size_t)(row0 + tid) * 16 + hs) * 16);
    dst[0] = make_uint4(__float_as_uint(a[0]), __float_as_uint(a[1]), __float_as_uint(a[2]), __float_as_uint(a[3]));
    dst[1] = make_uint4(__float_as_uint(a[4]), __float_as_uint(a[5]), __float_as_uint(a[6]), __float_as_uint(a[7]));
    dst[2] = make_uint4(__float_as_uint(a[8]), __float_as_uint(a[9]), __float_as_uint(a[10]), __float_as_uint(a[11]));
    dst[3] = make_uint4(__float_as_uint(a[12]), __float_as_uint(a[13]), __float_as_uint(a[14]), __float_as_uint(a[15]));
  }
}
__device__ void peer_gather_item(const Params& p, int item, char* lds) {
  const int tid = threadIdx.x, lane = tid & 63, w = tid >> 6;
  unsigned* LA = (unsigned*)lds;
  int* LE = (int*)(lds + 256 * 33 * 4);
  float* LG = (float*)(lds + 256 * 33 * 4 + 32 * 128 * 4);
  __syncthreads();
  {
    const int tl_ = tid >> 3, h = tid & 7; const int t = item * 32 + tl_;
    const uint4* src = (const uint4*)(p.TOPS + ((size_t)t * 16 + h * 2) * 16);
    float a[16], bq[16];
#pragma unroll
    for (int i = 0; i < 4; ++i) { const uint4 v = src[i]; a[4 * i] = __uint_as_float(v.x); a[4 * i + 1] = __uint_as_float(v.y); a[4 * i + 2] = __uint_as_float(v.z); a[4 * i + 3] = __uint_as_float(v.w); }
#pragma unroll
    for (int i = 0; i < 4; ++i) { const uint4 v = src[4 + i]; bq[4 * i] = __uint_as_float(v.x); bq[4 * i + 1] = __uint_as_float(v.y); bq[4 * i + 2] = __uint_as_float(v.z); bq[4 * i + 3] = __uint_as_float(v.w); }
#pragma unroll
    for (int i = 0; i < 16; ++i) { LA[tid * 33 + i] = __float_as_uint(a[i]); LA[tid * 33 + 16 + i] = __float_as_uint(bq[i]); }
    float c[16];
#pragma unroll
    for (int i = 0; i < 16; ++i) c[i] = -__builtin_inff();
#pragma unroll
    for (int i = 0; i < 16; ++i)
#pragma unroll
      for (int j = 0; j < 16; ++j) if ((i + 1) * (j + 1) <= 16) { const float s = a[i] + bq[j]; ins16(c, __uint_as_float((__float_as_uint(s) & ~255u) | (unsigned)(i * 16 + j))); }
    const float mx = c[0]; float e[16]; float sum = 0.f;
#pragma unroll
    for (int i = 0; i < 16; ++i) { e[i] = __expf(c[i] - mx); sum += e[i]; }
    const float inv = 1.0f / sum;
#pragma unroll
    for (int i = 0; i < 16; ++i) { const unsigned pos = __float_as_uint(c[i]) & 255u; const unsigned ia = LA[tid * 33 + (pos >> 4)] & 127u, ib = LA[tid * 33 + 16 + (pos & 15u)] & 127u;
      LE[tl_ * 128 + h * 16 + i] = (int)(ia * 128u + ib); LG[tl_ * 128 + h * 16 + i] = e[i] * inv; }
  }
  __syncthreads();
  for (int ti = 0; ti < 8; ++ti) {
    const int tl_ = w * 8 + ti; const int t = item * 32 + tl_;
    const float rs = row_rs16(p.ss_h2, t);
    float hn[16], hres[16]; float* op = p.out + (size_t)t * 1024;
    { const uint4 ha = *(const uint4*)(p.H2B + (size_t)t * 1024 + lane * 8), hb = *(const uint4*)(p.H2B + (size_t)t * 1024 + 512 + lane * 8);
      hres[0] = __uint_as_float(ha.x << 16); hres[1] = __uint_as_float(ha.x & 0xffff0000u); hres[2] = __uint_as_float(ha.y << 16); hres[3] = __uint_as_float(ha.y & 0xffff0000u);
      hres[4] = __uint_as_float(ha.z << 16); hres[5] = __uint_as_float(ha.z & 0xffff0000u); hres[6] = __uint_as_float(ha.w << 16); hres[7] = __uint_as_float(ha.w & 0xffff0000u);
      hres[8] = __uint_as_float(hb.x << 16); hres[9] = __uint_as_float(hb.x & 0xffff0000u); hres[10] = __uint_as_float(hb.y << 16); hres[11] = __uint_as_float(hb.y & 0xffff0000u);
      hres[12] = __uint_as_float(hb.z << 16); hres[13] = __uint_as_float(hb.z & 0xffff0000u); hres[14] = __uint_as_float(hb.w << 16); hres[15] = __uint_as_float(hb.w & 0xffff0000u);
      const float4 g0 = *(const float4*)(p.norm_peer_g + lane * 8), g1 = *(const float4*)(p.norm_peer_g + lane * 8 + 4), g2 = *(const float4*)(p.norm_peer_g + 512 + lane * 8), g3 = *(const float4*)(p.norm_peer_g + 512 + lane * 8 + 4);
      hn[0] = hres[0] * rs * g0.x; hn[1] = hres[1] * rs * g0.y; hn[2] = hres[2] * rs * g0.z; hn[3] = hres[3] * rs * g0.w; hn[4] = hres[4] * rs * g1.x; hn[5] = hres[5] * rs * g1.y; hn[6] = hres[6] * rs * g1.z; hn[7] = hres[7] * rs * g1.w;
      hn[8] = hres[8] * rs * g2.x; hn[9] = hres[9] * rs * g2.y; hn[10] = hres[10] * rs * g2.z; hn[11] = hres[11] * rs * g2.w; hn[12] = hres[12] * rs * g3.x; hn[13] = hres[13] * rs * g3.y; hn[14] = hres[14] * rs * g3.z; hn[15] = hres[15] * rs * g3.w; }
    float oa[16];
#pragma unroll
    for (int i = 0; i < 16; ++i) oa[i] = 0.f;
#pragma unroll 2
    for (int k = 0; k < 128; ++k) {
      const int e = LE[tl_ * 128 + k]; const float gg = LG[tl_ * 128 + k];
      const bf16_t* ur = p.PU + (size_t)e * 1024 + lane * 8; const uint4 ua = *(const uint4*)ur, ub = *(const uint4*)(ur + 512);
      const bf16_t* vr = p.PV + (size_t)e * 1024 + lane * 8; const uint4 va = *(const uint4*)vr, vb = *(const uint4*)(vr + 512);
      float d = 0.f;
      d += __uint_as_float(ua.x << 16) * hn[0] + __uint_as_float(ua.x & 0xffff0000u) * hn[1] + __uint_as_float(ua.y << 16) * hn[2] + __uint_as_float(ua.y & 0xffff0000u) * hn[3];
      d += __uint_as_float(ua.z << 16) * hn[4] + __uint_as_float(ua.z & 0xffff0000u) * hn[5] + __uint_as_float(ua.w << 16) * hn[6] + __uint_as_float(ua.w & 0xffff0000u) * hn[7];
      d += __uint_as_float(ub.x << 16) * hn[8] + __uint_as_float(ub.x & 0xffff0000u) * hn[9] + __uint_as_float(ub.y << 16) * hn[10] + __uint_as_float(ub.y & 0xffff0000u) * hn[11];
      d += __uint_as_float(ub.z << 16) * hn[12] + __uint_as_float(ub.z & 0xffff0000u) * hn[13] + __uint_as_float(ub.w << 16) * hn[14] + __uint_as_float(ub.w & 0xffff0000u) * hn[15];
#pragma unroll
      for (int o = 32; o > 0; o >>= 1) d += __shfl_xor(d, o);
      const float wgt = gg * gelu_f(d);
      oa[0] += wgt * __uint_as_float(va.x << 16); oa[1] += wgt * __uint_as_float(va.x & 0xffff0000u); oa[2] += wgt * __uint_as_float(va.y << 16); oa[3] += wgt * __uint_as_float(va.y & 0xffff0000u);
      oa[4] += wgt * __uint_as_float(va.z << 16); oa[5] += wgt * __uint_as_float(va.z & 0xffff0000u); oa[6] += wgt * __uint_as_float(va.w << 16); oa[7] += wgt * __uint_as_float(va.w & 0xffff0000u);
      oa[8] += wgt * __uint_as_float(vb.x << 16); oa[9] += wgt * __uint_as_float(vb.x & 0xffff0000u); oa[10] += wgt * __uint_as_float(vb.y << 16); oa[11] += wgt * __uint_as_float(vb.y & 0xffff0000u);
      oa[12] += wgt * __uint_as_float(vb.z << 16); oa[13] += wgt * __uint_as_float(vb.z & 0xffff0000u); oa[14] += wgt * __uint_as_float(vb.w << 16); oa[15] += wgt * __uint_as_float(vb.w & 0xffff0000u);
    }
    { float4 a0, a1, b0, b1;
      a0.x = hres[0] + oa[0]; a0.y = hres[1] + oa[1]; a0.z = hres[2] + oa[2]; a0.w = hres[3] + oa[3]; a1.x = hres[4] + oa[4]; a1.y = hres[5] + oa[5]; a1.z = hres[6] + oa[6]; a1.w = hres[7] + oa[7];
      b0.x = hres[8] + oa[8]; b0.y = hres[9] + oa[9]; b0.z = hres[10] + oa[10]; b0.w = hres[11] + oa[11]; b1.x = hres[12] + oa[12]; b1.y = hres[13] + oa[13]; b1.z = hres[14] + oa[14]; b1.w = hres[15] + oa[15];
      *(float4*)(op + lane * 8) = a0; *(float4*)(op + lane * 8 + 4) = a1; *(float4*)(op + 512 + lane * 8) = b0; *(float4*)(op + 512 + lane * 8 + 4) = b1; }
  }
}

template <int PH>
__device__ __forceinline__ void run_phase(const Params& p, char* lds, int bid, int nb) {
  if (PH == 0) {
    const int nt_in = 16 * 32, nt_glu = 8 * 8, nt_out = 16 * 16, nt_m = 16 * 16, nt_pq = 16 * 32;
    const int total = nt_in + nt_glu + nt_out + 4 * nt_m + nt_pq;
    for (int t = bid; t < total; t += nb) {
      int i = t; float* tl = (float*)lds;
      if (i < nt_in) { transpose_tile(p.w_in, p.WtIn, 1024, 2048, i, p.norm_mix_g, p.norm_mix_g, 1024, tl); continue; } i -= nt_in;
      if (i < nt_glu) { transpose_tile(p.w_glu, p.WtGlu, 512, 512, i, nullptr, nullptr, 0, tl); continue; } i -= nt_glu;
      if (i < nt_out) { transpose_tile(p.w_out, p.WtOut, 1024, 1024, i, p.att_out_g, p.ssm_out_g, 512, tl); continue; } i -= nt_out;
      if (i < nt_m) { transpose_tile(p.w_mem_q, p.WtMq, 1024, 1024, i, p.norm_mem_g, p.norm_mem_g, 1024, tl); continue; } i -= nt_m;
      if (i < nt_m) { transpose_tile(p.w_mem_k, p.WtMk, 1024, 1024, i, p.norm_memkv_g, p.norm_memkv_g, 1024, tl); continue; } i -= nt_m;
      if (i < nt_m) { transpose_tile(p.w_mem_v, p.WtMv, 1024, 1024, i, p.norm_memkv_g, p.norm_memkv_g, 1024, tl); continue; } i -= nt_m;
      if (i < nt_m) { transpose_tile(p.w_mem_o, p.WtMo, 1024, 1024, i, nullptr, nullptr, 0, tl); continue; } i -= nt_m;
      transpose_tile(p.w_peer_q, p.WtPq, 1024, 2048, i, p.norm_peer_g, p.norm_peer_g, 1024, tl);
    }
    convert_flat(p.peer_keys, p.PK, (size_t)16 * 128 * 128 / 8, bid, nb);
    convert_flat(p.peer_u, p.PU, (size_t)16384 * 1024 / 8, bid, nb);
    convert_flat(p.peer_v, p.PV, (size_t)16384 * 1024 / 8, bid, nb);
    rows_bf16_rs(p.x, p.XB, p.rs_x, T_TOK, bid, nb);
    rows_bf16_rs(p.mem, p.MEMB, p.rs_mem, 512, bid, nb);
    for (int i = bid * NTHREADS + threadIdx.x; i < 2048; i += nb * NTHREADS) ssm_stage1(p, i);
  } else if (PH == 1) {
    for (int t = bid; t < 2048 + 64; t += nb) { if (t < 2048) tile_win(p, t, lds); else tile_memkv(p, t - 2048, lds); }
    ssm_stage2(p, bid, nb);
  } else if (PH == 2) {
    for (int t = bid; t < 2048; t += nb) chunk_attn_item(p, t, (float*)lds);
    for (int t = bid; t < 2048; t += nb) ssm_item<false>(p, t, lds);
    memk_fix(p, bid, nb);
  } else if (PH == 3) {
    for (int t = bid; t < 2048; t += nb) ssm_item<true>(p, t, lds);
  } else if (PH == 4) {
    for (int t = bid; t < 512; t += nb) tile_glu(p, t, lds);
  } else if (PH == 5) {
    for (int t = bid; t < 1024; t += nb) tile_wout(p, t, lds);
  } else if (PH == 6) {
    for (int t = bid; t < 1024; t += nb) tile_memq(p, t, lds);
  } else if (PH == 7) {
    for (int t = bid; t < 1024; t += nb) mem_attn_item(p, t);
  } else if (PH == 8) {
    for (int t = bid; t < 1024; t += nb) tile_memo(p, t, lds);
  } else if (PH == 9) {
    for (int t = bid; t < 2048; t += nb) tile_peerq(p, t, lds);
  } else if (PH == 10) {
    for (int t = bid; t < 2048; t += nb) tile_scores(p, t, lds);
  } else if (PH == 11) {
    for (int t = bid; t < 512; t += nb) peer_gather_item(p, t, lds);
  }
}

template <int PH>
__global__ void __launch_bounds__(NTHREADS, 2) phase_kernel(Params p) {
  extern __shared__ __attribute__((aligned(16))) char lds[];
  run_phase<PH>(p, lds, blockIdx.x, gridDim.x);
}

#ifndef REPEAT_PH
#define REPEAT_PH -1
#endif
#define RUNPH(k) do { run_phase<k>(p, lds, bid, nb); if (REPEAT_PH == k) { xcd_barrier(xb); run_phase<k>(p, lds, bid, nb); } } while (0)
__global__ void __launch_bounds__(NTHREADS, 2) mega_kernel(Params p) {
  extern __shared__ __attribute__((aligned(16))) char lds[];
  cg::grid_group grid = cg::this_grid();
  const int bid = blockIdx.x, nb = gridDim.x;
  volatile LAS unsigned* stw = (volatile LAS unsigned*)((LAS char*)lds + LDS_WORK);
  if (threadIdx.x == 0) { stw[0] = 0u; stw[1] = 0u; stw[2] = 0u; stw[3] = 0u; }
  __syncthreads();
  XcdBarrier xb = xcd_barrier_post(p.bar, stw);
  RUNPH(0); grid.sync();
  RUNPH(1); xcd_barrier(xb);
  RUNPH(2); xcd_barrier(xb);
  RUNPH(3); xcd_barrier(xb);
  RUNPH(4); xcd_barrier(xb);
  RUNPH(5); xcd_barrier(xb);
  RUNPH(6); xcd_barrier(xb);
  RUNPH(7); xcd_barrier(xb);
  RUNPH(8); xcd_barrier(xb);
  RUNPH(9); xcd_barrier(xb);
  RUNPH(10); xcd_barrier(xb);
  RUNPH(11);
}

template <int PH> static void launch_phase(const Params& p, int grid, hipStream_t s) {
  hipFuncSetAttribute((const void*)phase_kernel<PH>, hipFuncAttributeMaxDynamicSharedMemorySize, LDS_BYTES);
  phase_kernel<PH><<<grid, NTHREADS, LDS_BYTES, s>>>(p);
}

extern "C" void kernel_launch(void* const* d_in, const int* in_sizes, int n_in, void* d_out, int out_size, void* d_ws, size_t ws_size, hipStream_t stream) {
  Params p{};
  const float** f = (const float**)&p;
  for (int i = 0; i < 33; ++i) f[i] = (const float*)d_in[i];
  p.out = (float*)d_out;
  char* ws = (char*)d_ws; size_t off = 0;
  auto take = [&](size_t bytes) { char* r = ws + off; off += (bytes + 255) & ~(size_t)255; return r; };
  const size_t MB = 1u << 20;
  p.bar = (unsigned*)take(16384);
  p.WtIn = (bf16_t*)take(4 * MB); p.WtGlu = (bf16_t*)take(MB / 2); p.WtOut = (bf16_t*)take(2 * MB);
  p.WtMq = (bf16_t*)take(2 * MB); p.WtMk = (bf16_t*)take(2 * MB); p.WtMv = (bf16_t*)take(2 * MB); p.WtMo = (bf16_t*)take(2 * MB); p.WtPq = (bf16_t*)take(4 * MB);
  p.PK = (bf16_t*)take(MB / 2); p.PU = (bf16_t*)take(32 * MB); p.PV = (bf16_t*)take(32 * MB);
  char* RA = take(64 * MB); char* RB = take(64 * MB);
  p.XB = (bf16_t*)RA; p.ATT = (bf16_t*)RA; p.YG = (bf16_t*)(RA + 16 * MB); p.QM = (bf16_t*)RA; p.H2B = (bf16_t*)RA;
  p.SSMO = (bf16_t*)(RA + 32 * MB); p.OM = (bf16_t*)(RA + 32 * MB);
  p.Qb = (bf16_t*)RB; p.Kb = (bf16_t*)(RB + 16 * MB); p.VT = (bf16_t*)(RB + 32 * MB); p.Ub = (bf16_t*)(RB + 48 * MB); p.H1B = (bf16_t*)RB; p.QP = (bf16_t*)RB;
  p.TOPS = (unsigned*)take(16 * MB);
  p.MEMB = (bf16_t*)take(MB); p.KMB = (bf16_t*)take(MB); p.VMT = (bf16_t*)take(MB); p.KMraw = (float*)take(2 * MB);
  p.WE16 = (bf16_t*)take(2 * MB); p.WY = (bf16_t*)take(6 * MB);
  p.rs_x = (float*)take(T_TOK * 4); p.rs_mem = (float*)take(512 * 4); p.ss_att = (float*)take(T_TOK * 8 * 4); p.ss_ssm = (float*)take(T_TOK * 8 * 4);
  p.ss_h1 = (float*)take(T_TOK * 16 * 4); p.ss_qm = (float*)take(T_TOK * 16 * 4); p.ss_km = (float*)take(512 * 16 * 4); p.ss_h2 = (float*)take(T_TOK * 16 * 4);
  p.ESEG = (float*)take(2 * 32 * 32 * 128 * 4);
  p.BBR = (float*)take(2048 * 16 * 4); p.BBI = (float*)take(2048 * 16 * 4); p.PWR = (float*)take(32 * 17 * 64 * 4); p.PWI = (float*)take(32 * 17 * 64 * 4); p.APW = (float*)take(5 * 4096 * 4);
  if (off > ws_size) { fprintf(stderr, "workspace too small: need %zu have %zu\n", off, ws_size); return; }
#if MEGA
  hipMemsetAsync(p.bar, 0, 16384, stream);
  static int grid_blocks = 0;
  if (!grid_blocks) {
    int dev = 0, cus = 0, per_cu = 0; hipGetDevice(&dev); hipDeviceGetAttribute(&cus, hipDeviceAttributeMultiprocessorCount, dev);
    hipFuncSetAttribute((const void*)mega_kernel, hipFuncAttributeMaxDynamicSharedMemorySize, LDS_BYTES);
    hipOccupancyMaxActiveBlocksPerMultiprocessor(&per_cu, mega_kernel, NTHREADS, LDS_BYTES);
    if (per_cu > 2) per_cu = 2; if (per_cu < 1) per_cu = 1;
    grid_blocks = cus * per_cu;
  }
  void* args[] = {&p};
  hipError_t e = hipLaunchCooperativeKernel((void*)mega_kernel, dim3(grid_blocks), dim3(NTHREADS), args, LDS_BYTES, stream);
  if (e != hipSuccess) fprintf(stderr, "cooperative launch failed: %s (grid %d)\n", hipGetErrorString(e), grid_blocks);
#else
  const int G = 1024;
  launch_phase<0>(p, G, stream); launch_phase<1>(p, G, stream); launch_phase<2>(p, G, stream); launch_phase<3>(p, G, stream);
  launch_phase<4>(p, G, stream); launch_phase<5>(p, G, stream); launch_phase<6>(p, G, stream); launch_phase<7>(p, G, stream);
  launch_phase<8>(p, G, stream); launch_phase<9>(p, G, stream); launch_phase<10>(p, G, stream); launch_phase<11>(p, G, stream);
#endif
}
```

```cpp
#include <hip/hip_runtime.h>
#include <hip/hip_cooperative_groups.h>
#include <cstdio>
#include <cstdint>
namespace cg = cooperative_groups;

#ifndef MEGA
#define MEGA 1
#endif

typedef unsigned short bf16_t;
typedef short bf16x8 __attribute__((ext_vector_type(8)));
typedef float f32x4 __attribute__((ext_vector_type(4)));
typedef unsigned u32x4 __attribute__((ext_vector_type(4)));
#define LAS __attribute__((address_space(3)))
__device__ __forceinline__ bf16x8 as_bf(u32x4 v) { return __builtin_bit_cast(bf16x8, v); }

#define T_TOK 16384
#define SEQL 8192
#define NTHREADS 256
#define LDS_WORK 66560
#define LDS_BYTES (LDS_WORK + 16)
#define EPSF 1e-6f

__device__ __forceinline__ unsigned short f2bf(float f) { unsigned u = __float_as_uint(f); u += 0x7fffu + ((u >> 16) & 1u); return (unsigned short)(u >> 16); }
__device__ __forceinline__ float bf2f(unsigned short b) { return __uint_as_float(((unsigned)b) << 16); }
__device__ __forceinline__ unsigned pack2(float lo, float hi) { return (unsigned)f2bf(lo) | ((unsigned)f2bf(hi) << 16); }
__device__ __forceinline__ float gelu_f(float v) {
  const float av = fabsf(v), t = __builtin_amdgcn_rcpf(av * 0.2316418882f + 1.0f);
  float q = t * 0.5307027145f + (-0.7265760135f); q = q * t + 0.7107068705f; q = q * t + (-0.142248368f); q = q * t + 0.127414796f; q = q * t;
  const float e = __builtin_amdgcn_exp2f((v * v) * (-0.72134752044f)); const float m = v * (q * e);
  return v < 0.f ? m : v - m; }
typedef float f32x2 __attribute__((ext_vector_type(2)));
__device__ __forceinline__ f32x4 mfma16(bf16x8 a, bf16x8 b, f32x4 c) { return __builtin_amdgcn_mfma_f32_16x16x32_bf16(a, b, c, 0, 0, 0); }


#define XB_TMO      128
#define XB_XCNT(j)  (256  + 64 * (j))
#define XB_XSUB(j)  (1280 + 64 * (j))
#define XB_XGEN(j)  (2304 + 64 * (j))
#define XB_TOP      3328
#define XB_TOPGEN   3392
#define XCD_BAR_WORDS 3456
#define XB_SPIN_CAP (1u << 18)
__device__ __forceinline__ unsigned xb_ld(unsigned* p)              { return __hip_atomic_load(p, __ATOMIC_RELAXED, __HIP_MEMORY_SCOPE_AGENT); }
__device__ __forceinline__ unsigned xb_add(unsigned* p, unsigned v) { return __hip_atomic_fetch_add(p, v, __ATOMIC_RELAXED, __HIP_MEMORY_SCOPE_AGENT); }
__device__ __forceinline__ unsigned xb_xcc_id() { return (unsigned)__builtin_amdgcn_s_getreg((3 << 11) | 20) & 0xFu; }
#define XB_SPIN(cond, bar) do { unsigned _sp = 0; while (cond) { __builtin_amdgcn_s_sleep(1); \
    if ((++_sp & 255u) == 0u) { if (xb_ld(&(bar)[XB_TMO])) break; if (_sp > XB_SPIN_CAP) { atomicAdd(&(bar)[XB_TMO], 1u); break; } } } } while (0)
struct XcdBarrier { unsigned* bar; unsigned x; volatile LAS unsigned* st; };
__device__ __forceinline__ XcdBarrier xcd_barrier_post(unsigned* bar, volatile LAS unsigned* st) {
  XcdBarrier b; b.bar = bar; b.x = xb_xcc_id(); b.st = st;
  if (threadIdx.x == 0) (void)xb_add(&bar[XB_XCNT(b.x)], 1u);
  return b;
}
__device__ __forceinline__ void xcd_barrier_complete(unsigned* bar, unsigned x, unsigned& nloc, unsigned& nx) {
  const unsigned G = gridDim.x * gridDim.y * gridDim.z;
  unsigned sum, cnt, mine, sp = 0u;
  for (;;) {
    sum = 0u; cnt = 0u; mine = 0u;
#pragma unroll
    for (unsigned j = 0; j < 16; ++j) { const unsigned c = xb_ld(&bar[XB_XCNT(j)]); sum += c; cnt += (c > 0u) ? 1u : 0u; mine = (j == x) ? c : mine; }
    if (sum == G) break;
    __builtin_amdgcn_s_sleep(1);
    if ((++sp & 255u) == 0u) { if (xb_ld(&bar[XB_TMO])) break; if (sp > XB_SPIN_CAP) { atomicAdd(&bar[XB_TMO], 1u); break; } }
  }
  nloc = mine > 0u ? mine : 1u; nx = cnt > 0u ? cnt : 1u;
}
__device__ __forceinline__ void xcd_barrier(const XcdBarrier& b) {
  asm volatile("s_waitcnt vmcnt(0)" ::: "memory");
  __syncthreads();
  if (threadIdx.x == 0) {
    unsigned* bar = b.bar;
    __builtin_amdgcn_s_waitcnt(0);
    unsigned nloc = b.st[0], nx = b.st[1];
    if (nloc == 0u) { xcd_barrier_complete(bar, b.x, nloc, nx); b.st[0] = nloc; b.st[1] = nx; }
    const unsigned old = xb_add(&bar[XB_XSUB(b.x)], 1u);
    const unsigned gen = old / nloc;
    if (old + 1u == (gen + 1u) * nloc) {
      __builtin_amdgcn_fence(__ATOMIC_RELEASE, "agent");
      asm volatile("s_waitcnt vmcnt(0)" ::: "memory");
      const unsigned og = xb_add(&bar[XB_TOP], 1u);
      const unsigned tg = og / nx;
      if (og + 1u == (tg + 1u) * nx) xb_add(&bar[XB_TOPGEN], 1u);
      else XB_SPIN(xb_ld(&bar[XB_TOPGEN]) == tg, bar);
      __builtin_amdgcn_fence(__ATOMIC_ACQUIRE, "agent");
      xb_add(&bar[XB_XGEN(b.x)], 1u);
      asm volatile("s_waitcnt vmcnt(0)" ::: "memory");
    } else {
      XB_SPIN(xb_ld(&bar[XB_XGEN(b.x)]) == gen, bar);
      __builtin_amdgcn_fence(__ATOMIC_ACQUIRE, "agent");
      asm volatile("s_waitcnt vmcnt(0)" ::: "memory");
    }
  }
  __syncthreads();
}

struct Params {
  const float *x, *mem, *norm_mix_g, *w_in, *att_q_g, *att_k_g, *rel_bias;
  const float *lam_re, *lam_im, *log_step, *b_re, *b_im, *c_re, *c_im, *d_skip, *w_glu, *b_glu;
  const float *att_out_g, *ssm_out_g, *w_out, *norm_mem_g, *norm_memkv_g, *w_mem_q, *w_mem_k, *w_mem_v;
  const float *mem_q_g, *mem_k_g, *w_mem_o, *norm_peer_g, *w_peer_q, *peer_keys, *peer_u, *peer_v;
  float* out;
  unsigned* bar;
  bf16_t *WtIn, *WtGlu, *WtOut, *WtMq, *WtMk, *WtMv, *WtMo, *WtPq, *PK, *PU, *PV;
  bf16_t *XB, *MEMB, *Qb, *Kb, *VT, *Ub, *ATT, *YG, *SSMO, *H1B, *QM, *OM, *H2B, *QP;
  bf16_t *KMB, *VMT, *WE16, *WY;
  float *rs_x, *rs_mem, *ss_att, *ss_ssm, *ss_h1, *ss_qm, *ss_km, *ss_h2, *KMraw, *ESEG;
  float *BBR, *BBI, *PWR, *PWI, *APW;
  unsigned* TOPS;
  unsigned char *PU8, *PV8; float *su, *sv;
};

template <bool ASC, bool ZERO = true>
__device__ __forceinline__ void gemm_mainloop(f32x4 (&acc)[4][4], const bf16_t* __restrict__ A, int lda, const bf16_t* __restrict__ Bt, int ldb, int K,
                                              int row0, int col0, char* lds_, const float* s0, const float* s1, int ksplit) {
  LAS char* lds = (LAS char*)lds_;
  const int tid = threadIdx.x, lane = tid & 63, w = tid >> 6, wr = w >> 1, wc = w & 1, fr = lane & 15, fq = lane >> 4;
  if (ZERO) {
#pragma unroll
    for (int m = 0; m < 4; ++m)
#pragma unroll
      for (int n = 0; n < 4; ++n) acc[m][n] = (f32x4){0.f, 0.f, 0.f, 0.f};
  }
  const int sr = tid >> 3, skc = tid & 7;
  const bf16_t* gA = A + (size_t)(row0 + sr) * lda + skc * 8;
  const bf16_t* gB = Bt + (size_t)(col0 + sr) * ldb + skc * 8;
  const int soff = sr * 128 + ((skc ^ (sr & 7)) << 4);
  u32x4 ra[4], rb[4];
  const int nk = K >> 6;
#pragma unroll
  for (int i = 0; i < 4; ++i) { ra[i] = *(const u32x4*)(gA + (size_t)(32 * i) * lda); rb[i] = *(const u32x4*)(gB + (size_t)(32 * i) * ldb); }
  __syncthreads();
  {
#pragma unroll
    for (int i = 0; i < 4; ++i) {
      u32x4 va = ra[i];
      if (ASC) { const float s = (0 < ksplit) ? s0[i] : s1[i];
        va.x = pack2(__uint_as_float(va.x << 16) * s, __uint_as_float(va.x & 0xffff0000u) * s); va.y = pack2(__uint_as_float(va.y << 16) * s, __uint_as_float(va.y & 0xffff0000u) * s);
        va.z = pack2(__uint_as_float(va.z << 16) * s, __uint_as_float(va.z & 0xffff0000u) * s); va.w = pack2(__uint_as_float(va.w << 16) * s, __uint_as_float(va.w & 0xffff0000u) * s); }
      *(LAS u32x4*)(lds + soff + i * 4096) = va; *(LAS u32x4*)(lds + 16384 + soff + i * 4096) = rb[i];
    }
  }
  __syncthreads();
  for (int kt = 0; kt < nk; ++kt) {
    LAS char* cur = lds + (kt & 1) * 32768; LAS char* nxt = lds + ((kt + 1) & 1) * 32768;
    const bool more = (kt + 1 < nk);
    if (more) {
      const int k1 = (kt + 1) << 6;
#pragma unroll
      for (int i = 0; i < 4; ++i) { ra[i] = *(const u32x4*)(gA + (size_t)(32 * i) * lda + k1); rb[i] = *(const u32x4*)(gB + (size_t)(32 * i) * ldb + k1); }
    }
#pragma unroll
    for (int ks = 0; ks < 2; ++ks) {
      bf16x8 af[4], bfr[4];
      const int kc = ks * 4 + fq;
#pragma unroll
      for (int m = 0; m < 4; ++m) { const int r = wr * 64 + m * 16 + fr; af[m] = as_bf(*(const LAS u32x4*)(cur + r * 128 + ((kc ^ (r & 7)) << 4))); }
#pragma unroll
      for (int n = 0; n < 4; ++n) { const int r = wc * 64 + n * 16 + fr; bfr[n] = as_bf(*(const LAS u32x4*)(cur + 16384 + r * 128 + ((kc ^ (r & 7)) << 4))); }
#pragma unroll
      for (int m = 0; m < 4; ++m)
#pragma unroll
        for (int n = 0; n < 4; ++n) acc[m][n] = mfma16(bfr[n], af[m], acc[m][n]);
    }
    if (more) {
      const int k1 = (kt + 1) << 6;
#pragma unroll
      for (int i = 0; i < 4; ++i) {
        u32x4 va = ra[i];
        if (ASC) { const float s = (k1 < ksplit) ? s0[i] : s1[i];
          va.x = pack2(__uint_as_float(va.x << 16) * s, __uint_as_float(va.x & 0xffff0000u) * s); va.y = pack2(__uint_as_float(va.y << 16) * s, __uint_as_float(va.y & 0xffff0000u) * s);
          va.z = pack2(__uint_as_float(va.z << 16) * s, __uint_as_float(va.z & 0xffff0000u) * s); va.w = pack2(__uint_as_float(va.w << 16) * s, __uint_as_float(va.w & 0xffff0000u) * s); }
        *(LAS u32x4*)(nxt + soff + i * 4096) = va; *(LAS u32x4*)(nxt + 16384 + soff + i * 4096) = rb[i];
      }
    }
    __syncthreads();
  }
}

__device__ void transpose_tile(const float* __restrict__ src, bf16_t* __restrict__ dst, int K, int N, int tile, const float* g0, const float* g1, int split, float* tl  ) {
  const int ntn = N >> 6; const int tk = tile / ntn, tn = tile % ntn; const int k0 = tk << 6, n0 = tn << 6; const int tid = threadIdx.x;
  __syncthreads();
#pragma unroll 4
  for (int i = 0; i < 16; ++i) { const int kk = i * 4 + (tid >> 6), nn = tid & 63; const int k = k0 + kk;
    float g = 1.f; if (g0) g = (k < split) ? g0[k] : g1[k - split];
    tl[kk * 65 + nn] = src[(size_t)k * N + n0 + nn] * g; }
  __syncthreads();
  const int n = tid >> 2, kq = (tid & 3) * 16;
  unsigned o[8];
#pragma unroll
  for (int j = 0; j < 8; ++j) o[j] = pack2(tl[(kq + 2 * j) * 65 + n], tl[(kq + 2 * j + 1) * 65 + n]);
  uint4* d = (uint4*)(dst + (size_t)(n0 + n) * K + k0 + kq);
  d[0] = make_uint4(o[0], o[1], o[2], o[3]); d[1] = make_uint4(o[4], o[5], o[6], o[7]);
}

__device__ void convert_flat(const float* __restrict__ src, bf16_t* __restrict__ dst, size_t n8  , int bid, int nb) {
  for (size_t i = (size_t)bid * NTHREADS + threadIdx.x; i < n8; i += (size_t)nb * NTHREADS) {
    const float4 a = ((const float4*)src)[2 * i], b = ((const float4*)src)[2 * i + 1];
    ((uint4*)dst)[i] = make_uint4(pack2(a.x, a.y), pack2(a.z, a.w), pack2(b.x, b.y), pack2(b.z, b.w));
  }
}
__device__ void rows_bf16_rs(const float* __restrict__ src, bf16_t* __restrict__ dst, float* __restrict__ rs, int nrows, int bid, int nb) {
  const int lane = threadIdx.x & 63, w = threadIdx.x >> 6;
  for (int row = bid * 4 + w; row < nrows; row += nb * 4) {
    const float4* s = (const float4*)(src + (size_t)row * 1024);
    float ss = 0.f; uint2* d = (uint2*)(dst + (size_t)row * 1024);
#pragma unroll
    for (int i = 0; i < 4; ++i) { const float4 v = s[i * 64 + lane]; ss += v.x * v.x + v.y * v.y + v.z * v.z + v.w * v.w; d[i * 64 + lane] = make_uint2(pack2(v.x, v.y), pack2(v.z, v.w)); }
#pragma unroll
    for (int o = 32; o > 0; o >>= 1) ss += __shfl_xor(ss, o);
    if (lane == 0) rs[row] = rsqrtf(ss * (1.0f / 1024.0f) + EPSF);
  }
}

__device__ void rows_fp8(const float* __restrict__ src, unsigned char* __restrict__ dst, float* __restrict__ sc, int nrows, int bid, int nb) {
  const int lane = threadIdx.x & 63, w = threadIdx.x >> 6;
  for (int row = bid * 4 + w; row < nrows; row += nb * 4) {
    const float4* s = (const float4*)(src + (size_t)row * 1024);
    float4 v[4]; float am = 0.f;
#pragma unroll
    for (int i = 0; i < 4; ++i) { v[i] = s[i * 64 + lane]; am = fmaxf(am, fmaxf(fmaxf(fabsf(v[i].x), fabsf(v[i].y)), fmaxf(fabsf(v[i].z), fabsf(v[i].w)))); }
#pragma unroll
    for (int o = 32; o > 0; o >>= 1) am = fmaxf(am, __shfl_xor(am, o));
    const float q = (am > 0.f) ? 224.0f / am : 1.0f;
    unsigned* d = (unsigned*)(dst + (size_t)row * 1024);
#pragma unroll
    for (int i = 0; i < 4; ++i) { int wd = 0; wd = __builtin_amdgcn_cvt_pk_fp8_f32(v[i].x * q, v[i].y * q, wd, false); wd = __builtin_amdgcn_cvt_pk_fp8_f32(v[i].z * q, v[i].w * q, wd, true); d[i * 64 + lane] = (unsigned)wd; }
    if (lane == 0) sc[row] = (am > 0.f) ? am * (1.0f / 224.0f) : 1.0f;
  }
}

__device__ void ssm_stage1(const Params& p, int gp) {
  const int g = gp >> 6;
  const float step = expf(p.log_step[g]); const float lr = p.lam_re[gp], li = p.lam_im[gp];
  const float mag = expf(lr * step); const float ar = mag * cosf(li * step), ai = mag * sinf(li * step);
  const float zr = ar - 1.0f, den = lr * lr + li * li; const float fr = (zr * lr + ai * li) / den, fi = (ai * lr - zr * li) / den;
  for (int c = 0; c < 16; ++c) { const float br = p.b_re[gp * 16 + c], bi = p.b_im[gp * 16 + c]; p.BBR[gp * 16 + c] = fr * br - fi * bi; p.BBI[gp * 16 + c] = fr * bi + fi * br; }
  float pr = 1.f, pi = 0.f; const int st = gp & 63;
  for (int j = 0; j <= 16; ++j) { p.PWR[(g * 17 + j) * 64 + st] = pr; p.PWI[(g * 17 + j) * 64 + st] = pi; const float nr = pr * ar - pi * ai, ni = pr * ai + pi * ar; if (j < 16) { pr = nr; pi = ni; } }
  const float a16r = pr, a16i = pi; const float a32r = a16r * a16r - a16i * a16i, a32i = 2.f * a16r * a16i;
  const float a48r = a32r * a16r - a32i * a16i, a48i = a32r * a16i + a32i * a16r; const float a64r = a32r * a32r - a32i * a32i, a64i = 2.f * a32r * a32i;
  const float a128r = a64r * a64r - a64i * a64i, a128i = 2.f * a64r * a64i; const float a256r = a128r * a128r - a128i * a128i, a256i = 2.f * a128r * a128i;
  float* A = p.APW;
  A[0 * 4096 + gp] = a16r; A[0 * 4096 + 2048 + gp] = a16i; A[1 * 4096 + gp] = a32r; A[1 * 4096 + 2048 + gp] = a32i; A[2 * 4096 + gp] = a48r; A[2 * 4096 + 2048 + gp] = a48i;
  A[3 * 4096 + gp] = a64r; A[3 * 4096 + 2048 + gp] = a64i; A[4 * 4096 + gp] = a256r; A[4 * 4096 + 2048 + gp] = a256i;
}
__device__ void ssm_stage2(const Params& p, int bid, int nb) {
  const int total1 = 32 * 128 * 256, total2 = 32 * 256 * 384;
  for (int i = bid * NTHREADS + threadIdx.x; i < total1 + total2; i += nb * NTHREADS) {
    if (i < total1) {
      const int k = i & 255, sr = (i >> 8) & 127, g = i >> 15; const int st = ((sr >> 5) << 4) | (sr & 15), ri = (sr >> 4) & 1; const int s = k >> 4, ch = k & 15;
      const int gp = g * 64 + st; const float pr = p.PWR[(g * 17 + 15 - s) * 64 + st], pi = p.PWI[(g * 17 + 15 - s) * 64 + st]; const float br = p.BBR[gp * 16 + ch], bi = p.BBI[gp * 16 + ch];
      p.WE16[i] = f2bf(ri == 0 ? (pr * br - pi * bi) : (pr * bi + pi * br));
    } else {
      const int e = i - total1; const int k = e % 384, r = (e / 384) & 255, g = e / (384 * 256); const int t = r >> 4, co = r & 15; float val;
      if (k < 128) { const int st = ((k >> 5) << 4) | (k & 15), ri = (k >> 4) & 1; const float cr = p.c_re[(g * 16 + co) * 64 + st], ci = p.c_im[(g * 16 + co) * 64 + st];
        const float pr = p.PWR[(g * 17 + t + 1) * 64 + st], pi = p.PWI[(g * 17 + t + 1) * 64 + st]; val = (ri == 0) ? (cr * pr - ci * pi) : -(cr * pi + ci * pr); }
      else { const int kk = k - 128, s = kk >> 4, cin = kk & 15; val = 0.f;
        if (s <= t) { const int j = t - s; float acc = 0.f;
          for (int st = 0; st < 64; ++st) { const float cr = p.c_re[(g * 16 + co) * 64 + st], ci = p.c_im[(g * 16 + co) * 64 + st]; const float pr = p.PWR[(g * 17 + j) * 64 + st], pi = p.PWI[(g * 17 + j) * 64 + st];
            const float br = p.BBR[(g * 64 + st) * 16 + cin], bi = p.BBI[(g * 64 + st) * 16 + cin]; acc += cr * (pr * br - pi * bi) - ci * (pr * bi + pi * br); }
          val = acc; } }
      p.WY[e] = f2bf(val);
    }
  }
}

#define EPI_IDS const int tid = threadIdx.x, lane = tid & 63, w = tid >> 6, wr = w >> 1, wc = w & 1, fr = lane & 15, fq = lane >> 4; (void)wr; (void)wc; (void)fr; (void)fq;

__device__ void tile_win(const Params& p, int tile, char* lds) {
  const int rt = tile >> 4, ct = tile & 15; const int row0 = rt * 128, col0 = ct * 128;
  f32x4 acc[4][4];
  gemm_mainloop<false>(acc, p.XB, 1024, p.WtIn, 1024, 1024, row0, col0, lds, nullptr, nullptr, 0);
  EPI_IDS
  const int cw = col0 + wc * 64;
#pragma unroll
  for (int m = 0; m < 4; ++m) {
    const int row = row0 + wr * 64 + m * 16 + fr; const float rsx = p.rs_x[row];
    if (cw < 1024) {
      float ss = 0.f;
#pragma unroll
      for (int n = 0; n < 4; ++n)
#pragma unroll
        for (int j = 0; j < 4; ++j) { const float v = acc[m][n][j] * rsx; acc[m][n][j] = v; ss += v * v; }
      ss += __shfl_xor(ss, 16); ss += __shfl_xor(ss, 32);
      const float rs = rsqrtf(ss * (1.0f / 64.0f) + EPSF) * (cw < 512 ? 0.125f : 1.0f);
      const float* g = (cw < 512) ? p.att_q_g : p.att_k_g; bf16_t* dst = (cw < 512 ? p.Qb : p.Kb) + (size_t)row * 512 + (cw & 511);
#pragma unroll
      for (int n = 0; n < 4; ++n) { const int c = n * 16 + fq * 4; const float4 gg = *(const float4*)(g + c);
        *(uint2*)(dst + c) = make_uint2(pack2(acc[m][n][0] * rs * gg.x, acc[m][n][1] * rs * gg.y), pack2(acc[m][n][2] * rs * gg.z, acc[m][n][3] * rs * gg.w)); }
    } else if (cw < 1536) {
      const int head = (cw - 1024) >> 6; const int b = row >> 13, tb = row & 8191;
      bf16_t* dst = p.VT + ((size_t)(b * 8 + head) * 64) * SEQL + tb;
#pragma unroll
      for (int n = 0; n < 4; ++n)
#pragma unroll
        for (int j = 0; j < 4; ++j) dst[(size_t)(n * 16 + fq * 4 + j) * SEQL] = f2bf(acc[m][n][j] * rsx);
    } else {
      bf16_t* dst = p.Ub + (size_t)row * 512 + (cw - 1536);
#pragma unroll
      for (int n = 0; n < 4; ++n) { const int c = n * 16 + fq * 4;
        *(uint2*)(dst + c) = make_uint2(pack2(acc[m][n][0] * rsx, acc[m][n][1] * rsx), pack2(acc[m][n][2] * rsx, acc[m][n][3] * rsx)); }
    }
  }
}
__device__ void tile_memkv(const Params& p, int tile, char* lds) {
  const int which = tile >> 5, t2 = tile & 31; const int rt = t2 >> 3, ct = t2 & 7; const int row0 = rt * 128, col0 = ct * 128;
  f32x4 acc[4][4];
  gemm_mainloop<false>(acc, p.MEMB, 1024, which ? p.WtMv : p.WtMk, 1024, 1024, row0, col0, lds, nullptr, nullptr, 0);
  EPI_IDS
  const int cw = col0 + wc * 64;
#pragma unroll
  for (int m = 0; m < 4; ++m) {
    const int row = row0 + wr * 64 + m * 16 + fr; const float rsm = p.rs_mem[row];
    if (which == 0) {
      float ss = 0.f;
#pragma unroll
      for (int n = 0; n < 4; ++n) { f32x4 v = acc[m][n] * rsm; ss += v[0] * v[0] + v[1] * v[1] + v[2] * v[2] + v[3] * v[3]; *(f32x4*)(p.KMraw + (size_t)row * 1024 + cw + n * 16 + fq * 4) = v; }
      ss += __shfl_xor(ss, 16); ss += __shfl_xor(ss, 32);
      if (fq == 0) p.ss_km[row * 16 + (cw >> 6)] = ss;
    } else {
      const int b = row >> 8, key = row & 255; const int head = cw >> 8; const int d0 = (cw & 255);
      bf16_t* dst = p.VMT + ((size_t)(b * 4 + head) * 256) * 256 + key;
#pragma unroll
      for (int n = 0; n < 4; ++n)
#pragma unroll
        for (int j = 0; j < 4; ++j) dst[(size_t)(d0 + n * 16 + fq * 4 + j) * 256] = f2bf(acc[m][n][j] * rsm);
    }
  }
}
__device__ void memk_fix(const Params& p, int bid, int nb) {
  for (int i = bid * NTHREADS + threadIdx.x; i < 512 * 1024 / 4; i += nb * NTHREADS) {
    const int row = i >> 8, c4 = (i & 255) * 4; const int head = c4 >> 8, d = c4 & 255;
    const float ss = p.ss_km[row * 16 + head * 4] + p.ss_km[row * 16 + head * 4 + 1] + p.ss_km[row * 16 + head * 4 + 2] + p.ss_km[row * 16 + head * 4 + 3];
    const float rs = rsqrtf(ss * (1.0f / 256.0f) + EPSF);
    const float4 v = *(const float4*)(p.KMraw + (size_t)row * 1024 + c4); const float4 gk = *(const float4*)(p.mem_k_g + d), gq = *(const float4*)(p.mem_q_g + d);
    const int b = row >> 8, key = row & 255;
    *(uint2*)(p.KMB + ((size_t)(b * 4 + head) * 256 + key) * 256 + d) = make_uint2(pack2(v.x * rs * gk.x * gq.x, v.y * rs * gk.y * gq.y), pack2(v.z * rs * gk.z * gq.z, v.w * rs * gk.w * gq.w));
  }
}

__device__ void chunk_attn_item(const Params& p, int item, float* rb) {
  const int h = item & 7, cn = (item >> 3) & 127, b = item >> 10;
  const int tid = threadIdx.x, lane = tid & 63, w = tid >> 6, fr = lane & 15, fq = lane >> 4;
  __syncthreads();
  if (tid < 192) rb[tid] = p.rel_bias[h * 192 + tid];
  __syncthreads();
  const int iq = w * 16 + fr; const int tq = b * SEQL + cn * 64 + iq;
  bf16x8 qf[2];
  qf[0] = *(const bf16x8*)(p.Qb + (size_t)tq * 512 + h * 64 + fq * 8); qf[1] = *(const bf16x8*)(p.Qb + (size_t)tq * 512 + h * 64 + 32 + fq * 8);
  f32x4 o[4]; for (int i = 0; i < 4; ++i) o[i] = (f32x4){0.f, 0.f, 0.f, 0.f};
  float mrun = -1e30f, lrun = 0.f;
  const int cstart = (cn >= 8) ? 0 : (8 - cn);
  const bf16_t* vtb = p.VT + ((size_t)(b * 8 + h) * 64) * SEQL;
  for (int c = cstart; c <= 8; ++c) {
    const int kc0 = (cn - 8 + c) * 64;
    f32x4 st[4];
#pragma unroll
    for (int mt = 0; mt < 4; ++mt) {
      const bf16_t* kr = p.Kb + (size_t)(b * SEQL + kc0 + mt * 16 + fr) * 512 + h * 64 + fq * 8;
      const bf16x8 k0 = *(const bf16x8*)kr, k1 = *(const bf16x8*)(kr + 32);
      f32x4 s = (f32x4){0.f, 0.f, 0.f, 0.f}; s = mfma16(k0, qf[0], s); s = mfma16(k1, qf[1], s); st[mt] = s;
    }
    float tmax = -1e30f;
#pragma unroll
    for (int mt = 0; mt < 4; ++mt)
#pragma unroll
      for (int j = 0; j < 4; ++j) { const int jk = mt * 16 + fq * 4 + j; int dist = 512 - 64 * c + iq - jk; dist = dist < -63 ? -63 : (dist > 128 ? 128 : dist);
        const float s = st[mt][j] + rb[dist + 63]; st[mt][j] = s; tmax = fmaxf(tmax, s); }
    tmax = fmaxf(tmax, __shfl_xor(tmax, 16)); tmax = fmaxf(tmax, __shfl_xor(tmax, 32));
    const float mnew = fmaxf(mrun, tmax); const float alpha = __expf(mrun - mnew); mrun = mnew;
    float ls = 0.f;
#pragma unroll
    for (int mt = 0; mt < 4; ++mt)
#pragma unroll
      for (int j = 0; j < 4; ++j) { const float pv = __expf(st[mt][j] - mnew); st[mt][j] = pv; ls += pv; }
    lrun = lrun * alpha + ls;
#pragma unroll
    for (int dt = 0; dt < 4; ++dt) o[dt] *= alpha;
#pragma unroll
    for (int s2 = 0; s2 < 2; ++s2) {
      union { bf16x8 v; unsigned u[4]; } pf;
      pf.u[0] = pack2(st[2 * s2][0], st[2 * s2][1]); pf.u[1] = pack2(st[2 * s2][2], st[2 * s2][3]); pf.u[2] = pack2(st[2 * s2 + 1][0], st[2 * s2 + 1][1]); pf.u[3] = pack2(st[2 * s2 + 1][2], st[2 * s2 + 1][3]);
#pragma unroll
      for (int dt = 0; dt < 4; ++dt) {
        const bf16_t* vr = vtb + (size_t)(dt * 16 + fr) * SEQL + kc0 + s2 * 32 + fq * 4;
        union { bf16x8 v; uint2 u[2]; } vf; vf.u[0] = *(const uint2*)vr; vf.u[1] = *(const uint2*)(vr + 16);
        o[dt] = mfma16(vf.v, pf.v, o[dt]);
      }
    }
  }
  float lt = lrun; lt += __shfl_xor(lt, 16); lt += __shfl_xor(lt, 32);
  const float inv = 1.0f / lt; float ss = 0.f;
  bf16_t* dst = p.ATT + (size_t)tq * 512 + h * 64;
#pragma unroll
  for (int dt = 0; dt < 4; ++dt) { const f32x4 v = o[dt] * inv; ss += v[0] * v[0] + v[1] * v[1] + v[2] * v[2] + v[3] * v[3];
    *(uint2*)(dst + dt * 16 + fq * 4) = make_uint2(pack2(v[0], v[1]), pack2(v[2], v[3])); }
  ss += __shfl_xor(ss, 16); ss += __shfl_xor(ss, 32);
  if (fq == 0) p.ss_att[tq * 8 + h] = ss;
}

template <bool FINAL>
__device__ void ssm_item(const Params& p, int item, char* lds) {
  const int g = item & 31, seg = (item >> 5) & 31, b = item >> 10;
  const int tid = threadIdx.x, lane = tid & 63, w = tid >> 6, fr = lane & 15, fq = lane >> 4;
  const int t0 = b * SEQL + seg * 256;
  bf16x8 uf[8];
#pragma unroll
  for (int ks = 0; ks < 8; ++ks) uf[ks] = *(const bf16x8*)(p.Ub + (size_t)(t0 + fr * 16 + 2 * ks + (fq >> 1)) * 512 + g * 16 + (fq & 1) * 8);
  f32x4 er = (f32x4){0.f, 0.f, 0.f, 0.f}, ei = er;
  const bf16_t* we = p.WE16 + ((size_t)g * 128 + w * 32 + fr) * 256 + fq * 8;
#pragma unroll
  for (int ks = 0; ks < 8; ++ks) { const bf16x8 br = *(const bf16x8*)(we + ks * 32), bi = *(const bf16x8*)(we + 16 * 256 + ks * 32); er = mfma16(uf[ks], br, er); ei = mfma16(uf[ks], bi, ei); }
  const int gp = g * 64 + w * 16 + fr;
  const float a16r = p.APW[gp], a16i = p.APW[2048 + gp];
  float xr[4], xi[4];
  xr[0] = er[0]; xi[0] = ei[0];
#pragma unroll
  for (int j = 1; j < 4; ++j) { xr[j] = a16r * xr[j - 1] - a16i * xi[j - 1] + er[j]; xi[j] = a16r * xi[j - 1] + a16i * xr[j - 1] + ei[j]; }
  float cr = 0.f, ci = 0.f;
  if (FINAL) {
    const float ar = p.APW[4 * 4096 + gp], ai = p.APW[4 * 4096 + 2048 + gp];
    const float* es = p.ESEG + ((size_t)(b * 32) * 32 + g) * 128 + w * 32 + fr;
    for (int j = 0; j < seg; ++j) { const float e_r = es[(size_t)j * 32 * 128], e_i = es[(size_t)j * 32 * 128 + 16]; const float nr = ar * cr - ai * ci + e_r, ni = ar * ci + ai * cr + e_i; cr = nr; ci = ni; }
  }
  const float a64r = p.APW[3 * 4096 + gp], a64i = p.APW[3 * 4096 + 2048 + gp];
  float tr = xr[3], ti = xi[3];
#pragma unroll
  for (int r = 0; r < 4; ++r) {
    float pr_ = __shfl(tr, (lane + 48) & 63), pi_ = __shfl(ti, (lane + 48) & 63);
    if (r == 0) { pr_ = cr; pi_ = ci; }
    if (fq == r) { const float nr = xr[3] + a64r * pr_ - a64i * pi_, ni = xi[3] + a64r * pi_ + a64i * pr_; tr = nr; ti = ni; }
  }
  if (!FINAL) {
    if (fq == 3) { float* es = p.ESEG + ((size_t)(b * 32 + seg) * 32 + g) * 128 + w * 32 + fr; es[0] = tr; es[16] = ti; }
    return;
  }
  float gr = __shfl(tr, (lane + 48) & 63), gi = __shfl(ti, (lane + 48) & 63);
  if (fq == 0) { gr = cr; gi = ci; }
  float pvr[4], pvi[4];
  pvr[0] = gr; pvi[0] = gi;
#pragma unroll
  for (int j = 1; j < 4; ++j) { const float ar = p.APW[(j - 1) * 4096 + gp], ai = p.APW[(j - 1) * 4096 + 2048 + gp]; pvr[j] = xr[j - 1] + ar * gr - ai * gi; pvi[j] = xi[j - 1] + ar * gi + ai * gr; }
  bf16_t* xl = (bf16_t*)lds;
  __syncthreads();
#pragma unroll
  for (int j = 0; j < 4; ++j) { xl[(fq * 4 + j) * 136 + w * 32 + fr] = f2bf(pvr[j]); xl[(fq * 4 + j) * 136 + w * 32 + 16 + fr] = f2bf(pvi[j]); }
  __syncthreads();
  bf16x8 xf[4];
#pragma unroll
  for (int ks = 0; ks < 4; ++ks) xf[ks] = *(const bf16x8*)(xl + fr * 136 + ks * 32 + fq * 8);
#pragma unroll
  for (int mi = 0; mi < 4; ++mi) {
    const int mt = w * 4 + mi;
    const bf16_t* wy = p.WY + ((size_t)g * 256 + mt * 16 + fr) * 384 + fq * 8;
    f32x4 y = (f32x4){0.f, 0.f, 0.f, 0.f};
#pragma unroll
    for (int ks = 0; ks < 4; ++ks) y = mfma16(*(const bf16x8*)(wy + ks * 32), xf[ks], y);
#pragma unroll
    for (int ks = 0; ks < 8; ++ks) if (2 * ks <= mt) y = mfma16(*(const bf16x8*)(wy + 128 + ks * 32), uf[ks], y);
    const size_t tok = (size_t)(t0 + fr * 16 + mt);
    const uint2 uu = *(const uint2*)(p.Ub + tok * 512 + g * 16 + fq * 4);
    const float4 dd = *(const float4*)(p.d_skip + g * 16 + fq * 4);
    const float y0 = gelu_f(y[0] + dd.x * __uint_as_float(uu.x << 16)), y1 = gelu_f(y[1] + dd.y * __uint_as_float(uu.x & 0xffff0000u));
    const float y2 = gelu_f(y[2] + dd.z * __uint_as_float(uu.y << 16)), y3 = gelu_f(y[3] + dd.w * __uint_as_float(uu.y & 0xffff0000u));
    *(uint2*)(p.YG + tok * 512 + g * 16 + fq * 4) = make_uint2(pack2(y0, y1), pack2(y2, y3));
  }
}

__device__ void tile_glu(const Params& p, int tile, char* lds) {
  const int rt = tile >> 2, ct = tile & 3; const int row0 = rt * 128, col0 = ct * 128;
  f32x4 acc[4][4];
  gemm_mainloop<false>(acc, p.YG, 512, p.WtGlu, 512, 512, row0, col0, lds, nullptr, nullptr, 0);
  EPI_IDS
  const int cw = col0 + wc * 64;
#pragma unroll
  for (int m = 0; m < 4; ++m) {
    const int row = row0 + wr * 64 + m * 16 + fr; float ss = 0.f;
#pragma unroll
    for (int n = 0; n < 4; ++n) { const int c = cw + n * 16 + fq * 4; const float4 bg = *(const float4*)(p.b_glu + c); const uint2 yy = *(const uint2*)(p.YG + (size_t)row * 512 + c);
      const float y0 = __uint_as_float(yy.x << 16), y1 = __uint_as_float(yy.x & 0xffff0000u), y2 = __uint_as_float(yy.y << 16), y3 = __uint_as_float(yy.y & 0xffff0000u);
      const float o0 = y0 / (1.f + __expf(-(acc[m][n][0] + bg.x))), o1 = y1 / (1.f + __expf(-(acc[m][n][1] + bg.y))), o2 = y2 / (1.f + __expf(-(acc[m][n][2] + bg.z))), o3 = y3 / (1.f + __expf(-(acc[m][n][3] + bg.w)));
      ss += o0 * o0 + o1 * o1 + o2 * o2 + o3 * o3;
      *(uint2*)(p.SSMO + (size_t)row * 512 + c) = make_uint2(pack2(o0, o1), pack2(o2, o3)); }
    ss += __shfl_xor(ss, 16); ss += __shfl_xor(ss, 32);
    if (fq == 0) p.ss_ssm[row * 8 + (cw >> 6)] = ss;
  }
}
__device__ void tile_wout(const Params& p, int tile, char* lds) {
  const int rt = tile >> 3, ct = tile & 7; const int row0 = rt * 128, col0 = ct * 128;
  f32x4 acc[4][4];
  float s0[4], s1[4];
  { const int sr = threadIdx.x >> 3;
#pragma unroll
    for (int i = 0; i < 4; ++i) { const int row = row0 + sr + 32 * i; float a = 0.f, c = 0.f;
#pragma unroll
      for (int j = 0; j < 8; ++j) { a += p.ss_att[row * 8 + j]; c += p.ss_ssm[row * 8 + j]; }
      s0[i] = rsqrtf(a * (1.0f / 512.0f) + EPSF); s1[i] = rsqrtf(c * (1.0f / 512.0f) + EPSF); } }
  gemm_mainloop<true, true>(acc, p.ATT, 512, p.WtOut, 1024, 512, row0, col0, lds, s0, s0, 1 << 30);
  gemm_mainloop<true, false>(acc, p.SSMO, 512, p.WtOut + 512, 1024, 512, row0, col0, lds, s1, s1, 1 << 30);
  EPI_IDS
  const int cw = col0 + wc * 64;
#pragma unroll
  for (int m = 0; m < 4; ++m) {
    const int row = row0 + wr * 64 + m * 16 + fr; float ss = 0.f;
#pragma unroll
    for (int n = 0; n < 4; ++n) { const int c = cw + n * 16 + fq * 4; const f32x4 xv = *(const f32x4*)(p.x + (size_t)row * 1024 + c); const f32x4 hv = xv + acc[m][n];
      ss += hv[0] * hv[0] + hv[1] * hv[1] + hv[2] * hv[2] + hv[3] * hv[3];
      *(uint2*)(p.H1B + (size_t)row * 1024 + c) = make_uint2(pack2(hv[0], hv[1]), pack2(hv[2], hv[3])); }
    ss += __shfl_xor(ss, 16); ss += __shfl_xor(ss, 32);
    if (fq == 0) p.ss_h1[row * 16 + (cw >> 6)] = ss;
  }
}
__device__ __forceinline__ float row_rs16(const float* ss, int row) { float a = 0.f;
#pragma unroll
  for (int j = 0; j < 16; ++j) a += ss[row * 16 + j];
  return rsqrtf(a * (1.0f / 1024.0f) + EPSF); }
__device__ void tile_memq(const Params& p, int tile, char* lds) {
  const int rt = tile >> 3, ct = tile & 7; const int row0 = rt * 128, col0 = ct * 128;
  f32x4 acc[4][4];
  gemm_mainloop<false>(acc, p.H1B, 1024, p.WtMq, 1024, 1024, row0, col0, lds, nullptr, nullptr, 0);
  EPI_IDS
  const int cw = col0 + wc * 64;
#pragma unroll
  for (int m = 0; m < 4; ++m) {
    const int row = row0 + wr * 64 + m * 16 + fr; const float rs = row_rs16(p.ss_h1, row); float ss = 0.f;
#pragma unroll
    for (int n = 0; n < 4; ++n) { const int c = cw + n * 16 + fq * 4; const f32x4 v = acc[m][n] * rs; ss += v[0] * v[0] + v[1] * v[1] + v[2] * v[2] + v[3] * v[3];
      *(uint2*)(p.QM + (size_t)row * 1024 + c) = make_uint2(pack2(v[0], v[1]), pack2(v[2], v[3])); }
    ss += __shfl_xor(ss, 16); ss += __shfl_xor(ss, 32);
    if (fq == 0) p.ss_qm[row * 16 + (cw >> 6)] = ss;
  }
}
__device__ void mem_attn_item(const Params& p, int item) {
  const int h = item & 3, tt = item >> 2; const int tid = threadIdx.x, lane = tid & 63, w = tid >> 6, fr = lane & 15, fq = lane >> 4;
  const int tq = tt * 64 + w * 16 + fr; const int b = tq >> 13;
  const float ssq = p.ss_qm[tq * 16 + h * 4] + p.ss_qm[tq * 16 + h * 4 + 1] + p.ss_qm[tq * 16 + h * 4 + 2] + p.ss_qm[tq * 16 + h * 4 + 3];
  const float rowscale = rsqrtf(ssq * (1.0f / 256.0f) + EPSF) * 0.0625f;
  f32x4 st[16];
  {
    bf16x8 qf[8];
#pragma unroll
    for (int ks = 0; ks < 8; ++ks) qf[ks] = *(const bf16x8*)(p.QM + (size_t)tq * 1024 + h * 256 + ks * 32 + fq * 8);
    const bf16_t* kb = p.KMB + ((size_t)(b * 4 + h) * 256 + fr) * 256 + fq * 8;
#pragma unroll
    for (int mt = 0; mt < 16; ++mt) { f32x4 s = (f32x4){0.f, 0.f, 0.f, 0.f};
#pragma unroll
      for (int ks = 0; ks < 8; ++ks) s = mfma16(*(const bf16x8*)(kb + (size_t)(mt * 16) * 256 + ks * 32), qf[ks], s);
      st[mt] = s * rowscale; }
  }
  float mx = -1e30f;
#pragma unroll
  for (int mt = 0; mt < 16; ++mt) mx = fmaxf(fmaxf(fmaxf(mx, st[mt][0]), fmaxf(st[mt][1], st[mt][2])), st[mt][3]);
  mx = fmaxf(mx, __shfl_xor(mx, 16)); mx = fmaxf(mx, __shfl_xor(mx, 32));
  float l = 0.f;
#pragma unroll
  for (int mt = 0; mt < 16; ++mt)
#pragma unroll
    for (int j = 0; j < 4; ++j) { const float e = __expf(st[mt][j] - mx); st[mt][j] = e; l += e; }
  l += __shfl_xor(l, 16); l += __shfl_xor(l, 32);
  const float inv = 1.0f / l;
  bf16x8 pf[8];
#pragma unroll
  for (int s2 = 0; s2 < 8; ++s2) { union { bf16x8 v; unsigned u[4]; } t; t.u[0] = pack2(st[2 * s2][0], st[2 * s2][1]); t.u[1] = pack2(st[2 * s2][2], st[2 * s2][3]); t.u[2] = pack2(st[2 * s2 + 1][0], st[2 * s2 + 1][1]); t.u[3] = pack2(st[2 * s2 + 1][2], st[2 * s2 + 1][3]); pf[s2] = t.v; }
  const bf16_t* vb = p.VMT + ((size_t)(b * 4 + h) * 256 + fr) * 256 + fq * 4;
  bf16_t* dst = p.OM + (size_t)tq * 1024 + h * 256;
#pragma unroll 4
  for (int dt = 0; dt < 16; ++dt) { f32x4 o = (f32x4){0.f, 0.f, 0.f, 0.f};
#pragma unroll
    for (int s2 = 0; s2 < 8; ++s2) { const bf16_t* vr = vb + (size_t)(dt * 16) * 256 + s2 * 32; union { bf16x8 v; uint2 u[2]; } vf; vf.u[0] = *(const uint2*)vr; vf.u[1] = *(const uint2*)(vr + 16); o = mfma16(vf.v, pf[s2], o); }
    o *= inv; *(uint2*)(dst + dt * 16 + fq * 4) = make_uint2(pack2(o[0], o[1]), pack2(o[2], o[3])); }
}
__device__ void tile_memo(const Params& p, int tile, char* lds) {
  const int rt = tile >> 3, ct = tile & 7; const int row0 = rt * 128, col0 = ct * 128;
  f32x4 acc[4][4];
  gemm_mainloop<false>(acc, p.OM, 1024, p.WtMo, 1024, 1024, row0, col0, lds, nullptr, nullptr, 0);
  EPI_IDS
  const int cw = col0 + wc * 64;
#pragma unroll
  for (int m = 0; m < 4; ++m) {
    const int row = row0 + wr * 64 + m * 16 + fr; float ss = 0.f;
#pragma unroll
    for (int n = 0; n < 4; ++n) { const int c = cw + n * 16 + fq * 4; const uint2 hb = *(const uint2*)(p.H1B + (size_t)row * 1024 + c);
      const f32x4 hv = (f32x4){__uint_as_float(hb.x << 16), __uint_as_float(hb.x & 0xffff0000u), __uint_as_float(hb.y << 16), __uint_as_float(hb.y & 0xffff0000u)} + acc[m][n];
      ss += hv[0] * hv[0] + hv[1] * hv[1] + hv[2] * hv[2] + hv[3] * hv[3];
      *(uint2*)(p.H2B + (size_t)row * 1024 + c) = make_uint2(pack2(hv[0], hv[1]), pack2(hv[2], hv[3])); }
    ss += __shfl_xor(ss, 16); ss += __shfl_xor(ss, 32);
    if (fq == 0) p.ss_h2[row * 16 + (cw >> 6)] = ss;
  }
}
__device__ void tile_peerq(const Params& p, int tile, char* lds) {
  const int rt = tile >> 4, ct = tile & 15; const int row0 = rt * 128, col0 = ct * 128;
  f32x4 acc[4][4];
  gemm_mainloop<false>(acc, p.H2B, 1024, p.WtPq, 1024, 1024, row0, col0, lds, nullptr, nullptr, 0);
  EPI_IDS
  const int cw = col0 + wc * 64;
#pragma unroll
  for (int m = 0; m < 4; ++m) {
    const int row = row0 + wr * 64 + m * 16 + fr; const float rs = row_rs16(p.ss_h2, row);
#pragma unroll
    for (int n = 0; n < 4; ++n) { const int c = cw + n * 16 + fq * 4; const f32x4 v = acc[m][n] * rs;
      *(uint2*)(p.QP + (size_t)row * 2048 + c) = make_uint2(pack2(v[0], v[1]), pack2(v[2], v[3])); }
  }
}
__device__ __forceinline__ void ins16(float (&a)[16], float v) {
#pragma unroll
  for (int i = 0; i < 16; ++i) { const float hi = fmaxf(a[i], v), lo = fminf(a[i], v); a[i] = hi; v = lo; }
}
__device__ void tile_scores(const Params& p, int tile, char* lds) {
  const int rt = tile >> 4, hs = tile & 15; const int row0 = rt * 128;
  f32x4 acc[4][4];
  gemm_mainloop<false>(acc, p.QP + hs * 128, 2048, p.PK + (size_t)hs * 128 * 128, 128, 128, row0, 0, lds, nullptr, nullptr, 0);
  EPI_IDS
  float* tl = (float*)lds;
#pragma unroll
  for (int m = 0; m < 4; ++m)
#pragma unroll
    for (int n = 0; n < 4; ++n)
#pragma unroll
      for (int j = 0; j < 4; ++j) tl[(wr * 64 + m * 16 + fr) * 129 + wc * 64 + n * 16 + fq * 4 + j] = acc[m][n][j];
  __syncthreads();
  if (tid < 128) {
    float a[16];
#pragma unroll
    for (int i = 0; i < 16; ++i) a[i] = -__builtin_inff();
    for (int n = 0; n < 128; ++n) { const float v = __uint_as_float((__float_as_uint(tl[tid * 129 + n]) & ~127u) | (unsigned)n); ins16(a, v); }
    uint4* dst = (uint4*)(p.TOPS + ((size_t)(row0 + tid) * 16 + hs) * 16);
    dst[0] = make_uint4(__float_as_uint(a[0]), __float_as_uint(a[1]), __float_as_uint(a[2]), __float_as_uint(a[3]));
    dst[1] = make_uint4(__float_as_uint(a[4]), __float_as_uint(a[5]), __float_as_uint(a[6]), __float_as_uint(a[7]));
    dst[2] = make_uint4(__float_as_uint(a[8]), __float_as_uint(a[9]), __float_as_uint(a[10]), __float_as_uint(a[11]));
    dst[3] = make_uint4(__float_as_uint(a[12]), __float_as_uint(a[13]), __float_as_uint(a[14]), __float_as_uint(a[15]));
  }
}
__device__ void peer_gather_item(const Params& p, int item, char* lds) {
  const int tid = threadIdx.x, lane = tid & 63, w = tid >> 6;
  unsigned* LA = (unsigned*)lds;
  int* LE = (int*)(lds + 256 * 33 * 4);
  float* LG = (float*)(lds + 256 * 33 * 4 + 32 * 128 * 4);
  __syncthreads();
  {
    const int tl_ = tid >> 3, h = tid & 7; const int t = item * 32 + tl_;
    const uint4* src = (const uint4*)(p.TOPS + ((size_t)t * 16 + h * 2) * 16);
    float a[16], bq[16];
#pragma unroll
    for (int i = 0; i < 4; ++i) { const uint4 v = src[i]; a[4 * i] = __uint_as_float(v.x); a[4 * i + 1] = __uint_as_float(v.y); a[4 * i + 2] = __uint_as_float(v.z); a[4 * i + 3] = __uint_as_float(v.w); }
#pragma unroll
    for (int i = 0; i < 4; ++i) { const uint4 v = src[4 + i]; bq[4 * i] = __uint_as_float(v.x); bq[4 * i + 1] = __uint_as_float(v.y); bq[4 * i + 2] = __uint_as_float(v.z); bq[4 * i + 3] = __uint_as_float(v.w); }
#pragma unroll
    for (int i = 0; i < 16; ++i) { LA[tid * 33 + i] = __float_as_uint(a[i]); LA[tid * 33 + 16 + i] = __float_as_uint(bq[i]); }
    float c[16];
#pragma unroll
    for (int i = 0; i < 16; ++i) c[i] = -__builtin_inff();
#pragma unroll
    for (int i = 0; i < 16; ++i)
#pragma unroll
      for (int j = 0; j < 16; ++j) if ((i + 1) * (j + 1) <= 16) { const float s = a[i] + bq[j]; ins16(c, __uint_as_float((__float_as_uint(s) & ~255u) | (unsigned)(i * 16 + j))); }
    const float mx = c[0]; float e[16]; float sum = 0.f;
#pragma unroll
    for (int i = 0; i < 16; ++i) { e[i] = __expf(c[i] - mx); sum += e[i]; }
    const float inv = 1.0f / sum;
#pragma unroll
    for (int i = 0; i < 16; ++i) { const unsigned pos = __float_as_uint(c[i]) & 255u; const unsigned ia = LA[tid * 33 + (pos >> 4)] & 127u, ib = LA[tid * 33 + 16 + (pos & 15u)] & 127u;
      LE[tl_ * 128 + h * 16 + i] = (int)(ia * 128u + ib); LG[tl_ * 128 + h * 16 + i] = e[i] * inv; }
  }
  __syncthreads();
  for (int ti = 0; ti < 8; ++ti) {
    const int tl_ = w * 8 + ti; const int t = item * 32 + tl_;
    const float rs = row_rs16(p.ss_h2, t);
    f32x2 hn[8], hres[8];
    { const uint4 ha = *(const uint4*)(p.H2B + (size_t)t * 1024 + lane * 16), hb = *(const uint4*)(p.H2B + (size_t)t * 1024 + lane * 16 + 8);
      const unsigned hw[8] = {ha.x, ha.y, ha.z, ha.w, hb.x, hb.y, hb.z, hb.w};
#pragma unroll
      for (int i = 0; i < 8; ++i) { hres[i].x = __uint_as_float(hw[i] << 16); hres[i].y = __uint_as_float(hw[i] & 0xffff0000u);
        const float2 g = *(const float2*)(p.norm_peer_g + lane * 16 + 2 * i); hn[i].x = hres[i].x * rs * g.x; hn[i].y = hres[i].y * rs * g.y; } }
    f32x2 oa[8];
#pragma unroll
    for (int i = 0; i < 8; ++i) oa[i] = (f32x2){0.f, 0.f};
    for (int k = 0; k < 128; k += 4) {
      int e[4]; float gg[4], scu[4], scv[4]; uint4 uq[4], vq[4];
#pragma unroll
      for (int u = 0; u < 4; ++u) { e[u] = __builtin_amdgcn_readfirstlane(LE[tl_ * 128 + k + u]); gg[u] = LG[tl_ * 128 + k + u]; }
#pragma unroll
      for (int u = 0; u < 4; ++u) { uq[u] = *(const uint4*)(p.PU8 + (size_t)e[u] * 1024 + lane * 16); vq[u] = *(const uint4*)(p.PV8 + (size_t)e[u] * 1024 + lane * 16); scu[u] = p.su[e[u]]; scv[u] = p.sv[e[u]]; }
#pragma unroll
      for (int u = 0; u < 4; ++u) {
        f32x2 d2 = (f32x2){0.f, 0.f};
        d2 += __builtin_amdgcn_cvt_pk_f32_fp8((int)uq[u].x, false) * hn[0]; d2 += __builtin_amdgcn_cvt_pk_f32_fp8((int)uq[u].x, true) * hn[1];
        d2 += __builtin_amdgcn_cvt_pk_f32_fp8((int)uq[u].y, false) * hn[2]; d2 += __builtin_amdgcn_cvt_pk_f32_fp8((int)uq[u].y, true) * hn[3];
        d2 += __builtin_amdgcn_cvt_pk_f32_fp8((int)uq[u].z, false) * hn[4]; d2 += __builtin_amdgcn_cvt_pk_f32_fp8((int)uq[u].z, true) * hn[5];
        d2 += __builtin_amdgcn_cvt_pk_f32_fp8((int)uq[u].w, false) * hn[6]; d2 += __builtin_amdgcn_cvt_pk_f32_fp8((int)uq[u].w, true) * hn[7];
        float d = d2.x + d2.y;
#pragma unroll
        for (int o = 32; o > 0; o >>= 1) d += __shfl_xor(d, o);
        const float wgt = gg[u] * gelu_f(d * scu[u]) * scv[u];
        oa[0] += __builtin_amdgcn_cvt_pk_f32_fp8((int)vq[u].x, false) * wgt; oa[1] += __builtin_amdgcn_cvt_pk_f32_fp8((int)vq[u].x, true) * wgt;
        oa[2] += __builtin_amdgcn_cvt_pk_f32_fp8((int)vq[u].y, false) * wgt; oa[3] += __builtin_amdgcn_cvt_pk_f32_fp8((int)vq[u].y, true) * wgt;
        oa[4] += __builtin_amdgcn_cvt_pk_f32_fp8((int)vq[u].z, false) * wgt; oa[5] += __builtin_amdgcn_cvt_pk_f32_fp8((int)vq[u].z, true) * wgt;
        oa[6] += __builtin_amdgcn_cvt_pk_f32_fp8((int)vq[u].w, false) * wgt; oa[7] += __builtin_amdgcn_cvt_pk_f32_fp8((int)vq[u].w, true) * wgt;
      }
    }
    float* op = p.out + (size_t)t * 1024 + lane * 16;
#pragma unroll
    for (int i = 0; i < 4; ++i) { const f32x2 a = hres[2 * i] + oa[2 * i], b = hres[2 * i + 1] + oa[2 * i + 1]; *(float4*)(op + 4 * i) = make_float4(a.x, a.y, b.x, b.y); }
  }
}

template <int PH>
__device__ __forceinline__ void run_phase(const Params& p, char* lds, int bid, int nb) {
  if (PH == 0) {
    const int nt_in = 16 * 32, nt_glu = 8 * 8, nt_out = 16 * 16, nt_m = 16 * 16, nt_pq = 16 * 32;
    const int total = nt_in + nt_glu + nt_out + 4 * nt_m + nt_pq;
    for (int t = bid; t < total; t += nb) {
      int i = t; float* tl = (float*)lds;
      if (i < nt_in) { transpose_tile(p.w_in, p.WtIn, 1024, 2048, i, p.norm_mix_g, p.norm_mix_g, 1024, tl); continue; } i -= nt_in;
      if (i < nt_glu) { transpose_tile(p.w_glu, p.WtGlu, 512, 512, i, nullptr, nullptr, 0, tl); continue; } i -= nt_glu;
      if (i < nt_out) { transpose_tile(p.w_out, p.WtOut, 1024, 1024, i, p.att_out_g, p.ssm_out_g, 512, tl); continue; } i -= nt_out;
      if (i < nt_m) { transpose_tile(p.w_mem_q, p.WtMq, 1024, 1024, i, p.norm_mem_g, p.norm_mem_g, 1024, tl); continue; } i -= nt_m;
      if (i < nt_m) { transpose_tile(p.w_mem_k, p.WtMk, 1024, 1024, i, p.norm_memkv_g, p.norm_memkv_g, 1024, tl); continue; } i -= nt_m;
      if (i < nt_m) { transpose_tile(p.w_mem_v, p.WtMv, 1024, 1024, i, p.norm_memkv_g, p.norm_memkv_g, 1024, tl); continue; } i -= nt_m;
      if (i < nt_m) { transpose_tile(p.w_mem_o, p.WtMo, 1024, 1024, i, nullptr, nullptr, 0, tl); continue; } i -= nt_m;
      transpose_tile(p.w_peer_q, p.WtPq, 1024, 2048, i, p.norm_peer_g, p.norm_peer_g, 1024, tl);
    }
    convert_flat(p.peer_keys, p.PK, (size_t)16 * 128 * 128 / 8, bid, nb);
    rows_fp8(p.peer_u, p.PU8, p.su, 16384, bid, nb);
    rows_fp8(p.peer_v, p.PV8, p.sv, 16384, bid, nb);
    rows_bf16_rs(p.x, p.XB, p.rs_x, T_TOK, bid, nb);
    rows_bf16_rs(p.mem, p.MEMB, p.rs_mem, 512, bid, nb);
    for (int i = bid * NTHREADS + threadIdx.x; i < 2048; i += nb * NTHREADS) ssm_stage1(p, i);
  } else if (PH == 1) {
    for (int t = bid; t < 2048 + 64; t += nb) { if (t < 2048) tile_win(p, t, lds); else tile_memkv(p, t - 2048, lds); }
    ssm_stage2(p, bid, nb);
  } else if (PH == 2) {
    for (int t = bid; t < 2048; t += nb) chunk_attn_item(p, t, (float*)lds);
    for (int t = bid; t < 2048; t += nb) ssm_item<false>(p, t, lds);
    memk_fix(p, bid, nb);
  } else if (PH == 3) {
    for (int t = bid; t < 2048; t += nb) ssm_item<true>(p, t, lds);
  } else if (PH == 4) {
    for (int t = bid; t < 512; t += nb) tile_glu(p, t, lds);
  } else if (PH == 5) {
    for (int t = bid; t < 1024; t += nb) tile_wout(p, t, lds);
  } else if (PH == 6) {
    for (int t = bid; t < 1024; t += nb) tile_memq(p, t, lds);
  } else if (PH == 7) {
    for (int t = bid; t < 1024; t += nb) mem_attn_item(p, t);
  } else if (PH == 8) {
    for (int t = bid; t < 1024; t += nb) tile_memo(p, t, lds);
  } else if (PH == 9) {
    for (int t = bid; t < 2048; t += nb) tile_peerq(p, t, lds);
  } else if (PH == 10) {
    for (int t = bid; t < 2048; t += nb) tile_scores(p, t, lds);
  } else if (PH == 11) {
    for (int t = bid; t < 512; t += nb) peer_gather_item(p, t, lds);
  }
}

#if !MEGA
template <int PH>
__global__ void __launch_bounds__(NTHREADS, 2) phase_kernel(Params p) {
  extern __shared__ __attribute__((aligned(16))) char lds[];
  run_phase<PH>(p, lds, blockIdx.x, gridDim.x);
}

#endif
#ifndef REPEAT_PH
#define REPEAT_PH -1
#endif
#define RUNPH(k) do { run_phase<k>(p, lds, bid, nb); if (REPEAT_PH == k) { xcd_barrier(xb); run_phase<k>(p, lds, bid, nb); } } while (0)
__global__ void __launch_bounds__(NTHREADS, 2) mega_kernel(Params p) {
  extern __shared__ __attribute__((aligned(16))) char lds[];
  cg::grid_group grid = cg::this_grid();
  const int bid = blockIdx.x, nb = gridDim.x;
  volatile LAS unsigned* stw = (volatile LAS unsigned*)((LAS char*)lds + LDS_WORK);
  if (threadIdx.x == 0) { stw[0] = 0u; stw[1] = 0u; stw[2] = 0u; stw[3] = 0u; }
  __syncthreads();
  XcdBarrier xb = xcd_barrier_post(p.bar, stw);
  RUNPH(0); grid.sync();
  RUNPH(1); xcd_barrier(xb);
  RUNPH(2); xcd_barrier(xb);
  RUNPH(3); xcd_barrier(xb);
  RUNPH(4); xcd_barrier(xb);
  RUNPH(5); xcd_barrier(xb);
  RUNPH(6); xcd_barrier(xb);
  RUNPH(7); xcd_barrier(xb);
  RUNPH(8); xcd_barrier(xb);
  RUNPH(9); xcd_barrier(xb);
  RUNPH(10); xcd_barrier(xb);
  RUNPH(11);
}

#if !MEGA
template <int PH> static void launch_phase(const Params& p, int grid, hipStream_t s) {
  hipFuncSetAttribute((const void*)phase_kernel<PH>, hipFuncAttributeMaxDynamicSharedMemorySize, LDS_BYTES);
  phase_kernel<PH><<<grid, NTHREADS, LDS_BYTES, s>>>(p);
}
#endif

extern "C" void kernel_launch(void* const* d_in, const int* in_sizes, int n_in, void* d_out, int out_size, void* d_ws, size_t ws_size, hipStream_t stream) {
  Params p{};
  const float** f = (const float**)&p;
  for (int i = 0; i < 33; ++i) f[i] = (const float*)d_in[i];
  p.out = (float*)d_out;
  char* ws = (char*)d_ws; size_t off = 0;
  auto take = [&](size_t bytes) { char* r = ws + off; off += (bytes + 255) & ~(size_t)255; return r; };
  const size_t MB = 1u << 20;
  p.bar = (unsigned*)take(16384);
  p.WtIn = (bf16_t*)take(4 * MB); p.WtGlu = (bf16_t*)take(MB / 2); p.WtOut = (bf16_t*)take(2 * MB);
  p.WtMq = (bf16_t*)take(2 * MB); p.WtMk = (bf16_t*)take(2 * MB); p.WtMv = (bf16_t*)take(2 * MB); p.WtMo = (bf16_t*)take(2 * MB); p.WtPq = (bf16_t*)take(4 * MB);
  p.PK = (bf16_t*)take(MB / 2); p.PU8 = (unsigned char*)take(16 * MB); p.PV8 = (unsigned char*)take(16 * MB); p.su = (float*)take(16384 * 4); p.sv = (float*)take(16384 * 4);
  char* RA = take(64 * MB); char* RB = take(64 * MB);
  p.XB = (bf16_t*)RA; p.ATT = (bf16_t*)RA; p.YG = (bf16_t*)(RA + 16 * MB); p.QM = (bf16_t*)RA; p.H2B = (bf16_t*)RA;
  p.SSMO = (bf16_t*)(RA + 32 * MB); p.OM = (bf16_t*)(RA + 32 * MB);
  p.Qb = (bf16_t*)RB; p.Kb = (bf16_t*)(RB + 16 * MB); p.VT = (bf16_t*)(RB + 32 * MB); p.Ub = (bf16_t*)(RB + 48 * MB); p.H1B = (bf16_t*)RB; p.QP = (bf16_t*)RB;
  p.TOPS = (unsigned*)take(16 * MB);
  p.MEMB = (bf16_t*)take(MB); p.KMB = (bf16_t*)take(MB); p.VMT = (bf16_t*)take(MB); p.KMraw = (float*)take(2 * MB);
  p.WE16 = (bf16_t*)take(2 * MB); p.WY = (bf16_t*)take(6 * MB);
  p.rs_x = (float*)take(T_TOK * 4); p.rs_mem = (float*)take(512 * 4); p.ss_att = (float*)take(T_TOK * 8 * 4); p.ss_ssm = (float*)take(T_TOK * 8 * 4);
  p.ss_h1 = (float*)take(T_TOK * 16 * 4); p.ss_qm = (float*)take(T_TOK * 16 * 4); p.ss_km = (float*)take(512 * 16 * 4); p.ss_h2 = (float*)take(T_TOK * 16 * 4);
  p.ESEG = (float*)take(2 * 32 * 32 * 128 * 4);
  p.BBR = (float*)take(2048 * 16 * 4); p.BBI = (float*)take(2048 * 16 * 4); p.PWR = (float*)take(32 * 17 * 64 * 4); p.PWI = (float*)take(32 * 17 * 64 * 4); p.APW = (float*)take(5 * 4096 * 4);
  if (off > ws_size) { fprintf(stderr, "workspace too small: need %zu have %zu\n", off, ws_size); return; }
#if MEGA
  hipMemsetAsync(p.bar, 0, 16384, stream);
  static int grid_blocks = 0;
  if (!grid_blocks) {
    int dev = 0, cus = 0, per_cu = 0; hipGetDevice(&dev); hipDeviceGetAttribute(&cus, hipDeviceAttributeMultiprocessorCount, dev);
    hipFuncSetAttribute((const void*)mega_kernel, hipFuncAttributeMaxDynamicSharedMemorySize, LDS_BYTES);
    hipOccupancyMaxActiveBlocksPerMultiprocessor(&per_cu, mega_kernel, NTHREADS, LDS_BYTES);
    if (per_cu > 2) per_cu = 2; if (per_cu < 1) per_cu = 1;
    grid_blocks = cus * per_cu;
  }
  void* args[] = {&p};
  hipError_t e = hipLaunchCooperativeKernel((void*)mega_kernel, dim3(grid_blocks), dim3(NTHREADS), args, LDS_BYTES, stream);
  if (e != hipSuccess) fprintf(stderr, "cooperative launch failed: %s (grid %d)\n", hipGetErrorString(e), grid_blocks);
#else
  const int G = 1024;
  launch_phase<0>(p, G, stream); launch_phase<1>(p, G, stream); launch_phase<2>(p, G, stream); launch_phase<3>(p, G, stream);
  launch_phase<4>(p, G, stream); launch_phase<5>(p, G, stream); launch_phase<6>(p, G, stream); launch_phase<7>(p, G, stream);
  launch_phase<8>(p, G, stream); launch_phase<9>(p, G, stream); launch_phase<10>(p, G, stream); launch_phase<11>(p, G, stream);
#endif
}
```

```cpp
#include <hip/hip_runtime.h>
#include <hip/hip_cooperative_groups.h>
#include <cstdio>
#include <cstdint>
namespace cg = cooperative_groups;

#ifndef MEGA
#define MEGA 1
#endif

typedef unsigned short bf16_t;
typedef short bf16x8 __attribute__((ext_vector_type(8)));
typedef float f32x4 __attribute__((ext_vector_type(4)));
typedef unsigned u32x4 __attribute__((ext_vector_type(4)));
#define LAS __attribute__((address_space(3)))
__device__ __forceinline__ bf16x8 as_bf(u32x4 v) { return __builtin_bit_cast(bf16x8, v); }

#define T_TOK 16384
#define SEQL 8192
#define NTHREADS 256
#define LDS_WORK 66560
#define LDS_BYTES (LDS_WORK + 16)
#define EPSF 1e-6f

__device__ __forceinline__ unsigned short f2bf(float f) { unsigned u = __float_as_uint(f); u += 0x7fffu + ((u >> 16) & 1u); return (unsigned short)(u >> 16); }
__device__ __forceinline__ float bf2f(unsigned short b) { return __uint_as_float(((unsigned)b) << 16); }
__device__ __forceinline__ unsigned pack2(float lo, float hi) { return (unsigned)f2bf(lo) | ((unsigned)f2bf(hi) << 16); }
__device__ __forceinline__ float gelu_f(float v) {
  const float av = fabsf(v), t = __builtin_amdgcn_rcpf(av * 0.2316418882f + 1.0f);
  float q = t * 0.5307027145f + (-0.7265760135f); q = q * t + 0.7107068705f; q = q * t + (-0.142248368f); q = q * t + 0.127414796f; q = q * t;
  const float e = __builtin_amdgcn_exp2f((v * v) * (-0.72134752044f)); const float m = v * (q * e);
  return v < 0.f ? m : v - m; }
typedef float f32x2 __attribute__((ext_vector_type(2)));
__device__ __forceinline__ f32x4 mfma16(bf16x8 a, bf16x8 b, f32x4 c) { return __builtin_amdgcn_mfma_f32_16x16x32_bf16(a, b, c, 0, 0, 0); }


#define XB_TMO      128
#define XB_XCNT(j)  (256  + 64 * (j))
#define XB_XSUB(j)  (1280 + 64 * (j))
#define XB_XGEN(j)  (2304 + 64 * (j))
#define XB_TOP      3328
#define XB_TOPGEN   3392
#define XCD_BAR_WORDS 3456
#define XB_SPIN_CAP (1u << 18)
__device__ __forceinline__ unsigned xb_ld(unsigned* p)              { return __hip_atomic_load(p, __ATOMIC_RELAXED, __HIP_MEMORY_SCOPE_AGENT); }
__device__ __forceinline__ unsigned xb_add(unsigned* p, unsigned v) { return __hip_atomic_fetch_add(p, v, __ATOMIC_RELAXED, __HIP_MEMORY_SCOPE_AGENT); }
__device__ __forceinline__ unsigned xb_xcc_id() { return (unsigned)__builtin_amdgcn_s_getreg((3 << 11) | 20) & 0xFu; }
#define XB_SPIN(cond, bar) do { unsigned _sp = 0; while (cond) { __builtin_amdgcn_s_sleep(1); \
    if ((++_sp & 255u) == 0u) { if (xb_ld(&(bar)[XB_TMO])) break; if (_sp > XB_SPIN_CAP) { atomicAdd(&(bar)[XB_TMO], 1u); break; } } } } while (0)
struct XcdBarrier { unsigned* bar; unsigned x; volatile LAS unsigned* st; };
__device__ __forceinline__ XcdBarrier xcd_barrier_post(unsigned* bar, volatile LAS unsigned* st) {
  XcdBarrier b; b.bar = bar; b.x = xb_xcc_id(); b.st = st;
  if (threadIdx.x == 0) (void)xb_add(&bar[XB_XCNT(b.x)], 1u);
  return b;
}
__device__ __forceinline__ void xcd_barrier_complete(unsigned* bar, unsigned x, unsigned& nloc, unsigned& nx) {
  const unsigned G = gridDim.x * gridDim.y * gridDim.z;
  unsigned sum, cnt, mine, sp = 0u;
  for (;;) {
    sum = 0u; cnt = 0u; mine = 0u;
#pragma unroll
    for (unsigned j = 0; j < 16; ++j) { const unsigned c = xb_ld(&bar[XB_XCNT(j)]); sum += c; cnt += (c > 0u) ? 1u : 0u; mine = (j == x) ? c : mine; }
    if (sum == G) break;
    __builtin_amdgcn_s_sleep(1);
    if ((++sp & 255u) == 0u) { if (xb_ld(&bar[XB_TMO])) break; if (sp > XB_SPIN_CAP) { atomicAdd(&bar[XB_TMO], 1u); break; } }
  }
  nloc = mine > 0u ? mine : 1u; nx = cnt > 0u ? cnt : 1u;
}
__device__ __forceinline__ void xcd_barrier(const XcdBarrier& b) {
  asm volatile("s_waitcnt vmcnt(0)" ::: "memory");
  __syncthreads();
  if (threadIdx.x == 0) {
    unsigned* bar = b.bar;
    __builtin_amdgcn_s_waitcnt(0);
    unsigned nloc = b.st[0], nx = b.st[1];
    if (nloc == 0u) { xcd_barrier_complete(bar, b.x, nloc, nx); b.st[0] = nloc; b.st[1] = nx; }
    const unsigned old = xb_add(&bar[XB_XSUB(b.x)], 1u);
    const unsigned gen = old / nloc;
    if (old + 1u == (gen + 1u) * nloc) {
      __builtin_amdgcn_fence(__ATOMIC_RELEASE, "agent");
      asm volatile("s_waitcnt vmcnt(0)" ::: "memory");
      const unsigned og = xb_add(&bar[XB_TOP], 1u);
      const unsigned tg = og / nx;
      if (og + 1u == (tg + 1u) * nx) xb_add(&bar[XB_TOPGEN], 1u);
      else XB_SPIN(xb_ld(&bar[XB_TOPGEN]) == tg, bar);
      __builtin_amdgcn_fence(__ATOMIC_ACQUIRE, "agent");
      xb_add(&bar[XB_XGEN(b.x)], 1u);
      asm volatile("s_waitcnt vmcnt(0)" ::: "memory");
    } else {
      XB_SPIN(xb_ld(&bar[XB_XGEN(b.x)]) == gen, bar);
      __builtin_amdgcn_fence(__ATOMIC_ACQUIRE, "agent");
      asm volatile("s_waitcnt vmcnt(0)" ::: "memory");
    }
  }
  __syncthreads();
}

struct Params {
  const float *x, *mem, *norm_mix_g, *w_in, *att_q_g, *att_k_g, *rel_bias;
  const float *lam_re, *lam_im, *log_step, *b_re, *b_im, *c_re, *c_im, *d_skip, *w_glu, *b_glu;
  const float *att_out_g, *ssm_out_g, *w_out, *norm_mem_g, *norm_memkv_g, *w_mem_q, *w_mem_k, *w_mem_v;
  const float *mem_q_g, *mem_k_g, *w_mem_o, *norm_peer_g, *w_peer_q, *peer_keys, *peer_u, *peer_v;
  float* out;
  unsigned* bar;
  bf16_t *WtIn, *WtGlu, *WtOut, *WtMq, *WtMk, *WtMv, *WtMo, *WtPq, *PK, *PU, *PV;
  bf16_t *XB, *MEMB, *Qb, *Kb, *VT, *Ub, *ATT, *YG, *SSMO, *H1B, *QM, *OM, *H2B, *QP;
  bf16_t *KMB, *VMT, *WE16, *WY;
  float *rs_x, *rs_mem, *ss_att, *ss_ssm, *ss_h1, *ss_qm, *ss_km, *ss_h2, *KMraw, *ESEG;
  float *BBR, *BBI, *PWR, *PWI, *APW;
  unsigned* TOPS;
  unsigned char *PU8, *PV8; float *su, *sv;
};

template <bool ASC, bool ZERO = true>
__device__ __forceinline__ void gemm_mainloop(f32x4 (&acc)[4][4], const bf16_t* __restrict__ A, int lda, const bf16_t* __restrict__ Bt, int ldb, int K,
                                              int row0, int col0, char* lds_, const float* s0, const float* s1, int ksplit) {
  LAS char* lds = (LAS char*)lds_;
  const int tid = threadIdx.x, lane = tid & 63, w = tid >> 6, wr = w >> 1, wc = w & 1, fr = lane & 15, fq = lane >> 4;
  if (ZERO) {
#pragma unroll
    for (int m = 0; m < 4; ++m)
#pragma unroll
      for (int n = 0; n < 4; ++n) acc[m][n] = (f32x4){0.f, 0.f, 0.f, 0.f};
  }
  const int sr = tid >> 3, skc = tid & 7;
  const bf16_t* gA = A + (size_t)(row0 + sr) * lda + skc * 8;
  const bf16_t* gB = Bt + (size_t)(col0 + sr) * ldb + skc * 8;
  const int soff = sr * 128 + ((skc ^ (sr & 7)) << 4);
  u32x4 ra[4], rb[4];
  const int nk = K >> 6;
#pragma unroll
  for (int i = 0; i < 4; ++i) { ra[i] = *(const u32x4*)(gA + (size_t)(32 * i) * lda); rb[i] = *(const u32x4*)(gB + (size_t)(32 * i) * ldb); }
  __syncthreads();
  {
#pragma unroll
    for (int i = 0; i < 4; ++i) {
      u32x4 va = ra[i];
      if (ASC) { const float s = (0 < ksplit) ? s0[i] : s1[i];
        va.x = pack2(__uint_as_float(va.x << 16) * s, __uint_as_float(va.x & 0xffff0000u) * s); va.y = pack2(__uint_as_float(va.y << 16) * s, __uint_as_float(va.y & 0xffff0000u) * s);
        va.z = pack2(__uint_as_float(va.z << 16) * s, __uint_as_float(va.z & 0xffff0000u) * s); va.w = pack2(__uint_as_float(va.w << 16) * s, __uint_as_float(va.w & 0xffff0000u) * s); }
      *(LAS u32x4*)(lds + soff + i * 4096) = va; *(LAS u32x4*)(lds + 16384 + soff + i * 4096) = rb[i];
    }
  }
  __syncthreads();
  for (int kt = 0; kt < nk; ++kt) {
    LAS char* cur = lds + (kt & 1) * 32768; LAS char* nxt = lds + ((kt + 1) & 1) * 32768;
    const bool more = (kt + 1 < nk);
    if (more) {
      const int k1 = (kt + 1) << 6;
#pragma unroll
      for (int i = 0; i < 4; ++i) { ra[i] = *(const u32x4*)(gA + (size_t)(32 * i) * lda + k1); rb[i] = *(const u32x4*)(gB + (size_t)(32 * i) * ldb + k1); }
    }
#pragma unroll
    for (int ks = 0; ks < 2; ++ks) {
      bf16x8 af[4], bfr[4];
      const int kc = ks * 4 + fq;
#pragma unroll
      for (int m = 0; m < 4; ++m) { const int r = wr * 64 + m * 16 + fr; af[m] = as_bf(*(const LAS u32x4*)(cur + r * 128 + ((kc ^ (r & 7)) << 4))); }
#pragma unroll
      for (int n = 0; n < 4; ++n) { const int r = wc * 64 + n * 16 + fr; bfr[n] = as_bf(*(const LAS u32x4*)(cur + 16384 + r * 128 + ((kc ^ (r & 7)) << 4))); }
#pragma unroll
      for (int m = 0; m < 4; ++m)
#pragma unroll
        for (int n = 0; n < 4; ++n) acc[m][n] = mfma16(bfr[n], af[m], acc[m][n]);
    }
    if (more) {
      const int k1 = (kt + 1) << 6;
#pragma unroll
      for (int i = 0; i < 4; ++i) {
        u32x4 va = ra[i];
        if (ASC) { const float s = (k1 < ksplit) ? s0[i] : s1[i];
          va.x = pack2(__uint_as_float(va.x << 16) * s, __uint_as_float(va.x & 0xffff0000u) * s); va.y = pack2(__uint_as_float(va.y << 16) * s, __uint_as_float(va.y & 0xffff0000u) * s);
          va.z = pack2(__uint_as_float(va.z << 16) * s, __uint_as_float(va.z & 0xffff0000u) * s); va.w = pack2(__uint_as_float(va.w << 16) * s, __uint_as_float(va.w & 0xffff0000u) * s); }
        *(LAS u32x4*)(nxt + soff + i * 4096) = va; *(LAS u32x4*)(nxt + 16384 + soff + i * 4096) = rb[i];
      }
    }
    __syncthreads();
  }
}

__device__ void transpose_tile(const float* __restrict__ src, bf16_t* __restrict__ dst, int K, int N, int tile, const float* g0, const float* g1, int split, float* tl  ) {
  const int ntn = N >> 6; const int tk = tile / ntn, tn = tile % ntn; const int k0 = tk << 6, n0 = tn << 6; const int tid = threadIdx.x;
  __syncthreads();
#pragma unroll 4
  for (int i = 0; i < 16; ++i) { const int kk = i * 4 + (tid >> 6), nn = tid & 63; const int k = k0 + kk;
    float g = 1.f; if (g0) g = (k < split) ? g0[k] : g1[k - split];
    tl[kk * 65 + nn] = src[(size_t)k * N + n0 + nn] * g; }
  __syncthreads();
  const int n = tid >> 2, kq = (tid & 3) * 16;
  unsigned o[8];
#pragma unroll
  for (int j = 0; j < 8; ++j) o[j] = pack2(tl[(kq + 2 * j) * 65 + n], tl[(kq + 2 * j + 1) * 65 + n]);
  uint4* d = (uint4*)(dst + (size_t)(n0 + n) * K + k0 + kq);
  d[0] = make_uint4(o[0], o[1], o[2], o[3]); d[1] = make_uint4(o[4], o[5], o[6], o[7]);
}

__device__ void convert_flat(const float* __restrict__ src, bf16_t* __restrict__ dst, size_t n8  , int bid, int nb) {
  for (size_t i = (size_t)bid * NTHREADS + threadIdx.x; i < n8; i += (size_t)nb * NTHREADS) {
    const float4 a = ((const float4*)src)[2 * i], b = ((const float4*)src)[2 * i + 1];
    ((uint4*)dst)[i] = make_uint4(pack2(a.x, a.y), pack2(a.z, a.w), pack2(b.x, b.y), pack2(b.z, b.w));
  }
}
__device__ void rows_bf16_rs(const float* __restrict__ src, bf16_t* __restrict__ dst, float* __restrict__ rs, int nrows, int bid, int nb) {
  const int lane = threadIdx.x & 63, w = threadIdx.x >> 6;
  for (int row = bid * 4 + w; row < nrows; row += nb * 4) {
    const float4* s = (const float4*)(src + (size_t)row * 1024);
    float ss = 0.f; uint2* d = (uint2*)(dst + (size_t)row * 1024);
#pragma unroll
    for (int i = 0; i < 4; ++i) { const float4 v = s[i * 64 + lane]; ss += v.x * v.x + v.y * v.y + v.z * v.z + v.w * v.w; d[i * 64 + lane] = make_uint2(pack2(v.x, v.y), pack2(v.z, v.w)); }
#pragma unroll
    for (int o = 32; o > 0; o >>= 1) ss += __shfl_xor(ss, o);
    if (lane == 0) rs[row] = rsqrtf(ss * (1.0f / 1024.0f) + EPSF);
  }
}

__device__ void rows_fp8(const float* __restrict__ src, unsigned char* __restrict__ dst, float* __restrict__ sc, int nrows, int bid, int nb) {
  const int lane = threadIdx.x & 63, w = threadIdx.x >> 6;
  for (int row = bid * 4 + w; row < nrows; row += nb * 4) {
    const float4* s = (const float4*)(src + (size_t)row * 1024);
    float4 v[4]; float am = 0.f;
#pragma unroll
    for (int i = 0; i < 4; ++i) { v[i] = s[i * 64 + lane]; am = fmaxf(am, fmaxf(fmaxf(fabsf(v[i].x), fabsf(v[i].y)), fmaxf(fabsf(v[i].z), fabsf(v[i].w)))); }
#pragma unroll
    for (int o = 32; o > 0; o >>= 1) am = fmaxf(am, __shfl_xor(am, o));
    const float q = (am > 0.f) ? 224.0f / am : 1.0f;
    unsigned* d = (unsigned*)(dst + (size_t)row * 1024);
#pragma unroll
    for (int i = 0; i < 4; ++i) { int wd = 0; wd = __builtin_amdgcn_cvt_pk_fp8_f32(v[i].x * q, v[i].y * q, wd, false); wd = __builtin_amdgcn_cvt_pk_fp8_f32(v[i].z * q, v[i].w * q, wd, true); d[i * 64 + lane] = (unsigned)wd; }
    if (lane == 0) sc[row] = (am > 0.f) ? am * (1.0f / 224.0f) : 1.0f;
  }
}

__device__ void ssm_stage1(const Params& p, int gp) {
  const int g = gp >> 6;
  const float step = expf(p.log_step[g]); const float lr = p.lam_re[gp], li = p.lam_im[gp];
  const float mag = expf(lr * step); const float ar = mag * cosf(li * step), ai = mag * sinf(li * step);
  const float zr = ar - 1.0f, den = lr * lr + li * li; const float fr = (zr * lr + ai * li) / den, fi = (ai * lr - zr * li) / den;
  for (int c = 0; c < 16; ++c) { const float br = p.b_re[gp * 16 + c], bi = p.b_im[gp * 16 + c]; p.BBR[gp * 16 + c] = fr * br - fi * bi; p.BBI[gp * 16 + c] = fr * bi + fi * br; }
  float pr = 1.f, pi = 0.f; const int st = gp & 63;
  for (int j = 0; j <= 16; ++j) { p.PWR[(g * 17 + j) * 64 + st] = pr; p.PWI[(g * 17 + j) * 64 + st] = pi; const float nr = pr * ar - pi * ai, ni = pr * ai + pi * ar; if (j < 16) { pr = nr; pi = ni; } }
  const float a16r = pr, a16i = pi; const float a32r = a16r * a16r - a16i * a16i, a32i = 2.f * a16r * a16i;
  const float a48r = a32r * a16r - a32i * a16i, a48i = a32r * a16i + a32i * a16r; const float a64r = a32r * a32r - a32i * a32i, a64i = 2.f * a32r * a32i;
  const float a128r = a64r * a64r - a64i * a64i, a128i = 2.f * a64r * a64i; const float a256r = a128r * a128r - a128i * a128i, a256i = 2.f * a128r * a128i;
  float* A = p.APW;
  A[0 * 4096 + gp] = a16r; A[0 * 4096 + 2048 + gp] = a16i; A[1 * 4096 + gp] = a32r; A[1 * 4096 + 2048 + gp] = a32i; A[2 * 4096 + gp] = a48r; A[2 * 4096 + 2048 + gp] = a48i;
  A[3 * 4096 + gp] = a64r; A[3 * 4096 + 2048 + gp] = a64i; A[4 * 4096 + gp] = a256r; A[4 * 4096 + 2048 + gp] = a256i;
}
__device__ void ssm_stage2(const Params& p, int bid, int nb) {
  const int total1 = 32 * 128 * 256, total2 = 32 * 256 * 384;
  for (int i = bid * NTHREADS + threadIdx.x; i < total1 + total2; i += nb * NTHREADS) {
    if (i < total1) {
      const int k = i & 255, sr = (i >> 8) & 127, g = i >> 15; const int st = ((sr >> 5) << 4) | (sr & 15), ri = (sr >> 4) & 1; const int s = k >> 4, ch = k & 15;
      const int gp = g * 64 + st; const float pr = p.PWR[(g * 17 + 15 - s) * 64 + st], pi = p.PWI[(g * 17 + 15 - s) * 64 + st]; const float br = p.BBR[gp * 16 + ch], bi = p.BBI[gp * 16 + ch];
      p.WE16[i] = f2bf(ri == 0 ? (pr * br - pi * bi) : (pr * bi + pi * br));
    } else {
      const int e = i - total1; const int k = e % 384, r = (e / 384) & 255, g = e / (384 * 256); const int t = r >> 4, co = r & 15; float val;
      if (k < 128) { const int st = ((k >> 5) << 4) | (k & 15), ri = (k >> 4) & 1; const float cr = p.c_re[(g * 16 + co) * 64 + st], ci = p.c_im[(g * 16 + co) * 64 + st];
        const float pr = p.PWR[(g * 17 + t + 1) * 64 + st], pi = p.PWI[(g * 17 + t + 1) * 64 + st]; val = (ri == 0) ? (cr * pr - ci * pi) : -(cr * pi + ci * pr); }
      else { const int kk = k - 128, s = kk >> 4, cin = kk & 15; val = 0.f;
        if (s <= t) { const int j = t - s; float acc = 0.f;
          for (int st = 0; st < 64; ++st) { const float cr = p.c_re[(g * 16 + co) * 64 + st], ci = p.c_im[(g * 16 + co) * 64 + st]; const float pr = p.PWR[(g * 17 + j) * 64 + st], pi = p.PWI[(g * 17 + j) * 64 + st];
            const float br = p.BBR[(g * 64 + st) * 16 + cin], bi = p.BBI[(g * 64 + st) * 16 + cin]; acc += cr * (pr * br - pi * bi) - ci * (pr * bi + pi * br); }
          val = acc; } }
      p.WY[e] = f2bf(val);
    }
  }
}

#define EPI_IDS const int tid = threadIdx.x, lane = tid & 63, w = tid >> 6, wr = w >> 1, wc = w & 1, fr = lane & 15, fq = lane >> 4; (void)wr; (void)wc; (void)fr; (void)fq;

__device__ void tile_win(const Params& p, int tile, char* lds) {
  const int rt = tile >> 4, ct = tile & 15; const int row0 = rt * 128, col0 = ct * 128;
  f32x4 acc[4][4];
  gemm_mainloop<false>(acc, p.XB, 1024, p.WtIn, 1024, 1024, row0, col0, lds, nullptr, nullptr, 0);
  EPI_IDS
  const int cw = col0 + wc * 64;
#pragma unroll
  for (int m = 0; m < 4; ++m) {
    const int row = row0 + wr * 64 + m * 16 + fr; const float rsx = p.rs_x[row];
    if (cw < 1024) {
      float ss = 0.f;
#pragma unroll
      for (int n = 0; n < 4; ++n)
#pragma unroll
        for (int j = 0; j < 4; ++j) { const float v = acc[m][n][j] * rsx; acc[m][n][j] = v; ss += v * v; }
      ss += __shfl_xor(ss, 16); ss += __shfl_xor(ss, 32);
      const float rs = rsqrtf(ss * (1.0f / 64.0f) + EPSF) * (cw < 512 ? 0.125f : 1.0f);
      const float* g = (cw < 512) ? p.att_q_g : p.att_k_g; bf16_t* dst = (cw < 512 ? p.Qb : p.Kb) + (size_t)row * 512 + (cw & 511);
#pragma unroll
      for (int n = 0; n < 4; ++n) { const int c = n * 16 + fq * 4; const float4 gg = *(const float4*)(g + c);
        *(uint2*)(dst + c) = make_uint2(pack2(acc[m][n][0] * rs * gg.x, acc[m][n][1] * rs * gg.y), pack2(acc[m][n][2] * rs * gg.z, acc[m][n][3] * rs * gg.w)); }
    } else if (cw < 1536) {
      const int head = (cw - 1024) >> 6; const int b = row >> 13, tb = row & 8191;
      bf16_t* dst = p.VT + ((size_t)(b * 8 + head) * 64) * SEQL + tb;
#pragma unroll
      for (int n = 0; n < 4; ++n)
#pragma unroll
        for (int j = 0; j < 4; ++j) dst[(size_t)(n * 16 + fq * 4 + j) * SEQL] = f2bf(acc[m][n][j] * rsx);
    } else {
      bf16_t* dst = p.Ub + (size_t)row * 512 + (cw - 1536);
#pragma unroll
      for (int n = 0; n < 4; ++n) { const int c = n * 16 + fq * 4;
        *(uint2*)(dst + c) = make_uint2(pack2(acc[m][n][0] * rsx, acc[m][n][1] * rsx), pack2(acc[m][n][2] * rsx, acc[m][n][3] * rsx)); }
    }
  }
}
__device__ void tile_memkv(const Params& p, int tile, char* lds) {
  const int which = tile >> 5, t2 = tile & 31; const int rt = t2 >> 3, ct = t2 & 7; const int row0 = rt * 128, col0 = ct * 128;
  f32x4 acc[4][4];
  gemm_mainloop<false>(acc, p.MEMB, 1024, which ? p.WtMv : p.WtMk, 1024, 1024, row0, col0, lds, nullptr, nullptr, 0);
  EPI_IDS
  const int cw = col0 + wc * 64;
#pragma unroll
  for (int m = 0; m < 4; ++m) {
    const int row = row0 + wr * 64 + m * 16 + fr; const float rsm = p.rs_mem[row];
    if (which == 0) {
      float ss = 0.f;
#pragma unroll
      for (int n = 0; n < 4; ++n) { f32x4 v = acc[m][n] * rsm; ss += v[0] * v[0] + v[1] * v[1] + v[2] * v[2] + v[3] * v[3]; *(f32x4*)(p.KMraw + (size_t)row * 1024 + cw + n * 16 + fq * 4) = v; }
      ss += __shfl_xor(ss, 16); ss += __shfl_xor(ss, 32);
      if (fq == 0) p.ss_km[row * 16 + (cw >> 6)] = ss;
    } else {
      const int b = row >> 8, key = row & 255; const int head = cw >> 8; const int d0 = (cw & 255);
      bf16_t* dst = p.VMT + ((size_t)(b * 4 + head) * 256) * 256 + key;
#pragma unroll
      for (int n = 0; n < 4; ++n)
#pragma unroll
        for (int j = 0; j < 4; ++j) dst[(size_t)(d0 + n * 16 + fq * 4 + j) * 256] = f2bf(acc[m][n][j] * rsm);
    }
  }
}
__device__ void memk_fix(const Params& p, int bid, int nb) {
  for (int i = bid * NTHREADS + threadIdx.x; i < 512 * 1024 / 4; i += nb * NTHREADS) {
    const int row = i >> 8, c4 = (i & 255) * 4; const int head = c4 >> 8, d = c4 & 255;
    const float ss = p.ss_km[row * 16 + head * 4] + p.ss_km[row * 16 + head * 4 + 1] + p.ss_km[row * 16 + head * 4 + 2] + p.ss_km[row * 16 + head * 4 + 3];
    const float rs = rsqrtf(ss * (1.0f / 256.0f) + EPSF);
    const float4 v = *(const float4*)(p.KMraw + (size_t)row * 1024 + c4); const float4 gk = *(const float4*)(p.mem_k_g + d), gq = *(const float4*)(p.mem_q_g + d);
    const int b = row >> 8, key = row & 255;
    *(uint2*)(p.KMB + ((size_t)(b * 4 + head) * 256 + key) * 256 + d) = make_uint2(pack2(v.x * rs * gk.x * gq.x, v.y * rs * gk.y * gq.y), pack2(v.z * rs * gk.z * gq.z, v.w * rs * gk.w * gq.w));
  }
}

__device__ void chunk_attn_item(const Params& p, int item, char* lds_) {
  LAS char* lds = (LAS char*)lds_; LAS float* rb = (LAS float*)(lds + 32768);
  typedef unsigned u32x2 __attribute__((ext_vector_type(2)));
  const int h = item & 7, cn = (item >> 3) & 127, b = item >> 10;
  const int tid = threadIdx.x, lane = tid & 63, w = tid >> 6, fr = lane & 15, fq = lane >> 4;
  const int iq = w * 16 + fr; const int tq = b * SEQL + cn * 64 + iq;
  const int cstart = (cn >= 8) ? 0 : (8 - cn);
  const bf16_t* vtb = p.VT + ((size_t)(b * 8 + h) * 64) * SEQL;
  const int r0 = tid >> 3, ch = tid & 7;
  u32x4 kr[2], vr[2];
  { const int kc0 = (cn - 8 + cstart) * 64;
#pragma unroll
    for (int i = 0; i < 2; ++i) { kr[i] = *(const u32x4*)(p.Kb + (size_t)(b * SEQL + kc0 + r0 + 32 * i) * 512 + h * 64 + ch * 8); vr[i] = *(const u32x4*)(vtb + (size_t)(r0 + 32 * i) * SEQL + kc0 + ch * 8); } }
  bf16x8 qf[2];
  qf[0] = *(const bf16x8*)(p.Qb + (size_t)tq * 512 + h * 64 + fq * 8); qf[1] = *(const bf16x8*)(p.Qb + (size_t)tq * 512 + h * 64 + 32 + fq * 8);
  __syncthreads();
  if (tid < 192) rb[tid] = p.rel_bias[h * 192 + tid];
#pragma unroll
  for (int i = 0; i < 2; ++i) { const int r = r0 + 32 * i; *(LAS u32x4*)(lds + r * 128 + ((ch ^ (r & 7)) << 4)) = kr[i]; *(LAS u32x4*)(lds + 8192 + r * 128 + ((ch ^ ((r >> 1) & 7)) << 4)) = vr[i]; }
  __syncthreads();
  f32x4 o[4]; for (int i = 0; i < 4; ++i) o[i] = (f32x4){0.f, 0.f, 0.f, 0.f};
  float mrun = -1e30f, lrun = 0.f;
  for (int c = cstart; c <= 8; ++c) {
    LAS char* cur = lds + ((c - cstart) & 1) * 16384; LAS char* nxt = lds + ((c - cstart + 1) & 1) * 16384;
    const bool more = c < 8;
    if (more) { const int kc1 = (cn - 8 + c + 1) * 64;
#pragma unroll
      for (int i = 0; i < 2; ++i) { kr[i] = *(const u32x4*)(p.Kb + (size_t)(b * SEQL + kc1 + r0 + 32 * i) * 512 + h * 64 + ch * 8); vr[i] = *(const u32x4*)(vtb + (size_t)(r0 + 32 * i) * SEQL + kc1 + ch * 8); } }
    f32x4 st[4];
#pragma unroll
    for (int mt = 0; mt < 4; ++mt) { const int row = mt * 16 + fr; f32x4 sacc = (f32x4){0.f, 0.f, 0.f, 0.f};
      sacc = mfma16(as_bf(*(const LAS u32x4*)(cur + row * 128 + ((fq ^ (row & 7)) << 4))), qf[0], sacc);
      sacc = mfma16(as_bf(*(const LAS u32x4*)(cur + row * 128 + (((4 + fq) ^ (row & 7)) << 4))), qf[1], sacc); st[mt] = sacc; }
    float tmax = -1e30f;
#pragma unroll
    for (int mt = 0; mt < 4; ++mt)
#pragma unroll
      for (int j = 0; j < 4; ++j) { const int jk = mt * 16 + fq * 4 + j; int dist = 512 - 64 * c + iq - jk; dist = dist < -63 ? -63 : (dist > 128 ? 128 : dist);
        const float sv = st[mt][j] + rb[dist + 63]; st[mt][j] = sv; tmax = fmaxf(tmax, sv); }
    tmax = fmaxf(tmax, __shfl_xor(tmax, 16)); tmax = fmaxf(tmax, __shfl_xor(tmax, 32));
    const float mnew = fmaxf(mrun, tmax); const float alpha = __expf(mrun - mnew); mrun = mnew;
    float ls = 0.f;
#pragma unroll
    for (int mt = 0; mt < 4; ++mt)
#pragma unroll
      for (int j = 0; j < 4; ++j) { const float pv = __expf(st[mt][j] - mnew); st[mt][j] = pv; ls += pv; }
    lrun = lrun * alpha + ls;
    bf16x8 pf[2];
#pragma unroll
    for (int s2 = 0; s2 < 2; ++s2) { u32x4 t; t.x = pack2(st[2 * s2][0], st[2 * s2][1]); t.y = pack2(st[2 * s2][2], st[2 * s2][3]); t.z = pack2(st[2 * s2 + 1][0], st[2 * s2 + 1][1]); t.w = pack2(st[2 * s2 + 1][2], st[2 * s2 + 1][3]); pf[s2] = as_bf(t); }
#pragma unroll
    for (int dt = 0; dt < 4; ++dt) { const int d = dt * 16 + fr; const int sw = ((d >> 1) & 7) << 1; f32x4 oc = o[dt] * alpha;
#pragma unroll
      for (int s2 = 0; s2 < 2; ++s2) {
        const u32x2 lo = *(const LAS u32x2*)(cur + 8192 + d * 128 + (((s2 * 8 + fq) ^ sw) << 3)), hi = *(const LAS u32x2*)(cur + 8192 + d * 128 + (((s2 * 8 + fq + 4) ^ sw) << 3));
        u32x4 vv; vv.x = lo.x; vv.y = lo.y; vv.z = hi.x; vv.w = hi.y; oc = mfma16(as_bf(vv), pf[s2], oc); }
      o[dt] = oc; }
    if (more) {
#pragma unroll
      for (int i = 0; i < 2; ++i) { const int r = r0 + 32 * i; *(LAS u32x4*)(nxt + r * 128 + ((ch ^ (r & 7)) << 4)) = kr[i]; *(LAS u32x4*)(nxt + 8192 + r * 128 + ((ch ^ ((r >> 1) & 7)) << 4)) = vr[i]; }
    }
    __syncthreads();
  }
  float lt = lrun; lt += __shfl_xor(lt, 16); lt += __shfl_xor(lt, 32);
  const float inv = 1.0f / lt; float ss = 0.f;
  bf16_t* dst = p.ATT + (size_t)tq * 512 + h * 64;
#pragma unroll
  for (int dt = 0; dt < 4; ++dt) { const f32x4 v = o[dt] * inv; ss += v[0] * v[0] + v[1] * v[1] + v[2] * v[2] + v[3] * v[3];
    *(uint2*)(dst + dt * 16 + fq * 4) = make_uint2(pack2(v[0], v[1]), pack2(v[2], v[3])); }
  ss += __shfl_xor(ss, 16); ss += __shfl_xor(ss, 32);
  if (fq == 0) p.ss_att[tq * 8 + h] = ss;
}

template <bool FINAL>
__device__ void ssm_item(const Params& p, int item, char* lds) {
  const int g = item & 31, seg = (item >> 5) & 31, b = item >> 10;
  const int tid = threadIdx.x, lane = tid & 63, w = tid >> 6, fr = lane & 15, fq = lane >> 4;
  const int t0 = b * SEQL + seg * 256;
  bf16x8 uf[8];
#pragma unroll
  for (int ks = 0; ks < 8; ++ks) uf[ks] = *(const bf16x8*)(p.Ub + (size_t)(t0 + fr * 16 + 2 * ks + (fq >> 1)) * 512 + g * 16 + (fq & 1) * 8);
  f32x4 er = (f32x4){0.f, 0.f, 0.f, 0.f}, ei = er;
  const bf16_t* we = p.WE16 + ((size_t)g * 128 + w * 32 + fr) * 256 + fq * 8;
#pragma unroll
  for (int ks = 0; ks < 8; ++ks) { const bf16x8 br = *(const bf16x8*)(we + ks * 32), bi = *(const bf16x8*)(we + 16 * 256 + ks * 32); er = mfma16(uf[ks], br, er); ei = mfma16(uf[ks], bi, ei); }
  const int gp = g * 64 + w * 16 + fr;
  const float a16r = p.APW[gp], a16i = p.APW[2048 + gp];
  float xr[4], xi[4];
  xr[0] = er[0]; xi[0] = ei[0];
#pragma unroll
  for (int j = 1; j < 4; ++j) { xr[j] = a16r * xr[j - 1] - a16i * xi[j - 1] + er[j]; xi[j] = a16r * xi[j - 1] + a16i * xr[j - 1] + ei[j]; }
  float cr = 0.f, ci = 0.f;
  if (FINAL) {
    const float ar = p.APW[4 * 4096 + gp], ai = p.APW[4 * 4096 + 2048 + gp];
    const float* es = p.ESEG + ((size_t)(b * 32) * 32 + g) * 128 + w * 32 + fr;
    for (int j = 0; j < seg; ++j) { const float e_r = es[(size_t)j * 32 * 128], e_i = es[(size_t)j * 32 * 128 + 16]; const float nr = ar * cr - ai * ci + e_r, ni = ar * ci + ai * cr + e_i; cr = nr; ci = ni; }
  }
  const float a64r = p.APW[3 * 4096 + gp], a64i = p.APW[3 * 4096 + 2048 + gp];
  float tr = xr[3], ti = xi[3];
#pragma unroll
  for (int r = 0; r < 4; ++r) {
    float pr_ = __shfl(tr, (lane + 48) & 63), pi_ = __shfl(ti, (lane + 48) & 63);
    if (r == 0) { pr_ = cr; pi_ = ci; }
    if (fq == r) { const float nr = xr[3] + a64r * pr_ - a64i * pi_, ni = xi[3] + a64r * pi_ + a64i * pr_; tr = nr; ti = ni; }
  }
  if (!FINAL) {
    if (fq == 3) { float* es = p.ESEG + ((size_t)(b * 32 + seg) * 32 + g) * 128 + w * 32 + fr; es[0] = tr; es[16] = ti; }
    return;
  }
  float gr = __shfl(tr, (lane + 48) & 63), gi = __shfl(ti, (lane + 48) & 63);
  if (fq == 0) { gr = cr; gi = ci; }
  float pvr[4], pvi[4];
  pvr[0] = gr; pvi[0] = gi;
#pragma unroll
  for (int j = 1; j < 4; ++j) { const float ar = p.APW[(j - 1) * 4096 + gp], ai = p.APW[(j - 1) * 4096 + 2048 + gp]; pvr[j] = xr[j - 1] + ar * gr - ai * gi; pvi[j] = xi[j - 1] + ar * gi + ai * gr; }
  bf16_t* xl = (bf16_t*)lds;
  __syncthreads();
#pragma unroll
  for (int j = 0; j < 4; ++j) { xl[(fq * 4 + j) * 136 + w * 32 + fr] = f2bf(pvr[j]); xl[(fq * 4 + j) * 136 + w * 32 + 16 + fr] = f2bf(pvi[j]); }
  __syncthreads();
  bf16x8 xf[4];
#pragma unroll
  for (int ks = 0; ks < 4; ++ks) xf[ks] = *(const bf16x8*)(xl + fr * 136 + ks * 32 + fq * 8);
#pragma unroll
  for (int mi = 0; mi < 4; ++mi) {
    const int mt = w * 4 + mi;
    const bf16_t* wy = p.WY + ((size_t)g * 256 + mt * 16 + fr) * 384 + fq * 8;
    f32x4 y = (f32x4){0.f, 0.f, 0.f, 0.f};
#pragma unroll
    for (int ks = 0; ks < 4; ++ks) y = mfma16(*(const bf16x8*)(wy + ks * 32), xf[ks], y);
#pragma unroll
    for (int ks = 0; ks < 8; ++ks) if (2 * ks <= mt) y = mfma16(*(const bf16x8*)(wy + 128 + ks * 32), uf[ks], y);
    const size_t tok = (size_t)(t0 + fr * 16 + mt);
    const uint2 uu = *(const uint2*)(p.Ub + tok * 512 + g * 16 + fq * 4);
    const float4 dd = *(const float4*)(p.d_skip + g * 16 + fq * 4);
    const float y0 = gelu_f(y[0] + dd.x * __uint_as_float(uu.x << 16)), y1 = gelu_f(y[1] + dd.y * __uint_as_float(uu.x & 0xffff0000u));
    const float y2 = gelu_f(y[2] + dd.z * __uint_as_float(uu.y << 16)), y3 = gelu_f(y[3] + dd.w * __uint_as_float(uu.y & 0xffff0000u));
    *(uint2*)(p.YG + tok * 512 + g * 16 + fq * 4) = make_uint2(pack2(y0, y1), pack2(y2, y3));
  }
}

__device__ void tile_glu(const Params& p, int tile, char* lds) {
  const int rt = tile >> 2, ct = tile & 3; const int row0 = rt * 128, col0 = ct * 128;
  f32x4 acc[4][4];
  gemm_mainloop<false>(acc, p.YG, 512, p.WtGlu, 512, 512, row0, col0, lds, nullptr, nullptr, 0);
  EPI_IDS
  const int cw = col0 + wc * 64;
#pragma unroll
  for (int m = 0; m < 4; ++m) {
    const int row = row0 + wr * 64 + m * 16 + fr; float ss = 0.f;
#pragma unroll
    for (int n = 0; n < 4; ++n) { const int c = cw + n * 16 + fq * 4; const float4 bg = *(const float4*)(p.b_glu + c); const uint2 yy = *(const uint2*)(p.YG + (size_t)row * 512 + c);
      const float y0 = __uint_as_float(yy.x << 16), y1 = __uint_as_float(yy.x & 0xffff0000u), y2 = __uint_as_float(yy.y << 16), y3 = __uint_as_float(yy.y & 0xffff0000u);
      const float o0 = y0 / (1.f + __expf(-(acc[m][n][0] + bg.x))), o1 = y1 / (1.f + __expf(-(acc[m][n][1] + bg.y))), o2 = y2 / (1.f + __expf(-(acc[m][n][2] + bg.z))), o3 = y3 / (1.f + __expf(-(acc[m][n][3] + bg.w)));
      ss += o0 * o0 + o1 * o1 + o2 * o2 + o3 * o3;
      *(uint2*)(p.SSMO + (size_t)row * 512 + c) = make_uint2(pack2(o0, o1), pack2(o2, o3)); }
    ss += __shfl_xor(ss, 16); ss += __shfl_xor(ss, 32);
    if (fq == 0) p.ss_ssm[row * 8 + (cw >> 6)] = ss;
  }
}
__device__ void tile_wout(const Params& p, int tile, char* lds) {
  const int rt = tile >> 3, ct = tile & 7; const int row0 = rt * 128, col0 = ct * 128;
  f32x4 acc[4][4];
  float s0[4], s1[4];
  { const int sr = threadIdx.x >> 3;
#pragma unroll
    for (int i = 0; i < 4; ++i) { const int row = row0 + sr + 32 * i; float a = 0.f, c = 0.f;
#pragma unroll
      for (int j = 0; j < 8; ++j) { a += p.ss_att[row * 8 + j]; c += p.ss_ssm[row * 8 + j]; }
      s0[i] = rsqrtf(a * (1.0f / 512.0f) + EPSF); s1[i] = rsqrtf(c * (1.0f / 512.0f) + EPSF); } }
  gemm_mainloop<true, true>(acc, p.ATT, 512, p.WtOut, 1024, 512, row0, col0, lds, s0, s0, 1 << 30);
  gemm_mainloop<true, false>(acc, p.SSMO, 512, p.WtOut + 512, 1024, 512, row0, col0, lds, s1, s1, 1 << 30);
  EPI_IDS
  const int cw = col0 + wc * 64;
#pragma unroll
  for (int m = 0; m < 4; ++m) {
    const int row = row0 + wr * 64 + m * 16 + fr; float ss = 0.f;
#pragma unroll
    for (int n = 0; n < 4; ++n) { const int c = cw + n * 16 + fq * 4; const f32x4 xv = *(const f32x4*)(p.x + (size_t)row * 1024 + c); const f32x4 hv = xv + acc[m][n];
      ss += hv[0] * hv[0] + hv[1] * hv[1] + hv[2] * hv[2] + hv[3] * hv[3];
      *(uint2*)(p.H1B + (size_t)row * 1024 + c) = make_uint2(pack2(hv[0], hv[1]), pack2(hv[2], hv[3])); }
    ss += __shfl_xor(ss, 16); ss += __shfl_xor(ss, 32);
    if (fq == 0) p.ss_h1[row * 16 + (cw >> 6)] = ss;
  }
}
__device__ __forceinline__ float row_rs16(const float* ss, int row) { float a = 0.f;
#pragma unroll
  for (int j = 0; j < 16; ++j) a += ss[row * 16 + j];
  return rsqrtf(a * (1.0f / 1024.0f) + EPSF); }
__device__ void tile_memq(const Params& p, int tile, char* lds) {
  const int rt = tile >> 3, ct = tile & 7; const int row0 = rt * 128, col0 = ct * 128;
  f32x4 acc[4][4];
  gemm_mainloop<false>(acc, p.H1B, 1024, p.WtMq, 1024, 1024, row0, col0, lds, nullptr, nullptr, 0);
  EPI_IDS
  const int cw = col0 + wc * 64;
#pragma unroll
  for (int m = 0; m < 4; ++m) {
    const int row = row0 + wr * 64 + m * 16 + fr; const float rs = row_rs16(p.ss_h1, row); float ss = 0.f;
#pragma unroll
    for (int n = 0; n < 4; ++n) { const int c = cw + n * 16 + fq * 4; const f32x4 v = acc[m][n] * rs; ss += v[0] * v[0] + v[1] * v[1] + v[2] * v[2] + v[3] * v[3];
      *(uint2*)(p.QM + (size_t)row * 1024 + c) = make_uint2(pack2(v[0], v[1]), pack2(v[2], v[3])); }
    ss += __shfl_xor(ss, 16); ss += __shfl_xor(ss, 32);
    if (fq == 0) p.ss_qm[row * 16 + (cw >> 6)] = ss;
  }
}
__device__ void mem_attn_item(const Params& p, int item, char* lds_) {
  LAS char* lds = (LAS char*)lds_;
  const int h = item & 3, tt = item >> 2; const int tid = threadIdx.x, lane = tid & 63, w = tid >> 6, fr = lane & 15, fq = lane >> 4;
  const int tq = tt * 64 + w * 16 + fr; const int b = tq >> 13;
  const float ssq = p.ss_qm[tq * 16 + h * 4] + p.ss_qm[tq * 16 + h * 4 + 1] + p.ss_qm[tq * 16 + h * 4 + 2] + p.ss_qm[tq * 16 + h * 4 + 3];
  const float rowscale = rsqrtf(ssq * (1.0f / 256.0f) + EPSF) * 0.0625f;
  bf16x8 qf[8];
#pragma unroll
  for (int ks = 0; ks < 8; ++ks) qf[ks] = *(const bf16x8*)(p.QM + (size_t)tq * 1024 + h * 256 + ks * 32 + fq * 8);
  const bf16_t* kg = p.KMB + (size_t)(b * 4 + h) * 256 * 256;
  const bf16_t* vg = p.VMT + (size_t)(b * 4 + h) * 256 * 256;
  f32x4 o[16];
#pragma unroll
  for (int i = 0; i < 16; ++i) o[i] = (f32x4){0.f, 0.f, 0.f, 0.f};
  float mrun = -1e30f, lrun = 0.f;
  for (int kc = 0; kc < 4; ++kc) {
    __syncthreads();
#pragma unroll
    for (int i = 0; i < 8; ++i) { const int idx = tid + 256 * i; const int row = idx >> 5, ch = idx & 31;
      const u32x4 v = *(const u32x4*)(kg + (size_t)(kc * 64 + row) * 256 + ch * 8); *(LAS u32x4*)(lds + row * 512 + ((ch ^ (row & 15)) << 4)) = v; }
#pragma unroll
    for (int i = 0; i < 8; ++i) { const int idx = tid + 256 * i; const int d = idx >> 3, j = idx & 7;
      const u32x4 v = *(const u32x4*)(vg + (size_t)d * 256 + kc * 64 + j * 8); *(LAS u32x4*)(lds + 32768 + d * 128 + ((j ^ ((d >> 1) & 7)) << 4)) = v; }
    __syncthreads();
    f32x4 st[4];
#pragma unroll
    for (int mt = 0; mt < 4; ++mt) { f32x4 sacc = (f32x4){0.f, 0.f, 0.f, 0.f}; const int row = mt * 16 + fr;
#pragma unroll
      for (int ks = 0; ks < 8; ++ks) sacc = mfma16(as_bf(*(const LAS u32x4*)(lds + row * 512 + (((ks * 4 + fq) ^ (row & 15)) << 4))), qf[ks], sacc);
      st[mt] = sacc * rowscale; }
    float tmax = -1e30f;
#pragma unroll
    for (int mt = 0; mt < 4; ++mt) tmax = fmaxf(fmaxf(fmaxf(tmax, st[mt][0]), fmaxf(st[mt][1], st[mt][2])), st[mt][3]);
    tmax = fmaxf(tmax, __shfl_xor(tmax, 16)); tmax = fmaxf(tmax, __shfl_xor(tmax, 32));
    const float mnew = fmaxf(mrun, tmax); const float alpha = __expf(mrun - mnew); mrun = mnew;
    float ls = 0.f;
#pragma unroll
    for (int mt = 0; mt < 4; ++mt)
#pragma unroll
      for (int j = 0; j < 4; ++j) { const float e = __expf(st[mt][j] - mnew); st[mt][j] = e; ls += e; }
    lrun = lrun * alpha + ls;
    bf16x8 pf[2];
#pragma unroll
    for (int s2 = 0; s2 < 2; ++s2) { u32x4 t; t.x = pack2(st[2 * s2][0], st[2 * s2][1]); t.y = pack2(st[2 * s2][2], st[2 * s2][3]); t.z = pack2(st[2 * s2 + 1][0], st[2 * s2 + 1][1]); t.w = pack2(st[2 * s2 + 1][2], st[2 * s2 + 1][3]); pf[s2] = as_bf(t); }
#pragma unroll
    for (int dt = 0; dt < 16; ++dt) { const int d = dt * 16 + fr; const int sw = ((d >> 1) & 7) << 1; f32x4 oc = o[dt] * alpha;
#pragma unroll
      for (int s2 = 0; s2 < 2; ++s2) { typedef unsigned u32x2 __attribute__((ext_vector_type(2)));
        const u32x2 lo = *(const LAS u32x2*)(lds + 32768 + d * 128 + (((s2 * 8 + fq) ^ sw) << 3)), hi = *(const LAS u32x2*)(lds + 32768 + d * 128 + (((s2 * 8 + fq + 4) ^ sw) << 3));
        u32x4 vv; vv.x = lo.x; vv.y = lo.y; vv.z = hi.x; vv.w = hi.y; oc = mfma16(as_bf(vv), pf[s2], oc); }
      o[dt] = oc; }
  }
  float lt = lrun; lt += __shfl_xor(lt, 16); lt += __shfl_xor(lt, 32);
  const float inv = 1.0f / lt;
  bf16_t* dst = p.OM + (size_t)tq * 1024 + h * 256;
#pragma unroll
  for (int dt = 0; dt < 16; ++dt) { const f32x4 v = o[dt] * inv; *(uint2*)(dst + dt * 16 + fq * 4) = make_uint2(pack2(v[0], v[1]), pack2(v[2], v[3])); }
}
__device__ void tile_memo(const Params& p, int tile, char* lds) {
  const int rt = tile >> 3, ct = tile & 7; const int row0 = rt * 128, col0 = ct * 128;
  f32x4 acc[4][4];
  gemm_mainloop<false>(acc, p.OM, 1024, p.WtMo, 1024, 1024, row0, col0, lds, nullptr, nullptr, 0);
  EPI_IDS
  const int cw = col0 + wc * 64;
#pragma unroll
  for (int m = 0; m < 4; ++m) {
    const int row = row0 + wr * 64 + m * 16 + fr; float ss = 0.f;
#pragma unroll
    for (int n = 0; n < 4; ++n) { const int c = cw + n * 16 + fq * 4; const uint2 hb = *(const uint2*)(p.H1B + (size_t)row * 1024 + c);
      const f32x4 hv = (f32x4){__uint_as_float(hb.x << 16), __uint_as_float(hb.x & 0xffff0000u), __uint_as_float(hb.y << 16), __uint_as_float(hb.y & 0xffff0000u)} + acc[m][n];
      ss += hv[0] * hv[0] + hv[1] * hv[1] + hv[2] * hv[2] + hv[3] * hv[3];
      *(uint2*)(p.H2B + (size_t)row * 1024 + c) = make_uint2(pack2(hv[0], hv[1]), pack2(hv[2], hv[3])); }
    ss += __shfl_xor(ss, 16); ss += __shfl_xor(ss, 32);
    if (fq == 0) p.ss_h2[row * 16 + (cw >> 6)] = ss;
  }
}
__device__ void tile_peerq(const Params& p, int tile, char* lds) {
  const int rt = tile >> 4, ct = tile & 15; const int row0 = rt * 128, col0 = ct * 128;
  f32x4 acc[4][4];
  gemm_mainloop<false>(acc, p.H2B, 1024, p.WtPq, 1024, 1024, row0, col0, lds, nullptr, nullptr, 0);
  EPI_IDS
  const int cw = col0 + wc * 64;
#pragma unroll
  for (int m = 0; m < 4; ++m) {
    const int row = row0 + wr * 64 + m * 16 + fr; const float rs = row_rs16(p.ss_h2, row);
#pragma unroll
    for (int n = 0; n < 4; ++n) { const int c = cw + n * 16 + fq * 4; const f32x4 v = acc[m][n] * rs;
      *(uint2*)(p.QP + (size_t)row * 2048 + c) = make_uint2(pack2(v[0], v[1]), pack2(v[2], v[3])); }
  }
}
__device__ __forceinline__ void ins16(float (&a)[16], float v) {
#pragma unroll
  for (int i = 0; i < 16; ++i) { const float hi = fmaxf(a[i], v), lo = fminf(a[i], v); a[i] = hi; v = lo; }
}
__device__ void tile_scores(const Params& p, int tile, char* lds) {
  const int rt = tile >> 4, hs = tile & 15; const int row0 = rt * 128;
  f32x4 acc[4][4];
  gemm_mainloop<false>(acc, p.QP + hs * 128, 2048, p.PK + (size_t)hs * 128 * 128, 128, 128, row0, 0, lds, nullptr, nullptr, 0);
  EPI_IDS
  float* tl = (float*)lds;
#pragma unroll
  for (int m = 0; m < 4; ++m)
#pragma unroll
    for (int n = 0; n < 4; ++n)
#pragma unroll
      for (int j = 0; j < 4; ++j) tl[(wr * 64 + m * 16 + fr) * 129 + wc * 64 + n * 16 + fq * 4 + j] = acc[m][n][j];
  __syncthreads();
  if (tid < 128) {
    float a[16];
#pragma unroll
    for (int i = 0; i < 16; ++i) a[i] = -__builtin_inff();
    for (int n = 0; n < 128; ++n) { const float v = __uint_as_float((__float_as_uint(tl[tid * 129 + n]) & ~127u) | (unsigned)n); ins16(a, v); }
    uint4* dst = (uint4*)(p.TOPS + ((size_t)(row0 + tid) * 16 + hs) * 16);
    dst[0] = make_uint4(__float_as_uint(a[0]), __float_as_uint(a[1]), __float_as_uint(a[2]), __float_as_uint(a[3]));
    dst[1] = make_uint4(__float_as_uint(a[4]), __float_as_uint(a[5]), __float_as_uint(a[6]), __float_as_uint(a[7]));
    dst[2] = make_uint4(__float_as_uint(a[8]), __float_as_uint(a[9]), __float_as_uint(a[10]), __float_as_uint(a[11]));
    dst[3] = make_uint4(__float_as_uint(a[12]), __float_as_uint(a[13]), __float_as_uint(a[14]), __float_as_uint(a[15]));
  }
}
__device__ void peer_gather_item(const Params& p, int item, char* lds) {
  const int tid = threadIdx.x, lane = tid & 63, w = tid >> 6;
  unsigned* LA = (unsigned*)lds;
  int* LE = (int*)(lds + 256 * 33 * 4);
  float* LG = (float*)(lds + 256 * 33 * 4 + 32 * 128 * 4);
  __syncthreads();
  {
    const int tl_ = tid >> 3, h = tid & 7; const int t = item * 32 + tl_;
    const uint4* src = (const uint4*)(p.TOPS + ((size_t)t * 16 + h * 2) * 16);
    float a[16], bq[16];
#pragma unroll
    for (int i = 0; i < 4; ++i) { const uint4 v = src[i]; a[4 * i] = __uint_as_float(v.x); a[4 * i + 1] = __uint_as_float(v.y); a[4 * i + 2] = __uint_as_float(v.z); a[4 * i + 3] = __uint_as_float(v.w); }
#pragma unroll
    for (int i = 0; i < 4; ++i) { const uint4 v = src[4 + i]; bq[4 * i] = __uint_as_float(v.x); bq[4 * i + 1] = __uint_as_float(v.y); bq[4 * i + 2] = __uint_as_float(v.z); bq[4 * i + 3] = __uint_as_float(v.w); }
#pragma unroll
    for (int i = 0; i < 16; ++i) { LA[tid * 33 + i] = __float_as_uint(a[i]); LA[tid * 33 + 16 + i] = __float_as_uint(bq[i]); }
    float c[16];
#pragma unroll
    for (int i = 0; i < 16; ++i) c[i] = -__builtin_inff();
#pragma unroll
    for (int i = 0; i < 16; ++i)
#pragma unroll
      for (int j = 0; j < 16; ++j) if ((i + 1) * (j + 1) <= 16) { const float s = a[i] + bq[j]; ins16(c, __uint_as_float((__float_as_uint(s) & ~255u) | (unsigned)(i * 16 + j))); }
    const float mx = c[0]; float e[16]; float sum = 0.f;
#pragma unroll
    for (int i = 0; i < 16; ++i) { e[i] = __expf(c[i] - mx); sum += e[i]; }
    const float inv = 1.0f / sum;
#pragma unroll
    for (int i = 0; i < 16; ++i) { const unsigned pos = __float_as_uint(c[i]) & 255u; const unsigned ia = LA[tid * 33 + (pos >> 4)] & 127u, ib = LA[tid * 33 + 16 + (pos & 15u)] & 127u;
      LE[tl_ * 128 + h * 16 + i] = (int)(ia * 128u + ib); LG[tl_ * 128 + h * 16 + i] = e[i] * inv; }
  }
  __syncthreads();
  for (int ti = 0; ti < 8; ++ti) {
    const int tl_ = w * 8 + ti; const int t = item * 32 + tl_;
    const float rs = row_rs16(p.ss_h2, t);
    f32x2 hn[8], hres[8];
    { const uint4 ha = *(const uint4*)(p.H2B + (size_t)t * 1024 + lane * 16), hb = *(const uint4*)(p.H2B + (size_t)t * 1024 + lane * 16 + 8);
      const unsigned hw[8] = {ha.x, ha.y, ha.z, ha.w, hb.x, hb.y, hb.z, hb.w};
#pragma unroll
      for (int i = 0; i < 8; ++i) { hres[i].x = __uint_as_float(hw[i] << 16); hres[i].y = __uint_as_float(hw[i] & 0xffff0000u);
        const float2 g = *(const float2*)(p.norm_peer_g + lane * 16 + 2 * i); hn[i].x = hres[i].x * rs * g.x; hn[i].y = hres[i].y * rs * g.y; } }
    f32x2 oa[8];
#pragma unroll
    for (int i = 0; i < 8; ++i) oa[i] = (f32x2){0.f, 0.f};
    for (int k = 0; k < 128; k += 4) {
      int e[4]; float gg[4], scu[4], scv[4]; uint4 uq[4], vq[4];
#pragma unroll
      for (int u = 0; u < 4; ++u) { e[u] = __builtin_amdgcn_readfirstlane(LE[tl_ * 128 + k + u]); gg[u] = LG[tl_ * 128 + k + u]; }
#pragma unroll
      for (int u = 0; u < 4; ++u) { uq[u] = *(const uint4*)(p.PU8 + (size_t)e[u] * 1024 + lane * 16); vq[u] = *(const uint4*)(p.PV8 + (size_t)e[u] * 1024 + lane * 16); scu[u] = p.su[e[u]]; scv[u] = p.sv[e[u]]; }
#pragma unroll
      for (int u = 0; u < 4; ++u) {
        f32x2 d2 = (f32x2){0.f, 0.f};
        d2 += __builtin_amdgcn_cvt_pk_f32_fp8((int)uq[u].x, false) * hn[0]; d2 += __builtin_amdgcn_cvt_pk_f32_fp8((int)uq[u].x, true) * hn[1];
        d2 += __builtin_amdgcn_cvt_pk_f32_fp8((int)uq[u].y, false) * hn[2]; d2 += __builtin_amdgcn_cvt_pk_f32_fp8((int)uq[u].y, true) * hn[3];
        d2 += __builtin_amdgcn_cvt_pk_f32_fp8((int)uq[u].z, false) * hn[4]; d2 += __builtin_amdgcn_cvt_pk_f32_fp8((int)uq[u].z, true) * hn[5];
        d2 += __builtin_amdgcn_cvt_pk_f32_fp8((int)uq[u].w, false) * hn[6]; d2 += __builtin_amdgcn_cvt_pk_f32_fp8((int)uq[u].w, true) * hn[7];
        float d = d2.x + d2.y;
#pragma unroll
        for (int o = 32; o > 0; o >>= 1) d += __shfl_xor(d, o);
        const float wgt = gg[u] * gelu_f(d * scu[u]) * scv[u];
        oa[0] += __builtin_amdgcn_cvt_pk_f32_fp8((int)vq[u].x, false) * wgt; oa[1] += __builtin_amdgcn_cvt_pk_f32_fp8((int)vq[u].x, true) * wgt;
        oa[2] += __builtin_amdgcn_cvt_pk_f32_fp8((int)vq[u].y, false) * wgt; oa[3] += __builtin_amdgcn_cvt_pk_f32_fp8((int)vq[u].y, true) * wgt;
        oa[4] += __builtin_amdgcn_cvt_pk_f32_fp8((int)vq[u].z, false) * wgt; oa[5] += __builtin_amdgcn_cvt_pk_f32_fp8((int)vq[u].z, true) * wgt;
        oa[6] += __builtin_amdgcn_cvt_pk_f32_fp8((int)vq[u].w, false) * wgt; oa[7] += __builtin_amdgcn_cvt_pk_f32_fp8((int)vq[u].w, true) * wgt;
      }
    }
    float* op = p.out + (size_t)t * 1024 + lane * 16;
#pragma unroll
    for (int i = 0; i < 4; ++i) { const f32x2 a = hres[2 * i] + oa[2 * i], b = hres[2 * i + 1] + oa[2 * i + 1]; *(float4*)(op + 4 * i) = make_float4(a.x, a.y, b.x, b.y); }
  }
}

template <int PH>
__device__ __forceinline__ void run_phase(const Params& p, char* lds, int bid, int nb) {
  if (PH == 0) {
    const int nt_in = 16 * 32, nt_glu = 8 * 8, nt_out = 16 * 16, nt_m = 16 * 16, nt_pq = 16 * 32;
    const int total = nt_in + nt_glu + nt_out + 4 * nt_m + nt_pq;
    for (int t = bid; t < total; t += nb) {
      int i = t; float* tl = (float*)lds;
      if (i < nt_in) { transpose_tile(p.w_in, p.WtIn, 1024, 2048, i, p.norm_mix_g, p.norm_mix_g, 1024, tl); continue; } i -= nt_in;
      if (i < nt_glu) { transpose_tile(p.w_glu, p.WtGlu, 512, 512, i, nullptr, nullptr, 0, tl); continue; } i -= nt_glu;
      if (i < nt_out) { transpose_tile(p.w_out, p.WtOut, 1024, 1024, i, p.att_out_g, p.ssm_out_g, 512, tl); continue; } i -= nt_out;
      if (i < nt_m) { transpose_tile(p.w_mem_q, p.WtMq, 1024, 1024, i, p.norm_mem_g, p.norm_mem_g, 1024, tl); continue; } i -= nt_m;
      if (i < nt_m) { transpose_tile(p.w_mem_k, p.WtMk, 1024, 1024, i, p.norm_memkv_g, p.norm_memkv_g, 1024, tl); continue; } i -= nt_m;
      if (i < nt_m) { transpose_tile(p.w_mem_v, p.WtMv, 1024, 1024, i, p.norm_memkv_g, p.norm_memkv_g, 1024, tl); continue; } i -= nt_m;
      if (i < nt_m) { transpose_tile(p.w_mem_o, p.WtMo, 1024, 1024, i, nullptr, nullptr, 0, tl); continue; } i -= nt_m;
      transpose_tile(p.w_peer_q, p.WtPq, 1024, 2048, i, p.norm_peer_g, p.norm_peer_g, 1024, tl);
    }
    convert_flat(p.peer_keys, p.PK, (size_t)16 * 128 * 128 / 8, bid, nb);
    rows_fp8(p.peer_u, p.PU8, p.su, 16384, bid, nb);
    rows_fp8(p.peer_v, p.PV8, p.sv, 16384, bid, nb);
    rows_bf16_rs(p.x, p.XB, p.rs_x, T_TOK, bid, nb);
    rows_bf16_rs(p.mem, p.MEMB, p.rs_mem, 512, bid, nb);
    for (int i = bid * NTHREADS + threadIdx.x; i < 2048; i += nb * NTHREADS) ssm_stage1(p, i);
  } else if (PH == 1) {
    for (int t = bid; t < 2048 + 64; t += nb) { if (t < 2048) tile_win(p, t, lds); else tile_memkv(p, t - 2048, lds); }
    ssm_stage2(p, bid, nb);
  } else if (PH == 2) {
    for (int t = bid; t < 2048; t += nb) chunk_attn_item(p, t, lds);
    for (int t = bid; t < 2048; t += nb) ssm_item<false>(p, t, lds);
    memk_fix(p, bid, nb);
  } else if (PH == 3) {
    for (int t = bid; t < 2048; t += nb) ssm_item<true>(p, t, lds);
  } else if (PH == 4) {
    for (int t = bid; t < 512; t += nb) tile_glu(p, t, lds);
  } else if (PH == 5) {
    for (int t = bid; t < 1024; t += nb) tile_wout(p, t, lds);
  } else if (PH == 6) {
    for (int t = bid; t < 1024; t += nb) tile_memq(p, t, lds);
  } else if (PH == 7) {
    for (int t = bid; t < 1024; t += nb) mem_attn_item(p, t, lds);
  } else if (PH == 8) {
    for (int t = bid; t < 1024; t += nb) tile_memo(p, t, lds);
  } else if (PH == 9) {
    for (int t = bid; t < 2048; t += nb) tile_peerq(p, t, lds);
  } else if (PH == 10) {
    for (int t = bid; t < 2048; t += nb) tile_scores(p, t, lds);
  } else if (PH == 11) {
    for (int t = bid; t < 512; t += nb) peer_gather_item(p, t, lds);
  }
}

#if !MEGA
template <int PH>
__global__ void __launch_bounds__(NTHREADS, 2) phase_kernel(Params p) {
  extern __shared__ __attribute__((aligned(16))) char lds[];
  run_phase<PH>(p, lds, blockIdx.x, gridDim.x);
}

#endif
#ifndef REPEAT_PH
#define REPEAT_PH -1
#endif
#define RUNPH(k) do { run_phase<k>(p, lds, bid, nb); if (REPEAT_PH == k) { xcd_barrier(xb); run_phase<k>(p, lds, bid, nb); } } while (0)
__global__ void __launch_bounds__(NTHREADS, 2) mega_kernel(Params p) {
  extern __shared__ __attribute__((aligned(16))) char lds[];
  cg::grid_group grid = cg::this_grid();
  const int bid = blockIdx.x, nb = gridDim.x;
  volatile LAS unsigned* stw = (volatile LAS unsigned*)((LAS char*)lds + LDS_WORK);
  if (threadIdx.x == 0) { stw[0] = 0u; stw[1] = 0u; stw[2] = 0u; stw[3] = 0u; }
  __syncthreads();
  XcdBarrier xb = xcd_barrier_post(p.bar, stw);
  RUNPH(0); grid.sync();
  RUNPH(1); xcd_barrier(xb);
  RUNPH(2); xcd_barrier(xb);
  RUNPH(3); xcd_barrier(xb);
  RUNPH(4); xcd_barrier(xb);
  RUNPH(5); xcd_barrier(xb);
  RUNPH(6); xcd_barrier(xb);
  RUNPH(7); xcd_barrier(xb);
  RUNPH(8); xcd_barrier(xb);
  RUNPH(9); xcd_barrier(xb);
  RUNPH(10); xcd_barrier(xb);
  RUNPH(11);
}

#if !MEGA
template <int PH> static void launch_phase(const Params& p, int grid, hipStream_t s) {
  hipFuncSetAttribute((const void*)phase_kernel<PH>, hipFuncAttributeMaxDynamicSharedMemorySize, LDS_BYTES);
  phase_kernel<PH><<<grid, NTHREADS, LDS_BYTES, s>>>(p);
}
#endif

extern "C" void kernel_launch(void* const* d_in, const int* in_sizes, int n_in, void* d_out, int out_size, void* d_ws, size_t ws_size, hipStream_t stream) {
  Params p{};
  const float** f = (const float**)&p;
  for (int i = 0; i < 33; ++i) f[i] = (const float*)d_in[i];
  p.out = (float*)d_out;
  char* ws = (char*)d_ws; size_t off = 0;
  auto take = [&](size_t bytes) { char* r = ws + off; off += (bytes + 255) & ~(size_t)255; return r; };
  const size_t MB = 1u << 20;
  p.bar = (unsigned*)take(16384);
  p.WtIn = (bf16_t*)take(4 * MB); p.WtGlu = (bf16_t*)take(MB / 2); p.WtOut = (bf16_t*)take(2 * MB);
  p.WtMq = (bf16_t*)take(2 * MB); p.WtMk = (bf16_t*)take(2 * MB); p.WtMv = (bf16_t*)take(2 * MB); p.WtMo = (bf16_t*)take(2 * MB); p.WtPq = (bf16_t*)take(4 * MB);
  p.PK = (bf16_t*)take(MB / 2); p.PU8 = (unsigned char*)take(16 * MB); p.PV8 = (unsigned char*)take(16 * MB); p.su = (float*)take(16384 * 4); p.sv = (float*)take(16384 * 4);
  char* RA = take(64 * MB); char* RB = take(64 * MB);
  p.XB = (bf16_t*)RA; p.ATT = (bf16_t*)RA; p.YG = (bf16_t*)(RA + 16 * MB); p.QM = (bf16_t*)RA; p.H2B = (bf16_t*)RA;
  p.SSMO = (bf16_t*)(RA + 32 * MB); p.OM = (bf16_t*)(RA + 32 * MB);
  p.Qb = (bf16_t*)RB; p.Kb = (bf16_t*)(RB + 16 * MB); p.VT = (bf16_t*)(RB + 32 * MB); p.Ub = (bf16_t*)(RB + 48 * MB); p.H1B = (bf16_t*)RB; p.QP = (bf16_t*)RB;
  p.TOPS = (unsigned*)take(16 * MB);
  p.MEMB = (bf16_t*)take(MB); p.KMB = (bf16_t*)take(MB); p.VMT = (bf16_t*)take(MB); p.KMraw = (float*)take(2 * MB);
  p.WE16 = (bf16_t*)take(2 * MB); p.WY = (bf16_t*)take(6 * MB);
  p.rs_x = (float*)take(T_TOK * 4); p.rs_mem = (float*)take(512 * 4); p.ss_att = (float*)take(T_TOK * 8 * 4); p.ss_ssm = (float*)take(T_TOK * 8 * 4);
  p.ss_h1 = (float*)take(T_TOK * 16 * 4); p.ss_qm = (float*)take(T_TOK * 16 * 4); p.ss_km = (float*)take(512 * 16 * 4); p.ss_h2 = (float*)take(T_TOK * 16 * 4);
  p.ESEG = (float*)take(2 * 32 * 32 * 128 * 4);
  p.BBR = (float*)take(2048 * 16 * 4); p.BBI = (float*)take(2048 * 16 * 4); p.PWR = (float*)take(32 * 17 * 64 * 4); p.PWI = (float*)take(32 * 17 * 64 * 4); p.APW = (float*)take(5 * 4096 * 4);
  if (off > ws_size) { fprintf(stderr, "workspace too small: need %zu have %zu\n", off, ws_size); return; }
#if MEGA
  hipMemsetAsync(p.bar, 0, 16384, stream);
  static int grid_blocks = 0;
  if (!grid_blocks) {
    int dev = 0, cus = 0, per_cu = 0; hipGetDevice(&dev); hipDeviceGetAttribute(&cus, hipDeviceAttributeMultiprocessorCount, dev);
    hipFuncSetAttribute((const void*)mega_kernel, hipFuncAttributeMaxDynamicSharedMemorySize, LDS_BYTES);
    hipOccupancyMaxActiveBlocksPerMultiprocessor(&per_cu, mega_kernel, NTHREADS, LDS_BYTES);
    if (per_cu > 2) per_cu = 2; if (per_cu < 1) per_cu = 1;
    grid_blocks = cus * per_cu;
  }
  void* args[] = {&p};
  hipError_t e = hipLaunchCooperativeKernel((void*)mega_kernel, dim3(grid_blocks), dim3(NTHREADS), args, LDS_BYTES, stream);
  if (e != hipSuccess) fprintf(stderr, "cooperative launch failed: %s (grid %d)\n", hipGetErrorString(e), grid_blocks);
#else
  const int G = 1024;
  launch_phase<0>(p, G, stream); launch_phase<1>(p, G, stream); launch_phase<2>(p, G, stream); launch_phase<3>(p, G, stream);
  launch_phase<4>(p, G, stream); launch_phase<5>(p, G, stream); launch_phase<6>(p, G, stream); launch_phase<7>(p, G, stream);
  launch_phase<8>(p, G, stream); launch_phase<9>(p, G, stream); launch_phase<10>(p, G, stream); launch_phase<11>(p, G, stream);
#endif
}
```

```cpp
#include <hip/hip_runtime.h>
#include <hip/hip_cooperative_groups.h>
#include <cstdio>
#include <cstdint>
namespace cg = cooperative_groups;

#ifndef MEGA
#define MEGA 1
#endif

typedef unsigned short bf16_t;
typedef short bf16x8 __attribute__((ext_vector_type(8)));
typedef float f32x4 __attribute__((ext_vector_type(4)));
typedef unsigned u32x4 __attribute__((ext_vector_type(4)));
#define LAS __attribute__((address_space(3)))
__device__ __forceinline__ bf16x8 as_bf(u32x4 v) { return __builtin_bit_cast(bf16x8, v); }

#define T_TOK 16384
#define SEQL 8192
#define NTHREADS 256
#define LDS_WORK 66560
#define LDS_BYTES (LDS_WORK + 16)
#define EPSF 1e-6f

__device__ __forceinline__ unsigned short f2bf(float f) { unsigned u = __float_as_uint(f); u += 0x7fffu + ((u >> 16) & 1u); return (unsigned short)(u >> 16); }
__device__ __forceinline__ float bf2f(unsigned short b) { return __uint_as_float(((unsigned)b) << 16); }
__device__ __forceinline__ unsigned pack2(float lo, float hi) { return (unsigned)f2bf(lo) | ((unsigned)f2bf(hi) << 16); }
__device__ __forceinline__ float gelu_f(float v) {
  const float av = fabsf(v), t = __builtin_amdgcn_rcpf(av * 0.2316418882f + 1.0f);
  float q = t * 0.5307027145f + (-0.7265760135f); q = q * t + 0.7107068705f; q = q * t + (-0.142248368f); q = q * t + 0.127414796f; q = q * t;
  const float e = __builtin_amdgcn_exp2f((v * v) * (-0.72134752044f)); const float m = v * (q * e);
  return v < 0.f ? m : v - m; }
typedef float f32x2 __attribute__((ext_vector_type(2)));
__device__ __forceinline__ f32x4 mfma16(bf16x8 a, bf16x8 b, f32x4 c) { return __builtin_amdgcn_mfma_f32_16x16x32_bf16(a, b, c, 0, 0, 0); }


#define XB_TMO      128
#define XB_XCNT(j)  (256  + 64 * (j))
#define XB_XSUB(j)  (1280 + 64 * (j))
#define XB_XGEN(j)  (2304 + 64 * (j))
#define XB_TOP      3328
#define XB_TOPGEN   3392
#define XCD_BAR_WORDS 3456
#define XB_SPIN_CAP (1u << 18)
__device__ __forceinline__ unsigned xb_ld(unsigned* p)              { return __hip_atomic_load(p, __ATOMIC_RELAXED, __HIP_MEMORY_SCOPE_AGENT); }
__device__ __forceinline__ unsigned xb_add(unsigned* p, unsigned v) { return __hip_atomic_fetch_add(p, v, __ATOMIC_RELAXED, __HIP_MEMORY_SCOPE_AGENT); }
__device__ __forceinline__ unsigned xb_xcc_id() { return (unsigned)__builtin_amdgcn_s_getreg((3 << 11) | 20) & 0xFu; }
#define XB_SPIN(cond, bar) do { unsigned _sp = 0; while (cond) { __builtin_amdgcn_s_sleep(1); \
    if ((++_sp & 255u) == 0u) { if (xb_ld(&(bar)[XB_TMO])) break; if (_sp > XB_SPIN_CAP) { atomicAdd(&(bar)[XB_TMO], 1u); break; } } } } while (0)
struct XcdBarrier { unsigned* bar; unsigned x; volatile LAS unsigned* st; };
__device__ __forceinline__ XcdBarrier xcd_barrier_post(unsigned* bar, volatile LAS unsigned* st) {
  XcdBarrier b; b.bar = bar; b.x = xb_xcc_id(); b.st = st;
  if (threadIdx.x == 0) (void)xb_add(&bar[XB_XCNT(b.x)], 1u);
  return b;
}
__device__ __forceinline__ void xcd_barrier_complete(unsigned* bar, unsigned x, unsigned& nloc, unsigned& nx) {
  const unsigned G = gridDim.x * gridDim.y * gridDim.z;
  unsigned sum, cnt, mine, sp = 0u;
  for (;;) {
    sum = 0u; cnt = 0u; mine = 0u;
#pragma unroll
    for (unsigned j = 0; j < 16; ++j) { const unsigned c = xb_ld(&bar[XB_XCNT(j)]); sum += c; cnt += (c > 0u) ? 1u : 0u; mine = (j == x) ? c : mine; }
    if (sum == G) break;
    __builtin_amdgcn_s_sleep(1);
    if ((++sp & 255u) == 0u) { if (xb_ld(&bar[XB_TMO])) break; if (sp > XB_SPIN_CAP) { atomicAdd(&bar[XB_TMO], 1u); break; } }
  }
  nloc = mine > 0u ? mine : 1u; nx = cnt > 0u ? cnt : 1u;
}
__device__ __forceinline__ void xcd_barrier(const XcdBarrier& b) {
  asm volatile("s_waitcnt vmcnt(0)" ::: "memory");
  __syncthreads();
  if (threadIdx.x == 0) {
    unsigned* bar = b.bar;
    __builtin_amdgcn_s_waitcnt(0);
    unsigned nloc = b.st[0], nx = b.st[1];
    if (nloc == 0u) { xcd_barrier_complete(bar, b.x, nloc, nx); b.st[0] = nloc; b.st[1] = nx; }
    const unsigned old = xb_add(&bar[XB_XSUB(b.x)], 1u);
    const unsigned gen = old / nloc;
    if (old + 1u == (gen + 1u) * nloc) {
      __builtin_amdgcn_fence(__ATOMIC_RELEASE, "agent");
      asm volatile("s_waitcnt vmcnt(0)" ::: "memory");
      const unsigned og = xb_add(&bar[XB_TOP], 1u);
      const unsigned tg = og / nx;
      if (og + 1u == (tg + 1u) * nx) xb_add(&bar[XB_TOPGEN], 1u);
      else XB_SPIN(xb_ld(&bar[XB_TOPGEN]) == tg, bar);
      __builtin_amdgcn_fence(__ATOMIC_ACQUIRE, "agent");
      xb_add(&bar[XB_XGEN(b.x)], 1u);
      asm volatile("s_waitcnt vmcnt(0)" ::: "memory");
    } else {
      XB_SPIN(xb_ld(&bar[XB_XGEN(b.x)]) == gen, bar);
      __builtin_amdgcn_fence(__ATOMIC_ACQUIRE, "agent");
      asm volatile("s_waitcnt vmcnt(0)" ::: "memory");
    }
  }
  __syncthreads();
}

struct Params {
  const float *x, *mem, *norm_mix_g, *w_in, *att_q_g, *att_k_g, *rel_bias;
  const float *lam_re, *lam_im, *log_step, *b_re, *b_im, *c_re, *c_im, *d_skip, *w_glu, *b_glu;
  const float *att_out_g, *ssm_out_g, *w_out, *norm_mem_g, *norm_memkv_g, *w_mem_q, *w_mem_k, *w_mem_v;
  const float *mem_q_g, *mem_k_g, *w_mem_o, *norm_peer_g, *w_peer_q, *peer_keys, *peer_u, *peer_v;
  float* out;
  unsigned* bar;
  bf16_t *WtIn, *WtGlu, *WtOut, *WtMq, *WtMk, *WtMv, *WtMo, *WtPq, *PK, *PU, *PV;
  bf16_t *XB, *MEMB, *Qb, *Kb, *VT, *Ub, *ATT, *YG, *SSMO, *H1B, *QM, *OM, *H2B, *QP;
  bf16_t *KMB, *VMT, *WE16, *WY;
  float *rs_x, *rs_mem, *ss_att, *ss_ssm, *ss_h1, *ss_qm, *ss_km, *ss_h2, *KMraw, *ESEG;
  float *BBR, *BBI, *PWR, *PWI, *KJ, *APW;
  unsigned* TOPS;
  unsigned char *PU8, *PV8; float *su, *sv;
};

template <bool ASC, bool ZERO = true, bool SWAP = false>
__device__ __forceinline__ void gemm_mainloop(f32x4 (&acc)[4][4], const bf16_t* __restrict__ A, int lda, const bf16_t* __restrict__ Bt, int ldb, int K,
                                              int row0, int col0, char* lds_, const float* s0, const float* s1, int ksplit) {
  LAS char* lds = (LAS char*)lds_;
  const int tid = threadIdx.x, lane = tid & 63, w = tid >> 6, wr = w >> 1, wc = w & 1, fr = lane & 15, fq = lane >> 4;
  if (ZERO) {
#pragma unroll
    for (int m = 0; m < 4; ++m)
#pragma unroll
      for (int n = 0; n < 4; ++n) acc[m][n] = (f32x4){0.f, 0.f, 0.f, 0.f};
  }
  const int sr = tid >> 3, skc = tid & 7;
  const bf16_t* gA = A + (size_t)(row0 + sr) * lda + skc * 8;
  const bf16_t* gB = Bt + (size_t)(col0 + sr) * ldb + skc * 8;
  const int soff = sr * 128 + ((skc ^ (sr & 7)) << 4);
  u32x4 ra[4], rb[4];
  const int nk = K >> 6;
#pragma unroll
  for (int i = 0; i < 4; ++i) { ra[i] = *(const u32x4*)(gA + (size_t)(32 * i) * lda); rb[i] = *(const u32x4*)(gB + (size_t)(32 * i) * ldb); }
  __syncthreads();
  {
#pragma unroll
    for (int i = 0; i < 4; ++i) {
      u32x4 va = ra[i];
      if (ASC) { const float s = (0 < ksplit) ? s0[i] : s1[i];
        va.x = pack2(__uint_as_float(va.x << 16) * s, __uint_as_float(va.x & 0xffff0000u) * s); va.y = pack2(__uint_as_float(va.y << 16) * s, __uint_as_float(va.y & 0xffff0000u) * s);
        va.z = pack2(__uint_as_float(va.z << 16) * s, __uint_as_float(va.z & 0xffff0000u) * s); va.w = pack2(__uint_as_float(va.w << 16) * s, __uint_as_float(va.w & 0xffff0000u) * s); }
      *(LAS u32x4*)(lds + soff + i * 4096) = va; *(LAS u32x4*)(lds + 16384 + soff + i * 4096) = rb[i];
    }
  }
  __syncthreads();
  for (int kt = 0; kt < nk; ++kt) {
    LAS char* cur = lds + (kt & 1) * 32768; LAS char* nxt = lds + ((kt + 1) & 1) * 32768;
    const bool more = (kt + 1 < nk);
    if (more) {
      const int k1 = (kt + 1) << 6;
#pragma unroll
      for (int i = 0; i < 4; ++i) { ra[i] = *(const u32x4*)(gA + (size_t)(32 * i) * lda + k1); rb[i] = *(const u32x4*)(gB + (size_t)(32 * i) * ldb + k1); }
    }
#pragma unroll
    for (int ks = 0; ks < 2; ++ks) {
      bf16x8 af[4], bfr[4];
      const int kc = ks * 4 + fq;
#pragma unroll
      for (int m = 0; m < 4; ++m) { const int r = wr * 64 + m * 16 + fr; af[m] = as_bf(*(const LAS u32x4*)(cur + r * 128 + ((kc ^ (r & 7)) << 4))); }
#pragma unroll
      for (int n = 0; n < 4; ++n) { const int r = wc * 64 + n * 16 + fr; bfr[n] = as_bf(*(const LAS u32x4*)(cur + 16384 + r * 128 + ((kc ^ (r & 7)) << 4))); }
#pragma unroll
      for (int m = 0; m < 4; ++m)
#pragma unroll
        for (int n = 0; n < 4; ++n) acc[m][n] = SWAP ? mfma16(af[m], bfr[n], acc[m][n]) : mfma16(bfr[n], af[m], acc[m][n]);
    }
    if (more) {
      const int k1 = (kt + 1) << 6;
#pragma unroll
      for (int i = 0; i < 4; ++i) {
        u32x4 va = ra[i];
        if (ASC) { const float s = (k1 < ksplit) ? s0[i] : s1[i];
          va.x = pack2(__uint_as_float(va.x << 16) * s, __uint_as_float(va.x & 0xffff0000u) * s); va.y = pack2(__uint_as_float(va.y << 16) * s, __uint_as_float(va.y & 0xffff0000u) * s);
          va.z = pack2(__uint_as_float(va.z << 16) * s, __uint_as_float(va.z & 0xffff0000u) * s); va.w = pack2(__uint_as_float(va.w << 16) * s, __uint_as_float(va.w & 0xffff0000u) * s); }
        *(LAS u32x4*)(nxt + soff + i * 4096) = va; *(LAS u32x4*)(nxt + 16384 + soff + i * 4096) = rb[i];
      }
    }
    __syncthreads();
  }
}

__device__ void transpose_tile(const float* __restrict__ src, bf16_t* __restrict__ dst, int K, int N, int tile, const float* g0, const float* g1, int split, float* tl  ) {
  const int ntn = N >> 6; const int tk = tile / ntn, tn = tile % ntn; const int k0 = tk << 6, n0 = tn << 6; const int tid = threadIdx.x;
  __syncthreads();
#pragma unroll 4
  for (int i = 0; i < 16; ++i) { const int kk = i * 4 + (tid >> 6), nn = tid & 63; const int k = k0 + kk;
    float g = 1.f; if (g0) g = (k < split) ? g0[k] : g1[k - split];
    tl[kk * 65 + nn] = src[(size_t)k * N + n0 + nn] * g; }
  __syncthreads();
  const int n = tid >> 2, kq = (tid & 3) * 16;
  unsigned o[8];
#pragma unroll
  for (int j = 0; j < 8; ++j) o[j] = pack2(tl[(kq + 2 * j) * 65 + n], tl[(kq + 2 * j + 1) * 65 + n]);
  uint4* d = (uint4*)(dst + (size_t)(n0 + n) * K + k0 + kq);
  d[0] = make_uint4(o[0], o[1], o[2], o[3]); d[1] = make_uint4(o[4], o[5], o[6], o[7]);
}

__device__ void convert_flat(const float* __restrict__ src, bf16_t* __restrict__ dst, size_t n8  , int bid, int nb) {
  for (size_t i = (size_t)bid * NTHREADS + threadIdx.x; i < n8; i += (size_t)nb * NTHREADS) {
    const float4 a = ((const float4*)src)[2 * i], b = ((const float4*)src)[2 * i + 1];
    ((uint4*)dst)[i] = make_uint4(pack2(a.x, a.y), pack2(a.z, a.w), pack2(b.x, b.y), pack2(b.z, b.w));
  }
}
__device__ void rows_bf16_rs(const float* __restrict__ src, bf16_t* __restrict__ dst, float* __restrict__ rs, int nrows, int bid, int nb) {
  const int lane = threadIdx.x & 63, w = threadIdx.x >> 6;
  for (int row = bid * 4 + w; row < nrows; row += nb * 4) {
    const float4* s = (const float4*)(src + (size_t)row * 1024);
    float ss = 0.f; uint2* d = (uint2*)(dst + (size_t)row * 1024);
#pragma unroll
    for (int i = 0; i < 4; ++i) { const float4 v = s[i * 64 + lane]; ss += v.x * v.x + v.y * v.y + v.z * v.z + v.w * v.w; d[i * 64 + lane] = make_uint2(pack2(v.x, v.y), pack2(v.z, v.w)); }
#pragma unroll
    for (int o = 32; o > 0; o >>= 1) ss += __shfl_xor(ss, o);
    if (lane == 0) rs[row] = rsqrtf(ss * (1.0f / 1024.0f) + EPSF);
  }
}

__device__ void rows_fp8(const float* __restrict__ src, unsigned char* __restrict__ dst, float* __restrict__ sc, int nrows, int bid, int nb) {
  const int lane = threadIdx.x & 63, w = threadIdx.x >> 6;
  for (int row = bid * 4 + w; row < nrows; row += nb * 4) {
    const float4* s = (const float4*)(src + (size_t)row * 1024);
    float4 v[4]; float am = 0.f;
#pragma unroll
    for (int i = 0; i < 4; ++i) { v[i] = s[i * 64 + lane]; am = fmaxf(am, fmaxf(fmaxf(fabsf(v[i].x), fabsf(v[i].y)), fmaxf(fabsf(v[i].z), fabsf(v[i].w)))); }
#pragma unroll
    for (int o = 32; o > 0; o >>= 1) am = fmaxf(am, __shfl_xor(am, o));
    const float q = (am > 0.f) ? 224.0f / am : 1.0f;
    unsigned* d = (unsigned*)(dst + (size_t)row * 1024);
#pragma unroll
    for (int i = 0; i < 4; ++i) { int wd = 0; wd = __builtin_amdgcn_cvt_pk_fp8_f32(v[i].x * q, v[i].y * q, wd, false); wd = __builtin_amdgcn_cvt_pk_fp8_f32(v[i].z * q, v[i].w * q, wd, true); d[i * 64 + lane] = (unsigned)wd; }
    if (lane == 0) sc[row] = (am > 0.f) ? am * (1.0f / 224.0f) : 1.0f;
  }
}

__device__ void ssm_stage1(const Params& p, int gp) {
  const int g = gp >> 6;
  const float step = expf(p.log_step[g]); const float lr = p.lam_re[gp], li = p.lam_im[gp];
  const float mag = expf(lr * step); const float ar = mag * cosf(li * step), ai = mag * sinf(li * step);
  const float zr = ar - 1.0f, den = lr * lr + li * li; const float fr = (zr * lr + ai * li) / den, fi = (ai * lr - zr * li) / den;
  for (int c = 0; c < 16; ++c) { const float br = p.b_re[gp * 16 + c], bi = p.b_im[gp * 16 + c]; p.BBR[gp * 16 + c] = fr * br - fi * bi; p.BBI[gp * 16 + c] = fr * bi + fi * br; }
  float pr = 1.f, pi = 0.f; const int st = gp & 63;
  for (int j = 0; j <= 16; ++j) { p.PWR[(g * 17 + j) * 64 + st] = pr; p.PWI[(g * 17 + j) * 64 + st] = pi; const float nr = pr * ar - pi * ai, ni = pr * ai + pi * ar; if (j < 16) { pr = nr; pi = ni; } }
  const float a16r = pr, a16i = pi; const float a32r = a16r * a16r - a16i * a16i, a32i = 2.f * a16r * a16i;
  const float a48r = a32r * a16r - a32i * a16i, a48i = a32r * a16i + a32i * a16r; const float a64r = a32r * a32r - a32i * a32i, a64i = 2.f * a32r * a32i;
  const float a128r = a64r * a64r - a64i * a64i, a128i = 2.f * a64r * a64i; const float a256r = a128r * a128r - a128i * a128i, a256i = 2.f * a128r * a128i;
  float* A = p.APW;
  A[0 * 4096 + gp] = a16r; A[0 * 4096 + 2048 + gp] = a16i; A[1 * 4096 + gp] = a32r; A[1 * 4096 + 2048 + gp] = a32i; A[2 * 4096 + gp] = a48r; A[2 * 4096 + 2048 + gp] = a48i;
  A[3 * 4096 + gp] = a64r; A[3 * 4096 + 2048 + gp] = a64i; A[4 * 4096 + gp] = a256r; A[4 * 4096 + 2048 + gp] = a256i;
}
__device__ void ssm_stage2a(const Params& p, int bid, int nb) {
  const int n1 = 32 * 128 * 256, n2 = 32 * 16 * 4 * 512, n3 = 32 * 16 * 256;
  for (int i = bid * NTHREADS + threadIdx.x; i < n1 + n2 + n3; i += nb * NTHREADS) {
    if (i < n1) {
      const int j = i & 7, lane = (i >> 3) & 63, ks = (i >> 9) & 7, ri = (i >> 12) & 1, w = (i >> 13) & 3, g = i >> 15;
      const int st = w * 16 + (lane & 15), k = ks * 32 + (lane >> 4) * 8 + j; const int s_ = k >> 4, ch = k & 15;
      const int gp = g * 64 + st; const float pr = p.PWR[(g * 17 + 15 - s_) * 64 + st], pi = p.PWI[(g * 17 + 15 - s_) * 64 + st]; const float br = p.BBR[gp * 16 + ch], bi = p.BBI[gp * 16 + ch];
      p.WE16[i] = f2bf(ri == 0 ? (pr * br - pi * bi) : (pr * bi + pi * br));
    } else if (i < n1 + n2) {
      const int e = i - n1; const int j = e & 7, lane = (e >> 3) & 63, ks = (e >> 9) & 3, mt = (e >> 11) & 15, g = e >> 15;
      const int t = mt, co = lane & 15, k = ks * 32 + (lane >> 4) * 8 + j;
      const int st = ((k >> 5) << 4) | (k & 15), ri = (k >> 4) & 1; const float cr = p.c_re[(g * 16 + co) * 64 + st], ci = p.c_im[(g * 16 + co) * 64 + st];
      const float pr = p.PWR[(g * 17 + t + 1) * 64 + st], pi = p.PWI[(g * 17 + t + 1) * 64 + st];
      p.WY[((size_t)(g * 16 + mt) * 12 + ks) * 512 + lane * 8 + j] = f2bf((ri == 0) ? (cr * pr - ci * pi) : -(cr * pi + ci * pr));
    } else {
      const int e = i - n1 - n2; const int cin = e & 15, co = (e >> 4) & 15, j = (e >> 8) & 15, g = e >> 12; float acc = 0.f;
      for (int st = 0; st < 64; ++st) { const float cr = p.c_re[(g * 16 + co) * 64 + st], ci = p.c_im[(g * 16 + co) * 64 + st]; const float pr = p.PWR[(g * 17 + j) * 64 + st], pi = p.PWI[(g * 17 + j) * 64 + st];
        const float br = p.BBR[(g * 64 + st) * 16 + cin], bi = p.BBI[(g * 64 + st) * 16 + cin]; acc += cr * (pr * br - pi * bi) - ci * (pr * bi + pi * br); }
      p.KJ[e] = acc;
    }
  }
}
__device__ void ssm_stage2b(const Params& p, int bid, int nb) {
  const int n = 32 * 16 * 8 * 512;
  for (int i = bid * NTHREADS + threadIdx.x; i < n; i += nb * NTHREADS) {
    const int j = i & 7, lane = (i >> 3) & 63, ks8 = (i >> 9) & 7, mt = (i >> 12) & 15, g = i >> 16;
    const int t = mt, co = lane & 15, kk = ks8 * 32 + (lane >> 4) * 8 + j; const int s_ = kk >> 4, cin = kk & 15;
    const float val = (s_ <= t) ? p.KJ[((g * 16 + (t - s_)) * 16 + co) * 16 + cin] : 0.f;
    p.WY[((size_t)(g * 16 + mt) * 12 + 4 + ks8) * 512 + lane * 8 + j] = f2bf(val);
  }
}

#define EPI_IDS const int tid = threadIdx.x, lane = tid & 63, w = tid >> 6, wr = w >> 1, wc = w & 1, fr = lane & 15, fq = lane >> 4; (void)wr; (void)wc; (void)fr; (void)fq;

__device__ void tile_win_v(const Params& p, int tile, char* lds) {
  const int rt = tile >> 4, ct = tile & 15; const int row0 = rt * 128, col0 = ct * 128;
  f32x4 acc[4][4];
  gemm_mainloop<false, true, true>(acc, p.XB, 1024, p.WtIn, 1024, 1024, row0, col0, lds, nullptr, nullptr, 0);
  EPI_IDS
  const int head = (col0 + wc * 64 - 1024) >> 6;
#pragma unroll
  for (int m = 0; m < 4; ++m) {
    const int row = row0 + wr * 64 + m * 16 + fq * 4; const f32x4 rsx = *(const f32x4*)(p.rs_x + row); const int b = row >> 13, tb = row & 8191;
#pragma unroll
    for (int n = 0; n < 4; ++n) { const f32x4 v = acc[m][n] * rsx;
      *(uint2*)(p.VT + ((size_t)(b * 8 + head) * 64 + n * 16 + fr) * SEQL + tb) = make_uint2(pack2(v[0], v[1]), pack2(v[2], v[3])); }
  }
}
__device__ void tile_win(const Params& p, int tile, char* lds) {
  const int rt = tile >> 4, ct = tile & 15; const int row0 = rt * 128, col0 = ct * 128;
  f32x4 acc[4][4];
  gemm_mainloop<false>(acc, p.XB, 1024, p.WtIn, 1024, 1024, row0, col0, lds, nullptr, nullptr, 0);
  EPI_IDS
  const int cw = col0 + wc * 64;
#pragma unroll
  for (int m = 0; m < 4; ++m) {
    const int row = row0 + wr * 64 + m * 16 + fr; const float rsx = p.rs_x[row];
    if (cw < 1024) {
      float ss = 0.f;
#pragma unroll
      for (int n = 0; n < 4; ++n)
#pragma unroll
        for (int j = 0; j < 4; ++j) { const float v = acc[m][n][j] * rsx; acc[m][n][j] = v; ss += v * v; }
      ss += __shfl_xor(ss, 16); ss += __shfl_xor(ss, 32);
      const float rs = rsqrtf(ss * (1.0f / 64.0f) + EPSF) * (cw < 512 ? 0.125f : 1.0f);
      const float* g = (cw < 512) ? p.att_q_g : p.att_k_g; bf16_t* dst = (cw < 512 ? p.Qb : p.Kb) + (size_t)row * 512 + (cw & 511);
#pragma unroll
      for (int n = 0; n < 4; ++n) { const int c = n * 16 + fq * 4; const float4 gg = *(const float4*)(g + c);
        *(uint2*)(dst + c) = make_uint2(pack2(acc[m][n][0] * rs * gg.x, acc[m][n][1] * rs * gg.y), pack2(acc[m][n][2] * rs * gg.z, acc[m][n][3] * rs * gg.w)); }
    } else if (cw < 1536) {
      const int head = (cw - 1024) >> 6; const int b = row >> 13, tb = row & 8191;
      bf16_t* dst = p.VT + ((size_t)(b * 8 + head) * 64) * SEQL + tb;
#pragma unroll
      for (int n = 0; n < 4; ++n)
#pragma unroll
        for (int j = 0; j < 4; ++j) dst[(size_t)(n * 16 + fq * 4 + j) * SEQL] = f2bf(acc[m][n][j] * rsx);
    } else {
      const int b = row >> 13, tb = row & 8191;
#pragma unroll
      for (int n = 0; n < 4; ++n) { const int g = ((cw - 1536) >> 4) + n;
        *(uint2*)(p.Ub + ((size_t)(b * 32 + g) * SEQL + tb) * 16 + fq * 4) = make_uint2(pack2(acc[m][n][0] * rsx, acc[m][n][1] * rsx), pack2(acc[m][n][2] * rsx, acc[m][n][3] * rsx)); }
    }
  }
}
__device__ void tile_memkv(const Params& p, int tile, char* lds) {
  const int which = tile >> 5, t2 = tile & 31; const int rt = t2 >> 3, ct = t2 & 7; const int row0 = rt * 128, col0 = ct * 128;
  f32x4 acc[4][4];
  gemm_mainloop<false>(acc, p.MEMB, 1024, which ? p.WtMv : p.WtMk, 1024, 1024, row0, col0, lds, nullptr, nullptr, 0);
  EPI_IDS
  const int cw = col0 + wc * 64;
#pragma unroll
  for (int m = 0; m < 4; ++m) {
    const int row = row0 + wr * 64 + m * 16 + fr; const float rsm = p.rs_mem[row];
    if (which == 0) {
      float ss = 0.f;
#pragma unroll
      for (int n = 0; n < 4; ++n) { f32x4 v = acc[m][n] * rsm; ss += v[0] * v[0] + v[1] * v[1] + v[2] * v[2] + v[3] * v[3]; *(f32x4*)(p.KMraw + (size_t)row * 1024 + cw + n * 16 + fq * 4) = v; }
      ss += __shfl_xor(ss, 16); ss += __shfl_xor(ss, 32);
      if (fq == 0) p.ss_km[row * 16 + (cw >> 6)] = ss;
    } else {
      const int b = row >> 8, key = row & 255; const int head = cw >> 8; const int d0 = (cw & 255);
      bf16_t* dst = p.VMT + ((size_t)(b * 4 + head) * 256) * 256 + key;
#pragma unroll
      for (int n = 0; n < 4; ++n)
#pragma unroll
        for (int j = 0; j < 4; ++j) dst[(size_t)(d0 + n * 16 + fq * 4 + j) * 256] = f2bf(acc[m][n][j] * rsm);
    }
  }
}
__device__ void memk_fix(const Params& p, int bid, int nb) {
  for (int i = bid * NTHREADS + threadIdx.x; i < 512 * 1024 / 4; i += nb * NTHREADS) {
    const int row = i >> 8, c4 = (i & 255) * 4; const int head = c4 >> 8, d = c4 & 255;
    const float ss = p.ss_km[row * 16 + head * 4] + p.ss_km[row * 16 + head * 4 + 1] + p.ss_km[row * 16 + head * 4 + 2] + p.ss_km[row * 16 + head * 4 + 3];
    const float rs = rsqrtf(ss * (1.0f / 256.0f) + EPSF);
    const float4 v = *(const float4*)(p.KMraw + (size_t)row * 1024 + c4); const float4 gk = *(const float4*)(p.mem_k_g + d), gq = *(const float4*)(p.mem_q_g + d);
    const int b = row >> 8, key = row & 255;
    *(uint2*)(p.KMB + ((size_t)(b * 4 + head) * 256 + key) * 256 + d) = make_uint2(pack2(v.x * rs * gk.x * gq.x, v.y * rs * gk.y * gq.y), pack2(v.z * rs * gk.z * gq.z, v.w * rs * gk.w * gq.w));
  }
}

__device__ void chunk_attn_item(const Params& p, int item, char* lds_) {
  LAS char* lds = (LAS char*)lds_; LAS float* rb = (LAS float*)(lds + 32768);
  typedef unsigned u32x2 __attribute__((ext_vector_type(2)));
  const int h = item & 7, cn = (item >> 3) & 127, b = item >> 10;
  const int tid = threadIdx.x, lane = tid & 63, w = tid >> 6, fr = lane & 15, fq = lane >> 4;
  const int iq = w * 16 + fr; const int tq = b * SEQL + cn * 64 + iq;
  const int cstart = (cn >= 8) ? 0 : (8 - cn);
  const bf16_t* vtb = p.VT + ((size_t)(b * 8 + h) * 64) * SEQL;
  const int r0 = tid >> 3, ch = tid & 7;
  u32x4 kr[2], vr[2];
  { const int kc0 = (cn - 8 + cstart) * 64;
#pragma unroll
    for (int i = 0; i < 2; ++i) { kr[i] = *(const u32x4*)(p.Kb + (size_t)(b * SEQL + kc0 + r0 + 32 * i) * 512 + h * 64 + ch * 8); vr[i] = *(const u32x4*)(vtb + (size_t)(r0 + 32 * i) * SEQL + kc0 + ch * 8); } }
  bf16x8 qf[2];
  qf[0] = *(const bf16x8*)(p.Qb + (size_t)tq * 512 + h * 64 + fq * 8); qf[1] = *(const bf16x8*)(p.Qb + (size_t)tq * 512 + h * 64 + 32 + fq * 8);
  __syncthreads();
  if (tid < 192) rb[tid] = p.rel_bias[h * 192 + tid];
#pragma unroll
  for (int i = 0; i < 2; ++i) { const int r = r0 + 32 * i; *(LAS u32x4*)(lds + r * 128 + ((ch ^ (r & 7)) << 4)) = kr[i]; *(LAS u32x4*)(lds + 8192 + r * 128 + ((ch ^ ((r >> 1) & 7)) << 4)) = vr[i]; }
  __syncthreads();
  f32x4 o[4]; for (int i = 0; i < 4; ++i) o[i] = (f32x4){0.f, 0.f, 0.f, 0.f};
  float mrun = -1e30f, lrun = 0.f;
  for (int c = cstart; c <= 8; ++c) {
    LAS char* cur = lds + ((c - cstart) & 1) * 16384; LAS char* nxt = lds + ((c - cstart + 1) & 1) * 16384;
    const bool more = c < 8;
    if (more) { const int kc1 = (cn - 8 + c + 1) * 64;
#pragma unroll
      for (int i = 0; i < 2; ++i) { kr[i] = *(const u32x4*)(p.Kb + (size_t)(b * SEQL + kc1 + r0 + 32 * i) * 512 + h * 64 + ch * 8); vr[i] = *(const u32x4*)(vtb + (size_t)(r0 + 32 * i) * SEQL + kc1 + ch * 8); } }
    f32x4 st[4];
#pragma unroll
    for (int mt = 0; mt < 4; ++mt) { const int row = mt * 16 + fr; f32x4 sacc = (f32x4){0.f, 0.f, 0.f, 0.f};
      sacc = mfma16(as_bf(*(const LAS u32x4*)(cur + row * 128 + ((fq ^ (row & 7)) << 4))), qf[0], sacc);
      sacc = mfma16(as_bf(*(const LAS u32x4*)(cur + row * 128 + (((4 + fq) ^ (row & 7)) << 4))), qf[1], sacc); st[mt] = sacc; }
    float tmax = -1e30f;
#pragma unroll
    for (int mt = 0; mt < 4; ++mt)
#pragma unroll
      for (int j = 0; j < 4; ++j) { const int jk = mt * 16 + fq * 4 + j; int dist = 512 - 64 * c + iq - jk; dist = dist < -63 ? -63 : (dist > 128 ? 128 : dist);
        const float sv = st[mt][j] + rb[dist + 63]; st[mt][j] = sv; tmax = fmaxf(tmax, sv); }
    tmax = fmaxf(tmax, __shfl_xor(tmax, 16)); tmax = fmaxf(tmax, __shfl_xor(tmax, 32));
    const float mnew = fmaxf(mrun, tmax); const float alpha = __expf(mrun - mnew); mrun = mnew;
    float ls = 0.f;
#pragma unroll
    for (int mt = 0; mt < 4; ++mt)
#pragma unroll
      for (int j = 0; j < 4; ++j) { const float pv = __expf(st[mt][j] - mnew); st[mt][j] = pv; ls += pv; }
    lrun = lrun * alpha + ls;
    bf16x8 pf[2];
#pragma unroll
    for (int s2 = 0; s2 < 2; ++s2) { u32x4 t; t.x = pack2(st[2 * s2][0], st[2 * s2][1]); t.y = pack2(st[2 * s2][2], st[2 * s2][3]); t.z = pack2(st[2 * s2 + 1][0], st[2 * s2 + 1][1]); t.w = pack2(st[2 * s2 + 1][2], st[2 * s2 + 1][3]); pf[s2] = as_bf(t); }
#pragma unroll
    for (int dt = 0; dt < 4; ++dt) { const int d = dt * 16 + fr; const int sw = ((d >> 1) & 7) << 1; f32x4 oc = o[dt] * alpha;
#pragma unroll
      for (int s2 = 0; s2 < 2; ++s2) {
        const u32x2 lo = *(const LAS u32x2*)(cur + 8192 + d * 128 + (((s2 * 8 + fq) ^ sw) << 3)), hi = *(const LAS u32x2*)(cur + 8192 + d * 128 + (((s2 * 8 + fq + 4) ^ sw) << 3));
        u32x4 vv; vv.x = lo.x; vv.y = lo.y; vv.z = hi.x; vv.w = hi.y; oc = mfma16(as_bf(vv), pf[s2], oc); }
      o[dt] = oc; }
    if (more) {
#pragma unroll
      for (int i = 0; i < 2; ++i) { const int r = r0 + 32 * i; *(LAS u32x4*)(nxt + r * 128 + ((ch ^ (r & 7)) << 4)) = kr[i]; *(LAS u32x4*)(nxt + 8192 + r * 128 + ((ch ^ ((r >> 1) & 7)) << 4)) = vr[i]; }
    }
    __syncthreads();
  }
  float lt = lrun; lt += __shfl_xor(lt, 16); lt += __shfl_xor(lt, 32);
  const float inv = 1.0f / lt; float ss = 0.f;
  bf16_t* dst = p.ATT + (size_t)tq * 512 + h * 64;
#pragma unroll
  for (int dt = 0; dt < 4; ++dt) { const f32x4 v = o[dt] * inv; ss += v[0] * v[0] + v[1] * v[1] + v[2] * v[2] + v[3] * v[3];
    *(uint2*)(dst + dt * 16 + fq * 4) = make_uint2(pack2(v[0], v[1]), pack2(v[2], v[3])); }
  ss += __shfl_xor(ss, 16); ss += __shfl_xor(ss, 32);
  if (fq == 0) p.ss_att[tq * 8 + h] = ss;
}

template <bool FINAL>
__device__ void ssm_item(const Params& p, int item, char* lds) {
  const int g = item & 31, seg = (item >> 5) & 31, b = item >> 10;
  const int tid = threadIdx.x, lane = tid & 63, w = tid >> 6, fr = lane & 15, fq = lane >> 4;
  const int t0 = b * SEQL + seg * 256;
  const bf16_t* ug = p.Ub + ((size_t)(b * 32 + g) * SEQL + seg * 256) * 16;
  bf16x8 uf[8];
#pragma unroll
  for (int ks = 0; ks < 8; ++ks) uf[ks] = *(const bf16x8*)(ug + (size_t)(fr * 16 + 2 * ks + (fq >> 1)) * 16 + (fq & 1) * 8);
  f32x4 er = (f32x4){0.f, 0.f, 0.f, 0.f}, ei = er;
  const bf16_t* we = p.WE16 + ((size_t)(g * 4 + w) * 2 * 8 * 64 + lane) * 8;
#pragma unroll
  for (int ks = 0; ks < 8; ++ks) { const bf16x8 br = *(const bf16x8*)(we + ks * 512), bi = *(const bf16x8*)(we + 4096 + ks * 512); er = mfma16(uf[ks], br, er); ei = mfma16(uf[ks], bi, ei); }
  const int gp = g * 64 + w * 16 + fr;
  const float a16r = p.APW[gp], a16i = p.APW[2048 + gp];
  float xr[4], xi[4];
  xr[0] = er[0]; xi[0] = ei[0];
#pragma unroll
  for (int j = 1; j < 4; ++j) { xr[j] = a16r * xr[j - 1] - a16i * xi[j - 1] + er[j]; xi[j] = a16r * xi[j - 1] + a16i * xr[j - 1] + ei[j]; }
  float cr = 0.f, ci = 0.f;
  if (FINAL) {
    const float ar = p.APW[4 * 4096 + gp], ai = p.APW[4 * 4096 + 2048 + gp];
    const float* es = p.ESEG + ((size_t)(b * 32) * 32 + g) * 128 + w * 32 + fr;
    for (int j0 = 0; j0 < seg; j0 += 8) { float e_r[8], e_i[8];
#pragma unroll
      for (int u = 0; u < 8; ++u) { e_r[u] = es[(size_t)(j0 + u) * 32 * 128]; e_i[u] = es[(size_t)(j0 + u) * 32 * 128 + 16]; }
#pragma unroll
      for (int u = 0; u < 8; ++u) if (j0 + u < seg) { const float nr = ar * cr - ai * ci + e_r[u], ni = ar * ci + ai * cr + e_i[u]; cr = nr; ci = ni; } }
  }
  const float a64r = p.APW[3 * 4096 + gp], a64i = p.APW[3 * 4096 + 2048 + gp];
  float tr = xr[3], ti = xi[3];
#pragma unroll
  for (int r = 0; r < 4; ++r) {
    float pr_ = __shfl(tr, (lane + 48) & 63), pi_ = __shfl(ti, (lane + 48) & 63);
    if (r == 0) { pr_ = cr; pi_ = ci; }
    if (fq == r) { const float nr = xr[3] + a64r * pr_ - a64i * pi_, ni = xi[3] + a64r * pi_ + a64i * pr_; tr = nr; ti = ni; }
  }
  if (!FINAL) {
    if (fq == 3) { float* es = p.ESEG + ((size_t)(b * 32 + seg) * 32 + g) * 128 + w * 32 + fr; es[0] = tr; es[16] = ti; }
    return;
  }
  float gr = __shfl(tr, (lane + 48) & 63), gi = __shfl(ti, (lane + 48) & 63);
  if (fq == 0) { gr = cr; gi = ci; }
  float pvr[4], pvi[4];
  pvr[0] = gr; pvi[0] = gi;
#pragma unroll
  for (int j = 1; j < 4; ++j) { const float ar = p.APW[(j - 1) * 4096 + gp], ai = p.APW[(j - 1) * 4096 + 2048 + gp]; pvr[j] = xr[j - 1] + ar * gr - ai * gi; pvi[j] = xi[j - 1] + ar * gi + ai * gr; }
  bf16_t* xl = (bf16_t*)lds;
  __syncthreads();
#pragma unroll
  for (int j = 0; j < 4; ++j) { xl[(fq * 4 + j) * 136 + w * 32 + fr] = f2bf(pvr[j]); xl[(fq * 4 + j) * 136 + w * 32 + 16 + fr] = f2bf(pvi[j]); }
  __syncthreads();
  bf16x8 xf[4];
#pragma unroll
  for (int ks = 0; ks < 4; ++ks) xf[ks] = *(const bf16x8*)(xl + fr * 136 + ks * 32 + fq * 8);
#pragma unroll
  for (int mi = 0; mi < 4; ++mi) {
    const int mt = w * 4 + mi;
    const bf16_t* wy = p.WY + ((size_t)(g * 16 + mt) * 12 * 64 + lane) * 8;
    f32x4 y = (f32x4){0.f, 0.f, 0.f, 0.f};
#pragma unroll
    for (int ks = 0; ks < 4; ++ks) y = mfma16(*(const bf16x8*)(wy + ks * 512), xf[ks], y);
#pragma unroll
    for (int ks = 0; ks < 8; ++ks) if (2 * ks <= mt) y = mfma16(*(const bf16x8*)(wy + (4 + ks) * 512), uf[ks], y);
    const size_t tok = (size_t)(t0 + fr * 16 + mt);
    const uint2 uu = *(const uint2*)(ug + (size_t)(fr * 16 + mt) * 16 + fq * 4);
    const float4 dd = *(const float4*)(p.d_skip + g * 16 + fq * 4);
    const float y0 = gelu_f(y[0] + dd.x * __uint_as_float(uu.x << 16)), y1 = gelu_f(y[1] + dd.y * __uint_as_float(uu.x & 0xffff0000u));
    const float y2 = gelu_f(y[2] + dd.z * __uint_as_float(uu.y << 16)), y3 = gelu_f(y[3] + dd.w * __uint_as_float(uu.y & 0xffff0000u));
    *(uint2*)(p.YG + tok * 512 + g * 16 + fq * 4) = make_uint2(pack2(y0, y1), pack2(y2, y3));
  }
}

__device__ void tile_glu(const Params& p, int tile, char* lds) {
  const int rt = tile >> 2, ct = tile & 3; const int row0 = rt * 128, col0 = ct * 128;
  f32x4 acc[4][4];
  gemm_mainloop<false>(acc, p.YG, 512, p.WtGlu, 512, 512, row0, col0, lds, nullptr, nullptr, 0);
  EPI_IDS
  const int cw = col0 + wc * 64;
#pragma unroll
  for (int m = 0; m < 4; ++m) {
    const int row = row0 + wr * 64 + m * 16 + fr; float ss = 0.f;
#pragma unroll
    for (int n = 0; n < 4; ++n) { const int c = cw + n * 16 + fq * 4; const float4 bg = *(const float4*)(p.b_glu + c); const uint2 yy = *(const uint2*)(p.YG + (size_t)row * 512 + c);
      const float y0 = __uint_as_float(yy.x << 16), y1 = __uint_as_float(yy.x & 0xffff0000u), y2 = __uint_as_float(yy.y << 16), y3 = __uint_as_float(yy.y & 0xffff0000u);
      const float o0 = y0 / (1.f + __expf(-(acc[m][n][0] + bg.x))), o1 = y1 / (1.f + __expf(-(acc[m][n][1] + bg.y))), o2 = y2 / (1.f + __expf(-(acc[m][n][2] + bg.z))), o3 = y3 / (1.f + __expf(-(acc[m][n][3] + bg.w)));
      ss += o0 * o0 + o1 * o1 + o2 * o2 + o3 * o3;
      *(uint2*)(p.SSMO + (size_t)row * 512 + c) = make_uint2(pack2(o0, o1), pack2(o2, o3)); }
    ss += __shfl_xor(ss, 16); ss += __shfl_xor(ss, 32);
    if (fq == 0) p.ss_ssm[row * 8 + (cw >> 6)] = ss;
  }
}
__device__ void tile_wout(const Params& p, int tile, char* lds) {
  const int rt = tile >> 3, ct = tile & 7; const int row0 = rt * 128, col0 = ct * 128;
  f32x4 acc[4][4];
  float s0[4], s1[4];
  { const int sr = threadIdx.x >> 3;
#pragma unroll
    for (int i = 0; i < 4; ++i) { const int row = row0 + sr + 32 * i; float a = 0.f, c = 0.f;
#pragma unroll
      for (int j = 0; j < 8; ++j) { a += p.ss_att[row * 8 + j]; c += p.ss_ssm[row * 8 + j]; }
      s0[i] = rsqrtf(a * (1.0f / 512.0f) + EPSF); s1[i] = rsqrtf(c * (1.0f / 512.0f) + EPSF); } }
  gemm_mainloop<true, true>(acc, p.ATT, 512, p.WtOut, 1024, 512, row0, col0, lds, s0, s0, 1 << 30);
  gemm_mainloop<true, false>(acc, p.SSMO, 512, p.WtOut + 512, 1024, 512, row0, col0, lds, s1, s1, 1 << 30);
  EPI_IDS
  const int cw = col0 + wc * 64;
#pragma unroll
  for (int m = 0; m < 4; ++m) {
    const int row = row0 + wr * 64 + m * 16 + fr; float ss = 0.f;
#pragma unroll
    for (int n = 0; n < 4; ++n) { const int c = cw + n * 16 + fq * 4; const f32x4 xv = *(const f32x4*)(p.x + (size_t)row * 1024 + c); const f32x4 hv = xv + acc[m][n];
      ss += hv[0] * hv[0] + hv[1] * hv[1] + hv[2] * hv[2] + hv[3] * hv[3];
      *(uint2*)(p.H1B + (size_t)row * 1024 + c) = make_uint2(pack2(hv[0], hv[1]), pack2(hv[2], hv[3])); }
    ss += __shfl_xor(ss, 16); ss += __shfl_xor(ss, 32);
    if (fq == 0) p.ss_h1[row * 16 + (cw >> 6)] = ss;
  }
}
__device__ __forceinline__ float row_rs16(const float* ss, int row) { float a = 0.f;
#pragma unroll
  for (int j = 0; j < 16; ++j) a += ss[row * 16 + j];
  return rsqrtf(a * (1.0f / 1024.0f) + EPSF); }
__device__ void tile_memq(const Params& p, int tile, char* lds) {
  const int rt = tile >> 3, ct = tile & 7; const int row0 = rt * 128, col0 = ct * 128;
  f32x4 acc[4][4];
  gemm_mainloop<false>(acc, p.H1B, 1024, p.WtMq, 1024, 1024, row0, col0, lds, nullptr, nullptr, 0);
  EPI_IDS
  const int cw = col0 + wc * 64;
#pragma unroll
  for (int m = 0; m < 4; ++m) {
    const int row = row0 + wr * 64 + m * 16 + fr; const float rs = row_rs16(p.ss_h1, row); float ss = 0.f;
#pragma unroll
    for (int n = 0; n < 4; ++n) { const int c = cw + n * 16 + fq * 4; const f32x4 v = acc[m][n] * rs; ss += v[0] * v[0] + v[1] * v[1] + v[2] * v[2] + v[3] * v[3];
      *(uint2*)(p.QM + (size_t)row * 1024 + c) = make_uint2(pack2(v[0], v[1]), pack2(v[2], v[3])); }
    ss += __shfl_xor(ss, 16); ss += __shfl_xor(ss, 32);
    if (fq == 0) p.ss_qm[row * 16 + (cw >> 6)] = ss;
  }
}
__device__ void mem_attn_item(const Params& p, int item, char* lds_) {
  LAS char* lds = (LAS char*)lds_;
  const int h = item & 3, tt = item >> 2; const int tid = threadIdx.x, lane = tid & 63, w = tid >> 6, fr = lane & 15, fq = lane >> 4;
  const int tq = tt * 64 + w * 16 + fr; const int b = tq >> 13;
  const float ssq = p.ss_qm[tq * 16 + h * 4] + p.ss_qm[tq * 16 + h * 4 + 1] + p.ss_qm[tq * 16 + h * 4 + 2] + p.ss_qm[tq * 16 + h * 4 + 3];
  const float rowscale = rsqrtf(ssq * (1.0f / 256.0f) + EPSF) * 0.0625f;
  bf16x8 qf[8];
#pragma unroll
  for (int ks = 0; ks < 8; ++ks) qf[ks] = *(const bf16x8*)(p.QM + (size_t)tq * 1024 + h * 256 + ks * 32 + fq * 8);
  const bf16_t* kg = p.KMB + (size_t)(b * 4 + h) * 256 * 256;
  const bf16_t* vg = p.VMT + (size_t)(b * 4 + h) * 256 * 256;
  f32x4 o[16];
#pragma unroll
  for (int i = 0; i < 16; ++i) o[i] = (f32x4){0.f, 0.f, 0.f, 0.f};
  float mrun = -1e30f, lrun = 0.f;
  for (int kc = 0; kc < 4; ++kc) {
    __syncthreads();
#pragma unroll
    for (int i = 0; i < 8; ++i) { const int idx = tid + 256 * i; const int row = idx >> 5, ch = idx & 31;
      const u32x4 v = *(const u32x4*)(kg + (size_t)(kc * 64 + row) * 256 + ch * 8); *(LAS u32x4*)(lds + row * 512 + ((ch ^ (row & 15)) << 4)) = v; }
#pragma unroll
    for (int i = 0; i < 8; ++i) { const int idx = tid + 256 * i; const int d = idx >> 3, j = idx & 7;
      const u32x4 v = *(const u32x4*)(vg + (size_t)d * 256 + kc * 64 + j * 8); *(LAS u32x4*)(lds + 32768 + d * 128 + ((j ^ ((d >> 1) & 7)) << 4)) = v; }
    __syncthreads();
    f32x4 st[4];
#pragma unroll
    for (int mt = 0; mt < 4; ++mt) { f32x4 sacc = (f32x4){0.f, 0.f, 0.f, 0.f}; const int row = mt * 16 + fr;
#pragma unroll
      for (int ks = 0; ks < 8; ++ks) sacc = mfma16(as_bf(*(const LAS u32x4*)(lds + row * 512 + (((ks * 4 + fq) ^ (row & 15)) << 4))), qf[ks], sacc);
      st[mt] = sacc * rowscale; }
    float tmax = -1e30f;
#pragma unroll
    for (int mt = 0; mt < 4; ++mt) tmax = fmaxf(fmaxf(fmaxf(tmax, st[mt][0]), fmaxf(st[mt][1], st[mt][2])), st[mt][3]);
    tmax = fmaxf(tmax, __shfl_xor(tmax, 16)); tmax = fmaxf(tmax, __shfl_xor(tmax, 32));
    const float mnew = fmaxf(mrun, tmax); const float alpha = __expf(mrun - mnew); mrun = mnew;
    float ls = 0.f;
#pragma unroll
    for (int mt = 0; mt < 4; ++mt)
#pragma unroll
      for (int j = 0; j < 4; ++j) { const float e = __expf(st[mt][j] - mnew); st[mt][j] = e; ls += e; }
    lrun = lrun * alpha + ls;
    bf16x8 pf[2];
#pragma unroll
    for (int s2 = 0; s2 < 2; ++s2) { u32x4 t; t.x = pack2(st[2 * s2][0], st[2 * s2][1]); t.y = pack2(st[2 * s2][2], st[2 * s2][3]); t.z = pack2(st[2 * s2 + 1][0], st[2 * s2 + 1][1]); t.w = pack2(st[2 * s2 + 1][2], st[2 * s2 + 1][3]); pf[s2] = as_bf(t); }
#pragma unroll
    for (int dt = 0; dt < 16; ++dt) { const int d = dt * 16 + fr; const int sw = ((d >> 1) & 7) << 1; f32x4 oc = o[dt] * alpha;
#pragma unroll
      for (int s2 = 0; s2 < 2; ++s2) { typedef unsigned u32x2 __attribute__((ext_vector_type(2)));
        const u32x2 lo = *(const LAS u32x2*)(lds + 32768 + d * 128 + (((s2 * 8 + fq) ^ sw) << 3)), hi = *(const LAS u32x2*)(lds + 32768 + d * 128 + (((s2 * 8 + fq + 4) ^ sw) << 3));
        u32x4 vv; vv.x = lo.x; vv.y = lo.y; vv.z = hi.x; vv.w = hi.y; oc = mfma16(as_bf(vv), pf[s2], oc); }
      o[dt] = oc; }
  }
  float lt = lrun; lt += __shfl_xor(lt, 16); lt += __shfl_xor(lt, 32);
  const float inv = 1.0f / lt;
  bf16_t* dst = p.OM + (size_t)tq * 1024 + h * 256;
#pragma unroll
  for (int dt = 0; dt < 16; ++dt) { const f32x4 v = o[dt] * inv; *(uint2*)(dst + dt * 16 + fq * 4) = make_uint2(pack2(v[0], v[1]), pack2(v[2], v[3])); }
}
__device__ void tile_memo(const Params& p, int tile, char* lds) {
  const int rt = tile >> 3, ct = tile & 7; const int row0 = rt * 128, col0 = ct * 128;
  f32x4 acc[4][4];
  gemm_mainloop<false>(acc, p.OM, 1024, p.WtMo, 1024, 1024, row0, col0, lds, nullptr, nullptr, 0);
  EPI_IDS
  const int cw = col0 + wc * 64;
#pragma unroll
  for (int m = 0; m < 4; ++m) {
    const int row = row0 + wr * 64 + m * 16 + fr; float ss = 0.f;
#pragma unroll
    for (int n = 0; n < 4; ++n) { const int c = cw + n * 16 + fq * 4; const uint2 hb = *(const uint2*)(p.H1B + (size_t)row * 1024 + c);
      const f32x4 hv = (f32x4){__uint_as_float(hb.x << 16), __uint_as_float(hb.x & 0xffff0000u), __uint_as_float(hb.y << 16), __uint_as_float(hb.y & 0xffff0000u)} + acc[m][n];
      ss += hv[0] * hv[0] + hv[1] * hv[1] + hv[2] * hv[2] + hv[3] * hv[3];
      *(uint2*)(p.H2B + (size_t)row * 1024 + c) = make_uint2(pack2(hv[0], hv[1]), pack2(hv[2], hv[3])); }
    ss += __shfl_xor(ss, 16); ss += __shfl_xor(ss, 32);
    if (fq == 0) p.ss_h2[row * 16 + (cw >> 6)] = ss;
  }
}
__device__ void tile_peerq(const Params& p, int tile, char* lds) {
  const int rt = tile >> 4, ct = tile & 15; const int row0 = rt * 128, col0 = ct * 128;
  f32x4 acc[4][4];
  gemm_mainloop<false>(acc, p.H2B, 1024, p.WtPq, 1024, 1024, row0, col0, lds, nullptr, nullptr, 0);
  EPI_IDS
  const int cw = col0 + wc * 64;
#pragma unroll
  for (int m = 0; m < 4; ++m) {
    const int row = row0 + wr * 64 + m * 16 + fr; const float rs = row_rs16(p.ss_h2, row);
#pragma unroll
    for (int n = 0; n < 4; ++n) { const int c = cw + n * 16 + fq * 4; const f32x4 v = acc[m][n] * rs;
      *(uint2*)(p.QP + (size_t)row * 2048 + c) = make_uint2(pack2(v[0], v[1]), pack2(v[2], v[3])); }
  }
}
__device__ __forceinline__ void ins16(float (&a)[16], float v) {
#pragma unroll
  for (int i = 0; i < 16; ++i) { const float hi = fmaxf(a[i], v), lo = fminf(a[i], v); a[i] = hi; v = lo; }
}
__device__ void tile_scores(const Params& p, int tile, char* lds) {
  const int rt = tile >> 4, hs = tile & 15; const int row0 = rt * 128;
  f32x4 acc[4][4];
  gemm_mainloop<false>(acc, p.QP + hs * 128, 2048, p.PK + (size_t)hs * 128 * 128, 128, 128, row0, 0, lds, nullptr, nullptr, 0);
  EPI_IDS
  float* tl = (float*)lds;
#pragma unroll
  for (int m = 0; m < 4; ++m)
#pragma unroll
    for (int n = 0; n < 4; ++n)
#pragma unroll
      for (int j = 0; j < 4; ++j) tl[(wr * 64 + m * 16 + fr) * 129 + wc * 64 + n * 16 + fq * 4 + j] = acc[m][n][j];
  __syncthreads();
  if (tid < 128) {
    float a[16];
#pragma unroll
    for (int i = 0; i < 16; ++i) a[i] = -__builtin_inff();
    for (int n = 0; n < 128; ++n) { const float v = __uint_as_float((__float_as_uint(tl[tid * 129 + n]) & ~127u) | (unsigned)n); ins16(a, v); }
    uint4* dst = (uint4*)(p.TOPS + ((size_t)(row0 + tid) * 16 + hs) * 16);
    dst[0] = make_uint4(__float_as_uint(a[0]), __float_as_uint(a[1]), __float_as_uint(a[2]), __float_as_uint(a[3]));
    dst[1] = make_uint4(__float_as_uint(a[4]), __float_as_uint(a[5]), __float_as_uint(a[6]), __float_as_uint(a[7]));
    dst[2] = make_uint4(__float_as_uint(a[8]), __float_as_uint(a[9]), __float_as_uint(a[10]), __float_as_uint(a[11]));
    dst[3] = make_uint4(__float_as_uint(a[12]), __float_as_uint(a[13]), __float_as_uint(a[14]), __float_as_uint(a[15]));
  }
}
__device__ void peer_gather_item(const Params& p, int item, char* lds) {
  const int tid = threadIdx.x, lane = tid & 63, w = tid >> 6;
  unsigned* LA = (unsigned*)lds;
  int* LE = (int*)(lds + 256 * 33 * 4);
  float* LG = (float*)(lds + 256 * 33 * 4 + 32 * 128 * 4);
  __syncthreads();
  {
    const int tl_ = tid >> 3, h = tid & 7; const int t = item * 32 + tl_;
    const uint4* src = (const uint4*)(p.TOPS + ((size_t)t * 16 + h * 2) * 16);
    float a[16], bq[16];
#pragma unroll
    for (int i = 0; i < 4; ++i) { const uint4 v = src[i]; a[4 * i] = __uint_as_float(v.x); a[4 * i + 1] = __uint_as_float(v.y); a[4 * i + 2] = __uint_as_float(v.z); a[4 * i + 3] = __uint_as_float(v.w); }
#pragma unroll
    for (int i = 0; i < 4; ++i) { const uint4 v = src[4 + i]; bq[4 * i] = __uint_as_float(v.x); bq[4 * i + 1] = __uint_as_float(v.y); bq[4 * i + 2] = __uint_as_float(v.z); bq[4 * i + 3] = __uint_as_float(v.w); }
#pragma unroll
    for (int i = 0; i < 16; ++i) { LA[tid * 33 + i] = __float_as_uint(a[i]); LA[tid * 33 + 16 + i] = __float_as_uint(bq[i]); }
    float c[16];
#pragma unroll
    for (int i = 0; i < 16; ++i) c[i] = -__builtin_inff();
#pragma unroll
    for (int i = 0; i < 16; ++i)
#pragma unroll
      for (int j = 0; j < 16; ++j) if ((i + 1) * (j + 1) <= 16) { const float s = a[i] + bq[j]; ins16(c, __uint_as_float((__float_as_uint(s) & ~255u) | (unsigned)(i * 16 + j))); }
    const float mx = c[0]; float e[16]; float sum = 0.f;
#pragma unroll
    for (int i = 0; i < 16; ++i) { e[i] = __expf(c[i] - mx); sum += e[i]; }
    const float inv = 1.0f / sum;
#pragma unroll
    for (int i = 0; i < 16; ++i) { const unsigned pos = __float_as_uint(c[i]) & 255u; const unsigned ia = LA[tid * 33 + (pos >> 4)] & 127u, ib = LA[tid * 33 + 16 + (pos & 15u)] & 127u;
      LE[tl_ * 128 + h * 16 + i] = (int)(ia * 128u + ib); LG[tl_ * 128 + h * 16 + i] = e[i] * inv; }
  }
  __syncthreads();
  for (int ti = 0; ti < 8; ++ti) {
    const int tl_ = w * 8 + ti; const int t = item * 32 + tl_;
    const float rs = row_rs16(p.ss_h2, t);
    f32x2 hn[8], hres[8];
    { const uint4 ha = *(const uint4*)(p.H2B + (size_t)t * 1024 + lane * 16), hb = *(const uint4*)(p.H2B + (size_t)t * 1024 + lane * 16 + 8);
      const unsigned hw[8] = {ha.x, ha.y, ha.z, ha.w, hb.x, hb.y, hb.z, hb.w};
#pragma unroll
      for (int i = 0; i < 8; ++i) { hres[i].x = __uint_as_float(hw[i] << 16); hres[i].y = __uint_as_float(hw[i] & 0xffff0000u);
        const float2 g = *(const float2*)(p.norm_peer_g + lane * 16 + 2 * i); hn[i].x = hres[i].x * rs * g.x; hn[i].y = hres[i].y * rs * g.y; } }
    f32x2 oa[8];
#pragma unroll
    for (int i = 0; i < 8; ++i) oa[i] = (f32x2){0.f, 0.f};
    for (int k = 0; k < 128; k += 4) {
      int e[4]; float gg[4], scu[4], scv[4]; uint4 uq[4], vq[4];
#pragma unroll
      for (int u = 0; u < 4; ++u) { e[u] = __builtin_amdgcn_readfirstlane(LE[tl_ * 128 + k + u]); gg[u] = LG[tl_ * 128 + k + u]; }
#pragma unroll
      for (int u = 0; u < 4; ++u) { uq[u] = *(const uint4*)(p.PU8 + (size_t)e[u] * 1024 + lane * 16); vq[u] = *(const uint4*)(p.PV8 + (size_t)e[u] * 1024 + lane * 16); scu[u] = p.su[e[u]]; scv[u] = p.sv[e[u]]; }
#pragma unroll
      for (int u = 0; u < 4; ++u) {
        f32x2 d2 = (f32x2){0.f, 0.f};
        d2 += __builtin_amdgcn_cvt_pk_f32_fp8((int)uq[u].x, false) * hn[0]; d2 += __builtin_amdgcn_cvt_pk_f32_fp8((int)uq[u].x, true) * hn[1];
        d2 += __builtin_amdgcn_cvt_pk_f32_fp8((int)uq[u].y, false) * hn[2]; d2 += __builtin_amdgcn_cvt_pk_f32_fp8((int)uq[u].y, true) * hn[3];
        d2 += __builtin_amdgcn_cvt_pk_f32_fp8((int)uq[u].z, false) * hn[4]; d2 += __builtin_amdgcn_cvt_pk_f32_fp8((int)uq[u].z, true) * hn[5];
        d2 += __builtin_amdgcn_cvt_pk_f32_fp8((int)uq[u].w, false) * hn[6]; d2 += __builtin_amdgcn_cvt_pk_f32_fp8((int)uq[u].w, true) * hn[7];
        float d = d2.x + d2.y;
#pragma unroll
        for (int o = 32; o > 0; o >>= 1) d += __shfl_xor(d, o);
        const float wgt = gg[u] * gelu_f(d * scu[u]) * scv[u];
        oa[0] += __builtin_amdgcn_cvt_pk_f32_fp8((int)vq[u].x, false) * wgt; oa[1] += __builtin_amdgcn_cvt_pk_f32_fp8((int)vq[u].x, true) * wgt;
        oa[2] += __builtin_amdgcn_cvt_pk_f32_fp8((int)vq[u].y, false) * wgt; oa[3] += __builtin_amdgcn_cvt_pk_f32_fp8((int)vq[u].y, true) * wgt;
        oa[4] += __builtin_amdgcn_cvt_pk_f32_fp8((int)vq[u].z, false) * wgt; oa[5] += __builtin_amdgcn_cvt_pk_f32_fp8((int)vq[u].z, true) * wgt;
        oa[6] += __builtin_amdgcn_cvt_pk_f32_fp8((int)vq[u].w, false) * wgt; oa[7] += __builtin_amdgcn_cvt_pk_f32_fp8((int)vq[u].w, true) * wgt;
      }
    }
    float* op = p.out + (size_t)t * 1024 + lane * 16;
#pragma unroll
    for (int i = 0; i < 4; ++i) { const f32x2 a = hres[2 * i] + oa[2 * i], b = hres[2 * i + 1] + oa[2 * i + 1]; *(float4*)(op + 4 * i) = make_float4(a.x, a.y, b.x, b.y); }
  }
}

template <int PH>
__device__ __forceinline__ void run_phase(const Params& p, char* lds, int bid, int nb) {
  if (PH == 0) {
    const int nt_in = 16 * 32, nt_glu = 8 * 8, nt_out = 16 * 16, nt_m = 16 * 16, nt_pq = 16 * 32;
    const int total = nt_in + nt_glu + nt_out + 4 * nt_m + nt_pq;
    for (int t = bid; t < total; t += nb) {
      int i = t; float* tl = (float*)lds;
      if (i < nt_in) { transpose_tile(p.w_in, p.WtIn, 1024, 2048, i, p.norm_mix_g, p.norm_mix_g, 1024, tl); continue; } i -= nt_in;
      if (i < nt_glu) { transpose_tile(p.w_glu, p.WtGlu, 512, 512, i, nullptr, nullptr, 0, tl); continue; } i -= nt_glu;
      if (i < nt_out) { transpose_tile(p.w_out, p.WtOut, 1024, 1024, i, p.att_out_g, p.ssm_out_g, 512, tl); continue; } i -= nt_out;
      if (i < nt_m) { transpose_tile(p.w_mem_q, p.WtMq, 1024, 1024, i, p.norm_mem_g, p.norm_mem_g, 1024, tl); continue; } i -= nt_m;
      if (i < nt_m) { transpose_tile(p.w_mem_k, p.WtMk, 1024, 1024, i, p.norm_memkv_g, p.norm_memkv_g, 1024, tl); continue; } i -= nt_m;
      if (i < nt_m) { transpose_tile(p.w_mem_v, p.WtMv, 1024, 1024, i, p.norm_memkv_g, p.norm_memkv_g, 1024, tl); continue; } i -= nt_m;
      if (i < nt_m) { transpose_tile(p.w_mem_o, p.WtMo, 1024, 1024, i, nullptr, nullptr, 0, tl); continue; } i -= nt_m;
      transpose_tile(p.w_peer_q, p.WtPq, 1024, 2048, i, p.norm_peer_g, p.norm_peer_g, 1024, tl);
    }
    convert_flat(p.peer_keys, p.PK, (size_t)16 * 128 * 128 / 8, bid, nb);
    rows_fp8(p.peer_u, p.PU8, p.su, 16384, bid, nb);
    rows_fp8(p.peer_v, p.PV8, p.sv, 16384, bid, nb);
    rows_bf16_rs(p.x, p.XB, p.rs_x, T_TOK, bid, nb);
    rows_bf16_rs(p.mem, p.MEMB, p.rs_mem, 512, bid, nb);
    for (int i = bid * NTHREADS + threadIdx.x; i < 2048; i += nb * NTHREADS) ssm_stage1(p, i);
  } else if (PH == 1) {
    for (int t = bid; t < 2048 + 64; t += nb) { if (t < 2048) { if (((t & 15) >> 2) == 2) tile_win_v(p, t, lds); else tile_win(p, t, lds); } else tile_memkv(p, t - 2048, lds); }
    ssm_stage2a(p, bid, nb);
  } else if (PH == 2) {
    for (int t = bid; t < 2048; t += nb) chunk_attn_item(p, t, lds);
    for (int t = bid; t < 2048; t += nb) ssm_item<false>(p, t, lds);
    memk_fix(p, bid, nb);
    ssm_stage2b(p, bid, nb);
  } else if (PH == 3) {
    for (int t = bid; t < 2048; t += nb) ssm_item<true>(p, t, lds);
  } else if (PH == 4) {
    for (int t = bid; t < 512; t += nb) tile_glu(p, t, lds);
  } else if (PH == 5) {
    for (int t = bid; t < 1024; t += nb) tile_wout(p, t, lds);
  } else if (PH == 6) {
    for (int t = bid; t < 1024; t += nb) tile_memq(p, t, lds);
  } else if (PH == 7) {
    for (int t = bid; t < 1024; t += nb) mem_attn_item(p, t, lds);
  } else if (PH == 8) {
    for (int t = bid; t < 1024; t += nb) tile_memo(p, t, lds);
  } else if (PH == 9) {
    for (int t = bid; t < 2048; t += nb) tile_peerq(p, t, lds);
  } else if (PH == 10) {
    for (int t = bid; t < 2048; t += nb) tile_scores(p, t, lds);
  } else if (PH == 11) {
    for (int t = bid; t < 512; t += nb) peer_gather_item(p, t, lds);
  }
}

#if !MEGA
template <int PH>
__global__ void __launch_bounds__(NTHREADS, 2) phase_kernel(Params p) {
  extern __shared__ __attribute__((aligned(16))) char lds[];
  run_phase<PH>(p, lds, blockIdx.x, gridDim.x);
}

#endif
#ifndef REPEAT_PH
#define REPEAT_PH -1
#endif
#define RUNPH(k) do { run_phase<k>(p, lds, bid, nb); if (REPEAT_PH == k) { xcd_barrier(xb); run_phase<k>(p, lds, bid, nb); } } while (0)
__global__ void __launch_bounds__(NTHREADS, 2) mega_kernel(Params p) {
  extern __shared__ __attribute__((aligned(16))) char lds[];
  cg::grid_group grid = cg::this_grid();
  const int bid = blockIdx.x, nb = gridDim.x;
  volatile LAS unsigned* stw = (volatile LAS unsigned*)((LAS char*)lds + LDS_WORK);
  if (threadIdx.x == 0) { stw[0] = 0u; stw[1] = 0u; stw[2] = 0u; stw[3] = 0u; }
  __syncthreads();
  XcdBarrier xb = xcd_barrier_post(p.bar, stw);
  RUNPH(0); grid.sync();
  RUNPH(1); xcd_barrier(xb);
  RUNPH(2); xcd_barrier(xb);
  RUNPH(3); xcd_barrier(xb);
  RUNPH(4); xcd_barrier(xb);
  RUNPH(5); xcd_barrier(xb);
  RUNPH(6); xcd_barrier(xb);
  RUNPH(7); xcd_barrier(xb);
  RUNPH(8); xcd_barrier(xb);
  RUNPH(9); xcd_barrier(xb);
  RUNPH(10); xcd_barrier(xb);
  RUNPH(11);
}

#if !MEGA
template <int PH> static void launch_phase(const Params& p, int grid, hipStream_t s) {
  hipFuncSetAttribute((const void*)phase_kernel<PH>, hipFuncAttributeMaxDynamicSharedMemorySize, LDS_BYTES);
  phase_kernel<PH><<<grid, NTHREADS, LDS_BYTES, s>>>(p);
}
#endif

extern "C" void kernel_launch(void* const* d_in, const int* in_sizes, int n_in, void* d_out, int out_size, void* d_ws, size_t ws_size, hipStream_t stream) {
  Params p{};
  const float** f = (const float**)&p;
  for (int i = 0; i < 33; ++i) f[i] = (const float*)d_in[i];
  p.out = (float*)d_out;
  char* ws = (char*)d_ws; size_t off = 0;
  auto take = [&](size_t bytes) { char* r = ws + off; off += (bytes + 255) & ~(size_t)255; return r; };
  const size_t MB = 1u << 20;
  p.bar = (unsigned*)take(16384);
  p.WtIn = (bf16_t*)take(4 * MB); p.WtGlu = (bf16_t*)take(MB / 2); p.WtOut = (bf16_t*)take(2 * MB);
  p.WtMq = (bf16_t*)take(2 * MB); p.WtMk = (bf16_t*)take(2 * MB); p.WtMv = (bf16_t*)take(2 * MB); p.WtMo = (bf16_t*)take(2 * MB); p.WtPq = (bf16_t*)take(4 * MB);
  p.PK = (bf16_t*)take(MB / 2); p.PU8 = (unsigned char*)take(16 * MB); p.PV8 = (unsigned char*)take(16 * MB); p.su = (float*)take(16384 * 4); p.sv = (float*)take(16384 * 4);
  char* RA = take(64 * MB); char* RB = take(64 * MB);
  p.XB = (bf16_t*)RA; p.ATT = (bf16_t*)RA; p.YG = (bf16_t*)(RA + 16 * MB); p.QM = (bf16_t*)RA; p.H2B = (bf16_t*)RA;
  p.SSMO = (bf16_t*)(RA + 32 * MB); p.OM = (bf16_t*)(RA + 32 * MB);
  p.Qb = (bf16_t*)RB; p.Kb = (bf16_t*)(RB + 16 * MB); p.VT = (bf16_t*)(RB + 32 * MB); p.Ub = (bf16_t*)(RB + 48 * MB); p.H1B = (bf16_t*)RB; p.QP = (bf16_t*)RB;
  p.TOPS = (unsigned*)take(16 * MB);
  p.MEMB = (bf16_t*)take(MB); p.KMB = (bf16_t*)take(MB); p.VMT = (bf16_t*)take(MB); p.KMraw = (float*)take(2 * MB);
  p.WE16 = (bf16_t*)take(2 * MB); p.WY = (bf16_t*)take(6 * MB);
  p.rs_x = (float*)take(T_TOK * 4); p.rs_mem = (float*)take(512 * 4); p.ss_att = (float*)take(T_TOK * 8 * 4); p.ss_ssm = (float*)take(T_TOK * 8 * 4);
  p.ss_h1 = (float*)take(T_TOK * 16 * 4); p.ss_qm = (float*)take(T_TOK * 16 * 4); p.ss_km = (float*)take(512 * 16 * 4); p.ss_h2 = (float*)take(T_TOK * 16 * 4);
  p.ESEG = (float*)take(2 * 32 * 32 * 128 * 4);
  p.BBR = (float*)take(2048 * 16 * 4); p.BBI = (float*)take(2048 * 16 * 4); p.PWR = (float*)take(32 * 17 * 64 * 4); p.PWI = (float*)take(32 * 17 * 64 * 4); p.KJ = (float*)take(32 * 16 * 256 * 4); p.APW = (float*)take(5 * 4096 * 4);
  if (off > ws_size) { fprintf(stderr, "workspace too small: need %zu have %zu\n", off, ws_size); return; }
#if MEGA
  hipMemsetAsync(p.bar, 0, 16384, stream);
  static int grid_blocks = 0;
  if (!grid_blocks) {
    int dev = 0, cus = 0, per_cu = 0; hipGetDevice(&dev); hipDeviceGetAttribute(&cus, hipDeviceAttributeMultiprocessorCount, dev);
    hipFuncSetAttribute((const void*)mega_kernel, hipFuncAttributeMaxDynamicSharedMemorySize, LDS_BYTES);
    hipOccupancyMaxActiveBlocksPerMultiprocessor(&per_cu, mega_kernel, NTHREADS, LDS_BYTES);
    if (per_cu > 2) per_cu = 2; if (per_cu < 1) per_cu = 1;
    grid_blocks = cus * per_cu;
  }
  void* args[] = {&p};
  hipError_t e = hipLaunchCooperativeKernel((void*)mega_kernel, dim3(grid_blocks), dim3(NTHREADS), args, LDS_BYTES, stream);
  if (e != hipSuccess) fprintf(stderr, "cooperative launch failed: %s (grid %d)\n", hipGetErrorString(e), grid_blocks);
#else
  const int G = 1024;
  launch_phase<0>(p, G, stream); launch_phase<1>(p, G, stream); launch_phase<2>(p, G, stream); launch_phase<3>(p, G, stream);
  launch_phase<4>(p, G, stream); launch_phase<5>(p, G, stream); launch_phase<6>(p, G, stream); launch_phase<7>(p, G, stream);
  launch_phase<8>(p, G, stream); launch_phase<9>(p, G, stream); launch_phase<10>(p, G, stream); launch_phase<11>(p, G, stream);
#endif
}
```

```cpp
#include <hip/hip_runtime.h>
#include <hip/hip_cooperative_groups.h>
#include <cstdio>
#include <cstdint>
namespace cg = cooperative_groups;

#ifndef MEGA
#define MEGA 1
#endif

typedef unsigned short bf16_t;
typedef short bf16x8 __attribute__((ext_vector_type(8)));
typedef float f32x4 __attribute__((ext_vector_type(4)));
typedef unsigned u32x4 __attribute__((ext_vector_type(4)));
#define LAS __attribute__((address_space(3)))
__device__ __forceinline__ bf16x8 as_bf(u32x4 v) { return __builtin_bit_cast(bf16x8, v); }

#define T_TOK 16384
#define SEQL 8192
#define NTHREADS 256
#define LDS_WORK 66560
#define LDS_BYTES (LDS_WORK + 16)
#define EPSF 1e-6f

__device__ __forceinline__ unsigned short f2bf(float f) { unsigned u = __float_as_uint(f); u += 0x7fffu + ((u >> 16) & 1u); return (unsigned short)(u >> 16); }
__device__ __forceinline__ float bf2f(unsigned short b) { return __uint_as_float(((unsigned)b) << 16); }
__device__ __forceinline__ unsigned pack2(float lo, float hi) { return (unsigned)f2bf(lo) | ((unsigned)f2bf(hi) << 16); }
__device__ __forceinline__ float gelu_f(float v) {
  const float av = fabsf(v), t = __builtin_amdgcn_rcpf(av * 0.2316418882f + 1.0f);
  float q = t * 0.5307027145f + (-0.7265760135f); q = q * t + 0.7107068705f; q = q * t + (-0.142248368f); q = q * t + 0.127414796f; q = q * t;
  const float e = __builtin_amdgcn_exp2f((v * v) * (-0.72134752044f)); const float m = v * (q * e);
  return v < 0.f ? m : v - m; }
typedef float f32x2 __attribute__((ext_vector_type(2)));
__device__ __forceinline__ f32x4 mfma16(bf16x8 a, bf16x8 b, f32x4 c) { return __builtin_amdgcn_mfma_f32_16x16x32_bf16(a, b, c, 0, 0, 0); }


#define XB_TMO      128
#define XB_XCNT(j)  (256  + 64 * (j))
#define XB_XSUB(j)  (1280 + 64 * (j))
#define XB_XGEN(j)  (2304 + 64 * (j))
#define XB_TOP      3328
#define XB_TOPGEN   3392
#define XCD_BAR_WORDS 3456
#define XB_SPIN_CAP (1u << 18)
__device__ __forceinline__ unsigned xb_ld(unsigned* p)              { return __hip_atomic_load(p, __ATOMIC_RELAXED, __HIP_MEMORY_SCOPE_AGENT); }
__device__ __forceinline__ unsigned xb_add(unsigned* p, unsigned v) { return __hip_atomic_fetch_add(p, v, __ATOMIC_RELAXED, __HIP_MEMORY_SCOPE_AGENT); }
__device__ __forceinline__ unsigned xb_xcc_id() { return (unsigned)__builtin_amdgcn_s_getreg((3 << 11) | 20) & 0xFu; }
#define XB_SPIN(cond, bar) do { unsigned _sp = 0; while (cond) { __builtin_amdgcn_s_sleep(1); \
    if ((++_sp & 255u) == 0u) { if (xb_ld(&(bar)[XB_TMO])) break; if (_sp > XB_SPIN_CAP) { atomicAdd(&(bar)[XB_TMO], 1u); break; } } } } while (0)
struct XcdBarrier { unsigned* bar; unsigned x; volatile LAS unsigned* st; };
__device__ __forceinline__ XcdBarrier xcd_barrier_post(unsigned* bar, volatile LAS unsigned* st) {
  XcdBarrier b; b.bar = bar; b.x = xb_xcc_id(); b.st = st;
  if (threadIdx.x == 0) (void)xb_add(&bar[XB_XCNT(b.x)], 1u);
  return b;
}
__device__ __forceinline__ void xcd_barrier_complete(unsigned* bar, unsigned x, unsigned& nloc, unsigned& nx) {
  const unsigned G = gridDim.x * gridDim.y * gridDim.z;
  unsigned sum, cnt, mine, sp = 0u;
  for (;;) {
    sum = 0u; cnt = 0u; mine = 0u;
#pragma unroll
    for (unsigned j = 0; j < 16; ++j) { const unsigned c = xb_ld(&bar[XB_XCNT(j)]); sum += c; cnt += (c > 0u) ? 1u : 0u; mine = (j == x) ? c : mine; }
    if (sum == G) break;
    __builtin_amdgcn_s_sleep(1);
    if ((++sp & 255u) == 0u) { if (xb_ld(&bar[XB_TMO])) break; if (sp > XB_SPIN_CAP) { atomicAdd(&bar[XB_TMO], 1u); break; } }
  }
  nloc = mine > 0u ? mine : 1u; nx = cnt > 0u ? cnt : 1u;
}
__device__ __forceinline__ void xcd_barrier(const XcdBarrier& b) {
  asm volatile("s_waitcnt vmcnt(0)" ::: "memory");
  __syncthreads();
  if (threadIdx.x == 0) {
    unsigned* bar = b.bar;
    __builtin_amdgcn_s_waitcnt(0);
    unsigned nloc = b.st[0], nx = b.st[1];
    if (nloc == 0u) { xcd_barrier_complete(bar, b.x, nloc, nx); b.st[0] = nloc; b.st[1] = nx; }
    const unsigned old = xb_add(&bar[XB_XSUB(b.x)], 1u);
    const unsigned gen = old / nloc;
    if (old + 1u == (gen + 1u) * nloc) {
      __builtin_amdgcn_fence(__ATOMIC_RELEASE, "agent");
      asm volatile("s_waitcnt vmcnt(0)" ::: "memory");
      const unsigned og = xb_add(&bar[XB_TOP], 1u);
      const unsigned tg = og / nx;
      if (og + 1u == (tg + 1u) * nx) xb_add(&bar[XB_TOPGEN], 1u);
      else XB_SPIN(xb_ld(&bar[XB_TOPGEN]) == tg, bar);
      __builtin_amdgcn_fence(__ATOMIC_ACQUIRE, "agent");
      xb_add(&bar[XB_XGEN(b.x)], 1u);
      asm volatile("s_waitcnt vmcnt(0)" ::: "memory");
    } else {
      XB_SPIN(xb_ld(&bar[XB_XGEN(b.x)]) == gen, bar);
      __builtin_amdgcn_fence(__ATOMIC_ACQUIRE, "agent");
      asm volatile("s_waitcnt vmcnt(0)" ::: "memory");
    }
  }
  __syncthreads();
}

struct Params {
  const float *x, *mem, *norm_mix_g, *w_in, *att_q_g, *att_k_g, *rel_bias;
  const float *lam_re, *lam_im, *log_step, *b_re, *b_im, *c_re, *c_im, *d_skip, *w_glu, *b_glu;
  const float *att_out_g, *ssm_out_g, *w_out, *norm_mem_g, *norm_memkv_g, *w_mem_q, *w_mem_k, *w_mem_v;
  const float *mem_q_g, *mem_k_g, *w_mem_o, *norm_peer_g, *w_peer_q, *peer_keys, *peer_u, *peer_v;
  float* out;
  unsigned* bar;
  bf16_t *WtIn, *WtGlu, *WtOut, *WtMq, *WtMk, *WtMv, *WtMo, *WtPq, *PK, *PU, *PV;
  bf16_t *XB, *MEMB, *Qb, *Kb, *VT, *Ub, *ATT, *YG, *SSMO, *H1B, *QM, *OM, *H2B, *QP;
  bf16_t *KMB, *VMT, *WE16, *WY;
  float *rs_x, *rs_mem, *ss_att, *ss_ssm, *ss_h1, *ss_qm, *ss_km, *ss_h2, *KMraw, *ESEG;
  float *BBR, *BBI, *PWR, *PWI, *KJ, *APW;
  unsigned* TOPS;
  unsigned char *PU8, *PV8; float *su, *sv;
};

#define GAS __attribute__((address_space(1)))
template <bool ZERO = true, bool SWAP = false>
__device__ __forceinline__ void gemm_mainloop(f32x4 (&acc)[4][4], const bf16_t* __restrict__ A, int lda, const bf16_t* __restrict__ Bt, int ldb, int K,
                                              int row0, int col0, char* lds_) {
  LAS char* lds = (LAS char*)lds_;
  const int tid = threadIdx.x, lane = tid & 63, w = tid >> 6, wr = w >> 1, wc = w & 1, fr = lane & 15, fq = lane >> 4;
  if (ZERO) {
#pragma unroll
    for (int m = 0; m < 4; ++m)
#pragma unroll
      for (int n = 0; n < 4; ++n) acc[m][n] = (f32x4){0.f, 0.f, 0.f, 0.f};
  }
  const int lr = lane >> 3, lc = (lane & 7) ^ lr;
  const bf16_t* gA = A + (size_t)(row0 + w * 32 + lr) * lda + lc * 8;
  const bf16_t* gB = Bt + (size_t)(col0 + w * 32 + lr) * ldb + lc * 8;
  const int wbase = __builtin_amdgcn_readfirstlane(w) * 4096;
  const int nk = K >> 6;
  __syncthreads();
#pragma unroll
  for (int i = 0; i < 4; ++i) {
    __builtin_amdgcn_global_load_lds((const GAS void*)(gA + (size_t)(i * 8) * lda), (LAS void*)(lds + wbase + i * 1024), 16, 0, 0);
    __builtin_amdgcn_global_load_lds((const GAS void*)(gB + (size_t)(i * 8) * ldb), (LAS void*)(lds + 16384 + wbase + i * 1024), 16, 0, 0);
  }
  asm volatile("s_waitcnt vmcnt(0)" ::: "memory");
  __syncthreads();
  for (int kt = 0; kt < nk; ++kt) {
    LAS char* cur = lds + (kt & 1) * 32768; LAS char* nxt = lds + ((kt + 1) & 1) * 32768;
    if (kt + 1 < nk) {
      const int k1 = (kt + 1) << 6;
#pragma unroll
      for (int i = 0; i < 4; ++i) {
        __builtin_amdgcn_global_load_lds((const GAS void*)(gA + (size_t)(i * 8) * lda + k1), (LAS void*)(nxt + wbase + i * 1024), 16, 0, 0);
        __builtin_amdgcn_global_load_lds((const GAS void*)(gB + (size_t)(i * 8) * ldb + k1), (LAS void*)(nxt + 16384 + wbase + i * 1024), 16, 0, 0);
      }
    }
#pragma unroll
    for (int ks = 0; ks < 2; ++ks) {
      bf16x8 af[4], bfr[4];
      const int kc = ks * 4 + fq;
#pragma unroll
      for (int m = 0; m < 4; ++m) { const int r = wr * 64 + m * 16 + fr; af[m] = as_bf(*(const LAS u32x4*)(cur + r * 128 + ((kc ^ (r & 7)) << 4))); }
#pragma unroll
      for (int n = 0; n < 4; ++n) { const int r = wc * 64 + n * 16 + fr; bfr[n] = as_bf(*(const LAS u32x4*)(cur + 16384 + r * 128 + ((kc ^ (r & 7)) << 4))); }
#pragma unroll
      for (int m = 0; m < 4; ++m)
#pragma unroll
        for (int n = 0; n < 4; ++n) acc[m][n] = SWAP ? mfma16(af[m], bfr[n], acc[m][n]) : mfma16(bfr[n], af[m], acc[m][n]);
    }
    asm volatile("s_waitcnt vmcnt(0)" ::: "memory");
    __syncthreads();
  }
}

__device__ void transpose_tile(const float* __restrict__ src, bf16_t* __restrict__ dst, int K, int N, int tile, const float* g0, const float* g1, int split, float* tl  ) {
  const int ntn = N >> 6; const int tk = tile / ntn, tn = tile % ntn; const int k0 = tk << 6, n0 = tn << 6; const int tid = threadIdx.x;
  __syncthreads();
#pragma unroll 4
  for (int i = 0; i < 16; ++i) { const int kk = i * 4 + (tid >> 6), nn = tid & 63; const int k = k0 + kk;
    float g = 1.f; if (g0) g = (k < split) ? g0[k] : g1[k - split];
    tl[kk * 65 + nn] = src[(size_t)k * N + n0 + nn] * g; }
  __syncthreads();
  const int n = tid >> 2, kq = (tid & 3) * 16;
  unsigned o[8];
#pragma unroll
  for (int j = 0; j < 8; ++j) o[j] = pack2(tl[(kq + 2 * j) * 65 + n], tl[(kq + 2 * j + 1) * 65 + n]);
  uint4* d = (uint4*)(dst + (size_t)(n0 + n) * K + k0 + kq);
  d[0] = make_uint4(o[0], o[1], o[2], o[3]); d[1] = make_uint4(o[4], o[5], o[6], o[7]);
}

__device__ void convert_flat(const float* __restrict__ src, bf16_t* __restrict__ dst, size_t n8  , int bid, int nb) {
  for (size_t i = (size_t)bid * NTHREADS + threadIdx.x; i < n8; i += (size_t)nb * NTHREADS) {
    const float4 a = ((const float4*)src)[2 * i], b = ((const float4*)src)[2 * i + 1];
    ((uint4*)dst)[i] = make_uint4(pack2(a.x, a.y), pack2(a.z, a.w), pack2(b.x, b.y), pack2(b.z, b.w));
  }
}
__device__ void rows_bf16_rs(const float* __restrict__ src, bf16_t* __restrict__ dst, float* __restrict__ rs, int nrows, int bid, int nb) {
  const int lane = threadIdx.x & 63, w = threadIdx.x >> 6;
  for (int row = bid * 4 + w; row < nrows; row += nb * 4) {
    const float4* s = (const float4*)(src + (size_t)row * 1024);
    float ss = 0.f; uint2* d = (uint2*)(dst + (size_t)row * 1024);
#pragma unroll
    for (int i = 0; i < 4; ++i) { const float4 v = s[i * 64 + lane]; ss += v.x * v.x + v.y * v.y + v.z * v.z + v.w * v.w; d[i * 64 + lane] = make_uint2(pack2(v.x, v.y), pack2(v.z, v.w)); }
#pragma unroll
    for (int o = 32; o > 0; o >>= 1) ss += __shfl_xor(ss, o);
    if (lane == 0) rs[row] = rsqrtf(ss * (1.0f / 1024.0f) + EPSF);
  }
}

__device__ void rows_fp8(const float* __restrict__ src, unsigned char* __restrict__ dst, float* __restrict__ sc, int nrows, int bid, int nb) {
  const int lane = threadIdx.x & 63, w = threadIdx.x >> 6;
  for (int row = bid * 4 + w; row < nrows; row += nb * 4) {
    const float4* s = (const float4*)(src + (size_t)row * 1024);
    float4 v[4]; float am = 0.f;
#pragma unroll
    for (int i = 0; i < 4; ++i) { v[i] = s[i * 64 + lane]; am = fmaxf(am, fmaxf(fmaxf(fabsf(v[i].x), fabsf(v[i].y)), fmaxf(fabsf(v[i].z), fabsf(v[i].w)))); }
#pragma unroll
    for (int o = 32; o > 0; o >>= 1) am = fmaxf(am, __shfl_xor(am, o));
    const float q = (am > 0.f) ? 224.0f / am : 1.0f;
    unsigned* d = (unsigned*)(dst + (size_t)row * 1024);
#pragma unroll
    for (int i = 0; i < 4; ++i) { int wd = 0; wd = __builtin_amdgcn_cvt_pk_fp8_f32(v[i].x * q, v[i].y * q, wd, false); wd = __builtin_amdgcn_cvt_pk_fp8_f32(v[i].z * q, v[i].w * q, wd, true); d[i * 64 + lane] = (unsigned)wd; }
    if (lane == 0) sc[row] = (am > 0.f) ? am * (1.0f / 224.0f) : 1.0f;
  }
}

__device__ void ssm_stage1(const Params& p, int gp) {
  const int g = gp >> 6;
  const float step = expf(p.log_step[g]); const float lr = p.lam_re[gp], li = p.lam_im[gp];
  const float mag = expf(lr * step); const float ar = mag * cosf(li * step), ai = mag * sinf(li * step);
  const float zr = ar - 1.0f, den = lr * lr + li * li; const float fr = (zr * lr + ai * li) / den, fi = (ai * lr - zr * li) / den;
  for (int c = 0; c < 16; ++c) { const float br = p.b_re[gp * 16 + c], bi = p.b_im[gp * 16 + c]; p.BBR[gp * 16 + c] = fr * br - fi * bi; p.BBI[gp * 16 + c] = fr * bi + fi * br; }
  float pr = 1.f, pi = 0.f; const int st = gp & 63;
  for (int j = 0; j <= 16; ++j) { p.PWR[(g * 17 + j) * 64 + st] = pr; p.PWI[(g * 17 + j) * 64 + st] = pi; const float nr = pr * ar - pi * ai, ni = pr * ai + pi * ar; if (j < 16) { pr = nr; pi = ni; } }
  const float a16r = pr, a16i = pi; const float a32r = a16r * a16r - a16i * a16i, a32i = 2.f * a16r * a16i;
  const float a48r = a32r * a16r - a32i * a16i, a48i = a32r * a16i + a32i * a16r; const float a64r = a32r * a32r - a32i * a32i, a64i = 2.f * a32r * a32i;
  const float a128r = a64r * a64r - a64i * a64i, a128i = 2.f * a64r * a64i; const float a256r = a128r * a128r - a128i * a128i, a256i = 2.f * a128r * a128i;
  float* A = p.APW;
  A[0 * 4096 + gp] = a16r; A[0 * 4096 + 2048 + gp] = a16i; A[1 * 4096 + gp] = a32r; A[1 * 4096 + 2048 + gp] = a32i; A[2 * 4096 + gp] = a48r; A[2 * 4096 + 2048 + gp] = a48i;
  A[3 * 4096 + gp] = a64r; A[3 * 4096 + 2048 + gp] = a64i; A[4 * 4096 + gp] = a256r; A[4 * 4096 + 2048 + gp] = a256i;
}
__device__ void ssm_stage2a(const Params& p, int bid, int nb) {
  const int n1 = 32 * 128 * 256, n2 = 32 * 16 * 4 * 512, n3 = 32 * 16 * 256;
  for (int i = bid * NTHREADS + threadIdx.x; i < n1 + n2 + n3; i += nb * NTHREADS) {
    if (i < n1) {
      const int j = i & 7, lane = (i >> 3) & 63, ks = (i >> 9) & 7, ri = (i >> 12) & 1, w = (i >> 13) & 3, g = i >> 15;
      const int st = w * 16 + (lane & 15), k = ks * 32 + (lane >> 4) * 8 + j; const int s_ = k >> 4, ch = k & 15;
      const int gp = g * 64 + st; const float pr = p.PWR[(g * 17 + 15 - s_) * 64 + st], pi = p.PWI[(g * 17 + 15 - s_) * 64 + st]; const float br = p.BBR[gp * 16 + ch], bi = p.BBI[gp * 16 + ch];
      p.WE16[i] = f2bf(ri == 0 ? (pr * br - pi * bi) : (pr * bi + pi * br));
    } else if (i < n1 + n2) {
      const int e = i - n1; const int j = e & 7, lane = (e >> 3) & 63, ks = (e >> 9) & 3, mt = (e >> 11) & 15, g = e >> 15;
      const int t = mt, co = lane & 15, k = ks * 32 + (lane >> 4) * 8 + j;
      const int st = ((k >> 5) << 4) | (k & 15), ri = (k >> 4) & 1; const float cr = p.c_re[(g * 16 + co) * 64 + st], ci = p.c_im[(g * 16 + co) * 64 + st];
      const float pr = p.PWR[(g * 17 + t + 1) * 64 + st], pi = p.PWI[(g * 17 + t + 1) * 64 + st];
      p.WY[((size_t)(g * 16 + mt) * 12 + ks) * 512 + lane * 8 + j] = f2bf((ri == 0) ? (cr * pr - ci * pi) : -(cr * pi + ci * pr));
    } else {
      const int e = i - n1 - n2; const int cin = e & 15, co = (e >> 4) & 15, j = (e >> 8) & 15, g = e >> 12; float acc = 0.f;
      for (int st = 0; st < 64; ++st) { const float cr = p.c_re[(g * 16 + co) * 64 + st], ci = p.c_im[(g * 16 + co) * 64 + st]; const float pr = p.PWR[(g * 17 + j) * 64 + st], pi = p.PWI[(g * 17 + j) * 64 + st];
        const float br = p.BBR[(g * 64 + st) * 16 + cin], bi = p.BBI[(g * 64 + st) * 16 + cin]; acc += cr * (pr * br - pi * bi) - ci * (pr * bi + pi * br); }
      p.KJ[e] = acc;
    }
  }
}
__device__ void ssm_stage2b(const Params& p, int bid, int nb) {
  const int n = 32 * 16 * 8 * 512;
  for (int i = bid * NTHREADS + threadIdx.x; i < n; i += nb * NTHREADS) {
    const int j = i & 7, lane = (i >> 3) & 63, ks8 = (i >> 9) & 7, mt = (i >> 12) & 15, g = i >> 16;
    const int t = mt, co = lane & 15, kk = ks8 * 32 + (lane >> 4) * 8 + j; const int s_ = kk >> 4, cin = kk & 15;
    const float val = (s_ <= t) ? p.KJ[((g * 16 + (t - s_)) * 16 + co) * 16 + cin] : 0.f;
    p.WY[((size_t)(g * 16 + mt) * 12 + 4 + ks8) * 512 + lane * 8 + j] = f2bf(val);
  }
}

#define EPI_IDS const int tid = threadIdx.x, lane = tid & 63, w = tid >> 6, wr = w >> 1, wc = w & 1, fr = lane & 15, fq = lane >> 4; (void)wr; (void)wc; (void)fr; (void)fq;

__device__ void tile_win_v(const Params& p, int tile, char* lds) {
  const int rt = tile >> 4, ct = tile & 15; const int row0 = rt * 128, col0 = ct * 128;
  f32x4 acc[4][4];
  gemm_mainloop<true, true>(acc, p.XB, 1024, p.WtIn, 1024, 1024, row0, col0, lds);
  EPI_IDS
  const int head = (col0 + wc * 64 - 1024) >> 6;
#pragma unroll
  for (int m = 0; m < 4; ++m) {
    const int row = row0 + wr * 64 + m * 16 + fq * 4; const f32x4 rsx = *(const f32x4*)(p.rs_x + row); const int b = row >> 13, tb = row & 8191;
#pragma unroll
    for (int n = 0; n < 4; ++n) { const f32x4 v = acc[m][n] * rsx;
      *(uint2*)(p.VT + ((size_t)(b * 8 + head) * 64 + n * 16 + fr) * SEQL + tb) = make_uint2(pack2(v[0], v[1]), pack2(v[2], v[3])); }
  }
}
__device__ void tile_win(const Params& p, int tile, char* lds) {
  const int rt = tile >> 4, ct = tile & 15; const int row0 = rt * 128, col0 = ct * 128;
  f32x4 acc[4][4];
  gemm_mainloop<true>(acc, p.XB, 1024, p.WtIn, 1024, 1024, row0, col0, lds);
  EPI_IDS
  const int cw = col0 + wc * 64;
#pragma unroll
  for (int m = 0; m < 4; ++m) {
    const int row = row0 + wr * 64 + m * 16 + fr; const float rsx = p.rs_x[row];
    if (cw < 1024) {
      float ss = 0.f;
#pragma unroll
      for (int n = 0; n < 4; ++n)
#pragma unroll
        for (int j = 0; j < 4; ++j) { const float v = acc[m][n][j] * rsx; acc[m][n][j] = v; ss += v * v; }
      ss += __shfl_xor(ss, 16); ss += __shfl_xor(ss, 32);
      const float rs = rsqrtf(ss * (1.0f / 64.0f) + EPSF) * (cw < 512 ? 0.125f : 1.0f);
      const float* g = (cw < 512) ? p.att_q_g : p.att_k_g; bf16_t* dst = (cw < 512 ? p.Qb : p.Kb) + (size_t)row * 512 + (cw & 511);
#pragma unroll
      for (int n = 0; n < 4; ++n) { const int c = n * 16 + fq * 4; const float4 gg = *(const float4*)(g + c);
        *(uint2*)(dst + c) = make_uint2(pack2(acc[m][n][0] * rs * gg.x, acc[m][n][1] * rs * gg.y), pack2(acc[m][n][2] * rs * gg.z, acc[m][n][3] * rs * gg.w)); }
    } else if (cw < 1536) {
      const int head = (cw - 1024) >> 6; const int b = row >> 13, tb = row & 8191;
      bf16_t* dst = p.VT + ((size_t)(b * 8 + head) * 64) * SEQL + tb;
#pragma unroll
      for (int n = 0; n < 4; ++n)
#pragma unroll
        for (int j = 0; j < 4; ++j) dst[(size_t)(n * 16 + fq * 4 + j) * SEQL] = f2bf(acc[m][n][j] * rsx);
    } else {
      const int b = row >> 13, tb = row & 8191;
#pragma unroll
      for (int n = 0; n < 4; ++n) { const int g = ((cw - 1536) >> 4) + n;
        *(uint2*)(p.Ub + ((size_t)(b * 32 + g) * SEQL + tb) * 16 + fq * 4) = make_uint2(pack2(acc[m][n][0] * rsx, acc[m][n][1] * rsx), pack2(acc[m][n][2] * rsx, acc[m][n][3] * rsx)); }
    }
  }
}
__device__ void tile_memkv(const Params& p, int tile, char* lds) {
  const int which = tile >> 5, t2 = tile & 31; const int rt = t2 >> 3, ct = t2 & 7; const int row0 = rt * 128, col0 = ct * 128;
  f32x4 acc[4][4];
  gemm_mainloop<true>(acc, p.MEMB, 1024, which ? p.WtMv : p.WtMk, 1024, 1024, row0, col0, lds);
  EPI_IDS
  const int cw = col0 + wc * 64;
#pragma unroll
  for (int m = 0; m < 4; ++m) {
    const int row = row0 + wr * 64 + m * 16 + fr; const float rsm = p.rs_mem[row];
    if (which == 0) {
      float ss = 0.f;
#pragma unroll
      for (int n = 0; n < 4; ++n) { f32x4 v = acc[m][n] * rsm; ss += v[0] * v[0] + v[1] * v[1] + v[2] * v[2] + v[3] * v[3]; *(f32x4*)(p.KMraw + (size_t)row * 1024 + cw + n * 16 + fq * 4) = v; }
      ss += __shfl_xor(ss, 16); ss += __shfl_xor(ss, 32);
      if (fq == 0) p.ss_km[row * 16 + (cw >> 6)] = ss;
    } else {
      const int b = row >> 8, key = row & 255; const int head = cw >> 8; const int d0 = (cw & 255);
      bf16_t* dst = p.VMT + ((size_t)(b * 4 + head) * 256) * 256 + key;
#pragma unroll
      for (int n = 0; n < 4; ++n)
#pragma unroll
        for (int j = 0; j < 4; ++j) dst[(size_t)(d0 + n * 16 + fq * 4 + j) * 256] = f2bf(acc[m][n][j] * rsm);
    }
  }
}
__device__ void memk_fix(const Params& p, int bid, int nb) {
  for (int i = bid * NTHREADS + threadIdx.x; i < 512 * 1024 / 4; i += nb * NTHREADS) {
    const int row = i >> 8, c4 = (i & 255) * 4; const int head = c4 >> 8, d = c4 & 255;
    const float ss = p.ss_km[row * 16 + head * 4] + p.ss_km[row * 16 + head * 4 + 1] + p.ss_km[row * 16 + head * 4 + 2] + p.ss_km[row * 16 + head * 4 + 3];
    const float rs = rsqrtf(ss * (1.0f / 256.0f) + EPSF);
    const float4 v = *(const float4*)(p.KMraw + (size_t)row * 1024 + c4); const float4 gk = *(const float4*)(p.mem_k_g + d), gq = *(const float4*)(p.mem_q_g + d);
    const int b = row >> 8, key = row & 255;
    *(uint2*)(p.KMB + ((size_t)(b * 4 + head) * 256 + key) * 256 + d) = make_uint2(pack2(v.x * rs * gk.x * gq.x, v.y * rs * gk.y * gq.y), pack2(v.z * rs * gk.z * gq.z, v.w * rs * gk.w * gq.w));
  }
}

__device__ void chunk_attn_item(const Params& p, int item, char* lds_) {
  LAS char* lds = (LAS char*)lds_; LAS float* rb = (LAS float*)(lds + 32768);
  typedef unsigned u32x2 __attribute__((ext_vector_type(2)));
  const int h = item & 7, cn = (item >> 3) & 127, b = item >> 10;
  const int tid = threadIdx.x, lane = tid & 63, w = tid >> 6, fr = lane & 15, fq = lane >> 4;
  const int iq = w * 16 + fr; const int tq = b * SEQL + cn * 64 + iq;
  const int cstart = (cn >= 8) ? 0 : (8 - cn);
  const bf16_t* vtb = p.VT + ((size_t)(b * 8 + h) * 64) * SEQL;
  const int r0 = tid >> 3, ch = tid & 7;
  u32x4 kr[2], vr[2];
  { const int kc0 = (cn - 8 + cstart) * 64;
#pragma unroll
    for (int i = 0; i < 2; ++i) { kr[i] = *(const u32x4*)(p.Kb + (size_t)(b * SEQL + kc0 + r0 + 32 * i) * 512 + h * 64 + ch * 8); vr[i] = *(const u32x4*)(vtb + (size_t)(r0 + 32 * i) * SEQL + kc0 + ch * 8); } }
  bf16x8 qf[2];
  qf[0] = *(const bf16x8*)(p.Qb + (size_t)tq * 512 + h * 64 + fq * 8); qf[1] = *(const bf16x8*)(p.Qb + (size_t)tq * 512 + h * 64 + 32 + fq * 8);
  __syncthreads();
  if (tid < 192) rb[tid] = p.rel_bias[h * 192 + tid];
#pragma unroll
  for (int i = 0; i < 2; ++i) { const int r = r0 + 32 * i; *(LAS u32x4*)(lds + r * 128 + ((ch ^ (r & 7)) << 4)) = kr[i]; *(LAS u32x4*)(lds + 8192 + r * 128 + ((ch ^ ((r >> 1) & 7)) << 4)) = vr[i]; }
  __syncthreads();
  f32x4 o[4]; for (int i = 0; i < 4; ++i) o[i] = (f32x4){0.f, 0.f, 0.f, 0.f};
  float mrun = -1e30f, lrun = 0.f;
  for (int c = cstart; c <= 8; ++c) {
    LAS char* cur = lds + ((c - cstart) & 1) * 16384; LAS char* nxt = lds + ((c - cstart + 1) & 1) * 16384;
    const bool more = c < 8;
    if (more) { const int kc1 = (cn - 8 + c + 1) * 64;
#pragma unroll
      for (int i = 0; i < 2; ++i) { kr[i] = *(const u32x4*)(p.Kb + (size_t)(b * SEQL + kc1 + r0 + 32 * i) * 512 + h * 64 + ch * 8); vr[i] = *(const u32x4*)(vtb + (size_t)(r0 + 32 * i) * SEQL + kc1 + ch * 8); } }
    f32x4 st[4];
#pragma unroll
    for (int mt = 0; mt < 4; ++mt) { const int row = mt * 16 + fr; f32x4 sacc = (f32x4){0.f, 0.f, 0.f, 0.f};
      sacc = mfma16(as_bf(*(const LAS u32x4*)(cur + row * 128 + ((fq ^ (row & 7)) << 4))), qf[0], sacc);
      sacc = mfma16(as_bf(*(const LAS u32x4*)(cur + row * 128 + (((4 + fq) ^ (row & 7)) << 4))), qf[1], sacc); st[mt] = sacc; }
    float tmax = -1e30f;
#pragma unroll
    for (int mt = 0; mt < 4; ++mt)
#pragma unroll
      for (int j = 0; j < 4; ++j) { const int jk = mt * 16 + fq * 4 + j; int dist = 512 - 64 * c + iq - jk; dist = dist < -63 ? -63 : (dist > 128 ? 128 : dist);
        const float sv = st[mt][j] + rb[dist + 63]; st[mt][j] = sv; tmax = fmaxf(tmax, sv); }
    tmax = fmaxf(tmax, __shfl_xor(tmax, 16)); tmax = fmaxf(tmax, __shfl_xor(tmax, 32));
    const float mnew = fmaxf(mrun, tmax); const float alpha = __expf(mrun - mnew); mrun = mnew;
    float ls = 0.f;
#pragma unroll
    for (int mt = 0; mt < 4; ++mt)
#pragma unroll
      for (int j = 0; j < 4; ++j) { const float pv = __expf(st[mt][j] - mnew); st[mt][j] = pv; ls += pv; }
    lrun = lrun * alpha + ls;
    bf16x8 pf[2];
#pragma unroll
    for (int s2 = 0; s2 < 2; ++s2) { u32x4 t; t.x = pack2(st[2 * s2][0], st[2 * s2][1]); t.y = pack2(st[2 * s2][2], st[2 * s2][3]); t.z = pack2(st[2 * s2 + 1][0], st[2 * s2 + 1][1]); t.w = pack2(st[2 * s2 + 1][2], st[2 * s2 + 1][3]); pf[s2] = as_bf(t); }
#pragma unroll
    for (int dt = 0; dt < 4; ++dt) { const int d = dt * 16 + fr; const int sw = ((d >> 1) & 7) << 1; f32x4 oc = o[dt] * alpha;
#pragma unroll
      for (int s2 = 0; s2 < 2; ++s2) {
        const u32x2 lo = *(const LAS u32x2*)(cur + 8192 + d * 128 + (((s2 * 8 + fq) ^ sw) << 3)), hi = *(const LAS u32x2*)(cur + 8192 + d * 128 + (((s2 * 8 + fq + 4) ^ sw) << 3));
        u32x4 vv; vv.x = lo.x; vv.y = lo.y; vv.z = hi.x; vv.w = hi.y; oc = mfma16(as_bf(vv), pf[s2], oc); }
      o[dt] = oc; }
    if (more) {
#pragma unroll
      for (int i = 0; i < 2; ++i) { const int r = r0 + 32 * i; *(LAS u32x4*)(nxt + r * 128 + ((ch ^ (r & 7)) << 4)) = kr[i]; *(LAS u32x4*)(nxt + 8192 + r * 128 + ((ch ^ ((r >> 1) & 7)) << 4)) = vr[i]; }
    }
    __syncthreads();
  }
  float lt = lrun; lt += __shfl_xor(lt, 16); lt += __shfl_xor(lt, 32);
  const float inv = 1.0f / lt; float ss = 0.f;
  bf16_t* dst = p.ATT + (size_t)tq * 512 + h * 64;
#pragma unroll
  for (int dt = 0; dt < 4; ++dt) { const f32x4 v = o[dt] * inv; ss += v[0] * v[0] + v[1] * v[1] + v[2] * v[2] + v[3] * v[3];
    *(uint2*)(dst + dt * 16 + fq * 4) = make_uint2(pack2(v[0], v[1]), pack2(v[2], v[3])); }
  ss += __shfl_xor(ss, 16); ss += __shfl_xor(ss, 32);
  if (fq == 0) p.ss_att[tq * 8 + h] = ss;
}

template <bool FINAL>
__device__ void ssm_item(const Params& p, int item, char* lds) {
  const int g = item & 31, seg = (item >> 5) & 31, b = item >> 10;
  const int tid = threadIdx.x, lane = tid & 63, w = tid >> 6, fr = lane & 15, fq = lane >> 4;
  const int t0 = b * SEQL + seg * 256;
  const bf16_t* ug = p.Ub + ((size_t)(b * 32 + g) * SEQL + seg * 256) * 16;
  bf16x8 uf[8];
#pragma unroll
  for (int ks = 0; ks < 8; ++ks) uf[ks] = *(const bf16x8*)(ug + (size_t)(fr * 16 + 2 * ks + (fq >> 1)) * 16 + (fq & 1) * 8);
  f32x4 er = (f32x4){0.f, 0.f, 0.f, 0.f}, ei = er;
  const bf16_t* we = p.WE16 + ((size_t)(g * 4 + w) * 2 * 8 * 64 + lane) * 8;
#pragma unroll
  for (int ks = 0; ks < 8; ++ks) { const bf16x8 br = *(const bf16x8*)(we + ks * 512), bi = *(const bf16x8*)(we + 4096 + ks * 512); er = mfma16(uf[ks], br, er); ei = mfma16(uf[ks], bi, ei); }
  const int gp = g * 64 + w * 16 + fr;
  const float a16r = p.APW[gp], a16i = p.APW[2048 + gp];
  float xr[4], xi[4];
  xr[0] = er[0]; xi[0] = ei[0];
#pragma unroll
  for (int j = 1; j < 4; ++j) { xr[j] = a16r * xr[j - 1] - a16i * xi[j - 1] + er[j]; xi[j] = a16r * xi[j - 1] + a16i * xr[j - 1] + ei[j]; }
  float cr = 0.f, ci = 0.f;
  if (FINAL) {
    const float ar = p.APW[4 * 4096 + gp], ai = p.APW[4 * 4096 + 2048 + gp];
    const float* es = p.ESEG + ((size_t)(b * 32) * 32 + g) * 128 + w * 32 + fr;
    for (int j0 = 0; j0 < seg; j0 += 8) { float e_r[8], e_i[8];
#pragma unroll
      for (int u = 0; u < 8; ++u) { e_r[u] = es[(size_t)(j0 + u) * 32 * 128]; e_i[u] = es[(size_t)(j0 + u) * 32 * 128 + 16]; }
#pragma unroll
      for (int u = 0; u < 8; ++u) if (j0 + u < seg) { const float nr = ar * cr - ai * ci + e_r[u], ni = ar * ci + ai * cr + e_i[u]; cr = nr; ci = ni; } }
  }
  const float a64r = p.APW[3 * 4096 + gp], a64i = p.APW[3 * 4096 + 2048 + gp];
  float tr = xr[3], ti = xi[3];
#pragma unroll
  for (int r = 0; r < 4; ++r) {
    float pr_ = __shfl(tr, (lane + 48) & 63), pi_ = __shfl(ti, (lane + 48) & 63);
    if (r == 0) { pr_ = cr; pi_ = ci; }
    if (fq == r) { const float nr = xr[3] + a64r * pr_ - a64i * pi_, ni = xi[3] + a64r * pi_ + a64i * pr_; tr = nr; ti = ni; }
  }
  if (!FINAL) {
    if (fq == 3) { float* es = p.ESEG + ((size_t)(b * 32 + seg) * 32 + g) * 128 + w * 32 + fr; es[0] = tr; es[16] = ti; }
    return;
  }
  float gr = __shfl(tr, (lane + 48) & 63), gi = __shfl(ti, (lane + 48) & 63);
  if (fq == 0) { gr = cr; gi = ci; }
  float pvr[4], pvi[4];
  pvr[0] = gr; pvi[0] = gi;
#pragma unroll
  for (int j = 1; j < 4; ++j) { const float ar = p.APW[(j - 1) * 4096 + gp], ai = p.APW[(j - 1) * 4096 + 2048 + gp]; pvr[j] = xr[j - 1] + ar * gr - ai * gi; pvi[j] = xi[j - 1] + ar * gi + ai * gr; }
  bf16_t* xl = (bf16_t*)lds;
  __syncthreads();
#pragma unroll
  for (int j = 0; j < 4; ++j) { xl[(fq * 4 + j) * 136 + w * 32 + fr] = f2bf(pvr[j]); xl[(fq * 4 + j) * 136 + w * 32 + 16 + fr] = f2bf(pvi[j]); }
  __syncthreads();
  bf16x8 xf[4];
#pragma unroll
  for (int ks = 0; ks < 4; ++ks) xf[ks] = *(const bf16x8*)(xl + fr * 136 + ks * 32 + fq * 8);
#pragma unroll
  for (int mi = 0; mi < 4; ++mi) {
    const int mt = w * 4 + mi;
    const bf16_t* wy = p.WY + ((size_t)(g * 16 + mt) * 12 * 64 + lane) * 8;
    f32x4 y = (f32x4){0.f, 0.f, 0.f, 0.f};
#pragma unroll
    for (int ks = 0; ks < 4; ++ks) y = mfma16(*(const bf16x8*)(wy + ks * 512), xf[ks], y);
#pragma unroll
    for (int ks = 0; ks < 8; ++ks) if (2 * ks <= mt) y = mfma16(*(const bf16x8*)(wy + (4 + ks) * 512), uf[ks], y);
    const size_t tok = (size_t)(t0 + fr * 16 + mt);
    const uint2 uu = *(const uint2*)(ug + (size_t)(fr * 16 + mt) * 16 + fq * 4);
    const float4 dd = *(const float4*)(p.d_skip + g * 16 + fq * 4);
    const float y0 = gelu_f(y[0] + dd.x * __uint_as_float(uu.x << 16)), y1 = gelu_f(y[1] + dd.y * __uint_as_float(uu.x & 0xffff0000u));
    const float y2 = gelu_f(y[2] + dd.z * __uint_as_float(uu.y << 16)), y3 = gelu_f(y[3] + dd.w * __uint_as_float(uu.y & 0xffff0000u));
    *(uint2*)(p.YG + tok * 512 + g * 16 + fq * 4) = make_uint2(pack2(y0, y1), pack2(y2, y3));
  }
}

__device__ void tile_glu(const Params& p, int tile, char* lds) {
  const int rt = tile >> 2, ct = tile & 3; const int row0 = rt * 128, col0 = ct * 128;
  f32x4 acc[4][4];
  gemm_mainloop<true>(acc, p.YG, 512, p.WtGlu, 512, 512, row0, col0, lds);
  EPI_IDS
  const int cw = col0 + wc * 64;
#pragma unroll
  for (int m = 0; m < 4; ++m) {
    const int row = row0 + wr * 64 + m * 16 + fr; float ss = 0.f;
#pragma unroll
    for (int n = 0; n < 4; ++n) { const int c = cw + n * 16 + fq * 4; const float4 bg = *(const float4*)(p.b_glu + c); const uint2 yy = *(const uint2*)(p.YG + (size_t)row * 512 + c);
      const float y0 = __uint_as_float(yy.x << 16), y1 = __uint_as_float(yy.x & 0xffff0000u), y2 = __uint_as_float(yy.y << 16), y3 = __uint_as_float(yy.y & 0xffff0000u);
      const float o0 = y0 / (1.f + __expf(-(acc[m][n][0] + bg.x))), o1 = y1 / (1.f + __expf(-(acc[m][n][1] + bg.y))), o2 = y2 / (1.f + __expf(-(acc[m][n][2] + bg.z))), o3 = y3 / (1.f + __expf(-(acc[m][n][3] + bg.w)));
      ss += o0 * o0 + o1 * o1 + o2 * o2 + o3 * o3;
      *(uint2*)(p.SSMO + (size_t)row * 512 + c) = make_uint2(pack2(o0, o1), pack2(o2, o3)); }
    ss += __shfl_xor(ss, 16); ss += __shfl_xor(ss, 32);
    if (fq == 0) p.ss_ssm[row * 8 + (cw >> 6)] = ss;
  }
}
__device__ void tile_wout(const Params& p, int tile, char* lds) {
  const int rt = tile >> 3, ct = tile & 7; const int row0 = rt * 128, col0 = ct * 128;
  f32x4 acc[4][4];
  float s1[4];
  gemm_mainloop<true>(acc, p.ATT, 512, p.WtOut, 1024, 512, row0, col0, lds);
  { const int lane_ = threadIdx.x & 63, w_ = threadIdx.x >> 6;
#pragma unroll
    for (int m = 0; m < 4; ++m) { const int row = row0 + (w_ >> 1) * 64 + m * 16 + (lane_ & 15); float a = 0.f, c = 0.f;
#pragma unroll
      for (int j = 0; j < 8; ++j) { a += p.ss_att[row * 8 + j]; c += p.ss_ssm[row * 8 + j]; }
      const float ra = rsqrtf(a * (1.0f / 512.0f) + EPSF); s1[m] = rsqrtf(c * (1.0f / 512.0f) + EPSF); const float f = ra / s1[m];
#pragma unroll
      for (int n = 0; n < 4; ++n) acc[m][n] *= f; } }
  gemm_mainloop<false>(acc, p.SSMO, 512, p.WtOut + 512, 1024, 512, row0, col0, lds);
  EPI_IDS
  const int cw = col0 + wc * 64;
#pragma unroll
  for (int m = 0; m < 4; ++m) {
    const int row = row0 + wr * 64 + m * 16 + fr; float ss = 0.f;
#pragma unroll
    for (int n = 0; n < 4; ++n) { const int c = cw + n * 16 + fq * 4; const f32x4 xv = *(const f32x4*)(p.x + (size_t)row * 1024 + c); const f32x4 hv = xv + acc[m][n] * s1[m];
      ss += hv[0] * hv[0] + hv[1] * hv[1] + hv[2] * hv[2] + hv[3] * hv[3];
      *(uint2*)(p.H1B + (size_t)row * 1024 + c) = make_uint2(pack2(hv[0], hv[1]), pack2(hv[2], hv[3])); }
    ss += __shfl_xor(ss, 16); ss += __shfl_xor(ss, 32);
    if (fq == 0) p.ss_h1[row * 16 + (cw >> 6)] = ss;
  }
}
__device__ __forceinline__ float row_rs16(const float* ss, int row) { float a = 0.f;
#pragma unroll
  for (int j = 0; j < 16; ++j) a += ss[row * 16 + j];
  return rsqrtf(a * (1.0f / 1024.0f) + EPSF); }
__device__ void tile_memq(const Params& p, int tile, char* lds) {
  const int rt = tile >> 3, ct = tile & 7; const int row0 = rt * 128, col0 = ct * 128;
  f32x4 acc[4][4];
  gemm_mainloop<true>(acc, p.H1B, 1024, p.WtMq, 1024, 1024, row0, col0, lds);
  EPI_IDS
  const int cw = col0 + wc * 64;
#pragma unroll
  for (int m = 0; m < 4; ++m) {
    const int row = row0 + wr * 64 + m * 16 + fr; const float rs = row_rs16(p.ss_h1, row); float ss = 0.f;
#pragma unroll
    for (int n = 0; n < 4; ++n) { const int c = cw + n * 16 + fq * 4; const f32x4 v = acc[m][n] * rs; ss += v[0] * v[0] + v[1] * v[1] + v[2] * v[2] + v[3] * v[3];
      *(uint2*)(p.QM + (size_t)row * 1024 + c) = make_uint2(pack2(v[0], v[1]), pack2(v[2], v[3])); }
    ss += __shfl_xor(ss, 16); ss += __shfl_xor(ss, 32);
    if (fq == 0) p.ss_qm[row * 16 + (cw >> 6)] = ss;
  }
}
__device__ void mem_attn_item(const Params& p, int item, char* lds_) {
  LAS char* lds = (LAS char*)lds_;
  const int h = item & 3, tt = item >> 2; const int tid = threadIdx.x, lane = tid & 63, w = tid >> 6, fr = lane & 15, fq = lane >> 4;
  const int tq = tt * 64 + w * 16 + fr; const int b = tq >> 13;
  const float ssq = p.ss_qm[tq * 16 + h * 4] + p.ss_qm[tq * 16 + h * 4 + 1] + p.ss_qm[tq * 16 + h * 4 + 2] + p.ss_qm[tq * 16 + h * 4 + 3];
  const float rowscale = rsqrtf(ssq * (1.0f / 256.0f) + EPSF) * 0.0625f;
  bf16x8 qf[8];
#pragma unroll
  for (int ks = 0; ks < 8; ++ks) qf[ks] = *(const bf16x8*)(p.QM + (size_t)tq * 1024 + h * 256 + ks * 32 + fq * 8);
  const bf16_t* kg = p.KMB + (size_t)(b * 4 + h) * 256 * 256;
  const bf16_t* vg = p.VMT + (size_t)(b * 4 + h) * 256 * 256;
  f32x4 o[16];
#pragma unroll
  for (int i = 0; i < 16; ++i) o[i] = (f32x4){0.f, 0.f, 0.f, 0.f};
  float mrun = -1e30f, lrun = 0.f;
  for (int kc = 0; kc < 4; ++kc) {
    __syncthreads();
#pragma unroll
    for (int i = 0; i < 8; ++i) { const int idx = tid + 256 * i; const int row = idx >> 5, ch = idx & 31;
      const u32x4 v = *(const u32x4*)(kg + (size_t)(kc * 64 + row) * 256 + ch * 8); *(LAS u32x4*)(lds + row * 512 + ((ch ^ (row & 15)) << 4)) = v; }
#pragma unroll
    for (int i = 0; i < 8; ++i) { const int idx = tid + 256 * i; const int d = idx >> 3, j = idx & 7;
      const u32x4 v = *(const u32x4*)(vg + (size_t)d * 256 + kc * 64 + j * 8); *(LAS u32x4*)(lds + 32768 + d * 128 + ((j ^ ((d >> 1) & 7)) << 4)) = v; }
    __syncthreads();
    f32x4 st[4];
#pragma unroll
    for (int mt = 0; mt < 4; ++mt) { f32x4 sacc = (f32x4){0.f, 0.f, 0.f, 0.f}; const int row = mt * 16 + fr;
#pragma unroll
      for (int ks = 0; ks < 8; ++ks) sacc = mfma16(as_bf(*(const LAS u32x4*)(lds + row * 512 + (((ks * 4 + fq) ^ (row & 15)) << 4))), qf[ks], sacc);
      st[mt] = sacc * rowscale; }
    float tmax = -1e30f;
#pragma unroll
    for (int mt = 0; mt < 4; ++mt) tmax = fmaxf(fmaxf(fmaxf(tmax, st[mt][0]), fmaxf(st[mt][1], st[mt][2])), st[mt][3]);
    tmax = fmaxf(tmax, __shfl_xor(tmax, 16)); tmax = fmaxf(tmax, __shfl_xor(tmax, 32));
    const float mnew = fmaxf(mrun, tmax); const float alpha = __expf(mrun - mnew); mrun = mnew;
    float ls = 0.f;
#pragma unroll
    for (int mt = 0; mt < 4; ++mt)
#pragma unroll
      for (int j = 0; j < 4; ++j) { const float e = __expf(st[mt][j] - mnew); st[mt][j] = e; ls += e; }
    lrun = lrun * alpha + ls;
    bf16x8 pf[2];
#pragma unroll
    for (int s2 = 0; s2 < 2; ++s2) { u32x4 t; t.x = pack2(st[2 * s2][0], st[2 * s2][1]); t.y = pack2(st[2 * s2][2], st[2 * s2][3]); t.z = pack2(st[2 * s2 + 1][0], st[2 * s2 + 1][1]); t.w = pack2(st[2 * s2 + 1][2], st[2 * s2 + 1][3]); pf[s2] = as_bf(t); }
#pragma unroll
    for (int dt = 0; dt < 16; ++dt) { const int d = dt * 16 + fr; const int sw = ((d >> 1) & 7) << 1; f32x4 oc = o[dt] * alpha;
#pragma unroll
      for (int s2 = 0; s2 < 2; ++s2) { typedef unsigned u32x2 __attribute__((ext_vector_type(2)));
        const u32x2 lo = *(const LAS u32x2*)(lds + 32768 + d * 128 + (((s2 * 8 + fq) ^ sw) << 3)), hi = *(const LAS u32x2*)(lds + 32768 + d * 128 + (((s2 * 8 + fq + 4) ^ sw) << 3));
        u32x4 vv; vv.x = lo.x; vv.y = lo.y; vv.z = hi.x; vv.w = hi.y; oc = mfma16(as_bf(vv), pf[s2], oc); }
      o[dt] = oc; }
  }
  float lt = lrun; lt += __shfl_xor(lt, 16); lt += __shfl_xor(lt, 32);
  const float inv = 1.0f / lt;
  bf16_t* dst = p.OM + (size_t)tq * 1024 + h * 256;
#pragma unroll
  for (int dt = 0; dt < 16; ++dt) { const f32x4 v = o[dt] * inv; *(uint2*)(dst + dt * 16 + fq * 4) = make_uint2(pack2(v[0], v[1]), pack2(v[2], v[3])); }
}
__device__ void tile_memo(const Params& p, int tile, char* lds) {
  const int rt = tile >> 3, ct = tile & 7; const int row0 = rt * 128, col0 = ct * 128;
  f32x4 acc[4][4];
  gemm_mainloop<true>(acc, p.OM, 1024, p.WtMo, 1024, 1024, row0, col0, lds);
  EPI_IDS
  const int cw = col0 + wc * 64;
#pragma unroll
  for (int m = 0; m < 4; ++m) {
    const int row = row0 + wr * 64 + m * 16 + fr; float ss = 0.f;
#pragma unroll
    for (int n = 0; n < 4; ++n) { const int c = cw + n * 16 + fq * 4; const uint2 hb = *(const uint2*)(p.H1B + (size_t)row * 1024 + c);
      const f32x4 hv = (f32x4){__uint_as_float(hb.x << 16), __uint_as_float(hb.x & 0xffff0000u), __uint_as_float(hb.y << 16), __uint_as_float(hb.y & 0xffff0000u)} + acc[m][n];
      ss += hv[0] * hv[0] + hv[1] * hv[1] + hv[2] * hv[2] + hv[3] * hv[3];
      *(uint2*)(p.H2B + (size_t)row * 1024 + c) = make_uint2(pack2(hv[0], hv[1]), pack2(hv[2], hv[3])); }
    ss += __shfl_xor(ss, 16); ss += __shfl_xor(ss, 32);
    if (fq == 0) p.ss_h2[row * 16 + (cw >> 6)] = ss;
  }
}
__device__ void tile_peerq(const Params& p, int tile, char* lds) {
  const int rt = tile >> 4, ct = tile & 15; const int row0 = rt * 128, col0 = ct * 128;
  f32x4 acc[4][4];
  gemm_mainloop<true>(acc, p.H2B, 1024, p.WtPq, 1024, 1024, row0, col0, lds);
  EPI_IDS
  const int cw = col0 + wc * 64;
#pragma unroll
  for (int m = 0; m < 4; ++m) {
    const int row = row0 + wr * 64 + m * 16 + fr; const float rs = row_rs16(p.ss_h2, row);
#pragma unroll
    for (int n = 0; n < 4; ++n) { const int c = cw + n * 16 + fq * 4; const f32x4 v = acc[m][n] * rs;
      *(uint2*)(p.QP + (size_t)row * 2048 + c) = make_uint2(pack2(v[0], v[1]), pack2(v[2], v[3])); }
  }
}
__device__ __forceinline__ void ins16(float (&a)[16], float v) {
#pragma unroll
  for (int i = 0; i < 16; ++i) { const float hi = fmaxf(a[i], v), lo = fminf(a[i], v); a[i] = hi; v = lo; }
}
__device__ void tile_scores(const Params& p, int tile, char* lds) {
  const int rt = tile >> 4, hs = tile & 15; const int row0 = rt * 128;
  f32x4 acc[4][4];
  gemm_mainloop<true>(acc, p.QP + hs * 128, 2048, p.PK + (size_t)hs * 128 * 128, 128, 128, row0, 0, lds);
  EPI_IDS
  float* tl = (float*)lds;
#pragma unroll
  for (int m = 0; m < 4; ++m)
#pragma unroll
    for (int n = 0; n < 4; ++n)
#pragma unroll
      for (int j = 0; j < 4; ++j) tl[(wr * 64 + m * 16 + fr) * 129 + wc * 64 + n * 16 + fq * 4 + j] = acc[m][n][j];
  __syncthreads();
  if (tid < 128) {
    float a[16];
#pragma unroll
    for (int i = 0; i < 16; ++i) a[i] = -__builtin_inff();
    for (int n = 0; n < 128; ++n) { const float v = __uint_as_float((__float_as_uint(tl[tid * 129 + n]) & ~127u) | (unsigned)n); ins16(a, v); }
    uint4* dst = (uint4*)(p.TOPS + ((size_t)(row0 + tid) * 16 + hs) * 16);
    dst[0] = make_uint4(__float_as_uint(a[0]), __float_as_uint(a[1]), __float_as_uint(a[2]), __float_as_uint(a[3]));
    dst[1] = make_uint4(__float_as_uint(a[4]), __float_as_uint(a[5]), __float_as_uint(a[6]), __float_as_uint(a[7]));
    dst[2] = make_uint4(__float_as_uint(a[8]), __float_as_uint(a[9]), __float_as_uint(a[10]), __float_as_uint(a[11]));
    dst[3] = make_uint4(__float_as_uint(a[12]), __float_as_uint(a[13]), __float_as_uint(a[14]), __float_as_uint(a[15]));
  }
}
__device__ void peer_gather_item(const Params& p, int item, char* lds) {
  const int tid = threadIdx.x, lane = tid & 63, w = tid >> 6;
  unsigned* LA = (unsigned*)lds;
  int* LE = (int*)(lds + 256 * 33 * 4);
  float* LG = (float*)(lds + 256 * 33 * 4 + 32 * 128 * 4);
  __syncthreads();
  {
    const int tl_ = tid >> 3, h = tid & 7; const int t = item * 32 + tl_;
    const uint4* src = (const uint4*)(p.TOPS + ((size_t)t * 16 + h * 2) * 16);
    float a[16], bq[16];
#pragma unroll
    for (int i = 0; i < 4; ++i) { const uint4 v = src[i]; a[4 * i] = __uint_as_float(v.x); a[4 * i + 1] = __uint_as_float(v.y); a[4 * i + 2] = __uint_as_float(v.z); a[4 * i + 3] = __uint_as_float(v.w); }
#pragma unroll
    for (int i = 0; i < 4; ++i) { const uint4 v = src[4 + i]; bq[4 * i] = __uint_as_float(v.x); bq[4 * i + 1] = __uint_as_float(v.y); bq[4 * i + 2] = __uint_as_float(v.z); bq[4 * i + 3] = __uint_as_float(v.w); }
#pragma unroll
    for (int i = 0; i < 16; ++i) { LA[tid * 33 + i] = __float_as_uint(a[i]); LA[tid * 33 + 16 + i] = __float_as_uint(bq[i]); }
    float c[16];
#pragma unroll
    for (int i = 0; i < 16; ++i) c[i] = -__builtin_inff();
#pragma unroll
    for (int i = 0; i < 16; ++i)
#pragma unroll
      for (int j = 0; j < 16; ++j) if ((i + 1) * (j + 1) <= 16) { const float s = a[i] + bq[j]; ins16(c, __uint_as_float((__float_as_uint(s) & ~255u) | (unsigned)(i * 16 + j))); }
    const float mx = c[0]; float e[16]; float sum = 0.f;
#pragma unroll
    for (int i = 0; i < 16; ++i) { e[i] = __expf(c[i] - mx); sum += e[i]; }
    const float inv = 1.0f / sum;
#pragma unroll
    for (int i = 0; i < 16; ++i) { const unsigned pos = __float_as_uint(c[i]) & 255u; const unsigned ia = LA[tid * 33 + (pos >> 4)] & 127u, ib = LA[tid * 33 + 16 + (pos & 15u)] & 127u;
      LE[tl_ * 128 + h * 16 + i] = (int)(ia * 128u + ib); LG[tl_ * 128 + h * 16 + i] = e[i] * inv; }
  }
  __syncthreads();
  for (int ti = 0; ti < 8; ++ti) {
    const int tl_ = w * 8 + ti; const int t = item * 32 + tl_;
    const float rs = row_rs16(p.ss_h2, t);
    f32x2 hn[8], hres[8];
    { const uint4 ha = *(const uint4*)(p.H2B + (size_t)t * 1024 + lane * 16), hb = *(const uint4*)(p.H2B + (size_t)t * 1024 + lane * 16 + 8);
      const unsigned hw[8] = {ha.x, ha.y, ha.z, ha.w, hb.x, hb.y, hb.z, hb.w};
#pragma unroll
      for (int i = 0; i < 8; ++i) { hres[i].x = __uint_as_float(hw[i] << 16); hres[i].y = __uint_as_float(hw[i] & 0xffff0000u);
        const float2 g = *(const float2*)(p.norm_peer_g + lane * 16 + 2 * i); hn[i].x = hres[i].x * rs * g.x; hn[i].y = hres[i].y * rs * g.y; } }
    f32x2 oa[8];
#pragma unroll
    for (int i = 0; i < 8; ++i) oa[i] = (f32x2){0.f, 0.f};
    for (int k = 0; k < 128; k += 4) {
      int e[4]; float gg[4], scu[4], scv[4]; uint4 uq[4], vq[4];
#pragma unroll
      for (int u = 0; u < 4; ++u) { e[u] = __builtin_amdgcn_readfirstlane(LE[tl_ * 128 + k + u]); gg[u] = LG[tl_ * 128 + k + u]; }
#pragma unroll
      for (int u = 0; u < 4; ++u) { uq[u] = *(const uint4*)(p.PU8 + (size_t)e[u] * 1024 + lane * 16); vq[u] = *(const uint4*)(p.PV8 + (size_t)e[u] * 1024 + lane * 16); scu[u] = p.su[e[u]]; scv[u] = p.sv[e[u]]; }
#pragma unroll
      for (int u = 0; u < 4; ++u) {
        f32x2 d2 = (f32x2){0.f, 0.f};
        d2 += __builtin_amdgcn_cvt_pk_f32_fp8((int)uq[u].x, false) * hn[0]; d2 += __builtin_amdgcn_cvt_pk_f32_fp8((int)uq[u].x, true) * hn[1];
        d2 += __builtin_amdgcn_cvt_pk_f32_fp8((int)uq[u].y, false) * hn[2]; d2 += __builtin_amdgcn_cvt_pk_f32_fp8((int)uq[u].y, true) * hn[3];
        d2 += __builtin_amdgcn_cvt_pk_f32_fp8((int)uq[u].z, false) * hn[4]; d2 += __builtin_amdgcn_cvt_pk_f32_fp8((int)uq[u].z, true) * hn[5];
        d2 += __builtin_amdgcn_cvt_pk_f32_fp8((int)uq[u].w, false) * hn[6]; d2 += __builtin_amdgcn_cvt_pk_f32_fp8((int)uq[u].w, true) * hn[7];
        float d = d2.x + d2.y;
#pragma unroll
        for (int o = 32; o > 0; o >>= 1) d += __shfl_xor(d, o);
        const float wgt = gg[u] * gelu_f(d * scu[u]) * scv[u];
        oa[0] += __builtin_amdgcn_cvt_pk_f32_fp8((int)vq[u].x, false) * wgt; oa[1] += __builtin_amdgcn_cvt_pk_f32_fp8((int)vq[u].x, true) * wgt;
        oa[2] += __builtin_amdgcn_cvt_pk_f32_fp8((int)vq[u].y, false) * wgt; oa[3] += __builtin_amdgcn_cvt_pk_f32_fp8((int)vq[u].y, true) * wgt;
        oa[4] += __builtin_amdgcn_cvt_pk_f32_fp8((int)vq[u].z, false) * wgt; oa[5] += __builtin_amdgcn_cvt_pk_f32_fp8((int)vq[u].z, true) * wgt;
        oa[6] += __builtin_amdgcn_cvt_pk_f32_fp8((int)vq[u].w, false) * wgt; oa[7] += __builtin_amdgcn_cvt_pk_f32_fp8((int)vq[u].w, true) * wgt;
      }
    }
    float* op = p.out + (size_t)t * 1024 + lane * 16;
#pragma unroll
    for (int i = 0; i < 4; ++i) { const f32x2 a = hres[2 * i] + oa[2 * i], b = hres[2 * i + 1] + oa[2 * i + 1]; *(float4*)(op + 4 * i) = make_float4(a.x, a.y, b.x, b.y); }
  }
}

template <int PH>
__device__ __forceinline__ void run_phase(const Params& p, char* lds, int bid, int nb) {
  if (PH == 0) {
    const int nt_in = 16 * 32, nt_glu = 8 * 8, nt_out = 16 * 16, nt_m = 16 * 16, nt_pq = 16 * 32;
    const int total = nt_in + nt_glu + nt_out + 4 * nt_m + nt_pq;
    for (int t = bid; t < total; t += nb) {
      int i = t; float* tl = (float*)lds;
      if (i < nt_in) { transpose_tile(p.w_in, p.WtIn, 1024, 2048, i, p.norm_mix_g, p.norm_mix_g, 1024, tl); continue; } i -= nt_in;
      if (i < nt_glu) { transpose_tile(p.w_glu, p.WtGlu, 512, 512, i, nullptr, nullptr, 0, tl); continue; } i -= nt_glu;
      if (i < nt_out) { transpose_tile(p.w_out, p.WtOut, 1024, 1024, i, p.att_out_g, p.ssm_out_g, 512, tl); continue; } i -= nt_out;
      if (i < nt_m) { transpose_tile(p.w_mem_q, p.WtMq, 1024, 1024, i, p.norm_mem_g, p.norm_mem_g, 1024, tl); continue; } i -= nt_m;
      if (i < nt_m) { transpose_tile(p.w_mem_k, p.WtMk, 1024, 1024, i, p.norm_memkv_g, p.norm_memkv_g, 1024, tl); continue; } i -= nt_m;
      if (i < nt_m) { transpose_tile(p.w_mem_v, p.WtMv, 1024, 1024, i, p.norm_memkv_g, p.norm_memkv_g, 1024, tl); continue; } i -= nt_m;
      if (i < nt_m) { transpose_tile(p.w_mem_o, p.WtMo, 1024, 1024, i, nullptr, nullptr, 0, tl); continue; } i -= nt_m;
      transpose_tile(p.w_peer_q, p.WtPq, 1024, 2048, i, p.norm_peer_g, p.norm_peer_g, 1024, tl);
    }
    convert_flat(p.peer_keys, p.PK, (size_t)16 * 128 * 128 / 8, bid, nb);
    rows_fp8(p.peer_u, p.PU8, p.su, 16384, bid, nb);
    rows_fp8(p.peer_v, p.PV8, p.sv, 16384, bid, nb);
    rows_bf16_rs(p.x, p.XB, p.rs_x, T_TOK, bid, nb);
    rows_bf16_rs(p.mem, p.MEMB, p.rs_mem, 512, bid, nb);
    for (int i = bid * NTHREADS + threadIdx.x; i < 2048; i += nb * NTHREADS) ssm_stage1(p, i);
  } else if (PH == 1) {
    for (int t = bid; t < 2048 + 64; t += nb) { if (t < 2048) { if (((t & 15) >> 2) == 2) tile_win_v(p, t, lds); else tile_win(p, t, lds); } else tile_memkv(p, t - 2048, lds); }
    ssm_stage2a(p, bid, nb);
  } else if (PH == 2) {
    for (int t = bid; t < 2048; t += nb) chunk_attn_item(p, t, lds);
    for (int t = bid; t < 2048; t += nb) ssm_item<false>(p, t, lds);
    memk_fix(p, bid, nb);
    ssm_stage2b(p, bid, nb);
  } else if (PH == 3) {
    for (int t = bid; t < 2048; t += nb) ssm_item<true>(p, t, lds);
  } else if (PH == 4) {
    for (int t = bid; t < 512; t += nb) tile_glu(p, t, lds);
  } else if (PH == 5) {
    for (int t = bid; t < 1024; t += nb) tile_wout(p, t, lds);
  } else if (PH == 6) {
    for (int t = bid; t < 1024; t += nb) tile_memq(p, t, lds);
  } else if (PH == 7) {
    for (int t = bid; t < 1024; t += nb) mem_attn_item(p, t, lds);
  } else if (PH == 8) {
    for (int t = bid; t < 1024; t += nb) tile_memo(p, t, lds);
  } else if (PH == 9) {
    for (int t = bid; t < 2048; t += nb) tile_peerq(p, t, lds);
  } else if (PH == 10) {
    for (int t = bid; t < 2048; t += nb) tile_scores(p, t, lds);
  } else if (PH == 11) {
    for (int t = bid; t < 512; t += nb) peer_gather_item(p, t, lds);
  }
}

#if !MEGA
template <int PH>
__global__ void __launch_bounds__(NTHREADS, 2) phase_kernel(Params p) {
  extern __shared__ __attribute__((aligned(16))) char lds[];
  run_phase<PH>(p, lds, blockIdx.x, gridDim.x);
}

#endif
#ifndef REPEAT_PH
#define REPEAT_PH -1
#endif
#define RUNPH(k) do { run_phase<k>(p, lds, bid, nb); if (REPEAT_PH == k) { xcd_barrier(xb); run_phase<k>(p, lds, bid, nb); } } while (0)
__global__ void __launch_bounds__(NTHREADS, 2) mega_kernel(Params p) {
  extern __shared__ __attribute__((aligned(16))) char lds[];
  cg::grid_group grid = cg::this_grid();
  const int bid = blockIdx.x, nb = gridDim.x;
  volatile LAS unsigned* stw = (volatile LAS unsigned*)((LAS char*)lds + LDS_WORK);
  if (threadIdx.x == 0) { stw[0] = 0u; stw[1] = 0u; stw[2] = 0u; stw[3] = 0u; }
  __syncthreads();
  XcdBarrier xb = xcd_barrier_post(p.bar, stw);
  RUNPH(0); grid.sync();
  RUNPH(1); xcd_barrier(xb);
  RUNPH(2); xcd_barrier(xb);
  RUNPH(3); xcd_barrier(xb);
  RUNPH(4); xcd_barrier(xb);
  RUNPH(5); xcd_barrier(xb);
  RUNPH(6); xcd_barrier(xb);
  RUNPH(7); xcd_barrier(xb);
  RUNPH(8); xcd_barrier(xb);
  RUNPH(9); xcd_barrier(xb);
  RUNPH(10); xcd_barrier(xb);
  RUNPH(11);
}

#if !MEGA
template <int PH> static void launch_phase(const Params& p, int grid, hipStream_t s) {
  hipFuncSetAttribute((const void*)phase_kernel<PH>, hipFuncAttributeMaxDynamicSharedMemorySize, LDS_BYTES);
  phase_kernel<PH><<<grid, NTHREADS, LDS_BYTES, s>>>(p);
}
#endif

extern "C" void kernel_launch(void* const* d_in, const int* in_sizes, int n_in, void* d_out, int out_size, void* d_ws, size_t ws_size, hipStream_t stream) {
  Params p{};
  const float** f = (const float**)&p;
  for (int i = 0; i < 33; ++i) f[i] = (const float*)d_in[i];
  p.out = (float*)d_out;
  char* ws = (char*)d_ws; size_t off = 0;
  auto take = [&](size_t bytes) { char* r = ws + off; off += (bytes + 255) & ~(size_t)255; return r; };
  const size_t MB = 1u << 20;
  p.bar = (unsigned*)take(16384);
  p.WtIn = (bf16_t*)take(4 * MB); p.WtGlu = (bf16_t*)take(MB / 2); p.WtOut = (bf16_t*)take(2 * MB);
  p.WtMq = (bf16_t*)take(2 * MB); p.WtMk = (bf16_t*)take(2 * MB); p.WtMv = (bf16_t*)take(2 * MB); p.WtMo = (bf16_t*)take(2 * MB); p.WtPq = (bf16_t*)take(4 * MB);
  p.PK = (bf16_t*)take(MB / 2); p.PU8 = (unsigned char*)take(16 * MB); p.PV8 = (unsigned char*)take(16 * MB); p.su = (float*)take(16384 * 4); p.sv = (float*)take(16384 * 4);
  char* RA = take(64 * MB); char* RB = take(64 * MB);
  p.XB = (bf16_t*)RA; p.ATT = (bf16_t*)RA; p.YG = (bf16_t*)(RA + 16 * MB); p.QM = (bf16_t*)RA; p.H2B = (bf16_t*)RA;
  p.SSMO = (bf16_t*)(RA + 32 * MB); p.OM = (bf16_t*)(RA + 32 * MB);
  p.Qb = (bf16_t*)RB; p.Kb = (bf16_t*)(RB + 16 * MB); p.VT = (bf16_t*)(RB + 32 * MB); p.Ub = (bf16_t*)(RB + 48 * MB); p.H1B = (bf16_t*)RB; p.QP = (bf16_t*)RB;
  p.TOPS = (unsigned*)take(16 * MB);
  p.MEMB = (bf16_t*)take(MB); p.KMB = (bf16_t*)take(MB); p.VMT = (bf16_t*)take(MB); p.KMraw = (float*)take(2 * MB);
  p.WE16 = (bf16_t*)take(2 * MB); p.WY = (bf16_t*)take(6 * MB);
  p.rs_x = (float*)take(T_TOK * 4); p.rs_mem = (float*)take(512 * 4); p.ss_att = (float*)take(T_TOK * 8 * 4); p.ss_ssm = (float*)take(T_TOK * 8 * 4);
  p.ss_h1 = (float*)take(T_TOK * 16 * 4); p.ss_qm = (float*)take(T_TOK * 16 * 4); p.ss_km = (float*)take(512 * 16 * 4); p.ss_h2 = (float*)take(T_TOK * 16 * 4);
  p.ESEG = (float*)take(2 * 32 * 32 * 128 * 4);
  p.BBR = (float*)take(2048 * 16 * 4); p.BBI = (float*)take(2048 * 16 * 4); p.PWR = (float*)take(32 * 17 * 64 * 4); p.PWI = (float*)take(32 * 17 * 64 * 4); p.KJ = (float*)take(32 * 16 * 256 * 4); p.APW = (float*)take(5 * 4096 * 4);
  if (off > ws_size) { fprintf(stderr, "workspace too small: need %zu have %zu\n", off, ws_size); return; }
#if MEGA
  hipMemsetAsync(p.bar, 0, 16384, stream);
  static int grid_blocks = 0;
  if (!grid_blocks) {
    int dev = 0, cus = 0, per_cu = 0; hipGetDevice(&dev); hipDeviceGetAttribute(&cus, hipDeviceAttributeMultiprocessorCount, dev);
    hipFuncSetAttribute((const void*)mega_kernel, hipFuncAttributeMaxDynamicSharedMemorySize, LDS_BYTES);
    hipOccupancyMaxActiveBlocksPerMultiprocessor(&per_cu, mega_kernel, NTHREADS, LDS_BYTES);
    if (per_cu > 2) per_cu = 2; if (per_cu < 1) per_cu = 1;
    grid_blocks = cus * per_cu;
  }
  void* args[] = {&p};
  hipError_t e = hipLaunchCooperativeKernel((void*)mega_kernel, dim3(grid_blocks), dim3(NTHREADS), args, LDS_BYTES, stream);
  if (e != hipSuccess) fprintf(stderr, "cooperative launch failed: %s (grid %d)\n", hipGetErrorString(e), grid_blocks);
#else
  const int G = 1024;
  launch_phase<0>(p, G, stream); launch_phase<1>(p, G, stream); launch_phase<2>(p, G, stream); launch_phase<3>(p, G, stream);
  launch_phase<4>(p, G, stream); launch_phase<5>(p, G, stream); launch_phase<6>(p, G, stream); launch_phase<7>(p, G, stream);
  launch_phase<8>(p, G, stream); launch_phase<9>(p, G, stream); launch_phase<10>(p, G, stream); launch_phase<11>(p, G, stream);
#endif
}
```

```cpp
#include <hip/hip_runtime.h>
#include <hip/hip_cooperative_groups.h>
#include <cstdio>
#include <cstdint>
namespace cg = cooperative_groups;

#ifndef MEGA
#define MEGA 1
#endif

typedef unsigned short bf16_t;
typedef short bf16x8 __attribute__((ext_vector_type(8)));
typedef float f32x4 __attribute__((ext_vector_type(4)));
typedef unsigned u32x4 __attribute__((ext_vector_type(4)));
#define LAS __attribute__((address_space(3)))
__device__ __forceinline__ bf16x8 as_bf(u32x4 v) { return __builtin_bit_cast(bf16x8, v); }

#define T_TOK 16384
#define SEQL 8192
#define NTHREADS 256
#define LDS_WORK 66560
#define LDS_BYTES (LDS_WORK + 16)
#define EPSF 1e-6f

__device__ __forceinline__ unsigned short f2bf(float f) { unsigned u = __float_as_uint(f); u += 0x7fffu + ((u >> 16) & 1u); return (unsigned short)(u >> 16); }
__device__ __forceinline__ float bf2f(unsigned short b) { return __uint_as_float(((unsigned)b) << 16); }
__device__ __forceinline__ unsigned pack2(float lo, float hi) { return (unsigned)f2bf(lo) | ((unsigned)f2bf(hi) << 16); }
__device__ __forceinline__ float gelu_f(float v) {
  const float av = fabsf(v), t = __builtin_amdgcn_rcpf(av * 0.2316418882f + 1.0f);
  float q = t * 0.5307027145f + (-0.7265760135f); q = q * t + 0.7107068705f; q = q * t + (-0.142248368f); q = q * t + 0.127414796f; q = q * t;
  const float e = __builtin_amdgcn_exp2f((v * v) * (-0.72134752044f)); const float m = v * (q * e);
  return v < 0.f ? m : v - m; }
typedef float f32x2 __attribute__((ext_vector_type(2)));
__device__ __forceinline__ f32x4 mfma16(bf16x8 a, bf16x8 b, f32x4 c) { return __builtin_amdgcn_mfma_f32_16x16x32_bf16(a, b, c, 0, 0, 0); }


#define XB_TMO      128
#define XB_XCNT(j)  (256  + 64 * (j))
#define XB_XSUB(j)  (1280 + 64 * (j))
#define XB_XGEN(j)  (2304 + 64 * (j))
#define XB_TOP      3328
#define XB_TOPGEN   3392
#define XCD_BAR_WORDS 3456
#define XB_SPIN_CAP (1u << 18)
__device__ __forceinline__ unsigned xb_ld(unsigned* p)              { return __hip_atomic_load(p, __ATOMIC_RELAXED, __HIP_MEMORY_SCOPE_AGENT); }
__device__ __forceinline__ unsigned xb_add(unsigned* p, unsigned v) { return __hip_atomic_fetch_add(p, v, __ATOMIC_RELAXED, __HIP_MEMORY_SCOPE_AGENT); }
__device__ __forceinline__ unsigned xb_xcc_id() { return (unsigned)__builtin_amdgcn_s_getreg((3 << 11) | 20) & 0xFu; }
#define XB_SPIN(cond, bar) do { unsigned _sp = 0; while (cond) { __builtin_amdgcn_s_sleep(1); \
    if ((++_sp & 255u) == 0u) { if (xb_ld(&(bar)[XB_TMO])) break; if (_sp > XB_SPIN_CAP) { atomicAdd(&(bar)[XB_TMO], 1u); break; } } } } while (0)
struct XcdBarrier { unsigned* bar; unsigned x; volatile LAS unsigned* st; };
__device__ __forceinline__ XcdBarrier xcd_barrier_post(unsigned* bar, volatile LAS unsigned* st) {
  XcdBarrier b; b.bar = bar; b.x = xb_xcc_id(); b.st = st;
  if (threadIdx.x == 0) (void)xb_add(&bar[XB_XCNT(b.x)], 1u);
  return b;
}
__device__ __forceinline__ void xcd_barrier_complete(unsigned* bar, unsigned x, unsigned& nloc, unsigned& nx) {
  const unsigned G = gridDim.x * gridDim.y * gridDim.z;
  unsigned sum, cnt, mine, sp = 0u;
  for (;;) {
    sum = 0u; cnt = 0u; mine = 0u;
#pragma unroll
    for (unsigned j = 0; j < 16; ++j) { const unsigned c = xb_ld(&bar[XB_XCNT(j)]); sum += c; cnt += (c > 0u) ? 1u : 0u; mine = (j == x) ? c : mine; }
    if (sum == G) break;
    __builtin_amdgcn_s_sleep(1);
    if ((++sp & 255u) == 0u) { if (xb_ld(&bar[XB_TMO])) break; if (sp > XB_SPIN_CAP) { atomicAdd(&bar[XB_TMO], 1u); break; } }
  }
  nloc = mine > 0u ? mine : 1u; nx = cnt > 0u ? cnt : 1u;
}
__device__ __forceinline__ void xcd_barrier(const XcdBarrier& b) {
  asm volatile("s_waitcnt vmcnt(0)" ::: "memory");
  __syncthreads();
  if (threadIdx.x == 0) {
    unsigned* bar = b.bar;
    __builtin_amdgcn_s_waitcnt(0);
    unsigned nloc = b.st[0], nx = b.st[1];
    if (nloc == 0u) { xcd_barrier_complete(bar, b.x, nloc, nx); b.st[0] = nloc; b.st[1] = nx; }
    const unsigned old = xb_add(&bar[XB_XSUB(b.x)], 1u);
    const unsigned gen = old / nloc;
    if (old + 1u == (gen + 1u) * nloc) {
      __builtin_amdgcn_fence(__ATOMIC_RELEASE, "agent");
      asm volatile("s_waitcnt vmcnt(0)" ::: "memory");
      const unsigned og = xb_add(&bar[XB_TOP], 1u);
      const unsigned tg = og / nx;
      if (og + 1u == (tg + 1u) * nx) xb_add(&bar[XB_TOPGEN], 1u);
      else XB_SPIN(xb_ld(&bar[XB_TOPGEN]) == tg, bar);
      __builtin_amdgcn_fence(__ATOMIC_ACQUIRE, "agent");
      xb_add(&bar[XB_XGEN(b.x)], 1u);
      asm volatile("s_waitcnt vmcnt(0)" ::: "memory");
    } else {
      XB_SPIN(xb_ld(&bar[XB_XGEN(b.x)]) == gen, bar);
      __builtin_amdgcn_fence(__ATOMIC_ACQUIRE, "agent");
      asm volatile("s_waitcnt vmcnt(0)" ::: "memory");
    }
  }
  __syncthreads();
}

struct Params {
  const float *x, *mem, *norm_mix_g, *w_in, *att_q_g, *att_k_g, *rel_bias;
  const float *lam_re, *lam_im, *log_step, *b_re, *b_im, *c_re, *c_im, *d_skip, *w_glu, *b_glu;
  const float *att_out_g, *ssm_out_g, *w_out, *norm_mem_g, *norm_memkv_g, *w_mem_q, *w_mem_k, *w_mem_v;
  const float *mem_q_g, *mem_k_g, *w_mem_o, *norm_peer_g, *w_peer_q, *peer_keys, *peer_u, *peer_v;
  float* out;
  unsigned* bar;
  bf16_t *WtIn, *WtGlu, *WtOut, *WtMq, *WtMk, *WtMv, *WtMo, *WtPq, *PK, *PU, *PV;
  bf16_t *XB, *MEMB, *Qb, *Kb, *VT, *Ub, *ATT, *YG, *SSMO, *H1B, *QM, *OM, *H2B, *QP;
  bf16_t *KMB, *VMT, *WE16, *WY;
  float *rs_x, *rs_mem, *ss_att, *ss_ssm, *ss_h1, *ss_qm, *ss_km, *ss_h2, *KMraw, *ESEG;
  float *BBR, *BBI, *PWR, *PWI, *KJ, *APW;
  unsigned* TOPS;
  unsigned char *PU8, *PV8; float *su, *sv;
};

#define GAS __attribute__((address_space(1)))
template <bool ZERO = true, bool SWAP = false>
__device__ __forceinline__ void gemm_mainloop(f32x4 (&acc)[4][4], const bf16_t* __restrict__ A, int lda, const bf16_t* __restrict__ Bt, int ldb, int K,
                                              int row0, int col0, char* lds_) {
  LAS char* lds = (LAS char*)lds_;
  const int tid = threadIdx.x, lane = tid & 63, w = tid >> 6, wr = w >> 1, wc = w & 1, fr = lane & 15, fq = lane >> 4;
  if (ZERO) {
#pragma unroll
    for (int m = 0; m < 4; ++m)
#pragma unroll
      for (int n = 0; n < 4; ++n) acc[m][n] = (f32x4){0.f, 0.f, 0.f, 0.f};
  }
  const int lr = lane >> 3, lc = (lane & 7) ^ lr;
  const bf16_t* gA = A + (size_t)(row0 + w * 32 + lr) * lda + lc * 8;
  const bf16_t* gB = Bt + (size_t)(col0 + w * 32 + lr) * ldb + lc * 8;
  const int wbase = __builtin_amdgcn_readfirstlane(w) * 4096;
  const int nk = K >> 6;
  __syncthreads();
#pragma unroll
  for (int i = 0; i < 4; ++i) {
    __builtin_amdgcn_global_load_lds((const GAS void*)(gA + (size_t)(i * 8) * lda), (LAS void*)(lds + wbase + i * 1024), 16, 0, 0);
    __builtin_amdgcn_global_load_lds((const GAS void*)(gB + (size_t)(i * 8) * ldb), (LAS void*)(lds + 16384 + wbase + i * 1024), 16, 0, 0);
  }
  asm volatile("s_waitcnt vmcnt(0)" ::: "memory");
  __syncthreads();
  for (int kt = 0; kt < nk; ++kt) {
    LAS char* cur = lds + (kt & 1) * 32768; LAS char* nxt = lds + ((kt + 1) & 1) * 32768;
    if (kt + 1 < nk) {
      const int k1 = (kt + 1) << 6;
#pragma unroll
      for (int i = 0; i < 4; ++i) {
        __builtin_amdgcn_global_load_lds((const GAS void*)(gA + (size_t)(i * 8) * lda + k1), (LAS void*)(nxt + wbase + i * 1024), 16, 0, 0);
        __builtin_amdgcn_global_load_lds((const GAS void*)(gB + (size_t)(i * 8) * ldb + k1), (LAS void*)(nxt + 16384 + wbase + i * 1024), 16, 0, 0);
      }
    }
#pragma unroll
    for (int ks = 0; ks < 2; ++ks) {
      bf16x8 af[4], bfr[4];
      const int kc = ks * 4 + fq;
#pragma unroll
      for (int m = 0; m < 4; ++m) { const int r = wr * 64 + m * 16 + fr; af[m] = as_bf(*(const LAS u32x4*)(cur + r * 128 + ((kc ^ (r & 7)) << 4))); }
#pragma unroll
      for (int n = 0; n < 4; ++n) { const int r = wc * 64 + n * 16 + fr; bfr[n] = as_bf(*(const LAS u32x4*)(cur + 16384 + r * 128 + ((kc ^ (r & 7)) << 4))); }
#pragma unroll
      for (int m = 0; m < 4; ++m)
#pragma unroll
        for (int n = 0; n < 4; ++n) acc[m][n] = SWAP ? mfma16(af[m], bfr[n], acc[m][n]) : mfma16(bfr[n], af[m], acc[m][n]);
    }
    asm volatile("s_waitcnt vmcnt(0)" ::: "memory");
    __syncthreads();
  }
}

__device__ void transpose_tile(const float* __restrict__ src, bf16_t* __restrict__ dst, int K, int N, int tile, const float* g0, const float* g1, int split, float* tl  ) {
  const int ntn = N >> 6; const int tk = tile / ntn, tn = tile % ntn; const int k0 = tk << 6, n0 = tn << 6; const int tid = threadIdx.x;
  __syncthreads();
#pragma unroll 4
  for (int i = 0; i < 16; ++i) { const int kk = i * 4 + (tid >> 6), nn = tid & 63; const int k = k0 + kk;
    float g = 1.f; if (g0) g = (k < split) ? g0[k] : g1[k - split];
    tl[kk * 65 + nn] = src[(size_t)k * N + n0 + nn] * g; }
  __syncthreads();
  const int n = tid >> 2, kq = (tid & 3) * 16;
  unsigned o[8];
#pragma unroll
  for (int j = 0; j < 8; ++j) o[j] = pack2(tl[(kq + 2 * j) * 65 + n], tl[(kq + 2 * j + 1) * 65 + n]);
  uint4* d = (uint4*)(dst + (size_t)(n0 + n) * K + k0 + kq);
  d[0] = make_uint4(o[0], o[1], o[2], o[3]); d[1] = make_uint4(o[4], o[5], o[6], o[7]);
}

__device__ void convert_flat(const float* __restrict__ src, bf16_t* __restrict__ dst, size_t n8  , int bid, int nb) {
  for (size_t i = (size_t)bid * NTHREADS + threadIdx.x; i < n8; i += (size_t)nb * NTHREADS) {
    const float4 a = ((const float4*)src)[2 * i], b = ((const float4*)src)[2 * i + 1];
    ((uint4*)dst)[i] = make_uint4(pack2(a.x, a.y), pack2(a.z, a.w), pack2(b.x, b.y), pack2(b.z, b.w));
  }
}
__device__ void rows_bf16_rs(const float* __restrict__ src, bf16_t* __restrict__ dst, float* __restrict__ rs, int nrows, int bid, int nb) {
  const int lane = threadIdx.x & 63, w = threadIdx.x >> 6;
  for (int row = bid * 4 + w; row < nrows; row += nb * 4) {
    const float4* s = (const float4*)(src + (size_t)row * 1024);
    float ss = 0.f; uint2* d = (uint2*)(dst + (size_t)row * 1024);
#pragma unroll
    for (int i = 0; i < 4; ++i) { const float4 v = s[i * 64 + lane]; ss += v.x * v.x + v.y * v.y + v.z * v.z + v.w * v.w; d[i * 64 + lane] = make_uint2(pack2(v.x, v.y), pack2(v.z, v.w)); }
#pragma unroll
    for (int o = 32; o > 0; o >>= 1) ss += __shfl_xor(ss, o);
    if (lane == 0) rs[row] = rsqrtf(ss * (1.0f / 1024.0f) + EPSF);
  }
}

__device__ void rows_fp8(const float* __restrict__ src, unsigned char* __restrict__ dst, float* __restrict__ sc, int nrows, int bid, int nb) {
  const int lane = threadIdx.x & 63, w = threadIdx.x >> 6;
  for (int row = bid * 4 + w; row < nrows; row += nb * 4) {
    const float4* s = (const float4*)(src + (size_t)row * 1024);
    float4 v[4]; float am = 0.f;
#pragma unroll
    for (int i = 0; i < 4; ++i) { v[i] = s[i * 64 + lane]; am = fmaxf(am, fmaxf(fmaxf(fabsf(v[i].x), fabsf(v[i].y)), fmaxf(fabsf(v[i].z), fabsf(v[i].w)))); }
#pragma unroll
    for (int o = 32; o > 0; o >>= 1) am = fmaxf(am, __shfl_xor(am, o));
    const float q = (am > 0.f) ? 224.0f / am : 1.0f;
    unsigned* d = (unsigned*)(dst + (size_t)row * 1024);
#pragma unroll
    for (int i = 0; i < 4; ++i) { int wd = 0; wd = __builtin_amdgcn_cvt_pk_fp8_f32(v[i].x * q, v[i].y * q, wd, false); wd = __builtin_amdgcn_cvt_pk_fp8_f32(v[i].z * q, v[i].w * q, wd, true); d[i * 64 + lane] = (unsigned)wd; }
    if (lane == 0) sc[row] = (am > 0.f) ? am * (1.0f / 224.0f) : 1.0f;
  }
}

__device__ void ssm_stage1(const Params& p, int gp) {
  const int g = gp >> 6;
  const float step = expf(p.log_step[g]); const float lr = p.lam_re[gp], li = p.lam_im[gp];
  const float mag = expf(lr * step); const float ar = mag * cosf(li * step), ai = mag * sinf(li * step);
  const float zr = ar - 1.0f, den = lr * lr + li * li; const float fr = (zr * lr + ai * li) / den, fi = (ai * lr - zr * li) / den;
  for (int c = 0; c < 16; ++c) { const float br = p.b_re[gp * 16 + c], bi = p.b_im[gp * 16 + c]; p.BBR[gp * 16 + c] = fr * br - fi * bi; p.BBI[gp * 16 + c] = fr * bi + fi * br; }
  float pr = 1.f, pi = 0.f; const int st = gp & 63;
  for (int j = 0; j <= 16; ++j) { p.PWR[(g * 17 + j) * 64 + st] = pr; p.PWI[(g * 17 + j) * 64 + st] = pi; const float nr = pr * ar - pi * ai, ni = pr * ai + pi * ar; if (j < 16) { pr = nr; pi = ni; } }
  const float a16r = pr, a16i = pi; const float a32r = a16r * a16r - a16i * a16i, a32i = 2.f * a16r * a16i;
  const float a48r = a32r * a16r - a32i * a16i, a48i = a32r * a16i + a32i * a16r; const float a64r = a32r * a32r - a32i * a32i, a64i = 2.f * a32r * a32i;
  const float a128r = a64r * a64r - a64i * a64i, a128i = 2.f * a64r * a64i; const float a256r = a128r * a128r - a128i * a128i, a256i = 2.f * a128r * a128i;
  float* A = p.APW;
  A[0 * 4096 + gp] = a16r; A[0 * 4096 + 2048 + gp] = a16i; A[1 * 4096 + gp] = a32r; A[1 * 4096 + 2048 + gp] = a32i; A[2 * 4096 + gp] = a48r; A[2 * 4096 + 2048 + gp] = a48i;
  A[3 * 4096 + gp] = a64r; A[3 * 4096 + 2048 + gp] = a64i; A[4 * 4096 + gp] = a256r; A[4 * 4096 + 2048 + gp] = a256i;
}
__device__ void ssm_stage2a(const Params& p, int bid, int nb) {
  const int n1 = 32 * 128 * 256, n2 = 32 * 16 * 4 * 512, n3 = 32 * 16 * 256;
  for (int i = bid * NTHREADS + threadIdx.x; i < n1 + n2 + n3; i += nb * NTHREADS) {
    if (i < n1) {
      const int j = i & 7, lane = (i >> 3) & 63, ks = (i >> 9) & 7, ri = (i >> 12) & 1, w = (i >> 13) & 3, g = i >> 15;
      const int st = w * 16 + (lane & 15), k = ks * 32 + (lane >> 4) * 8 + j; const int s_ = k >> 4, ch = k & 15;
      const int gp = g * 64 + st; const float pr = p.PWR[(g * 17 + 15 - s_) * 64 + st], pi = p.PWI[(g * 17 + 15 - s_) * 64 + st]; const float br = p.BBR[gp * 16 + ch], bi = p.BBI[gp * 16 + ch];
      p.WE16[i] = f2bf(ri == 0 ? (pr * br - pi * bi) : (pr * bi + pi * br));
    } else if (i < n1 + n2) {
      const int e = i - n1; const int j = e & 7, lane = (e >> 3) & 63, ks = (e >> 9) & 3, mt = (e >> 11) & 15, g = e >> 15;
      const int t = mt, co = lane & 15, k = ks * 32 + (lane >> 4) * 8 + j;
      const int st = ((k >> 5) << 4) | (k & 15), ri = (k >> 4) & 1; const float cr = p.c_re[(g * 16 + co) * 64 + st], ci = p.c_im[(g * 16 + co) * 64 + st];
      const float pr = p.PWR[(g * 17 + t + 1) * 64 + st], pi = p.PWI[(g * 17 + t + 1) * 64 + st];
      p.WY[((size_t)(g * 16 + mt) * 12 + ks) * 512 + lane * 8 + j] = f2bf((ri == 0) ? (cr * pr - ci * pi) : -(cr * pi + ci * pr));
    } else {
      const int e = i - n1 - n2; const int cin = e & 15, co = (e >> 4) & 15, j = (e >> 8) & 15, g = e >> 12; float acc = 0.f;
      for (int st = 0; st < 64; ++st) { const float cr = p.c_re[(g * 16 + co) * 64 + st], ci = p.c_im[(g * 16 + co) * 64 + st]; const float pr = p.PWR[(g * 17 + j) * 64 + st], pi = p.PWI[(g * 17 + j) * 64 + st];
        const float br = p.BBR[(g * 64 + st) * 16 + cin], bi = p.BBI[(g * 64 + st) * 16 + cin]; acc += cr * (pr * br - pi * bi) - ci * (pr * bi + pi * br); }
      p.KJ[e] = acc;
    }
  }
}
__device__ void ssm_stage2b(const Params& p, int bid, int nb) {
  const int n = 32 * 16 * 8 * 512;
  for (int i = bid * NTHREADS + threadIdx.x; i < n; i += nb * NTHREADS) {
    const int j = i & 7, lane = (i >> 3) & 63, ks8 = (i >> 9) & 7, mt = (i >> 12) & 15, g = i >> 16;
    const int t = mt, co = lane & 15, kk = ks8 * 32 + (lane >> 4) * 8 + j; const int s_ = kk >> 4, cin = kk & 15;
    const float val = (s_ <= t) ? p.KJ[((g * 16 + (t - s_)) * 16 + co) * 16 + cin] : 0.f;
    p.WY[((size_t)(g * 16 + mt) * 12 + 4 + ks8) * 512 + lane * 8 + j] = f2bf(val);
  }
}

#define EPI_IDS const int tid = threadIdx.x, lane = tid & 63, w = tid >> 6, wr = w >> 1, wc = w & 1, fr = lane & 15, fq = lane >> 4; (void)wr; (void)wc; (void)fr; (void)fq;

__device__ void tile_win_v(const Params& p, int tile, char* lds) {
  const int rt = tile >> 4, ct = tile & 15; const int row0 = rt * 128, col0 = ct * 128;
  f32x4 acc[4][4];
  gemm_mainloop<true, true>(acc, p.XB, 1024, p.WtIn, 1024, 1024, row0, col0, lds);
  EPI_IDS
  const int head = (col0 + wc * 64 - 1024) >> 6;
#pragma unroll
  for (int m = 0; m < 4; ++m) {
    const int row = row0 + wr * 64 + m * 16 + fq * 4; const f32x4 rsx = *(const f32x4*)(p.rs_x + row); const int b = row >> 13, tb = row & 8191;
#pragma unroll
    for (int n = 0; n < 4; ++n) { const f32x4 v = acc[m][n] * rsx;
      *(uint2*)(p.VT + ((size_t)(b * 8 + head) * 64 + n * 16 + fr) * SEQL + tb) = make_uint2(pack2(v[0], v[1]), pack2(v[2], v[3])); }
  }
}
__device__ void tile_win(const Params& p, int tile, char* lds) {
  const int rt = tile >> 4, ct = tile & 15; const int row0 = rt * 128, col0 = ct * 128;
  f32x4 acc[4][4];
  gemm_mainloop<true>(acc, p.XB, 1024, p.WtIn, 1024, 1024, row0, col0, lds);
  EPI_IDS
  const int cw = col0 + wc * 64;
#pragma unroll
  for (int m = 0; m < 4; ++m) {
    const int row = row0 + wr * 64 + m * 16 + fr; const float rsx = p.rs_x[row];
    if (cw < 1024) {
      float ss = 0.f;
#pragma unroll
      for (int n = 0; n < 4; ++n)
#pragma unroll
        for (int j = 0; j < 4; ++j) { const float v = acc[m][n][j] * rsx; acc[m][n][j] = v; ss += v * v; }
      ss += __shfl_xor(ss, 16); ss += __shfl_xor(ss, 32);
      const float rs = rsqrtf(ss * (1.0f / 64.0f) + EPSF) * (cw < 512 ? 0.125f : 1.0f);
      const float* g = (cw < 512) ? p.att_q_g : p.att_k_g; bf16_t* dst = (cw < 512 ? p.Qb : p.Kb) + (size_t)row * 512 + (cw & 511);
#pragma unroll
      for (int n = 0; n < 4; ++n) { const int c = n * 16 + fq * 4; const float4 gg = *(const float4*)(g + c);
        *(uint2*)(dst + c) = make_uint2(pack2(acc[m][n][0] * rs * gg.x, acc[m][n][1] * rs * gg.y), pack2(acc[m][n][2] * rs * gg.z, acc[m][n][3] * rs * gg.w)); }
    } else if (cw < 1536) {
      const int head = (cw - 1024) >> 6; const int b = row >> 13, tb = row & 8191;
      bf16_t* dst = p.VT + ((size_t)(b * 8 + head) * 64) * SEQL + tb;
#pragma unroll
      for (int n = 0; n < 4; ++n)
#pragma unroll
        for (int j = 0; j < 4; ++j) dst[(size_t)(n * 16 + fq * 4 + j) * SEQL] = f2bf(acc[m][n][j] * rsx);
    } else {
      const int b = row >> 13, tb = row & 8191;
#pragma unroll
      for (int n = 0; n < 4; ++n) { const int g = ((cw - 1536) >> 4) + n;
        *(uint2*)(p.Ub + ((size_t)(b * 32 + g) * SEQL + tb) * 16 + fq * 4) = make_uint2(pack2(acc[m][n][0] * rsx, acc[m][n][1] * rsx), pack2(acc[m][n][2] * rsx, acc[m][n][3] * rsx)); }
    }
  }
}
__device__ void tile_memkv(const Params& p, int tile, char* lds) {
  const int which = tile >> 5, t2 = tile & 31; const int rt = t2 >> 3, ct = t2 & 7; const int row0 = rt * 128, col0 = ct * 128;
  f32x4 acc[4][4];
  gemm_mainloop<true>(acc, p.MEMB, 1024, which ? p.WtMv : p.WtMk, 1024, 1024, row0, col0, lds);
  EPI_IDS
  const int cw = col0 + wc * 64;
#pragma unroll
  for (int m = 0; m < 4; ++m) {
    const int row = row0 + wr * 64 + m * 16 + fr; const float rsm = p.rs_mem[row];
    if (which == 0) {
      float ss = 0.f;
#pragma unroll
      for (int n = 0; n < 4; ++n) { f32x4 v = acc[m][n] * rsm; ss += v[0] * v[0] + v[1] * v[1] + v[2] * v[2] + v[3] * v[3]; *(f32x4*)(p.KMraw + (size_t)row * 1024 + cw + n * 16 + fq * 4) = v; }
      ss += __shfl_xor(ss, 16); ss += __shfl_xor(ss, 32);
      if (fq == 0) p.ss_km[row * 16 + (cw >> 6)] = ss;
    } else {
      const int b = row >> 8, key = row & 255; const int head = cw >> 8; const int d0 = (cw & 255);
      bf16_t* dst = p.VMT + ((size_t)(b * 4 + head) * 256) * 256 + key;
#pragma unroll
      for (int n = 0; n < 4; ++n)
#pragma unroll
        for (int j = 0; j < 4; ++j) dst[(size_t)(d0 + n * 16 + fq * 4 + j) * 256] = f2bf(acc[m][n][j] * rsm);
    }
  }
}
__device__ void memk_fix(const Params& p, int bid, int nb) {
  for (int i = bid * NTHREADS + threadIdx.x; i < 512 * 1024 / 4; i += nb * NTHREADS) {
    const int row = i >> 8, c4 = (i & 255) * 4; const int head = c4 >> 8, d = c4 & 255;
    const float ss = p.ss_km[row * 16 + head * 4] + p.ss_km[row * 16 + head * 4 + 1] + p.ss_km[row * 16 + head * 4 + 2] + p.ss_km[row * 16 + head * 4 + 3];
    const float rs = rsqrtf(ss * (1.0f / 256.0f) + EPSF);
    const float4 v = *(const float4*)(p.KMraw + (size_t)row * 1024 + c4); const float4 gk = *(const float4*)(p.mem_k_g + d), gq = *(const float4*)(p.mem_q_g + d);
    const int b = row >> 8, key = row & 255;
    *(uint2*)(p.KMB + ((size_t)(b * 4 + head) * 256 + key) * 256 + d) = make_uint2(pack2(v.x * rs * gk.x * gq.x, v.y * rs * gk.y * gq.y), pack2(v.z * rs * gk.z * gq.z, v.w * rs * gk.w * gq.w));
  }
}

__device__ void chunk_attn_item(const Params& p, int item, char* lds_) {
  LAS char* lds = (LAS char*)lds_; LAS float* rb = (LAS float*)(lds + 32768);
  typedef unsigned u32x2 __attribute__((ext_vector_type(2)));
  const int h = item & 7, cn = (item >> 3) & 127, b = item >> 10;
  const int tid = threadIdx.x, lane = tid & 63, w = tid >> 6, fr = lane & 15, fq = lane >> 4;
  const int iq = w * 16 + fr; const int tq = b * SEQL + cn * 64 + iq;
  const int cstart = (cn >= 8) ? 0 : (8 - cn);
  const bf16_t* vtb = p.VT + ((size_t)(b * 8 + h) * 64) * SEQL;
  const int r0 = tid >> 3, ch = tid & 7;
  u32x4 kr[2], vr[2];
  { const int kc0 = (cn - 8 + cstart) * 64;
#pragma unroll
    for (int i = 0; i < 2; ++i) { kr[i] = *(const u32x4*)(p.Kb + (size_t)(b * SEQL + kc0 + r0 + 32 * i) * 512 + h * 64 + ch * 8); vr[i] = *(const u32x4*)(vtb + (size_t)(r0 + 32 * i) * SEQL + kc0 + ch * 8); } }
  bf16x8 qf[2];
  qf[0] = *(const bf16x8*)(p.Qb + (size_t)tq * 512 + h * 64 + fq * 8); qf[1] = *(const bf16x8*)(p.Qb + (size_t)tq * 512 + h * 64 + 32 + fq * 8);
  __syncthreads();
  if (tid < 192) rb[tid] = p.rel_bias[h * 192 + tid];
#pragma unroll
  for (int i = 0; i < 2; ++i) { const int r = r0 + 32 * i; *(LAS u32x4*)(lds + r * 128 + ((ch ^ (r & 7)) << 4)) = kr[i]; *(LAS u32x4*)(lds + 8192 + r * 128 + ((ch ^ ((r >> 1) & 7)) << 4)) = vr[i]; }
  __syncthreads();
  f32x4 o[4]; for (int i = 0; i < 4; ++i) o[i] = (f32x4){0.f, 0.f, 0.f, 0.f};
  float mrun = -1e30f, lrun = 0.f;
  for (int c = cstart; c <= 8; ++c) {
    LAS char* cur = lds + ((c - cstart) & 1) * 16384; LAS char* nxt = lds + ((c - cstart + 1) & 1) * 16384;
    const bool more = c < 8;
    if (more) { const int kc1 = (cn - 8 + c + 1) * 64;
#pragma unroll
      for (int i = 0; i < 2; ++i) { kr[i] = *(const u32x4*)(p.Kb + (size_t)(b * SEQL + kc1 + r0 + 32 * i) * 512 + h * 64 + ch * 8); vr[i] = *(const u32x4*)(vtb + (size_t)(r0 + 32 * i) * SEQL + kc1 + ch * 8); } }
    f32x4 st[4];
#pragma unroll
    for (int mt = 0; mt < 4; ++mt) { const int row = mt * 16 + fr; f32x4 sacc = (f32x4){0.f, 0.f, 0.f, 0.f};
      sacc = mfma16(as_bf(*(const LAS u32x4*)(cur + row * 128 + ((fq ^ (row & 7)) << 4))), qf[0], sacc);
      sacc = mfma16(as_bf(*(const LAS u32x4*)(cur + row * 128 + (((4 + fq) ^ (row & 7)) << 4))), qf[1], sacc); st[mt] = sacc; }
    float tmax = -1e30f;
#pragma unroll
    for (int mt = 0; mt < 4; ++mt)
#pragma unroll
      for (int j = 0; j < 4; ++j) { const int jk = mt * 16 + fq * 4 + j; int dist = 512 - 64 * c + iq - jk; dist = dist < -63 ? -63 : (dist > 128 ? 128 : dist);
        const float sv = st[mt][j] + rb[dist + 63]; st[mt][j] = sv; tmax = fmaxf(tmax, sv); }
    tmax = fmaxf(tmax, __shfl_xor(tmax, 16)); tmax = fmaxf(tmax, __shfl_xor(tmax, 32));
    const float mnew = fmaxf(mrun, tmax); const float alpha = __expf(mrun - mnew); mrun = mnew;
    float ls = 0.f;
#pragma unroll
    for (int mt = 0; mt < 4; ++mt)
#pragma unroll
      for (int j = 0; j < 4; ++j) { const float pv = __expf(st[mt][j] - mnew); st[mt][j] = pv; ls += pv; }
    lrun = lrun * alpha + ls;
    bf16x8 pf[2];
#pragma unroll
    for (int s2 = 0; s2 < 2; ++s2) { u32x4 t; t.x = pack2(st[2 * s2][0], st[2 * s2][1]); t.y = pack2(st[2 * s2][2], st[2 * s2][3]); t.z = pack2(st[2 * s2 + 1][0], st[2 * s2 + 1][1]); t.w = pack2(st[2 * s2 + 1][2], st[2 * s2 + 1][3]); pf[s2] = as_bf(t); }
#pragma unroll
    for (int dt = 0; dt < 4; ++dt) { const int d = dt * 16 + fr; const int sw = ((d >> 1) & 7) << 1; f32x4 oc = o[dt] * alpha;
#pragma unroll
      for (int s2 = 0; s2 < 2; ++s2) {
        const u32x2 lo = *(const LAS u32x2*)(cur + 8192 + d * 128 + (((s2 * 8 + fq) ^ sw) << 3)), hi = *(const LAS u32x2*)(cur + 8192 + d * 128 + (((s2 * 8 + fq + 4) ^ sw) << 3));
        u32x4 vv; vv.x = lo.x; vv.y = lo.y; vv.z = hi.x; vv.w = hi.y; oc = mfma16(as_bf(vv), pf[s2], oc); }
      o[dt] = oc; }
    if (more) {
#pragma unroll
      for (int i = 0; i < 2; ++i) { const int r = r0 + 32 * i; *(LAS u32x4*)(nxt + r * 128 + ((ch ^ (r & 7)) << 4)) = kr[i]; *(LAS u32x4*)(nxt + 8192 + r * 128 + ((ch ^ ((r >> 1) & 7)) << 4)) = vr[i]; }
    }
    __syncthreads();
  }
  float lt = lrun; lt += __shfl_xor(lt, 16); lt += __shfl_xor(lt, 32);
  const float inv = 1.0f / lt; float ss = 0.f;
  bf16_t* dst = p.ATT + (size_t)tq * 512 + h * 64;
#pragma unroll
  for (int dt = 0; dt < 4; ++dt) { const f32x4 v = o[dt] * inv; ss += v[0] * v[0] + v[1] * v[1] + v[2] * v[2] + v[3] * v[3];
    *(uint2*)(dst + dt * 16 + fq * 4) = make_uint2(pack2(v[0], v[1]), pack2(v[2], v[3])); }
  ss += __shfl_xor(ss, 16); ss += __shfl_xor(ss, 32);
  if (fq == 0) p.ss_att[tq * 8 + h] = ss;
}

template <bool FINAL>
__device__ void ssm_item(const Params& p, int item, char* lds) {
  const int g = item & 31, seg = (item >> 5) & 31, b = item >> 10;
  const int tid = threadIdx.x, lane = tid & 63, w = tid >> 6, fr = lane & 15, fq = lane >> 4;
  const int t0 = b * SEQL + seg * 256;
  const bf16_t* ug = p.Ub + ((size_t)(b * 32 + g) * SEQL + seg * 256) * 16;
  bf16x8 uf[8];
#pragma unroll
  for (int ks = 0; ks < 8; ++ks) uf[ks] = *(const bf16x8*)(ug + (size_t)(fr * 16 + 2 * ks + (fq >> 1)) * 16 + (fq & 1) * 8);
  f32x4 er = (f32x4){0.f, 0.f, 0.f, 0.f}, ei = er;
  const bf16_t* we = p.WE16 + ((size_t)(g * 4 + w) * 2 * 8 * 64 + lane) * 8;
#pragma unroll
  for (int ks = 0; ks < 8; ++ks) { const bf16x8 br = *(const bf16x8*)(we + ks * 512), bi = *(const bf16x8*)(we + 4096 + ks * 512); er = mfma16(uf[ks], br, er); ei = mfma16(uf[ks], bi, ei); }
  const int gp = g * 64 + w * 16 + fr;
  const float a16r = p.APW[gp], a16i = p.APW[2048 + gp];
  float xr[4], xi[4];
  xr[0] = er[0]; xi[0] = ei[0];
#pragma unroll
  for (int j = 1; j < 4; ++j) { xr[j] = a16r * xr[j - 1] - a16i * xi[j - 1] + er[j]; xi[j] = a16r * xi[j - 1] + a16i * xr[j - 1] + ei[j]; }
  float cr = 0.f, ci = 0.f;
  if (FINAL) {
    const float ar = p.APW[4 * 4096 + gp], ai = p.APW[4 * 4096 + 2048 + gp];
    const float* es = p.ESEG + ((size_t)(b * 32) * 32 + g) * 128 + w * 32 + fr;
    for (int j0 = 0; j0 < seg; j0 += 8) { float e_r[8], e_i[8];
#pragma unroll
      for (int u = 0; u < 8; ++u) { e_r[u] = es[(size_t)(j0 + u) * 32 * 128]; e_i[u] = es[(size_t)(j0 + u) * 32 * 128 + 16]; }
#pragma unroll
      for (int u = 0; u < 8; ++u) if (j0 + u < seg) { const float nr = ar * cr - ai * ci + e_r[u], ni = ar * ci + ai * cr + e_i[u]; cr = nr; ci = ni; } }
  }
  const float a64r = p.APW[3 * 4096 + gp], a64i = p.APW[3 * 4096 + 2048 + gp];
  float tr = xr[3], ti = xi[3];
#pragma unroll
  for (int r = 0; r < 4; ++r) {
    float pr_ = __shfl(tr, (lane + 48) & 63), pi_ = __shfl(ti, (lane + 48) & 63);
    if (r == 0) { pr_ = cr; pi_ = ci; }
    if (fq == r) { const float nr = xr[3] + a64r * pr_ - a64i * pi_, ni = xi[3] + a64r * pi_ + a64i * pr_; tr = nr; ti = ni; }
  }
  if (!FINAL) {
    if (fq == 3) { float* es = p.ESEG + ((size_t)(b * 32 + seg) * 32 + g) * 128 + w * 32 + fr; es[0] = tr; es[16] = ti; }
    return;
  }
  float gr = __shfl(tr, (lane + 48) & 63), gi = __shfl(ti, (lane + 48) & 63);
  if (fq == 0) { gr = cr; gi = ci; }
  float pvr[4], pvi[4];
  pvr[0] = gr; pvi[0] = gi;
#pragma unroll
  for (int j = 1; j < 4; ++j) { const float ar = p.APW[(j - 1) * 4096 + gp], ai = p.APW[(j - 1) * 4096 + 2048 + gp]; pvr[j] = xr[j - 1] + ar * gr - ai * gi; pvi[j] = xi[j - 1] + ar * gi + ai * gr; }
  bf16_t* xl = (bf16_t*)lds;
  __syncthreads();
#pragma unroll
  for (int j = 0; j < 4; ++j) { xl[(fq * 4 + j) * 136 + w * 32 + fr] = f2bf(pvr[j]); xl[(fq * 4 + j) * 136 + w * 32 + 16 + fr] = f2bf(pvi[j]); }
  __syncthreads();
  bf16x8 xf[4];
#pragma unroll
  for (int ks = 0; ks < 4; ++ks) xf[ks] = *(const bf16x8*)(xl + fr * 136 + ks * 32 + fq * 8);
#pragma unroll
  for (int mi = 0; mi < 4; ++mi) {
    const int mt = w * 4 + mi;
    const bf16_t* wy = p.WY + ((size_t)(g * 16 + mt) * 12 * 64 + lane) * 8;
    f32x4 y = (f32x4){0.f, 0.f, 0.f, 0.f};
#pragma unroll
    for (int ks = 0; ks < 4; ++ks) y = mfma16(*(const bf16x8*)(wy + ks * 512), xf[ks], y);
#pragma unroll
    for (int ks = 0; ks < 8; ++ks) if (2 * ks <= mt) y = mfma16(*(const bf16x8*)(wy + (4 + ks) * 512), uf[ks], y);
    const size_t tok = (size_t)(t0 + fr * 16 + mt);
    const uint2 uu = *(const uint2*)(ug + (size_t)(fr * 16 + mt) * 16 + fq * 4);
    const float4 dd = *(const float4*)(p.d_skip + g * 16 + fq * 4);
    const float y0 = gelu_f(y[0] + dd.x * __uint_as_float(uu.x << 16)), y1 = gelu_f(y[1] + dd.y * __uint_as_float(uu.x & 0xffff0000u));
    const float y2 = gelu_f(y[2] + dd.z * __uint_as_float(uu.y << 16)), y3 = gelu_f(y[3] + dd.w * __uint_as_float(uu.y & 0xffff0000u));
    *(uint2*)(p.YG + tok * 512 + g * 16 + fq * 4) = make_uint2(pack2(y0, y1), pack2(y2, y3));
  }
}

__device__ void tile_glu(const Params& p, int tile, char* lds) {
  const int rt = tile >> 2, ct = tile & 3; const int row0 = rt * 128, col0 = ct * 128;
  f32x4 acc[4][4];
  gemm_mainloop<true>(acc, p.YG, 512, p.WtGlu, 512, 512, row0, col0, lds);
  EPI_IDS
  const int cw = col0 + wc * 64;
#pragma unroll
  for (int m = 0; m < 4; ++m) {
    const int row = row0 + wr * 64 + m * 16 + fr; float ss = 0.f;
#pragma unroll
    for (int n = 0; n < 4; ++n) { const int c = cw + n * 16 + fq * 4; const float4 bg = *(const float4*)(p.b_glu + c); const uint2 yy = *(const uint2*)(p.YG + (size_t)row * 512 + c);
      const float y0 = __uint_as_float(yy.x << 16), y1 = __uint_as_float(yy.x & 0xffff0000u), y2 = __uint_as_float(yy.y << 16), y3 = __uint_as_float(yy.y & 0xffff0000u);
      const float o0 = y0 / (1.f + __expf(-(acc[m][n][0] + bg.x))), o1 = y1 / (1.f + __expf(-(acc[m][n][1] + bg.y))), o2 = y2 / (1.f + __expf(-(acc[m][n][2] + bg.z))), o3 = y3 / (1.f + __expf(-(acc[m][n][3] + bg.w)));
      ss += o0 * o0 + o1 * o1 + o2 * o2 + o3 * o3;
      *(uint2*)(p.SSMO + (size_t)row * 512 + c) = make_uint2(pack2(o0, o1), pack2(o2, o3)); }
    ss += __shfl_xor(ss, 16); ss += __shfl_xor(ss, 32);
    if (fq == 0) p.ss_ssm[row * 8 + (cw >> 6)] = ss;
  }
}
__device__ void tile_wout(const Params& p, int tile, char* lds) {
  const int rt = tile >> 3, ct = tile & 7; const int row0 = rt * 128, col0 = ct * 128;
  f32x4 acc[4][4];
  float s1[4];
  gemm_mainloop<true>(acc, p.ATT, 512, p.WtOut, 1024, 512, row0, col0, lds);
  { const int lane_ = threadIdx.x & 63, w_ = threadIdx.x >> 6;
#pragma unroll
    for (int m = 0; m < 4; ++m) { const int row = row0 + (w_ >> 1) * 64 + m * 16 + (lane_ & 15); float a = 0.f, c = 0.f;
#pragma unroll
      for (int j = 0; j < 8; ++j) { a += p.ss_att[row * 8 + j]; c += p.ss_ssm[row * 8 + j]; }
      const float ra = rsqrtf(a * (1.0f / 512.0f) + EPSF); s1[m] = rsqrtf(c * (1.0f / 512.0f) + EPSF); const float f = ra / s1[m];
#pragma unroll
      for (int n = 0; n < 4; ++n) acc[m][n] *= f; } }
  gemm_mainloop<false>(acc, p.SSMO, 512, p.WtOut + 512, 1024, 512, row0, col0, lds);
  EPI_IDS
  const int cw = col0 + wc * 64;
#pragma unroll
  for (int m = 0; m < 4; ++m) {
    const int row = row0 + wr * 64 + m * 16 + fr; float ss = 0.f;
#pragma unroll
    for (int n = 0; n < 4; ++n) { const int c = cw + n * 16 + fq * 4; const f32x4 xv = *(const f32x4*)(p.x + (size_t)row * 1024 + c); const f32x4 hv = xv + acc[m][n] * s1[m];
      ss += hv[0] * hv[0] + hv[1] * hv[1] + hv[2] * hv[2] + hv[3] * hv[3];
      *(uint2*)(p.H1B + (size_t)row * 1024 + c) = make_uint2(pack2(hv[0], hv[1]), pack2(hv[2], hv[3])); }
    ss += __shfl_xor(ss, 16); ss += __shfl_xor(ss, 32);
    if (fq == 0) p.ss_h1[row * 16 + (cw >> 6)] = ss;
  }
}
__device__ __forceinline__ float row_rs16(const float* ss, int row) { float a = 0.f;
#pragma unroll
  for (int j = 0; j < 16; ++j) a += ss[row * 16 + j];
  return rsqrtf(a * (1.0f / 1024.0f) + EPSF); }
__device__ void tile_memq(const Params& p, int tile, char* lds) {
  const int rt = tile >> 3, ct = tile & 7; const int row0 = rt * 128, col0 = ct * 128;
  f32x4 acc[4][4];
  gemm_mainloop<true>(acc, p.H1B, 1024, p.WtMq, 1024, 1024, row0, col0, lds);
  EPI_IDS
  const int cw = col0 + wc * 64;
#pragma unroll
  for (int m = 0; m < 4; ++m) {
    const int row = row0 + wr * 64 + m * 16 + fr; const float rs = row_rs16(p.ss_h1, row); float ss = 0.f;
#pragma unroll
    for (int n = 0; n < 4; ++n) { const int c = cw + n * 16 + fq * 4; const f32x4 v = acc[m][n] * rs; ss += v[0] * v[0] + v[1] * v[1] + v[2] * v[2] + v[3] * v[3];
      *(uint2*)(p.QM + (size_t)row * 1024 + c) = make_uint2(pack2(v[0], v[1]), pack2(v[2], v[3])); }
    ss += __shfl_xor(ss, 16); ss += __shfl_xor(ss, 32);
    if (fq == 0) p.ss_qm[row * 16 + (cw >> 6)] = ss;
  }
}
__device__ void mem_attn_item(const Params& p, int item, char* lds_) {
  LAS char* lds = (LAS char*)lds_;
  const int h = item & 3, tt = item >> 2; const int tid = threadIdx.x, lane = tid & 63, w = tid >> 6, fr = lane & 15, fq = lane >> 4;
  const int tq = tt * 64 + w * 16 + fr; const int b = tq >> 13;
  const float ssq = p.ss_qm[tq * 16 + h * 4] + p.ss_qm[tq * 16 + h * 4 + 1] + p.ss_qm[tq * 16 + h * 4 + 2] + p.ss_qm[tq * 16 + h * 4 + 3];
  const float rowscale = rsqrtf(ssq * (1.0f / 256.0f) + EPSF) * 0.0625f;
  bf16x8 qf[8];
#pragma unroll
  for (int ks = 0; ks < 8; ++ks) qf[ks] = *(const bf16x8*)(p.QM + (size_t)tq * 1024 + h * 256 + ks * 32 + fq * 8);
  const bf16_t* kg = p.KMB + (size_t)(b * 4 + h) * 256 * 256;
  const bf16_t* vg = p.VMT + (size_t)(b * 4 + h) * 256 * 256;
  f32x4 o[16];
#pragma unroll
  for (int i = 0; i < 16; ++i) o[i] = (f32x4){0.f, 0.f, 0.f, 0.f};
  float mrun = -1e30f, lrun = 0.f;
  for (int kc = 0; kc < 4; ++kc) {
    __syncthreads();
#pragma unroll
    for (int i = 0; i < 8; ++i) { const int idx = tid + 256 * i; const int row = idx >> 5, ch = idx & 31;
      const u32x4 v = *(const u32x4*)(kg + (size_t)(kc * 64 + row) * 256 + ch * 8); *(LAS u32x4*)(lds + row * 512 + ((ch ^ (row & 15)) << 4)) = v; }
#pragma unroll
    for (int i = 0; i < 8; ++i) { const int idx = tid + 256 * i; const int d = idx >> 3, j = idx & 7;
      const u32x4 v = *(const u32x4*)(vg + (size_t)d * 256 + kc * 64 + j * 8); *(LAS u32x4*)(lds + 32768 + d * 128 + ((j ^ ((d >> 1) & 7)) << 4)) = v; }
    __syncthreads();
    f32x4 st[4];
#pragma unroll
    for (int mt = 0; mt < 4; ++mt) { f32x4 sacc = (f32x4){0.f, 0.f, 0.f, 0.f}; const int row = mt * 16 + fr;
#pragma unroll
      for (int ks = 0; ks < 8; ++ks) sacc = mfma16(as_bf(*(const LAS u32x4*)(lds + row * 512 + (((ks * 4 + fq) ^ (row & 15)) << 4))), qf[ks], sacc);
      st[mt] = sacc * rowscale; }
    float tmax = -1e30f;
#pragma unroll
    for (int mt = 0; mt < 4; ++mt) tmax = fmaxf(fmaxf(fmaxf(tmax, st[mt][0]), fmaxf(st[mt][1], st[mt][2])), st[mt][3]);
    tmax = fmaxf(tmax, __shfl_xor(tmax, 16)); tmax = fmaxf(tmax, __shfl_xor(tmax, 32));
    const float mnew = fmaxf(mrun, tmax); const float alpha = __expf(mrun - mnew); mrun = mnew;
    float ls = 0.f;
#pragma unroll
    for (int mt = 0; mt < 4; ++mt)
#pragma unroll
      for (int j = 0; j < 4; ++j) { const float e = __expf(st[mt][j] - mnew); st[mt][j] = e; ls += e; }
    lrun = lrun * alpha + ls;
    bf16x8 pf[2];
#pragma unroll
    for (int s2 = 0; s2 < 2; ++s2) { u32x4 t; t.x = pack2(st[2 * s2][0], st[2 * s2][1]); t.y = pack2(st[2 * s2][2], st[2 * s2][3]); t.z = pack2(st[2 * s2 + 1][0], st[2 * s2 + 1][1]); t.w = pack2(st[2 * s2 + 1][2], st[2 * s2 + 1][3]); pf[s2] = as_bf(t); }
#pragma unroll
    for (int dt = 0; dt < 16; ++dt) { const int d = dt * 16 + fr; const int sw = ((d >> 1) & 7) << 1; f32x4 oc = o[dt] * alpha;
#pragma unroll
      for (int s2 = 0; s2 < 2; ++s2) { typedef unsigned u32x2 __attribute__((ext_vector_type(2)));
        const u32x2 lo = *(const LAS u32x2*)(lds + 32768 + d * 128 + (((s2 * 8 + fq) ^ sw) << 3)), hi = *(const LAS u32x2*)(lds + 32768 + d * 128 + (((s2 * 8 + fq + 4) ^ sw) << 3));
        u32x4 vv; vv.x = lo.x; vv.y = lo.y; vv.z = hi.x; vv.w = hi.y; oc = mfma16(as_bf(vv), pf[s2], oc); }
      o[dt] = oc; }
  }
  float lt = lrun; lt += __shfl_xor(lt, 16); lt += __shfl_xor(lt, 32);
  const float inv = 1.0f / lt;
  bf16_t* dst = p.OM + (size_t)tq * 1024 + h * 256;
#pragma unroll
  for (int dt = 0; dt < 16; ++dt) { const f32x4 v = o[dt] * inv; *(uint2*)(dst + dt * 16 + fq * 4) = make_uint2(pack2(v[0], v[1]), pack2(v[2], v[3])); }
}
__device__ void tile_memo(const Params& p, int tile, char* lds) {
  const int rt = tile >> 3, ct = tile & 7; const int row0 = rt * 128, col0 = ct * 128;
  f32x4 acc[4][4];
  gemm_mainloop<true>(acc, p.OM, 1024, p.WtMo, 1024, 1024, row0, col0, lds);
  EPI_IDS
  const int cw = col0 + wc * 64;
#pragma unroll
  for (int m = 0; m < 4; ++m) {
    const int row = row0 + wr * 64 + m * 16 + fr; float ss = 0.f;
#pragma unroll
    for (int n = 0; n < 4; ++n) { const int c = cw + n * 16 + fq * 4; const uint2 hb = *(const uint2*)(p.H1B + (size_t)row * 1024 + c);
      const f32x4 hv = (f32x4){__uint_as_float(hb.x << 16), __uint_as_float(hb.x & 0xffff0000u), __uint_as_float(hb.y << 16), __uint_as_float(hb.y & 0xffff0000u)} + acc[m][n];
      ss += hv[0] * hv[0] + hv[1] * hv[1] + hv[2] * hv[2] + hv[3] * hv[3];
      *(uint2*)(p.H2B + (size_t)row * 1024 + c) = make_uint2(pack2(hv[0], hv[1]), pack2(hv[2], hv[3])); }
    ss += __shfl_xor(ss, 16); ss += __shfl_xor(ss, 32);
    if (fq == 0) p.ss_h2[row * 16 + (cw >> 6)] = ss;
  }
}
__device__ __forceinline__ void ce_desc(float& x, float& y) { const float hi = fmaxf(x, y), lo = fminf(x, y); x = hi; y = lo; }
__device__ __forceinline__ void sort16_desc(float (&a)[16]) {
#pragma unroll
  for (int k = 2; k <= 16; k <<= 1)
#pragma unroll
    for (int j = k >> 1; j > 0; j >>= 1)
#pragma unroll
      for (int i = 0; i < 16; ++i) { const int l = i ^ j; if (l > i) { if ((i & k) == 0) ce_desc(a[i], a[l]); else ce_desc(a[l], a[i]); } }
}
__device__ __forceinline__ void merge16_desc(float (&a)[16], const float (&b)[16]) {
#pragma unroll
  for (int i = 0; i < 16; ++i) a[i] = fmaxf(a[i], b[15 - i]);
#pragma unroll
  for (int j = 8; j > 0; j >>= 1)
#pragma unroll
    for (int i = 0; i < 16; ++i) { const int l = i ^ j; if (l > i) ce_desc(a[i], a[l]); }
}
__device__ __forceinline__ void ins16(float (&a)[16], float v) {
#pragma unroll
  for (int i = 0; i < 16; ++i) { const float hi = fmaxf(a[i], v), lo = fminf(a[i], v); a[i] = hi; v = lo; }
}
__device__ void tile_peer(const Params& p, int tile, char* lds_) {
  const int rt = tile >> 4, hs = tile & 15; const int row0 = rt * 128, col0 = hs * 128;
  f32x4 acc[4][4];
  gemm_mainloop<true>(acc, p.H2B, 1024, p.WtPq, 1024, 1024, row0, col0, lds_);
  LAS char* lds = (LAS char*)lds_;
  EPI_IDS
  { const int lr = lane >> 3, lc = (lane & 7) ^ lr; const int wbase = __builtin_amdgcn_readfirstlane(w) * 4096;
    const bf16_t* gK = p.PK + (size_t)hs * 128 * 128 + (size_t)(w * 32 + lr) * 128 + lc * 8;
#pragma unroll
    for (int i = 0; i < 4; ++i) {
      __builtin_amdgcn_global_load_lds((const GAS void*)(gK + (size_t)(i * 8) * 128), (LAS void*)(lds + 16384 + wbase + i * 1024), 16, 0, 0);
      __builtin_amdgcn_global_load_lds((const GAS void*)(gK + (size_t)(i * 8) * 128 + 64), (LAS void*)(lds + 32768 + 16384 + wbase + i * 1024), 16, 0, 0);
    } }
  typedef unsigned u32x2 __attribute__((ext_vector_type(2)));
#pragma unroll
  for (int m = 0; m < 4; ++m) { const int r = wr * 64 + m * 16 + fr; const float rs = row_rs16(p.ss_h2, row0 + r);
#pragma unroll
    for (int n = 0; n < 4; ++n) { const f32x4 v = acc[m][n] * rs; u32x2 pk; pk.x = pack2(v[0], v[1]); pk.y = pack2(v[2], v[3]);
      *(LAS u32x2*)(lds + wc * 32768 + r * 128 + (((n * 2 + (fq >> 1)) ^ (r & 7)) << 4) + (fq & 1) * 8) = pk; } }
  asm volatile("s_waitcnt vmcnt(0)" ::: "memory");
  __syncthreads();
#pragma unroll
  for (int m = 0; m < 4; ++m)
#pragma unroll
    for (int n = 0; n < 4; ++n) acc[m][n] = (f32x4){0.f, 0.f, 0.f, 0.f};
#pragma unroll
  for (int kt = 0; kt < 2; ++kt) { LAS char* cur = lds + kt * 32768;
#pragma unroll
    for (int ks = 0; ks < 2; ++ks) { bf16x8 af[4], bfr[4]; const int kc = ks * 4 + fq;
#pragma unroll
      for (int m = 0; m < 4; ++m) { const int r = wr * 64 + m * 16 + fr; af[m] = as_bf(*(const LAS u32x4*)(cur + r * 128 + ((kc ^ (r & 7)) << 4))); }
#pragma unroll
      for (int n = 0; n < 4; ++n) { const int r = wc * 64 + n * 16 + fr; bfr[n] = as_bf(*(const LAS u32x4*)(cur + 16384 + r * 128 + ((kc ^ (r & 7)) << 4))); }
#pragma unroll
      for (int m = 0; m < 4; ++m)
#pragma unroll
        for (int n = 0; n < 4; ++n) acc[m][n] = mfma16(bfr[n], af[m], acc[m][n]);
    } }
  __syncthreads();
  LAS float* L = (LAS float*)lds;
#pragma unroll
  for (int m = 0; m < 4; ++m) {
    float a[16], b[16];
#pragma unroll
    for (int n = 0; n < 4; ++n)
#pragma unroll
      for (int j = 0; j < 4; ++j) a[n * 4 + j] = __uint_as_float((__float_as_uint(acc[m][n][j]) & ~127u) | (unsigned)(wc * 64 + n * 16 + fq * 4 + j));
    sort16_desc(a);
#pragma unroll
    for (int i = 0; i < 16; ++i) b[i] = __shfl_xor(a[i], 16);
    merge16_desc(a, b);
#pragma unroll
    for (int i = 0; i < 16; ++i) b[i] = __shfl_xor(a[i], 32);
    merge16_desc(a, b);
    const int r = wr * 64 + m * 16 + fr;
    f32x4 o; o[0] = fq == 0 ? a[0] : fq == 1 ? a[4] : fq == 2 ? a[8] : a[12]; o[1] = fq == 0 ? a[1] : fq == 1 ? a[5] : fq == 2 ? a[9] : a[13];
    o[2] = fq == 0 ? a[2] : fq == 1 ? a[6] : fq == 2 ? a[10] : a[14]; o[3] = fq == 0 ? a[3] : fq == 1 ? a[7] : fq == 2 ? a[11] : a[15];
    *(LAS f32x4*)(L + (r * 2 + wc) * 16 + fq * 4) = o;
  }
  __syncthreads();
#pragma unroll
  for (int mi = 0; mi < 2; ++mi) { const int m = wc * 2 + mi; const int r = wr * 64 + m * 16 + fr;
    float a[16], b[16];
#pragma unroll
    for (int q = 0; q < 4; ++q) { const f32x4 va = *(const LAS f32x4*)(L + (r * 2 + 0) * 16 + q * 4), vb = *(const LAS f32x4*)(L + (r * 2 + 1) * 16 + q * 4);
      a[q * 4] = va[0]; a[q * 4 + 1] = va[1]; a[q * 4 + 2] = va[2]; a[q * 4 + 3] = va[3]; b[q * 4] = vb[0]; b[q * 4 + 1] = vb[1]; b[q * 4 + 2] = vb[2]; b[q * 4 + 3] = vb[3]; }
    merge16_desc(a, b);
    u32x4 o; o.x = __float_as_uint(fq == 0 ? a[0] : fq == 1 ? a[4] : fq == 2 ? a[8] : a[12]); o.y = __float_as_uint(fq == 0 ? a[1] : fq == 1 ? a[5] : fq == 2 ? a[9] : a[13]);
    o.z = __float_as_uint(fq == 0 ? a[2] : fq == 1 ? a[6] : fq == 2 ? a[10] : a[14]); o.w = __float_as_uint(fq == 0 ? a[3] : fq == 1 ? a[7] : fq == 2 ? a[11] : a[15]);
    *(u32x4*)(p.TOPS + ((size_t)(row0 + r) * 16 + hs) * 16 + fq * 4) = o;
  }
}
__device__ void peer_gather_item(const Params& p, int item, char* lds) {
  const int tid = threadIdx.x, lane = tid & 63, w = tid >> 6;
  unsigned* LA = (unsigned*)lds;
  int* LE = (int*)(lds + 256 * 33 * 4);
  float* LG = (float*)(lds + 256 * 33 * 4 + 32 * 128 * 4);
  __syncthreads();
  {
    const int tl_ = tid >> 3, h = tid & 7; const int t = item * 32 + tl_;
    const uint4* src = (const uint4*)(p.TOPS + ((size_t)t * 16 + h * 2) * 16);
    float a[16], bq[16];
#pragma unroll
    for (int i = 0; i < 4; ++i) { const uint4 v = src[i]; a[4 * i] = __uint_as_float(v.x); a[4 * i + 1] = __uint_as_float(v.y); a[4 * i + 2] = __uint_as_float(v.z); a[4 * i + 3] = __uint_as_float(v.w); }
#pragma unroll
    for (int i = 0; i < 4; ++i) { const uint4 v = src[4 + i]; bq[4 * i] = __uint_as_float(v.x); bq[4 * i + 1] = __uint_as_float(v.y); bq[4 * i + 2] = __uint_as_float(v.z); bq[4 * i + 3] = __uint_as_float(v.w); }
#pragma unroll
    for (int i = 0; i < 16; ++i) { LA[tid * 33 + i] = __float_as_uint(a[i]); LA[tid * 33 + 16 + i] = __float_as_uint(bq[i]); }
    float c[16];
#pragma unroll
    for (int i = 0; i < 16; ++i) c[i] = -__builtin_inff();
#pragma unroll
    for (int i = 0; i < 16; ++i)
#pragma unroll
      for (int j = 0; j < 16; ++j) if ((i + 1) * (j + 1) <= 16) { const float s = a[i] + bq[j]; ins16(c, __uint_as_float((__float_as_uint(s) & ~255u) | (unsigned)(i * 16 + j))); }
    const float mx = c[0]; float e[16]; float sum = 0.f;
#pragma unroll
    for (int i = 0; i < 16; ++i) { e[i] = __expf(c[i] - mx); sum += e[i]; }
    const float inv = 1.0f / sum;
#pragma unroll
    for (int i = 0; i < 16; ++i) { const unsigned pos = __float_as_uint(c[i]) & 255u; const unsigned ia = LA[tid * 33 + (pos >> 4)] & 127u, ib = LA[tid * 33 + 16 + (pos & 15u)] & 127u;
      LE[tl_ * 128 + h * 16 + i] = (int)(ia * 128u + ib); LG[tl_ * 128 + h * 16 + i] = e[i] * inv; }
  }
  __syncthreads();
  for (int ti = 0; ti < 8; ++ti) {
    const int tl_ = w * 8 + ti; const int t = item * 32 + tl_;
    const float rs = row_rs16(p.ss_h2, t);
    f32x2 hn[8], hres[8];
    { const uint4 ha = *(const uint4*)(p.H2B + (size_t)t * 1024 + lane * 16), hb = *(const uint4*)(p.H2B + (size_t)t * 1024 + lane * 16 + 8);
      const unsigned hw[8] = {ha.x, ha.y, ha.z, ha.w, hb.x, hb.y, hb.z, hb.w};
#pragma unroll
      for (int i = 0; i < 8; ++i) { hres[i].x = __uint_as_float(hw[i] << 16); hres[i].y = __uint_as_float(hw[i] & 0xffff0000u);
        const float2 g = *(const float2*)(p.norm_peer_g + lane * 16 + 2 * i); hn[i].x = hres[i].x * rs * g.x; hn[i].y = hres[i].y * rs * g.y; } }
    f32x2 oa[8];
#pragma unroll
    for (int i = 0; i < 8; ++i) oa[i] = (f32x2){0.f, 0.f};
    for (int k = 0; k < 128; k += 4) {
      int e[4]; float gg[4], scu[4], scv[4]; uint4 uq[4], vq[4];
#pragma unroll
      for (int u = 0; u < 4; ++u) { e[u] = __builtin_amdgcn_readfirstlane(LE[tl_ * 128 + k + u]); gg[u] = LG[tl_ * 128 + k + u]; }
#pragma unroll
      for (int u = 0; u < 4; ++u) { uq[u] = *(const uint4*)(p.PU8 + (size_t)e[u] * 1024 + lane * 16); vq[u] = *(const uint4*)(p.PV8 + (size_t)e[u] * 1024 + lane * 16); scu[u] = p.su[e[u]]; scv[u] = p.sv[e[u]]; }
#pragma unroll
      for (int u = 0; u < 4; ++u) {
        f32x2 d2 = (f32x2){0.f, 0.f};
        d2 += __builtin_amdgcn_cvt_pk_f32_fp8((int)uq[u].x, false) * hn[0]; d2 += __builtin_amdgcn_cvt_pk_f32_fp8((int)uq[u].x, true) * hn[1];
        d2 += __builtin_amdgcn_cvt_pk_f32_fp8((int)uq[u].y, false) * hn[2]; d2 += __builtin_amdgcn_cvt_pk_f32_fp8((int)uq[u].y, true) * hn[3];
        d2 += __builtin_amdgcn_cvt_pk_f32_fp8((int)uq[u].z, false) * hn[4]; d2 += __builtin_amdgcn_cvt_pk_f32_fp8((int)uq[u].z, true) * hn[5];
        d2 += __builtin_amdgcn_cvt_pk_f32_fp8((int)uq[u].w, false) * hn[6]; d2 += __builtin_amdgcn_cvt_pk_f32_fp8((int)uq[u].w, true) * hn[7];
        float d = d2.x + d2.y;
#pragma unroll
        for (int o = 32; o > 0; o >>= 1) d += __shfl_xor(d, o);
        const float wgt = gg[u] * gelu_f(d * scu[u]) * scv[u];
        oa[0] += __builtin_amdgcn_cvt_pk_f32_fp8((int)vq[u].x, false) * wgt; oa[1] += __builtin_amdgcn_cvt_pk_f32_fp8((int)vq[u].x, true) * wgt;
        oa[2] += __builtin_amdgcn_cvt_pk_f32_fp8((int)vq[u].y, false) * wgt; oa[3] += __builtin_amdgcn_cvt_pk_f32_fp8((int)vq[u].y, true) * wgt;
        oa[4] += __builtin_amdgcn_cvt_pk_f32_fp8((int)vq[u].z, false) * wgt; oa[5] += __builtin_amdgcn_cvt_pk_f32_fp8((int)vq[u].z, true) * wgt;
        oa[6] += __builtin_amdgcn_cvt_pk_f32_fp8((int)vq[u].w, false) * wgt; oa[7] += __builtin_amdgcn_cvt_pk_f32_fp8((int)vq[u].w, true) * wgt;
      }
    }
    float* op = p.out + (size_t)t * 1024 + lane * 16;
#pragma unroll
    for (int i = 0; i < 4; ++i) { const f32x2 a = hres[2 * i] + oa[2 * i], b = hres[2 * i + 1] + oa[2 * i + 1]; *(float4*)(op + 4 * i) = make_float4(a.x, a.y, b.x, b.y); }
  }
}

template <int PH>
__device__ __forceinline__ void run_phase(const Params& p, char* lds, int bid, int nb) {
  if (PH == 0) {
    const int nt_in = 16 * 32, nt_glu = 8 * 8, nt_out = 16 * 16, nt_m = 16 * 16, nt_pq = 16 * 32;
    const int total = nt_in + nt_glu + nt_out + 4 * nt_m + nt_pq;
    for (int t = bid; t < total; t += nb) {
      int i = t; float* tl = (float*)lds;
      if (i < nt_in) { transpose_tile(p.w_in, p.WtIn, 1024, 2048, i, p.norm_mix_g, p.norm_mix_g, 1024, tl); continue; } i -= nt_in;
      if (i < nt_glu) { transpose_tile(p.w_glu, p.WtGlu, 512, 512, i, nullptr, nullptr, 0, tl); continue; } i -= nt_glu;
      if (i < nt_out) { transpose_tile(p.w_out, p.WtOut, 1024, 1024, i, p.att_out_g, p.ssm_out_g, 512, tl); continue; } i -= nt_out;
      if (i < nt_m) { transpose_tile(p.w_mem_q, p.WtMq, 1024, 1024, i, p.norm_mem_g, p.norm_mem_g, 1024, tl); continue; } i -= nt_m;
      if (i < nt_m) { transpose_tile(p.w_mem_k, p.WtMk, 1024, 1024, i, p.norm_memkv_g, p.norm_memkv_g, 1024, tl); continue; } i -= nt_m;
      if (i < nt_m) { transpose_tile(p.w_mem_v, p.WtMv, 1024, 1024, i, p.norm_memkv_g, p.norm_memkv_g, 1024, tl); continue; } i -= nt_m;
      if (i < nt_m) { transpose_tile(p.w_mem_o, p.WtMo, 1024, 1024, i, nullptr, nullptr, 0, tl); continue; } i -= nt_m;
      transpose_tile(p.w_peer_q, p.WtPq, 1024, 2048, i, p.norm_peer_g, p.norm_peer_g, 1024, tl);
    }
    convert_flat(p.peer_keys, p.PK, (size_t)16 * 128 * 128 / 8, bid, nb);
    rows_fp8(p.peer_u, p.PU8, p.su, 16384, bid, nb);
    rows_fp8(p.peer_v, p.PV8, p.sv, 16384, bid, nb);
    rows_bf16_rs(p.x, p.XB, p.rs_x, T_TOK, bid, nb);
    rows_bf16_rs(p.mem, p.MEMB, p.rs_mem, 512, bid, nb);
    for (int i = bid * NTHREADS + threadIdx.x; i < 2048; i += nb * NTHREADS) ssm_stage1(p, i);
  } else if (PH == 1) {
    for (int t = bid; t < 2048; t += nb) { if (((t & 15) >> 2) == 2) tile_win_v(p, t, lds); else tile_win(p, t, lds); }
    ssm_stage2a(p, bid, nb);
  } else if (PH == 2) {
    for (int t = nb - 1 - bid; t < 64; t += nb) tile_memkv(p, t, lds);
    for (int t = bid; t < 2048; t += nb) chunk_attn_item(p, t, lds);
    for (int t = bid; t < 2048; t += nb) ssm_item<false>(p, t, lds);
    ssm_stage2b(p, bid, nb);
  } else if (PH == 3) {
    memk_fix(p, bid, nb);
    for (int t = bid; t < 2048; t += nb) ssm_item<true>(p, t, lds);
  } else if (PH == 4) {
    for (int t = bid; t < 512; t += nb) tile_glu(p, t, lds);
  } else if (PH == 5) {
    for (int t = bid; t < 1024; t += nb) tile_wout(p, t, lds);
  } else if (PH == 6) {
    for (int t = bid; t < 1024; t += nb) tile_memq(p, t, lds);
  } else if (PH == 7) {
    for (int t = bid; t < 1024; t += nb) mem_attn_item(p, t, lds);
  } else if (PH == 8) {
    for (int t = bid; t < 1024; t += nb) tile_memo(p, t, lds);
  } else if (PH == 9) {
    for (int t = bid; t < 2048; t += nb) tile_peer(p, t, lds);
  } else if (PH == 11) {
    for (int t = bid; t < 512; t += nb) peer_gather_item(p, t, lds);
  }
}

#if !MEGA
template <int PH>
__global__ void __launch_bounds__(NTHREADS, 2) phase_kernel(Params p) {
  extern __shared__ __attribute__((aligned(16))) char lds[];
  run_phase<PH>(p, lds, blockIdx.x, gridDim.x);
}

#endif
#ifndef REPEAT_PH
#define REPEAT_PH -1
#endif
#define RUNPH(k) do { run_phase<k>(p, lds, bid, nb); if (REPEAT_PH == k) { xcd_barrier(xb); run_phase<k>(p, lds, bid, nb); } } while (0)
__global__ void __launch_bounds__(NTHREADS, 2) mega_kernel(Params p) {
  extern __shared__ __attribute__((aligned(16))) char lds[];
  const int bid = blockIdx.x, nb = gridDim.x;
  volatile LAS unsigned* stw = (volatile LAS unsigned*)((LAS char*)lds + LDS_WORK);
  if (threadIdx.x == 0) { stw[0] = 0u; stw[1] = 0u; stw[2] = 0u; stw[3] = 0u; }
  __syncthreads();
  XcdBarrier xb = xcd_barrier_post(p.bar, stw);
  RUNPH(0); xcd_barrier(xb);
  RUNPH(1); xcd_barrier(xb);
  RUNPH(2); xcd_barrier(xb);
  RUNPH(3); xcd_barrier(xb);
  RUNPH(4); xcd_barrier(xb);
  RUNPH(5); xcd_barrier(xb);
  RUNPH(6); xcd_barrier(xb);
  RUNPH(7); xcd_barrier(xb);
  RUNPH(8); xcd_barrier(xb);
  RUNPH(9); xcd_barrier(xb);
  RUNPH(11);
}

#if !MEGA
template <int PH> static void launch_phase(const Params& p, int grid, hipStream_t s) {
  hipFuncSetAttribute((const void*)phase_kernel<PH>, hipFuncAttributeMaxDynamicSharedMemorySize, LDS_BYTES);
  phase_kernel<PH><<<grid, NTHREADS, LDS_BYTES, s>>>(p);
}
#endif

extern "C" void kernel_launch(void* const* d_in, const int* in_sizes, int n_in, void* d_out, int out_size, void* d_ws, size_t ws_size, hipStream_t stream) {
  Params p{};
  const float** f = (const float**)&p;
  for (int i = 0; i < 33; ++i) f[i] = (const float*)d_in[i];
  p.out = (float*)d_out;
  char* ws = (char*)d_ws; size_t off = 0;
  auto take = [&](size_t bytes) { char* r = ws + off; off += (bytes + 255) & ~(size_t)255; return r; };
  const size_t MB = 1u << 20;
  p.bar = (unsigned*)take(16384);
  p.WtIn = (bf16_t*)take(4 * MB); p.WtGlu = (bf16_t*)take(MB / 2); p.WtOut = (bf16_t*)take(2 * MB);
  p.WtMq = (bf16_t*)take(2 * MB); p.WtMk = (bf16_t*)take(2 * MB); p.WtMv = (bf16_t*)take(2 * MB); p.WtMo = (bf16_t*)take(2 * MB); p.WtPq = (bf16_t*)take(4 * MB);
  p.PK = (bf16_t*)take(MB / 2); p.PU8 = (unsigned char*)take(16 * MB); p.PV8 = (unsigned char*)take(16 * MB); p.su = (float*)take(16384 * 4); p.sv = (float*)take(16384 * 4);
  char* RA = take(64 * MB); char* RB = take(64 * MB);
  p.XB = (bf16_t*)RA; p.ATT = (bf16_t*)RA; p.YG = (bf16_t*)(RA + 16 * MB); p.QM = (bf16_t*)RA; p.H2B = (bf16_t*)RA;
  p.SSMO = (bf16_t*)(RA + 32 * MB); p.OM = (bf16_t*)(RA + 32 * MB);
  p.Qb = (bf16_t*)RB; p.Kb = (bf16_t*)(RB + 16 * MB); p.VT = (bf16_t*)(RB + 32 * MB); p.Ub = (bf16_t*)(RB + 48 * MB); p.H1B = (bf16_t*)RB; p.QP = (bf16_t*)RB;
  p.TOPS = (unsigned*)take(16 * MB);
  p.MEMB = (bf16_t*)take(MB); p.KMB = (bf16_t*)take(MB); p.VMT = (bf16_t*)take(MB); p.KMraw = (float*)take(2 * MB);
  p.WE16 = (bf16_t*)take(2 * MB); p.WY = (bf16_t*)take(6 * MB);
  p.rs_x = (float*)take(T_TOK * 4); p.rs_mem = (float*)take(512 * 4); p.ss_att = (float*)take(T_TOK * 8 * 4); p.ss_ssm = (float*)take(T_TOK * 8 * 4);
  p.ss_h1 = (float*)take(T_TOK * 16 * 4); p.ss_qm = (float*)take(T_TOK * 16 * 4); p.ss_km = (float*)take(512 * 16 * 4); p.ss_h2 = (float*)take(T_TOK * 16 * 4);
  p.ESEG = (float*)take(2 * 32 * 32 * 128 * 4);
  p.BBR = (float*)take(2048 * 16 * 4); p.BBI = (float*)take(2048 * 16 * 4); p.PWR = (float*)take(32 * 17 * 64 * 4); p.PWI = (float*)take(32 * 17 * 64 * 4); p.KJ = (float*)take(32 * 16 * 256 * 4); p.APW = (float*)take(5 * 4096 * 4);
  if (off > ws_size) { fprintf(stderr, "workspace too small: need %zu have %zu\n", off, ws_size); return; }
#if MEGA
  hipMemsetAsync(p.bar, 0, 16384, stream);
  static int grid_blocks = 0;
  if (!grid_blocks) {
    int dev = 0, cus = 0, per_cu = 0; hipGetDevice(&dev); hipDeviceGetAttribute(&cus, hipDeviceAttributeMultiprocessorCount, dev);
    hipFuncSetAttribute((const void*)mega_kernel, hipFuncAttributeMaxDynamicSharedMemorySize, LDS_BYTES);
    hipOccupancyMaxActiveBlocksPerMultiprocessor(&per_cu, mega_kernel, NTHREADS, LDS_BYTES);
    if (per_cu > 2) per_cu = 2; if (per_cu < 1) per_cu = 1;
    grid_blocks = cus * per_cu;
  }
  void* args[] = {&p};
  hipError_t e = hipLaunchCooperativeKernel((void*)mega_kernel, dim3(grid_blocks), dim3(NTHREADS), args, LDS_BYTES, stream);
  if (e != hipSuccess) fprintf(stderr, "cooperative launch failed: %s (grid %d)\n", hipGetErrorString(e), grid_blocks);
#else
  const int G = 1024;
  launch_phase<0>(p, G, stream); launch_phase<1>(p, G, stream); launch_phase<2>(p, G, stream); launch_phase<3>(p, G, stream);
  launch_phase<4>(p, G, stream); launch_phase<5>(p, G, stream); launch_phase<6>(p, G, stream); launch_phase<7>(p, G, stream);
  launch_phase<8>(p, G, stream); launch_phase<9>(p, G, stream); launch_phase<11>(p, G, stream);
#endif
}
```

```cpp
#include <hip/hip_runtime.h>
#include <hip/hip_cooperative_groups.h>
#include <cstdio>
#include <cstdint>
namespace cg = cooperative_groups;

#ifndef MEGA
#define MEGA 1
#endif

typedef unsigned short bf16_t;
typedef short bf16x8 __attribute__((ext_vector_type(8)));
typedef float f32x4 __attribute__((ext_vector_type(4)));
typedef unsigned u32x4 __attribute__((ext_vector_type(4)));
#define LAS __attribute__((address_space(3)))
__device__ __forceinline__ bf16x8 as_bf(u32x4 v) { return __builtin_bit_cast(bf16x8, v); }

#define T_TOK 16384
#define SEQL 8192
#define NTHREADS 256
#define LDS_WORK 66560
#define LDS_BYTES (LDS_WORK + 16)
#define EPSF 1e-6f

__device__ __forceinline__ unsigned short f2bf(float f) { unsigned u = __float_as_uint(f); u += 0x7fffu + ((u >> 16) & 1u); return (unsigned short)(u >> 16); }
__device__ __forceinline__ float bf2f(unsigned short b) { return __uint_as_float(((unsigned)b) << 16); }
__device__ __forceinline__ unsigned pack2(float lo, float hi) { return (unsigned)f2bf(lo) | ((unsigned)f2bf(hi) << 16); }
__device__ __forceinline__ float gelu_f(float v) {
  const float av = fabsf(v), t = __builtin_amdgcn_rcpf(av * 0.2316418882f + 1.0f);
  float q = t * 0.5307027145f + (-0.7265760135f); q = q * t + 0.7107068705f; q = q * t + (-0.142248368f); q = q * t + 0.127414796f; q = q * t;
  const float e = __builtin_amdgcn_exp2f((v * v) * (-0.72134752044f)); const float m = v * (q * e);
  return v < 0.f ? m : v - m; }
typedef float f32x2 __attribute__((ext_vector_type(2)));
__device__ __forceinline__ f32x4 mfma16(bf16x8 a, bf16x8 b, f32x4 c) { return __builtin_amdgcn_mfma_f32_16x16x32_bf16(a, b, c, 0, 0, 0); }


#define XB_TMO      128
#define XB_XCNT(j)  (256  + 64 * (j))
#define XB_XSUB(j)  (1280 + 64 * (j))
#define XB_XGEN(j)  (2304 + 64 * (j))
#define XB_TOP      3328
#define XB_TOPGEN   3392
#define XCD_BAR_WORDS 3456
#define XB_SPIN_CAP (1u << 18)
__device__ __forceinline__ unsigned xb_ld(unsigned* p)              { return __hip_atomic_load(p, __ATOMIC_RELAXED, __HIP_MEMORY_SCOPE_AGENT); }
__device__ __forceinline__ unsigned xb_add(unsigned* p, unsigned v) { return __hip_atomic_fetch_add(p, v, __ATOMIC_RELAXED, __HIP_MEMORY_SCOPE_AGENT); }
__device__ __forceinline__ unsigned xb_xcc_id() { return (unsigned)__builtin_amdgcn_s_getreg((3 << 11) | 20) & 0xFu; }
#define XB_SPIN(cond, bar) do { unsigned _sp = 0; while (cond) { __builtin_amdgcn_s_sleep(1); \
    if ((++_sp & 255u) == 0u) { if (xb_ld(&(bar)[XB_TMO])) break; if (_sp > XB_SPIN_CAP) { atomicAdd(&(bar)[XB_TMO], 1u); break; } } } } while (0)
struct XcdBarrier { unsigned* bar; unsigned x; volatile LAS unsigned* st; };
__device__ __forceinline__ XcdBarrier xcd_barrier_post(unsigned* bar, volatile LAS unsigned* st) {
  XcdBarrier b; b.bar = bar; b.x = xb_xcc_id(); b.st = st;
  if (threadIdx.x == 0) (void)xb_add(&bar[XB_XCNT(b.x)], 1u);
  return b;
}
__device__ __forceinline__ void xcd_barrier_complete(unsigned* bar, unsigned x, unsigned& nloc, unsigned& nx) {
  const unsigned G = gridDim.x * gridDim.y * gridDim.z;
  unsigned sum, cnt, mine, sp = 0u;
  for (;;) {
    sum = 0u; cnt = 0u; mine = 0u;
#pragma unroll
    for (unsigned j = 0; j < 16; ++j) { const unsigned c = xb_ld(&bar[XB_XCNT(j)]); sum += c; cnt += (c > 0u) ? 1u : 0u; mine = (j == x) ? c : mine; }
    if (sum == G) break;
    __builtin_amdgcn_s_sleep(1);
    if ((++sp & 255u) == 0u) { if (xb_ld(&bar[XB_TMO])) break; if (sp > XB_SPIN_CAP) { atomicAdd(&bar[XB_TMO], 1u); break; } }
  }
  nloc = mine > 0u ? mine : 1u; nx = cnt > 0u ? cnt : 1u;
}
__device__ __forceinline__ void xcd_barrier(const XcdBarrier& b) {
  asm volatile("s_waitcnt vmcnt(0)" ::: "memory");
  __syncthreads();
  if (threadIdx.x == 0) {
    unsigned* bar = b.bar;
    __builtin_amdgcn_s_waitcnt(0);
    unsigned nloc = b.st[0], nx = b.st[1];
    if (nloc == 0u) { xcd_barrier_complete(bar, b.x, nloc, nx); b.st[0] = nloc; b.st[1] = nx; }
    const unsigned old = xb_add(&bar[XB_XSUB(b.x)], 1u);
    const unsigned gen = old / nloc;
    if (old + 1u == (gen + 1u) * nloc) {
      __builtin_amdgcn_fence(__ATOMIC_RELEASE, "agent");
      asm volatile("s_waitcnt vmcnt(0)" ::: "memory");
      const unsigned og = xb_add(&bar[XB_TOP], 1u);
      const unsigned tg = og / nx;
      if (og + 1u == (tg + 1u) * nx) xb_add(&bar[XB_TOPGEN], 1u);
      else XB_SPIN(xb_ld(&bar[XB_TOPGEN]) == tg, bar);
      __builtin_amdgcn_fence(__ATOMIC_ACQUIRE, "agent");
      xb_add(&bar[XB_XGEN(b.x)], 1u);
      asm volatile("s_waitcnt vmcnt(0)" ::: "memory");
    } else {
      XB_SPIN(xb_ld(&bar[XB_XGEN(b.x)]) == gen, bar);
      __builtin_amdgcn_fence(__ATOMIC_ACQUIRE, "agent");
      asm volatile("s_waitcnt vmcnt(0)" ::: "memory");
    }
  }
  __syncthreads();
}

struct Params {
  const float *x, *mem, *norm_mix_g, *w_in, *att_q_g, *att_k_g, *rel_bias;
  const float *lam_re, *lam_im, *log_step, *b_re, *b_im, *c_re, *c_im, *d_skip, *w_glu, *b_glu;
  const float *att_out_g, *ssm_out_g, *w_out, *norm_mem_g, *norm_memkv_g, *w_mem_q, *w_mem_k, *w_mem_v;
  const float *mem_q_g, *mem_k_g, *w_mem_o, *norm_peer_g, *w_peer_q, *peer_keys, *peer_u, *peer_v;
  float* out;
  unsigned* bar;
  bf16_t *WtIn, *WtGlu, *WtOut, *WtMq, *WtMk, *WtMv, *WtMo, *WtPq, *PK, *PU, *PV;
  bf16_t *XB, *MEMB, *Qb, *Kb, *VT, *Ub, *ATT, *YG, *SSMO, *H1B, *QM, *OM, *H2B, *QP;
  bf16_t *KMB, *VMT, *WE16, *WY;
  float *rs_x, *rs_mem, *ss_att, *ss_ssm, *ss_h1, *ss_qm, *ss_km, *ss_h2, *KMraw, *ESEG;
  float *BBR, *BBI, *PWR, *PWI, *KJ, *APW;
  unsigned* TOPS;
  unsigned char *PU8, *PV8; float *su, *sv;
};

#define GAS __attribute__((address_space(1)))
template <bool ZERO = true, bool SWAP = false>
__device__ __forceinline__ void gemm_mainloop(f32x4 (&acc)[4][4], const bf16_t* __restrict__ A, int lda, const bf16_t* __restrict__ Bt, int ldb, int K,
                                              int row0, int col0, char* lds_) {
  LAS char* lds = (LAS char*)lds_;
  const int tid = threadIdx.x, lane = tid & 63, w = tid >> 6, wr = w >> 1, wc = w & 1, fr = lane & 15, fq = lane >> 4;
  if (ZERO) {
#pragma unroll
    for (int m = 0; m < 4; ++m)
#pragma unroll
      for (int n = 0; n < 4; ++n) acc[m][n] = (f32x4){0.f, 0.f, 0.f, 0.f};
  }
  const int lr = lane >> 3, lc = (lane & 7) ^ lr;
  const bf16_t* gA = A + (size_t)(row0 + w * 32 + lr) * lda + lc * 8;
  const bf16_t* gB = Bt + (size_t)(col0 + w * 32 + lr) * ldb + lc * 8;
  const int wbase = __builtin_amdgcn_readfirstlane(w) * 4096;
  const int nk = K >> 6;
  __syncthreads();
#pragma unroll
  for (int i = 0; i < 4; ++i) {
    __builtin_amdgcn_global_load_lds((const GAS void*)(gA + (size_t)(i * 8) * lda), (LAS void*)(lds + wbase + i * 1024), 16, 0, 0);
    __builtin_amdgcn_global_load_lds((const GAS void*)(gB + (size_t)(i * 8) * ldb), (LAS void*)(lds + 16384 + wbase + i * 1024), 16, 0, 0);
  }
  asm volatile("s_waitcnt vmcnt(0)" ::: "memory");
  __syncthreads();
  for (int kt = 0; kt < nk; ++kt) {
    LAS char* cur = lds + (kt & 1) * 32768; LAS char* nxt = lds + ((kt + 1) & 1) * 32768;
    if (kt + 1 < nk) {
      const int k1 = (kt + 1) << 6;
#pragma unroll
      for (int i = 0; i < 4; ++i) {
        __builtin_amdgcn_global_load_lds((const GAS void*)(gA + (size_t)(i * 8) * lda + k1), (LAS void*)(nxt + wbase + i * 1024), 16, 0, 0);
        __builtin_amdgcn_global_load_lds((const GAS void*)(gB + (size_t)(i * 8) * ldb + k1), (LAS void*)(nxt + 16384 + wbase + i * 1024), 16, 0, 0);
      }
    }
#pragma unroll
    for (int ks = 0; ks < 2; ++ks) {
      bf16x8 af[4], bfr[4];
      const int kc = ks * 4 + fq;
#pragma unroll
      for (int m = 0; m < 4; ++m) { const int r = wr * 64 + m * 16 + fr; af[m] = as_bf(*(const LAS u32x4*)(cur + r * 128 + ((kc ^ (r & 7)) << 4))); }
#pragma unroll
      for (int n = 0; n < 4; ++n) { const int r = wc * 64 + n * 16 + fr; bfr[n] = as_bf(*(const LAS u32x4*)(cur + 16384 + r * 128 + ((kc ^ (r & 7)) << 4))); }
#pragma unroll
      for (int m = 0; m < 4; ++m)
#pragma unroll
        for (int n = 0; n < 4; ++n) acc[m][n] = SWAP ? mfma16(af[m], bfr[n], acc[m][n]) : mfma16(bfr[n], af[m], acc[m][n]);
    }
    asm volatile("s_waitcnt vmcnt(0)" ::: "memory");
    __syncthreads();
  }
}

__device__ void transpose_tile(const float* __restrict__ src, bf16_t* __restrict__ dst, int K, int N, int tile, const float* g0, const float* g1, int split, float* tl  ) {
  const int ntn = N >> 6; const int tk = tile / ntn, tn = tile % ntn; const int k0 = tk << 6, n0 = tn << 6; const int tid = threadIdx.x;
  __syncthreads();
#pragma unroll 4
  for (int i = 0; i < 16; ++i) { const int kk = i * 4 + (tid >> 6), nn = tid & 63; const int k = k0 + kk;
    float g = 1.f; if (g0) g = (k < split) ? g0[k] : g1[k - split];
    tl[kk * 65 + nn] = src[(size_t)k * N + n0 + nn] * g; }
  __syncthreads();
  const int n = tid >> 2, kq = (tid & 3) * 16;
  unsigned o[8];
#pragma unroll
  for (int j = 0; j < 8; ++j) o[j] = pack2(tl[(kq + 2 * j) * 65 + n], tl[(kq + 2 * j + 1) * 65 + n]);
  uint4* d = (uint4*)(dst + (size_t)(n0 + n) * K + k0 + kq);
  d[0] = make_uint4(o[0], o[1], o[2], o[3]); d[1] = make_uint4(o[4], o[5], o[6], o[7]);
}

__device__ void convert_flat(const float* __restrict__ src, bf16_t* __restrict__ dst, size_t n8  , int bid, int nb) {
  for (size_t i = (size_t)bid * NTHREADS + threadIdx.x; i < n8; i += (size_t)nb * NTHREADS) {
    const float4 a = ((const float4*)src)[2 * i], b = ((const float4*)src)[2 * i + 1];
    ((uint4*)dst)[i] = make_uint4(pack2(a.x, a.y), pack2(a.z, a.w), pack2(b.x, b.y), pack2(b.z, b.w));
  }
}
__device__ void rows_bf16_rs(const float* __restrict__ src, bf16_t* __restrict__ dst, float* __restrict__ rs, int nrows, int bid, int nb) {
  const int lane = threadIdx.x & 63, w = threadIdx.x >> 6;
  for (int row = bid * 4 + w; row < nrows; row += nb * 4) {
    const float4* s = (const float4*)(src + (size_t)row * 1024);
    float ss = 0.f; uint2* d = (uint2*)(dst + (size_t)row * 1024);
#pragma unroll
    for (int i = 0; i < 4; ++i) { const float4 v = s[i * 64 + lane]; ss += v.x * v.x + v.y * v.y + v.z * v.z + v.w * v.w; d[i * 64 + lane] = make_uint2(pack2(v.x, v.y), pack2(v.z, v.w)); }
#pragma unroll
    for (int o = 32; o > 0; o >>= 1) ss += __shfl_xor(ss, o);
    if (lane == 0) rs[row] = rsqrtf(ss * (1.0f / 1024.0f) + EPSF);
  }
}

__device__ void rows_fp8(const float* __restrict__ src, unsigned char* __restrict__ dst, float* __restrict__ sc, int nrows, int bid, int nb) {
  const int lane = threadIdx.x & 63, w = threadIdx.x >> 6;
  for (int row = bid * 4 + w; row < nrows; row += nb * 4) {
    const float4* s = (const float4*)(src + (size_t)row * 1024);
    float4 v[4]; float am = 0.f;
#pragma unroll
    for (int i = 0; i < 4; ++i) { v[i] = s[i * 64 + lane]; am = fmaxf(am, fmaxf(fmaxf(fabsf(v[i].x), fabsf(v[i].y)), fmaxf(fabsf(v[i].z), fabsf(v[i].w)))); }
#pragma unroll
    for (int o = 32; o > 0; o >>= 1) am = fmaxf(am, __shfl_xor(am, o));
    const float q = (am > 0.f) ? 224.0f / am : 1.0f;
    unsigned* d = (unsigned*)(dst + (size_t)row * 1024);
#pragma unroll
    for (int i = 0; i < 4; ++i) { int wd = 0; wd = __builtin_amdgcn_cvt_pk_fp8_f32(v[i].x * q, v[i].y * q, wd, false); wd = __builtin_amdgcn_cvt_pk_fp8_f32(v[i].z * q, v[i].w * q, wd, true); d[i * 64 + lane] = (unsigned)wd; }
    if (lane == 0) sc[row] = (am > 0.f) ? am * (1.0f / 224.0f) : 1.0f;
  }
}

__device__ void rows_fp4(const float* __restrict__ src, unsigned char* __restrict__ dst, float* __restrict__ sc, int nrows, int bid, int nb) {
  const int lane = threadIdx.x & 63, w = threadIdx.x >> 6;
  for (int row = bid * 4 + w; row < nrows; row += nb * 4) {
    const float4* s = (const float4*)(src + (size_t)row * 1024 + lane * 16);
    float4 v[4]; float am = 0.f;
#pragma unroll
    for (int i = 0; i < 4; ++i) { v[i] = s[i]; am = fmaxf(am, fmaxf(fmaxf(fabsf(v[i].x), fabsf(v[i].y)), fmaxf(fabsf(v[i].z), fabsf(v[i].w)))); }
#pragma unroll
    for (int o = 32; o > 0; o >>= 1) am = fmaxf(am, __shfl_xor(am, o));
    const float q = (am > 0.f) ? 6.0f / am : 1.0f;
    unsigned w0 = 0, w1 = 0;
    w0 = __builtin_amdgcn_cvt_scalef32_pk_fp4_f32(w0, v[0].x * q, v[0].y * q, 1.0f, 0); w0 = __builtin_amdgcn_cvt_scalef32_pk_fp4_f32(w0, v[0].z * q, v[0].w * q, 1.0f, 1);
    w0 = __builtin_amdgcn_cvt_scalef32_pk_fp4_f32(w0, v[1].x * q, v[1].y * q, 1.0f, 2); w0 = __builtin_amdgcn_cvt_scalef32_pk_fp4_f32(w0, v[1].z * q, v[1].w * q, 1.0f, 3);
    w1 = __builtin_amdgcn_cvt_scalef32_pk_fp4_f32(w1, v[2].x * q, v[2].y * q, 1.0f, 0); w1 = __builtin_amdgcn_cvt_scalef32_pk_fp4_f32(w1, v[2].z * q, v[2].w * q, 1.0f, 1);
    w1 = __builtin_amdgcn_cvt_scalef32_pk_fp4_f32(w1, v[3].x * q, v[3].y * q, 1.0f, 2); w1 = __builtin_amdgcn_cvt_scalef32_pk_fp4_f32(w1, v[3].z * q, v[3].w * q, 1.0f, 3);
    *(uint2*)(dst + (size_t)row * 512 + lane * 8) = make_uint2(w0, w1);
    if (lane == 0) sc[row] = (am > 0.f) ? am * (1.0f / 6.0f) : 1.0f;
  }
}

__device__ void ssm_stage1(const Params& p, int gp) {
  const int g = gp >> 6;
  const float step = expf(p.log_step[g]); const float lr = p.lam_re[gp], li = p.lam_im[gp];
  const float mag = expf(lr * step); const float ar = mag * cosf(li * step), ai = mag * sinf(li * step);
  const float zr = ar - 1.0f, den = lr * lr + li * li; const float fr = (zr * lr + ai * li) / den, fi = (ai * lr - zr * li) / den;
  for (int c = 0; c < 16; ++c) { const float br = p.b_re[gp * 16 + c], bi = p.b_im[gp * 16 + c]; p.BBR[gp * 16 + c] = fr * br - fi * bi; p.BBI[gp * 16 + c] = fr * bi + fi * br; }
  float pr = 1.f, pi = 0.f; const int st = gp & 63;
  for (int j = 0; j <= 16; ++j) { p.PWR[(g * 17 + j) * 64 + st] = pr; p.PWI[(g * 17 + j) * 64 + st] = pi; const float nr = pr * ar - pi * ai, ni = pr * ai + pi * ar; if (j < 16) { pr = nr; pi = ni; } }
  const float a16r = pr, a16i = pi; const float a32r = a16r * a16r - a16i * a16i, a32i = 2.f * a16r * a16i;
  const float a48r = a32r * a16r - a32i * a16i, a48i = a32r * a16i + a32i * a16r; const float a64r = a32r * a32r - a32i * a32i, a64i = 2.f * a32r * a32i;
  const float a128r = a64r * a64r - a64i * a64i, a128i = 2.f * a64r * a64i; const float a256r = a128r * a128r - a128i * a128i, a256i = 2.f * a128r * a128i;
  float* A = p.APW;
  A[0 * 4096 + gp] = a16r; A[0 * 4096 + 2048 + gp] = a16i; A[1 * 4096 + gp] = a32r; A[1 * 4096 + 2048 + gp] = a32i; A[2 * 4096 + gp] = a48r; A[2 * 4096 + 2048 + gp] = a48i;
  A[3 * 4096 + gp] = a64r; A[3 * 4096 + 2048 + gp] = a64i; A[4 * 4096 + gp] = a256r; A[4 * 4096 + 2048 + gp] = a256i;
}
__device__ void ssm_stage2a(const Params& p, int bid, int nb) {
  const int n1 = 32 * 128 * 256, n2 = 32 * 16 * 4 * 512, n3 = 32 * 16 * 256;
  for (int i = bid * NTHREADS + threadIdx.x; i < n1 + n2 + n3; i += nb * NTHREADS) {
    if (i < n1) {
      const int j = i & 7, lane = (i >> 3) & 63, ks = (i >> 9) & 7, ri = (i >> 12) & 1, w = (i >> 13) & 3, g = i >> 15;
      const int st = w * 16 + (lane & 15), k = ks * 32 + (lane >> 4) * 8 + j; const int s_ = k >> 4, ch = k & 15;
      const int gp = g * 64 + st; const float pr = p.PWR[(g * 17 + 15 - s_) * 64 + st], pi = p.PWI[(g * 17 + 15 - s_) * 64 + st]; const float br = p.BBR[gp * 16 + ch], bi = p.BBI[gp * 16 + ch];
      p.WE16[i] = f2bf(ri == 0 ? (pr * br - pi * bi) : (pr * bi + pi * br));
    } else if (i < n1 + n2) {
      const int e = i - n1; const int j = e & 7, lane = (e >> 3) & 63, ks = (e >> 9) & 3, mt = (e >> 11) & 15, g = e >> 15;
      const int t = mt, co = lane & 15, k = ks * 32 + (lane >> 4) * 8 + j;
      const int st = ((k >> 5) << 4) | (k & 15), ri = (k >> 4) & 1; const float cr = p.c_re[(g * 16 + co) * 64 + st], ci = p.c_im[(g * 16 + co) * 64 + st];
      const float pr = p.PWR[(g * 17 + t + 1) * 64 + st], pi = p.PWI[(g * 17 + t + 1) * 64 + st];
      p.WY[((size_t)(g * 16 + mt) * 12 + ks) * 512 + lane * 8 + j] = f2bf((ri == 0) ? (cr * pr - ci * pi) : -(cr * pi + ci * pr));
    } else {
      const int e = i - n1 - n2; const int cin = e & 15, co = (e >> 4) & 15, j = (e >> 8) & 15, g = e >> 12; float acc = 0.f;
      for (int st = 0; st < 64; ++st) { const float cr = p.c_re[(g * 16 + co) * 64 + st], ci = p.c_im[(g * 16 + co) * 64 + st]; const float pr = p.PWR[(g * 17 + j) * 64 + st], pi = p.PWI[(g * 17 + j) * 64 + st];
        const float br = p.BBR[(g * 64 + st) * 16 + cin], bi = p.BBI[(g * 64 + st) * 16 + cin]; acc += cr * (pr * br - pi * bi) - ci * (pr * bi + pi * br); }
      p.KJ[e] = acc;
    }
  }
}
__device__ void ssm_stage2b(const Params& p, int bid, int nb) {
  const int n = 32 * 16 * 8 * 512;
  for (int i = bid * NTHREADS + threadIdx.x; i < n; i += nb * NTHREADS) {
    const int j = i & 7, lane = (i >> 3) & 63, ks8 = (i >> 9) & 7, mt = (i >> 12) & 15, g = i >> 16;
    const int t = mt, co = lane & 15, kk = ks8 * 32 + (lane >> 4) * 8 + j; const int s_ = kk >> 4, cin = kk & 15;
    const float val = (s_ <= t) ? p.KJ[((g * 16 + (t - s_)) * 16 + co) * 16 + cin] : 0.f;
    p.WY[((size_t)(g * 16 + mt) * 12 + 4 + ks8) * 512 + lane * 8 + j] = f2bf(val);
  }
}

#define EPI_IDS const int tid = threadIdx.x, lane = tid & 63, w = tid >> 6, wr = w >> 1, wc = w & 1, fr = lane & 15, fq = lane >> 4; (void)wr; (void)wc; (void)fr; (void)fq;

__device__ void tile_win_v(const Params& p, int tile, char* lds) {
  const int rt = tile >> 4, ct = tile & 15; const int row0 = rt * 128, col0 = ct * 128;
  f32x4 acc[4][4];
  gemm_mainloop<true, true>(acc, p.XB, 1024, p.WtIn, 1024, 1024, row0, col0, lds);
  EPI_IDS
  const int head = (col0 + wc * 64 - 1024) >> 6;
#pragma unroll
  for (int m = 0; m < 4; ++m) {
    const int row = row0 + wr * 64 + m * 16 + fq * 4; const f32x4 rsx = *(const f32x4*)(p.rs_x + row); const int b = row >> 13, tb = row & 8191;
#pragma unroll
    for (int n = 0; n < 4; ++n) { const f32x4 v = acc[m][n] * rsx;
      *(uint2*)(p.VT + ((size_t)(b * 8 + head) * 64 + n * 16 + fr) * SEQL + tb) = make_uint2(pack2(v[0], v[1]), pack2(v[2], v[3])); }
  }
}
__device__ void tile_win(const Params& p, int tile, char* lds) {
  const int rt = tile >> 4, ct = tile & 15; const int row0 = rt * 128, col0 = ct * 128;
  f32x4 acc[4][4];
  gemm_mainloop<true>(acc, p.XB, 1024, p.WtIn, 1024, 1024, row0, col0, lds);
  EPI_IDS
  const int cw = col0 + wc * 64;
#pragma unroll
  for (int m = 0; m < 4; ++m) {
    const int row = row0 + wr * 64 + m * 16 + fr; const float rsx = p.rs_x[row];
    if (cw < 1024) {
      float ss = 0.f;
#pragma unroll
      for (int n = 0; n < 4; ++n)
#pragma unroll
        for (int j = 0; j < 4; ++j) { const float v = acc[m][n][j] * rsx; acc[m][n][j] = v; ss += v * v; }
      ss += __shfl_xor(ss, 16); ss += __shfl_xor(ss, 32);
      const float rs = rsqrtf(ss * (1.0f / 64.0f) + EPSF) * (cw < 512 ? 0.125f : 1.0f);
      const float* g = (cw < 512) ? p.att_q_g : p.att_k_g; bf16_t* dst = (cw < 512 ? p.Qb : p.Kb) + (size_t)row * 512 + (cw & 511);
#pragma unroll
      for (int n = 0; n < 4; ++n) { const int c = n * 16 + fq * 4; const float4 gg = *(const float4*)(g + c);
        *(uint2*)(dst + c) = make_uint2(pack2(acc[m][n][0] * rs * gg.x, acc[m][n][1] * rs * gg.y), pack2(acc[m][n][2] * rs * gg.z, acc[m][n][3] * rs * gg.w)); }
    } else if (cw < 1536) {
      const int head = (cw - 1024) >> 6; const int b = row >> 13, tb = row & 8191;
      bf16_t* dst = p.VT + ((size_t)(b * 8 + head) * 64) * SEQL + tb;
#pragma unroll
      for (int n = 0; n < 4; ++n)
#pragma unroll
        for (int j = 0; j < 4; ++j) dst[(size_t)(n * 16 + fq * 4 + j) * SEQL] = f2bf(acc[m][n][j] * rsx);
    } else {
      const int b = row >> 13, tb = row & 8191;
#pragma unroll
      for (int n = 0; n < 4; ++n) { const int g = ((cw - 1536) >> 4) + n;
        *(uint2*)(p.Ub + ((size_t)(b * 32 + g) * SEQL + tb) * 16 + fq * 4) = make_uint2(pack2(acc[m][n][0] * rsx, acc[m][n][1] * rsx), pack2(acc[m][n][2] * rsx, acc[m][n][3] * rsx)); }
    }
  }
}
__device__ void tile_memkv(const Params& p, int tile, char* lds) {
  const int which = tile >> 5, t2 = tile & 31; const int rt = t2 >> 3, ct = t2 & 7; const int row0 = rt * 128, col0 = ct * 128;
  f32x4 acc[4][4];
  gemm_mainloop<true>(acc, p.MEMB, 1024, which ? p.WtMv : p.WtMk, 1024, 1024, row0, col0, lds);
  EPI_IDS
  const int cw = col0 + wc * 64;
#pragma unroll
  for (int m = 0; m < 4; ++m) {
    const int row = row0 + wr * 64 + m * 16 + fr; const float rsm = p.rs_mem[row];
    if (which == 0) {
      float ss = 0.f;
#pragma unroll
      for (int n = 0; n < 4; ++n) { f32x4 v = acc[m][n] * rsm; ss += v[0] * v[0] + v[1] * v[1] + v[2] * v[2] + v[3] * v[3]; *(f32x4*)(p.KMraw + (size_t)row * 1024 + cw + n * 16 + fq * 4) = v; }
      ss += __shfl_xor(ss, 16); ss += __shfl_xor(ss, 32);
      if (fq == 0) p.ss_km[row * 16 + (cw >> 6)] = ss;
    } else {
      const int b = row >> 8, key = row & 255; const int head = cw >> 8; const int d0 = (cw & 255);
      bf16_t* dst = p.VMT + ((size_t)(b * 4 + head) * 256) * 256 + key;
#pragma unroll
      for (int n = 0; n < 4; ++n)
#pragma unroll
        for (int j = 0; j < 4; ++j) dst[(size_t)(d0 + n * 16 + fq * 4 + j) * 256] = f2bf(acc[m][n][j] * rsm);
    }
  }
}
__device__ void memk_fix(const Params& p, int bid, int nb) {
  for (int i = bid * NTHREADS + threadIdx.x; i < 512 * 1024 / 4; i += nb * NTHREADS) {
    const int row = i >> 8, c4 = (i & 255) * 4; const int head = c4 >> 8, d = c4 & 255;
    const float ss = p.ss_km[row * 16 + head * 4] + p.ss_km[row * 16 + head * 4 + 1] + p.ss_km[row * 16 + head * 4 + 2] + p.ss_km[row * 16 + head * 4 + 3];
    const float rs = rsqrtf(ss * (1.0f / 256.0f) + EPSF);
    const float4 v = *(const float4*)(p.KMraw + (size_t)row * 1024 + c4); const float4 gk = *(const float4*)(p.mem_k_g + d), gq = *(const float4*)(p.mem_q_g + d);
    const int b = row >> 8, key = row & 255;
    *(uint2*)(p.KMB + ((size_t)(b * 4 + head) * 256 + key) * 256 + d) = make_uint2(pack2(v.x * rs * gk.x * gq.x, v.y * rs * gk.y * gq.y), pack2(v.z * rs * gk.z * gq.z, v.w * rs * gk.w * gq.w));
  }
}

__device__ void chunk_attn_item(const Params& p, int item, char* lds_) {
  LAS char* lds = (LAS char*)lds_; LAS float* rb = (LAS float*)(lds + 32768);
  typedef unsigned u32x2 __attribute__((ext_vector_type(2)));
  const int h = item & 7, cn = (item >> 3) & 127, b = item >> 10;
  const int tid = threadIdx.x, lane = tid & 63, w = tid >> 6, fr = lane & 15, fq = lane >> 4;
  const int iq = w * 16 + fr; const int tq = b * SEQL + cn * 64 + iq;
  const int cstart = (cn >= 8) ? 0 : (8 - cn);
  const bf16_t* vtb = p.VT + ((size_t)(b * 8 + h) * 64) * SEQL;
  const int r0 = tid >> 3, ch = tid & 7;
  u32x4 kr[2], vr[2];
  { const int kc0 = (cn - 8 + cstart) * 64;
#pragma unroll
    for (int i = 0; i < 2; ++i) { kr[i] = *(const u32x4*)(p.Kb + (size_t)(b * SEQL + kc0 + r0 + 32 * i) * 512 + h * 64 + ch * 8); vr[i] = *(const u32x4*)(vtb + (size_t)(r0 + 32 * i) * SEQL + kc0 + ch * 8); } }
  bf16x8 qf[2];
  qf[0] = *(const bf16x8*)(p.Qb + (size_t)tq * 512 + h * 64 + fq * 8); qf[1] = *(const bf16x8*)(p.Qb + (size_t)tq * 512 + h * 64 + 32 + fq * 8);
  __syncthreads();
  if (tid < 192) rb[tid] = p.rel_bias[h * 192 + tid];
#pragma unroll
  for (int i = 0; i < 2; ++i) { const int r = r0 + 32 * i; *(LAS u32x4*)(lds + r * 128 + ((ch ^ (r & 7)) << 4)) = kr[i]; *(LAS u32x4*)(lds + 8192 + r * 128 + ((ch ^ ((r >> 1) & 7)) << 4)) = vr[i]; }
  __syncthreads();
  f32x4 o[4]; for (int i = 0; i < 4; ++i) o[i] = (f32x4){0.f, 0.f, 0.f, 0.f};
  float mrun = -1e30f, lrun = 0.f;
  for (int c = cstart; c <= 8; ++c) {
    LAS char* cur = lds + ((c - cstart) & 1) * 16384; LAS char* nxt = lds + ((c - cstart + 1) & 1) * 16384;
    const bool more = c < 8;
    if (more) { const int kc1 = (cn - 8 + c + 1) * 64;
#pragma unroll
      for (int i = 0; i < 2; ++i) { kr[i] = *(const u32x4*)(p.Kb + (size_t)(b * SEQL + kc1 + r0 + 32 * i) * 512 + h * 64 + ch * 8); vr[i] = *(const u32x4*)(vtb + (size_t)(r0 + 32 * i) * SEQL + kc1 + ch * 8); } }
    f32x4 st[4];
#pragma unroll
    for (int mt = 0; mt < 4; ++mt) { const int row = mt * 16 + fr; f32x4 sacc = (f32x4){0.f, 0.f, 0.f, 0.f};
      sacc = mfma16(as_bf(*(const LAS u32x4*)(cur + row * 128 + ((fq ^ (row & 7)) << 4))), qf[0], sacc);
      sacc = mfma16(as_bf(*(const LAS u32x4*)(cur + row * 128 + (((4 + fq) ^ (row & 7)) << 4))), qf[1], sacc); st[mt] = sacc; }
    float tmax = -1e30f;
#pragma unroll
    for (int mt = 0; mt < 4; ++mt)
#pragma unroll
      for (int j = 0; j < 4; ++j) { const int jk = mt * 16 + fq * 4 + j; int dist = 512 - 64 * c + iq - jk; dist = dist < -63 ? -63 : (dist > 128 ? 128 : dist);
        const float sv = st[mt][j] + rb[dist + 63]; st[mt][j] = sv; tmax = fmaxf(tmax, sv); }
    tmax = fmaxf(tmax, __shfl_xor(tmax, 16)); tmax = fmaxf(tmax, __shfl_xor(tmax, 32));
    const float mnew = fmaxf(mrun, tmax); const float alpha = __expf(mrun - mnew); mrun = mnew;
    float ls = 0.f;
#pragma unroll
    for (int mt = 0; mt < 4; ++mt)
#pragma unroll
      for (int j = 0; j < 4; ++j) { const float pv = __expf(st[mt][j] - mnew); st[mt][j] = pv; ls += pv; }
    lrun = lrun * alpha + ls;
    bf16x8 pf[2];
#pragma unroll
    for (int s2 = 0; s2 < 2; ++s2) { u32x4 t; t.x = pack2(st[2 * s2][0], st[2 * s2][1]); t.y = pack2(st[2 * s2][2], st[2 * s2][3]); t.z = pack2(st[2 * s2 + 1][0], st[2 * s2 + 1][1]); t.w = pack2(st[2 * s2 + 1][2], st[2 * s2 + 1][3]); pf[s2] = as_bf(t); }
#pragma unroll
    for (int dt = 0; dt < 4; ++dt) { const int d = dt * 16 + fr; const int sw = ((d >> 1) & 7) << 1; f32x4 oc = o[dt] * alpha;
#pragma unroll
      for (int s2 = 0; s2 < 2; ++s2) {
        const u32x2 lo = *(const LAS u32x2*)(cur + 8192 + d * 128 + (((s2 * 8 + fq) ^ sw) << 3)), hi = *(const LAS u32x2*)(cur + 8192 + d * 128 + (((s2 * 8 + fq + 4) ^ sw) << 3));
        u32x4 vv; vv.x = lo.x; vv.y = lo.y; vv.z = hi.x; vv.w = hi.y; oc = mfma16(as_bf(vv), pf[s2], oc); }
      o[dt] = oc; }
    if (more) {
#pragma unroll
      for (int i = 0; i < 2; ++i) { const int r = r0 + 32 * i; *(LAS u32x4*)(nxt + r * 128 + ((ch ^ (r & 7)) << 4)) = kr[i]; *(LAS u32x4*)(nxt + 8192 + r * 128 + ((ch ^ ((r >> 1) & 7)) << 4)) = vr[i]; }
    }
    __syncthreads();
  }
  float lt = lrun; lt += __shfl_xor(lt, 16); lt += __shfl_xor(lt, 32);
  const float inv = 1.0f / lt; float ss = 0.f;
  bf16_t* dst = p.ATT + (size_t)tq * 512 + h * 64;
#pragma unroll
  for (int dt = 0; dt < 4; ++dt) { const f32x4 v = o[dt] * inv; ss += v[0] * v[0] + v[1] * v[1] + v[2] * v[2] + v[3] * v[3];
    *(uint2*)(dst + dt * 16 + fq * 4) = make_uint2(pack2(v[0], v[1]), pack2(v[2], v[3])); }
  ss += __shfl_xor(ss, 16); ss += __shfl_xor(ss, 32);
  if (fq == 0) p.ss_att[tq * 8 + h] = ss;
}

template <bool FINAL>
__device__ void ssm_item(const Params& p, int item, char* lds) {
  const int g = item & 31, seg = (item >> 5) & 31, b = item >> 10;
  const int tid = threadIdx.x, lane = tid & 63, w = tid >> 6, fr = lane & 15, fq = lane >> 4;
  const int t0 = b * SEQL + seg * 256;
  const bf16_t* ug = p.Ub + ((size_t)(b * 32 + g) * SEQL + seg * 256) * 16;
  bf16x8 uf[8];
#pragma unroll
  for (int ks = 0; ks < 8; ++ks) uf[ks] = *(const bf16x8*)(ug + (size_t)(fr * 16 + 2 * ks + (fq >> 1)) * 16 + (fq & 1) * 8);
  f32x4 er = (f32x4){0.f, 0.f, 0.f, 0.f}, ei = er;
  const bf16_t* we = p.WE16 + ((size_t)(g * 4 + w) * 2 * 8 * 64 + lane) * 8;
#pragma unroll
  for (int ks = 0; ks < 8; ++ks) { const bf16x8 br = *(const bf16x8*)(we + ks * 512), bi = *(const bf16x8*)(we + 4096 + ks * 512); er = mfma16(uf[ks], br, er); ei = mfma16(uf[ks], bi, ei); }
  const int gp = g * 64 + w * 16 + fr;
  const float a16r = p.APW[gp], a16i = p.APW[2048 + gp];
  float xr[4], xi[4];
  xr[0] = er[0]; xi[0] = ei[0];
#pragma unroll
  for (int j = 1; j < 4; ++j) { xr[j] = a16r * xr[j - 1] - a16i * xi[j - 1] + er[j]; xi[j] = a16r * xi[j - 1] + a16i * xr[j - 1] + ei[j]; }
  float cr = 0.f, ci = 0.f;
  if (FINAL) {
    const float ar = p.APW[4 * 4096 + gp], ai = p.APW[4 * 4096 + 2048 + gp];
    const float* es = p.ESEG + ((size_t)(b * 32) * 32 + g) * 128 + w * 32 + fr;
    for (int j0 = 0; j0 < seg; j0 += 8) { float e_r[8], e_i[8];
#pragma unroll
      for (int u = 0; u < 8; ++u) { e_r[u] = es[(size_t)(j0 + u) * 32 * 128]; e_i[u] = es[(size_t)(j0 + u) * 32 * 128 + 16]; }
#pragma unroll
      for (int u = 0; u < 8; ++u) if (j0 + u < seg) { const float nr = ar * cr - ai * ci + e_r[u], ni = ar * ci + ai * cr + e_i[u]; cr = nr; ci = ni; } }
  }
  const float a64r = p.APW[3 * 4096 + gp], a64i = p.APW[3 * 4096 + 2048 + gp];
  float tr = xr[3], ti = xi[3];
#pragma unroll
  for (int r = 0; r < 4; ++r) {
    float pr_ = __shfl(tr, (lane + 48) & 63), pi_ = __shfl(ti, (lane + 48) & 63);
    if (r == 0) { pr_ = cr; pi_ = ci; }
    if (fq == r) { const float nr = xr[3] + a64r * pr_ - a64i * pi_, ni = xi[3] + a64r * pi_ + a64i * pr_; tr = nr; ti = ni; }
  }
  if (!FINAL) {
    if (fq == 3) { float* es = p.ESEG + ((size_t)(b * 32 + seg) * 32 + g) * 128 + w * 32 + fr; es[0] = tr; es[16] = ti; }
    return;
  }
  float gr = __shfl(tr, (lane + 48) & 63), gi = __shfl(ti, (lane + 48) & 63);
  if (fq == 0) { gr = cr; gi = ci; }
  float pvr[4], pvi[4];
  pvr[0] = gr; pvi[0] = gi;
#pragma unroll
  for (int j = 1; j < 4; ++j) { const float ar = p.APW[(j - 1) * 4096 + gp], ai = p.APW[(j - 1) * 4096 + 2048 + gp]; pvr[j] = xr[j - 1] + ar * gr - ai * gi; pvi[j] = xi[j - 1] + ar * gi + ai * gr; }
  bf16_t* xl = (bf16_t*)lds;
  __syncthreads();
#pragma unroll
  for (int j = 0; j < 4; ++j) { xl[(fq * 4 + j) * 136 + w * 32 + fr] = f2bf(pvr[j]); xl[(fq * 4 + j) * 136 + w * 32 + 16 + fr] = f2bf(pvi[j]); }
  __syncthreads();
  bf16x8 xf[4];
#pragma unroll
  for (int ks = 0; ks < 4; ++ks) xf[ks] = *(const bf16x8*)(xl + fr * 136 + ks * 32 + fq * 8);
#pragma unroll
  for (int mi = 0; mi < 4; ++mi) {
    const int mt = w * 4 + mi;
    const bf16_t* wy = p.WY + ((size_t)(g * 16 + mt) * 12 * 64 + lane) * 8;
    f32x4 y = (f32x4){0.f, 0.f, 0.f, 0.f};
#pragma unroll
    for (int ks = 0; ks < 4; ++ks) y = mfma16(*(const bf16x8*)(wy + ks * 512), xf[ks], y);
#pragma unroll
    for (int ks = 0; ks < 8; ++ks) if (2 * ks <= mt) y = mfma16(*(const bf16x8*)(wy + (4 + ks) * 512), uf[ks], y);
    const size_t tok = (size_t)(t0 + fr * 16 + mt);
    const uint2 uu = *(const uint2*)(ug + (size_t)(fr * 16 + mt) * 16 + fq * 4);
    const float4 dd = *(const float4*)(p.d_skip + g * 16 + fq * 4);
    const float y0 = gelu_f(y[0] + dd.x * __uint_as_float(uu.x << 16)), y1 = gelu_f(y[1] + dd.y * __uint_as_float(uu.x & 0xffff0000u));
    const float y2 = gelu_f(y[2] + dd.z * __uint_as_float(uu.y << 16)), y3 = gelu_f(y[3] + dd.w * __uint_as_float(uu.y & 0xffff0000u));
    *(uint2*)(p.YG + tok * 512 + g * 16 + fq * 4) = make_uint2(pack2(y0, y1), pack2(y2, y3));
  }
}

__device__ void tile_glu(const Params& p, int tile, char* lds) {
  const int rt = tile >> 2, ct = tile & 3; const int row0 = rt * 128, col0 = ct * 128;
  f32x4 acc[4][4];
  gemm_mainloop<true>(acc, p.YG, 512, p.WtGlu, 512, 512, row0, col0, lds);
  EPI_IDS
  const int cw = col0 + wc * 64;
#pragma unroll
  for (int m = 0; m < 4; ++m) {
    const int row = row0 + wr * 64 + m * 16 + fr; float ss = 0.f;
#pragma unroll
    for (int n = 0; n < 4; ++n) { const int c = cw + n * 16 + fq * 4; const float4 bg = *(const float4*)(p.b_glu + c); const uint2 yy = *(const uint2*)(p.YG + (size_t)row * 512 + c);
      const float y0 = __uint_as_float(yy.x << 16), y1 = __uint_as_float(yy.x & 0xffff0000u), y2 = __uint_as_float(yy.y << 16), y3 = __uint_as_float(yy.y & 0xffff0000u);
      const float o0 = y0 / (1.f + __expf(-(acc[m][n][0] + bg.x))), o1 = y1 / (1.f + __expf(-(acc[m][n][1] + bg.y))), o2 = y2 / (1.f + __expf(-(acc[m][n][2] + bg.z))), o3 = y3 / (1.f + __expf(-(acc[m][n][3] + bg.w)));
      ss += o0 * o0 + o1 * o1 + o2 * o2 + o3 * o3;
      *(uint2*)(p.SSMO + (size_t)row * 512 + c) = make_uint2(pack2(o0, o1), pack2(o2, o3)); }
    ss += __shfl_xor(ss, 16); ss += __shfl_xor(ss, 32);
    if (fq == 0) p.ss_ssm[row * 8 + (cw >> 6)] = ss;
  }
}
__device__ void tile_wout(const Params& p, int tile, char* lds) {
  const int rt = tile >> 3, ct = tile & 7; const int row0 = rt * 128, col0 = ct * 128;
  f32x4 acc[4][4];
  float s1[4];
  gemm_mainloop<true>(acc, p.ATT, 512, p.WtOut, 1024, 512, row0, col0, lds);
  { const int lane_ = threadIdx.x & 63, w_ = threadIdx.x >> 6;
#pragma unroll
    for (int m = 0; m < 4; ++m) { const int row = row0 + (w_ >> 1) * 64 + m * 16 + (lane_ & 15); float a = 0.f, c = 0.f;
#pragma unroll
      for (int j = 0; j < 8; ++j) { a += p.ss_att[row * 8 + j]; c += p.ss_ssm[row * 8 + j]; }
      const float ra = rsqrtf(a * (1.0f / 512.0f) + EPSF); s1[m] = rsqrtf(c * (1.0f / 512.0f) + EPSF); const float f = ra / s1[m];
#pragma unroll
      for (int n = 0; n < 4; ++n) acc[m][n] *= f; } }
  gemm_mainloop<false>(acc, p.SSMO, 512, p.WtOut + 512, 1024, 512, row0, col0, lds);
  EPI_IDS
  const int cw = col0 + wc * 64;
#pragma unroll
  for (int m = 0; m < 4; ++m) {
    const int row = row0 + wr * 64 + m * 16 + fr; float ss = 0.f;
#pragma unroll
    for (int n = 0; n < 4; ++n) { const int c = cw + n * 16 + fq * 4; const f32x4 xv = *(const f32x4*)(p.x + (size_t)row * 1024 + c); const f32x4 hv = xv + acc[m][n] * s1[m];
      ss += hv[0] * hv[0] + hv[1] * hv[1] + hv[2] * hv[2] + hv[3] * hv[3];
      *(uint2*)(p.H1B + (size_t)row * 1024 + c) = make_uint2(pack2(hv[0], hv[1]), pack2(hv[2], hv[3])); }
    ss += __shfl_xor(ss, 16); ss += __shfl_xor(ss, 32);
    if (fq == 0) p.ss_h1[row * 16 + (cw >> 6)] = ss;
  }
}
__device__ __forceinline__ float row_rs16(const float* ss, int row) { float a = 0.f;
#pragma unroll
  for (int j = 0; j < 16; ++j) a += ss[row * 16 + j];
  return rsqrtf(a * (1.0f / 1024.0f) + EPSF); }
__device__ void tile_memq(const Params& p, int tile, char* lds) {
  const int rt = tile >> 3, ct = tile & 7; const int row0 = rt * 128, col0 = ct * 128;
  f32x4 acc[4][4];
  gemm_mainloop<true>(acc, p.H1B, 1024, p.WtMq, 1024, 1024, row0, col0, lds);
  EPI_IDS
  const int cw = col0 + wc * 64;
#pragma unroll
  for (int m = 0; m < 4; ++m) {
    const int row = row0 + wr * 64 + m * 16 + fr; const float rs = row_rs16(p.ss_h1, row); float ss = 0.f;
#pragma unroll
    for (int n = 0; n < 4; ++n) { const int c = cw + n * 16 + fq * 4; const f32x4 v = acc[m][n] * rs; ss += v[0] * v[0] + v[1] * v[1] + v[2] * v[2] + v[3] * v[3];
      *(uint2*)(p.QM + (size_t)row * 1024 + c) = make_uint2(pack2(v[0], v[1]), pack2(v[2], v[3])); }
    ss += __shfl_xor(ss, 16); ss += __shfl_xor(ss, 32);
    if (fq == 0) p.ss_qm[row * 16 + (cw >> 6)] = ss;
  }
}
__device__ __forceinline__ void mem_stage(const bf16_t* kg, const bf16_t* vg, int kc, LAS char* buf, int w, int lane) {
  const int wb = __builtin_amdgcn_readfirstlane(w) * 4096;
#pragma unroll
  for (int i = 0; i < 4; ++i) {
    const int row = w * 8 + i * 2 + (lane >> 5), pos = lane & 31; const int ch = pos ^ (row & 15);
    __builtin_amdgcn_global_load_lds((const GAS void*)(kg + (size_t)(kc * 32 + row) * 256 + ch * 8), (LAS void*)(buf + wb + i * 1024), 16, 0, 0);
  }
#pragma unroll
  for (int i = 0; i < 4; ++i) {
    const int d = w * 64 + i * 16 + (lane >> 2), pos = lane & 3; const int ch = pos ^ ((d >> 2) & 3);
    __builtin_amdgcn_global_load_lds((const GAS void*)(vg + (size_t)d * 256 + kc * 32 + ch * 8), (LAS void*)(buf + 16384 + wb + i * 1024), 16, 0, 0);
  }
}
__device__ void mem_attn_item(const Params& p, int item, char* lds_) {
  LAS char* lds = (LAS char*)lds_;
  typedef unsigned u32x2 __attribute__((ext_vector_type(2)));
  const int h = item & 3, tt = item >> 2; const int tid = threadIdx.x, lane = tid & 63, w = tid >> 6, fr = lane & 15, fq = lane >> 4;
  const int tq = tt * 64 + w * 16 + fr; const int b = tq >> 13;
  const bf16_t* kg = p.KMB + (size_t)(b * 4 + h) * 256 * 256;
  const bf16_t* vg = p.VMT + (size_t)(b * 4 + h) * 256 * 256;
  __syncthreads();
  mem_stage(kg, vg, 0, lds, w, lane);
  const float ssq = p.ss_qm[tq * 16 + h * 4] + p.ss_qm[tq * 16 + h * 4 + 1] + p.ss_qm[tq * 16 + h * 4 + 2] + p.ss_qm[tq * 16 + h * 4 + 3];
  const float rowscale = rsqrtf(ssq * (1.0f / 256.0f) + EPSF) * 0.0625f;
  bf16x8 qf[8];
#pragma unroll
  for (int ks = 0; ks < 8; ++ks) qf[ks] = *(const bf16x8*)(p.QM + (size_t)tq * 1024 + h * 256 + ks * 32 + fq * 8);
  f32x4 o[16];
#pragma unroll
  for (int i = 0; i < 16; ++i) o[i] = (f32x4){0.f, 0.f, 0.f, 0.f};
  float mrun = -1e30f, lrun = 0.f;
  asm volatile("s_waitcnt vmcnt(0)" ::: "memory");
  __syncthreads();
  for (int kc = 0; kc < 8; ++kc) {
    LAS char* cur = lds + (kc & 1) * 32768; LAS char* nxt = lds + ((kc + 1) & 1) * 32768;
    if (kc + 1 < 8) mem_stage(kg, vg, kc + 1, nxt, w, lane);
    f32x4 st[2];
#pragma unroll
    for (int mt = 0; mt < 2; ++mt) { f32x4 sacc = (f32x4){0.f, 0.f, 0.f, 0.f}; const int row = mt * 16 + fr;
#pragma unroll
      for (int ks = 0; ks < 8; ++ks) sacc = mfma16(as_bf(*(const LAS u32x4*)(cur + row * 512 + (((ks * 4 + fq) ^ (row & 15)) << 4))), qf[ks], sacc);
      st[mt] = sacc * rowscale; }
    float tmax = fmaxf(fmaxf(fmaxf(st[0][0], st[0][1]), fmaxf(st[0][2], st[0][3])), fmaxf(fmaxf(st[1][0], st[1][1]), fmaxf(st[1][2], st[1][3])));
    tmax = fmaxf(tmax, __shfl_xor(tmax, 16)); tmax = fmaxf(tmax, __shfl_xor(tmax, 32));
    const float mnew = fmaxf(mrun, tmax); const float alpha = __expf(mrun - mnew); mrun = mnew;
    float ls = 0.f;
#pragma unroll
    for (int mt = 0; mt < 2; ++mt)
#pragma unroll
      for (int j = 0; j < 4; ++j) { const float e = __expf(st[mt][j] - mnew); st[mt][j] = e; ls += e; }
    lrun = lrun * alpha + ls;
    u32x4 t; t.x = pack2(st[0][0], st[0][1]); t.y = pack2(st[0][2], st[0][3]); t.z = pack2(st[1][0], st[1][1]); t.w = pack2(st[1][2], st[1][3]);
    const bf16x8 pf = as_bf(t);
#pragma unroll
    for (int dt = 0; dt < 16; ++dt) { const int d = dt * 16 + fr; const int sw = ((d >> 2) & 3) << 1;
      const u32x2 lo = *(const LAS u32x2*)(cur + 16384 + d * 64 + ((fq ^ sw) << 3)), hi = *(const LAS u32x2*)(cur + 16384 + d * 64 + (((fq + 4) ^ sw) << 3));
      u32x4 vv; vv.x = lo.x; vv.y = lo.y; vv.z = hi.x; vv.w = hi.y; o[dt] = mfma16(as_bf(vv), pf, o[dt] * alpha); }
    asm volatile("s_waitcnt vmcnt(0)" ::: "memory");
    __syncthreads();
  }
  float lt = lrun; lt += __shfl_xor(lt, 16); lt += __shfl_xor(lt, 32);
  const float inv = 1.0f / lt;
  bf16_t* dst = p.OM + (size_t)tq * 1024 + h * 256;
#pragma unroll
  for (int dt = 0; dt < 16; ++dt) { const f32x4 v = o[dt] * inv; *(uint2*)(dst + dt * 16 + fq * 4) = make_uint2(pack2(v[0], v[1]), pack2(v[2], v[3])); }
}
__device__ void tile_memo(const Params& p, int tile, char* lds) {
  const int rt = tile >> 3, ct = tile & 7; const int row0 = rt * 128, col0 = ct * 128;
  f32x4 acc[4][4];
  gemm_mainloop<true>(acc, p.OM, 1024, p.WtMo, 1024, 1024, row0, col0, lds);
  EPI_IDS
  const int cw = col0 + wc * 64;
#pragma unroll
  for (int m = 0; m < 4; ++m) {
    const int row = row0 + wr * 64 + m * 16 + fr; float ss = 0.f;
#pragma unroll
    for (int n = 0; n < 4; ++n) { const int c = cw + n * 16 + fq * 4; const uint2 hb = *(const uint2*)(p.H1B + (size_t)row * 1024 + c);
      const f32x4 hv = (f32x4){__uint_as_float(hb.x << 16), __uint_as_float(hb.x & 0xffff0000u), __uint_as_float(hb.y << 16), __uint_as_float(hb.y & 0xffff0000u)} + acc[m][n];
      ss += hv[0] * hv[0] + hv[1] * hv[1] + hv[2] * hv[2] + hv[3] * hv[3];
      *(uint2*)(p.H2B + (size_t)row * 1024 + c) = make_uint2(pack2(hv[0], hv[1]), pack2(hv[2], hv[3])); }
    ss += __shfl_xor(ss, 16); ss += __shfl_xor(ss, 32);
    if (fq == 0) p.ss_h2[row * 16 + (cw >> 6)] = ss;
  }
}
__device__ __forceinline__ void ce_desc(float& x, float& y) { const float hi = fmaxf(x, y), lo = fminf(x, y); x = hi; y = lo; }
__device__ __forceinline__ void sort16_desc(float (&a)[16]) {
#pragma unroll
  for (int k = 2; k <= 16; k <<= 1)
#pragma unroll
    for (int j = k >> 1; j > 0; j >>= 1)
#pragma unroll
      for (int i = 0; i < 16; ++i) { const int l = i ^ j; if (l > i) { if ((i & k) == 0) ce_desc(a[i], a[l]); else ce_desc(a[l], a[i]); } }
}
__device__ __forceinline__ void merge16_desc(float (&a)[16], const float (&b)[16]) {
#pragma unroll
  for (int i = 0; i < 16; ++i) a[i] = fmaxf(a[i], b[15 - i]);
#pragma unroll
  for (int j = 8; j > 0; j >>= 1)
#pragma unroll
    for (int i = 0; i < 16; ++i) { const int l = i ^ j; if (l > i) ce_desc(a[i], a[l]); }
}
__device__ __forceinline__ void ins16(float (&a)[16], float v) {
#pragma unroll
  for (int i = 0; i < 16; ++i) { const float hi = fmaxf(a[i], v), lo = fminf(a[i], v); a[i] = hi; v = lo; }
}
__device__ void tile_peer(const Params& p, int tile, char* lds_) {
  const int rt = tile >> 4, hs = tile & 15; const int row0 = rt * 128, col0 = hs * 128;
  f32x4 acc[4][4];
  gemm_mainloop<true>(acc, p.H2B, 1024, p.WtPq, 1024, 1024, row0, col0, lds_);
  LAS char* lds = (LAS char*)lds_;
  EPI_IDS
  { const int lr = lane >> 3, lc = (lane & 7) ^ lr; const int wbase = __builtin_amdgcn_readfirstlane(w) * 4096;
    const bf16_t* gK = p.PK + (size_t)hs * 128 * 128 + (size_t)(w * 32 + lr) * 128 + lc * 8;
#pragma unroll
    for (int i = 0; i < 4; ++i) {
      __builtin_amdgcn_global_load_lds((const GAS void*)(gK + (size_t)(i * 8) * 128), (LAS void*)(lds + 16384 + wbase + i * 1024), 16, 0, 0);
      __builtin_amdgcn_global_load_lds((const GAS void*)(gK + (size_t)(i * 8) * 128 + 64), (LAS void*)(lds + 32768 + 16384 + wbase + i * 1024), 16, 0, 0);
    } }
  typedef unsigned u32x2 __attribute__((ext_vector_type(2)));
#pragma unroll
  for (int m = 0; m < 4; ++m) { const int r = wr * 64 + m * 16 + fr; const float rs = row_rs16(p.ss_h2, row0 + r);
#pragma unroll
    for (int n = 0; n < 4; ++n) { const f32x4 v = acc[m][n] * rs; u32x2 pk; pk.x = pack2(v[0], v[1]); pk.y = pack2(v[2], v[3]);
      *(LAS u32x2*)(lds + wc * 32768 + r * 128 + (((n * 2 + (fq >> 1)) ^ (r & 7)) << 4) + (fq & 1) * 8) = pk; } }
  asm volatile("s_waitcnt vmcnt(0)" ::: "memory");
  __syncthreads();
#pragma unroll
  for (int m = 0; m < 4; ++m)
#pragma unroll
    for (int n = 0; n < 4; ++n) acc[m][n] = (f32x4){0.f, 0.f, 0.f, 0.f};
#pragma unroll
  for (int kt = 0; kt < 2; ++kt) { LAS char* cur = lds + kt * 32768;
#pragma unroll
    for (int ks = 0; ks < 2; ++ks) { bf16x8 af[4], bfr[4]; const int kc = ks * 4 + fq;
#pragma unroll
      for (int m = 0; m < 4; ++m) { const int r = wr * 64 + m * 16 + fr; af[m] = as_bf(*(const LAS u32x4*)(cur + r * 128 + ((kc ^ (r & 7)) << 4))); }
#pragma unroll
      for (int n = 0; n < 4; ++n) { const int r = wc * 64 + n * 16 + fr; bfr[n] = as_bf(*(const LAS u32x4*)(cur + 16384 + r * 128 + ((kc ^ (r & 7)) << 4))); }
#pragma unroll
      for (int m = 0; m < 4; ++m)
#pragma unroll
        for (int n = 0; n < 4; ++n) acc[m][n] = mfma16(bfr[n], af[m], acc[m][n]);
    } }
  __syncthreads();
  LAS float* L = (LAS float*)lds;
#pragma unroll
  for (int m = 0; m < 4; ++m) {
    float a[16], b[16];
#pragma unroll
    for (int n = 0; n < 4; ++n)
#pragma unroll
      for (int j = 0; j < 4; ++j) a[n * 4 + j] = __uint_as_float((__float_as_uint(acc[m][n][j]) & ~127u) | (unsigned)(wc * 64 + n * 16 + fq * 4 + j));
    sort16_desc(a);
#pragma unroll
    for (int i = 0; i < 16; ++i) b[i] = __shfl_xor(a[i], 16);
    merge16_desc(a, b);
#pragma unroll
    for (int i = 0; i < 16; ++i) b[i] = __shfl_xor(a[i], 32);
    merge16_desc(a, b);
    const int r = wr * 64 + m * 16 + fr;
    f32x4 o; o[0] = fq == 0 ? a[0] : fq == 1 ? a[4] : fq == 2 ? a[8] : a[12]; o[1] = fq == 0 ? a[1] : fq == 1 ? a[5] : fq == 2 ? a[9] : a[13];
    o[2] = fq == 0 ? a[2] : fq == 1 ? a[6] : fq == 2 ? a[10] : a[14]; o[3] = fq == 0 ? a[3] : fq == 1 ? a[7] : fq == 2 ? a[11] : a[15];
    *(LAS f32x4*)(L + (r * 2 + wc) * 16 + fq * 4) = o;
  }
  __syncthreads();
#pragma unroll
  for (int mi = 0; mi < 2; ++mi) { const int m = wc * 2 + mi; const int r = wr * 64 + m * 16 + fr;
    float a[16], b[16];
#pragma unroll
    for (int q = 0; q < 4; ++q) { const f32x4 va = *(const LAS f32x4*)(L + (r * 2 + 0) * 16 + q * 4), vb = *(const LAS f32x4*)(L + (r * 2 + 1) * 16 + q * 4);
      a[q * 4] = va[0]; a[q * 4 + 1] = va[1]; a[q * 4 + 2] = va[2]; a[q * 4 + 3] = va[3]; b[q * 4] = vb[0]; b[q * 4 + 1] = vb[1]; b[q * 4 + 2] = vb[2]; b[q * 4 + 3] = vb[3]; }
    merge16_desc(a, b);
    u32x4 o; o.x = __float_as_uint(fq == 0 ? a[0] : fq == 1 ? a[4] : fq == 2 ? a[8] : a[12]); o.y = __float_as_uint(fq == 0 ? a[1] : fq == 1 ? a[5] : fq == 2 ? a[9] : a[13]);
    o.z = __float_as_uint(fq == 0 ? a[2] : fq == 1 ? a[6] : fq == 2 ? a[10] : a[14]); o.w = __float_as_uint(fq == 0 ? a[3] : fq == 1 ? a[7] : fq == 2 ? a[11] : a[15]);
    *(u32x4*)(p.TOPS + ((size_t)(row0 + r) * 16 + hs) * 16 + fq * 4) = o;
  }
}
__device__ void peer_gather_item(const Params& p, int item, char* lds_) {
  LAS char* lds = (LAS char*)lds_;
  const int tid = threadIdx.x, lane = tid & 63, w = tid >> 6;
  LAS unsigned* LA = (LAS unsigned*)lds;
  LAS int* LE = (LAS int*)(lds + 256 * 33 * 4);
  LAS float* LG = (LAS float*)(lds + 256 * 33 * 4 + 32 * 128 * 4);
  __syncthreads();
  {
    const int tl_ = tid >> 3, h = tid & 7; const int t = item * 32 + tl_;
    const uint4* src = (const uint4*)(p.TOPS + ((size_t)t * 16 + h * 2) * 16);
    float a[16], bq[16];
#pragma unroll
    for (int i = 0; i < 4; ++i) { const uint4 v = src[i]; a[4 * i] = __uint_as_float(v.x); a[4 * i + 1] = __uint_as_float(v.y); a[4 * i + 2] = __uint_as_float(v.z); a[4 * i + 3] = __uint_as_float(v.w); }
#pragma unroll
    for (int i = 0; i < 4; ++i) { const uint4 v = src[4 + i]; bq[4 * i] = __uint_as_float(v.x); bq[4 * i + 1] = __uint_as_float(v.y); bq[4 * i + 2] = __uint_as_float(v.z); bq[4 * i + 3] = __uint_as_float(v.w); }
#pragma unroll
    for (int i = 0; i < 16; ++i) { LA[tid * 33 + i] = __float_as_uint(a[i]); LA[tid * 33 + 16 + i] = __float_as_uint(bq[i]); }
    float c[16];
#pragma unroll
    for (int i = 0; i < 16; ++i) c[i] = -__builtin_inff();
#pragma unroll
    for (int i = 0; i < 16; ++i)
#pragma unroll
      for (int j = 0; j < 16; ++j) if ((i + 1) * (j + 1) <= 16) { const float s = a[i] + bq[j]; ins16(c, __uint_as_float((__float_as_uint(s) & ~255u) | (unsigned)(i * 16 + j))); }
    const float mx = c[0]; float e[16]; float sum = 0.f;
#pragma unroll
    for (int i = 0; i < 16; ++i) { e[i] = __expf(c[i] - mx); sum += e[i]; }
    const float inv = 1.0f / sum;
#pragma unroll
    for (int i = 0; i < 16; ++i) { const unsigned pos = __float_as_uint(c[i]) & 255u; const unsigned ia = LA[tid * 33 + (pos >> 4)] & 127u, ib = LA[tid * 33 + 16 + (pos & 15u)] & 127u;
      LE[tl_ * 128 + h * 16 + i] = (int)(ia * 128u + ib); LG[tl_ * 128 + h * 16 + i] = e[i] * inv; }
  }
  __syncthreads();
  LAS char* HQ = (LAS char*)LA;
  const int fr = lane & 15, fq = lane >> 4;
  for (int ti = 0; ti < 8; ++ti) {
    const int tl_ = w * 8 + ti; const int t = item * 32 + tl_;
    const float rs = row_rs16(p.ss_h2, t) * 16.0f;
    { const uint4 ha = *(const uint4*)(p.H2B + (size_t)t * 1024 + lane * 16), hb = *(const uint4*)(p.H2B + (size_t)t * 1024 + lane * 16 + 8);
      const unsigned hw[8] = {ha.x, ha.y, ha.z, ha.w, hb.x, hb.y, hb.z, hb.w}; u32x4 q;
#pragma unroll
      for (int i = 0; i < 4; ++i) { const float4 g = *(const float4*)(p.norm_peer_g + lane * 16 + 4 * i); int wd = 0;
        wd = __builtin_amdgcn_cvt_pk_fp8_f32(__uint_as_float(hw[2 * i] << 16) * rs * g.x, __uint_as_float(hw[2 * i] & 0xffff0000u) * rs * g.y, wd, false);
        wd = __builtin_amdgcn_cvt_pk_fp8_f32(__uint_as_float(hw[2 * i + 1] << 16) * rs * g.z, __uint_as_float(hw[2 * i + 1] & 0xffff0000u) * rs * g.w, wd, true); q[i] = (unsigned)wd; }
      *(LAS u32x4*)(HQ + tl_ * 1024 + lane * 16) = q; }
    f32x2 oa[8];
#pragma unroll
    for (int i = 0; i < 8; ++i) oa[i] = (f32x2){0.f, 0.f};
    for (int bt = 0; bt < 8; ++bt) {
      const LAS int* LEb = LE + tl_ * 128 + bt * 16; const LAS float* LGb = LG + tl_ * 128 + bt * 16;
      const int er = LEb[fr];
      u32x4 uqa[8], uqb[8]; uint2 vqa[8], vqb[8];
      const unsigned char* ub = p.PU8 + (size_t)er * 1024 + fq * 16;
#pragma unroll
      for (int ks = 0; ks < 8; ++ks) uqa[ks] = *(const u32x4*)(ub + ks * 64);
#pragma unroll
      for (int x = 0; x < 8; ++x) { const int ex = __builtin_amdgcn_readlane(er, x); vqa[x] = *(const uint2*)(p.PV8 + (size_t)ex * 512 + lane * 8); }
#pragma unroll
      for (int ks = 0; ks < 8; ++ks) uqb[ks] = *(const u32x4*)(ub + 512 + ks * 64);
      int e4[4]; float g4[4], su4[4], sv4[4];
#pragma unroll
      for (int j = 0; j < 4; ++j) { e4[j] = LEb[fq * 4 + j]; g4[j] = LGb[fq * 4 + j]; su4[j] = p.su[e4[j]]; sv4[j] = p.sv[e4[j]]; }
      f32x4 acc = (f32x4){0.f, 0.f, 0.f, 0.f};
#pragma unroll
      for (int ks = 0; ks < 8; ++ks) { const u32x4 hq = *(const LAS u32x4*)(HQ + tl_ * 1024 + ks * 64 + fq * 16);
        acc = __builtin_amdgcn_mfma_f32_16x16x32_fp8_fp8((long)(((unsigned long long)uqa[ks].y << 32) | uqa[ks].x), (long)(((unsigned long long)hq.y << 32) | hq.x), acc, 0, 0, 0);
        acc = __builtin_amdgcn_mfma_f32_16x16x32_fp8_fp8((long)(((unsigned long long)uqa[ks].w << 32) | uqa[ks].z), (long)(((unsigned long long)hq.w << 32) | hq.z), acc, 0, 0, 0); }
#pragma unroll
      for (int x = 0; x < 8; ++x) { const int ex = __builtin_amdgcn_readlane(er, 8 + x); vqb[x] = *(const uint2*)(p.PV8 + (size_t)ex * 512 + lane * 8); }
#pragma unroll
      for (int ks = 0; ks < 8; ++ks) { const u32x4 hq = *(const LAS u32x4*)(HQ + tl_ * 1024 + 512 + ks * 64 + fq * 16);
        acc = __builtin_amdgcn_mfma_f32_16x16x32_fp8_fp8((long)(((unsigned long long)uqb[ks].y << 32) | uqb[ks].x), (long)(((unsigned long long)hq.y << 32) | hq.x), acc, 0, 0, 0);
        acc = __builtin_amdgcn_mfma_f32_16x16x32_fp8_fp8((long)(((unsigned long long)uqb[ks].w << 32) | uqb[ks].z), (long)(((unsigned long long)hq.w << 32) | hq.z), acc, 0, 0, 0); }
      float wg[4];
#pragma unroll
      for (int j = 0; j < 4; ++j) wg[j] = g4[j] * gelu_f(acc[j] * su4[j] * 0.0625f) * sv4[j];
#define PEER_V(VQ, X0) { _Pragma("unroll") for (int x = 0; x < 8; ++x) { const float wgt = __int_as_float(__builtin_amdgcn_readlane(__float_as_int(wg[((X0) + x) & 3]), (((X0) + x) >> 2) * 16)); \
        oa[0] += __builtin_amdgcn_cvt_scalef32_pk_f32_fp4(VQ[x].x, 1.0f, 0) * wgt; oa[1] += __builtin_amdgcn_cvt_scalef32_pk_f32_fp4(VQ[x].x, 1.0f, 1) * wgt; \
        oa[2] += __builtin_amdgcn_cvt_scalef32_pk_f32_fp4(VQ[x].x, 1.0f, 2) * wgt; oa[3] += __builtin_amdgcn_cvt_scalef32_pk_f32_fp4(VQ[x].x, 1.0f, 3) * wgt; \
        oa[4] += __builtin_amdgcn_cvt_scalef32_pk_f32_fp4(VQ[x].y, 1.0f, 0) * wgt; oa[5] += __builtin_amdgcn_cvt_scalef32_pk_f32_fp4(VQ[x].y, 1.0f, 1) * wgt; \
        oa[6] += __builtin_amdgcn_cvt_scalef32_pk_f32_fp4(VQ[x].y, 1.0f, 2) * wgt; oa[7] += __builtin_amdgcn_cvt_scalef32_pk_f32_fp4(VQ[x].y, 1.0f, 3) * wgt; } }
      PEER_V(vqa, 0)
      PEER_V(vqb, 8)
    }
    { const uint4 ha = *(const uint4*)(p.H2B + (size_t)t * 1024 + lane * 16), hb = *(const uint4*)(p.H2B + (size_t)t * 1024 + lane * 16 + 8);
      const unsigned hw[8] = {ha.x, ha.y, ha.z, ha.w, hb.x, hb.y, hb.z, hb.w};
      float* op = p.out + (size_t)t * 1024 + lane * 16;
#pragma unroll
      for (int i = 0; i < 4; ++i) { const f32x2 a = oa[2 * i], b = oa[2 * i + 1];
        *(float4*)(op + 4 * i) = make_float4(__uint_as_float(hw[2 * i] << 16) + a.x, __uint_as_float(hw[2 * i] & 0xffff0000u) + a.y, __uint_as_float(hw[2 * i + 1] << 16) + b.x, __uint_as_float(hw[2 * i + 1] & 0xffff0000u) + b.y); } }
  }
}

template <int PH>
__device__ __forceinline__ void run_phase(const Params& p, char* lds, int bid, int nb) {
  if (PH == 0) {
    const int nt_in = 16 * 32, nt_glu = 8 * 8, nt_out = 16 * 16, nt_m = 16 * 16, nt_pq = 16 * 32;
    const int total = nt_in + nt_glu + nt_out + 4 * nt_m + nt_pq;
    for (int t = bid; t < total; t += nb) {
      int i = t; float* tl = (float*)lds;
      if (i < nt_in) { transpose_tile(p.w_in, p.WtIn, 1024, 2048, i, p.norm_mix_g, p.norm_mix_g, 1024, tl); continue; } i -= nt_in;
      if (i < nt_glu) { transpose_tile(p.w_glu, p.WtGlu, 512, 512, i, nullptr, nullptr, 0, tl); continue; } i -= nt_glu;
      if (i < nt_out) { transpose_tile(p.w_out, p.WtOut, 1024, 1024, i, p.att_out_g, p.ssm_out_g, 512, tl); continue; } i -= nt_out;
      if (i < nt_m) { transpose_tile(p.w_mem_q, p.WtMq, 1024, 1024, i, p.norm_mem_g, p.norm_mem_g, 1024, tl); continue; } i -= nt_m;
      if (i < nt_m) { transpose_tile(p.w_mem_k, p.WtMk, 1024, 1024, i, p.norm_memkv_g, p.norm_memkv_g, 1024, tl); continue; } i -= nt_m;
      if (i < nt_m) { transpose_tile(p.w_mem_v, p.WtMv, 1024, 1024, i, p.norm_memkv_g, p.norm_memkv_g, 1024, tl); continue; } i -= nt_m;
      if (i < nt_m) { transpose_tile(p.w_mem_o, p.WtMo, 1024, 1024, i, nullptr, nullptr, 0, tl); continue; } i -= nt_m;
      transpose_tile(p.w_peer_q, p.WtPq, 1024, 2048, i, p.norm_peer_g, p.norm_peer_g, 1024, tl);
    }
    convert_flat(p.peer_keys, p.PK, (size_t)16 * 128 * 128 / 8, bid, nb);
    rows_fp8(p.peer_u, p.PU8, p.su, 16384, bid, nb);
    rows_fp4(p.peer_v, p.PV8, p.sv, 16384, bid, nb);
    rows_bf16_rs(p.x, p.XB, p.rs_x, T_TOK, bid, nb);
    rows_bf16_rs(p.mem, p.MEMB, p.rs_mem, 512, bid, nb);
    for (int i = bid * NTHREADS + threadIdx.x; i < 2048; i += nb * NTHREADS) ssm_stage1(p, i);
  } else if (PH == 1) {
    for (int t = bid; t < 2048; t += nb) { if (((t & 15) >> 2) == 2) tile_win_v(p, t, lds); else tile_win(p, t, lds); }
    ssm_stage2a(p, bid, nb);
  } else if (PH == 2) {
    for (int t = nb - 1 - bid; t < 64; t += nb) tile_memkv(p, t, lds);
    for (int t = bid; t < 2048; t += nb) chunk_attn_item(p, t, lds);
    for (int t = bid; t < 2048; t += nb) ssm_item<false>(p, t, lds);
    ssm_stage2b(p, bid, nb);
  } else if (PH == 3) {
    memk_fix(p, bid, nb);
    for (int t = bid; t < 2048; t += nb) ssm_item<true>(p, t, lds);
  } else if (PH == 4) {
    for (int t = bid; t < 512; t += nb) tile_glu(p, t, lds);
  } else if (PH == 5) {
    for (int t = bid; t < 1024; t += nb) tile_wout(p, t, lds);
  } else if (PH == 6) {
    for (int t = bid; t < 1024; t += nb) tile_memq(p, t, lds);
  } else if (PH == 7) {
    for (int t = bid; t < 1024; t += nb) mem_attn_item(p, t, lds);
  } else if (PH == 8) {
    for (int t = bid; t < 1024; t += nb) tile_memo(p, t, lds);
  } else if (PH == 9) {
    for (int t = bid; t < 2048; t += nb) tile_peer(p, t, lds);
  } else if (PH == 11) {
    for (int t = bid; t < 512; t += nb) peer_gather_item(p, t, lds);
  }
}

#if !MEGA
template <int PH>
__global__ void __launch_bounds__(NTHREADS, 2) phase_kernel(Params p) {
  extern __shared__ __attribute__((aligned(16))) char lds[];
  run_phase<PH>(p, lds, blockIdx.x, gridDim.x);
}

#endif
#ifndef REPEAT_PH
#define REPEAT_PH -1
#endif
#define RUNPH(k) do { run_phase<k>(p, lds, bid, nb); if (REPEAT_PH == k) { xcd_barrier(xb); run_phase<k>(p, lds, bid, nb); } } while (0)
__global__ void __launch_bounds__(NTHREADS, 2) mega_kernel(Params p) {
  extern __shared__ __attribute__((aligned(16))) char lds[];
  const int bid = blockIdx.x, nb = gridDim.x;
  volatile LAS unsigned* stw = (volatile LAS unsigned*)((LAS char*)lds + LDS_WORK);
  if (threadIdx.x == 0) { stw[0] = 0u; stw[1] = 0u; stw[2] = 0u; stw[3] = 0u; }
  __syncthreads();
  XcdBarrier xb = xcd_barrier_post(p.bar, stw);
  RUNPH(0); xcd_barrier(xb);
  RUNPH(1); xcd_barrier(xb);
  RUNPH(2); xcd_barrier(xb);
  RUNPH(3); xcd_barrier(xb);
  RUNPH(4); xcd_barrier(xb);
  RUNPH(5); xcd_barrier(xb);
  RUNPH(6); xcd_barrier(xb);
  RUNPH(7); xcd_barrier(xb);
  RUNPH(8); xcd_barrier(xb);
  RUNPH(9); xcd_barrier(xb);
  RUNPH(11);
}

#if !MEGA
template <int PH> static void launch_phase(const Params& p, int grid, hipStream_t s) {
  hipFuncSetAttribute((const void*)phase_kernel<PH>, hipFuncAttributeMaxDynamicSharedMemorySize, LDS_BYTES);
  phase_kernel<PH><<<grid, NTHREADS, LDS_BYTES, s>>>(p);
}
#endif

extern "C" void kernel_launch(void* const* d_in, const int* in_sizes, int n_in, void* d_out, int out_size, void* d_ws, size_t ws_size, hipStream_t stream) {
  Params p{};
  const float** f = (const float**)&p;
  for (int i = 0; i < 33; ++i) f[i] = (const float*)d_in[i];
  p.out = (float*)d_out;
  char* ws = (char*)d_ws; size_t off = 0;
  auto take = [&](size_t bytes) { char* r = ws + off; off += (bytes + 255) & ~(size_t)255; return r; };
  const size_t MB = 1u << 20;
  p.bar = (unsigned*)take(16384);
  p.WtIn = (bf16_t*)take(4 * MB); p.WtGlu = (bf16_t*)take(MB / 2); p.WtOut = (bf16_t*)take(2 * MB);
  p.WtMq = (bf16_t*)take(2 * MB); p.WtMk = (bf16_t*)take(2 * MB); p.WtMv = (bf16_t*)take(2 * MB); p.WtMo = (bf16_t*)take(2 * MB); p.WtPq = (bf16_t*)take(4 * MB);
  p.PK = (bf16_t*)take(MB / 2); p.PU8 = (unsigned char*)take(16 * MB); p.PV8 = (unsigned char*)take(8 * MB); p.su = (float*)take(16384 * 4); p.sv = (float*)take(16384 * 4);
  char* RA = take(64 * MB); char* RB = take(64 * MB);
  p.XB = (bf16_t*)RA; p.ATT = (bf16_t*)RA; p.YG = (bf16_t*)(RA + 16 * MB); p.QM = (bf16_t*)RA; p.H2B = (bf16_t*)RA;
  p.SSMO = (bf16_t*)(RA + 32 * MB); p.OM = (bf16_t*)(RA + 32 * MB);
  p.Qb = (bf16_t*)RB; p.Kb = (bf16_t*)(RB + 16 * MB); p.VT = (bf16_t*)(RB + 32 * MB); p.Ub = (bf16_t*)(RB + 48 * MB); p.H1B = (bf16_t*)RB; p.QP = (bf16_t*)RB;
  p.TOPS = (unsigned*)take(16 * MB);
  p.MEMB = (bf16_t*)take(MB); p.KMB = (bf16_t*)take(MB); p.VMT = (bf16_t*)take(MB); p.KMraw = (float*)take(2 * MB);
  p.WE16 = (bf16_t*)take(2 * MB); p.WY = (bf16_t*)take(6 * MB);
  p.rs_x = (float*)take(T_TOK * 4); p.rs_mem = (float*)take(512 * 4); p.ss_att = (float*)take(T_TOK * 8 * 4); p.ss_ssm = (float*)take(T_TOK * 8 * 4);
  p.ss_h1 = (float*)take(T_TOK * 16 * 4); p.ss_qm = (float*)take(T_TOK * 16 * 4); p.ss_km = (float*)take(512 * 16 * 4); p.ss_h2 = (float*)take(T_TOK * 16 * 4);
  p.ESEG = (float*)take(2 * 32 * 32 * 128 * 4);
  p.BBR = (float*)take(2048 * 16 * 4); p.BBI = (float*)take(2048 * 16 * 4); p.PWR = (float*)take(32 * 17 * 64 * 4); p.PWI = (float*)take(32 * 17 * 64 * 4); p.KJ = (float*)take(32 * 16 * 256 * 4); p.APW = (float*)take(5 * 4096 * 4);
  if (off > ws_size) { fprintf(stderr, "workspace too small: need %zu have %zu\n", off, ws_size); return; }
#if MEGA
  hipMemsetAsync(p.bar, 0, 16384, stream);
  static int grid_blocks = 0;
  if (!grid_blocks) {
    int dev = 0, cus = 0, per_cu = 0; hipGetDevice(&dev); hipDeviceGetAttribute(&cus, hipDeviceAttributeMultiprocessorCount, dev);
    hipFuncSetAttribute((const void*)mega_kernel, hipFuncAttributeMaxDynamicSharedMemorySize, LDS_BYTES);
    hipOccupancyMaxActiveBlocksPerMultiprocessor(&per_cu, mega_kernel, NTHREADS, LDS_BYTES);
    if (per_cu > 2) per_cu = 2; if (per_cu < 1) per_cu = 1;
    grid_blocks = cus * per_cu;
  }
  void* args[] = {&p};
  hipError_t e = hipLaunchCooperativeKernel((void*)mega_kernel, dim3(grid_blocks), dim3(NTHREADS), args, LDS_BYTES, stream);
  if (e != hipSuccess) fprintf(stderr, "cooperative launch failed: %s (grid %d)\n", hipGetErrorString(e), grid_blocks);
#else
  const int G = 1024;
  launch_phase<0>(p, G, stream); launch_phase<1>(p, G, stream); launch_phase<2>(p, G, stream); launch_phase<3>(p, G, stream);
  launch_phase<4>(p, G, stream); launch_phase<5>(p, G, stream); launch_phase<6>(p, G, stream); launch_phase<7>(p, G, stream);
  launch_phase<8>(p, G, stream); launch_phase<9>(p, G, stream); launch_phase<11>(p, G, stream);
#endif
}
```

```cpp
#include <hip/hip_runtime.h>
#include <hip/hip_cooperative_groups.h>
#include <cstdio>
#include <cstdint>
namespace cg = cooperative_groups;

#ifndef MEGA
#define MEGA 1
#endif

typedef unsigned short bf16_t;
typedef short bf16x8 __attribute__((ext_vector_type(8)));
typedef float f32x4 __attribute__((ext_vector_type(4)));
typedef unsigned u32x4 __attribute__((ext_vector_type(4)));
#define LAS __attribute__((address_space(3)))
__device__ __forceinline__ bf16x8 as_bf(u32x4 v) { return __builtin_bit_cast(bf16x8, v); }

#define T_TOK 16384
#define SEQL 8192
#define NTHREADS 256
#define LDS_WORK 66560
#define LDS_BYTES (LDS_WORK + 16)
#define EPSF 1e-6f

__device__ __forceinline__ unsigned short f2bf(float f) { unsigned u = __float_as_uint(f); u += 0x7fffu + ((u >> 16) & 1u); return (unsigned short)(u >> 16); }
__device__ __forceinline__ float bf2f(unsigned short b) { return __uint_as_float(((unsigned)b) << 16); }
__device__ __forceinline__ unsigned pack2(float lo, float hi) { return (unsigned)f2bf(lo) | ((unsigned)f2bf(hi) << 16); }
__device__ __forceinline__ float gelu_f(float v) {
  const float av = fabsf(v), t = __builtin_amdgcn_rcpf(av * 0.2316418882f + 1.0f);
  float q = t * 0.5307027145f + (-0.7265760135f); q = q * t + 0.7107068705f; q = q * t + (-0.142248368f); q = q * t + 0.127414796f; q = q * t;
  const float e = __builtin_amdgcn_exp2f((v * v) * (-0.72134752044f)); const float m = v * (q * e);
  return v < 0.f ? m : v - m; }
typedef float f32x2 __attribute__((ext_vector_type(2)));
__device__ __forceinline__ f32x4 mfma16(bf16x8 a, bf16x8 b, f32x4 c) { return __builtin_amdgcn_mfma_f32_16x16x32_bf16(a, b, c, 0, 0, 0); }


#define XB_TMO      128
#define XB_XCNT(j)  (256  + 64 * (j))
#define XB_XSUB(j)  (1280 + 64 * (j))
#define XB_XGEN(j)  (2304 + 64 * (j))
#define XB_TOP      3328
#define XB_TOPGEN   3392
#define XCD_BAR_WORDS 3456
#define XB_SPIN_CAP (1u << 18)
__device__ __forceinline__ unsigned xb_ld(unsigned* p)              { return __hip_atomic_load(p, __ATOMIC_RELAXED, __HIP_MEMORY_SCOPE_AGENT); }
__device__ __forceinline__ unsigned xb_add(unsigned* p, unsigned v) { return __hip_atomic_fetch_add(p, v, __ATOMIC_RELAXED, __HIP_MEMORY_SCOPE_AGENT); }
__device__ __forceinline__ unsigned xb_xcc_id() { return (unsigned)__builtin_amdgcn_s_getreg((3 << 11) | 20) & 0xFu; }
#define XB_SPIN(cond, bar) do { unsigned _sp = 0; while (cond) { __builtin_amdgcn_s_sleep(1); \
    if ((++_sp & 255u) == 0u) { if (xb_ld(&(bar)[XB_TMO])) break; if (_sp > XB_SPIN_CAP) { atomicAdd(&(bar)[XB_TMO], 1u); break; } } } } while (0)
struct XcdBarrier { unsigned* bar; unsigned x; volatile LAS unsigned* st; };
__device__ __forceinline__ XcdBarrier xcd_barrier_post(unsigned* bar, volatile LAS unsigned* st) {
  XcdBarrier b; b.bar = bar; b.x = xb_xcc_id(); b.st = st;
  if (threadIdx.x == 0) (void)xb_add(&bar[XB_XCNT(b.x)], 1u);
  return b;
}
__device__ __forceinline__ void xcd_barrier_complete(unsigned* bar, unsigned x, unsigned& nloc, unsigned& nx) {
  const unsigned G = gridDim.x * gridDim.y * gridDim.z;
  unsigned sum, cnt, mine, sp = 0u;
  for (;;) {
    sum = 0u; cnt = 0u; mine = 0u;
#pragma unroll
    for (unsigned j = 0; j < 16; ++j) { const unsigned c = xb_ld(&bar[XB_XCNT(j)]); sum += c; cnt += (c > 0u) ? 1u : 0u; mine = (j == x) ? c : mine; }
    if (sum == G) break;
    __builtin_amdgcn_s_sleep(1);
    if ((++sp & 255u) == 0u) { if (xb_ld(&bar[XB_TMO])) break; if (sp > XB_SPIN_CAP) { atomicAdd(&bar[XB_TMO], 1u); break; } }
  }
  nloc = mine > 0u ? mine : 1u; nx = cnt > 0u ? cnt : 1u;
}
__device__ __forceinline__ void xcd_barrier(const XcdBarrier& b) {
  asm volatile("s_waitcnt vmcnt(0)" ::: "memory");
  __syncthreads();
  if (threadIdx.x == 0) {
    unsigned* bar = b.bar;
    __builtin_amdgcn_s_waitcnt(0);
    unsigned nloc = b.st[0], nx = b.st[1];
    if (nloc == 0u) { xcd_barrier_complete(bar, b.x, nloc, nx); b.st[0] = nloc; b.st[1] = nx; }
    const unsigned old = xb_add(&bar[XB_XSUB(b.x)], 1u);
    const unsigned gen = old / nloc;
    if (old + 1u == (gen + 1u) * nloc) {
      __builtin_amdgcn_fence(__ATOMIC_RELEASE, "agent");
      asm volatile("s_waitcnt vmcnt(0)" ::: "memory");
      const unsigned og = xb_add(&bar[XB_TOP], 1u);
      const unsigned tg = og / nx;
      if (og + 1u == (tg + 1u) * nx) xb_add(&bar[XB_TOPGEN], 1u);
      else XB_SPIN(xb_ld(&bar[XB_TOPGEN]) == tg, bar);
      __builtin_amdgcn_fence(__ATOMIC_ACQUIRE, "agent");
      xb_add(&bar[XB_XGEN(b.x)], 1u);
      asm volatile("s_waitcnt vmcnt(0)" ::: "memory");
    } else {
      XB_SPIN(xb_ld(&bar[XB_XGEN(b.x)]) == gen, bar);
      __builtin_amdgcn_fence(__ATOMIC_ACQUIRE, "agent");
      asm volatile("s_waitcnt vmcnt(0)" ::: "memory");
    }
  }
  __syncthreads();
}

struct Params {
  const float *x, *mem, *norm_mix_g, *w_in, *att_q_g, *att_k_g, *rel_bias;
  const float *lam_re, *lam_im, *log_step, *b_re, *b_im, *c_re, *c_im, *d_skip, *w_glu, *b_glu;
  const float *att_out_g, *ssm_out_g, *w_out, *norm_mem_g, *norm_memkv_g, *w_mem_q, *w_mem_k, *w_mem_v;
  const float *mem_q_g, *mem_k_g, *w_mem_o, *norm_peer_g, *w_peer_q, *peer_keys, *peer_u, *peer_v;
  float* out;
  unsigned* bar;
  bf16_t *WtIn, *WtGlu, *WtOut, *WtMq, *WtMk, *WtMv, *WtMo, *WtPq, *PK, *PU, *PV;
  bf16_t *XB, *MEMB, *Qb, *Kb, *VT, *Ub, *ATT, *YG, *SSMO, *H1B, *QM, *OM, *H2B, *QP;
  bf16_t *KMB, *VMT, *WE16, *WY;
  float *rs_x, *rs_mem, *ss_att, *ss_ssm, *ss_h1, *ss_qm, *ss_km, *ss_h2, *KMraw, *ESEG;
  float *BBR, *BBI, *PWR, *PWI, *KJ, *APW;
  unsigned* TOPS;
  unsigned char *PU8, *PV8; float *su, *sv;
};

#define GAS __attribute__((address_space(1)))
template <bool ZERO = true, bool SWAP = false>
__device__ __forceinline__ void gemm_mainloop(f32x4 (&acc)[4][4], const bf16_t* __restrict__ A, int lda, const bf16_t* __restrict__ Bt, int ldb, int K,
                                              int row0, int col0, char* lds_) {
  LAS char* lds = (LAS char*)lds_;
  const int tid = threadIdx.x, lane = tid & 63, w = tid >> 6, wr = w >> 1, wc = w & 1, fr = lane & 15, fq = lane >> 4;
  if (ZERO) {
#pragma unroll
    for (int m = 0; m < 4; ++m)
#pragma unroll
      for (int n = 0; n < 4; ++n) acc[m][n] = (f32x4){0.f, 0.f, 0.f, 0.f};
  }
  const int lr = lane >> 3, lc = (lane & 7) ^ lr;
  const bf16_t* gA = A + (size_t)(row0 + w * 32 + lr) * lda + lc * 8;
  const bf16_t* gB = Bt + (size_t)(col0 + w * 32 + lr) * ldb + lc * 8;
  const int wbase = __builtin_amdgcn_readfirstlane(w) * 4096;
  const int nk = K >> 6;
  __syncthreads();
#pragma unroll
  for (int i = 0; i < 4; ++i) {
    __builtin_amdgcn_global_load_lds((const GAS void*)(gA + (size_t)(i * 8) * lda), (LAS void*)(lds + wbase + i * 1024), 16, 0, 0);
    __builtin_amdgcn_global_load_lds((const GAS void*)(gB + (size_t)(i * 8) * ldb), (LAS void*)(lds + 16384 + wbase + i * 1024), 16, 0, 0);
  }
  asm volatile("s_waitcnt vmcnt(0)" ::: "memory");
  __syncthreads();
  for (int kt = 0; kt < nk; ++kt) {
    LAS char* cur = lds + (kt & 1) * 32768; LAS char* nxt = lds + ((kt + 1) & 1) * 32768;
    if (kt + 1 < nk) {
      const int k1 = (kt + 1) << 6;
#pragma unroll
      for (int i = 0; i < 4; ++i) {
        __builtin_amdgcn_global_load_lds((const GAS void*)(gA + (size_t)(i * 8) * lda + k1), (LAS void*)(nxt + wbase + i * 1024), 16, 0, 0);
        __builtin_amdgcn_global_load_lds((const GAS void*)(gB + (size_t)(i * 8) * ldb + k1), (LAS void*)(nxt + 16384 + wbase + i * 1024), 16, 0, 0);
      }
    }
#pragma unroll
    for (int ks = 0; ks < 2; ++ks) {
      bf16x8 af[4], bfr[4];
      const int kc = ks * 4 + fq;
#pragma unroll
      for (int m = 0; m < 4; ++m) { const int r = wr * 64 + m * 16 + fr; af[m] = as_bf(*(const LAS u32x4*)(cur + r * 128 + ((kc ^ (r & 7)) << 4))); }
#pragma unroll
      for (int n = 0; n < 4; ++n) { const int r = wc * 64 + n * 16 + fr; bfr[n] = as_bf(*(const LAS u32x4*)(cur + 16384 + r * 128 + ((kc ^ (r & 7)) << 4))); }
#pragma unroll
      for (int m = 0; m < 4; ++m)
#pragma unroll
        for (int n = 0; n < 4; ++n) acc[m][n] = SWAP ? mfma16(af[m], bfr[n], acc[m][n]) : mfma16(bfr[n], af[m], acc[m][n]);
    }
    asm volatile("s_waitcnt vmcnt(0)" ::: "memory");
    __syncthreads();
  }
}

__device__ void transpose_tile(const float* __restrict__ src, bf16_t* __restrict__ dst, int K, int N, int tile, const float* g0, const float* g1, int split, float* tl  ) {
  const int ntn = N >> 6; const int tk = tile / ntn, tn = tile % ntn; const int k0 = tk << 6, n0 = tn << 6; const int tid = threadIdx.x;
  __syncthreads();
#pragma unroll 4
  for (int i = 0; i < 16; ++i) { const int kk = i * 4 + (tid >> 6), nn = tid & 63; const int k = k0 + kk;
    float g = 1.f; if (g0) g = (k < split) ? g0[k] : g1[k - split];
    tl[kk * 65 + nn] = src[(size_t)k * N + n0 + nn] * g; }
  __syncthreads();
  const int n = tid >> 2, kq = (tid & 3) * 16;
  unsigned o[8];
#pragma unroll
  for (int j = 0; j < 8; ++j) o[j] = pack2(tl[(kq + 2 * j) * 65 + n], tl[(kq + 2 * j + 1) * 65 + n]);
  uint4* d = (uint4*)(dst + (size_t)(n0 + n) * K + k0 + kq);
  d[0] = make_uint4(o[0], o[1], o[2], o[3]); d[1] = make_uint4(o[4], o[5], o[6], o[7]);
}

__device__ void convert_flat(const float* __restrict__ src, bf16_t* __restrict__ dst, size_t n8  , int bid, int nb) {
  for (size_t i = (size_t)bid * NTHREADS + threadIdx.x; i < n8; i += (size_t)nb * NTHREADS) {
    const float4 a = ((const float4*)src)[2 * i], b = ((const float4*)src)[2 * i + 1];
    ((uint4*)dst)[i] = make_uint4(pack2(a.x, a.y), pack2(a.z, a.w), pack2(b.x, b.y), pack2(b.z, b.w));
  }
}
__device__ void rows_bf16_rs(const float* __restrict__ src, bf16_t* __restrict__ dst, float* __restrict__ rs, int nrows, int bid, int nb) {
  const int lane = threadIdx.x & 63, w = threadIdx.x >> 6;
  for (int row = bid * 4 + w; row < nrows; row += nb * 4) {
    const float4* s = (const float4*)(src + (size_t)row * 1024);
    float ss = 0.f; uint2* d = (uint2*)(dst + (size_t)row * 1024);
#pragma unroll
    for (int i = 0; i < 4; ++i) { const float4 v = s[i * 64 + lane]; ss += v.x * v.x + v.y * v.y + v.z * v.z + v.w * v.w; d[i * 64 + lane] = make_uint2(pack2(v.x, v.y), pack2(v.z, v.w)); }
#pragma unroll
    for (int o = 32; o > 0; o >>= 1) ss += __shfl_xor(ss, o);
    if (lane == 0) rs[row] = rsqrtf(ss * (1.0f / 1024.0f) + EPSF);
  }
}

__device__ void rows_fp8(const float* __restrict__ src, unsigned char* __restrict__ dst, float* __restrict__ sc, int nrows, int bid, int nb) {
  const int lane = threadIdx.x & 63, w = threadIdx.x >> 6;
  for (int row = bid * 4 + w; row < nrows; row += nb * 4) {
    const float4* s = (const float4*)(src + (size_t)row * 1024);
    float4 v[4]; float am = 0.f;
#pragma unroll
    for (int i = 0; i < 4; ++i) { v[i] = s[i * 64 + lane]; am = fmaxf(am, fmaxf(fmaxf(fabsf(v[i].x), fabsf(v[i].y)), fmaxf(fabsf(v[i].z), fabsf(v[i].w)))); }
#pragma unroll
    for (int o = 32; o > 0; o >>= 1) am = fmaxf(am, __shfl_xor(am, o));
    const float q = (am > 0.f) ? 224.0f / am : 1.0f;
    unsigned* d = (unsigned*)(dst + (size_t)row * 1024);
#pragma unroll
    for (int i = 0; i < 4; ++i) { int wd = 0; wd = __builtin_amdgcn_cvt_pk_fp8_f32(v[i].x * q, v[i].y * q, wd, false); wd = __builtin_amdgcn_cvt_pk_fp8_f32(v[i].z * q, v[i].w * q, wd, true); d[i * 64 + lane] = (unsigned)wd; }
    if (lane == 0) sc[row] = (am > 0.f) ? am * (1.0f / 224.0f) : 1.0f;
  }
}

template <bool SWAPN>
__device__ void rows_fp4(const float* __restrict__ src, unsigned char* __restrict__ dst, float* __restrict__ sc, int nrows, int bid, int nb) {
  const int lane = threadIdx.x & 63, w = threadIdx.x >> 6;
  for (int row = bid * 4 + w; row < nrows; row += nb * 4) {
    const float4* s = (const float4*)(src + (size_t)row * 1024 + lane * 16);
    float4 v[4]; float am = 0.f;
#pragma unroll
    for (int i = 0; i < 4; ++i) { v[i] = s[i]; am = fmaxf(am, fmaxf(fmaxf(fabsf(v[i].x), fabsf(v[i].y)), fmaxf(fabsf(v[i].z), fabsf(v[i].w)))); }
#pragma unroll
    for (int o = 32; o > 0; o >>= 1) am = fmaxf(am, __shfl_xor(am, o));
    const float q = (am > 0.f) ? 6.0f / am : 1.0f;
    if (SWAPN) {
#pragma unroll
      for (int i = 0; i < 4; ++i) { float t = v[i].x; v[i].x = v[i].y; v[i].y = t; t = v[i].z; v[i].z = v[i].w; v[i].w = t; } }
    unsigned w0 = 0, w1 = 0;
    w0 = __builtin_amdgcn_cvt_scalef32_pk_fp4_f32(w0, v[0].x * q, v[0].y * q, 1.0f, 0); w0 = __builtin_amdgcn_cvt_scalef32_pk_fp4_f32(w0, v[0].z * q, v[0].w * q, 1.0f, 1);
    w0 = __builtin_amdgcn_cvt_scalef32_pk_fp4_f32(w0, v[1].x * q, v[1].y * q, 1.0f, 2); w0 = __builtin_amdgcn_cvt_scalef32_pk_fp4_f32(w0, v[1].z * q, v[1].w * q, 1.0f, 3);
    w1 = __builtin_amdgcn_cvt_scalef32_pk_fp4_f32(w1, v[2].x * q, v[2].y * q, 1.0f, 0); w1 = __builtin_amdgcn_cvt_scalef32_pk_fp4_f32(w1, v[2].z * q, v[2].w * q, 1.0f, 1);
    w1 = __builtin_amdgcn_cvt_scalef32_pk_fp4_f32(w1, v[3].x * q, v[3].y * q, 1.0f, 2); w1 = __builtin_amdgcn_cvt_scalef32_pk_fp4_f32(w1, v[3].z * q, v[3].w * q, 1.0f, 3);
    *(uint2*)(dst + (size_t)row * 512 + lane * 8) = make_uint2(w0, w1);
    if (lane == 0) sc[row] = (am > 0.f) ? am * (1.0f / 6.0f) : 1.0f;
  }
}

__device__ void ssm_stage1(const Params& p, int gp) {
  const int g = gp >> 6;
  const float step = expf(p.log_step[g]); const float lr = p.lam_re[gp], li = p.lam_im[gp];
  const float mag = expf(lr * step); const float ar = mag * cosf(li * step), ai = mag * sinf(li * step);
  const float zr = ar - 1.0f, den = lr * lr + li * li; const float fr = (zr * lr + ai * li) / den, fi = (ai * lr - zr * li) / den;
  for (int c = 0; c < 16; ++c) { const float br = p.b_re[gp * 16 + c], bi = p.b_im[gp * 16 + c]; p.BBR[gp * 16 + c] = fr * br - fi * bi; p.BBI[gp * 16 + c] = fr * bi + fi * br; }
  float pr = 1.f, pi = 0.f; const int st = gp & 63;
  for (int j = 0; j <= 16; ++j) { p.PWR[(g * 17 + j) * 64 + st] = pr; p.PWI[(g * 17 + j) * 64 + st] = pi; const float nr = pr * ar - pi * ai, ni = pr * ai + pi * ar; if (j < 16) { pr = nr; pi = ni; } }
  const float a16r = pr, a16i = pi; const float a32r = a16r * a16r - a16i * a16i, a32i = 2.f * a16r * a16i;
  const float a48r = a32r * a16r - a32i * a16i, a48i = a32r * a16i + a32i * a16r; const float a64r = a32r * a32r - a32i * a32i, a64i = 2.f * a32r * a32i;
  const float a128r = a64r * a64r - a64i * a64i, a128i = 2.f * a64r * a64i; const float a256r = a128r * a128r - a128i * a128i, a256i = 2.f * a128r * a128i;
  float* A = p.APW;
  A[0 * 4096 + gp] = a16r; A[0 * 4096 + 2048 + gp] = a16i; A[1 * 4096 + gp] = a32r; A[1 * 4096 + 2048 + gp] = a32i; A[2 * 4096 + gp] = a48r; A[2 * 4096 + 2048 + gp] = a48i;
  A[3 * 4096 + gp] = a64r; A[3 * 4096 + 2048 + gp] = a64i; A[4 * 4096 + gp] = a256r; A[4 * 4096 + 2048 + gp] = a256i;
}
__device__ void ssm_stage2a(const Params& p, int bid, int nb) {
  const int n1 = 32 * 128 * 256, n2 = 32 * 16 * 4 * 512, n3 = 32 * 16 * 256;
  for (int i = bid * NTHREADS + threadIdx.x; i < n1 + n2 + n3; i += nb * NTHREADS) {
    if (i < n1) {
      const int j = i & 7, lane = (i >> 3) & 63, ks = (i >> 9) & 7, ri = (i >> 12) & 1, w = (i >> 13) & 3, g = i >> 15;
      const int st = w * 16 + (lane & 15), k = ks * 32 + (lane >> 4) * 8 + j; const int s_ = k >> 4, ch = k & 15;
      const int gp = g * 64 + st; const float pr = p.PWR[(g * 17 + 15 - s_) * 64 + st], pi = p.PWI[(g * 17 + 15 - s_) * 64 + st]; const float br = p.BBR[gp * 16 + ch], bi = p.BBI[gp * 16 + ch];
      p.WE16[i] = f2bf(ri == 0 ? (pr * br - pi * bi) : (pr * bi + pi * br));
    } else if (i < n1 + n2) {
      const int e = i - n1; const int j = e & 7, lane = (e >> 3) & 63, ks = (e >> 9) & 3, mt = (e >> 11) & 15, g = e >> 15;
      const int t = mt, co = lane & 15, k = ks * 32 + (lane >> 4) * 8 + j;
      const int st = ((k >> 5) << 4) | (k & 15), ri = (k >> 4) & 1; const float cr = p.c_re[(g * 16 + co) * 64 + st], ci = p.c_im[(g * 16 + co) * 64 + st];
      const float pr = p.PWR[(g * 17 + t + 1) * 64 + st], pi = p.PWI[(g * 17 + t + 1) * 64 + st];
      p.WY[((size_t)(g * 16 + mt) * 12 + ks) * 512 + lane * 8 + j] = f2bf((ri == 0) ? (cr * pr - ci * pi) : -(cr * pi + ci * pr));
    } else {
      const int e = i - n1 - n2; const int cin = e & 15, co = (e >> 4) & 15, j = (e >> 8) & 15, g = e >> 12; float acc = 0.f;
      for (int st = 0; st < 64; ++st) { const float cr = p.c_re[(g * 16 + co) * 64 + st], ci = p.c_im[(g * 16 + co) * 64 + st]; const float pr = p.PWR[(g * 17 + j) * 64 + st], pi = p.PWI[(g * 17 + j) * 64 + st];
        const float br = p.BBR[(g * 64 + st) * 16 + cin], bi = p.BBI[(g * 64 + st) * 16 + cin]; acc += cr * (pr * br - pi * bi) - ci * (pr * bi + pi * br); }
      p.KJ[e] = acc;
    }
  }
}
__device__ void ssm_stage2b(const Params& p, int bid, int nb) {
  const int n = 32 * 16 * 8 * 512;
  for (int i = bid * NTHREADS + threadIdx.x; i < n; i += nb * NTHREADS) {
    const int j = i & 7, lane = (i >> 3) & 63, ks8 = (i >> 9) & 7, mt = (i >> 12) & 15, g = i >> 16;
    const int t = mt, co = lane & 15, kk = ks8 * 32 + (lane >> 4) * 8 + j; const int s_ = kk >> 4, cin = kk & 15;
    const float val = (s_ <= t) ? p.KJ[((g * 16 + (t - s_)) * 16 + co) * 16 + cin] : 0.f;
    p.WY[((size_t)(g * 16 + mt) * 12 + 4 + ks8) * 512 + lane * 8 + j] = f2bf(val);
  }
}

#define EPI_IDS const int tid = threadIdx.x, lane = tid & 63, w = tid >> 6, wr = w >> 1, wc = w & 1, fr = lane & 15, fq = lane >> 4; (void)wr; (void)wc; (void)fr; (void)fq;

__device__ void tile_win_v(const Params& p, int tile, char* lds) {
  const int rt = tile >> 4, ct = tile & 15; const int row0 = rt * 128, col0 = ct * 128;
  f32x4 acc[4][4];
  gemm_mainloop<true, true>(acc, p.XB, 1024, p.WtIn, 1024, 1024, row0, col0, lds);
  EPI_IDS
  const int head = (col0 + wc * 64 - 1024) >> 6;
#pragma unroll
  for (int m = 0; m < 4; ++m) {
    const int row = row0 + wr * 64 + m * 16 + fq * 4; const f32x4 rsx = *(const f32x4*)(p.rs_x + row); const int b = row >> 13, tb = row & 8191;
#pragma unroll
    for (int n = 0; n < 4; ++n) { const f32x4 v = acc[m][n] * rsx;
      *(uint2*)(p.VT + ((size_t)(b * 8 + head) * 64 + n * 16 + fr) * SEQL + tb) = make_uint2(pack2(v[0], v[1]), pack2(v[2], v[3])); }
  }
}
__device__ void tile_win(const Params& p, int tile, char* lds) {
  const int rt = tile >> 4, ct = tile & 15; const int row0 = rt * 128, col0 = ct * 128;
  f32x4 acc[4][4];
  gemm_mainloop<true>(acc, p.XB, 1024, p.WtIn, 1024, 1024, row0, col0, lds);
  EPI_IDS
  const int cw = col0 + wc * 64;
#pragma unroll
  for (int m = 0; m < 4; ++m) {
    const int row = row0 + wr * 64 + m * 16 + fr; const float rsx = p.rs_x[row];
    if (cw < 1024) {
      float ss = 0.f;
#pragma unroll
      for (int n = 0; n < 4; ++n)
#pragma unroll
        for (int j = 0; j < 4; ++j) { const float v = acc[m][n][j] * rsx; acc[m][n][j] = v; ss += v * v; }
      ss += __shfl_xor(ss, 16); ss += __shfl_xor(ss, 32);
      const float rs = rsqrtf(ss * (1.0f / 64.0f) + EPSF) * (cw < 512 ? 0.125f : 1.0f);
      const float* g = (cw < 512) ? p.att_q_g : p.att_k_g; bf16_t* dst = (cw < 512 ? p.Qb : p.Kb) + (size_t)row * 512 + (cw & 511);
#pragma unroll
      for (int n = 0; n < 4; ++n) { const int c = n * 16 + fq * 4; const float4 gg = *(const float4*)(g + c);
        *(uint2*)(dst + c) = make_uint2(pack2(acc[m][n][0] * rs * gg.x, acc[m][n][1] * rs * gg.y), pack2(acc[m][n][2] * rs * gg.z, acc[m][n][3] * rs * gg.w)); }
    } else if (cw < 1536) {
      const int head = (cw - 1024) >> 6; const int b = row >> 13, tb = row & 8191;
      bf16_t* dst = p.VT + ((size_t)(b * 8 + head) * 64) * SEQL + tb;
#pragma unroll
      for (int n = 0; n < 4; ++n)
#pragma unroll
        for (int j = 0; j < 4; ++j) dst[(size_t)(n * 16 + fq * 4 + j) * SEQL] = f2bf(acc[m][n][j] * rsx);
    } else {
      const int b = row >> 13, tb = row & 8191;
#pragma unroll
      for (int n = 0; n < 4; ++n) { const int g = ((cw - 1536) >> 4) + n;
        *(uint2*)(p.Ub + ((size_t)(b * 32 + g) * SEQL + tb) * 16 + fq * 4) = make_uint2(pack2(acc[m][n][0] * rsx, acc[m][n][1] * rsx), pack2(acc[m][n][2] * rsx, acc[m][n][3] * rsx)); }
    }
  }
}
__device__ void tile_memkv(const Params& p, int tile, char* lds) {
  const int which = tile >> 5, t2 = tile & 31; const int rt = t2 >> 3, ct = t2 & 7; const int row0 = rt * 128, col0 = ct * 128;
  f32x4 acc[4][4];
  gemm_mainloop<true>(acc, p.MEMB, 1024, which ? p.WtMv : p.WtMk, 1024, 1024, row0, col0, lds);
  EPI_IDS
  const int cw = col0 + wc * 64;
#pragma unroll
  for (int m = 0; m < 4; ++m) {
    const int row = row0 + wr * 64 + m * 16 + fr; const float rsm = p.rs_mem[row];
    if (which == 0) {
      float ss = 0.f;
#pragma unroll
      for (int n = 0; n < 4; ++n) { f32x4 v = acc[m][n] * rsm; ss += v[0] * v[0] + v[1] * v[1] + v[2] * v[2] + v[3] * v[3]; *(f32x4*)(p.KMraw + (size_t)row * 1024 + cw + n * 16 + fq * 4) = v; }
      ss += __shfl_xor(ss, 16); ss += __shfl_xor(ss, 32);
      if (fq == 0) p.ss_km[row * 16 + (cw >> 6)] = ss;
    } else {
      const int b = row >> 8, key = row & 255; const int head = cw >> 8; const int d0 = (cw & 255);
      bf16_t* dst = p.VMT + ((size_t)(b * 4 + head) * 256) * 256 + key;
#pragma unroll
      for (int n = 0; n < 4; ++n)
#pragma unroll
        for (int j = 0; j < 4; ++j) dst[(size_t)(d0 + n * 16 + fq * 4 + j) * 256] = f2bf(acc[m][n][j] * rsm);
    }
  }
}
__device__ void memk_fix(const Params& p, int bid, int nb) {
  for (int i = bid * NTHREADS + threadIdx.x; i < 512 * 1024 / 4; i += nb * NTHREADS) {
    const int row = i >> 8, c4 = (i & 255) * 4; const int head = c4 >> 8, d = c4 & 255;
    const float ss = p.ss_km[row * 16 + head * 4] + p.ss_km[row * 16 + head * 4 + 1] + p.ss_km[row * 16 + head * 4 + 2] + p.ss_km[row * 16 + head * 4 + 3];
    const float rs = rsqrtf(ss * (1.0f / 256.0f) + EPSF);
    const float4 v = *(const float4*)(p.KMraw + (size_t)row * 1024 + c4); const float4 gk = *(const float4*)(p.mem_k_g + d), gq = *(const float4*)(p.mem_q_g + d);
    const int b = row >> 8, key = row & 255;
    *(uint2*)(p.KMB + ((size_t)(b * 4 + head) * 256 + key) * 256 + d) = make_uint2(pack2(v.x * rs * gk.x * gq.x, v.y * rs * gk.y * gq.y), pack2(v.z * rs * gk.z * gq.z, v.w * rs * gk.w * gq.w));
  }
}

__device__ void chunk_attn_item(const Params& p, int item, char* lds_) {
  LAS char* lds = (LAS char*)lds_; LAS float* rb = (LAS float*)(lds + 32768);
  typedef unsigned u32x2 __attribute__((ext_vector_type(2)));
  const int h = item & 7, cn = (item >> 3) & 127, b = item >> 10;
  const int tid = threadIdx.x, lane = tid & 63, w = tid >> 6, fr = lane & 15, fq = lane >> 4;
  const int iq = w * 16 + fr; const int tq = b * SEQL + cn * 64 + iq;
  const int cstart = (cn >= 8) ? 0 : (8 - cn);
  const bf16_t* vtb = p.VT + ((size_t)(b * 8 + h) * 64) * SEQL;
  const int r0 = tid >> 3, ch = tid & 7;
  u32x4 kr[2], vr[2];
  { const int kc0 = (cn - 8 + cstart) * 64;
#pragma unroll
    for (int i = 0; i < 2; ++i) { kr[i] = *(const u32x4*)(p.Kb + (size_t)(b * SEQL + kc0 + r0 + 32 * i) * 512 + h * 64 + ch * 8); vr[i] = *(const u32x4*)(vtb + (size_t)(r0 + 32 * i) * SEQL + kc0 + ch * 8); } }
  bf16x8 qf[2];
  qf[0] = *(const bf16x8*)(p.Qb + (size_t)tq * 512 + h * 64 + fq * 8); qf[1] = *(const bf16x8*)(p.Qb + (size_t)tq * 512 + h * 64 + 32 + fq * 8);
  __syncthreads();
  if (tid < 192) rb[tid] = p.rel_bias[h * 192 + tid];
#pragma unroll
  for (int i = 0; i < 2; ++i) { const int r = r0 + 32 * i; *(LAS u32x4*)(lds + r * 128 + ((ch ^ (r & 7)) << 4)) = kr[i]; *(LAS u32x4*)(lds + 8192 + r * 128 + ((ch ^ ((r >> 1) & 7)) << 4)) = vr[i]; }
  __syncthreads();
  f32x4 o[4]; for (int i = 0; i < 4; ++i) o[i] = (f32x4){0.f, 0.f, 0.f, 0.f};
  float mrun = -1e30f, lrun = 0.f;
  for (int c = cstart; c <= 8; ++c) {
    LAS char* cur = lds + ((c - cstart) & 1) * 16384; LAS char* nxt = lds + ((c - cstart + 1) & 1) * 16384;
    const bool more = c < 8;
    if (more) { const int kc1 = (cn - 8 + c + 1) * 64;
#pragma unroll
      for (int i = 0; i < 2; ++i) { kr[i] = *(const u32x4*)(p.Kb + (size_t)(b * SEQL + kc1 + r0 + 32 * i) * 512 + h * 64 + ch * 8); vr[i] = *(const u32x4*)(vtb + (size_t)(r0 + 32 * i) * SEQL + kc1 + ch * 8); } }
    f32x4 st[4];
#pragma unroll
    for (int mt = 0; mt < 4; ++mt) { const int row = mt * 16 + fr; f32x4 sacc = (f32x4){0.f, 0.f, 0.f, 0.f};
      sacc = mfma16(as_bf(*(const LAS u32x4*)(cur + row * 128 + ((fq ^ (row & 7)) << 4))), qf[0], sacc);
      sacc = mfma16(as_bf(*(const LAS u32x4*)(cur + row * 128 + (((4 + fq) ^ (row & 7)) << 4))), qf[1], sacc); st[mt] = sacc; }
    float tmax = -1e30f;
#pragma unroll
    for (int mt = 0; mt < 4; ++mt)
#pragma unroll
      for (int j = 0; j < 4; ++j) { const int jk = mt * 16 + fq * 4 + j; int dist = 512 - 64 * c + iq - jk; dist = dist < -63 ? -63 : (dist > 128 ? 128 : dist);
        const float sv = st[mt][j] + rb[dist + 63]; st[mt][j] = sv; tmax = fmaxf(tmax, sv); }
    tmax = fmaxf(tmax, __shfl_xor(tmax, 16)); tmax = fmaxf(tmax, __shfl_xor(tmax, 32));
    const float mnew = fmaxf(mrun, tmax); const float alpha = __expf(mrun - mnew); mrun = mnew;
    float ls = 0.f;
#pragma unroll
    for (int mt = 0; mt < 4; ++mt)
#pragma unroll
      for (int j = 0; j < 4; ++j) { const float pv = __expf(st[mt][j] - mnew); st[mt][j] = pv; ls += pv; }
    lrun = lrun * alpha + ls;
    bf16x8 pf[2];
#pragma unroll
    for (int s2 = 0; s2 < 2; ++s2) { u32x4 t; t.x = pack2(st[2 * s2][0], st[2 * s2][1]); t.y = pack2(st[2 * s2][2], st[2 * s2][3]); t.z = pack2(st[2 * s2 + 1][0], st[2 * s2 + 1][1]); t.w = pack2(st[2 * s2 + 1][2], st[2 * s2 + 1][3]); pf[s2] = as_bf(t); }
#pragma unroll
    for (int dt = 0; dt < 4; ++dt) { const int d = dt * 16 + fr; const int sw = ((d >> 1) & 7) << 1; f32x4 oc = o[dt] * alpha;
#pragma unroll
      for (int s2 = 0; s2 < 2; ++s2) {
        const u32x2 lo = *(const LAS u32x2*)(cur + 8192 + d * 128 + (((s2 * 8 + fq) ^ sw) << 3)), hi = *(const LAS u32x2*)(cur + 8192 + d * 128 + (((s2 * 8 + fq + 4) ^ sw) << 3));
        u32x4 vv; vv.x = lo.x; vv.y = lo.y; vv.z = hi.x; vv.w = hi.y; oc = mfma16(as_bf(vv), pf[s2], oc); }
      o[dt] = oc; }
    if (more) {
#pragma unroll
      for (int i = 0; i < 2; ++i) { const int r = r0 + 32 * i; *(LAS u32x4*)(nxt + r * 128 + ((ch ^ (r & 7)) << 4)) = kr[i]; *(LAS u32x4*)(nxt + 8192 + r * 128 + ((ch ^ ((r >> 1) & 7)) << 4)) = vr[i]; }
    }
    __syncthreads();
  }
  float lt = lrun; lt += __shfl_xor(lt, 16); lt += __shfl_xor(lt, 32);
  const float inv = 1.0f / lt; float ss = 0.f;
  bf16_t* dst = p.ATT + (size_t)tq * 512 + h * 64;
#pragma unroll
  for (int dt = 0; dt < 4; ++dt) { const f32x4 v = o[dt] * inv; ss += v[0] * v[0] + v[1] * v[1] + v[2] * v[2] + v[3] * v[3];
    *(uint2*)(dst + dt * 16 + fq * 4) = make_uint2(pack2(v[0], v[1]), pack2(v[2], v[3])); }
  ss += __shfl_xor(ss, 16); ss += __shfl_xor(ss, 32);
  if (fq == 0) p.ss_att[tq * 8 + h] = ss;
}

template <bool FINAL>
__device__ void ssm_item(const Params& p, int item, char* lds) {
  const int g = item & 31, seg = (item >> 5) & 31, b = item >> 10;
  const int tid = threadIdx.x, lane = tid & 63, w = tid >> 6, fr = lane & 15, fq = lane >> 4;
  const int t0 = b * SEQL + seg * 256;
  const bf16_t* ug = p.Ub + ((size_t)(b * 32 + g) * SEQL + seg * 256) * 16;
  bf16x8 uf[8];
#pragma unroll
  for (int ks = 0; ks < 8; ++ks) uf[ks] = *(const bf16x8*)(ug + (size_t)(fr * 16 + 2 * ks + (fq >> 1)) * 16 + (fq & 1) * 8);
  f32x4 er = (f32x4){0.f, 0.f, 0.f, 0.f}, ei = er;
  const bf16_t* we = p.WE16 + ((size_t)(g * 4 + w) * 2 * 8 * 64 + lane) * 8;
#pragma unroll
  for (int ks = 0; ks < 8; ++ks) { const bf16x8 br = *(const bf16x8*)(we + ks * 512), bi = *(const bf16x8*)(we + 4096 + ks * 512); er = mfma16(uf[ks], br, er); ei = mfma16(uf[ks], bi, ei); }
  const int gp = g * 64 + w * 16 + fr;
  const float a16r = p.APW[gp], a16i = p.APW[2048 + gp];
  float xr[4], xi[4];
  xr[0] = er[0]; xi[0] = ei[0];
#pragma unroll
  for (int j = 1; j < 4; ++j) { xr[j] = a16r * xr[j - 1] - a16i * xi[j - 1] + er[j]; xi[j] = a16r * xi[j - 1] + a16i * xr[j - 1] + ei[j]; }
  float cr = 0.f, ci = 0.f;
  if (FINAL) {
    const float ar = p.APW[4 * 4096 + gp], ai = p.APW[4 * 4096 + 2048 + gp];
    const float* es = p.ESEG + ((size_t)(b * 32) * 32 + g) * 128 + w * 32 + fr;
    for (int j0 = 0; j0 < seg; j0 += 8) { float e_r[8], e_i[8];
#pragma unroll
      for (int u = 0; u < 8; ++u) { e_r[u] = es[(size_t)(j0 + u) * 32 * 128]; e_i[u] = es[(size_t)(j0 + u) * 32 * 128 + 16]; }
#pragma unroll
      for (int u = 0; u < 8; ++u) if (j0 + u < seg) { const float nr = ar * cr - ai * ci + e_r[u], ni = ar * ci + ai * cr + e_i[u]; cr = nr; ci = ni; } }
  }
  const float a64r = p.APW[3 * 4096 + gp], a64i = p.APW[3 * 4096 + 2048 + gp];
  float tr = xr[3], ti = xi[3];
#pragma unroll
  for (int r = 0; r < 4; ++r) {
    float pr_ = __shfl(tr, (lane + 48) & 63), pi_ = __shfl(ti, (lane + 48) & 63);
    if (r == 0) { pr_ = cr; pi_ = ci; }
    if (fq == r) { const float nr = xr[3] + a64r * pr_ - a64i * pi_, ni = xi[3] + a64r * pi_ + a64i * pr_; tr = nr; ti = ni; }
  }
  if (!FINAL) {
    if (fq == 3) { float* es = p.ESEG + ((size_t)(b * 32 + seg) * 32 + g) * 128 + w * 32 + fr; es[0] = tr; es[16] = ti; }
    return;
  }
  float gr = __shfl(tr, (lane + 48) & 63), gi = __shfl(ti, (lane + 48) & 63);
  if (fq == 0) { gr = cr; gi = ci; }
  float pvr[4], pvi[4];
  pvr[0] = gr; pvi[0] = gi;
#pragma unroll
  for (int j = 1; j < 4; ++j) { const float ar = p.APW[(j - 1) * 4096 + gp], ai = p.APW[(j - 1) * 4096 + 2048 + gp]; pvr[j] = xr[j - 1] + ar * gr - ai * gi; pvi[j] = xi[j - 1] + ar * gi + ai * gr; }
  bf16_t* xl = (bf16_t*)lds;
  __syncthreads();
#pragma unroll
  for (int j = 0; j < 4; ++j) { xl[(fq * 4 + j) * 136 + w * 32 + fr] = f2bf(pvr[j]); xl[(fq * 4 + j) * 136 + w * 32 + 16 + fr] = f2bf(pvi[j]); }
  __syncthreads();
  bf16x8 xf[4];
#pragma unroll
  for (int ks = 0; ks < 4; ++ks) xf[ks] = *(const bf16x8*)(xl + fr * 136 + ks * 32 + fq * 8);
#pragma unroll
  for (int mi = 0; mi < 4; ++mi) {
    const int mt = w * 4 + mi;
    const bf16_t* wy = p.WY + ((size_t)(g * 16 + mt) * 12 * 64 + lane) * 8;
    f32x4 y = (f32x4){0.f, 0.f, 0.f, 0.f};
#pragma unroll
    for (int ks = 0; ks < 4; ++ks) y = mfma16(*(const bf16x8*)(wy + ks * 512), xf[ks], y);
#pragma unroll
    for (int ks = 0; ks < 8; ++ks) if (2 * ks <= mt) y = mfma16(*(const bf16x8*)(wy + (4 + ks) * 512), uf[ks], y);
    const size_t tok = (size_t)(t0 + fr * 16 + mt);
    const uint2 uu = *(const uint2*)(ug + (size_t)(fr * 16 + mt) * 16 + fq * 4);
    const float4 dd = *(const float4*)(p.d_skip + g * 16 + fq * 4);
    const float y0 = gelu_f(y[0] + dd.x * __uint_as_float(uu.x << 16)), y1 = gelu_f(y[1] + dd.y * __uint_as_float(uu.x & 0xffff0000u));
    const float y2 = gelu_f(y[2] + dd.z * __uint_as_float(uu.y << 16)), y3 = gelu_f(y[3] + dd.w * __uint_as_float(uu.y & 0xffff0000u));
    *(uint2*)(p.YG + tok * 512 + g * 16 + fq * 4) = make_uint2(pack2(y0, y1), pack2(y2, y3));
  }
}

__device__ void tile_glu(const Params& p, int tile, char* lds) {
  const int rt = tile >> 2, ct = tile & 3; const int row0 = rt * 128, col0 = ct * 128;
  f32x4 acc[4][4];
  gemm_mainloop<true>(acc, p.YG, 512, p.WtGlu, 512, 512, row0, col0, lds);
  EPI_IDS
  const int cw = col0 + wc * 64;
#pragma unroll
  for (int m = 0; m < 4; ++m) {
    const int row = row0 + wr * 64 + m * 16 + fr; float ss = 0.f;
#pragma unroll
    for (int n = 0; n < 4; ++n) { const int c = cw + n * 16 + fq * 4; const float4 bg = *(const float4*)(p.b_glu + c); const uint2 yy = *(const uint2*)(p.YG + (size_t)row * 512 + c);
      const float y0 = __uint_as_float(yy.x << 16), y1 = __uint_as_float(yy.x & 0xffff0000u), y2 = __uint_as_float(yy.y << 16), y3 = __uint_as_float(yy.y & 0xffff0000u);
      const float o0 = y0 / (1.f + __expf(-(acc[m][n][0] + bg.x))), o1 = y1 / (1.f + __expf(-(acc[m][n][1] + bg.y))), o2 = y2 / (1.f + __expf(-(acc[m][n][2] + bg.z))), o3 = y3 / (1.f + __expf(-(acc[m][n][3] + bg.w)));
      ss += o0 * o0 + o1 * o1 + o2 * o2 + o3 * o3;
      *(uint2*)(p.SSMO + (size_t)row * 512 + c) = make_uint2(pack2(o0, o1), pack2(o2, o3)); }
    ss += __shfl_xor(ss, 16); ss += __shfl_xor(ss, 32);
    if (fq == 0) p.ss_ssm[row * 8 + (cw >> 6)] = ss;
  }
}
__device__ void tile_wout(const Params& p, int tile, char* lds) {
  const int rt = tile >> 3, ct = tile & 7; const int row0 = rt * 128, col0 = ct * 128;
  f32x4 acc[4][4];
  float s1[4];
  gemm_mainloop<true>(acc, p.ATT, 512, p.WtOut, 1024, 512, row0, col0, lds);
  { const int lane_ = threadIdx.x & 63, w_ = threadIdx.x >> 6;
#pragma unroll
    for (int m = 0; m < 4; ++m) { const int row = row0 + (w_ >> 1) * 64 + m * 16 + (lane_ & 15); float a = 0.f, c = 0.f;
#pragma unroll
      for (int j = 0; j < 8; ++j) { a += p.ss_att[row * 8 + j]; c += p.ss_ssm[row * 8 + j]; }
      const float ra = rsqrtf(a * (1.0f / 512.0f) + EPSF); s1[m] = rsqrtf(c * (1.0f / 512.0f) + EPSF); const float f = ra / s1[m];
#pragma unroll
      for (int n = 0; n < 4; ++n) acc[m][n] *= f; } }
  gemm_mainloop<false>(acc, p.SSMO, 512, p.WtOut + 512, 1024, 512, row0, col0, lds);
  EPI_IDS
  const int cw = col0 + wc * 64;
#pragma unroll
  for (int m = 0; m < 4; ++m) {
    const int row = row0 + wr * 64 + m * 16 + fr; float ss = 0.f;
#pragma unroll
    for (int n = 0; n < 4; ++n) { const int c = cw + n * 16 + fq * 4; const f32x4 xv = *(const f32x4*)(p.x + (size_t)row * 1024 + c); const f32x4 hv = xv + acc[m][n] * s1[m];
      ss += hv[0] * hv[0] + hv[1] * hv[1] + hv[2] * hv[2] + hv[3] * hv[3];
      *(uint2*)(p.H1B + (size_t)row * 1024 + c) = make_uint2(pack2(hv[0], hv[1]), pack2(hv[2], hv[3])); }
    ss += __shfl_xor(ss, 16); ss += __shfl_xor(ss, 32);
    if (fq == 0) p.ss_h1[row * 16 + (cw >> 6)] = ss;
  }
}
__device__ __forceinline__ float row_rs16(const float* ss, int row) { float a = 0.f;
#pragma unroll
  for (int j = 0; j < 16; ++j) a += ss[row * 16 + j];
  return rsqrtf(a * (1.0f / 1024.0f) + EPSF); }
__device__ void tile_memq(const Params& p, int tile, char* lds) {
  const int rt = tile >> 3, ct = tile & 7; const int row0 = rt * 128, col0 = ct * 128;
  f32x4 acc[4][4];
  gemm_mainloop<true>(acc, p.H1B, 1024, p.WtMq, 1024, 1024, row0, col0, lds);
  EPI_IDS
  const int cw = col0 + wc * 64;
#pragma unroll
  for (int m = 0; m < 4; ++m) {
    const int row = row0 + wr * 64 + m * 16 + fr; const float rs = row_rs16(p.ss_h1, row); float ss = 0.f;
#pragma unroll
    for (int n = 0; n < 4; ++n) { const int c = cw + n * 16 + fq * 4; const f32x4 v = acc[m][n] * rs; ss += v[0] * v[0] + v[1] * v[1] + v[2] * v[2] + v[3] * v[3];
      *(uint2*)(p.QM + (size_t)row * 1024 + c) = make_uint2(pack2(v[0], v[1]), pack2(v[2], v[3])); }
    ss += __shfl_xor(ss, 16); ss += __shfl_xor(ss, 32);
    if (fq == 0) p.ss_qm[row * 16 + (cw >> 6)] = ss;
  }
}
__device__ __forceinline__ void mem_stage(const bf16_t* kg, const bf16_t* vg, int kc, LAS char* buf, int w, int lane) {
  const int wb = __builtin_amdgcn_readfirstlane(w) * 4096;
#pragma unroll
  for (int i = 0; i < 4; ++i) {
    const int row = w * 8 + i * 2 + (lane >> 5), pos = lane & 31; const int ch = pos ^ (row & 15);
    __builtin_amdgcn_global_load_lds((const GAS void*)(kg + (size_t)(kc * 32 + row) * 256 + ch * 8), (LAS void*)(buf + wb + i * 1024), 16, 0, 0);
  }
#pragma unroll
  for (int i = 0; i < 4; ++i) {
    const int d = w * 64 + i * 16 + (lane >> 2), pos = lane & 3; const int ch = pos ^ ((d >> 2) & 3);
    __builtin_amdgcn_global_load_lds((const GAS void*)(vg + (size_t)d * 256 + kc * 32 + ch * 8), (LAS void*)(buf + 16384 + wb + i * 1024), 16, 0, 0);
  }
}
__device__ void mem_attn_item(const Params& p, int item, char* lds_) {
  LAS char* lds = (LAS char*)lds_;
  typedef unsigned u32x2 __attribute__((ext_vector_type(2)));
  const int h = item & 3, tt = item >> 2; const int tid = threadIdx.x, lane = tid & 63, w = tid >> 6, fr = lane & 15, fq = lane >> 4;
  const int tq = tt * 64 + w * 16 + fr; const int b = tq >> 13;
  const bf16_t* kg = p.KMB + (size_t)(b * 4 + h) * 256 * 256;
  const bf16_t* vg = p.VMT + (size_t)(b * 4 + h) * 256 * 256;
  __syncthreads();
  mem_stage(kg, vg, 0, lds, w, lane);
  const float ssq = p.ss_qm[tq * 16 + h * 4] + p.ss_qm[tq * 16 + h * 4 + 1] + p.ss_qm[tq * 16 + h * 4 + 2] + p.ss_qm[tq * 16 + h * 4 + 3];
  const float rowscale = rsqrtf(ssq * (1.0f / 256.0f) + EPSF) * 0.0625f;
  bf16x8 qf[8];
#pragma unroll
  for (int ks = 0; ks < 8; ++ks) qf[ks] = *(const bf16x8*)(p.QM + (size_t)tq * 1024 + h * 256 + ks * 32 + fq * 8);
  f32x4 o[16];
#pragma unroll
  for (int i = 0; i < 16; ++i) o[i] = (f32x4){0.f, 0.f, 0.f, 0.f};
  float mrun = -1e30f, lrun = 0.f;
  asm volatile("s_waitcnt vmcnt(0)" ::: "memory");
  __syncthreads();
  for (int kc = 0; kc < 8; ++kc) {
    LAS char* cur = lds + (kc & 1) * 32768; LAS char* nxt = lds + ((kc + 1) & 1) * 32768;
    if (kc + 1 < 8) mem_stage(kg, vg, kc + 1, nxt, w, lane);
    f32x4 st[2];
#pragma unroll
    for (int mt = 0; mt < 2; ++mt) { f32x4 sacc = (f32x4){0.f, 0.f, 0.f, 0.f}; const int row = mt * 16 + fr;
#pragma unroll
      for (int ks = 0; ks < 8; ++ks) sacc = mfma16(as_bf(*(const LAS u32x4*)(cur + row * 512 + (((ks * 4 + fq) ^ (row & 15)) << 4))), qf[ks], sacc);
      st[mt] = sacc * rowscale; }
    float tmax = fmaxf(fmaxf(fmaxf(st[0][0], st[0][1]), fmaxf(st[0][2], st[0][3])), fmaxf(fmaxf(st[1][0], st[1][1]), fmaxf(st[1][2], st[1][3])));
    tmax = fmaxf(tmax, __shfl_xor(tmax, 16)); tmax = fmaxf(tmax, __shfl_xor(tmax, 32));
    const float mnew = fmaxf(mrun, tmax); const float alpha = __expf(mrun - mnew); mrun = mnew;
    float ls = 0.f;
#pragma unroll
    for (int mt = 0; mt < 2; ++mt)
#pragma unroll
      for (int j = 0; j < 4; ++j) { const float e = __expf(st[mt][j] - mnew); st[mt][j] = e; ls += e; }
    lrun = lrun * alpha + ls;
    u32x4 t; t.x = pack2(st[0][0], st[0][1]); t.y = pack2(st[0][2], st[0][3]); t.z = pack2(st[1][0], st[1][1]); t.w = pack2(st[1][2], st[1][3]);
    const bf16x8 pf = as_bf(t);
#pragma unroll
    for (int dt = 0; dt < 16; ++dt) { const int d = dt * 16 + fr; const int sw = ((d >> 2) & 3) << 1;
      const u32x2 lo = *(const LAS u32x2*)(cur + 16384 + d * 64 + ((fq ^ sw) << 3)), hi = *(const LAS u32x2*)(cur + 16384 + d * 64 + (((fq + 4) ^ sw) << 3));
      u32x4 vv; vv.x = lo.x; vv.y = lo.y; vv.z = hi.x; vv.w = hi.y; o[dt] = mfma16(as_bf(vv), pf, o[dt] * alpha); }
    asm volatile("s_waitcnt vmcnt(0)" ::: "memory");
    __syncthreads();
  }
  float lt = lrun; lt += __shfl_xor(lt, 16); lt += __shfl_xor(lt, 32);
  const float inv = 1.0f / lt;
  bf16_t* dst = p.OM + (size_t)tq * 1024 + h * 256;
#pragma unroll
  for (int dt = 0; dt < 16; ++dt) { const f32x4 v = o[dt] * inv; *(uint2*)(dst + dt * 16 + fq * 4) = make_uint2(pack2(v[0], v[1]), pack2(v[2], v[3])); }
}
__device__ void tile_memo(const Params& p, int tile, char* lds) {
  const int rt = tile >> 3, ct = tile & 7; const int row0 = rt * 128, col0 = ct * 128;
  f32x4 acc[4][4];
  gemm_mainloop<true>(acc, p.OM, 1024, p.WtMo, 1024, 1024, row0, col0, lds);
  EPI_IDS
  const int cw = col0 + wc * 64;
#pragma unroll
  for (int m = 0; m < 4; ++m) {
    const int row = row0 + wr * 64 + m * 16 + fr; float ss = 0.f;
#pragma unroll
    for (int n = 0; n < 4; ++n) { const int c = cw + n * 16 + fq * 4; const uint2 hb = *(const uint2*)(p.H1B + (size_t)row * 1024 + c);
      const f32x4 hv = (f32x4){__uint_as_float(hb.x << 16), __uint_as_float(hb.x & 0xffff0000u), __uint_as_float(hb.y << 16), __uint_as_float(hb.y & 0xffff0000u)} + acc[m][n];
      ss += hv[0] * hv[0] + hv[1] * hv[1] + hv[2] * hv[2] + hv[3] * hv[3];
      *(uint2*)(p.H2B + (size_t)row * 1024 + c) = make_uint2(pack2(hv[0], hv[1]), pack2(hv[2], hv[3])); }
    ss += __shfl_xor(ss, 16); ss += __shfl_xor(ss, 32);
    if (fq == 0) p.ss_h2[row * 16 + (cw >> 6)] = ss;
  }
}
__device__ __forceinline__ void ce_desc(float& x, float& y) { const float hi = fmaxf(x, y), lo = fminf(x, y); x = hi; y = lo; }
__device__ __forceinline__ void sort16_desc(float (&a)[16]) {
#pragma unroll
  for (int k = 2; k <= 16; k <<= 1)
#pragma unroll
    for (int j = k >> 1; j > 0; j >>= 1)
#pragma unroll
      for (int i = 0; i < 16; ++i) { const int l = i ^ j; if (l > i) { if ((i & k) == 0) ce_desc(a[i], a[l]); else ce_desc(a[l], a[i]); } }
}
__device__ __forceinline__ void merge16_desc(float (&a)[16], const float (&b)[16]) {
#pragma unroll
  for (int i = 0; i < 16; ++i) a[i] = fmaxf(a[i], b[15 - i]);
#pragma unroll
  for (int j = 8; j > 0; j >>= 1)
#pragma unroll
    for (int i = 0; i < 16; ++i) { const int l = i ^ j; if (l > i) ce_desc(a[i], a[l]); }
}
__device__ __forceinline__ void ins16(float (&a)[16], float v) {
#pragma unroll
  for (int i = 0; i < 16; ++i) { const float hi = fmaxf(a[i], v), lo = fminf(a[i], v); a[i] = hi; v = lo; }
}
__device__ void tile_peer(const Params& p, int tile, char* lds_) {
  const int rt = tile >> 4, hs = tile & 15; const int row0 = rt * 128, col0 = hs * 128;
  f32x4 acc[4][4];
  gemm_mainloop<true>(acc, p.H2B, 1024, p.WtPq, 1024, 1024, row0, col0, lds_);
  LAS char* lds = (LAS char*)lds_;
  EPI_IDS
  { const int lr = lane >> 3, lc = (lane & 7) ^ lr; const int wbase = __builtin_amdgcn_readfirstlane(w) * 4096;
    const bf16_t* gK = p.PK + (size_t)hs * 128 * 128 + (size_t)(w * 32 + lr) * 128 + lc * 8;
#pragma unroll
    for (int i = 0; i < 4; ++i) {
      __builtin_amdgcn_global_load_lds((const GAS void*)(gK + (size_t)(i * 8) * 128), (LAS void*)(lds + 16384 + wbase + i * 1024), 16, 0, 0);
      __builtin_amdgcn_global_load_lds((const GAS void*)(gK + (size_t)(i * 8) * 128 + 64), (LAS void*)(lds + 32768 + 16384 + wbase + i * 1024), 16, 0, 0);
    } }
  typedef unsigned u32x2 __attribute__((ext_vector_type(2)));
#pragma unroll
  for (int m = 0; m < 4; ++m) { const int r = wr * 64 + m * 16 + fr; const float rs = row_rs16(p.ss_h2, row0 + r);
#pragma unroll
    for (int n = 0; n < 4; ++n) { const f32x4 v = acc[m][n] * rs; u32x2 pk; pk.x = pack2(v[0], v[1]); pk.y = pack2(v[2], v[3]);
      *(LAS u32x2*)(lds + wc * 32768 + r * 128 + (((n * 2 + (fq >> 1)) ^ (r & 7)) << 4) + (fq & 1) * 8) = pk; } }
  asm volatile("s_waitcnt vmcnt(0)" ::: "memory");
  __syncthreads();
#pragma unroll
  for (int m = 0; m < 4; ++m)
#pragma unroll
    for (int n = 0; n < 4; ++n) acc[m][n] = (f32x4){0.f, 0.f, 0.f, 0.f};
#pragma unroll
  for (int kt = 0; kt < 2; ++kt) { LAS char* cur = lds + kt * 32768;
#pragma unroll
    for (int ks = 0; ks < 2; ++ks) { bf16x8 af[4], bfr[4]; const int kc = ks * 4 + fq;
#pragma unroll
      for (int m = 0; m < 4; ++m) { const int r = wr * 64 + m * 16 + fr; af[m] = as_bf(*(const LAS u32x4*)(cur + r * 128 + ((kc ^ (r & 7)) << 4))); }
#pragma unroll
      for (int n = 0; n < 4; ++n) { const int r = wc * 64 + n * 16 + fr; bfr[n] = as_bf(*(const LAS u32x4*)(cur + 16384 + r * 128 + ((kc ^ (r & 7)) << 4))); }
#pragma unroll
      for (int m = 0; m < 4; ++m)
#pragma unroll
        for (int n = 0; n < 4; ++n) acc[m][n] = mfma16(bfr[n], af[m], acc[m][n]);
    } }
  __syncthreads();
  LAS float* L = (LAS float*)lds;
#pragma unroll
  for (int m = 0; m < 4; ++m) {
    float a[16], b[16];
#pragma unroll
    for (int n = 0; n < 4; ++n)
#pragma unroll
      for (int j = 0; j < 4; ++j) a[n * 4 + j] = __uint_as_float((__float_as_uint(acc[m][n][j]) & ~127u) | (unsigned)(wc * 64 + n * 16 + fq * 4 + j));
    sort16_desc(a);
#pragma unroll
    for (int i = 0; i < 16; ++i) b[i] = __shfl_xor(a[i], 16);
    merge16_desc(a, b);
#pragma unroll
    for (int i = 0; i < 16; ++i) b[i] = __shfl_xor(a[i], 32);
    merge16_desc(a, b);
    const int r = wr * 64 + m * 16 + fr;
    f32x4 o; o[0] = fq == 0 ? a[0] : fq == 1 ? a[4] : fq == 2 ? a[8] : a[12]; o[1] = fq == 0 ? a[1] : fq == 1 ? a[5] : fq == 2 ? a[9] : a[13];
    o[2] = fq == 0 ? a[2] : fq == 1 ? a[6] : fq == 2 ? a[10] : a[14]; o[3] = fq == 0 ? a[3] : fq == 1 ? a[7] : fq == 2 ? a[11] : a[15];
    *(LAS f32x4*)(L + (r * 2 + wc) * 16 + fq * 4) = o;
  }
  __syncthreads();
#pragma unroll
  for (int mi = 0; mi < 2; ++mi) { const int m = wc * 2 + mi; const int r = wr * 64 + m * 16 + fr;
    float a[16], b[16];
#pragma unroll
    for (int q = 0; q < 4; ++q) { const f32x4 va = *(const LAS f32x4*)(L + (r * 2 + 0) * 16 + q * 4), vb = *(const LAS f32x4*)(L + (r * 2 + 1) * 16 + q * 4);
      a[q * 4] = va[0]; a[q * 4 + 1] = va[1]; a[q * 4 + 2] = va[2]; a[q * 4 + 3] = va[3]; b[q * 4] = vb[0]; b[q * 4 + 1] = vb[1]; b[q * 4 + 2] = vb[2]; b[q * 4 + 3] = vb[3]; }
    merge16_desc(a, b);
    u32x4 o; o.x = __float_as_uint(fq == 0 ? a[0] : fq == 1 ? a[4] : fq == 2 ? a[8] : a[12]); o.y = __float_as_uint(fq == 0 ? a[1] : fq == 1 ? a[5] : fq == 2 ? a[9] : a[13]);
    o.z = __float_as_uint(fq == 0 ? a[2] : fq == 1 ? a[6] : fq == 2 ? a[10] : a[14]); o.w = __float_as_uint(fq == 0 ? a[3] : fq == 1 ? a[7] : fq == 2 ? a[11] : a[15]);
    *(u32x4*)(p.TOPS + ((size_t)(row0 + r) * 16 + hs) * 16 + fq * 4) = o;
  }
}
__device__ void peer_gather_item(const Params& p, int item, char* lds_) {
  LAS char* lds = (LAS char*)lds_;
  const int tid = threadIdx.x, lane = tid & 63, w = tid >> 6;
  LAS unsigned* LA = (LAS unsigned*)lds;
  LAS int* LE = (LAS int*)(lds + 256 * 33 * 4);
  LAS float* LG = (LAS float*)(lds + 256 * 33 * 4 + 32 * 128 * 4);
  __syncthreads();
  {
    const int tl_ = tid >> 3, h = tid & 7; const int t = item * 32 + tl_;
    const uint4* src = (const uint4*)(p.TOPS + ((size_t)t * 16 + h * 2) * 16);
    float a[16], bq[16];
#pragma unroll
    for (int i = 0; i < 4; ++i) { const uint4 v = src[i]; a[4 * i] = __uint_as_float(v.x); a[4 * i + 1] = __uint_as_float(v.y); a[4 * i + 2] = __uint_as_float(v.z); a[4 * i + 3] = __uint_as_float(v.w); }
#pragma unroll
    for (int i = 0; i < 4; ++i) { const uint4 v = src[4 + i]; bq[4 * i] = __uint_as_float(v.x); bq[4 * i + 1] = __uint_as_float(v.y); bq[4 * i + 2] = __uint_as_float(v.z); bq[4 * i + 3] = __uint_as_float(v.w); }
#pragma unroll
    for (int i = 0; i < 16; ++i) { LA[tid * 33 + i] = __float_as_uint(a[i]); LA[tid * 33 + 16 + i] = __float_as_uint(bq[i]); }
    float c[16];
#pragma unroll
    for (int i = 0; i < 16; ++i) c[i] = -__builtin_inff();
#pragma unroll
    for (int i = 0; i < 16; ++i)
#pragma unroll
      for (int j = 0; j < 16; ++j) if ((i + 1) * (j + 1) <= 16) { const float s = a[i] + bq[j]; ins16(c, __uint_as_float((__float_as_uint(s) & ~255u) | (unsigned)(i * 16 + j))); }
    const float mx = c[0]; float e[16]; float sum = 0.f;
#pragma unroll
    for (int i = 0; i < 16; ++i) { e[i] = __expf(c[i] - mx); sum += e[i]; }
    const float inv = 1.0f / sum;
#pragma unroll
    for (int i = 0; i < 16; ++i) { const unsigned pos = __float_as_uint(c[i]) & 255u; const unsigned ia = LA[tid * 33 + (pos >> 4)] & 127u, ib = LA[tid * 33 + 16 + (pos & 15u)] & 127u;
      LE[tl_ * 128 + h * 16 + i] = (int)(ia * 128u + ib); LG[tl_ * 128 + h * 16 + i] = e[i] * inv; }
  }
  __syncthreads();
  LAS char* HQ = (LAS char*)LA;
  const int fr = lane & 15, fq = lane >> 4;
  for (int ti = 0; ti < 8; ++ti) {
    const int tl_ = w * 8 + ti; const int t = item * 32 + tl_;
    const float rs = row_rs16(p.ss_h2, t) * 16.0f;
    { const uint4 ha = *(const uint4*)(p.H2B + (size_t)t * 1024 + lane * 16), hb = *(const uint4*)(p.H2B + (size_t)t * 1024 + lane * 16 + 8);
      const unsigned hw[8] = {ha.x, ha.y, ha.z, ha.w, hb.x, hb.y, hb.z, hb.w}; u32x4 q;
#pragma unroll
      for (int i = 0; i < 4; ++i) { const float4 g = *(const float4*)(p.norm_peer_g + lane * 16 + 4 * i); int wd = 0;
        wd = __builtin_amdgcn_cvt_pk_fp8_f32(__uint_as_float(hw[2 * i] << 16) * rs * g.x, __uint_as_float(hw[2 * i] & 0xffff0000u) * rs * g.y, wd, false);
        wd = __builtin_amdgcn_cvt_pk_fp8_f32(__uint_as_float(hw[2 * i + 1] << 16) * rs * g.z, __uint_as_float(hw[2 * i + 1] & 0xffff0000u) * rs * g.w, wd, true); q[i] = (unsigned)wd; }
      *(LAS u32x4*)(HQ + tl_ * 1024 + lane * 16) = q; }
    f32x2 oa[8];
#pragma unroll
    for (int i = 0; i < 8; ++i) oa[i] = (f32x2){0.f, 0.f};
    for (int bt = 0; bt < 8; ++bt) {
      const LAS int* LEb = LE + tl_ * 128 + bt * 16; const LAS float* LGb = LG + tl_ * 128 + bt * 16;
      const int er = LEb[fr];
      typedef int i32x8 __attribute__((ext_vector_type(8)));
      u32x4 uq[8]; uint2 vqa[8], vqb[8];
      const unsigned char* ub = p.PU8 + (size_t)er * 512 + fq * 16;
#pragma unroll
      for (int ks = 0; ks < 8; ++ks) uq[ks] = *(const u32x4*)(ub + ks * 64);
#pragma unroll
      for (int x = 0; x < 8; ++x) { const int ex = __builtin_amdgcn_readlane(er, x); vqa[x] = *(const uint2*)(p.PV8 + (size_t)ex * 512 + lane * 8); }
#pragma unroll
      for (int x = 0; x < 8; ++x) { const int ex = __builtin_amdgcn_readlane(er, 8 + x); vqb[x] = *(const uint2*)(p.PV8 + (size_t)ex * 512 + lane * 8); }
      int e4[4]; float g4[4], su4[4], sv4[4];
#pragma unroll
      for (int j = 0; j < 4; ++j) { e4[j] = LEb[fq * 4 + j]; g4[j] = LGb[fq * 4 + j]; su4[j] = p.su[e4[j]]; sv4[j] = p.sv[e4[j]]; }
      f32x4 acc = (f32x4){0.f, 0.f, 0.f, 0.f};
#pragma unroll
      for (int ks = 0; ks < 8; ++ks) { const u32x4 h0 = *(const LAS u32x4*)(HQ + tl_ * 1024 + ks * 128 + fq * 16), h1 = *(const LAS u32x4*)(HQ + tl_ * 1024 + ks * 128 + 64 + fq * 16);
        i32x8 A, B; A[0] = (int)uq[ks].x; A[1] = (int)uq[ks].y; A[2] = (int)uq[ks].z; A[3] = (int)uq[ks].w; A[4] = 0; A[5] = 0; A[6] = 0; A[7] = 0;
        B[0] = (int)h0.x; B[1] = (int)h0.y; B[2] = (int)h0.z; B[3] = (int)h0.w; B[4] = (int)h1.x; B[5] = (int)h1.y; B[6] = (int)h1.z; B[7] = (int)h1.w;
        acc = __builtin_amdgcn_mfma_scale_f32_16x16x128_f8f6f4(A, B, acc, 4  , 0  , 0, 0x7f7f7f7f, 0, 0x7f7f7f7f); }
      float wg[4];
#pragma unroll
      for (int j = 0; j < 4; ++j) wg[j] = g4[j] * gelu_f(acc[j] * su4[j] * 0.0625f) * sv4[j];
#define PEER_V(VQ, X0) { _Pragma("unroll") for (int x = 0; x < 8; ++x) { const float wgt = __int_as_float(__builtin_amdgcn_readlane(__float_as_int(wg[((X0) + x) & 3]), (((X0) + x) >> 2) * 16)); \
        oa[0] += __builtin_amdgcn_cvt_scalef32_pk_f32_fp4(VQ[x].x, 1.0f, 0) * wgt; oa[1] += __builtin_amdgcn_cvt_scalef32_pk_f32_fp4(VQ[x].x, 1.0f, 1) * wgt; \
        oa[2] += __builtin_amdgcn_cvt_scalef32_pk_f32_fp4(VQ[x].x, 1.0f, 2) * wgt; oa[3] += __builtin_amdgcn_cvt_scalef32_pk_f32_fp4(VQ[x].x, 1.0f, 3) * wgt; \
        oa[4] += __builtin_amdgcn_cvt_scalef32_pk_f32_fp4(VQ[x].y, 1.0f, 0) * wgt; oa[5] += __builtin_amdgcn_cvt_scalef32_pk_f32_fp4(VQ[x].y, 1.0f, 1) * wgt; \
        oa[6] += __builtin_amdgcn_cvt_scalef32_pk_f32_fp4(VQ[x].y, 1.0f, 2) * wgt; oa[7] += __builtin_amdgcn_cvt_scalef32_pk_f32_fp4(VQ[x].y, 1.0f, 3) * wgt; } }
      PEER_V(vqa, 0)
      PEER_V(vqb, 8)
    }
    { const uint4 ha = *(const uint4*)(p.H2B + (size_t)t * 1024 + lane * 16), hb = *(const uint4*)(p.H2B + (size_t)t * 1024 + lane * 16 + 8);
      const unsigned hw[8] = {ha.x, ha.y, ha.z, ha.w, hb.x, hb.y, hb.z, hb.w};
      float* op = p.out + (size_t)t * 1024 + lane * 16;
#pragma unroll
      for (int i = 0; i < 4; ++i) { const f32x2 a = oa[2 * i], b = oa[2 * i + 1];
        *(float4*)(op + 4 * i) = make_float4(__uint_as_float(hw[2 * i] << 16) + a.x, __uint_as_float(hw[2 * i] & 0xffff0000u) + a.y, __uint_as_float(hw[2 * i + 1] << 16) + b.x, __uint_as_float(hw[2 * i + 1] & 0xffff0000u) + b.y); } }
  }
}

template <int PH>
__device__ __forceinline__ void run_phase(const Params& p, char* lds, int bid, int nb) {
  if (PH == 0) {
    const int nt_in = 16 * 32, nt_glu = 8 * 8, nt_out = 16 * 16, nt_m = 16 * 16, nt_pq = 16 * 32;
    const int total = nt_in + nt_glu + nt_out + 4 * nt_m + nt_pq;
    for (int t = bid; t < total; t += nb) {
      int i = t; float* tl = (float*)lds;
      if (i < nt_in) { transpose_tile(p.w_in, p.WtIn, 1024, 2048, i, p.norm_mix_g, p.norm_mix_g, 1024, tl); continue; } i -= nt_in;
      if (i < nt_glu) { transpose_tile(p.w_glu, p.WtGlu, 512, 512, i, nullptr, nullptr, 0, tl); continue; } i -= nt_glu;
      if (i < nt_out) { transpose_tile(p.w_out, p.WtOut, 1024, 1024, i, p.att_out_g, p.ssm_out_g, 512, tl); continue; } i -= nt_out;
      if (i < nt_m) { transpose_tile(p.w_mem_q, p.WtMq, 1024, 1024, i, p.norm_mem_g, p.norm_mem_g, 1024, tl); continue; } i -= nt_m;
      if (i < nt_m) { transpose_tile(p.w_mem_k, p.WtMk, 1024, 1024, i, p.norm_memkv_g, p.norm_memkv_g, 1024, tl); continue; } i -= nt_m;
      if (i < nt_m) { transpose_tile(p.w_mem_v, p.WtMv, 1024, 1024, i, p.norm_memkv_g, p.norm_memkv_g, 1024, tl); continue; } i -= nt_m;
      if (i < nt_m) { transpose_tile(p.w_mem_o, p.WtMo, 1024, 1024, i, nullptr, nullptr, 0, tl); continue; } i -= nt_m;
      transpose_tile(p.w_peer_q, p.WtPq, 1024, 2048, i, p.norm_peer_g, p.norm_peer_g, 1024, tl);
    }
    convert_flat(p.peer_keys, p.PK, (size_t)16 * 128 * 128 / 8, bid, nb);
    rows_fp4<false>(p.peer_u, p.PU8, p.su, 16384, bid, nb);
    rows_fp4<false>(p.peer_v, p.PV8, p.sv, 16384, bid, nb);
    rows_bf16_rs(p.x, p.XB, p.rs_x, T_TOK, bid, nb);
    rows_bf16_rs(p.mem, p.MEMB, p.rs_mem, 512, bid, nb);
    for (int i = bid * NTHREADS + threadIdx.x; i < 2048; i += nb * NTHREADS) ssm_stage1(p, i);
  } else if (PH == 1) {
    for (int t = bid; t < 2048; t += nb) { if (((t & 15) >> 2) == 2) tile_win_v(p, t, lds); else tile_win(p, t, lds); }
    ssm_stage2a(p, bid, nb);
  } else if (PH == 2) {
    for (int t = nb - 1 - bid; t < 64; t += nb) tile_memkv(p, t, lds);
    for (int t = bid; t < 2048; t += nb) chunk_attn_item(p, t, lds);
    for (int t = bid; t < 2048; t += nb) ssm_item<false>(p, t, lds);
    ssm_stage2b(p, bid, nb);
  } else if (PH == 3) {
    memk_fix(p, bid, nb);
    for (int t = bid; t < 2048; t += nb) ssm_item<true>(p, t, lds);
  } else if (PH == 4) {
    for (int t = bid; t < 512; t += nb) tile_glu(p, t, lds);
  } else if (PH == 5) {
    for (int t = bid; t < 1024; t += nb) tile_wout(p, t, lds);
  } else if (PH == 6) {
    for (int t = bid; t < 1024; t += nb) tile_memq(p, t, lds);
  } else if (PH == 7) {
    for (int t = bid; t < 1024; t += nb) mem_attn_item(p, t, lds);
  } else if (PH == 8) {
    for (int t = bid; t < 1024; t += nb) tile_memo(p, t, lds);
  } else if (PH == 9) {
    for (int t = bid; t < 2048; t += nb) tile_peer(p, t, lds);
  } else if (PH == 11) {
    for (int t = bid; t < 512; t += nb) peer_gather_item(p, t, lds);
  }
}

#if !MEGA
template <int PH>
__global__ void __launch_bounds__(NTHREADS, 2) phase_kernel(Params p) {
  extern __shared__ __attribute__((aligned(16))) char lds[];
  run_phase<PH>(p, lds, blockIdx.x, gridDim.x);
}

#endif
#ifndef REPEAT_PH
#define REPEAT_PH -1
#endif
#define RUNPH(k) do { run_phase<k>(p, lds, bid, nb); if (REPEAT_PH == k) { xcd_barrier(xb); run_phase<k>(p, lds, bid, nb); } } while (0)
__global__ void __launch_bounds__(NTHREADS, 2) mega_kernel(Params p) {
  extern __shared__ __attribute__((aligned(16))) char lds[];
  const int bid = blockIdx.x, nb = gridDim.x;
  volatile LAS unsigned* stw = (volatile LAS unsigned*)((LAS char*)lds + LDS_WORK);
  if (threadIdx.x == 0) { stw[0] = 0u; stw[1] = 0u; stw[2] = 0u; stw[3] = 0u; }
  __syncthreads();
  XcdBarrier xb = xcd_barrier_post(p.bar, stw);
  RUNPH(0); xcd_barrier(xb);
  RUNPH(1); xcd_barrier(xb);
  RUNPH(2); xcd_barrier(xb);
  RUNPH(3); xcd_barrier(xb);
  RUNPH(4); xcd_barrier(xb);
  RUNPH(5); xcd_barrier(xb);
  RUNPH(6); xcd_barrier(xb);
  RUNPH(7); xcd_barrier(xb);
  RUNPH(8); xcd_barrier(xb);
  RUNPH(9); xcd_barrier(xb);
  RUNPH(11);
}

#if !MEGA
template <int PH> static void launch_phase(const Params& p, int grid, hipStream_t s) {
  hipFuncSetAttribute((const void*)phase_kernel<PH>, hipFuncAttributeMaxDynamicSharedMemorySize, LDS_BYTES);
  phase_kernel<PH><<<grid, NTHREADS, LDS_BYTES, s>>>(p);
}
#endif

extern "C" void kernel_launch(void* const* d_in, const int* in_sizes, int n_in, void* d_out, int out_size, void* d_ws, size_t ws_size, hipStream_t stream) {
  Params p{};
  const float** f = (const float**)&p;
  for (int i = 0; i < 33; ++i) f[i] = (const float*)d_in[i];
  p.out = (float*)d_out;
  char* ws = (char*)d_ws; size_t off = 0;
  auto take = [&](size_t bytes) { char* r = ws + off; off += (bytes + 255) & ~(size_t)255; return r; };
  const size_t MB = 1u << 20;
  p.bar = (unsigned*)take(16384);
  p.WtIn = (bf16_t*)take(4 * MB); p.WtGlu = (bf16_t*)take(MB / 2); p.WtOut = (bf16_t*)take(2 * MB);
  p.WtMq = (bf16_t*)take(2 * MB); p.WtMk = (bf16_t*)take(2 * MB); p.WtMv = (bf16_t*)take(2 * MB); p.WtMo = (bf16_t*)take(2 * MB); p.WtPq = (bf16_t*)take(4 * MB);
  p.PK = (bf16_t*)take(MB / 2); p.PU8 = (unsigned char*)take(8 * MB); p.PV8 = (unsigned char*)take(8 * MB); p.su = (float*)take(16384 * 4); p.sv = (float*)take(16384 * 4);
  char* RA = take(64 * MB); char* RB = take(64 * MB);
  p.XB = (bf16_t*)RA; p.ATT = (bf16_t*)RA; p.YG = (bf16_t*)(RA + 16 * MB); p.QM = (bf16_t*)RA; p.H2B = (bf16_t*)RA;
  p.SSMO = (bf16_t*)(RA + 32 * MB); p.OM = (bf16_t*)(RA + 32 * MB);
  p.Qb = (bf16_t*)RB; p.Kb = (bf16_t*)(RB + 16 * MB); p.VT = (bf16_t*)(RB + 32 * MB); p.Ub = (bf16_t*)(RB + 48 * MB); p.H1B = (bf16_t*)RB; p.QP = (bf16_t*)RB;
  p.TOPS = (unsigned*)take(16 * MB);
  p.MEMB = (bf16_t*)take(MB); p.KMB = (bf16_t*)take(MB); p.VMT = (bf16_t*)take(MB); p.KMraw = (float*)take(2 * MB);
  p.WE16 = (bf16_t*)take(2 * MB); p.WY = (bf16_t*)take(6 * MB);
  p.rs_x = (float*)take(T_TOK * 4); p.rs_mem = (float*)take(512 * 4); p.ss_att = (float*)take(T_TOK * 8 * 4); p.ss_ssm = (float*)take(T_TOK * 8 * 4);
  p.ss_h1 = (float*)take(T_TOK * 16 * 4); p.ss_qm = (float*)take(T_TOK * 16 * 4); p.ss_km = (float*)take(512 * 16 * 4); p.ss_h2 = (float*)take(T_TOK * 16 * 4);
  p.ESEG = (float*)take(2 * 32 * 32 * 128 * 4);
  p.BBR = (float*)take(2048 * 16 * 4); p.BBI = (float*)take(2048 * 16 * 4); p.PWR = (float*)take(32 * 17 * 64 * 4); p.PWI = (float*)take(32 * 17 * 64 * 4); p.KJ = (float*)take(32 * 16 * 256 * 4); p.APW = (float*)take(5 * 4096 * 4);
  if (off > ws_size) { fprintf(stderr, "workspace too small: need %zu have %zu\n", off, ws_size); return; }
#if MEGA
  hipMemsetAsync(p.bar, 0, 16384, stream);
  static int grid_blocks = 0;
  if (!grid_blocks) {
    int dev = 0, cus = 0, per_cu = 0; hipGetDevice(&dev); hipDeviceGetAttribute(&cus, hipDeviceAttributeMultiprocessorCount, dev);
    hipFuncSetAttribute((const void*)mega_kernel, hipFuncAttributeMaxDynamicSharedMemorySize, LDS_BYTES);
    hipOccupancyMaxActiveBlocksPerMultiprocessor(&per_cu, mega_kernel, NTHREADS, LDS_BYTES);
    if (per_cu > 2) per_cu = 2; if (per_cu < 1) per_cu = 1;
    grid_blocks = cus * per_cu;
  }
  void* args[] = {&p};
  hipError_t e = hipLaunchCooperativeKernel((void*)mega_kernel, dim3(grid_blocks), dim3(NTHREADS), args, LDS_BYTES, stream);
  if (e != hipSuccess) fprintf(stderr, "cooperative launch failed: %s (grid %d)\n", hipGetErrorString(e), grid_blocks);
#else
  const int G = 1024;
  launch_phase<0>(p, G, stream); launch_phase<1>(p, G, stream); launch_phase<2>(p, G, stream); launch_phase<3>(p, G, stream);
  launch_phase<4>(p, G, stream); launch_phase<5>(p, G, stream); launch_phase<6>(p, G, stream); launch_phase<7>(p, G, stream);
  launch_phase<8>(p, G, stream); launch_phase<9>(p, G, stream); launch_phase<11>(p, G, stream);
#endif
}
```

```cpp
#include <hip/hip_runtime.h>
#include <hip/hip_cooperative_groups.h>
#include <cstdio>
#include <cstdint>
namespace cg = cooperative_groups;

#ifndef MEGA
#define MEGA 1
#endif

typedef unsigned short bf16_t;
typedef short bf16x8 __attribute__((ext_vector_type(8)));
typedef float f32x4 __attribute__((ext_vector_type(4)));
typedef unsigned u32x4 __attribute__((ext_vector_type(4)));
#define LAS __attribute__((address_space(3)))
__device__ __forceinline__ bf16x8 as_bf(u32x4 v) { return __builtin_bit_cast(bf16x8, v); }

#define T_TOK 16384
#define SEQL 8192
#define NTHREADS 256
#define LDS_WORK 74752
#define LDS_BYTES (LDS_WORK + 16)
#define EPSF 1e-6f

typedef float f32x2_ __attribute__((ext_vector_type(2)));
typedef __bf16 bf16x2v __attribute__((ext_vector_type(2)));
__device__ __forceinline__ unsigned pack2(float lo, float hi) { f32x2_ v = {lo, hi}; bf16x2v b = __builtin_convertvector(v, bf16x2v); return __builtin_bit_cast(unsigned, b); }
__device__ __forceinline__ unsigned short f2bf(float f) { return (unsigned short)(pack2(f, 0.f) & 0xffffu); }
__device__ __forceinline__ float bf2f(unsigned short b) { return __uint_as_float(((unsigned)b) << 16); }
__device__ __forceinline__ float gelu_f(float v) {
  const float av = fabsf(v), t = __builtin_amdgcn_rcpf(av * 0.2316418882f + 1.0f);
  float q = t * 0.5307027145f + (-0.7265760135f); q = q * t + 0.7107068705f; q = q * t + (-0.142248368f); q = q * t + 0.127414796f; q = q * t;
  const float e = __builtin_amdgcn_exp2f((v * v) * (-0.72134752044f)); const float m = v * (q * e);
  return v < 0.f ? m : v - m; }
typedef float f32x2 __attribute__((ext_vector_type(2)));
__device__ __forceinline__ f32x4 mfma16(bf16x8 a, bf16x8 b, f32x4 c) { return __builtin_amdgcn_mfma_f32_16x16x32_bf16(a, b, c, 0, 0, 0); }


#define XB_TMO      128
#define XB_XCNT(j)  (256  + 64 * (j))
#define XB_XSUB(j)  (1280 + 64 * (j))
#define XB_XGEN(j)  (2304 + 64 * (j))
#define XB_TOP      3328
#define XB_TOPGEN   3392
#define XCD_BAR_WORDS 3456
#define XB_SPIN_CAP (1u << 18)
__device__ __forceinline__ unsigned xb_ld(unsigned* p)              { return __hip_atomic_load(p, __ATOMIC_RELAXED, __HIP_MEMORY_SCOPE_AGENT); }
__device__ __forceinline__ unsigned xb_add(unsigned* p, unsigned v) { return __hip_atomic_fetch_add(p, v, __ATOMIC_RELAXED, __HIP_MEMORY_SCOPE_AGENT); }
__device__ __forceinline__ unsigned xb_xcc_id() { return (unsigned)__builtin_amdgcn_s_getreg((3 << 11) | 20) & 0xFu; }
#define XB_SPIN(cond, bar) do { unsigned _sp = 0; while (cond) { __builtin_amdgcn_s_sleep(1); \
    if ((++_sp & 255u) == 0u) { if (xb_ld(&(bar)[XB_TMO])) break; if (_sp > XB_SPIN_CAP) { atomicAdd(&(bar)[XB_TMO], 1u); break; } } } } while (0)
struct XcdBarrier { unsigned* bar; unsigned x; volatile LAS unsigned* st; };
__device__ __forceinline__ XcdBarrier xcd_barrier_post(unsigned* bar, volatile LAS unsigned* st) {
  XcdBarrier b; b.bar = bar; b.x = xb_xcc_id(); b.st = st;
  if (threadIdx.x == 0) (void)xb_add(&bar[XB_XCNT(b.x)], 1u);
  return b;
}
__device__ __forceinline__ void xcd_barrier_complete(unsigned* bar, unsigned x, unsigned& nloc, unsigned& nx) {
  const unsigned G = gridDim.x * gridDim.y * gridDim.z;
  unsigned sum, cnt, mine, sp = 0u;
  for (;;) {
    sum = 0u; cnt = 0u; mine = 0u;
#pragma unroll
    for (unsigned j = 0; j < 16; ++j) { const unsigned c = xb_ld(&bar[XB_XCNT(j)]); sum += c; cnt += (c > 0u) ? 1u : 0u; mine = (j == x) ? c : mine; }
    if (sum == G) break;
    __builtin_amdgcn_s_sleep(1);
    if ((++sp & 255u) == 0u) { if (xb_ld(&bar[XB_TMO])) break; if (sp > XB_SPIN_CAP) { atomicAdd(&bar[XB_TMO], 1u); break; } }
  }
  nloc = mine > 0u ? mine : 1u; nx = cnt > 0u ? cnt : 1u;
}
__device__ __forceinline__ void xcd_barrier(const XcdBarrier& b) {
  asm volatile("s_waitcnt vmcnt(0)" ::: "memory");
  __syncthreads();
  if (threadIdx.x == 0) {
    unsigned* bar = b.bar;
    __builtin_amdgcn_s_waitcnt(0);
    unsigned nloc = b.st[0], nx = b.st[1];
    if (nloc == 0u) { xcd_barrier_complete(bar, b.x, nloc, nx); b.st[0] = nloc; b.st[1] = nx; }
    const unsigned old = xb_add(&bar[XB_XSUB(b.x)], 1u);
    const unsigned gen = old / nloc;
    if (old + 1u == (gen + 1u) * nloc) {
      __builtin_amdgcn_fence(__ATOMIC_RELEASE, "agent");
      asm volatile("s_waitcnt vmcnt(0)" ::: "memory");
      const unsigned og = xb_add(&bar[XB_TOP], 1u);
      const unsigned tg = og / nx;
      if (og + 1u == (tg + 1u) * nx) xb_add(&bar[XB_TOPGEN], 1u);
      else XB_SPIN(xb_ld(&bar[XB_TOPGEN]) == tg, bar);
      __builtin_amdgcn_fence(__ATOMIC_ACQUIRE, "agent");
      xb_add(&bar[XB_XGEN(b.x)], 1u);
      asm volatile("s_waitcnt vmcnt(0)" ::: "memory");
    } else {
      XB_SPIN(xb_ld(&bar[XB_XGEN(b.x)]) == gen, bar);
      __builtin_amdgcn_fence(__ATOMIC_ACQUIRE, "agent");
      asm volatile("s_waitcnt vmcnt(0)" ::: "memory");
    }
  }
  __syncthreads();
}

struct Params {
  const float *x, *mem, *norm_mix_g, *w_in, *att_q_g, *att_k_g, *rel_bias;
  const float *lam_re, *lam_im, *log_step, *b_re, *b_im, *c_re, *c_im, *d_skip, *w_glu, *b_glu;
  const float *att_out_g, *ssm_out_g, *w_out, *norm_mem_g, *norm_memkv_g, *w_mem_q, *w_mem_k, *w_mem_v;
  const float *mem_q_g, *mem_k_g, *w_mem_o, *norm_peer_g, *w_peer_q, *peer_keys, *peer_u, *peer_v;
  float* out;
  unsigned* bar;
  bf16_t *WtIn, *WtGlu, *WtOut, *WtMq, *WtMk, *WtMv, *WtMo, *WtPq, *PK, *PU, *PV;
  bf16_t *XB, *MEMB, *Qb, *Kb, *VT, *Ub, *ATT, *YG, *SSMO, *H1B, *QM, *OM, *H2B, *QP;
  bf16_t *KMB, *VMT, *WE16, *WY;
  float *rs_x, *rs_mem, *ss_att, *ss_ssm, *ss_h1, *ss_qm, *ss_km, *ss_h2, *KMraw, *ESEG;
  float *BBR, *BBI, *PWR, *PWI, *KJ, *APW, *SHF;
  unsigned* TOPS;
  unsigned char *PU8, *PV8; float *su, *sv;
};

#define GAS __attribute__((address_space(1)))
#define RAW_BARRIER() do { asm volatile("s_waitcnt lgkmcnt(0)" ::: "memory"); __builtin_amdgcn_s_barrier(); } while (0)
__device__ __forceinline__ void glds16(const void* gsrc, unsigned lds_dst) {
  unsigned keep;
  asm volatile("s_mov_b32 %0, m0\n\ts_mov_b32 m0, %2\n\ts_nop 0\n\tglobal_load_lds_dwordx4 %1, off\n\ts_mov_b32 m0, %0" : "=&s"(keep) : "v"(gsrc), "s"(lds_dst) : "memory");
}
template <bool ZERO = true, bool SWAP = false>
__device__ __forceinline__ void gemm_mainloop(f32x4 (&acc)[4][4], const bf16_t* __restrict__ A, int lda, const bf16_t* __restrict__ Bt, int ldb, int K,
                                              int row0, int col0, char* lds_) {
  LAS char* lds = (LAS char*)lds_;
  const int tid = threadIdx.x, lane = tid & 63, w = tid >> 6, wr = w >> 1, wc = w & 1, fr = lane & 15, fq = lane >> 4;
  if (ZERO) {
#pragma unroll
    for (int m = 0; m < 4; ++m)
#pragma unroll
      for (int n = 0; n < 4; ++n) acc[m][n] = (f32x4){0.f, 0.f, 0.f, 0.f};
  }
  const int lr = lane >> 3, lc = (lane & 7) ^ lr;
  const bf16_t* gA = A + (size_t)(row0 + w * 32 + lr) * lda + lc * 8;
  const bf16_t* gB = Bt + (size_t)(col0 + w * 32 + lr) * ldb + lc * 8;
  const int wbase = __builtin_amdgcn_readfirstlane(w) * 4096;
  const int nk = K >> 6;
  __syncthreads();
#pragma unroll
  for (int i = 0; i < 4; ++i) {
    __builtin_amdgcn_global_load_lds((const GAS void*)(gA + (size_t)(i * 8) * lda), (LAS void*)(lds + wbase + i * 1024), 16, 0, 0);
    __builtin_amdgcn_global_load_lds((const GAS void*)(gB + (size_t)(i * 8) * ldb), (LAS void*)(lds + 16384 + wbase + i * 1024), 16, 0, 0);
  }
  asm volatile("s_waitcnt vmcnt(0)" ::: "memory");
  __syncthreads();
  for (int kt = 0; kt < nk; ++kt) {
    LAS char* cur = lds + (kt & 1) * 32768; LAS char* nxt = lds + ((kt + 1) & 1) * 32768;
    if (kt + 1 < nk) {
      const int k1 = (kt + 1) << 6;
#pragma unroll
      for (int i = 0; i < 4; ++i) {
        __builtin_amdgcn_global_load_lds((const GAS void*)(gA + (size_t)(i * 8) * lda + k1), (LAS void*)(nxt + wbase + i * 1024), 16, 0, 0);
        __builtin_amdgcn_global_load_lds((const GAS void*)(gB + (size_t)(i * 8) * ldb + k1), (LAS void*)(nxt + 16384 + wbase + i * 1024), 16, 0, 0);
      }
    }
#pragma unroll
    for (int ks = 0; ks < 2; ++ks) {
      bf16x8 af[4], bfr[4];
      const int kc = ks * 4 + fq;
#pragma unroll
      for (int m = 0; m < 4; ++m) { const int r = wr * 64 + m * 16 + fr; af[m] = as_bf(*(const LAS u32x4*)(cur + r * 128 + ((kc ^ (r & 7)) << 4))); }
#pragma unroll
      for (int n = 0; n < 4; ++n) { const int r = wc * 64 + n * 16 + fr; bfr[n] = as_bf(*(const LAS u32x4*)(cur + 16384 + r * 128 + ((kc ^ (r & 7)) << 4))); }
#pragma unroll
      for (int m = 0; m < 4; ++m)
#pragma unroll
        for (int n = 0; n < 4; ++n) acc[m][n] = SWAP ? mfma16(af[m], bfr[n], acc[m][n]) : mfma16(bfr[n], af[m], acc[m][n]);
    }
    asm volatile("s_waitcnt vmcnt(0)" ::: "memory");
    __syncthreads();
  }
}

__device__ void transpose_tile(const float* __restrict__ src, bf16_t* __restrict__ dst, int K, int N, int tile, const float* g0, const float* g1, int split, float* tl  ) {
  const int ntn = N >> 6; const int tk = tile / ntn, tn = tile % ntn; const int k0 = tk << 6, n0 = tn << 6; const int tid = threadIdx.x;
  __syncthreads();
#pragma unroll
  for (int i = 0; i < 4; ++i) { const int kk = i * 16 + (tid >> 4), nn = (tid & 15) * 4; const int k = k0 + kk;
    float g = 1.f; if (g0) g = (k < split) ? g0[k] : g1[k - split];
    const float4 v = *(const float4*)(src + (size_t)k * N + n0 + nn);
    tl[kk * 65 + nn] = v.x * g; tl[kk * 65 + nn + 1] = v.y * g; tl[kk * 65 + nn + 2] = v.z * g; tl[kk * 65 + nn + 3] = v.w * g; }
  __syncthreads();
  const int n = tid >> 2, kq = (tid & 3) * 16;
  unsigned o[8];
#pragma unroll
  for (int j = 0; j < 8; ++j) o[j] = pack2(tl[(kq + 2 * j) * 65 + n], tl[(kq + 2 * j + 1) * 65 + n]);
  uint4* d = (uint4*)(dst + (size_t)(n0 + n) * K + k0 + kq);
  d[0] = make_uint4(o[0], o[1], o[2], o[3]); d[1] = make_uint4(o[4], o[5], o[6], o[7]);
}

__device__ void convert_flat(const float* __restrict__ src, bf16_t* __restrict__ dst, size_t n8  , int bid, int nb) {
  for (size_t i = (size_t)bid * NTHREADS + threadIdx.x; i < n8; i += (size_t)nb * NTHREADS) {
    const float4 a = ((const float4*)src)[2 * i], b = ((const float4*)src)[2 * i + 1];
    ((uint4*)dst)[i] = make_uint4(pack2(a.x, a.y), pack2(a.z, a.w), pack2(b.x, b.y), pack2(b.z, b.w));
  }
}
__device__ void rows_bf16_rs(const float* __restrict__ src, bf16_t* __restrict__ dst, float* __restrict__ rs, int nrows, int bid, int nb) {
  const int lane = threadIdx.x & 63, w = threadIdx.x >> 6; const int nwv = nb * 4;
  for (int row0 = bid * 4 + w; row0 < nrows; row0 += nwv * 4) {
    float4 v[4][4];
#pragma unroll
    for (int r = 0; r < 4; ++r) { const int row = row0 + r * nwv; if (row < nrows) { const float4* s = (const float4*)(src + (size_t)row * 1024);
#pragma unroll
        for (int i = 0; i < 4; ++i) v[r][i] = s[i * 64 + lane]; } }
#pragma unroll
    for (int r = 0; r < 4; ++r) { const int row = row0 + r * nwv; if (row < nrows) {
      float ss = 0.f; uint2* d = (uint2*)(dst + (size_t)row * 1024);
#pragma unroll
      for (int i = 0; i < 4; ++i) { const float4 x = v[r][i]; ss += x.x * x.x + x.y * x.y + x.z * x.z + x.w * x.w; d[i * 64 + lane] = make_uint2(pack2(x.x, x.y), pack2(x.z, x.w)); }
#pragma unroll
      for (int o = 32; o > 0; o >>= 1) ss += __shfl_xor(ss, o);
      if (lane == 0) rs[row] = rsqrtf(ss * (1.0f / 1024.0f) + EPSF); } }
  }
}
__device__ void rows_fp8(const float* __restrict__ src, unsigned char* __restrict__ dst, float* __restrict__ sc, int nrows, int bid, int nb) {
  const int lane = threadIdx.x & 63, w = threadIdx.x >> 6;
  for (int row = bid * 4 + w; row < nrows; row += nb * 4) {
    const float4* s = (const float4*)(src + (size_t)row * 1024);
    float4 v[4]; float am = 0.f;
#pragma unroll
    for (int i = 0; i < 4; ++i) { v[i] = s[i * 64 + lane]; am = fmaxf(am, fmaxf(fmaxf(fabsf(v[i].x), fabsf(v[i].y)), fmaxf(fabsf(v[i].z), fabsf(v[i].w)))); }
#pragma unroll
    for (int o = 32; o > 0; o >>= 1) am = fmaxf(am, __shfl_xor(am, o));
    const float q = (am > 0.f) ? 224.0f / am : 1.0f;
    unsigned* d = (unsigned*)(dst + (size_t)row * 1024);
#pragma unroll
    for (int i = 0; i < 4; ++i) { int wd = 0; wd = __builtin_amdgcn_cvt_pk_fp8_f32(v[i].x * q, v[i].y * q, wd, false); wd = __builtin_amdgcn_cvt_pk_fp8_f32(v[i].z * q, v[i].w * q, wd, true); d[i * 64 + lane] = (unsigned)wd; }
    if (lane == 0) sc[row] = (am > 0.f) ? am * (1.0f / 224.0f) : 1.0f;
  }
}

template <bool SWAPN>
__device__ void rows_fp4(const float* __restrict__ src, unsigned char* __restrict__ dst, float* __restrict__ sc, int nrows, int bid, int nb) {
  const int lane = threadIdx.x & 63, w = threadIdx.x >> 6; const int nwv = nb * 4;
  for (int row0 = bid * 4 + w; row0 < nrows; row0 += nwv * 4) {
    float4 v[4][4];
#pragma unroll
    for (int r = 0; r < 4; ++r) { const int row = row0 + r * nwv; if (row < nrows) { const float4* s = (const float4*)(src + (size_t)row * 1024 + lane * 16);
#pragma unroll
        for (int i = 0; i < 4; ++i) v[r][i] = s[i]; } }
#pragma unroll
    for (int r = 0; r < 4; ++r) { const int row = row0 + r * nwv; if (row < nrows) {
      float am = 0.f;
#pragma unroll
      for (int i = 0; i < 4; ++i) am = fmaxf(am, fmaxf(fmaxf(fabsf(v[r][i].x), fabsf(v[r][i].y)), fmaxf(fabsf(v[r][i].z), fabsf(v[r][i].w))));
#pragma unroll
      for (int o = 32; o > 0; o >>= 1) am = fmaxf(am, __shfl_xor(am, o));
      const float q = (am > 0.f) ? 6.0f / am : 1.0f;
      unsigned w0 = 0, w1 = 0;
      w0 = __builtin_amdgcn_cvt_scalef32_pk_fp4_f32(w0, v[r][0].x * q, v[r][0].y * q, 1.0f, 0); w0 = __builtin_amdgcn_cvt_scalef32_pk_fp4_f32(w0, v[r][0].z * q, v[r][0].w * q, 1.0f, 1);
      w0 = __builtin_amdgcn_cvt_scalef32_pk_fp4_f32(w0, v[r][1].x * q, v[r][1].y * q, 1.0f, 2); w0 = __builtin_amdgcn_cvt_scalef32_pk_fp4_f32(w0, v[r][1].z * q, v[r][1].w * q, 1.0f, 3);
      w1 = __builtin_amdgcn_cvt_scalef32_pk_fp4_f32(w1, v[r][2].x * q, v[r][2].y * q, 1.0f, 0); w1 = __builtin_amdgcn_cvt_scalef32_pk_fp4_f32(w1, v[r][2].z * q, v[r][2].w * q, 1.0f, 1);
      w1 = __builtin_amdgcn_cvt_scalef32_pk_fp4_f32(w1, v[r][3].x * q, v[r][3].y * q, 1.0f, 2); w1 = __builtin_amdgcn_cvt_scalef32_pk_fp4_f32(w1, v[r][3].z * q, v[r][3].w * q, 1.0f, 3);
      *(uint2*)(dst + (size_t)row * 512 + lane * 8) = make_uint2(w0, w1);
      if (lane == 0) sc[row] = (am > 0.f) ? am * (1.0f / 6.0f) : 1.0f; } }
  }
}

__device__ void ssm_stage1(const Params& p, int gp) {
  const int g = gp >> 6;
  const float step = expf(p.log_step[g]); const float lr = p.lam_re[gp], li = p.lam_im[gp];
  const float mag = expf(lr * step); const float ar = mag * cosf(li * step), ai = mag * sinf(li * step);
  const float zr = ar - 1.0f, den = lr * lr + li * li; const float fr = (zr * lr + ai * li) / den, fi = (ai * lr - zr * li) / den;
  for (int c = 0; c < 16; ++c) { const float br = p.b_re[gp * 16 + c], bi = p.b_im[gp * 16 + c]; p.BBR[gp * 16 + c] = fr * br - fi * bi; p.BBI[gp * 16 + c] = fr * bi + fi * br; }
  float pr = 1.f, pi = 0.f; const int st = gp & 63;
  for (int j = 0; j <= 16; ++j) { p.PWR[(g * 17 + j) * 64 + st] = pr; p.PWI[(g * 17 + j) * 64 + st] = pi; const float nr = pr * ar - pi * ai, ni = pr * ai + pi * ar; if (j < 16) { pr = nr; pi = ni; } }
  const float a16r = pr, a16i = pi; const float a32r = a16r * a16r - a16i * a16i, a32i = 2.f * a16r * a16i;
  const float a48r = a32r * a16r - a32i * a16i, a48i = a32r * a16i + a32i * a16r; const float a64r = a32r * a32r - a32i * a32i, a64i = 2.f * a32r * a32i;
  const float a128r = a64r * a64r - a64i * a64i, a128i = 2.f * a64r * a64i; const float a256r = a128r * a128r - a128i * a128i, a256i = 2.f * a128r * a128i;
  float* A = p.APW;
  A[0 * 4096 + gp] = a16r; A[0 * 4096 + 2048 + gp] = a16i; A[1 * 4096 + gp] = a32r; A[1 * 4096 + 2048 + gp] = a32i; A[2 * 4096 + gp] = a48r; A[2 * 4096 + 2048 + gp] = a48i;
  A[3 * 4096 + gp] = a64r; A[3 * 4096 + 2048 + gp] = a64i; A[4 * 4096 + gp] = a256r; A[4 * 4096 + 2048 + gp] = a256i;
}
__device__ void ssm_stage2a(const Params& p, int bid, int nb) {
  const int n1 = 32 * 128 * 256, n2 = 32 * 16 * 4 * 512, n3 = 32 * 16 * 256;
  for (int i = bid * NTHREADS + threadIdx.x; i < n1 + n2 + n3; i += nb * NTHREADS) {
    if (i < n1) {
      const int j = i & 7, lane = (i >> 3) & 63, ks = (i >> 9) & 7, ri = (i >> 12) & 1, w = (i >> 13) & 3, g = i >> 15;
      const int st = w * 16 + (lane & 15), k = ks * 32 + (lane >> 4) * 8 + j; const int s_ = k >> 4, ch = k & 15;
      const int gp = g * 64 + st; const float pr = p.PWR[(g * 17 + 15 - s_) * 64 + st], pi = p.PWI[(g * 17 + 15 - s_) * 64 + st]; const float br = p.BBR[gp * 16 + ch], bi = p.BBI[gp * 16 + ch];
      p.WE16[i] = f2bf(ri == 0 ? (pr * br - pi * bi) : (pr * bi + pi * br));
    } else if (i < n1 + n2) {
      const int e = i - n1; const int j = e & 7, lane = (e >> 3) & 63, ks = (e >> 9) & 3, mt = (e >> 11) & 15, g = e >> 15;
      const int t = mt, co = lane & 15, k = ks * 32 + (lane >> 4) * 8 + j;
      const int st = ((k >> 5) << 4) | (k & 15), ri = (k >> 4) & 1; const float cr = p.c_re[(g * 16 + co) * 64 + st], ci = p.c_im[(g * 16 + co) * 64 + st];
      const float pr = p.PWR[(g * 17 + t + 1) * 64 + st], pi = p.PWI[(g * 17 + t + 1) * 64 + st];
      p.WY[((size_t)(g * 16 + mt) * 12 + ks) * 512 + lane * 8 + j] = f2bf((ri == 0) ? (cr * pr - ci * pi) : -(cr * pi + ci * pr));
    } else {
      const int e = i - n1 - n2; const int cin = e & 15, co = (e >> 4) & 15, j = (e >> 8) & 15, g = e >> 12; float acc = 0.f;
      for (int st = 0; st < 64; ++st) { const float cr = p.c_re[(g * 16 + co) * 64 + st], ci = p.c_im[(g * 16 + co) * 64 + st]; const float pr = p.PWR[(g * 17 + j) * 64 + st], pi = p.PWI[(g * 17 + j) * 64 + st];
        const float br = p.BBR[(g * 64 + st) * 16 + cin], bi = p.BBI[(g * 64 + st) * 16 + cin]; acc += cr * (pr * br - pi * bi) - ci * (pr * bi + pi * br); }
      p.KJ[e] = acc;
    }
  }
}
__device__ void ssm_stage2b(const Params& p, int bid, int nb) {
  const int n = 32 * 16 * 8 * 512;
  for (int i = bid * NTHREADS + threadIdx.x; i < n; i += nb * NTHREADS) {
    const int j = i & 7, lane = (i >> 3) & 63, ks8 = (i >> 9) & 7, mt = (i >> 12) & 15, g = i >> 16;
    const int t = mt, co = lane & 15, kk = ks8 * 32 + (lane >> 4) * 8 + j; const int s_ = kk >> 4, cin = kk & 15;
    const float val = (s_ <= t) ? p.KJ[((g * 16 + (t - s_)) * 16 + co) * 16 + cin] : 0.f;
    p.WY[((size_t)(g * 16 + mt) * 12 + 4 + ks8) * 512 + lane * 8 + j] = f2bf(val);
  }
}

#define EPI_IDS const int tid = threadIdx.x, lane = tid & 63, w = tid >> 6, wr = w >> 1, wc = w & 1, fr = lane & 15, fq = lane >> 4; (void)wr; (void)wc; (void)fr; (void)fq;

__device__ void tile_win_v(const Params& p, int tile, char* lds) {
  const int rt = tile >> 4, ct = tile & 15; const int row0 = rt * 128, col0 = ct * 128;
  f32x4 acc[4][4];
  gemm_mainloop<true, true>(acc, p.XB, 1024, p.WtIn, 1024, 1024, row0, col0, lds);
  EPI_IDS
  const int head = (col0 + wc * 64 - 1024) >> 6;
#pragma unroll
  for (int m = 0; m < 4; ++m) {
    const int row = row0 + wr * 64 + m * 16 + fq * 4; const f32x4 rsx = *(const f32x4*)(p.rs_x + row); const int b = row >> 13, tb = row & 8191;
#pragma unroll
    for (int n = 0; n < 4; ++n) { const f32x4 v = acc[m][n] * rsx;
      *(uint2*)(p.VT + ((size_t)(b * 8 + head) * 64 + n * 16 + fr) * SEQL + tb) = make_uint2(pack2(v[0], v[1]), pack2(v[2], v[3])); }
  }
}
__device__ void tile_win(const Params& p, int tile, char* lds) {
  const int rt = tile >> 4, ct = tile & 15; const int row0 = rt * 128, col0 = ct * 128;
  f32x4 acc[4][4];
  gemm_mainloop<true>(acc, p.XB, 1024, p.WtIn, 1024, 1024, row0, col0, lds);
  EPI_IDS
  const int cw = col0 + wc * 64;
#pragma unroll
  for (int m = 0; m < 4; ++m) {
    const int row = row0 + wr * 64 + m * 16 + fr; const float rsx = p.rs_x[row];
    if (cw < 1024) {
      float ss = 0.f;
#pragma unroll
      for (int n = 0; n < 4; ++n)
#pragma unroll
        for (int j = 0; j < 4; ++j) { const float v = acc[m][n][j] * rsx; acc[m][n][j] = v; ss += v * v; }
      ss += __shfl_xor(ss, 16); ss += __shfl_xor(ss, 32);
      const float rs = rsqrtf(ss * (1.0f / 64.0f) + EPSF) * (cw < 512 ? 0.125f * 1.44269504f : 1.0f);
      const float* g = (cw < 512) ? p.att_q_g : p.att_k_g; bf16_t* dst = (cw < 512 ? p.Qb : p.Kb) + (size_t)row * 512 + (cw & 511);
#pragma unroll
      for (int n = 0; n < 4; ++n) { const int c = n * 16 + fq * 4; const float4 gg = *(const float4*)(g + c);
        *(uint2*)(dst + c) = make_uint2(pack2(acc[m][n][0] * rs * gg.x, acc[m][n][1] * rs * gg.y), pack2(acc[m][n][2] * rs * gg.z, acc[m][n][3] * rs * gg.w)); }
    } else if (cw < 1536) {
      const int head = (cw - 1024) >> 6; const int b = row >> 13, tb = row & 8191;
      bf16_t* dst = p.VT + ((size_t)(b * 8 + head) * 64) * SEQL + tb;
#pragma unroll
      for (int n = 0; n < 4; ++n)
#pragma unroll
        for (int j = 0; j < 4; ++j) dst[(size_t)(n * 16 + fq * 4 + j) * SEQL] = f2bf(acc[m][n][j] * rsx);
    } else {
      const int b = row >> 13, tb = row & 8191;
#pragma unroll
      for (int n = 0; n < 4; ++n) { const int g = ((cw - 1536) >> 4) + n;
        *(uint2*)(p.Ub + ((size_t)(b * 32 + g) * SEQL + tb) * 16 + fq * 4) = make_uint2(pack2(acc[m][n][0] * rsx, acc[m][n][1] * rsx), pack2(acc[m][n][2] * rsx, acc[m][n][3] * rsx)); }
    }
  }
}
__device__ void tile_memkv(const Params& p, int tile, char* lds) {
  const int which = tile >> 5, t2 = tile & 31; const int rt = t2 >> 3, ct = t2 & 7; const int row0 = rt * 128, col0 = ct * 128;
  f32x4 acc[4][4];
  gemm_mainloop<true>(acc, p.MEMB, 1024, which ? p.WtMv : p.WtMk, 1024, 1024, row0, col0, lds);
  EPI_IDS
  const int cw = col0 + wc * 64;
#pragma unroll
  for (int m = 0; m < 4; ++m) {
    const int row = row0 + wr * 64 + m * 16 + fr; const float rsm = p.rs_mem[row];
    if (which == 0) {
      float ss = 0.f;
#pragma unroll
      for (int n = 0; n < 4; ++n) { f32x4 v = acc[m][n] * rsm; ss += v[0] * v[0] + v[1] * v[1] + v[2] * v[2] + v[3] * v[3]; *(f32x4*)(p.KMraw + (size_t)row * 1024 + cw + n * 16 + fq * 4) = v; }
      ss += __shfl_xor(ss, 16); ss += __shfl_xor(ss, 32);
      if (fq == 0) p.ss_km[row * 16 + (cw >> 6)] = ss;
    } else {
      const int b = row >> 8, key = row & 255; const int head = cw >> 8; const int d0 = (cw & 255);
      bf16_t* dst = p.VMT + ((size_t)(b * 4 + head) * 256) * 256 + key;
#pragma unroll
      for (int n = 0; n < 4; ++n)
#pragma unroll
        for (int j = 0; j < 4; ++j) dst[(size_t)(d0 + n * 16 + fq * 4 + j) * 256] = f2bf(acc[m][n][j] * rsm);
    }
  }
}
__device__ void memk_fix(const Params& p, int bid, int nb) {
  for (int i = bid * NTHREADS + threadIdx.x; i < 512 * 1024 / 4; i += nb * NTHREADS) {
    const int row = i >> 8, c4 = (i & 255) * 4; const int head = c4 >> 8, d = c4 & 255;
    const float ss = p.ss_km[row * 16 + head * 4] + p.ss_km[row * 16 + head * 4 + 1] + p.ss_km[row * 16 + head * 4 + 2] + p.ss_km[row * 16 + head * 4 + 3];
    const float rs = rsqrtf(ss * (1.0f / 256.0f) + EPSF);
    const float4 v = *(const float4*)(p.KMraw + (size_t)row * 1024 + c4); const float4 gk = *(const float4*)(p.mem_k_g + d), gq = *(const float4*)(p.mem_q_g + d);
    const int b = row >> 8, key = row & 255;
    *(uint2*)(p.KMB + ((size_t)(b * 4 + head) * 256 + key) * 256 + d) = make_uint2(pack2(v.x * rs * gk.x * gq.x, v.y * rs * gk.y * gq.y), pack2(v.z * rs * gk.z * gq.z, v.w * rs * gk.w * gq.w));
  }
}

__device__ void chunk_attn_prep(const Params& p, char* lds_) {
  LAS float* rb = (LAS float*)((LAS char*)lds_ + 65536);
  __syncthreads();
  for (int i = threadIdx.x; i < 8 * 192; i += NTHREADS) rb[i] = p.rel_bias[i] * 1.44269504f - p.SHF[i / 192];
  __syncthreads();
}
__device__ __forceinline__ void cattn_stage(const bf16_t* kg, const bf16_t* vg, unsigned st, int w, int lane) {
  const unsigned wb = st + (unsigned)__builtin_amdgcn_readfirstlane(w) * 2048u; const int lr = lane >> 3, pos = lane & 7;
#pragma unroll
  for (int i = 0; i < 2; ++i) { const int row = w * 16 + i * 8 + lr;
    glds16(kg + (size_t)row * 512 + ((pos ^ (row & 7)) << 3), wb + i * 1024u);
    glds16(vg + (size_t)row * SEQL + ((pos ^ ((row >> 1) & 7)) << 3), wb + 8192u + i * 1024u); }
}
__device__ void chunk_attn_item(const Params& p, int item, char* lds_) {
  LAS char* lds = (LAS char*)lds_;
  typedef unsigned u32x2 __attribute__((ext_vector_type(2)));
  const int h = item & 7, cn = (item >> 3) & 127, b = item >> 10;
  LAS float* rb = (LAS float*)(lds + 65536) + h * 192;
  const unsigned lbase = (unsigned)(size_t)lds;
  const int tid = threadIdx.x, lane = tid & 63, w = tid >> 6, fr = lane & 15, fq = lane >> 4;
  const int iq = w * 16 + fr; const int tq = b * SEQL + cn * 64 + iq;
  const int cstart = (cn >= 8) ? 0 : (8 - cn); const int nch = 9 - cstart;
  const bf16_t* kbase = p.Kb + (size_t)(b * SEQL + (cn - 8) * 64) * 512 + h * 64;
  const bf16_t* vbase = p.VT + ((size_t)(b * 8 + h) * 64) * SEQL + (cn - 8) * 64;
  __syncthreads();
  {
    const unsigned wb = lbase + 49152u + (unsigned)__builtin_amdgcn_readfirstlane(w) * 2048u; const int lr = lane >> 3, pos = lane & 7;
#pragma unroll
    for (int i = 0; i < 2; ++i) { const int row = w * 16 + i * 8 + lr;
      glds16(p.Qb + (size_t)(b * SEQL + cn * 64 + row) * 512 + h * 64 + ((pos ^ (row & 7)) << 3), wb + i * 1024u); } }
#pragma unroll
  for (int i = 0; i < 3; ++i) if (i < nch) cattn_stage(kbase + (size_t)(cstart + i) * 64 * 512, vbase + (cstart + i) * 64, lbase + i * 16384u, w, lane);
  f32x4 o[4]; for (int i = 0; i < 4; ++i) o[i] = (f32x4){0.f, 0.f, 0.f, 0.f};
  float lrun = 0.f; const float cbias = rb[191]; bf16x8 qf[2];
  for (int i = 0; i < nch; ++i) {
    const int c = cstart + i; const int rem = nch - 1 - i;
    if (rem >= 2) asm volatile("s_waitcnt vmcnt(8)" ::: "memory"); else if (rem == 1) asm volatile("s_waitcnt vmcnt(4)" ::: "memory"); else asm volatile("s_waitcnt vmcnt(0)" ::: "memory");
    RAW_BARRIER();
    if (i == 0) { const int row = w * 16 + fr; LAS char* ql = lds + 49152;
      qf[0] = as_bf(*(const LAS u32x4*)(ql + row * 128 + ((fq ^ (row & 7)) << 4))); qf[1] = as_bf(*(const LAS u32x4*)(ql + row * 128 + (((4 + fq) ^ (row & 7)) << 4)));
      RAW_BARRIER(); }
    if (i + 3 < nch) cattn_stage(kbase + (size_t)(c + 3) * 64 * 512, vbase + (c + 3) * 64, lbase + (unsigned)(((i + 3) & 3) * 16384), w, lane);
    LAS char* cur = lds + (i & 3) * 16384;
    f32x4 st[4];
    const float ini = (c <= 5) ? cbias : 0.f;
#pragma unroll
    for (int mt = 0; mt < 4; ++mt) { const int row = mt * 16 + fr; f32x4 sacc = (f32x4){ini, ini, ini, ini};
      sacc = mfma16(as_bf(*(const LAS u32x4*)(cur + row * 128 + ((fq ^ (row & 7)) << 4))), qf[0], sacc);
      sacc = mfma16(as_bf(*(const LAS u32x4*)(cur + row * 128 + (((4 + fq) ^ (row & 7)) << 4))), qf[1], sacc); st[mt] = sacc; }
    if (c > 5) {
#pragma unroll
      for (int mt = 0; mt < 4; ++mt)
#pragma unroll
        for (int j = 0; j < 4; ++j) { const int jk = mt * 16 + fq * 4 + j; int dist = 512 - 64 * c + iq - jk; dist = dist > 128 ? 128 : dist; st[mt][j] += rb[dist + 63]; }
    }
    float ls = 0.f;
#pragma unroll
    for (int mt = 0; mt < 4; ++mt)
#pragma unroll
      for (int j = 0; j < 4; ++j) { const float pv = __builtin_amdgcn_exp2f(st[mt][j]); st[mt][j] = pv; ls += pv; }
    lrun += ls;
    bf16x8 pf[2];
#pragma unroll
    for (int s2 = 0; s2 < 2; ++s2) { u32x4 t; t.x = pack2(st[2 * s2][0], st[2 * s2][1]); t.y = pack2(st[2 * s2][2], st[2 * s2][3]); t.z = pack2(st[2 * s2 + 1][0], st[2 * s2 + 1][1]); t.w = pack2(st[2 * s2 + 1][2], st[2 * s2 + 1][3]); pf[s2] = as_bf(t); }
#pragma unroll
    for (int dt = 0; dt < 4; ++dt) { const int d = dt * 16 + fr; const int sw = ((d >> 1) & 7) << 1; f32x4 oc = o[dt];
#pragma unroll
      for (int s2 = 0; s2 < 2; ++s2) {
        const u32x2 lo = *(const LAS u32x2*)(cur + 8192 + d * 128 + (((s2 * 8 + fq) ^ sw) << 3)), hi = *(const LAS u32x2*)(cur + 8192 + d * 128 + (((s2 * 8 + fq + 4) ^ sw) << 3));
        u32x4 vv; vv.x = lo.x; vv.y = lo.y; vv.z = hi.x; vv.w = hi.y; oc = mfma16(as_bf(vv), pf[s2], oc); }
      o[dt] = oc; }
  }
  float lt = lrun; lt += __shfl_xor(lt, 16); lt += __shfl_xor(lt, 32);
  const float inv = 1.0f / lt; float ss = 0.f;
  bf16_t* dst = p.ATT + (size_t)tq * 512 + h * 64;
#pragma unroll
  for (int dt = 0; dt < 4; ++dt) { const f32x4 v = o[dt] * inv; ss += v[0] * v[0] + v[1] * v[1] + v[2] * v[2] + v[3] * v[3];
    *(uint2*)(dst + dt * 16 + fq * 4) = make_uint2(pack2(v[0], v[1]), pack2(v[2], v[3])); }
  ss += __shfl_xor(ss, 16); ss += __shfl_xor(ss, 32);
  if (fq == 0) p.ss_att[tq * 8 + h] = ss;
}

template <bool FINAL>
__device__ void ssm_item(const Params& p, int item, char* lds) {
  const int g = item & 31, seg = (item >> 5) & 31, b = item >> 10;
  const int tid = threadIdx.x, lane = tid & 63, w = tid >> 6, fr = lane & 15, fq = lane >> 4;
  const int t0 = b * SEQL + seg * 256;
  const bf16_t* ug = p.Ub + ((size_t)(b * 32 + g) * SEQL + seg * 256) * 16;
  bf16x8 uf[8];
#pragma unroll
  for (int ks = 0; ks < 8; ++ks) uf[ks] = *(const bf16x8*)(ug + (size_t)(fr * 16 + 2 * ks + (fq >> 1)) * 16 + (fq & 1) * 8);
  f32x4 er = (f32x4){0.f, 0.f, 0.f, 0.f}, ei = er;
  const bf16_t* we = p.WE16 + ((size_t)(g * 4 + w) * 2 * 8 * 64 + lane) * 8;
#pragma unroll
  for (int ks = 0; ks < 8; ++ks) { const bf16x8 br = *(const bf16x8*)(we + ks * 512), bi = *(const bf16x8*)(we + 4096 + ks * 512); er = mfma16(uf[ks], br, er); ei = mfma16(uf[ks], bi, ei); }
  const int gp = g * 64 + w * 16 + fr;
  const float a16r = p.APW[gp], a16i = p.APW[2048 + gp];
  float xr[4], xi[4];
  xr[0] = er[0]; xi[0] = ei[0];
#pragma unroll
  for (int j = 1; j < 4; ++j) { xr[j] = a16r * xr[j - 1] - a16i * xi[j - 1] + er[j]; xi[j] = a16r * xi[j - 1] + a16i * xr[j - 1] + ei[j]; }
  float cr = 0.f, ci = 0.f;
  if (FINAL) {
    const float ar = p.APW[4 * 4096 + gp], ai = p.APW[4 * 4096 + 2048 + gp];
    const float* es = p.ESEG + ((size_t)(b * 32) * 32 + g) * 128 + w * 32 + fr;
    for (int j0 = 0; j0 < seg; j0 += 8) { float e_r[8], e_i[8];
#pragma unroll
      for (int u = 0; u < 8; ++u) { e_r[u] = es[(size_t)(j0 + u) * 32 * 128]; e_i[u] = es[(size_t)(j0 + u) * 32 * 128 + 16]; }
#pragma unroll
      for (int u = 0; u < 8; ++u) if (j0 + u < seg) { const float nr = ar * cr - ai * ci + e_r[u], ni = ar * ci + ai * cr + e_i[u]; cr = nr; ci = ni; } }
  }
  const float a64r = p.APW[3 * 4096 + gp], a64i = p.APW[3 * 4096 + 2048 + gp];
  float tr = xr[3], ti = xi[3];
#pragma unroll
  for (int r = 0; r < 4; ++r) {
    float pr_ = __shfl(tr, (lane + 48) & 63), pi_ = __shfl(ti, (lane + 48) & 63);
    if (r == 0) { pr_ = cr; pi_ = ci; }
    if (fq == r) { const float nr = xr[3] + a64r * pr_ - a64i * pi_, ni = xi[3] + a64r * pi_ + a64i * pr_; tr = nr; ti = ni; }
  }
  if (!FINAL) {
    if (fq == 3) { float* es = p.ESEG + ((size_t)(b * 32 + seg) * 32 + g) * 128 + w * 32 + fr; es[0] = tr; es[16] = ti; }
    return;
  }
  float gr = __shfl(tr, (lane + 48) & 63), gi = __shfl(ti, (lane + 48) & 63);
  if (fq == 0) { gr = cr; gi = ci; }
  float pvr[4], pvi[4];
  pvr[0] = gr; pvi[0] = gi;
#pragma unroll
  for (int j = 1; j < 4; ++j) { const float ar = p.APW[(j - 1) * 4096 + gp], ai = p.APW[(j - 1) * 4096 + 2048 + gp]; pvr[j] = xr[j - 1] + ar * gr - ai * gi; pvi[j] = xi[j - 1] + ar * gi + ai * gr; }
  bf16_t* xl = (bf16_t*)lds;
  __syncthreads();
#pragma unroll
  for (int j = 0; j < 4; ++j) { xl[(fq * 4 + j) * 136 + w * 32 + fr] = f2bf(pvr[j]); xl[(fq * 4 + j) * 136 + w * 32 + 16 + fr] = f2bf(pvi[j]); }
  __syncthreads();
  bf16x8 xf[4];
#pragma unroll
  for (int ks = 0; ks < 4; ++ks) xf[ks] = *(const bf16x8*)(xl + fr * 136 + ks * 32 + fq * 8);
#pragma unroll
  for (int mi = 0; mi < 4; ++mi) {
    const int mt = w * 4 + mi;
    const bf16_t* wy = p.WY + ((size_t)(g * 16 + mt) * 12 * 64 + lane) * 8;
    f32x4 y = (f32x4){0.f, 0.f, 0.f, 0.f};
#pragma unroll
    for (int ks = 0; ks < 4; ++ks) y = mfma16(*(const bf16x8*)(wy + ks * 512), xf[ks], y);
#pragma unroll
    for (int ks = 0; ks < 8; ++ks) if (2 * ks <= mt) y = mfma16(*(const bf16x8*)(wy + (4 + ks) * 512), uf[ks], y);
    const size_t tok = (size_t)(t0 + fr * 16 + mt);
    const uint2 uu = *(const uint2*)(ug + (size_t)(fr * 16 + mt) * 16 + fq * 4);
    const float4 dd = *(const float4*)(p.d_skip + g * 16 + fq * 4);
    const float y0 = gelu_f(y[0] + dd.x * __uint_as_float(uu.x << 16)), y1 = gelu_f(y[1] + dd.y * __uint_as_float(uu.x & 0xffff0000u));
    const float y2 = gelu_f(y[2] + dd.z * __uint_as_float(uu.y << 16)), y3 = gelu_f(y[3] + dd.w * __uint_as_float(uu.y & 0xffff0000u));
    *(uint2*)(p.YG + tok * 512 + g * 16 + fq * 4) = make_uint2(pack2(y0, y1), pack2(y2, y3));
  }
}

__device__ void tile_glu(const Params& p, int tile, char* lds) {
  const int rt = tile >> 2, ct = tile & 3; const int row0 = rt * 128, col0 = ct * 128;
  f32x4 acc[4][4];
  gemm_mainloop<true>(acc, p.YG, 512, p.WtGlu, 512, 512, row0, col0, lds);
  EPI_IDS
  const int cw = col0 + wc * 64;
#pragma unroll
  for (int m = 0; m < 4; ++m) {
    const int row = row0 + wr * 64 + m * 16 + fr; float ss = 0.f;
#pragma unroll
    for (int n = 0; n < 4; ++n) { const int c = cw + n * 16 + fq * 4; const float4 bg = *(const float4*)(p.b_glu + c); const uint2 yy = *(const uint2*)(p.YG + (size_t)row * 512 + c);
      const float y0 = __uint_as_float(yy.x << 16), y1 = __uint_as_float(yy.x & 0xffff0000u), y2 = __uint_as_float(yy.y << 16), y3 = __uint_as_float(yy.y & 0xffff0000u);
      const float o0 = y0 / (1.f + __expf(-(acc[m][n][0] + bg.x))), o1 = y1 / (1.f + __expf(-(acc[m][n][1] + bg.y))), o2 = y2 / (1.f + __expf(-(acc[m][n][2] + bg.z))), o3 = y3 / (1.f + __expf(-(acc[m][n][3] + bg.w)));
      ss += o0 * o0 + o1 * o1 + o2 * o2 + o3 * o3;
      *(uint2*)(p.SSMO + (size_t)row * 512 + c) = make_uint2(pack2(o0, o1), pack2(o2, o3)); }
    ss += __shfl_xor(ss, 16); ss += __shfl_xor(ss, 32);
    if (fq == 0) p.ss_ssm[row * 8 + (cw >> 6)] = ss;
  }
}
__device__ void tile_wout(const Params& p, int tile, char* lds) {
  const int rt = tile >> 3, ct = tile & 7; const int row0 = rt * 128, col0 = ct * 128;
  f32x4 acc[4][4];
  float s1[4];
  gemm_mainloop<true>(acc, p.ATT, 512, p.WtOut, 1024, 512, row0, col0, lds);
  { const int lane_ = threadIdx.x & 63, w_ = threadIdx.x >> 6;
#pragma unroll
    for (int m = 0; m < 4; ++m) { const int row = row0 + (w_ >> 1) * 64 + m * 16 + (lane_ & 15); float a = 0.f, c = 0.f;
#pragma unroll
      for (int j = 0; j < 8; ++j) { a += p.ss_att[row * 8 + j]; c += p.ss_ssm[row * 8 + j]; }
      const float ra = rsqrtf(a * (1.0f / 512.0f) + EPSF); s1[m] = rsqrtf(c * (1.0f / 512.0f) + EPSF); const float f = ra / s1[m];
#pragma unroll
      for (int n = 0; n < 4; ++n) acc[m][n] *= f; } }
  gemm_mainloop<false>(acc, p.SSMO, 512, p.WtOut + 512, 1024, 512, row0, col0, lds);
  EPI_IDS
  const int cw = col0 + wc * 64;
#pragma unroll
  for (int m = 0; m < 4; ++m) {
    const int row = row0 + wr * 64 + m * 16 + fr; float ss = 0.f;
#pragma unroll
    for (int n = 0; n < 4; ++n) { const int c = cw + n * 16 + fq * 4; const f32x4 xv = *(const f32x4*)(p.x + (size_t)row * 1024 + c); const f32x4 hv = xv + acc[m][n] * s1[m];
      ss += hv[0] * hv[0] + hv[1] * hv[1] + hv[2] * hv[2] + hv[3] * hv[3];
      *(uint2*)(p.H1B + (size_t)row * 1024 + c) = make_uint2(pack2(hv[0], hv[1]), pack2(hv[2], hv[3])); }
    ss += __shfl_xor(ss, 16); ss += __shfl_xor(ss, 32);
    if (fq == 0) p.ss_h1[row * 16 + (cw >> 6)] = ss;
  }
}
__device__ __forceinline__ float row_rs16(const float* ss, int row) { float a = 0.f;
#pragma unroll
  for (int j = 0; j < 16; ++j) a += ss[row * 16 + j];
  return rsqrtf(a * (1.0f / 1024.0f) + EPSF); }
__device__ void tile_memq(const Params& p, int tile, char* lds) {
  const int rt = tile >> 3, ct = tile & 7; const int row0 = rt * 128, col0 = ct * 128;
  f32x4 acc[4][4];
  gemm_mainloop<true>(acc, p.H1B, 1024, p.WtMq, 1024, 1024, row0, col0, lds);
  EPI_IDS
  const int cw = col0 + wc * 64;
#pragma unroll
  for (int m = 0; m < 4; ++m) {
    const int row = row0 + wr * 64 + m * 16 + fr; const float rs = row_rs16(p.ss_h1, row); float ss = 0.f;
#pragma unroll
    for (int n = 0; n < 4; ++n) { const int c = cw + n * 16 + fq * 4; const f32x4 v = acc[m][n] * rs; ss += v[0] * v[0] + v[1] * v[1] + v[2] * v[2] + v[3] * v[3];
      *(uint2*)(p.QM + (size_t)row * 1024 + c) = make_uint2(pack2(v[0], v[1]), pack2(v[2], v[3])); }
    ss += __shfl_xor(ss, 16); ss += __shfl_xor(ss, 32);
    if (fq == 0) p.ss_qm[row * 16 + (cw >> 6)] = ss;
  }
}
__device__ __forceinline__ void mem_stage(const bf16_t* kg, const bf16_t* vg, int kc, LAS char* buf, int w, int lane) {
  const int wb = __builtin_amdgcn_readfirstlane(w) * 4096;
#pragma unroll
  for (int i = 0; i < 4; ++i) {
    const int row = w * 8 + i * 2 + (lane >> 5), pos = lane & 31; const int ch = pos ^ (row & 15);
    __builtin_amdgcn_global_load_lds((const GAS void*)(kg + (size_t)(kc * 32 + row) * 256 + ch * 8), (LAS void*)(buf + wb + i * 1024), 16, 0, 0);
  }
#pragma unroll
  for (int i = 0; i < 4; ++i) {
    const int d = w * 64 + i * 16 + (lane >> 2), pos = lane & 3; const int ch = pos ^ ((d >> 2) & 3);
    __builtin_amdgcn_global_load_lds((const GAS void*)(vg + (size_t)d * 256 + kc * 32 + ch * 8), (LAS void*)(buf + 16384 + wb + i * 1024), 16, 0, 0);
  }
}
__device__ void mem_attn_item(const Params& p, int item, char* lds_) {
  LAS char* lds = (LAS char*)lds_;
  typedef unsigned u32x2 __attribute__((ext_vector_type(2)));
  const int h = item & 3, tt = item >> 2; const int tid = threadIdx.x, lane = tid & 63, w = tid >> 6, fr = lane & 15, fq = lane >> 4;
  const int tq = tt * 64 + w * 16 + fr; const int b = tq >> 13;
  const bf16_t* kg = p.KMB + (size_t)(b * 4 + h) * 256 * 256;
  const bf16_t* vg = p.VMT + (size_t)(b * 4 + h) * 256 * 256;
  __syncthreads();
  mem_stage(kg, vg, 0, lds, w, lane);
  const float ssq = p.ss_qm[tq * 16 + h * 4] + p.ss_qm[tq * 16 + h * 4 + 1] + p.ss_qm[tq * 16 + h * 4 + 2] + p.ss_qm[tq * 16 + h * 4 + 3];
  const float rowscale = rsqrtf(ssq * (1.0f / 256.0f) + EPSF) * 0.0625f * 1.44269504f;
  const float shf = p.SHF[8];
  bf16x8 qf[8];
#pragma unroll
  for (int ks = 0; ks < 8; ++ks) qf[ks] = *(const bf16x8*)(p.QM + (size_t)tq * 1024 + h * 256 + ks * 32 + fq * 8);
  f32x4 o[16];
#pragma unroll
  for (int i = 0; i < 16; ++i) o[i] = (f32x4){0.f, 0.f, 0.f, 0.f};
  float lrun = 0.f;
  asm volatile("s_waitcnt vmcnt(0)" ::: "memory");
  __syncthreads();
  for (int kc = 0; kc < 8; ++kc) {
    LAS char* cur = lds + (kc & 1) * 32768; LAS char* nxt = lds + ((kc + 1) & 1) * 32768;
    if (kc + 1 < 8) mem_stage(kg, vg, kc + 1, nxt, w, lane);
    f32x4 st[2];
#pragma unroll
    for (int mt = 0; mt < 2; ++mt) { f32x4 sacc = (f32x4){0.f, 0.f, 0.f, 0.f}; const int row = mt * 16 + fr;
#pragma unroll
      for (int ks = 0; ks < 8; ++ks) sacc = mfma16(as_bf(*(const LAS u32x4*)(cur + row * 512 + (((ks * 4 + fq) ^ (row & 15)) << 4))), qf[ks], sacc);
      st[mt] = sacc * rowscale - shf; }
    float ls = 0.f;
#pragma unroll
    for (int mt = 0; mt < 2; ++mt)
#pragma unroll
      for (int j = 0; j < 4; ++j) { const float e = __builtin_amdgcn_exp2f(st[mt][j]); st[mt][j] = e; ls += e; }
    lrun += ls;
    u32x4 t; t.x = pack2(st[0][0], st[0][1]); t.y = pack2(st[0][2], st[0][3]); t.z = pack2(st[1][0], st[1][1]); t.w = pack2(st[1][2], st[1][3]);
    const bf16x8 pf = as_bf(t);
#pragma unroll
    for (int dt = 0; dt < 16; ++dt) { const int d = dt * 16 + fr; const int sw = ((d >> 2) & 3) << 1;
      const u32x2 lo = *(const LAS u32x2*)(cur + 16384 + d * 64 + ((fq ^ sw) << 3)), hi = *(const LAS u32x2*)(cur + 16384 + d * 64 + (((fq + 4) ^ sw) << 3));
      u32x4 vv; vv.x = lo.x; vv.y = lo.y; vv.z = hi.x; vv.w = hi.y; o[dt] = mfma16(as_bf(vv), pf, o[dt]); }
    asm volatile("s_waitcnt vmcnt(0)" ::: "memory");
    __syncthreads();
  }
  float lt = lrun; lt += __shfl_xor(lt, 16); lt += __shfl_xor(lt, 32);
  const float inv = 1.0f / lt;
  bf16_t* dst = p.OM + (size_t)tq * 1024 + h * 256;
#pragma unroll
  for (int dt = 0; dt < 16; ++dt) { const f32x4 v = o[dt] * inv; *(uint2*)(dst + dt * 16 + fq * 4) = make_uint2(pack2(v[0], v[1]), pack2(v[2], v[3])); }
}
__device__ void tile_memo(const Params& p, int tile, char* lds) {
  const int rt = tile >> 3, ct = tile & 7; const int row0 = rt * 128, col0 = ct * 128;
  f32x4 acc[4][4];
  gemm_mainloop<true>(acc, p.OM, 1024, p.WtMo, 1024, 1024, row0, col0, lds);
  EPI_IDS
  const int cw = col0 + wc * 64;
#pragma unroll
  for (int m = 0; m < 4; ++m) {
    const int row = row0 + wr * 64 + m * 16 + fr; float ss = 0.f;
#pragma unroll
    for (int n = 0; n < 4; ++n) { const int c = cw + n * 16 + fq * 4; const uint2 hb = *(const uint2*)(p.H1B + (size_t)row * 1024 + c);
      const f32x4 hv = (f32x4){__uint_as_float(hb.x << 16), __uint_as_float(hb.x & 0xffff0000u), __uint_as_float(hb.y << 16), __uint_as_float(hb.y & 0xffff0000u)} + acc[m][n];
      ss += hv[0] * hv[0] + hv[1] * hv[1] + hv[2] * hv[2] + hv[3] * hv[3];
      *(uint2*)(p.H2B + (size_t)row * 1024 + c) = make_uint2(pack2(hv[0], hv[1]), pack2(hv[2], hv[3])); }
    ss += __shfl_xor(ss, 16); ss += __shfl_xor(ss, 32);
    if (fq == 0) p.ss_h2[row * 16 + (cw >> 6)] = ss;
  }
}
__device__ __forceinline__ void ce_desc(float& x, float& y) { const float hi = fmaxf(x, y), lo = fminf(x, y); x = hi; y = lo; }
__device__ __forceinline__ void sort16_desc(float (&a)[16]) {
#pragma unroll
  for (int k = 2; k <= 16; k <<= 1)
#pragma unroll
    for (int j = k >> 1; j > 0; j >>= 1)
#pragma unroll
      for (int i = 0; i < 16; ++i) { const int l = i ^ j; if (l > i) { if ((i & k) == 0) ce_desc(a[i], a[l]); else ce_desc(a[l], a[i]); } }
}
__device__ __forceinline__ void merge16_desc(float (&a)[16], const float (&b)[16]) {
#pragma unroll
  for (int i = 0; i < 16; ++i) a[i] = fmaxf(a[i], b[15 - i]);
#pragma unroll
  for (int j = 8; j > 0; j >>= 1)
#pragma unroll
    for (int i = 0; i < 16; ++i) { const int l = i ^ j; if (l > i) ce_desc(a[i], a[l]); }
}
__device__ __forceinline__ void ins16(float (&a)[16], float v) {
#pragma unroll
  for (int i = 0; i < 16; ++i) { const float hi = fmaxf(a[i], v), lo = fminf(a[i], v); a[i] = hi; v = lo; }
}
__device__ void tile_peer(const Params& p, int tile, char* lds_) {
  const int rt = tile >> 4, hs = tile & 15; const int row0 = rt * 128, col0 = hs * 128;
  f32x4 acc[4][4];
  gemm_mainloop<true>(acc, p.H2B, 1024, p.WtPq, 1024, 1024, row0, col0, lds_);
  LAS char* lds = (LAS char*)lds_;
  EPI_IDS
  { const int lr = lane >> 3, lc = (lane & 7) ^ lr; const int wbase = __builtin_amdgcn_readfirstlane(w) * 4096;
    const bf16_t* gK = p.PK + (size_t)hs * 128 * 128 + (size_t)(w * 32 + lr) * 128 + lc * 8;
#pragma unroll
    for (int i = 0; i < 4; ++i) {
      __builtin_amdgcn_global_load_lds((const GAS void*)(gK + (size_t)(i * 8) * 128), (LAS void*)(lds + 16384 + wbase + i * 1024), 16, 0, 0);
      __builtin_amdgcn_global_load_lds((const GAS void*)(gK + (size_t)(i * 8) * 128 + 64), (LAS void*)(lds + 32768 + 16384 + wbase + i * 1024), 16, 0, 0);
    } }
  typedef unsigned u32x2 __attribute__((ext_vector_type(2)));
#pragma unroll
  for (int m = 0; m < 4; ++m) { const int r = wr * 64 + m * 16 + fr; const float rs = row_rs16(p.ss_h2, row0 + r);
#pragma unroll
    for (int n = 0; n < 4; ++n) { const f32x4 v = acc[m][n] * rs; u32x2 pk; pk.x = pack2(v[0], v[1]); pk.y = pack2(v[2], v[3]);
      *(LAS u32x2*)(lds + wc * 32768 + r * 128 + (((n * 2 + (fq >> 1)) ^ (r & 7)) << 4) + (fq & 1) * 8) = pk; } }
  asm volatile("s_waitcnt vmcnt(0)" ::: "memory");
  __syncthreads();
#pragma unroll
  for (int m = 0; m < 4; ++m)
#pragma unroll
    for (int n = 0; n < 4; ++n) acc[m][n] = (f32x4){0.f, 0.f, 0.f, 0.f};
#pragma unroll
  for (int kt = 0; kt < 2; ++kt) { LAS char* cur = lds + kt * 32768;
#pragma unroll
    for (int ks = 0; ks < 2; ++ks) { bf16x8 af[4], bfr[4]; const int kc = ks * 4 + fq;
#pragma unroll
      for (int m = 0; m < 4; ++m) { const int r = wr * 64 + m * 16 + fr; af[m] = as_bf(*(const LAS u32x4*)(cur + r * 128 + ((kc ^ (r & 7)) << 4))); }
#pragma unroll
      for (int n = 0; n < 4; ++n) { const int r = wc * 64 + n * 16 + fr; bfr[n] = as_bf(*(const LAS u32x4*)(cur + 16384 + r * 128 + ((kc ^ (r & 7)) << 4))); }
#pragma unroll
      for (int m = 0; m < 4; ++m)
#pragma unroll
        for (int n = 0; n < 4; ++n) acc[m][n] = mfma16(bfr[n], af[m], acc[m][n]);
    } }
  __syncthreads();
  LAS float* L = (LAS float*)lds;
#pragma unroll
  for (int m = 0; m < 4; ++m) {
    float a[16], b[16];
#pragma unroll
    for (int n = 0; n < 4; ++n)
#pragma unroll
      for (int j = 0; j < 4; ++j) a[n * 4 + j] = __uint_as_float((__float_as_uint(acc[m][n][j]) & ~127u) | (unsigned)(wc * 64 + n * 16 + fq * 4 + j));
    sort16_desc(a);
#pragma unroll
    for (int i = 0; i < 16; ++i) b[i] = __shfl_xor(a[i], 16);
    merge16_desc(a, b);
#pragma unroll
    for (int i = 0; i < 16; ++i) b[i] = __shfl_xor(a[i], 32);
    merge16_desc(a, b);
    const int r = wr * 64 + m * 16 + fr;
    f32x4 o; o[0] = fq == 0 ? a[0] : fq == 1 ? a[4] : fq == 2 ? a[8] : a[12]; o[1] = fq == 0 ? a[1] : fq == 1 ? a[5] : fq == 2 ? a[9] : a[13];
    o[2] = fq == 0 ? a[2] : fq == 1 ? a[6] : fq == 2 ? a[10] : a[14]; o[3] = fq == 0 ? a[3] : fq == 1 ? a[7] : fq == 2 ? a[11] : a[15];
    *(LAS f32x4*)(L + (r * 2 + wc) * 16 + fq * 4) = o;
  }
  __syncthreads();
#pragma unroll
  for (int mi = 0; mi < 2; ++mi) { const int m = wc * 2 + mi; const int r = wr * 64 + m * 16 + fr;
    float a[16], b[16];
#pragma unroll
    for (int q = 0; q < 4; ++q) { const f32x4 va = *(const LAS f32x4*)(L + (r * 2 + 0) * 16 + q * 4), vb = *(const LAS f32x4*)(L + (r * 2 + 1) * 16 + q * 4);
      a[q * 4] = va[0]; a[q * 4 + 1] = va[1]; a[q * 4 + 2] = va[2]; a[q * 4 + 3] = va[3]; b[q * 4] = vb[0]; b[q * 4 + 1] = vb[1]; b[q * 4 + 2] = vb[2]; b[q * 4 + 3] = vb[3]; }
    merge16_desc(a, b);
    u32x4 o; o.x = __float_as_uint(fq == 0 ? a[0] : fq == 1 ? a[4] : fq == 2 ? a[8] : a[12]); o.y = __float_as_uint(fq == 0 ? a[1] : fq == 1 ? a[5] : fq == 2 ? a[9] : a[13]);
    o.z = __float_as_uint(fq == 0 ? a[2] : fq == 1 ? a[6] : fq == 2 ? a[10] : a[14]); o.w = __float_as_uint(fq == 0 ? a[3] : fq == 1 ? a[7] : fq == 2 ? a[11] : a[15]);
    *(u32x4*)(p.TOPS + ((size_t)(row0 + r) * 16 + hs) * 16 + fq * 4) = o;
  }
}
__device__ void peer_gather_item(const Params& p, int item, char* lds_) {
  LAS char* lds = (LAS char*)lds_;
  const int tid = threadIdx.x, lane = tid & 63, w = tid >> 6;
  LAS unsigned* LA = (LAS unsigned*)lds;
  LAS int* LE = (LAS int*)(lds + 256 * 33 * 4);
  LAS float* LG = (LAS float*)(lds + 256 * 33 * 4 + 32 * 128 * 4);
  __syncthreads();
  {
    const int tl_ = tid >> 3, h = tid & 7; const int t = item * 32 + tl_;
    const uint4* src = (const uint4*)(p.TOPS + ((size_t)t * 16 + h * 2) * 16);
    float a[16], bq[16];
#pragma unroll
    for (int i = 0; i < 4; ++i) { const uint4 v = src[i]; a[4 * i] = __uint_as_float(v.x); a[4 * i + 1] = __uint_as_float(v.y); a[4 * i + 2] = __uint_as_float(v.z); a[4 * i + 3] = __uint_as_float(v.w); }
#pragma unroll
    for (int i = 0; i < 4; ++i) { const uint4 v = src[4 + i]; bq[4 * i] = __uint_as_float(v.x); bq[4 * i + 1] = __uint_as_float(v.y); bq[4 * i + 2] = __uint_as_float(v.z); bq[4 * i + 3] = __uint_as_float(v.w); }
#pragma unroll
    for (int i = 0; i < 16; ++i) { LA[tid * 33 + i] = __float_as_uint(a[i]); LA[tid * 33 + 16 + i] = __float_as_uint(bq[i]); }
    float c[16];
#pragma unroll
    for (int i = 0; i < 16; ++i) c[i] = -__builtin_inff();
#pragma unroll
    for (int i = 0; i < 16; ++i)
#pragma unroll
      for (int j = 0; j < 16; ++j) if ((i + 1) * (j + 1) <= 16) { const float s = a[i] + bq[j]; ins16(c, __uint_as_float((__float_as_uint(s) & ~255u) | (unsigned)(i * 16 + j))); }
    const float mx = c[0]; float e[16]; float sum = 0.f;
#pragma unroll
    for (int i = 0; i < 16; ++i) { e[i] = __expf(c[i] - mx); sum += e[i]; }
    const float inv = 1.0f / sum;
#pragma unroll
    for (int i = 0; i < 16; ++i) { const unsigned pos = __float_as_uint(c[i]) & 255u; const unsigned ia = LA[tid * 33 + (pos >> 4)] & 127u, ib = LA[tid * 33 + 16 + (pos & 15u)] & 127u;
      LE[tl_ * 128 + h * 16 + i] = (int)(ia * 128u + ib); LG[tl_ * 128 + h * 16 + i] = e[i] * inv; }
  }
  __syncthreads();
  LAS char* HQ = (LAS char*)LA;
  const int fr = lane & 15, fq = lane >> 4;
  for (int ti = 0; ti < 8; ++ti) {
    const int tl_ = w * 8 + ti; const int t = item * 32 + tl_;
    const float rs = row_rs16(p.ss_h2, t) * 16.0f;
    { const uint4 ha = *(const uint4*)(p.H2B + (size_t)t * 1024 + lane * 16), hb = *(const uint4*)(p.H2B + (size_t)t * 1024 + lane * 16 + 8);
      const unsigned hw[8] = {ha.x, ha.y, ha.z, ha.w, hb.x, hb.y, hb.z, hb.w}; u32x4 q;
#pragma unroll
      for (int i = 0; i < 4; ++i) { const float4 g = *(const float4*)(p.norm_peer_g + lane * 16 + 4 * i); int wd = 0;
        wd = __builtin_amdgcn_cvt_pk_fp8_f32(__uint_as_float(hw[2 * i] << 16) * rs * g.x, __uint_as_float(hw[2 * i] & 0xffff0000u) * rs * g.y, wd, false);
        wd = __builtin_amdgcn_cvt_pk_fp8_f32(__uint_as_float(hw[2 * i + 1] << 16) * rs * g.z, __uint_as_float(hw[2 * i + 1] & 0xffff0000u) * rs * g.w, wd, true); q[i] = (unsigned)wd; }
      *(LAS u32x4*)(HQ + tl_ * 1024 + lane * 16) = q; }
    f32x2 oa[8];
#pragma unroll
    for (int i = 0; i < 8; ++i) oa[i] = (f32x2){0.f, 0.f};
    for (int bt = 0; bt < 8; ++bt) {
      const LAS int* LEb = LE + tl_ * 128 + bt * 16; const LAS float* LGb = LG + tl_ * 128 + bt * 16;
      const int er = LEb[fr];
      typedef int i32x8 __attribute__((ext_vector_type(8)));
      u32x4 uq[8]; uint2 vqa[8], vqb[8];
      const unsigned char* ub = p.PU8 + (size_t)er * 512 + fq * 16;
#pragma unroll
      for (int ks = 0; ks < 8; ++ks) uq[ks] = *(const u32x4*)(ub + ks * 64);
#pragma unroll
      for (int x = 0; x < 8; ++x) { const int ex = __builtin_amdgcn_readlane(er, x); vqa[x] = *(const uint2*)(p.PV8 + (size_t)ex * 512 + lane * 8); }
#pragma unroll
      for (int x = 0; x < 8; ++x) { const int ex = __builtin_amdgcn_readlane(er, 8 + x); vqb[x] = *(const uint2*)(p.PV8 + (size_t)ex * 512 + lane * 8); }
      int e4[4]; float g4[4], su4[4], sv4[4];
#pragma unroll
      for (int j = 0; j < 4; ++j) { e4[j] = LEb[fq * 4 + j]; g4[j] = LGb[fq * 4 + j]; su4[j] = p.su[e4[j]]; sv4[j] = p.sv[e4[j]]; }
      f32x4 acc = (f32x4){0.f, 0.f, 0.f, 0.f};
#pragma unroll
      for (int ks = 0; ks < 8; ++ks) { const u32x4 h0 = *(const LAS u32x4*)(HQ + tl_ * 1024 + ks * 128 + fq * 16), h1 = *(const LAS u32x4*)(HQ + tl_ * 1024 + ks * 128 + 64 + fq * 16);
        i32x8 A, B; A[0] = (int)uq[ks].x; A[1] = (int)uq[ks].y; A[2] = (int)uq[ks].z; A[3] = (int)uq[ks].w; A[4] = 0; A[5] = 0; A[6] = 0; A[7] = 0;
        B[0] = (int)h0.x; B[1] = (int)h0.y; B[2] = (int)h0.z; B[3] = (int)h0.w; B[4] = (int)h1.x; B[5] = (int)h1.y; B[6] = (int)h1.z; B[7] = (int)h1.w;
        acc = __builtin_amdgcn_mfma_scale_f32_16x16x128_f8f6f4(A, B, acc, 4  , 0  , 0, 0x7f7f7f7f, 0, 0x7f7f7f7f); }
      float wg[4];
#pragma unroll
      for (int j = 0; j < 4; ++j) wg[j] = g4[j] * gelu_f(acc[j] * su4[j] * 0.0625f) * sv4[j];
#define PEER_V(VQ, X0) { _Pragma("unroll") for (int x = 0; x < 8; ++x) { const float wgt = __int_as_float(__builtin_amdgcn_readlane(__float_as_int(wg[((X0) + x) & 3]), (((X0) + x) >> 2) * 16)); \
        oa[0] += __builtin_amdgcn_cvt_scalef32_pk_f32_fp4(VQ[x].x, 1.0f, 0) * wgt; oa[1] += __builtin_amdgcn_cvt_scalef32_pk_f32_fp4(VQ[x].x, 1.0f, 1) * wgt; \
        oa[2] += __builtin_amdgcn_cvt_scalef32_pk_f32_fp4(VQ[x].x, 1.0f, 2) * wgt; oa[3] += __builtin_amdgcn_cvt_scalef32_pk_f32_fp4(VQ[x].x, 1.0f, 3) * wgt; \
        oa[4] += __builtin_amdgcn_cvt_scalef32_pk_f32_fp4(VQ[x].y, 1.0f, 0) * wgt; oa[5] += __builtin_amdgcn_cvt_scalef32_pk_f32_fp4(VQ[x].y, 1.0f, 1) * wgt; \
        oa[6] += __builtin_amdgcn_cvt_scalef32_pk_f32_fp4(VQ[x].y, 1.0f, 2) * wgt; oa[7] += __builtin_amdgcn_cvt_scalef32_pk_f32_fp4(VQ[x].y, 1.0f, 3) * wgt; } }
      PEER_V(vqa, 0)
      PEER_V(vqb, 8)
    }
    { const uint4 ha = *(const uint4*)(p.H2B + (size_t)t * 1024 + lane * 16), hb = *(const uint4*)(p.H2B + (size_t)t * 1024 + lane * 16 + 8);
      const unsigned hw[8] = {ha.x, ha.y, ha.z, ha.w, hb.x, hb.y, hb.z, hb.w};
      float* op = p.out + (size_t)t * 1024 + lane * 16;
#pragma unroll
      for (int i = 0; i < 4; ++i) { const f32x2 a = oa[2 * i], b = oa[2 * i + 1];
        *(float4*)(op + 4 * i) = make_float4(__uint_as_float(hw[2 * i] << 16) + a.x, __uint_as_float(hw[2 * i] & 0xffff0000u) + a.y, __uint_as_float(hw[2 * i + 1] << 16) + b.x, __uint_as_float(hw[2 * i + 1] & 0xffff0000u) + b.y); } }
  }
}

#define XCD_TILES(NCT, CALL) do { if ((nb & 7) == 0 && nb >= 8) { const int xcd_ = bid & 7, lb_ = bid >> 3, nlb_ = nb >> 3; \
    for (int i_ = lb_; i_ < 16 * (NCT); i_ += nlb_) { const int t = (xcd_ * 16 + i_ / (NCT)) * (NCT) + (i_ % (NCT)); CALL; } } \
  else { for (int t = bid; t < 128 * (NCT); t += nb) { CALL; } } } while (0)
template <int PH>
__device__ __forceinline__ void run_phase(const Params& p, char* lds, int bid, int nb) {
  if (PH == 0) {
    const int nt_in = 16 * 32, nt_glu = 8 * 8, nt_out = 16 * 16, nt_m = 16 * 16, nt_pq = 16 * 32;
    const int total = nt_in + nt_glu + nt_out + 4 * nt_m + nt_pq;
    for (int t = bid; t < total; t += nb) {
      int i = t; float* tl = (float*)lds;
      if (i < nt_in) { transpose_tile(p.w_in, p.WtIn, 1024, 2048, i, p.norm_mix_g, p.norm_mix_g, 1024, tl); continue; } i -= nt_in;
      if (i < nt_glu) { transpose_tile(p.w_glu, p.WtGlu, 512, 512, i, nullptr, nullptr, 0, tl); continue; } i -= nt_glu;
      if (i < nt_out) { transpose_tile(p.w_out, p.WtOut, 1024, 1024, i, p.att_out_g, p.ssm_out_g, 512, tl); continue; } i -= nt_out;
      if (i < nt_m) { transpose_tile(p.w_mem_q, p.WtMq, 1024, 1024, i, p.norm_mem_g, p.norm_mem_g, 1024, tl); continue; } i -= nt_m;
      if (i < nt_m) { transpose_tile(p.w_mem_k, p.WtMk, 1024, 1024, i, p.norm_memkv_g, p.norm_memkv_g, 1024, tl); continue; } i -= nt_m;
      if (i < nt_m) { transpose_tile(p.w_mem_v, p.WtMv, 1024, 1024, i, p.norm_memkv_g, p.norm_memkv_g, 1024, tl); continue; } i -= nt_m;
      if (i < nt_m) { transpose_tile(p.w_mem_o, p.WtMo, 1024, 1024, i, nullptr, nullptr, 0, tl); continue; } i -= nt_m;
      transpose_tile(p.w_peer_q, p.WtPq, 1024, 2048, i, p.norm_peer_g, p.norm_peer_g, 1024, tl);
    }
    convert_flat(p.peer_keys, p.PK, (size_t)16 * 128 * 128 / 8, bid, nb);
    rows_fp4<false>(p.peer_u, p.PU8, p.su, 16384, bid, nb);
    rows_fp4<false>(p.peer_v, p.PV8, p.sv, 16384, bid, nb);
    rows_bf16_rs(p.x, p.XB, p.rs_x, T_TOK, bid, nb);
    rows_bf16_rs(p.mem, p.MEMB, p.rs_mem, 512, bid, nb);
    for (int i = bid * NTHREADS + threadIdx.x; i < 2048; i += nb * NTHREADS) ssm_stage1(p, i);
    if (bid == nb - 1 && threadIdx.x < 9) {
      const int hh = threadIdx.x; float sh;
      if (hh < 8) { float mb = -1e30f, gq = 0.f, gk = 0.f; for (int i = 0; i < 192; ++i) mb = fmaxf(mb, p.rel_bias[hh * 192 + i]);
        for (int i = 0; i < 64; ++i) { gq = fmaxf(gq, fabsf(p.att_q_g[i])); gk = fmaxf(gk, fabsf(p.att_k_g[i])); }
        sh = (mb + 8.0f * gq * gk * 1.02f) * 1.44269504f; }
      else { float g = 0.f; for (int i = 0; i < 256; ++i) g = fmaxf(g, fabsf(p.mem_q_g[i] * p.mem_k_g[i])); sh = 16.0f * g * 1.02f * 1.44269504f; }
      p.SHF[hh] = sh; }
  } else if (PH == 1) {
    XCD_TILES(16, { if (((t & 15) >> 2) == 2) tile_win_v(p, t, lds); else tile_win(p, t, lds); });
    ssm_stage2a(p, bid, nb);
  } else if (PH == 2) {
    for (int t = nb - 1 - bid; t < 64; t += nb) tile_memkv(p, t, lds);
    chunk_attn_prep(p, lds);
    if ((nb & 7) == 0 && nb >= 8) { const int xcd_ = bid & 7, lb_ = bid >> 3, nlb_ = nb >> 3; const int per = (256 + nlb_ - 1) / nlb_;
      for (int k_ = 0; k_ < per; ++k_) { const int i_ = lb_ * per + k_; if (i_ < 256) chunk_attn_item(p, i_ * 8 + xcd_, lds); } }
    else { for (int t = bid; t < 2048; t += nb) chunk_attn_item(p, t, lds); }
    for (int t = bid; t < 2048; t += nb) ssm_item<false>(p, t, lds);
    ssm_stage2b(p, bid, nb);
  } else if (PH == 3) {
    memk_fix(p, bid, nb);
    for (int t = bid; t < 2048; t += nb) ssm_item<true>(p, t, lds);
  } else if (PH == 4) {
    XCD_TILES(4, tile_glu(p, t, lds));
  } else if (PH == 5) {
    XCD_TILES(8, tile_wout(p, t, lds));
  } else if (PH == 6) {
    XCD_TILES(8, tile_memq(p, t, lds));
  } else if (PH == 7) {
    for (int t = bid; t < 1024; t += nb) mem_attn_item(p, t, lds);
  } else if (PH == 8) {
    XCD_TILES(8, tile_memo(p, t, lds));
  } else if (PH == 9) {
    XCD_TILES(16, tile_peer(p, t, lds));
  } else if (PH == 11) {
    for (int t = bid; t < 512; t += nb) peer_gather_item(p, t, lds);
  }
}

#if !MEGA
template <int PH>
__global__ void __launch_bounds__(NTHREADS, 2) phase_kernel(Params p) {
  extern __shared__ __attribute__((aligned(16))) char lds[];
  run_phase<PH>(p, lds, blockIdx.x, gridDim.x);
}

#endif
#ifndef REPEAT_PH
#define REPEAT_PH -1
#endif
#define RUNPH(k) do { run_phase<k>(p, lds, bid, nb); if (REPEAT_PH == k) { xcd_barrier(xb); run_phase<k>(p, lds, bid, nb); } } while (0)
__global__ void __launch_bounds__(NTHREADS, 2) mega_kernel(Params p) {
  extern __shared__ __attribute__((aligned(16))) char lds[];
  const int bid = blockIdx.x, nb = gridDim.x;
  volatile LAS unsigned* stw = (volatile LAS unsigned*)((LAS char*)lds + LDS_WORK);
  if (threadIdx.x == 0) { stw[0] = 0u; stw[1] = 0u; stw[2] = 0u; stw[3] = 0u; }
  __syncthreads();
  XcdBarrier xb = xcd_barrier_post(p.bar, stw);
  RUNPH(0); xcd_barrier(xb);
  RUNPH(1); xcd_barrier(xb);
  RUNPH(2); xcd_barrier(xb);
  RUNPH(3); xcd_barrier(xb);
  RUNPH(4); xcd_barrier(xb);
  RUNPH(5); xcd_barrier(xb);
  RUNPH(6); xcd_barrier(xb);
  RUNPH(7); xcd_barrier(xb);
  RUNPH(8); xcd_barrier(xb);
  RUNPH(9); xcd_barrier(xb);
  RUNPH(11);
}

#if !MEGA
template <int PH> static void launch_phase(const Params& p, int grid, hipStream_t s) {
  hipFuncSetAttribute((const void*)phase_kernel<PH>, hipFuncAttributeMaxDynamicSharedMemorySize, LDS_BYTES);
  phase_kernel<PH><<<grid, NTHREADS, LDS_BYTES, s>>>(p);
}
#endif

extern "C" void kernel_launch(void* const* d_in, const int* in_sizes, int n_in, void* d_out, int out_size, void* d_ws, size_t ws_size, hipStream_t stream) {
  Params p{};
  const float** f = (const float**)&p;
  for (int i = 0; i < 33; ++i) f[i] = (const float*)d_in[i];
  p.out = (float*)d_out;
  char* ws = (char*)d_ws; size_t off = 0;
  auto take = [&](size_t bytes) { char* r = ws + off; off += (bytes + 255) & ~(size_t)255; return r; };
  const size_t MB = 1u << 20;
  p.bar = (unsigned*)take(16384);
  p.WtIn = (bf16_t*)take(4 * MB); p.WtGlu = (bf16_t*)take(MB / 2); p.WtOut = (bf16_t*)take(2 * MB);
  p.WtMq = (bf16_t*)take(2 * MB); p.WtMk = (bf16_t*)take(2 * MB); p.WtMv = (bf16_t*)take(2 * MB); p.WtMo = (bf16_t*)take(2 * MB); p.WtPq = (bf16_t*)take(4 * MB);
  p.PK = (bf16_t*)take(MB / 2); p.PU8 = (unsigned char*)take(8 * MB); p.PV8 = (unsigned char*)take(8 * MB); p.su = (float*)take(16384 * 4); p.sv = (float*)take(16384 * 4);
  char* RA = take(64 * MB); char* RB = take(64 * MB);
  p.XB = (bf16_t*)RA; p.ATT = (bf16_t*)RA; p.YG = (bf16_t*)(RA + 16 * MB); p.QM = (bf16_t*)RA; p.H2B = (bf16_t*)RA;
  p.SSMO = (bf16_t*)(RA + 32 * MB); p.OM = (bf16_t*)(RA + 32 * MB);
  p.Qb = (bf16_t*)RB; p.Kb = (bf16_t*)(RB + 16 * MB); p.VT = (bf16_t*)(RB + 32 * MB); p.Ub = (bf16_t*)(RB + 48 * MB); p.H1B = (bf16_t*)RB; p.QP = (bf16_t*)RB;
  p.TOPS = (unsigned*)take(16 * MB);
  p.MEMB = (bf16_t*)take(MB); p.KMB = (bf16_t*)take(MB); p.VMT = (bf16_t*)take(MB); p.KMraw = (float*)take(2 * MB);
  p.WE16 = (bf16_t*)take(2 * MB); p.WY = (bf16_t*)take(6 * MB);
  p.rs_x = (float*)take(T_TOK * 4); p.rs_mem = (float*)take(512 * 4); p.ss_att = (float*)take(T_TOK * 8 * 4); p.ss_ssm = (float*)take(T_TOK * 8 * 4);
  p.ss_h1 = (float*)take(T_TOK * 16 * 4); p.ss_qm = (float*)take(T_TOK * 16 * 4); p.ss_km = (float*)take(512 * 16 * 4); p.ss_h2 = (float*)take(T_TOK * 16 * 4);
  p.ESEG = (float*)take(2 * 32 * 32 * 128 * 4);
  p.BBR = (float*)take(2048 * 16 * 4); p.BBI = (float*)take(2048 * 16 * 4); p.PWR = (float*)take(32 * 17 * 64 * 4); p.PWI = (float*)take(32 * 17 * 64 * 4); p.KJ = (float*)take(32 * 16 * 256 * 4); p.SHF = (float*)take(256); p.APW = (float*)take(5 * 4096 * 4);
  if (off > ws_size) { fprintf(stderr, "workspace too small: need %zu have %zu\n", off, ws_size); return; }
#if MEGA
  hipMemsetAsync(p.bar, 0, 16384, stream);
  static int grid_blocks = 0;
  if (!grid_blocks) {
    int dev = 0, cus = 0, per_cu = 0; hipGetDevice(&dev); hipDeviceGetAttribute(&cus, hipDeviceAttributeMultiprocessorCount, dev);
    hipFuncSetAttribute((const void*)mega_kernel, hipFuncAttributeMaxDynamicSharedMemorySize, LDS_BYTES);
    hipOccupancyMaxActiveBlocksPerMultiprocessor(&per_cu, mega_kernel, NTHREADS, LDS_BYTES);
    if (per_cu > 2) per_cu = 2; if (per_cu < 1) per_cu = 1;
    grid_blocks = cus * per_cu;
  }
  void* args[] = {&p};
  hipError_t e = hipLaunchCooperativeKernel((void*)mega_kernel, dim3(grid_blocks), dim3(NTHREADS), args, LDS_BYTES, stream);
  if (e != hipSuccess) fprintf(stderr, "cooperative launch failed: %s (grid %d)\n", hipGetErrorString(e), grid_blocks);
#else
  const int G = 1024;
  launch_phase<0>(p, G, stream); launch_phase<1>(p, G, stream); launch_phase<2>(p, G, stream); launch_phase<3>(p, G, stream);
  launch_phase<4>(p, G, stream); launch_phase<5>(p, G, stream); launch_phase<6>(p, G, stream); launch_phase<7>(p, G, stream);
  launch_phase<8>(p, G, stream); launch_phase<9>(p, G, stream); launch_phase<11>(p, G, stream);
#endif
}
```

```cpp
#include <hip/hip_runtime.h>
#include <hip/hip_cooperative_groups.h>
#include <cstdio>
#include <cstdint>
namespace cg = cooperative_groups;

#ifndef MEGA
#define MEGA 1
#endif

typedef unsigned short bf16_t;
typedef short bf16x8 __attribute__((ext_vector_type(8)));
typedef float f32x4 __attribute__((ext_vector_type(4)));
typedef unsigned u32x4 __attribute__((ext_vector_type(4)));
#define LAS __attribute__((address_space(3)))
__device__ __forceinline__ bf16x8 as_bf(u32x4 v) { return __builtin_bit_cast(bf16x8, v); }

#define T_TOK 16384
#define SEQL 8192
#define NTHREADS 256
#define LDS_WORK 74752
#define LDS_BYTES (LDS_WORK + 16)
#define EPSF 1e-6f

typedef float f32x2_ __attribute__((ext_vector_type(2)));
typedef __bf16 bf16x2v __attribute__((ext_vector_type(2)));
__device__ __forceinline__ unsigned pack2(float lo, float hi) { f32x2_ v = {lo, hi}; bf16x2v b = __builtin_convertvector(v, bf16x2v); return __builtin_bit_cast(unsigned, b); }
__device__ __forceinline__ unsigned short f2bf(float f) { return (unsigned short)(pack2(f, 0.f) & 0xffffu); }
__device__ __forceinline__ float bf2f(unsigned short b) { return __uint_as_float(((unsigned)b) << 16); }
__device__ __forceinline__ float gelu_f(float v) {
  const float av = fabsf(v), t = __builtin_amdgcn_rcpf(av * 0.2316418882f + 1.0f);
  float q = t * 0.5307027145f + (-0.7265760135f); q = q * t + 0.7107068705f; q = q * t + (-0.142248368f); q = q * t + 0.127414796f; q = q * t;
  const float e = __builtin_amdgcn_exp2f((v * v) * (-0.72134752044f)); const float m = v * (q * e);
  return v < 0.f ? m : v - m; }
typedef float f32x2 __attribute__((ext_vector_type(2)));
__device__ __forceinline__ f32x4 mfma16(bf16x8 a, bf16x8 b, f32x4 c) { return __builtin_amdgcn_mfma_f32_16x16x32_bf16(a, b, c, 0, 0, 0); }


#define XB_TMO      128
#define XB_XCNT(j)  (256  + 64 * (j))
#define XB_XSUB(j)  (1280 + 64 * (j))
#define XB_XGEN(j)  (2304 + 64 * (j))
#define XB_TOP      3328
#define XB_TOPGEN   3392
#define XCD_BAR_WORDS 3456
#define XB_SPIN_CAP (1u << 18)
__device__ __forceinline__ unsigned xb_ld(unsigned* p)              { return __hip_atomic_load(p, __ATOMIC_RELAXED, __HIP_MEMORY_SCOPE_AGENT); }
__device__ __forceinline__ unsigned xb_add(unsigned* p, unsigned v) { return __hip_atomic_fetch_add(p, v, __ATOMIC_RELAXED, __HIP_MEMORY_SCOPE_AGENT); }
__device__ __forceinline__ unsigned xb_xcc_id() { return (unsigned)__builtin_amdgcn_s_getreg((3 << 11) | 20) & 0xFu; }
#define XB_SPIN(cond, bar) do { unsigned _sp = 0; while (cond) { __builtin_amdgcn_s_sleep(1); \
    if ((++_sp & 255u) == 0u) { if (xb_ld(&(bar)[XB_TMO])) break; if (_sp > XB_SPIN_CAP) { atomicAdd(&(bar)[XB_TMO], 1u); break; } } } } while (0)
struct XcdBarrier { unsigned* bar; unsigned x; volatile LAS unsigned* st; };
__device__ __forceinline__ XcdBarrier xcd_barrier_post(unsigned* bar, volatile LAS unsigned* st) {
  XcdBarrier b; b.bar = bar; b.x = xb_xcc_id(); b.st = st;
  if (threadIdx.x == 0) (void)xb_add(&bar[XB_XCNT(b.x)], 1u);
  return b;
}
__device__ __forceinline__ void xcd_barrier_complete(unsigned* bar, unsigned x, unsigned& nloc, unsigned& nx) {
  const unsigned G = gridDim.x * gridDim.y * gridDim.z;
  unsigned sum, cnt, mine, sp = 0u;
  for (;;) {
    sum = 0u; cnt = 0u; mine = 0u;
#pragma unroll
    for (unsigned j = 0; j < 16; ++j) { const unsigned c = xb_ld(&bar[XB_XCNT(j)]); sum += c; cnt += (c > 0u) ? 1u : 0u; mine = (j == x) ? c : mine; }
    if (sum == G) break;
    __builtin_amdgcn_s_sleep(1);
    if ((++sp & 255u) == 0u) { if (xb_ld(&bar[XB_TMO])) break; if (sp > XB_SPIN_CAP) { atomicAdd(&bar[XB_TMO], 1u); break; } }
  }
  nloc = mine > 0u ? mine : 1u; nx = cnt > 0u ? cnt : 1u;
}
__device__ __forceinline__ void xcd_barrier(const XcdBarrier& b) {
  asm volatile("s_waitcnt vmcnt(0)" ::: "memory");
  __syncthreads();
  if (threadIdx.x == 0) {
    unsigned* bar = b.bar;
    __builtin_amdgcn_s_waitcnt(0);
    unsigned nloc = b.st[0], nx = b.st[1];
    if (nloc == 0u) { xcd_barrier_complete(bar, b.x, nloc, nx); b.st[0] = nloc; b.st[1] = nx; }
    const unsigned old = xb_add(&bar[XB_XSUB(b.x)], 1u);
    const unsigned gen = old / nloc;
    if (old + 1u == (gen + 1u) * nloc) {
      __builtin_amdgcn_fence(__ATOMIC_RELEASE, "agent");
      asm volatile("s_waitcnt vmcnt(0)" ::: "memory");
      const unsigned og = xb_add(&bar[XB_TOP], 1u);
      const unsigned tg = og / nx;
      if (og + 1u == (tg + 1u) * nx) xb_add(&bar[XB_TOPGEN], 1u);
      else XB_SPIN(xb_ld(&bar[XB_TOPGEN]) == tg, bar);
      __builtin_amdgcn_fence(__ATOMIC_ACQUIRE, "agent");
      xb_add(&bar[XB_XGEN(b.x)], 1u);
      asm volatile("s_waitcnt vmcnt(0)" ::: "memory");
    } else {
      XB_SPIN(xb_ld(&bar[XB_XGEN(b.x)]) == gen, bar);
      __builtin_amdgcn_fence(__ATOMIC_ACQUIRE, "agent");
      asm volatile("s_waitcnt vmcnt(0)" ::: "memory");
    }
  }
  __syncthreads();
}

struct Params {
  const float *x, *mem, *norm_mix_g, *w_in, *att_q_g, *att_k_g, *rel_bias;
  const float *lam_re, *lam_im, *log_step, *b_re, *b_im, *c_re, *c_im, *d_skip, *w_glu, *b_glu;
  const float *att_out_g, *ssm_out_g, *w_out, *norm_mem_g, *norm_memkv_g, *w_mem_q, *w_mem_k, *w_mem_v;
  const float *mem_q_g, *mem_k_g, *w_mem_o, *norm_peer_g, *w_peer_q, *peer_keys, *peer_u, *peer_v;
  float* out;
  unsigned* bar;
  bf16_t *WtIn, *WtGlu, *WtOut, *WtMq, *WtMk, *WtMv, *WtMo, *WtPq, *PK, *PU, *PV;
  bf16_t *XB, *MEMB, *Qb, *Kb, *VT, *Ub, *ATT, *YG, *SSMO, *H1B, *QM, *OM, *H2B, *QP;
  bf16_t *KMB, *VMT, *WE16, *WY;
  float *rs_x, *rs_mem, *ss_att, *ss_ssm, *ss_h1, *ss_qm, *ss_km, *ss_h2, *KMraw, *ESEG;
  float *BBR, *BBI, *PWR, *PWI, *KJ, *APW, *SHF;
  unsigned* TOPS;
  unsigned char *PU8, *PV8; float *su, *sv;
};

#define GAS __attribute__((address_space(1)))
#define RAW_BARRIER() do { asm volatile("s_waitcnt lgkmcnt(0)" ::: "memory"); __builtin_amdgcn_s_barrier(); } while (0)
__device__ __forceinline__ void glds16(const void* gsrc, unsigned lds_dst) {
  unsigned keep;
  asm volatile("s_mov_b32 %0, m0\n\ts_mov_b32 m0, %2\n\ts_nop 0\n\tglobal_load_lds_dwordx4 %1, off\n\ts_mov_b32 m0, %0" : "=&s"(keep) : "v"(gsrc), "s"(lds_dst) : "memory");
}
template <bool ZERO = true, bool SWAP = false>
__device__ __forceinline__ void gemm_mainloop(f32x4 (&acc)[4][4], const bf16_t* __restrict__ A, int lda, const bf16_t* __restrict__ Bt, int ldb, int K,
                                              int row0, int col0, char* lds_) {
  LAS char* lds = (LAS char*)lds_;
  const int tid = threadIdx.x, lane = tid & 63, w = tid >> 6, wr = w >> 1, wc = w & 1, fr = lane & 15, fq = lane >> 4;
  if (ZERO) {
#pragma unroll
    for (int m = 0; m < 4; ++m)
#pragma unroll
      for (int n = 0; n < 4; ++n) acc[m][n] = (f32x4){0.f, 0.f, 0.f, 0.f};
  }
  const int lr = lane >> 3, lc = (lane & 7) ^ lr;
  const bf16_t* gA = A + (size_t)(row0 + w * 32 + lr) * lda + lc * 8;
  const bf16_t* gB = Bt + (size_t)(col0 + w * 32 + lr) * ldb + lc * 8;
  const unsigned wbase = (unsigned)(size_t)lds + (unsigned)__builtin_amdgcn_readfirstlane(w) * 4096u;
  const int nk = K >> 6;
  __syncthreads();
#pragma unroll
  for (int i = 0; i < 4; ++i) { glds16(gA + (size_t)(i * 8) * lda, wbase + i * 1024u); glds16(gB + (size_t)(i * 8) * ldb, wbase + 16384u + i * 1024u); }
  for (int kt = 0; kt < nk; ++kt) {
    asm volatile("s_waitcnt vmcnt(0)" ::: "memory");
    RAW_BARRIER();
    LAS char* cur = lds + (kt & 1) * 32768;
    if (kt + 1 < nk) { const int k1 = (kt + 1) << 6; const unsigned nb_ = wbase + (unsigned)(((kt + 1) & 1) * 32768);
#pragma unroll
      for (int i = 0; i < 4; ++i) { glds16(gA + (size_t)(i * 8) * lda + k1, nb_ + i * 1024u); glds16(gB + (size_t)(i * 8) * ldb + k1, nb_ + 16384u + i * 1024u); } }
#pragma unroll
    for (int ks = 0; ks < 2; ++ks) {
      bf16x8 af[4], bfr[4];
      const int kc = ks * 4 + fq;
#pragma unroll
      for (int m = 0; m < 4; ++m) { const int r = wr * 64 + m * 16 + fr; af[m] = as_bf(*(const LAS u32x4*)(cur + r * 128 + ((kc ^ (r & 7)) << 4))); }
#pragma unroll
      for (int n = 0; n < 4; ++n) { const int r = wc * 64 + n * 16 + fr; bfr[n] = as_bf(*(const LAS u32x4*)(cur + 16384 + r * 128 + ((kc ^ (r & 7)) << 4))); }
#pragma unroll
      for (int m = 0; m < 4; ++m)
#pragma unroll
        for (int n = 0; n < 4; ++n) acc[m][n] = SWAP ? mfma16(af[m], bfr[n], acc[m][n]) : mfma16(bfr[n], af[m], acc[m][n]);
    }
  }
  RAW_BARRIER();
}

__device__ __forceinline__ void transpose_tile(const float* __restrict__ src, bf16_t* __restrict__ dst, int K, int N, int tile, const float* g0, const float* g1, int split, float* tl  ) {
  const int ntn = N >> 6; const int tk = tile / ntn, tn = tile % ntn; const int k0 = tk << 6, n0 = tn << 6; const int tid = threadIdx.x;
  __syncthreads();
#pragma unroll
  for (int i = 0; i < 4; ++i) { const int kk = i * 16 + (tid >> 4), nn = (tid & 15) * 4; const int k = k0 + kk;
    float g = 1.f; if (g0) g = (k < split) ? g0[k] : g1[k - split];
    const float4 v = *(const float4*)(src + (size_t)k * N + n0 + nn);
    tl[kk * 65 + nn] = v.x * g; tl[kk * 65 + nn + 1] = v.y * g; tl[kk * 65 + nn + 2] = v.z * g; tl[kk * 65 + nn + 3] = v.w * g; }
  __syncthreads();
  const int n = tid >> 2, kq = (tid & 3) * 16;
  unsigned o[8];
#pragma unroll
  for (int j = 0; j < 8; ++j) o[j] = pack2(tl[(kq + 2 * j) * 65 + n], tl[(kq + 2 * j + 1) * 65 + n]);
  uint4* d = (uint4*)(dst + (size_t)(n0 + n) * K + k0 + kq);
  d[0] = make_uint4(o[0], o[1], o[2], o[3]); d[1] = make_uint4(o[4], o[5], o[6], o[7]);
}

__device__ __forceinline__ void convert_flat(const float* __restrict__ src, bf16_t* __restrict__ dst, size_t n8  , int bid, int nb) {
  for (size_t i = (size_t)bid * NTHREADS + threadIdx.x; i < n8; i += (size_t)nb * NTHREADS) {
    const float4 a = ((const float4*)src)[2 * i], b = ((const float4*)src)[2 * i + 1];
    ((uint4*)dst)[i] = make_uint4(pack2(a.x, a.y), pack2(a.z, a.w), pack2(b.x, b.y), pack2(b.z, b.w));
  }
}
__device__ __forceinline__ void rows_bf16_rs(const float* __restrict__ src, bf16_t* __restrict__ dst, float* __restrict__ rs, int nrows, int bid, int nb) {
  const int lane = threadIdx.x & 63, w = threadIdx.x >> 6; const int nwv = nb * 4;
  for (int row0 = bid * 4 + w; row0 < nrows; row0 += nwv * 4) {
    float4 v[4][4];
#pragma unroll
    for (int r = 0; r < 4; ++r) { const int row = row0 + r * nwv; if (row < nrows) { const float4* s = (const float4*)(src + (size_t)row * 1024);
#pragma unroll
        for (int i = 0; i < 4; ++i) v[r][i] = s[i * 64 + lane]; } }
#pragma unroll
    for (int r = 0; r < 4; ++r) { const int row = row0 + r * nwv; if (row < nrows) {
      float ss = 0.f; uint2* d = (uint2*)(dst + (size_t)row * 1024);
#pragma unroll
      for (int i = 0; i < 4; ++i) { const float4 x = v[r][i]; ss += x.x * x.x + x.y * x.y + x.z * x.z + x.w * x.w; d[i * 64 + lane] = make_uint2(pack2(x.x, x.y), pack2(x.z, x.w)); }
#pragma unroll
      for (int o = 32; o > 0; o >>= 1) ss += __shfl_xor(ss, o);
      if (lane == 0) rs[row] = rsqrtf(ss * (1.0f / 1024.0f) + EPSF); } }
  }
}
__device__ __forceinline__ void rows_fp8(const float* __restrict__ src, unsigned char* __restrict__ dst, float* __restrict__ sc, int nrows, int bid, int nb) {
  const int lane = threadIdx.x & 63, w = threadIdx.x >> 6;
  for (int row = bid * 4 + w; row < nrows; row += nb * 4) {
    const float4* s = (const float4*)(src + (size_t)row * 1024);
    float4 v[4]; float am = 0.f;
#pragma unroll
    for (int i = 0; i < 4; ++i) { v[i] = s[i * 64 + lane]; am = fmaxf(am, fmaxf(fmaxf(fabsf(v[i].x), fabsf(v[i].y)), fmaxf(fabsf(v[i].z), fabsf(v[i].w)))); }
#pragma unroll
    for (int o = 32; o > 0; o >>= 1) am = fmaxf(am, __shfl_xor(am, o));
    const float q = (am > 0.f) ? 224.0f / am : 1.0f;
    unsigned* d = (unsigned*)(dst + (size_t)row * 1024);
#pragma unroll
    for (int i = 0; i < 4; ++i) { int wd = 0; wd = __builtin_amdgcn_cvt_pk_fp8_f32(v[i].x * q, v[i].y * q, wd, false); wd = __builtin_amdgcn_cvt_pk_fp8_f32(v[i].z * q, v[i].w * q, wd, true); d[i * 64 + lane] = (unsigned)wd; }
    if (lane == 0) sc[row] = (am > 0.f) ? am * (1.0f / 224.0f) : 1.0f;
  }
}

template <bool SWAPN>
__device__ __forceinline__ void rows_fp4(const float* __restrict__ src, unsigned char* __restrict__ dst, float* __restrict__ sc, int nrows, int bid, int nb) {
  const int lane = threadIdx.x & 63, w = threadIdx.x >> 6; const int nwv = nb * 4;
  for (int row0 = bid * 4 + w; row0 < nrows; row0 += nwv * 4) {
    float4 v[4][4];
#pragma unroll
    for (int r = 0; r < 4; ++r) { const int row = row0 + r * nwv; if (row < nrows) { const float4* s = (const float4*)(src + (size_t)row * 1024 + lane * 16);
#pragma unroll
        for (int i = 0; i < 4; ++i) v[r][i] = s[i]; } }
#pragma unroll
    for (int r = 0; r < 4; ++r) { const int row = row0 + r * nwv; if (row < nrows) {
      float am = 0.f;
#pragma unroll
      for (int i = 0; i < 4; ++i) am = fmaxf(am, fmaxf(fmaxf(fabsf(v[r][i].x), fabsf(v[r][i].y)), fmaxf(fabsf(v[r][i].z), fabsf(v[r][i].w))));
#pragma unroll
      for (int o = 32; o > 0; o >>= 1) am = fmaxf(am, __shfl_xor(am, o));
      const float q = (am > 0.f) ? 6.0f / am : 1.0f;
      unsigned w0 = 0, w1 = 0;
      w0 = __builtin_amdgcn_cvt_scalef32_pk_fp4_f32(w0, v[r][0].x * q, v[r][0].y * q, 1.0f, 0); w0 = __builtin_amdgcn_cvt_scalef32_pk_fp4_f32(w0, v[r][0].z * q, v[r][0].w * q, 1.0f, 1);
      w0 = __builtin_amdgcn_cvt_scalef32_pk_fp4_f32(w0, v[r][1].x * q, v[r][1].y * q, 1.0f, 2); w0 = __builtin_amdgcn_cvt_scalef32_pk_fp4_f32(w0, v[r][1].z * q, v[r][1].w * q, 1.0f, 3);
      w1 = __builtin_amdgcn_cvt_scalef32_pk_fp4_f32(w1, v[r][2].x * q, v[r][2].y * q, 1.0f, 0); w1 = __builtin_amdgcn_cvt_scalef32_pk_fp4_f32(w1, v[r][2].z * q, v[r][2].w * q, 1.0f, 1);
      w1 = __builtin_amdgcn_cvt_scalef32_pk_fp4_f32(w1, v[r][3].x * q, v[r][3].y * q, 1.0f, 2); w1 = __builtin_amdgcn_cvt_scalef32_pk_fp4_f32(w1, v[r][3].z * q, v[r][3].w * q, 1.0f, 3);
      *(uint2*)(dst + (size_t)row * 512 + lane * 8) = make_uint2(w0, w1);
      if (lane == 0) sc[row] = (am > 0.f) ? am * (1.0f / 6.0f) : 1.0f; } }
  }
}

__device__ __forceinline__ void ssm_stage1(const Params& p, int gp) {
  const int g = gp >> 6;
  const float step = expf(p.log_step[g]); const float lr = p.lam_re[gp], li = p.lam_im[gp];
  const float mag = expf(lr * step); const float ar = mag * cosf(li * step), ai = mag * sinf(li * step);
  const float zr = ar - 1.0f, den = lr * lr + li * li; const float fr = (zr * lr + ai * li) / den, fi = (ai * lr - zr * li) / den;
  for (int c = 0; c < 16; ++c) { const float br = p.b_re[gp * 16 + c], bi = p.b_im[gp * 16 + c]; p.BBR[gp * 16 + c] = fr * br - fi * bi; p.BBI[gp * 16 + c] = fr * bi + fi * br; }
  float pr = 1.f, pi = 0.f; const int st = gp & 63;
  for (int j = 0; j <= 16; ++j) { p.PWR[(g * 17 + j) * 64 + st] = pr; p.PWI[(g * 17 + j) * 64 + st] = pi; const float nr = pr * ar - pi * ai, ni = pr * ai + pi * ar; if (j < 16) { pr = nr; pi = ni; } }
  const float a16r = pr, a16i = pi; const float a32r = a16r * a16r - a16i * a16i, a32i = 2.f * a16r * a16i;
  const float a48r = a32r * a16r - a32i * a16i, a48i = a32r * a16i + a32i * a16r; const float a64r = a32r * a32r - a32i * a32i, a64i = 2.f * a32r * a32i;
  const float a128r = a64r * a64r - a64i * a64i, a128i = 2.f * a64r * a64i; const float a256r = a128r * a128r - a128i * a128i, a256i = 2.f * a128r * a128i;
  float* A = p.APW;
  A[0 * 4096 + gp] = a16r; A[0 * 4096 + 2048 + gp] = a16i; A[1 * 4096 + gp] = a32r; A[1 * 4096 + 2048 + gp] = a32i; A[2 * 4096 + gp] = a48r; A[2 * 4096 + 2048 + gp] = a48i;
  A[3 * 4096 + gp] = a64r; A[3 * 4096 + 2048 + gp] = a64i; A[4 * 4096 + gp] = a256r; A[4 * 4096 + 2048 + gp] = a256i;
}
__device__ __forceinline__ void ssm_stage2a(const Params& p, int bid, int nb) {
  const int n1 = 32 * 128 * 256, n2 = 32 * 16 * 4 * 512, n3 = 32 * 16 * 256;
  for (int i = bid * NTHREADS + threadIdx.x; i < n1 + n2 + n3; i += nb * NTHREADS) {
    if (i < n1) {
      const int j = i & 7, lane = (i >> 3) & 63, ks = (i >> 9) & 7, ri = (i >> 12) & 1, w = (i >> 13) & 3, g = i >> 15;
      const int st = w * 16 + (lane & 15), k = ks * 32 + (lane >> 4) * 8 + j; const int s_ = k >> 4, ch = k & 15;
      const int gp = g * 64 + st; const float pr = p.PWR[(g * 17 + 15 - s_) * 64 + st], pi = p.PWI[(g * 17 + 15 - s_) * 64 + st]; const float br = p.BBR[gp * 16 + ch], bi = p.BBI[gp * 16 + ch];
      p.WE16[i] = f2bf(ri == 0 ? (pr * br - pi * bi) : (pr * bi + pi * br));
    } else if (i < n1 + n2) {
      const int e = i - n1; const int j = e & 7, lane = (e >> 3) & 63, ks = (e >> 9) & 3, mt = (e >> 11) & 15, g = e >> 15;
      const int t = mt, co = lane & 15, k = ks * 32 + (lane >> 4) * 8 + j;
      const int st = ((k >> 5) << 4) | (k & 15), ri = (k >> 4) & 1; const float cr = p.c_re[(g * 16 + co) * 64 + st], ci = p.c_im[(g * 16 + co) * 64 + st];
      const float pr = p.PWR[(g * 17 + t + 1) * 64 + st], pi = p.PWI[(g * 17 + t + 1) * 64 + st];
      p.WY[((size_t)(g * 16 + mt) * 12 + ks) * 512 + lane * 8 + j] = f2bf((ri == 0) ? (cr * pr - ci * pi) : -(cr * pi + ci * pr));
    } else {
      const int e = i - n1 - n2; const int cin = e & 15, co = (e >> 4) & 15, j = (e >> 8) & 15, g = e >> 12; float acc = 0.f;
      for (int st = 0; st < 64; ++st) { const float cr = p.c_re[(g * 16 + co) * 64 + st], ci = p.c_im[(g * 16 + co) * 64 + st]; const float pr = p.PWR[(g * 17 + j) * 64 + st], pi = p.PWI[(g * 17 + j) * 64 + st];
        const float br = p.BBR[(g * 64 + st) * 16 + cin], bi = p.BBI[(g * 64 + st) * 16 + cin]; acc += cr * (pr * br - pi * bi) - ci * (pr * bi + pi * br); }
      p.KJ[e] = acc;
    }
  }
}
__device__ __forceinline__ void ssm_stage2b(const Params& p, int bid, int nb) {
  const int n = 32 * 16 * 8 * 512;
  for (int i = bid * NTHREADS + threadIdx.x; i < n; i += nb * NTHREADS) {
    const int j = i & 7, lane = (i >> 3) & 63, ks8 = (i >> 9) & 7, mt = (i >> 12) & 15, g = i >> 16;
    const int t = mt, co = lane & 15, kk = ks8 * 32 + (lane >> 4) * 8 + j; const int s_ = kk >> 4, cin = kk & 15;
    const float val = (s_ <= t) ? p.KJ[((g * 16 + (t - s_)) * 16 + co) * 16 + cin] : 0.f;
    p.WY[((size_t)(g * 16 + mt) * 12 + 4 + ks8) * 512 + lane * 8 + j] = f2bf(val);
  }
}

#define EPI_IDS const int tid = threadIdx.x, lane = tid & 63, w = tid >> 6, wr = w >> 1, wc = w & 1, fr = lane & 15, fq = lane >> 4; (void)wr; (void)wc; (void)fr; (void)fq;

__device__ __forceinline__ void tile_win_v(const Params& p, int tile, char* lds) {
  const int rt = tile >> 4, ct = tile & 15; const int row0 = rt * 128, col0 = ct * 128;
  f32x4 acc[4][4];
  gemm_mainloop<true, true>(acc, p.XB, 1024, p.WtIn, 1024, 1024, row0, col0, lds);
  EPI_IDS
  const int head = (col0 + wc * 64 - 1024) >> 6;
#pragma unroll
  for (int m = 0; m < 4; ++m) {
    const int row = row0 + wr * 64 + m * 16 + fq * 4; const f32x4 rsx = *(const f32x4*)(p.rs_x + row); const int b = row >> 13, tb = row & 8191;
#pragma unroll
    for (int n = 0; n < 4; ++n) { const f32x4 v = acc[m][n] * rsx;
      *(uint2*)(p.VT + ((size_t)(b * 8 + head) * 64 + n * 16 + fr) * SEQL + tb) = make_uint2(pack2(v[0], v[1]), pack2(v[2], v[3])); }
  }
}
__device__ __forceinline__ void tile_win(const Params& p, int tile, char* lds) {
  const int rt = tile >> 4, ct = tile & 15; const int row0 = rt * 128, col0 = ct * 128;
  f32x4 acc[4][4];
  gemm_mainloop<true>(acc, p.XB, 1024, p.WtIn, 1024, 1024, row0, col0, lds);
  EPI_IDS
  const int cw = col0 + wc * 64;
#pragma unroll
  for (int m = 0; m < 4; ++m) {
    const int row = row0 + wr * 64 + m * 16 + fr; const float rsx = p.rs_x[row];
    if (cw < 1024) {
      float ss = 0.f;
#pragma unroll
      for (int n = 0; n < 4; ++n)
#pragma unroll
        for (int j = 0; j < 4; ++j) { const float v = acc[m][n][j] * rsx; acc[m][n][j] = v; ss += v * v; }
      ss += __shfl_xor(ss, 16); ss += __shfl_xor(ss, 32);
      const float rs = rsqrtf(ss * (1.0f / 64.0f) + EPSF) * (cw < 512 ? 0.125f * 1.44269504f : 1.0f);
      const float* g = (cw < 512) ? p.att_q_g : p.att_k_g; bf16_t* dst = (cw < 512 ? p.Qb : p.Kb) + (size_t)row * 512 + (cw & 511);
#pragma unroll
      for (int n = 0; n < 4; ++n) { const int c = n * 16 + fq * 4; const float4 gg = *(const float4*)(g + c);
        *(uint2*)(dst + c) = make_uint2(pack2(acc[m][n][0] * rs * gg.x, acc[m][n][1] * rs * gg.y), pack2(acc[m][n][2] * rs * gg.z, acc[m][n][3] * rs * gg.w)); }
    } else if (cw < 1536) {
      const int head = (cw - 1024) >> 6; const int b = row >> 13, tb = row & 8191;
      bf16_t* dst = p.VT + ((size_t)(b * 8 + head) * 64) * SEQL + tb;
#pragma unroll
      for (int n = 0; n < 4; ++n)
#pragma unroll
        for (int j = 0; j < 4; ++j) dst[(size_t)(n * 16 + fq * 4 + j) * SEQL] = f2bf(acc[m][n][j] * rsx);
    } else {
      const int b = row >> 13, tb = row & 8191;
#pragma unroll
      for (int n = 0; n < 4; ++n) { const int g = ((cw - 1536) >> 4) + n;
        *(uint2*)(p.Ub + ((size_t)(b * 32 + g) * SEQL + tb) * 16 + fq * 4) = make_uint2(pack2(acc[m][n][0] * rsx, acc[m][n][1] * rsx), pack2(acc[m][n][2] * rsx, acc[m][n][3] * rsx)); }
    }
  }
}
__device__ __forceinline__ void tile_memkv(const Params& p, int tile, char* lds) {
  const int which = tile >> 5, t2 = tile & 31; const int rt = t2 >> 3, ct = t2 & 7; const int row0 = rt * 128, col0 = ct * 128;
  f32x4 acc[4][4];
  gemm_mainloop<true>(acc, p.MEMB, 1024, which ? p.WtMv : p.WtMk, 1024, 1024, row0, col0, lds);
  EPI_IDS
  const int cw = col0 + wc * 64;
#pragma unroll
  for (int m = 0; m < 4; ++m) {
    const int row = row0 + wr * 64 + m * 16 + fr; const float rsm = p.rs_mem[row];
    if (which == 0) {
      float ss = 0.f;
#pragma unroll
      for (int n = 0; n < 4; ++n) { f32x4 v = acc[m][n] * rsm; ss += v[0] * v[0] + v[1] * v[1] + v[2] * v[2] + v[3] * v[3]; *(f32x4*)(p.KMraw + (size_t)row * 1024 + cw + n * 16 + fq * 4) = v; }
      ss += __shfl_xor(ss, 16); ss += __shfl_xor(ss, 32);
      if (fq == 0) p.ss_km[row * 16 + (cw >> 6)] = ss;
    } else {
      const int b = row >> 8, key = row & 255; const int head = cw >> 8; const int d0 = (cw & 255);
      bf16_t* dst = p.VMT + ((size_t)(b * 4 + head) * 256) * 256 + key;
#pragma unroll
      for (int n = 0; n < 4; ++n)
#pragma unroll
        for (int j = 0; j < 4; ++j) dst[(size_t)(d0 + n * 16 + fq * 4 + j) * 256] = f2bf(acc[m][n][j] * rsm);
    }
  }
}
__device__ __forceinline__ void memk_fix(const Params& p, int bid, int nb) {
  for (int i = bid * NTHREADS + threadIdx.x; i < 512 * 1024 / 4; i += nb * NTHREADS) {
    const int row = i >> 8, c4 = (i & 255) * 4; const int head = c4 >> 8, d = c4 & 255;
    const float ss = p.ss_km[row * 16 + head * 4] + p.ss_km[row * 16 + head * 4 + 1] + p.ss_km[row * 16 + head * 4 + 2] + p.ss_km[row * 16 + head * 4 + 3];
    const float rs = rsqrtf(ss * (1.0f / 256.0f) + EPSF);
    const float4 v = *(const float4*)(p.KMraw + (size_t)row * 1024 + c4); const float4 gk = *(const float4*)(p.mem_k_g + d), gq = *(const float4*)(p.mem_q_g + d);
    const int b = row >> 8, key = row & 255;
    *(uint2*)(p.KMB + ((size_t)(b * 4 + head) * 256 + key) * 256 + d) = make_uint2(pack2(v.x * rs * gk.x * gq.x, v.y * rs * gk.y * gq.y), pack2(v.z * rs * gk.z * gq.z, v.w * rs * gk.w * gq.w));
  }
}

__device__ __forceinline__ void chunk_attn_prep(const Params& p, char* lds_) {
  LAS float* rb = (LAS float*)((LAS char*)lds_ + 65536);
  __syncthreads();
  for (int i = threadIdx.x; i < 8 * 192; i += NTHREADS) rb[i] = p.rel_bias[i] * 1.44269504f - p.SHF[i / 192];
  __syncthreads();
}
__device__ __forceinline__ void cattn_stage(const bf16_t* kg, const bf16_t* vg, unsigned st, int w, int lane) {
  const unsigned wb = st + (unsigned)__builtin_amdgcn_readfirstlane(w) * 2048u; const int lr = lane >> 3, pos = lane & 7;
#pragma unroll
  for (int i = 0; i < 2; ++i) { const int row = w * 16 + i * 8 + lr;
    glds16(kg + (size_t)row * 512 + ((pos ^ (row & 7)) << 3), wb + i * 1024u);
    glds16(vg + (size_t)row * SEQL + ((pos ^ ((row >> 1) & 7)) << 3), wb + 8192u + i * 1024u); }
}
__device__ __forceinline__ void chunk_attn_item(const Params& p, int item, char* lds_) {
  LAS char* lds = (LAS char*)lds_;
  typedef unsigned u32x2 __attribute__((ext_vector_type(2)));
  const int h = item & 7, G = (item >> 3) & 31, b = item >> 8;
  LAS float* rb = (LAS float*)(lds + 65536) + h * 192;
  const unsigned lbase = (unsigned)(size_t)lds;
  const int tid = threadIdx.x, lane = tid & 63, w = tid >> 6, fr = lane & 15, fq = lane >> 4;
  const int iq = w * 16 + fr;
  const int cn0 = G * 4;
  const int t0 = (cn0 >= 8) ? cn0 - 8 : 0, ntl = cn0 + 3 - t0 + 1;
  const bf16_t* kbase = p.Kb + (size_t)(b * SEQL) * 512 + h * 64;
  const bf16_t* vbase = p.VT + ((size_t)(b * 8 + h) * 64) * SEQL;
  bf16x8 qf[4][2];
#pragma unroll
  for (int qc = 0; qc < 4; ++qc) { const bf16_t* qp = p.Qb + (size_t)(b * SEQL + (cn0 + qc) * 64 + iq) * 512 + h * 64 + fq * 8;
    qf[qc][0] = *(const bf16x8*)qp; qf[qc][1] = *(const bf16x8*)(qp + 32); }
  __syncthreads();
#pragma unroll
  for (int i = 0; i < 3; ++i) if (i < ntl) cattn_stage(kbase + (size_t)(t0 + i) * 64 * 512, vbase + (t0 + i) * 64, lbase + i * 16384u, w, lane);
  f32x4 o[4][4]; float lrun[4];
#pragma unroll
  for (int qc = 0; qc < 4; ++qc) { lrun[qc] = 0.f;
#pragma unroll
    for (int i = 0; i < 4; ++i) o[qc][i] = (f32x4){0.f, 0.f, 0.f, 0.f}; }
  const float cbias = rb[191];
  for (int i = 0; i < ntl; ++i) {
    const int t = t0 + i; const int rem = ntl - 1 - i;
    if (rem >= 2) asm volatile("s_waitcnt vmcnt(8)" ::: "memory"); else if (rem == 1) asm volatile("s_waitcnt vmcnt(4)" ::: "memory"); else asm volatile("s_waitcnt vmcnt(0)" ::: "memory");
    RAW_BARRIER();
    if (i + 3 < ntl) cattn_stage(kbase + (size_t)(t + 3) * 64 * 512, vbase + (t + 3) * 64, lbase + (unsigned)(((i + 3) & 3) * 16384), w, lane);
    LAS char* cur = lds + (i & 3) * 16384;
    bf16x8 kf[4][2], vf[4][2];
#pragma unroll
    for (int mt = 0; mt < 4; ++mt) { const int row = mt * 16 + fr;
      kf[mt][0] = as_bf(*(const LAS u32x4*)(cur + row * 128 + ((fq ^ (row & 7)) << 4))); kf[mt][1] = as_bf(*(const LAS u32x4*)(cur + row * 128 + (((4 + fq) ^ (row & 7)) << 4))); }
#pragma unroll
    for (int dt = 0; dt < 4; ++dt) { const int d = dt * 16 + fr; const int sw = ((d >> 1) & 7) << 1;
#pragma unroll
      for (int s2 = 0; s2 < 2; ++s2) {
        const u32x2 lo = *(const LAS u32x2*)(cur + 8192 + d * 128 + (((s2 * 8 + fq) ^ sw) << 3)), hi = *(const LAS u32x2*)(cur + 8192 + d * 128 + (((s2 * 8 + fq + 4) ^ sw) << 3));
        u32x4 vv; vv.x = lo.x; vv.y = lo.y; vv.z = hi.x; vv.w = hi.y; vf[dt][s2] = as_bf(vv); } }
#pragma unroll
    for (int qc = 0; qc < 4; ++qc) {
      const int c = t - (cn0 + qc - 8);
      if (c >= 0 && c <= 8) {
        f32x4 st[4];
        const float ini = (c <= 5) ? cbias : 0.f;
#pragma unroll
        for (int mt = 0; mt < 4; ++mt) { f32x4 sacc = (f32x4){ini, ini, ini, ini};
          sacc = mfma16(kf[mt][0], qf[qc][0], sacc); sacc = mfma16(kf[mt][1], qf[qc][1], sacc); st[mt] = sacc; }
        if (c > 5) {
#pragma unroll
          for (int mt = 0; mt < 4; ++mt)
#pragma unroll
            for (int j = 0; j < 4; ++j) { const int jk = mt * 16 + fq * 4 + j; int dist = 512 - 64 * c + iq - jk; dist = dist > 128 ? 128 : dist; st[mt][j] += rb[dist + 63]; }
        }
        float ls = 0.f;
#pragma unroll
        for (int mt = 0; mt < 4; ++mt)
#pragma unroll
          for (int j = 0; j < 4; ++j) { const float pv = __builtin_amdgcn_exp2f(st[mt][j]); st[mt][j] = pv; ls += pv; }
        lrun[qc] += ls;
        bf16x8 pf[2];
#pragma unroll
        for (int s2 = 0; s2 < 2; ++s2) { u32x4 tt; tt.x = pack2(st[2 * s2][0], st[2 * s2][1]); tt.y = pack2(st[2 * s2][2], st[2 * s2][3]); tt.z = pack2(st[2 * s2 + 1][0], st[2 * s2 + 1][1]); tt.w = pack2(st[2 * s2 + 1][2], st[2 * s2 + 1][3]); pf[s2] = as_bf(tt); }
#pragma unroll
        for (int dt = 0; dt < 4; ++dt) { f32x4 oc = o[qc][dt]; oc = mfma16(vf[dt][0], pf[0], oc); oc = mfma16(vf[dt][1], pf[1], oc); o[qc][dt] = oc; }
      }
    }
  }
#pragma unroll
  for (int qc = 0; qc < 4; ++qc) {
    const int tq = b * SEQL + (cn0 + qc) * 64 + iq;
    float lt = lrun[qc]; lt += __shfl_xor(lt, 16); lt += __shfl_xor(lt, 32);
    const float inv = 1.0f / lt; float ss = 0.f;
    bf16_t* dst = p.ATT + (size_t)tq * 512 + h * 64;
#pragma unroll
    for (int dt = 0; dt < 4; ++dt) { const f32x4 v = o[qc][dt] * inv; ss += v[0] * v[0] + v[1] * v[1] + v[2] * v[2] + v[3] * v[3];
      *(uint2*)(dst + dt * 16 + fq * 4) = make_uint2(pack2(v[0], v[1]), pack2(v[2], v[3])); }
    ss += __shfl_xor(ss, 16); ss += __shfl_xor(ss, 32);
    if (fq == 0) p.ss_att[tq * 8 + h] = ss;
  }
}

template <bool FINAL>
__device__ __forceinline__ void ssm_item(const Params& p, int item, char* lds) {
  const int g = item & 31, seg = (item >> 5) & 31, b = item >> 10;
  const int tid = threadIdx.x, lane = tid & 63, w = tid >> 6, fr = lane & 15, fq = lane >> 4;
  const int t0 = b * SEQL + seg * 256;
  const bf16_t* ug = p.Ub + ((size_t)(b * 32 + g) * SEQL + seg * 256) * 16;
  bf16x8 uf[8];
#pragma unroll
  for (int ks = 0; ks < 8; ++ks) uf[ks] = *(const bf16x8*)(ug + (size_t)(fr * 16 + 2 * ks + (fq >> 1)) * 16 + (fq & 1) * 8);
  f32x4 er = (f32x4){0.f, 0.f, 0.f, 0.f}, ei = er;
  const bf16_t* we = p.WE16 + ((size_t)(g * 4 + w) * 2 * 8 * 64 + lane) * 8;
#pragma unroll
  for (int ks = 0; ks < 8; ++ks) { const bf16x8 br = *(const bf16x8*)(we + ks * 512), bi = *(const bf16x8*)(we + 4096 + ks * 512); er = mfma16(uf[ks], br, er); ei = mfma16(uf[ks], bi, ei); }
  const int gp = g * 64 + w * 16 + fr;
  const float a16r = p.APW[gp], a16i = p.APW[2048 + gp];
  float xr[4], xi[4];
  xr[0] = er[0]; xi[0] = ei[0];
#pragma unroll
  for (int j = 1; j < 4; ++j) { xr[j] = a16r * xr[j - 1] - a16i * xi[j - 1] + er[j]; xi[j] = a16r * xi[j - 1] + a16i * xr[j - 1] + ei[j]; }
  float cr = 0.f, ci = 0.f;
  if (FINAL) {
    const float ar = p.APW[4 * 4096 + gp], ai = p.APW[4 * 4096 + 2048 + gp];
    const float* es = p.ESEG + ((size_t)(b * 32) * 32 + g) * 128 + w * 32 + fr;
    for (int j0 = 0; j0 < seg; j0 += 8) { float e_r[8], e_i[8];
#pragma unroll
      for (int u = 0; u < 8; ++u) { e_r[u] = es[(size_t)(j0 + u) * 32 * 128]; e_i[u] = es[(size_t)(j0 + u) * 32 * 128 + 16]; }
#pragma unroll
      for (int u = 0; u < 8; ++u) if (j0 + u < seg) { const float nr = ar * cr - ai * ci + e_r[u], ni = ar * ci + ai * cr + e_i[u]; cr = nr; ci = ni; } }
  }
  const float a64r = p.APW[3 * 4096 + gp], a64i = p.APW[3 * 4096 + 2048 + gp];
  float tr = xr[3], ti = xi[3];
#pragma unroll
  for (int r = 0; r < 4; ++r) {
    float pr_ = __shfl(tr, (lane + 48) & 63), pi_ = __shfl(ti, (lane + 48) & 63);
    if (r == 0) { pr_ = cr; pi_ = ci; }
    if (fq == r) { const float nr = xr[3] + a64r * pr_ - a64i * pi_, ni = xi[3] + a64r * pi_ + a64i * pr_; tr = nr; ti = ni; }
  }
  if (!FINAL) {
    if (fq == 3) { float* es = p.ESEG + ((size_t)(b * 32 + seg) * 32 + g) * 128 + w * 32 + fr; es[0] = tr; es[16] = ti; }
    return;
  }
  float gr = __shfl(tr, (lane + 48) & 63), gi = __shfl(ti, (lane + 48) & 63);
  if (fq == 0) { gr = cr; gi = ci; }
  float pvr[4], pvi[4];
  pvr[0] = gr; pvi[0] = gi;
#pragma unroll
  for (int j = 1; j < 4; ++j) { const float ar = p.APW[(j - 1) * 4096 + gp], ai = p.APW[(j - 1) * 4096 + 2048 + gp]; pvr[j] = xr[j - 1] + ar * gr - ai * gi; pvi[j] = xi[j - 1] + ar * gi + ai * gr; }
  bf16_t* xl = (bf16_t*)lds;
  __syncthreads();
#pragma unroll
  for (int j = 0; j < 4; ++j) { xl[(fq * 4 + j) * 136 + w * 32 + fr] = f2bf(pvr[j]); xl[(fq * 4 + j) * 136 + w * 32 + 16 + fr] = f2bf(pvi[j]); }
  __syncthreads();
  bf16x8 xf[4];
#pragma unroll
  for (int ks = 0; ks < 4; ++ks) xf[ks] = *(const bf16x8*)(xl + fr * 136 + ks * 32 + fq * 8);
#pragma unroll
  for (int mi = 0; mi < 4; ++mi) {
    const int mt = w * 4 + mi;
    const bf16_t* wy = p.WY + ((size_t)(g * 16 + mt) * 12 * 64 + lane) * 8;
    f32x4 y = (f32x4){0.f, 0.f, 0.f, 0.f};
#pragma unroll
    for (int ks = 0; ks < 4; ++ks) y = mfma16(*(const bf16x8*)(wy + ks * 512), xf[ks], y);
#pragma unroll
    for (int ks = 0; ks < 8; ++ks) if (2 * ks <= mt) y = mfma16(*(const bf16x8*)(wy + (4 + ks) * 512), uf[ks], y);
    const size_t tok = (size_t)(t0 + fr * 16 + mt);
    const uint2 uu = *(const uint2*)(ug + (size_t)(fr * 16 + mt) * 16 + fq * 4);
    const float4 dd = *(const float4*)(p.d_skip + g * 16 + fq * 4);
    const float y0 = gelu_f(y[0] + dd.x * __uint_as_float(uu.x << 16)), y1 = gelu_f(y[1] + dd.y * __uint_as_float(uu.x & 0xffff0000u));
    const float y2 = gelu_f(y[2] + dd.z * __uint_as_float(uu.y << 16)), y3 = gelu_f(y[3] + dd.w * __uint_as_float(uu.y & 0xffff0000u));
    *(uint2*)(p.YG + tok * 512 + g * 16 + fq * 4) = make_uint2(pack2(y0, y1), pack2(y2, y3));
  }
}

__device__ __forceinline__ void tile_glu(const Params& p, int tile, char* lds) {
  const int rt = tile >> 2, ct = tile & 3; const int row0 = rt * 128, col0 = ct * 128;
  f32x4 acc[4][4];
  gemm_mainloop<true>(acc, p.YG, 512, p.WtGlu, 512, 512, row0, col0, lds);
  EPI_IDS
  const int cw = col0 + wc * 64;
#pragma unroll
  for (int m = 0; m < 4; ++m) {
    const int row = row0 + wr * 64 + m * 16 + fr; float ss = 0.f;
#pragma unroll
    for (int n = 0; n < 4; ++n) { const int c = cw + n * 16 + fq * 4; const float4 bg = *(const float4*)(p.b_glu + c); const uint2 yy = *(const uint2*)(p.YG + (size_t)row * 512 + c);
      const float y0 = __uint_as_float(yy.x << 16), y1 = __uint_as_float(yy.x & 0xffff0000u), y2 = __uint_as_float(yy.y << 16), y3 = __uint_as_float(yy.y & 0xffff0000u);
      const float o0 = y0 / (1.f + __expf(-(acc[m][n][0] + bg.x))), o1 = y1 / (1.f + __expf(-(acc[m][n][1] + bg.y))), o2 = y2 / (1.f + __expf(-(acc[m][n][2] + bg.z))), o3 = y3 / (1.f + __expf(-(acc[m][n][3] + bg.w)));
      ss += o0 * o0 + o1 * o1 + o2 * o2 + o3 * o3;
      *(uint2*)(p.SSMO + (size_t)row * 512 + c) = make_uint2(pack2(o0, o1), pack2(o2, o3)); }
    ss += __shfl_xor(ss, 16); ss += __shfl_xor(ss, 32);
    if (fq == 0) p.ss_ssm[row * 8 + (cw >> 6)] = ss;
  }
}
__device__ __forceinline__ void tile_wout(const Params& p, int tile, char* lds) {
  const int rt = tile >> 3, ct = tile & 7; const int row0 = rt * 128, col0 = ct * 128;
  f32x4 acc[4][4];
  float s1[4];
  gemm_mainloop<true>(acc, p.ATT, 512, p.WtOut, 1024, 512, row0, col0, lds);
  { const int lane_ = threadIdx.x & 63, w_ = threadIdx.x >> 6;
#pragma unroll
    for (int m = 0; m < 4; ++m) { const int row = row0 + (w_ >> 1) * 64 + m * 16 + (lane_ & 15); float a = 0.f, c = 0.f;
      { const float4* qa = (const float4*)(p.ss_att + (size_t)row * 8); const float4* qc = (const float4*)(p.ss_ssm + (size_t)row * 8); const float4 a0 = qa[0], a1 = qa[1], c0 = qc[0], c1 = qc[1];
        a = ((a0.x + a0.y) + (a0.z + a0.w)) + ((a1.x + a1.y) + (a1.z + a1.w)); c = ((c0.x + c0.y) + (c0.z + c0.w)) + ((c1.x + c1.y) + (c1.z + c1.w)); }
      const float ra = rsqrtf(a * (1.0f / 512.0f) + EPSF); s1[m] = rsqrtf(c * (1.0f / 512.0f) + EPSF); const float f = ra / s1[m];
#pragma unroll
      for (int n = 0; n < 4; ++n) acc[m][n] *= f; } }
  gemm_mainloop<false>(acc, p.SSMO, 512, p.WtOut + 512, 1024, 512, row0, col0, lds);
  EPI_IDS
  const int cw = col0 + wc * 64;
#pragma unroll
  for (int m = 0; m < 4; ++m) {
    const int row = row0 + wr * 64 + m * 16 + fr; float ss = 0.f;
#pragma unroll
    for (int n = 0; n < 4; ++n) { const int c = cw + n * 16 + fq * 4; const f32x4 xv = *(const f32x4*)(p.x + (size_t)row * 1024 + c); const f32x4 hv = xv + acc[m][n] * s1[m];
      ss += hv[0] * hv[0] + hv[1] * hv[1] + hv[2] * hv[2] + hv[3] * hv[3];
      *(uint2*)(p.H1B + (size_t)row * 1024 + c) = make_uint2(pack2(hv[0], hv[1]), pack2(hv[2], hv[3])); }
    ss += __shfl_xor(ss, 16); ss += __shfl_xor(ss, 32);
    if (fq == 0) p.ss_h1[row * 16 + (cw >> 6)] = ss;
  }
}
__device__ __forceinline__ float row_rs16(const float* ss, int row) {
  const float4* q = (const float4*)(ss + (size_t)row * 16); const float4 a = q[0], b = q[1], c = q[2], d = q[3];
  const float t = ((a.x + a.y) + (a.z + a.w)) + ((b.x + b.y) + (b.z + b.w)) + ((c.x + c.y) + (c.z + c.w)) + ((d.x + d.y) + (d.z + d.w));
  return rsqrtf(t * (1.0f / 1024.0f) + EPSF); }
__device__ __forceinline__ void tile_memq(const Params& p, int tile, char* lds) {
  const int rt = tile >> 3, ct = tile & 7; const int row0 = rt * 128, col0 = ct * 128;
  f32x4 acc[4][4];
  gemm_mainloop<true>(acc, p.H1B, 1024, p.WtMq, 1024, 1024, row0, col0, lds);
  EPI_IDS
  const int cw = col0 + wc * 64;
#pragma unroll
  for (int m = 0; m < 4; ++m) {
    const int row = row0 + wr * 64 + m * 16 + fr; const float rs = row_rs16(p.ss_h1, row); float ss = 0.f;
#pragma unroll
    for (int n = 0; n < 4; ++n) { const int c = cw + n * 16 + fq * 4; const f32x4 v = acc[m][n] * rs; ss += v[0] * v[0] + v[1] * v[1] + v[2] * v[2] + v[3] * v[3];
      *(uint2*)(p.QM + (size_t)row * 1024 + c) = make_uint2(pack2(v[0], v[1]), pack2(v[2], v[3])); }
    ss += __shfl_xor(ss, 16); ss += __shfl_xor(ss, 32);
    if (fq == 0) p.ss_qm[row * 16 + (cw >> 6)] = ss;
  }
}
__device__ __forceinline__ void mem_stage(const bf16_t* kg, const bf16_t* vg, int kc, LAS char* buf, int w, int lane) {
  const int wb = __builtin_amdgcn_readfirstlane(w) * 4096;
#pragma unroll
  for (int i = 0; i < 4; ++i) {
    const int row = w * 8 + i * 2 + (lane >> 5), pos = lane & 31; const int ch = pos ^ (row & 15);
    __builtin_amdgcn_global_load_lds((const GAS void*)(kg + (size_t)(kc * 32 + row) * 256 + ch * 8), (LAS void*)(buf + wb + i * 1024), 16, 0, 0);
  }
#pragma unroll
  for (int i = 0; i < 4; ++i) {
    const int d = w * 64 + i * 16 + (lane >> 2), pos = lane & 3; const int ch = pos ^ ((d >> 2) & 3);
    __builtin_amdgcn_global_load_lds((const GAS void*)(vg + (size_t)d * 256 + kc * 32 + ch * 8), (LAS void*)(buf + 16384 + wb + i * 1024), 16, 0, 0);
  }
}
__device__ __forceinline__ void mem_attn_item(const Params& p, int item, char* lds_) {
  LAS char* lds = (LAS char*)lds_;
  typedef unsigned u32x2 __attribute__((ext_vector_type(2)));
  const int h = item & 3, tt = item >> 2; const int tid = threadIdx.x, lane = tid & 63, w = tid >> 6, fr = lane & 15, fq = lane >> 4;
  const int tq = tt * 64 + w * 16 + fr; const int b = tq >> 13;
  const bf16_t* kg = p.KMB + (size_t)(b * 4 + h) * 256 * 256;
  const bf16_t* vg = p.VMT + (size_t)(b * 4 + h) * 256 * 256;
  __syncthreads();
  mem_stage(kg, vg, 0, lds, w, lane);
  const float ssq = p.ss_qm[tq * 16 + h * 4] + p.ss_qm[tq * 16 + h * 4 + 1] + p.ss_qm[tq * 16 + h * 4 + 2] + p.ss_qm[tq * 16 + h * 4 + 3];
  const float rowscale = rsqrtf(ssq * (1.0f / 256.0f) + EPSF) * 0.0625f * 1.44269504f;
  const float shf = p.SHF[8];
  bf16x8 qf[8];
#pragma unroll
  for (int ks = 0; ks < 8; ++ks) qf[ks] = *(const bf16x8*)(p.QM + (size_t)tq * 1024 + h * 256 + ks * 32 + fq * 8);
  f32x4 o[16];
#pragma unroll
  for (int i = 0; i < 16; ++i) o[i] = (f32x4){0.f, 0.f, 0.f, 0.f};
  float lrun = 0.f;
  asm volatile("s_waitcnt vmcnt(0)" ::: "memory");
  __syncthreads();
  for (int kc = 0; kc < 8; ++kc) {
    LAS char* cur = lds + (kc & 1) * 32768; LAS char* nxt = lds + ((kc + 1) & 1) * 32768;
    if (kc + 1 < 8) mem_stage(kg, vg, kc + 1, nxt, w, lane);
    f32x4 st[2];
#pragma unroll
    for (int mt = 0; mt < 2; ++mt) { f32x4 sacc = (f32x4){0.f, 0.f, 0.f, 0.f}; const int row = mt * 16 + fr;
#pragma unroll
      for (int ks = 0; ks < 8; ++ks) sacc = mfma16(as_bf(*(const LAS u32x4*)(cur + row * 512 + (((ks * 4 + fq) ^ (row & 15)) << 4))), qf[ks], sacc);
      st[mt] = sacc * rowscale - shf; }
    float ls = 0.f;
#pragma unroll
    for (int mt = 0; mt < 2; ++mt)
#pragma unroll
      for (int j = 0; j < 4; ++j) { const float e = __builtin_amdgcn_exp2f(st[mt][j]); st[mt][j] = e; ls += e; }
    lrun += ls;
    u32x4 t; t.x = pack2(st[0][0], st[0][1]); t.y = pack2(st[0][2], st[0][3]); t.z = pack2(st[1][0], st[1][1]); t.w = pack2(st[1][2], st[1][3]);
    const bf16x8 pf = as_bf(t);
#pragma unroll
    for (int dt = 0; dt < 16; ++dt) { const int d = dt * 16 + fr; const int sw = ((d >> 2) & 3) << 1;
      const u32x2 lo = *(const LAS u32x2*)(cur + 16384 + d * 64 + ((fq ^ sw) << 3)), hi = *(const LAS u32x2*)(cur + 16384 + d * 64 + (((fq + 4) ^ sw) << 3));
      u32x4 vv; vv.x = lo.x; vv.y = lo.y; vv.z = hi.x; vv.w = hi.y; o[dt] = mfma16(as_bf(vv), pf, o[dt]); }
    asm volatile("s_waitcnt vmcnt(0)" ::: "memory");
    __syncthreads();
  }
  float lt = lrun; lt += __shfl_xor(lt, 16); lt += __shfl_xor(lt, 32);
  const float inv = 1.0f / lt;
  bf16_t* dst = p.OM + (size_t)tq * 1024 + h * 256;
#pragma unroll
  for (int dt = 0; dt < 16; ++dt) { const f32x4 v = o[dt] * inv; *(uint2*)(dst + dt * 16 + fq * 4) = make_uint2(pack2(v[0], v[1]), pack2(v[2], v[3])); }
}
__device__ __forceinline__ void tile_memo(const Params& p, int tile, char* lds) {
  const int rt = tile >> 3, ct = tile & 7; const int row0 = rt * 128, col0 = ct * 128;
  f32x4 acc[4][4];
  gemm_mainloop<true>(acc, p.OM, 1024, p.WtMo, 1024, 1024, row0, col0, lds);
  EPI_IDS
  const int cw = col0 + wc * 64;
#pragma unroll
  for (int m = 0; m < 4; ++m) {
    const int row = row0 + wr * 64 + m * 16 + fr; float ss = 0.f;
#pragma unroll
    for (int n = 0; n < 4; ++n) { const int c = cw + n * 16 + fq * 4; const uint2 hb = *(const uint2*)(p.H1B + (size_t)row * 1024 + c);
      const f32x4 hv = (f32x4){__uint_as_float(hb.x << 16), __uint_as_float(hb.x & 0xffff0000u), __uint_as_float(hb.y << 16), __uint_as_float(hb.y & 0xffff0000u)} + acc[m][n];
      ss += hv[0] * hv[0] + hv[1] * hv[1] + hv[2] * hv[2] + hv[3] * hv[3];
      *(uint2*)(p.H2B + (size_t)row * 1024 + c) = make_uint2(pack2(hv[0], hv[1]), pack2(hv[2], hv[3])); }
    ss += __shfl_xor(ss, 16); ss += __shfl_xor(ss, 32);
    if (fq == 0) p.ss_h2[row * 16 + (cw >> 6)] = ss;
  }
}
__device__ __forceinline__ void ce_desc(float& x, float& y) { const float hi = fmaxf(x, y), lo = fminf(x, y); x = hi; y = lo; }
__device__ __forceinline__ void sort16_desc(float (&a)[16]) {
#pragma unroll
  for (int k = 2; k <= 16; k <<= 1)
#pragma unroll
    for (int j = k >> 1; j > 0; j >>= 1)
#pragma unroll
      for (int i = 0; i < 16; ++i) { const int l = i ^ j; if (l > i) { if ((i & k) == 0) ce_desc(a[i], a[l]); else ce_desc(a[l], a[i]); } }
}
__device__ __forceinline__ void merge16_desc(float (&a)[16], const float (&b)[16]) {
#pragma unroll
  for (int i = 0; i < 16; ++i) a[i] = fmaxf(a[i], b[15 - i]);
#pragma unroll
  for (int j = 8; j > 0; j >>= 1)
#pragma unroll
    for (int i = 0; i < 16; ++i) { const int l = i ^ j; if (l > i) ce_desc(a[i], a[l]); }
}
__device__ __forceinline__ void ins16(float (&a)[16], float v) {
#pragma unroll
  for (int i = 0; i < 16; ++i) { const float hi = fmaxf(a[i], v), lo = fminf(a[i], v); a[i] = hi; v = lo; }
}
__device__ __forceinline__ void tile_peer(const Params& p, int tile, char* lds_) {
  const int rt = tile >> 4, hs = tile & 15; const int row0 = rt * 128, col0 = hs * 128;
  f32x4 acc[4][4];
  gemm_mainloop<true>(acc, p.H2B, 1024, p.WtPq, 1024, 1024, row0, col0, lds_);
  LAS char* lds = (LAS char*)lds_;
  EPI_IDS
  { const int lr = lane >> 3, lc = (lane & 7) ^ lr; const int wbase = __builtin_amdgcn_readfirstlane(w) * 4096;
    const bf16_t* gK = p.PK + (size_t)hs * 128 * 128 + (size_t)(w * 32 + lr) * 128 + lc * 8;
#pragma unroll
    for (int i = 0; i < 4; ++i) {
      __builtin_amdgcn_global_load_lds((const GAS void*)(gK + (size_t)(i * 8) * 128), (LAS void*)(lds + 16384 + wbase + i * 1024), 16, 0, 0);
      __builtin_amdgcn_global_load_lds((const GAS void*)(gK + (size_t)(i * 8) * 128 + 64), (LAS void*)(lds + 32768 + 16384 + wbase + i * 1024), 16, 0, 0);
    } }
  typedef unsigned u32x2 __attribute__((ext_vector_type(2)));
#pragma unroll
  for (int m = 0; m < 4; ++m) { const int r = wr * 64 + m * 16 + fr; const float rs = row_rs16(p.ss_h2, row0 + r);
#pragma unroll
    for (int n = 0; n < 4; ++n) { const f32x4 v = acc[m][n] * rs; u32x2 pk; pk.x = pack2(v[0], v[1]); pk.y = pack2(v[2], v[3]);
      *(LAS u32x2*)(lds + wc * 32768 + r * 128 + (((n * 2 + (fq >> 1)) ^ (r & 7)) << 4) + (fq & 1) * 8) = pk; } }
  asm volatile("s_waitcnt vmcnt(0)" ::: "memory");
  __syncthreads();
#pragma unroll
  for (int m = 0; m < 4; ++m)
#pragma unroll
    for (int n = 0; n < 4; ++n) acc[m][n] = (f32x4){0.f, 0.f, 0.f, 0.f};
#pragma unroll
  for (int kt = 0; kt < 2; ++kt) { LAS char* cur = lds + kt * 32768;
#pragma unroll
    for (int ks = 0; ks < 2; ++ks) { bf16x8 af[4], bfr[4]; const int kc = ks * 4 + fq;
#pragma unroll
      for (int m = 0; m < 4; ++m) { const int r = wr * 64 + m * 16 + fr; af[m] = as_bf(*(const LAS u32x4*)(cur + r * 128 + ((kc ^ (r & 7)) << 4))); }
#pragma unroll
      for (int n = 0; n < 4; ++n) { const int r = wc * 64 + n * 16 + fr; bfr[n] = as_bf(*(const LAS u32x4*)(cur + 16384 + r * 128 + ((kc ^ (r & 7)) << 4))); }
#pragma unroll
      for (int m = 0; m < 4; ++m)
#pragma unroll
        for (int n = 0; n < 4; ++n) acc[m][n] = mfma16(bfr[n], af[m], acc[m][n]);
    } }
  __syncthreads();
  LAS float* L = (LAS float*)lds;
#pragma unroll
  for (int m = 0; m < 4; ++m) {
    float a[16], b[16];
#pragma unroll
    for (int n = 0; n < 4; ++n)
#pragma unroll
      for (int j = 0; j < 4; ++j) a[n * 4 + j] = __uint_as_float((__float_as_uint(acc[m][n][j]) & ~127u) | (unsigned)(wc * 64 + n * 16 + fq * 4 + j));
    sort16_desc(a);
#pragma unroll
    for (int i = 0; i < 16; ++i) b[i] = __shfl_xor(a[i], 16);
    merge16_desc(a, b);
#pragma unroll
    for (int i = 0; i < 16; ++i) b[i] = __shfl_xor(a[i], 32);
    merge16_desc(a, b);
    const int r = wr * 64 + m * 16 + fr;
    f32x4 o; o[0] = fq == 0 ? a[0] : fq == 1 ? a[4] : fq == 2 ? a[8] : a[12]; o[1] = fq == 0 ? a[1] : fq == 1 ? a[5] : fq == 2 ? a[9] : a[13];
    o[2] = fq == 0 ? a[2] : fq == 1 ? a[6] : fq == 2 ? a[10] : a[14]; o[3] = fq == 0 ? a[3] : fq == 1 ? a[7] : fq == 2 ? a[11] : a[15];
    *(LAS f32x4*)(L + (r * 2 + wc) * 16 + fq * 4) = o;
  }
  __syncthreads();
#pragma unroll
  for (int mi = 0; mi < 2; ++mi) { const int m = wc * 2 + mi; const int r = wr * 64 + m * 16 + fr;
    float a[16], b[16];
#pragma unroll
    for (int q = 0; q < 4; ++q) { const f32x4 va = *(const LAS f32x4*)(L + (r * 2 + 0) * 16 + q * 4), vb = *(const LAS f32x4*)(L + (r * 2 + 1) * 16 + q * 4);
      a[q * 4] = va[0]; a[q * 4 + 1] = va[1]; a[q * 4 + 2] = va[2]; a[q * 4 + 3] = va[3]; b[q * 4] = vb[0]; b[q * 4 + 1] = vb[1]; b[q * 4 + 2] = vb[2]; b[q * 4 + 3] = vb[3]; }
    merge16_desc(a, b);
    u32x4 o; o.x = __float_as_uint(fq == 0 ? a[0] : fq == 1 ? a[4] : fq == 2 ? a[8] : a[12]); o.y = __float_as_uint(fq == 0 ? a[1] : fq == 1 ? a[5] : fq == 2 ? a[9] : a[13]);
    o.z = __float_as_uint(fq == 0 ? a[2] : fq == 1 ? a[6] : fq == 2 ? a[10] : a[14]); o.w = __float_as_uint(fq == 0 ? a[3] : fq == 1 ? a[7] : fq == 2 ? a[11] : a[15]);
    *(u32x4*)(p.TOPS + ((size_t)(row0 + r) * 16 + hs) * 16 + fq * 4) = o;
  }
}
__device__ __forceinline__ void peer_gather_item(const Params& p, int item, char* lds_) {
  LAS char* lds = (LAS char*)lds_;
  const int tid = threadIdx.x, lane = tid & 63, w = tid >> 6;
  LAS unsigned* LA = (LAS unsigned*)lds;
  LAS int* LE = (LAS int*)(lds + 256 * 33 * 4);
  LAS float* LG = (LAS float*)(lds + 256 * 33 * 4 + 32 * 128 * 4);
  __syncthreads();
  {
    const int tl_ = tid >> 3, h = tid & 7; const int t = item * 32 + tl_;
    const uint4* src = (const uint4*)(p.TOPS + ((size_t)t * 16 + h * 2) * 16);
    float a[16], bq[16];
#pragma unroll
    for (int i = 0; i < 4; ++i) { const uint4 v = src[i]; a[4 * i] = __uint_as_float(v.x); a[4 * i + 1] = __uint_as_float(v.y); a[4 * i + 2] = __uint_as_float(v.z); a[4 * i + 3] = __uint_as_float(v.w); }
#pragma unroll
    for (int i = 0; i < 4; ++i) { const uint4 v = src[4 + i]; bq[4 * i] = __uint_as_float(v.x); bq[4 * i + 1] = __uint_as_float(v.y); bq[4 * i + 2] = __uint_as_float(v.z); bq[4 * i + 3] = __uint_as_float(v.w); }
#pragma unroll
    for (int i = 0; i < 16; ++i) { LA[tid * 33 + i] = __float_as_uint(a[i]); LA[tid * 33 + 16 + i] = __float_as_uint(bq[i]); }
    float c[16];
#pragma unroll
    for (int i = 0; i < 16; ++i) c[i] = -__builtin_inff();
#pragma unroll
    for (int i = 0; i < 16; ++i)
#pragma unroll
      for (int j = 0; j < 16; ++j) if ((i + 1) * (j + 1) <= 16) { const float s = a[i] + bq[j]; ins16(c, __uint_as_float((__float_as_uint(s) & ~255u) | (unsigned)(i * 16 + j))); }
    const float mx = c[0]; float e[16]; float sum = 0.f;
#pragma unroll
    for (int i = 0; i < 16; ++i) { e[i] = __expf(c[i] - mx); sum += e[i]; }
    const float inv = 1.0f / sum;
#pragma unroll
    for (int i = 0; i < 16; ++i) { const unsigned pos = __float_as_uint(c[i]) & 255u; const unsigned ia = LA[tid * 33 + (pos >> 4)] & 127u, ib = LA[tid * 33 + 16 + (pos & 15u)] & 127u;
      LE[tl_ * 128 + h * 16 + i] = (int)(ia * 128u + ib); LG[tl_ * 128 + h * 16 + i] = e[i] * inv; }
  }
  __syncthreads();
  LAS char* HQ = (LAS char*)LA;
  const int fr = lane & 15, fq = lane >> 4;
  for (int ti = 0; ti < 8; ++ti) {
    const int tl_ = w * 8 + ti; const int t = item * 32 + tl_;
    const float rs = row_rs16(p.ss_h2, t) * 16.0f;
    { const uint4 ha = *(const uint4*)(p.H2B + (size_t)t * 1024 + lane * 16), hb = *(const uint4*)(p.H2B + (size_t)t * 1024 + lane * 16 + 8);
      const unsigned hw[8] = {ha.x, ha.y, ha.z, ha.w, hb.x, hb.y, hb.z, hb.w}; u32x4 q;
#pragma unroll
      for (int i = 0; i < 4; ++i) { const float4 g = *(const float4*)(p.norm_peer_g + lane * 16 + 4 * i); int wd = 0;
        wd = __builtin_amdgcn_cvt_pk_fp8_f32(__uint_as_float(hw[2 * i] << 16) * rs * g.x, __uint_as_float(hw[2 * i] & 0xffff0000u) * rs * g.y, wd, false);
        wd = __builtin_amdgcn_cvt_pk_fp8_f32(__uint_as_float(hw[2 * i + 1] << 16) * rs * g.z, __uint_as_float(hw[2 * i + 1] & 0xffff0000u) * rs * g.w, wd, true); q[i] = (unsigned)wd; }
      *(LAS u32x4*)(HQ + tl_ * 1024 + lane * 16) = q; }
    f32x2 oa[8];
#pragma unroll
    for (int i = 0; i < 8; ++i) oa[i] = (f32x2){0.f, 0.f};
    typedef int i32x8 __attribute__((ext_vector_type(8)));
    typedef unsigned u32x2 __attribute__((ext_vector_type(2)));
    int er0, er1; u32x4 uq0[8], uq1[8]; u32x2 vqa0[8], vqb0[8], vqa1[8], vqb1[8]; float g40[4], su40[4], sv40[4], g41[4], su41[4], sv41[4];
#define PEER_LOADSET(S, BT) { const LAS int* LEb = LE + tl_ * 128 + (BT) * 16; const LAS float* LGb = LG + tl_ * 128 + (BT) * 16; er##S = LEb[fr]; \
      const unsigned char* ub = p.PU8 + (size_t)er##S * 512 + fq * 16; \
      _Pragma("unroll") for (int ks = 0; ks < 8; ++ks) uq##S[ks] = *(const u32x4*)(ub + ks * 64); \
      _Pragma("unroll") for (int x = 0; x < 8; ++x) { const int ex = __builtin_amdgcn_readlane(er##S, x); vqa##S[x] = *(const u32x2*)(p.PV8 + (size_t)ex * 512 + lane * 8); } \
      _Pragma("unroll") for (int x = 0; x < 8; ++x) { const int ex = __builtin_amdgcn_readlane(er##S, 8 + x); vqb##S[x] = *(const u32x2*)(p.PV8 + (size_t)ex * 512 + lane * 8); } \
      _Pragma("unroll") for (int j = 0; j < 4; ++j) { const int e4 = LEb[fq * 4 + j]; g4##S[j] = LGb[fq * 4 + j]; su4##S[j] = p.su[e4]; sv4##S[j] = p.sv[e4]; } }
#define PEER_V(VQ, X0) { _Pragma("unroll") for (int x = 0; x < 8; ++x) { const float wgt = __int_as_float(__builtin_amdgcn_readlane(__float_as_int(wg[((X0) + x) & 3]), (((X0) + x) >> 2) * 16)); \
        oa[0] += __builtin_amdgcn_cvt_scalef32_pk_f32_fp4(VQ[x].x, 1.0f, 0) * wgt; oa[1] += __builtin_amdgcn_cvt_scalef32_pk_f32_fp4(VQ[x].x, 1.0f, 1) * wgt; \
        oa[2] += __builtin_amdgcn_cvt_scalef32_pk_f32_fp4(VQ[x].x, 1.0f, 2) * wgt; oa[3] += __builtin_amdgcn_cvt_scalef32_pk_f32_fp4(VQ[x].x, 1.0f, 3) * wgt; \
        oa[4] += __builtin_amdgcn_cvt_scalef32_pk_f32_fp4(VQ[x].y, 1.0f, 0) * wgt; oa[5] += __builtin_amdgcn_cvt_scalef32_pk_f32_fp4(VQ[x].y, 1.0f, 1) * wgt; \
        oa[6] += __builtin_amdgcn_cvt_scalef32_pk_f32_fp4(VQ[x].y, 1.0f, 2) * wgt; oa[7] += __builtin_amdgcn_cvt_scalef32_pk_f32_fp4(VQ[x].y, 1.0f, 3) * wgt; } }
#define PEER_COMPUTE(S) { f32x4 acc = (f32x4){0.f, 0.f, 0.f, 0.f}; \
      _Pragma("unroll") for (int ks = 0; ks < 8; ++ks) { const u32x4 h0 = *(const LAS u32x4*)(HQ + tl_ * 1024 + ks * 128 + fq * 16), h1 = *(const LAS u32x4*)(HQ + tl_ * 1024 + ks * 128 + 64 + fq * 16); \
        i32x8 A, B; A[0] = (int)uq##S[ks].x; A[1] = (int)uq##S[ks].y; A[2] = (int)uq##S[ks].z; A[3] = (int)uq##S[ks].w; A[4] = 0; A[5] = 0; A[6] = 0; A[7] = 0; \
        B[0] = (int)h0.x; B[1] = (int)h0.y; B[2] = (int)h0.z; B[3] = (int)h0.w; B[4] = (int)h1.x; B[5] = (int)h1.y; B[6] = (int)h1.z; B[7] = (int)h1.w; \
        acc = __builtin_amdgcn_mfma_scale_f32_16x16x128_f8f6f4(A, B, acc, 4, 0, 0, 0x7f7f7f7f, 0, 0x7f7f7f7f); } \
      float wg[4]; \
      _Pragma("unroll") for (int j = 0; j < 4; ++j) wg[j] = g4##S[j] * gelu_f(acc[j] * su4##S[j] * 0.0625f) * sv4##S[j]; \
      PEER_V(vqa##S, 0) PEER_V(vqb##S, 8) }
    PEER_LOADSET(0, 0)
    for (int bt = 0; bt < 8; bt += 2) {
      PEER_LOADSET(1, bt + 1)
      __builtin_amdgcn_sched_barrier(0);
      PEER_COMPUTE(0)
      __builtin_amdgcn_sched_barrier(0);
      if (bt + 2 < 8) PEER_LOADSET(0, bt + 2)
      __builtin_amdgcn_sched_barrier(0);
      PEER_COMPUTE(1)
      __builtin_amdgcn_sched_barrier(0);
    }
    { const uint4 ha = *(const uint4*)(p.H2B + (size_t)t * 1024 + lane * 16), hb = *(const uint4*)(p.H2B + (size_t)t * 1024 + lane * 16 + 8);
      const unsigned hw[8] = {ha.x, ha.y, ha.z, ha.w, hb.x, hb.y, hb.z, hb.w};
      float* op = p.out + (size_t)t * 1024 + lane * 16;
#pragma unroll
      for (int i = 0; i < 4; ++i) { const f32x2 a = oa[2 * i], b = oa[2 * i + 1];
        *(float4*)(op + 4 * i) = make_float4(__uint_as_float(hw[2 * i] << 16) + a.x, __uint_as_float(hw[2 * i] & 0xffff0000u) + a.y, __uint_as_float(hw[2 * i + 1] << 16) + b.x, __uint_as_float(hw[2 * i + 1] & 0xffff0000u) + b.y); } }
  }
}

#define XCD_TILES(NCT, CALL) do { if ((nb & 7) == 0 && nb >= 8) { const int xcd_ = bid & 7, lb_ = bid >> 3, nlb_ = nb >> 3; \
    for (int i_ = lb_; i_ < 16 * (NCT); i_ += nlb_) { const int t = (xcd_ * 16 + i_ / (NCT)) * (NCT) + (i_ % (NCT)); CALL; } } \
  else { for (int t = bid; t < 128 * (NCT); t += nb) { CALL; } } } while (0)
template <int PH>
__device__ __forceinline__ void run_phase(const Params& p, char* lds, int bid, int nb) {
  if (PH == 0) {
    const int nt_in = 16 * 32, nt_glu = 8 * 8, nt_out = 16 * 16, nt_m = 16 * 16, nt_pq = 16 * 32;
    const int total = nt_in + nt_glu + nt_out + 4 * nt_m + nt_pq;
    for (int t = bid; t < total; t += nb) {
      int i = t; float* tl = (float*)lds;
      if (i < nt_in) { transpose_tile(p.w_in, p.WtIn, 1024, 2048, i, p.norm_mix_g, p.norm_mix_g, 1024, tl); continue; } i -= nt_in;
      if (i < nt_glu) { transpose_tile(p.w_glu, p.WtGlu, 512, 512, i, nullptr, nullptr, 0, tl); continue; } i -= nt_glu;
      if (i < nt_out) { transpose_tile(p.w_out, p.WtOut, 1024, 1024, i, p.att_out_g, p.ssm_out_g, 512, tl); continue; } i -= nt_out;
      if (i < nt_m) { transpose_tile(p.w_mem_q, p.WtMq, 1024, 1024, i, p.norm_mem_g, p.norm_mem_g, 1024, tl); continue; } i -= nt_m;
      if (i < nt_m) { transpose_tile(p.w_mem_k, p.WtMk, 1024, 1024, i, p.norm_memkv_g, p.norm_memkv_g, 1024, tl); continue; } i -= nt_m;
      if (i < nt_m) { transpose_tile(p.w_mem_v, p.WtMv, 1024, 1024, i, p.norm_memkv_g, p.norm_memkv_g, 1024, tl); continue; } i -= nt_m;
      if (i < nt_m) { transpose_tile(p.w_mem_o, p.WtMo, 1024, 1024, i, nullptr, nullptr, 0, tl); continue; } i -= nt_m;
      transpose_tile(p.w_peer_q, p.WtPq, 1024, 2048, i, p.norm_peer_g, p.norm_peer_g, 1024, tl);
    }
    convert_flat(p.peer_keys, p.PK, (size_t)16 * 128 * 128 / 8, bid, nb);
    rows_fp4<false>(p.peer_u, p.PU8, p.su, 16384, bid, nb);
    rows_fp4<false>(p.peer_v, p.PV8, p.sv, 16384, bid, nb);
    rows_bf16_rs(p.x, p.XB, p.rs_x, T_TOK, bid, nb);
    rows_bf16_rs(p.mem, p.MEMB, p.rs_mem, 512, bid, nb);
    for (int i = bid * NTHREADS + threadIdx.x; i < 2048; i += nb * NTHREADS) ssm_stage1(p, i);
    if (bid == nb - 1 && threadIdx.x < 9) {
      const int hh = threadIdx.x; float sh;
      if (hh < 8) { float mb = -1e30f, gq = 0.f, gk = 0.f; for (int i = 0; i < 192; ++i) mb = fmaxf(mb, p.rel_bias[hh * 192 + i]);
        for (int i = 0; i < 64; ++i) { gq = fmaxf(gq, fabsf(p.att_q_g[i])); gk = fmaxf(gk, fabsf(p.att_k_g[i])); }
        sh = (mb + 8.0f * gq * gk * 1.02f) * 1.44269504f; }
      else { float g = 0.f; for (int i = 0; i < 256; ++i) g = fmaxf(g, fabsf(p.mem_q_g[i] * p.mem_k_g[i])); sh = 16.0f * g * 1.02f * 1.44269504f; }
      p.SHF[hh] = sh; }
  } else if (PH == 1) {
    XCD_TILES(16, { if (((t & 15) >> 2) == 2) tile_win_v(p, t, lds); else tile_win(p, t, lds); });
    ssm_stage2a(p, bid, nb);
  } else if (PH == 2) {
    for (int t = nb - 1 - bid; t < 64; t += nb) tile_memkv(p, t, lds);
    chunk_attn_prep(p, lds);
    if ((nb & 7) == 0 && nb >= 8) { const int xcd_ = bid & 7, lb_ = bid >> 3, nlb_ = nb >> 3;
      for (int i_ = lb_; i_ < 64; i_ += nlb_) chunk_attn_item(p, i_ * 8 + xcd_, lds); }
    else { for (int t = bid; t < 512; t += nb) chunk_attn_item(p, t, lds); }
    for (int t = bid; t < 2048; t += nb) ssm_item<false>(p, t, lds);
    ssm_stage2b(p, bid, nb);
  } else if (PH == 3) {
    memk_fix(p, bid, nb);
    for (int t = bid; t < 2048; t += nb) ssm_item<true>(p, t, lds);
  } else if (PH == 4) {
    XCD_TILES(4, tile_glu(p, t, lds));
  } else if (PH == 5) {
    XCD_TILES(8, tile_wout(p, t, lds));
  } else if (PH == 6) {
    XCD_TILES(8, tile_memq(p, t, lds));
  } else if (PH == 7) {
    for (int t = bid; t < 1024; t += nb) mem_attn_item(p, t, lds);
  } else if (PH == 8) {
    XCD_TILES(8, tile_memo(p, t, lds));
  } else if (PH == 9) {
    XCD_TILES(16, tile_peer(p, t, lds));
  } else if (PH == 11) {
    for (int t = bid; t < 512; t += nb) peer_gather_item(p, t, lds);
  }
}

#if !MEGA
template <int PH>
__global__ void __launch_bounds__(NTHREADS, 2) phase_kernel(Params p) {
  extern __shared__ __attribute__((aligned(16))) char lds[];
  run_phase<PH>(p, lds, blockIdx.x, gridDim.x);
}

#endif
#ifndef REPEAT_PH
#define REPEAT_PH -1
#endif
#define RUNPH(k) do { run_phase<k>(p, lds, bid, nb); if (REPEAT_PH == k) { xcd_barrier(xb); run_phase<k>(p, lds, bid, nb); } } while (0)
__global__ void __launch_bounds__(NTHREADS, 2) mega_kernel(Params p) {
  extern __shared__ __attribute__((aligned(16))) char lds[];
  const int bid = blockIdx.x, nb = gridDim.x;
  volatile LAS unsigned* stw = (volatile LAS unsigned*)((LAS char*)lds + LDS_WORK);
  if (threadIdx.x == 0) { stw[0] = 0u; stw[1] = 0u; stw[2] = 0u; stw[3] = 0u; }
  __syncthreads();
  XcdBarrier xb = xcd_barrier_post(p.bar, stw);
  RUNPH(0); xcd_barrier(xb);
  RUNPH(1); xcd_barrier(xb);
  RUNPH(2); xcd_barrier(xb);
  RUNPH(3); xcd_barrier(xb);
  RUNPH(4); xcd_barrier(xb);
  RUNPH(5); xcd_barrier(xb);
  RUNPH(6); xcd_barrier(xb);
  RUNPH(7); xcd_barrier(xb);
  RUNPH(8); xcd_barrier(xb);
  RUNPH(9); xcd_barrier(xb);
  RUNPH(11);
}

#if !MEGA
template <int PH> static void launch_phase(const Params& p, int grid, hipStream_t s) {
  hipFuncSetAttribute((const void*)phase_kernel<PH>, hipFuncAttributeMaxDynamicSharedMemorySize, LDS_BYTES);
  phase_kernel<PH><<<grid, NTHREADS, LDS_BYTES, s>>>(p);
}
#endif

extern "C" void kernel_launch(void* const* d_in, const int* in_sizes, int n_in, void* d_out, int out_size, void* d_ws, size_t ws_size, hipStream_t stream) {
  Params p{};
  const float** f = (const float**)&p;
  for (int i = 0; i < 33; ++i) f[i] = (const float*)d_in[i];
  p.out = (float*)d_out;
  char* ws = (char*)d_ws; size_t off = 0;
  auto take = [&](size_t bytes) { char* r = ws + off; off += (bytes + 255) & ~(size_t)255; return r; };
  const size_t MB = 1u << 20;
  p.bar = (unsigned*)take(16384);
  p.WtIn = (bf16_t*)take(4 * MB); p.WtGlu = (bf16_t*)take(MB / 2); p.WtOut = (bf16_t*)take(2 * MB);
  p.WtMq = (bf16_t*)take(2 * MB); p.WtMk = (bf16_t*)take(2 * MB); p.WtMv = (bf16_t*)take(2 * MB); p.WtMo = (bf16_t*)take(2 * MB); p.WtPq = (bf16_t*)take(4 * MB);
  p.PK = (bf16_t*)take(MB / 2); p.PU8 = (unsigned char*)take(8 * MB); p.PV8 = (unsigned char*)take(8 * MB); p.su = (float*)take(16384 * 4); p.sv = (float*)take(16384 * 4);
  char* RA = take(64 * MB); char* RB = take(64 * MB);
  p.XB = (bf16_t*)RA; p.ATT = (bf16_t*)RA; p.YG = (bf16_t*)(RA + 16 * MB); p.QM = (bf16_t*)RA; p.H2B = (bf16_t*)RA;
  p.SSMO = (bf16_t*)(RA + 32 * MB); p.OM = (bf16_t*)(RA + 32 * MB);
  p.Qb = (bf16_t*)RB; p.Kb = (bf16_t*)(RB + 16 * MB); p.VT = (bf16_t*)(RB + 32 * MB); p.Ub = (bf16_t*)(RB + 48 * MB); p.H1B = (bf16_t*)RB; p.QP = (bf16_t*)RB;
  p.TOPS = (unsigned*)take(16 * MB);
  p.MEMB = (bf16_t*)take(MB); p.KMB = (bf16_t*)take(MB); p.VMT = (bf16_t*)take(MB); p.KMraw = (float*)take(2 * MB);
  p.WE16 = (bf16_t*)take(2 * MB); p.WY = (bf16_t*)take(6 * MB);
  p.rs_x = (float*)take(T_TOK * 4); p.rs_mem = (float*)take(512 * 4); p.ss_att = (float*)take(T_TOK * 8 * 4); p.ss_ssm = (float*)take(T_TOK * 8 * 4);
  p.ss_h1 = (float*)take(T_TOK * 16 * 4); p.ss_qm = (float*)take(T_TOK * 16 * 4); p.ss_km = (float*)take(512 * 16 * 4); p.ss_h2 = (float*)take(T_TOK * 16 * 4);
  p.ESEG = (float*)take(2 * 32 * 32 * 128 * 4);
  p.BBR = (float*)take(2048 * 16 * 4); p.BBI = (float*)take(2048 * 16 * 4); p.PWR = (float*)take(32 * 17 * 64 * 4); p.PWI = (float*)take(32 * 17 * 64 * 4); p.KJ = (float*)take(32 * 16 * 256 * 4); p.SHF = (float*)take(256); p.APW = (float*)take(5 * 4096 * 4);
  if (off > ws_size) { fprintf(stderr, "workspace too small: need %zu have %zu\n", off, ws_size); return; }
#if MEGA
  hipMemsetAsync(p.bar, 0, 16384, stream);
  static int grid_blocks = 0;
  if (!grid_blocks) {
    int dev = 0, cus = 0, per_cu = 0; hipGetDevice(&dev); hipDeviceGetAttribute(&cus, hipDeviceAttributeMultiprocessorCount, dev);
    hipFuncSetAttribute((const void*)mega_kernel, hipFuncAttributeMaxDynamicSharedMemorySize, LDS_BYTES);
    hipOccupancyMaxActiveBlocksPerMultiprocessor(&per_cu, mega_kernel, NTHREADS, LDS_BYTES);
    if (per_cu > 2) per_cu = 2; if (per_cu < 1) per_cu = 1;
    grid_blocks = cus * per_cu;
  }
  void* args[] = {&p};
  hipError_t e = hipLaunchCooperativeKernel((void*)mega_kernel, dim3(grid_blocks), dim3(NTHREADS), args, LDS_BYTES, stream);
  if (e != hipSuccess) fprintf(stderr, "cooperative launch failed: %s (grid %d)\n", hipGetErrorString(e), grid_blocks);
#else
  const int G = 1024;
  launch_phase<0>(p, G, stream); launch_phase<1>(p, G, stream); launch_phase<2>(p, G, stream); launch_phase<3>(p, G, stream);
  launch_phase<4>(p, G, stream); launch_phase<5>(p, G, stream); launch_phase<6>(p, G, stream); launch_phase<7>(p, G, stream);
  launch_phase<8>(p, G, stream); launch_phase<9>(p, G, stream); launch_phase<11>(p, G, stream);
#endif
}
```

```cpp
#include <hip/hip_runtime.h>
#include <hip/hip_cooperative_groups.h>
#include <cstdio>
#include <cstdint>
namespace cg = cooperative_groups;

#ifndef MEGA
#define MEGA 1
#endif

typedef unsigned short bf16_t;
typedef short bf16x8 __attribute__((ext_vector_type(8)));
typedef float f32x4 __attribute__((ext_vector_type(4)));
typedef unsigned u32x4 __attribute__((ext_vector_type(4)));
#define LAS __attribute__((address_space(3)))
__device__ __forceinline__ bf16x8 as_bf(u32x4 v) { return __builtin_bit_cast(bf16x8, v); }

#define T_TOK 16384
#define SEQL 8192
#define NTHREADS 256
#define LDS_WORK 74752
#define LDS_BYTES (LDS_WORK + 16)
#define EPSF 1e-6f

typedef float f32x2_ __attribute__((ext_vector_type(2)));
typedef __bf16 bf16x2v __attribute__((ext_vector_type(2)));
__device__ __forceinline__ unsigned pack2(float lo, float hi) { f32x2_ v = {lo, hi}; bf16x2v b = __builtin_convertvector(v, bf16x2v); return __builtin_bit_cast(unsigned, b); }
__device__ __forceinline__ unsigned short f2bf(float f) { return (unsigned short)(pack2(f, 0.f) & 0xffffu); }
__device__ __forceinline__ float bf2f(unsigned short b) { return __uint_as_float(((unsigned)b) << 16); }
__device__ __forceinline__ float gelu_f(float v) {
  const float av = fabsf(v), t = __builtin_amdgcn_rcpf(av * 0.2316418882f + 1.0f);
  float q = t * 0.5307027145f + (-0.7265760135f); q = q * t + 0.7107068705f; q = q * t + (-0.142248368f); q = q * t + 0.127414796f; q = q * t;
  const float e = __builtin_amdgcn_exp2f((v * v) * (-0.72134752044f)); const float m = v * (q * e);
  return v < 0.f ? m : v - m; }
typedef float f32x2 __attribute__((ext_vector_type(2)));
__device__ __forceinline__ f32x4 mfma16(bf16x8 a, bf16x8 b, f32x4 c) { return __builtin_amdgcn_mfma_f32_16x16x32_bf16(a, b, c, 0, 0, 0); }


#define XB_TMO      128
#define XB_XCNT(j)  (256  + 64 * (j))
#define XB_XSUB(j)  (1280 + 64 * (j))
#define XB_XGEN(j)  (2304 + 64 * (j))
#define XB_TOP      3328
#define XB_TOPGEN   3392
#define XCD_BAR_WORDS 3456
#define XB_SPIN_CAP (1u << 18)
__device__ __forceinline__ unsigned xb_ld(unsigned* p)              { return __hip_atomic_load(p, __ATOMIC_RELAXED, __HIP_MEMORY_SCOPE_AGENT); }
__device__ __forceinline__ unsigned xb_add(unsigned* p, unsigned v) { return __hip_atomic_fetch_add(p, v, __ATOMIC_RELAXED, __HIP_MEMORY_SCOPE_AGENT); }
__device__ __forceinline__ unsigned xb_xcc_id() { return (unsigned)__builtin_amdgcn_s_getreg((3 << 11) | 20) & 0xFu; }
#define XB_SPIN(cond, bar) do { unsigned _sp = 0; while (cond) { __builtin_amdgcn_s_sleep(1); \
    if ((++_sp & 255u) == 0u) { if (xb_ld(&(bar)[XB_TMO])) break; if (_sp > XB_SPIN_CAP) { atomicAdd(&(bar)[XB_TMO], 1u); break; } } } } while (0)
struct XcdBarrier { unsigned* bar; unsigned x; volatile LAS unsigned* st; };
__device__ __forceinline__ XcdBarrier xcd_barrier_post(unsigned* bar, volatile LAS unsigned* st) {
  XcdBarrier b; b.bar = bar; b.x = xb_xcc_id(); b.st = st;
  if (threadIdx.x == 0) (void)xb_add(&bar[XB_XCNT(b.x)], 1u);
  return b;
}
__device__ __forceinline__ void xcd_barrier_complete(unsigned* bar, unsigned x, unsigned& nloc, unsigned& nx) {
  const unsigned G = gridDim.x * gridDim.y * gridDim.z;
  unsigned sum, cnt, mine, sp = 0u;
  for (;;) {
    sum = 0u; cnt = 0u; mine = 0u;
#pragma unroll
    for (unsigned j = 0; j < 16; ++j) { const unsigned c = xb_ld(&bar[XB_XCNT(j)]); sum += c; cnt += (c > 0u) ? 1u : 0u; mine = (j == x) ? c : mine; }
    if (sum == G) break;
    __builtin_amdgcn_s_sleep(1);
    if ((++sp & 255u) == 0u) { if (xb_ld(&bar[XB_TMO])) break; if (sp > XB_SPIN_CAP) { atomicAdd(&bar[XB_TMO], 1u); break; } }
  }
  nloc = mine > 0u ? mine : 1u; nx = cnt > 0u ? cnt : 1u;
}
__device__ __forceinline__ void xcd_barrier(const XcdBarrier& b) {
  asm volatile("s_waitcnt vmcnt(0)" ::: "memory");
  __syncthreads();
  if (threadIdx.x == 0) {
    unsigned* bar = b.bar;
    __builtin_amdgcn_s_waitcnt(0);
    unsigned nloc = b.st[0], nx = b.st[1];
    if (nloc == 0u) { xcd_barrier_complete(bar, b.x, nloc, nx); b.st[0] = nloc; b.st[1] = nx; }
    const unsigned old = xb_add(&bar[XB_XSUB(b.x)], 1u);
    const unsigned gen = old / nloc;
    if (old + 1u == (gen + 1u) * nloc) {
      __builtin_amdgcn_fence(__ATOMIC_RELEASE, "agent");
      asm volatile("s_waitcnt vmcnt(0)" ::: "memory");
      const unsigned og = xb_add(&bar[XB_TOP], 1u);
      const unsigned tg = og / nx;
      if (og + 1u == (tg + 1u) * nx) xb_add(&bar[XB_TOPGEN], 1u);
      else XB_SPIN(xb_ld(&bar[XB_TOPGEN]) == tg, bar);
      __builtin_amdgcn_fence(__ATOMIC_ACQUIRE, "agent");
      xb_add(&bar[XB_XGEN(b.x)], 1u);
      asm volatile("s_waitcnt vmcnt(0)" ::: "memory");
    } else {
      XB_SPIN(xb_ld(&bar[XB_XGEN(b.x)]) == gen, bar);
      __builtin_amdgcn_fence(__ATOMIC_ACQUIRE, "agent");
      asm volatile("s_waitcnt vmcnt(0)" ::: "memory");
    }
  }
  __syncthreads();
}

struct Params {
  const float *x, *mem, *norm_mix_g, *w_in, *att_q_g, *att_k_g, *rel_bias;
  const float *lam_re, *lam_im, *log_step, *b_re, *b_im, *c_re, *c_im, *d_skip, *w_glu, *b_glu;
  const float *att_out_g, *ssm_out_g, *w_out, *norm_mem_g, *norm_memkv_g, *w_mem_q, *w_mem_k, *w_mem_v;
  const float *mem_q_g, *mem_k_g, *w_mem_o, *norm_peer_g, *w_peer_q, *peer_keys, *peer_u, *peer_v;
  float* out;
  unsigned* bar;
  bf16_t *WtIn, *WtGlu, *WtOut, *WtMq, *WtMk, *WtMv, *WtMo, *WtPq, *PK, *PU, *PV;
  bf16_t *XB, *MEMB, *Qb, *Kb, *VT, *Ub, *ATT, *YG, *SSMO, *H1B, *QM, *OM, *H2B, *QP;
  bf16_t *KMB, *VMT, *WE16, *WY;
  float *rs_x, *rs_mem, *ss_att, *ss_ssm, *ss_h1, *ss_qm, *ss_km, *ss_h2, *KMraw, *ESEG;
  float *BBR, *BBI, *PWR, *PWI, *KJ, *APW, *SHF;
  unsigned* TOPS;
  unsigned char *PU8, *PV8; float *su, *sv;
};

#define GAS __attribute__((address_space(1)))
#define RAW_BARRIER() do { asm volatile("s_waitcnt lgkmcnt(0)" ::: "memory"); __builtin_amdgcn_s_barrier(); } while (0)
__device__ __forceinline__ void glds16(const void* gsrc, unsigned lds_dst) {
  unsigned keep;
  asm volatile("s_mov_b32 %0, m0\n\ts_mov_b32 m0, %2\n\ts_nop 0\n\tglobal_load_lds_dwordx4 %1, off\n\ts_mov_b32 m0, %0" : "=&s"(keep) : "v"(gsrc), "s"(lds_dst) : "memory");
}
template <bool ZERO = true, bool SWAP = false>
__device__ __forceinline__ void gemm_mainloop(f32x4 (&acc)[4][4], const bf16_t* __restrict__ A, int lda, const bf16_t* __restrict__ Bt, int ldb, int K,
                                              int row0, int col0, char* lds_) {
  LAS char* lds = (LAS char*)lds_;
  const int tid = threadIdx.x, lane = tid & 63, w = tid >> 6, wr = w >> 1, wc = w & 1, fr = lane & 15, fq = lane >> 4;
  if (ZERO) {
#pragma unroll
    for (int m = 0; m < 4; ++m)
#pragma unroll
      for (int n = 0; n < 4; ++n) acc[m][n] = (f32x4){0.f, 0.f, 0.f, 0.f};
  }
  const int lr = lane >> 3, lc = (lane & 7) ^ lr;
  const bf16_t* gA = A + (size_t)(row0 + w * 32 + lr) * lda + lc * 8;
  const bf16_t* gB = Bt + (size_t)(col0 + w * 32 + lr) * ldb + lc * 8;
  const unsigned wbase = (unsigned)(size_t)lds + (unsigned)__builtin_amdgcn_readfirstlane(w) * 4096u;
  const int nk = K >> 6;
  __syncthreads();
#pragma unroll
  for (int i = 0; i < 4; ++i) { glds16(gA + (size_t)(i * 8) * lda, wbase + i * 1024u); glds16(gB + (size_t)(i * 8) * ldb, wbase + 16384u + i * 1024u); }
  for (int kt = 0; kt < nk; ++kt) {
    asm volatile("s_waitcnt vmcnt(0)" ::: "memory");
    RAW_BARRIER();
    LAS char* cur = lds + (kt & 1) * 32768;
    if (kt + 1 < nk) { const int k1 = (kt + 1) << 6; const unsigned nb_ = wbase + (unsigned)(((kt + 1) & 1) * 32768);
#pragma unroll
      for (int i = 0; i < 4; ++i) { glds16(gA + (size_t)(i * 8) * lda + k1, nb_ + i * 1024u); glds16(gB + (size_t)(i * 8) * ldb + k1, nb_ + 16384u + i * 1024u); } }
#pragma unroll
    for (int ks = 0; ks < 2; ++ks) {
      bf16x8 af[4], bfr[4];
      const int kc = ks * 4 + fq;
#pragma unroll
      for (int m = 0; m < 4; ++m) { const int r = wr * 64 + m * 16 + fr; af[m] = as_bf(*(const LAS u32x4*)(cur + r * 128 + ((kc ^ (r & 7)) << 4))); }
#pragma unroll
      for (int n = 0; n < 4; ++n) { const int r = wc * 64 + n * 16 + fr; bfr[n] = as_bf(*(const LAS u32x4*)(cur + 16384 + r * 128 + ((kc ^ (r & 7)) << 4))); }
#pragma unroll
      for (int m = 0; m < 4; ++m)
#pragma unroll
        for (int n = 0; n < 4; ++n) acc[m][n] = SWAP ? mfma16(af[m], bfr[n], acc[m][n]) : mfma16(bfr[n], af[m], acc[m][n]);
    }
  }
  RAW_BARRIER();
}

__device__ __forceinline__ void transpose_tile(const float* __restrict__ src, bf16_t* __restrict__ dst, int K, int N, int tile, const float* g0, const float* g1, int split, float* tl  ) {
  const int ntn = N >> 6; const int tk = tile / ntn, tn = tile % ntn; const int k0 = tk << 6, n0 = tn << 6; const int tid = threadIdx.x;
  __syncthreads();
#pragma unroll
  for (int i = 0; i < 4; ++i) { const int kk = i * 16 + (tid >> 4), nn = (tid & 15) * 4; const int k = k0 + kk;
    float g = 1.f; if (g0) g = (k < split) ? g0[k] : g1[k - split];
    const float4 v = *(const float4*)(src + (size_t)k * N + n0 + nn);
    tl[kk * 65 + nn] = v.x * g; tl[kk * 65 + nn + 1] = v.y * g; tl[kk * 65 + nn + 2] = v.z * g; tl[kk * 65 + nn + 3] = v.w * g; }
  __syncthreads();
  const int n = tid >> 2, kq = (tid & 3) * 16;
  unsigned o[8];
#pragma unroll
  for (int j = 0; j < 8; ++j) o[j] = pack2(tl[(kq + 2 * j) * 65 + n], tl[(kq + 2 * j + 1) * 65 + n]);
  uint4* d = (uint4*)(dst + (size_t)(n0 + n) * K + k0 + kq);
  d[0] = make_uint4(o[0], o[1], o[2], o[3]); d[1] = make_uint4(o[4], o[5], o[6], o[7]);
}

__device__ __forceinline__ void convert_flat(const float* __restrict__ src, bf16_t* __restrict__ dst, size_t n8  , int bid, int nb) {
  for (size_t i = (size_t)bid * NTHREADS + threadIdx.x; i < n8; i += (size_t)nb * NTHREADS) {
    const float4 a = ((const float4*)src)[2 * i], b = ((const float4*)src)[2 * i + 1];
    ((uint4*)dst)[i] = make_uint4(pack2(a.x, a.y), pack2(a.z, a.w), pack2(b.x, b.y), pack2(b.z, b.w));
  }
}
__device__ __forceinline__ void rows_bf16_rs(const float* __restrict__ src, bf16_t* __restrict__ dst, float* __restrict__ rs, int nrows, int bid, int nb) {
  const int lane = threadIdx.x & 63, w = threadIdx.x >> 6; const int nwv = nb * 4;
  for (int row0 = bid * 4 + w; row0 < nrows; row0 += nwv * 4) {
    float4 v[4][4];
#pragma unroll
    for (int r = 0; r < 4; ++r) { const int row = row0 + r * nwv; if (row < nrows) { const float4* s = (const float4*)(src + (size_t)row * 1024);
#pragma unroll
        for (int i = 0; i < 4; ++i) v[r][i] = s[i * 64 + lane]; } }
#pragma unroll
    for (int r = 0; r < 4; ++r) { const int row = row0 + r * nwv; if (row < nrows) {
      float ss = 0.f; uint2* d = (uint2*)(dst + (size_t)row * 1024);
#pragma unroll
      for (int i = 0; i < 4; ++i) { const float4 x = v[r][i]; ss += x.x * x.x + x.y * x.y + x.z * x.z + x.w * x.w; d[i * 64 + lane] = make_uint2(pack2(x.x, x.y), pack2(x.z, x.w)); }
#pragma unroll
      for (int o = 32; o > 0; o >>= 1) ss += __shfl_xor(ss, o);
      if (lane == 0) rs[row] = rsqrtf(ss * (1.0f / 1024.0f) + EPSF); } }
  }
}
__device__ __forceinline__ void rows_fp8(const float* __restrict__ src, unsigned char* __restrict__ dst, float* __restrict__ sc, int nrows, int bid, int nb) {
  const int lane = threadIdx.x & 63, w = threadIdx.x >> 6;
  for (int row = bid * 4 + w; row < nrows; row += nb * 4) {
    const float4* s = (const float4*)(src + (size_t)row * 1024);
    float4 v[4]; float am = 0.f;
#pragma unroll
    for (int i = 0; i < 4; ++i) { v[i] = s[i * 64 + lane]; am = fmaxf(am, fmaxf(fmaxf(fabsf(v[i].x), fabsf(v[i].y)), fmaxf(fabsf(v[i].z), fabsf(v[i].w)))); }
#pragma unroll
    for (int o = 32; o > 0; o >>= 1) am = fmaxf(am, __shfl_xor(am, o));
    const float q = (am > 0.f) ? 224.0f / am : 1.0f;
    unsigned* d = (unsigned*)(dst + (size_t)row * 1024);
#pragma unroll
    for (int i = 0; i < 4; ++i) { int wd = 0; wd = __builtin_amdgcn_cvt_pk_fp8_f32(v[i].x * q, v[i].y * q, wd, false); wd = __builtin_amdgcn_cvt_pk_fp8_f32(v[i].z * q, v[i].w * q, wd, true); d[i * 64 + lane] = (unsigned)wd; }
    if (lane == 0) sc[row] = (am > 0.f) ? am * (1.0f / 224.0f) : 1.0f;
  }
}

template <bool SWAPN>
__device__ __forceinline__ void rows_fp4(const float* __restrict__ src, unsigned char* __restrict__ dst, float* __restrict__ sc, int nrows, int bid, int nb) {
  const int lane = threadIdx.x & 63, w = threadIdx.x >> 6; const int nwv = nb * 4;
  for (int row0 = bid * 4 + w; row0 < nrows; row0 += nwv * 4) {
    float4 v[4][4];
#pragma unroll
    for (int r = 0; r < 4; ++r) { const int row = row0 + r * nwv; if (row < nrows) { const float4* s = (const float4*)(src + (size_t)row * 1024 + lane * 16);
#pragma unroll
        for (int i = 0; i < 4; ++i) v[r][i] = s[i]; } }
#pragma unroll
    for (int r = 0; r < 4; ++r) { const int row = row0 + r * nwv; if (row < nrows) {
      float am = 0.f;
#pragma unroll
      for (int i = 0; i < 4; ++i) am = fmaxf(am, fmaxf(fmaxf(fabsf(v[r][i].x), fabsf(v[r][i].y)), fmaxf(fabsf(v[r][i].z), fabsf(v[r][i].w))));
#pragma unroll
      for (int o = 32; o > 0; o >>= 1) am = fmaxf(am, __shfl_xor(am, o));
      const float q = (am > 0.f) ? 6.0f / am : 1.0f;
      unsigned w0 = 0, w1 = 0;
      w0 = __builtin_amdgcn_cvt_scalef32_pk_fp4_f32(w0, v[r][0].x * q, v[r][0].y * q, 1.0f, 0); w0 = __builtin_amdgcn_cvt_scalef32_pk_fp4_f32(w0, v[r][0].z * q, v[r][0].w * q, 1.0f, 1);
      w0 = __builtin_amdgcn_cvt_scalef32_pk_fp4_f32(w0, v[r][1].x * q, v[r][1].y * q, 1.0f, 2); w0 = __builtin_amdgcn_cvt_scalef32_pk_fp4_f32(w0, v[r][1].z * q, v[r][1].w * q, 1.0f, 3);
      w1 = __builtin_amdgcn_cvt_scalef32_pk_fp4_f32(w1, v[r][2].x * q, v[r][2].y * q, 1.0f, 0); w1 = __builtin_amdgcn_cvt_scalef32_pk_fp4_f32(w1, v[r][2].z * q, v[r][2].w * q, 1.0f, 1);
      w1 = __builtin_amdgcn_cvt_scalef32_pk_fp4_f32(w1, v[r][3].x * q, v[r][3].y * q, 1.0f, 2); w1 = __builtin_amdgcn_cvt_scalef32_pk_fp4_f32(w1, v[r][3].z * q, v[r][3].w * q, 1.0f, 3);
      *(uint2*)(dst + (size_t)row * 512 + lane * 8) = make_uint2(w0, w1);
      if (lane == 0) sc[row] = (am > 0.f) ? am * (1.0f / 6.0f) : 1.0f; } }
  }
}

__device__ __forceinline__ void ssm_stage1(const Params& p, int gp) {
  const int g = gp >> 6;
  const float step = expf(p.log_step[g]); const float lr = p.lam_re[gp], li = p.lam_im[gp];
  const float mag = expf(lr * step); const float ar = mag * cosf(li * step), ai = mag * sinf(li * step);
  const float zr = ar - 1.0f, den = lr * lr + li * li; const float fr = (zr * lr + ai * li) / den, fi = (ai * lr - zr * li) / den;
  for (int c = 0; c < 16; ++c) { const float br = p.b_re[gp * 16 + c], bi = p.b_im[gp * 16 + c]; p.BBR[gp * 16 + c] = fr * br - fi * bi; p.BBI[gp * 16 + c] = fr * bi + fi * br; }
  float pr = 1.f, pi = 0.f; const int st = gp & 63;
  for (int j = 0; j <= 16; ++j) { p.PWR[(g * 17 + j) * 64 + st] = pr; p.PWI[(g * 17 + j) * 64 + st] = pi; const float nr = pr * ar - pi * ai, ni = pr * ai + pi * ar; if (j < 16) { pr = nr; pi = ni; } }
  const float a16r = pr, a16i = pi; const float a32r = a16r * a16r - a16i * a16i, a32i = 2.f * a16r * a16i;
  const float a48r = a32r * a16r - a32i * a16i, a48i = a32r * a16i + a32i * a16r; const float a64r = a32r * a32r - a32i * a32i, a64i = 2.f * a32r * a32i;
  const float a128r = a64r * a64r - a64i * a64i, a128i = 2.f * a64r * a64i; const float a256r = a128r * a128r - a128i * a128i, a256i = 2.f * a128r * a128i;
  float* A = p.APW;
  A[0 * 4096 + gp] = a16r; A[0 * 4096 + 2048 + gp] = a16i; A[1 * 4096 + gp] = a32r; A[1 * 4096 + 2048 + gp] = a32i; A[2 * 4096 + gp] = a48r; A[2 * 4096 + 2048 + gp] = a48i;
  A[3 * 4096 + gp] = a64r; A[3 * 4096 + 2048 + gp] = a64i; A[4 * 4096 + gp] = a256r; A[4 * 4096 + 2048 + gp] = a256i;
}
__device__ __forceinline__ void ssm_stage2a(const Params& p, int bid, int nb) {
  const int n1 = 32 * 128 * 256, n2 = 32 * 16 * 4 * 512, n3 = 32 * 16 * 256;
  for (int i = bid * NTHREADS + threadIdx.x; i < n1 + n2 + n3; i += nb * NTHREADS) {
    if (i < n1) {
      const int j = i & 7, lane = (i >> 3) & 63, ks = (i >> 9) & 7, ri = (i >> 12) & 1, w = (i >> 13) & 3, g = i >> 15;
      const int st = w * 16 + (lane & 15), k = ks * 32 + (lane >> 4) * 8 + j; const int s_ = k >> 4, ch = k & 15;
      const int gp = g * 64 + st; const float pr = p.PWR[(g * 17 + 15 - s_) * 64 + st], pi = p.PWI[(g * 17 + 15 - s_) * 64 + st]; const float br = p.BBR[gp * 16 + ch], bi = p.BBI[gp * 16 + ch];
      p.WE16[i] = f2bf(ri == 0 ? (pr * br - pi * bi) : (pr * bi + pi * br));
    } else if (i < n1 + n2) {
      const int e = i - n1; const int j = e & 7, lane = (e >> 3) & 63, ks = (e >> 9) & 3, mt = (e >> 11) & 15, g = e >> 15;
      const int t = mt, co = lane & 15, k = ks * 32 + (lane >> 4) * 8 + j;
      const int st = ((k >> 5) << 4) | (k & 15), ri = (k >> 4) & 1; const float cr = p.c_re[(g * 16 + co) * 64 + st], ci = p.c_im[(g * 16 + co) * 64 + st];
      const float pr = p.PWR[(g * 17 + t + 1) * 64 + st], pi = p.PWI[(g * 17 + t + 1) * 64 + st];
      p.WY[((size_t)(g * 16 + mt) * 12 + ks) * 512 + lane * 8 + j] = f2bf((ri == 0) ? (cr * pr - ci * pi) : -(cr * pi + ci * pr));
    } else {
      const int e = i - n1 - n2; const int cin = e & 15, co = (e >> 4) & 15, j = (e >> 8) & 15, g = e >> 12; float acc = 0.f;
      for (int st = 0; st < 64; ++st) { const float cr = p.c_re[(g * 16 + co) * 64 + st], ci = p.c_im[(g * 16 + co) * 64 + st]; const float pr = p.PWR[(g * 17 + j) * 64 + st], pi = p.PWI[(g * 17 + j) * 64 + st];
        const float br = p.BBR[(g * 64 + st) * 16 + cin], bi = p.BBI[(g * 64 + st) * 16 + cin]; acc += cr * (pr * br - pi * bi) - ci * (pr * bi + pi * br); }
      p.KJ[e] = acc;
    }
  }
}
__device__ __forceinline__ void ssm_stage2b(const Params& p, int bid, int nb) {
  const int n = 32 * 16 * 8 * 512;
  for (int i = bid * NTHREADS + threadIdx.x; i < n; i += nb * NTHREADS) {
    const int j = i & 7, lane = (i >> 3) & 63, ks8 = (i >> 9) & 7, mt = (i >> 12) & 15, g = i >> 16;
    const int t = mt, co = lane & 15, kk = ks8 * 32 + (lane >> 4) * 8 + j; const int s_ = kk >> 4, cin = kk & 15;
    const float val = (s_ <= t) ? p.KJ[((g * 16 + (t - s_)) * 16 + co) * 16 + cin] : 0.f;
    p.WY[((size_t)(g * 16 + mt) * 12 + 4 + ks8) * 512 + lane * 8 + j] = f2bf(val);
  }
}

#define EPI_IDS const int tid = threadIdx.x, lane = tid & 63, w = tid >> 6, wr = w >> 1, wc = w & 1, fr = lane & 15, fq = lane >> 4; (void)wr; (void)wc; (void)fr; (void)fq;

__device__ __forceinline__ void tile_win_v(const Params& p, int tile, char* lds) {
  const int rt = tile >> 4, ct = tile & 15; const int row0 = rt * 128, col0 = ct * 128;
  f32x4 acc[4][4];
  gemm_mainloop<true, true>(acc, p.XB, 1024, p.WtIn, 1024, 1024, row0, col0, lds);
  EPI_IDS
  const int head = (col0 + wc * 64 - 1024) >> 6;
#pragma unroll
  for (int m = 0; m < 4; ++m) {
    const int row = row0 + wr * 64 + m * 16 + fq * 4; const f32x4 rsx = *(const f32x4*)(p.rs_x + row); const int b = row >> 13, tb = row & 8191;
#pragma unroll
    for (int n = 0; n < 4; ++n) { const f32x4 v = acc[m][n] * rsx;
      *(uint2*)(p.VT + ((size_t)(b * 8 + head) * 64 + n * 16 + fr) * SEQL + tb) = make_uint2(pack2(v[0], v[1]), pack2(v[2], v[3])); }
  }
}
__device__ __forceinline__ void tile_win(const Params& p, int tile, char* lds) {
  const int rt = tile >> 4, ct = tile & 15; const int row0 = rt * 128, col0 = ct * 128;
  f32x4 acc[4][4];
  gemm_mainloop<true>(acc, p.XB, 1024, p.WtIn, 1024, 1024, row0, col0, lds);
  EPI_IDS
  const int cw = col0 + wc * 64;
#pragma unroll
  for (int m = 0; m < 4; ++m) {
    const int row = row0 + wr * 64 + m * 16 + fr; const float rsx = p.rs_x[row];
    if (cw < 1024) {
      float ss = 0.f;
#pragma unroll
      for (int n = 0; n < 4; ++n)
#pragma unroll
        for (int j = 0; j < 4; ++j) { const float v = acc[m][n][j] * rsx; acc[m][n][j] = v; ss += v * v; }
      ss += __shfl_xor(ss, 16); ss += __shfl_xor(ss, 32);
      const float rs = rsqrtf(ss * (1.0f / 64.0f) + EPSF) * (cw < 512 ? 0.125f * 1.44269504f : 1.0f);
      const float* g = (cw < 512) ? p.att_q_g : p.att_k_g; bf16_t* dst = (cw < 512 ? p.Qb : p.Kb) + (size_t)row * 512 + (cw & 511);
#pragma unroll
      for (int n = 0; n < 4; ++n) { const int c = n * 16 + fq * 4; const float4 gg = *(const float4*)(g + c);
        *(uint2*)(dst + c) = make_uint2(pack2(acc[m][n][0] * rs * gg.x, acc[m][n][1] * rs * gg.y), pack2(acc[m][n][2] * rs * gg.z, acc[m][n][3] * rs * gg.w)); }
    } else if (cw < 1536) {
      const int head = (cw - 1024) >> 6; const int b = row >> 13, tb = row & 8191;
      bf16_t* dst = p.VT + ((size_t)(b * 8 + head) * 64) * SEQL + tb;
#pragma unroll
      for (int n = 0; n < 4; ++n)
#pragma unroll
        for (int j = 0; j < 4; ++j) dst[(size_t)(n * 16 + fq * 4 + j) * SEQL] = f2bf(acc[m][n][j] * rsx);
    } else {
      const int b = row >> 13, tb = row & 8191;
#pragma unroll
      for (int n = 0; n < 4; ++n) { const int g = ((cw - 1536) >> 4) + n;
        *(uint2*)(p.Ub + ((size_t)(b * 32 + g) * SEQL + tb) * 16 + fq * 4) = make_uint2(pack2(acc[m][n][0] * rsx, acc[m][n][1] * rsx), pack2(acc[m][n][2] * rsx, acc[m][n][3] * rsx)); }
    }
  }
}
__device__ __forceinline__ void tile_memkv(const Params& p, int tile, char* lds) {
  const int which = tile >> 5, t2 = tile & 31; const int rt = t2 >> 3, ct = t2 & 7; const int row0 = rt * 128, col0 = ct * 128;
  f32x4 acc[4][4];
  gemm_mainloop<true>(acc, p.MEMB, 1024, which ? p.WtMv : p.WtMk, 1024, 1024, row0, col0, lds);
  EPI_IDS
  const int cw = col0 + wc * 64;
#pragma unroll
  for (int m = 0; m < 4; ++m) {
    const int row = row0 + wr * 64 + m * 16 + fr; const float rsm = p.rs_mem[row];
    if (which == 0) {
      float ss = 0.f;
#pragma unroll
      for (int n = 0; n < 4; ++n) { f32x4 v = acc[m][n] * rsm; ss += v[0] * v[0] + v[1] * v[1] + v[2] * v[2] + v[3] * v[3]; *(f32x4*)(p.KMraw + (size_t)row * 1024 + cw + n * 16 + fq * 4) = v; }
      ss += __shfl_xor(ss, 16); ss += __shfl_xor(ss, 32);
      if (fq == 0) p.ss_km[row * 16 + (cw >> 6)] = ss;
    } else {
      const int b = row >> 8, key = row & 255; const int head = cw >> 8; const int d0 = (cw & 255);
      bf16_t* dst = p.VMT + ((size_t)(b * 4 + head) * 256) * 256 + key;
#pragma unroll
      for (int n = 0; n < 4; ++n)
#pragma unroll
        for (int j = 0; j < 4; ++j) dst[(size_t)(d0 + n * 16 + fq * 4 + j) * 256] = f2bf(acc[m][n][j] * rsm);
    }
  }
}
__device__ __forceinline__ void memk_fix(const Params& p, int bid, int nb) {
  for (int i = bid * NTHREADS + threadIdx.x; i < 512 * 1024 / 4; i += nb * NTHREADS) {
    const int row = i >> 8, c4 = (i & 255) * 4; const int head = c4 >> 8, d = c4 & 255;
    const float ss = p.ss_km[row * 16 + head * 4] + p.ss_km[row * 16 + head * 4 + 1] + p.ss_km[row * 16 + head * 4 + 2] + p.ss_km[row * 16 + head * 4 + 3];
    const float rs = rsqrtf(ss * (1.0f / 256.0f) + EPSF);
    const float4 v = *(const float4*)(p.KMraw + (size_t)row * 1024 + c4); const float4 gk = *(const float4*)(p.mem_k_g + d), gq = *(const float4*)(p.mem_q_g + d);
    const int b = row >> 8, key = row & 255;
    *(uint2*)(p.KMB + ((size_t)(b * 4 + head) * 256 + key) * 256 + d) = make_uint2(pack2(v.x * rs * gk.x * gq.x, v.y * rs * gk.y * gq.y), pack2(v.z * rs * gk.z * gq.z, v.w * rs * gk.w * gq.w));
  }
}

__device__ __forceinline__ void chunk_attn_prep(const Params& p, char* lds_) {
  LAS float* rb = (LAS float*)((LAS char*)lds_ + 65536);
  __syncthreads();
  for (int i = threadIdx.x; i < 8 * 192; i += NTHREADS) rb[i] = p.rel_bias[i] * 1.44269504f - p.SHF[i / 192];
  __syncthreads();
}
__device__ __forceinline__ void cattn_stage(const bf16_t* kg, const bf16_t* vg, unsigned st, int w, int lane) {
  const unsigned wb = st + (unsigned)__builtin_amdgcn_readfirstlane(w) * 2048u; const int lr = lane >> 3, pos = lane & 7;
#pragma unroll
  for (int i = 0; i < 2; ++i) { const int row = w * 16 + i * 8 + lr;
    glds16(kg + (size_t)row * 512 + ((pos ^ (row & 7)) << 3), wb + i * 1024u);
    glds16(vg + (size_t)row * SEQL + ((pos ^ ((row >> 1) & 7)) << 3), wb + 8192u + i * 1024u); }
}
__device__ __forceinline__ void chunk_attn_item(const Params& p, int item, char* lds_) {
  LAS char* lds = (LAS char*)lds_;
  typedef unsigned u32x2 __attribute__((ext_vector_type(2)));
  const int h = item & 7, G = (item >> 3) & 31, b = item >> 8;
  LAS float* rb = (LAS float*)(lds + 65536) + h * 192;
  const unsigned lbase = (unsigned)(size_t)lds;
  const int tid = threadIdx.x, lane = tid & 63, w = tid >> 6, fr = lane & 15, fq = lane >> 4;
  const int iq = w * 16 + fr;
  const int cn0 = G * 4;
  const int t0 = (cn0 >= 8) ? cn0 - 8 : 0, ntl = cn0 + 3 - t0 + 1;
  const bf16_t* kbase = p.Kb + (size_t)(b * SEQL) * 512 + h * 64;
  const bf16_t* vbase = p.VT + ((size_t)(b * 8 + h) * 64) * SEQL;
  bf16x8 qf[4][2];
#pragma unroll
  for (int qc = 0; qc < 4; ++qc) { const bf16_t* qp = p.Qb + (size_t)(b * SEQL + (cn0 + qc) * 64 + iq) * 512 + h * 64 + fq * 8;
    qf[qc][0] = *(const bf16x8*)qp; qf[qc][1] = *(const bf16x8*)(qp + 32); }
  __syncthreads();
#pragma unroll
  for (int i = 0; i < 3; ++i) if (i < ntl) cattn_stage(kbase + (size_t)(t0 + i) * 64 * 512, vbase + (t0 + i) * 64, lbase + i * 16384u, w, lane);
  f32x4 o[4][4]; float lrun[4];
#pragma unroll
  for (int qc = 0; qc < 4; ++qc) { lrun[qc] = 0.f;
#pragma unroll
    for (int i = 0; i < 4; ++i) o[qc][i] = (f32x4){0.f, 0.f, 0.f, 0.f}; }
  const float cbias = rb[191];
  for (int i = 0; i < ntl; ++i) {
    const int t = t0 + i; const int rem = ntl - 1 - i;
    if (rem >= 2) asm volatile("s_waitcnt vmcnt(8)" ::: "memory"); else if (rem == 1) asm volatile("s_waitcnt vmcnt(4)" ::: "memory"); else asm volatile("s_waitcnt vmcnt(0)" ::: "memory");
    RAW_BARRIER();
    if (i + 3 < ntl) cattn_stage(kbase + (size_t)(t + 3) * 64 * 512, vbase + (t + 3) * 64, lbase + (unsigned)(((i + 3) & 3) * 16384), w, lane);
    LAS char* cur = lds + (i & 3) * 16384;
    bf16x8 kf[4][2], vf[4][2];
#pragma unroll
    for (int mt = 0; mt < 4; ++mt) { const int row = mt * 16 + fr;
      kf[mt][0] = as_bf(*(const LAS u32x4*)(cur + row * 128 + ((fq ^ (row & 7)) << 4))); kf[mt][1] = as_bf(*(const LAS u32x4*)(cur + row * 128 + (((4 + fq) ^ (row & 7)) << 4))); }
#pragma unroll
    for (int dt = 0; dt < 4; ++dt) { const int d = dt * 16 + fr; const int sw = ((d >> 1) & 7) << 1;
#pragma unroll
      for (int s2 = 0; s2 < 2; ++s2) {
        const u32x2 lo = *(const LAS u32x2*)(cur + 8192 + d * 128 + (((s2 * 8 + fq) ^ sw) << 3)), hi = *(const LAS u32x2*)(cur + 8192 + d * 128 + (((s2 * 8 + fq + 4) ^ sw) << 3));
        u32x4 vv; vv.x = lo.x; vv.y = lo.y; vv.z = hi.x; vv.w = hi.y; vf[dt][s2] = as_bf(vv); } }
#pragma unroll
    for (int qc = 0; qc < 4; ++qc) {
      const int c = t - (cn0 + qc - 8);
      if (c >= 0 && c <= 8) {
        f32x4 st[4];
        const float ini = (c <= 5) ? cbias : 0.f;
#pragma unroll
        for (int mt = 0; mt < 4; ++mt) { f32x4 sacc = (f32x4){ini, ini, ini, ini};
          sacc = mfma16(kf[mt][0], qf[qc][0], sacc); sacc = mfma16(kf[mt][1], qf[qc][1], sacc); st[mt] = sacc; }
        if (c > 5) {
#pragma unroll
          for (int mt = 0; mt < 4; ++mt)
#pragma unroll
            for (int j = 0; j < 4; ++j) { const int jk = mt * 16 + fq * 4 + j; int dist = 512 - 64 * c + iq - jk; dist = dist > 128 ? 128 : dist; st[mt][j] += rb[dist + 63]; }
        }
        float ls = 0.f;
#pragma unroll
        for (int mt = 0; mt < 4; ++mt)
#pragma unroll
          for (int j = 0; j < 4; ++j) { const float pv = __builtin_amdgcn_exp2f(st[mt][j]); st[mt][j] = pv; ls += pv; }
        lrun[qc] += ls;
        bf16x8 pf[2];
#pragma unroll
        for (int s2 = 0; s2 < 2; ++s2) { u32x4 tt; tt.x = pack2(st[2 * s2][0], st[2 * s2][1]); tt.y = pack2(st[2 * s2][2], st[2 * s2][3]); tt.z = pack2(st[2 * s2 + 1][0], st[2 * s2 + 1][1]); tt.w = pack2(st[2 * s2 + 1][2], st[2 * s2 + 1][3]); pf[s2] = as_bf(tt); }
#pragma unroll
        for (int dt = 0; dt < 4; ++dt) { f32x4 oc = o[qc][dt]; oc = mfma16(vf[dt][0], pf[0], oc); oc = mfma16(vf[dt][1], pf[1], oc); o[qc][dt] = oc; }
      }
    }
  }
#pragma unroll
  for (int qc = 0; qc < 4; ++qc) {
    const int tq = b * SEQL + (cn0 + qc) * 64 + iq;
    float lt = lrun[qc]; lt += __shfl_xor(lt, 16); lt += __shfl_xor(lt, 32);
    const float inv = 1.0f / lt; float ss = 0.f;
    bf16_t* dst = p.ATT + (size_t)tq * 512 + h * 64;
#pragma unroll
    for (int dt = 0; dt < 4; ++dt) { const f32x4 v = o[qc][dt] * inv; ss += v[0] * v[0] + v[1] * v[1] + v[2] * v[2] + v[3] * v[3];
      *(uint2*)(dst + dt * 16 + fq * 4) = make_uint2(pack2(v[0], v[1]), pack2(v[2], v[3])); }
    ss += __shfl_xor(ss, 16); ss += __shfl_xor(ss, 32);
    if (fq == 0) p.ss_att[tq * 8 + h] = ss;
  }
}

template <bool FINAL>
__device__ __forceinline__ void ssm_item(const Params& p, int item, char* lds) {
  const int g = item & 31, seg = (item >> 5) & 31, b = item >> 10;
  const int tid = threadIdx.x, lane = tid & 63, w = tid >> 6, fr = lane & 15, fq = lane >> 4;
  const int t0 = b * SEQL + seg * 256;
  const bf16_t* ug = p.Ub + ((size_t)(b * 32 + g) * SEQL + seg * 256) * 16;
  bf16x8 uf[8];
#pragma unroll
  for (int ks = 0; ks < 8; ++ks) uf[ks] = *(const bf16x8*)(ug + (size_t)(fr * 16 + 2 * ks + (fq >> 1)) * 16 + (fq & 1) * 8);
  f32x4 er = (f32x4){0.f, 0.f, 0.f, 0.f}, ei = er;
  const bf16_t* we = p.WE16 + ((size_t)(g * 4 + w) * 2 * 8 * 64 + lane) * 8;
#pragma unroll
  for (int ks = 0; ks < 8; ++ks) { const bf16x8 br = *(const bf16x8*)(we + ks * 512), bi = *(const bf16x8*)(we + 4096 + ks * 512); er = mfma16(uf[ks], br, er); ei = mfma16(uf[ks], bi, ei); }
  const int gp = g * 64 + w * 16 + fr;
  const float a16r = p.APW[gp], a16i = p.APW[2048 + gp];
  float xr[4], xi[4];
  xr[0] = er[0]; xi[0] = ei[0];
#pragma unroll
  for (int j = 1; j < 4; ++j) { xr[j] = a16r * xr[j - 1] - a16i * xi[j - 1] + er[j]; xi[j] = a16r * xi[j - 1] + a16i * xr[j - 1] + ei[j]; }
  float cr = 0.f, ci = 0.f;
  if (FINAL) {
    const float ar = p.APW[4 * 4096 + gp], ai = p.APW[4 * 4096 + 2048 + gp];
    const float* es = p.ESEG + ((size_t)(b * 32) * 32 + g) * 128 + w * 32 + fr;
    for (int j0 = 0; j0 < seg; j0 += 8) { float e_r[8], e_i[8];
#pragma unroll
      for (int u = 0; u < 8; ++u) { e_r[u] = es[(size_t)(j0 + u) * 32 * 128]; e_i[u] = es[(size_t)(j0 + u) * 32 * 128 + 16]; }
#pragma unroll
      for (int u = 0; u < 8; ++u) if (j0 + u < seg) { const float nr = ar * cr - ai * ci + e_r[u], ni = ar * ci + ai * cr + e_i[u]; cr = nr; ci = ni; } }
  }
  const float a64r = p.APW[3 * 4096 + gp], a64i = p.APW[3 * 4096 + 2048 + gp];
  float tr = xr[3], ti = xi[3];
#pragma unroll
  for (int r = 0; r < 4; ++r) {
    float pr_ = __shfl(tr, (lane + 48) & 63), pi_ = __shfl(ti, (lane + 48) & 63);
    if (r == 0) { pr_ = cr; pi_ = ci; }
    if (fq == r) { const float nr = xr[3] + a64r * pr_ - a64i * pi_, ni = xi[3] + a64r * pi_ + a64i * pr_; tr = nr; ti = ni; }
  }
  if (!FINAL) {
    if (fq == 3) { float* es = p.ESEG + ((size_t)(b * 32 + seg) * 32 + g) * 128 + w * 32 + fr; es[0] = tr; es[16] = ti; }
    return;
  }
  float gr = __shfl(tr, (lane + 48) & 63), gi = __shfl(ti, (lane + 48) & 63);
  if (fq == 0) { gr = cr; gi = ci; }
  float pvr[4], pvi[4];
  pvr[0] = gr; pvi[0] = gi;
#pragma unroll
  for (int j = 1; j < 4; ++j) { const float ar = p.APW[(j - 1) * 4096 + gp], ai = p.APW[(j - 1) * 4096 + 2048 + gp]; pvr[j] = xr[j - 1] + ar * gr - ai * gi; pvi[j] = xi[j - 1] + ar * gi + ai * gr; }
  bf16_t* xl = (bf16_t*)lds;
  __syncthreads();
#pragma unroll
  for (int j = 0; j < 4; ++j) { xl[(fq * 4 + j) * 136 + w * 32 + fr] = f2bf(pvr[j]); xl[(fq * 4 + j) * 136 + w * 32 + 16 + fr] = f2bf(pvi[j]); }
  __syncthreads();
  bf16x8 xf[4];
#pragma unroll
  for (int ks = 0; ks < 4; ++ks) xf[ks] = *(const bf16x8*)(xl + fr * 136 + ks * 32 + fq * 8);
#pragma unroll
  for (int mi = 0; mi < 4; ++mi) {
    const int mt = w * 4 + mi;
    const bf16_t* wy = p.WY + ((size_t)(g * 16 + mt) * 12 * 64 + lane) * 8;
    f32x4 y = (f32x4){0.f, 0.f, 0.f, 0.f};
#pragma unroll
    for (int ks = 0; ks < 4; ++ks) y = mfma16(*(const bf16x8*)(wy + ks * 512), xf[ks], y);
#pragma unroll
    for (int ks = 0; ks < 8; ++ks) if (2 * ks <= mt) y = mfma16(*(const bf16x8*)(wy + (4 + ks) * 512), uf[ks], y);
    const size_t tok = (size_t)(t0 + fr * 16 + mt);
    const uint2 uu = *(const uint2*)(ug + (size_t)(fr * 16 + mt) * 16 + fq * 4);
    const float4 dd = *(const float4*)(p.d_skip + g * 16 + fq * 4);
    const float y0 = gelu_f(y[0] + dd.x * __uint_as_float(uu.x << 16)), y1 = gelu_f(y[1] + dd.y * __uint_as_float(uu.x & 0xffff0000u));
    const float y2 = gelu_f(y[2] + dd.z * __uint_as_float(uu.y << 16)), y3 = gelu_f(y[3] + dd.w * __uint_as_float(uu.y & 0xffff0000u));
    *(uint2*)(p.YG + tok * 512 + g * 16 + fq * 4) = make_uint2(pack2(y0, y1), pack2(y2, y3));
  }
}

__device__ __forceinline__ void ssm_final_pair(const Params& p, int item, char* lds) {
  const int g = item & 31, sp = (item >> 5) & 15, b = item >> 9;
  const int tid = threadIdx.x, lane = tid & 63, w = tid >> 6, fr = lane & 15, fq = lane >> 4;
  const int gp = g * 64 + w * 16 + fr;
  const bf16_t* ug0 = p.Ub + ((size_t)(b * 32 + g) * SEQL + sp * 512) * 16;
  bf16x8 uf[2][8];
#pragma unroll
  for (int q = 0; q < 2; ++q)
#pragma unroll
    for (int ks = 0; ks < 8; ++ks) uf[q][ks] = *(const bf16x8*)(ug0 + (size_t)(q * 256 + fr * 16 + 2 * ks + (fq >> 1)) * 16 + (fq & 1) * 8);
  f32x4 er[2], ei[2];
#pragma unroll
  for (int q = 0; q < 2; ++q) { er[q] = (f32x4){0.f, 0.f, 0.f, 0.f}; ei[q] = er[q]; }
  const bf16_t* we = p.WE16 + ((size_t)(g * 4 + w) * 2 * 8 * 64 + lane) * 8;
#pragma unroll
  for (int ks = 0; ks < 8; ++ks) { const bf16x8 br = *(const bf16x8*)(we + ks * 512), bi = *(const bf16x8*)(we + 4096 + ks * 512);
#pragma unroll
    for (int q = 0; q < 2; ++q) { er[q] = mfma16(uf[q][ks], br, er[q]); ei[q] = mfma16(uf[q][ks], bi, ei[q]); } }
  const float a16r = p.APW[gp], a16i = p.APW[2048 + gp];
  const float a64r = p.APW[3 * 4096 + gp], a64i = p.APW[3 * 4096 + 2048 + gp];
  const float a256r = p.APW[4 * 4096 + gp], a256i = p.APW[4 * 4096 + 2048 + gp];
  float cr[2], ci[2]; cr[0] = 0.f; ci[0] = 0.f;
  const float* es = p.ESEG + ((size_t)(b * 32) * 32 + g) * 128 + w * 32 + fr;
  const int seg0 = sp * 2;
  for (int j0 = 0; j0 < seg0; j0 += 8) { float e_r[8], e_i[8];
#pragma unroll
    for (int u = 0; u < 8; ++u) { e_r[u] = es[(size_t)(j0 + u) * 32 * 128]; e_i[u] = es[(size_t)(j0 + u) * 32 * 128 + 16]; }
#pragma unroll
    for (int u = 0; u < 8; ++u) if (j0 + u < seg0) { const float nr = a256r * cr[0] - a256i * ci[0] + e_r[u], ni = a256r * ci[0] + a256i * cr[0] + e_i[u]; cr[0] = nr; ci[0] = ni; } }
  { const float e_r = es[(size_t)seg0 * 32 * 128], e_i = es[(size_t)seg0 * 32 * 128 + 16]; cr[1] = a256r * cr[0] - a256i * ci[0] + e_r; ci[1] = a256r * ci[0] + a256i * cr[0] + e_i; }
  bf16_t* xl = (bf16_t*)lds;
  __syncthreads();
#pragma unroll
  for (int q = 0; q < 2; ++q) {
    float xr[4], xi[4];
    xr[0] = er[q][0]; xi[0] = ei[q][0];
#pragma unroll
    for (int j = 1; j < 4; ++j) { xr[j] = a16r * xr[j - 1] - a16i * xi[j - 1] + er[q][j]; xi[j] = a16r * xi[j - 1] + a16i * xr[j - 1] + ei[q][j]; }
    float tr = xr[3], ti = xi[3];
#pragma unroll
    for (int r = 0; r < 4; ++r) {
      float pr_ = __shfl(tr, (lane + 48) & 63), pi_ = __shfl(ti, (lane + 48) & 63);
      if (r == 0) { pr_ = cr[q]; pi_ = ci[q]; }
      if (fq == r) { const float nr = xr[3] + a64r * pr_ - a64i * pi_, ni = xi[3] + a64r * pi_ + a64i * pr_; tr = nr; ti = ni; }
    }
    float gr = __shfl(tr, (lane + 48) & 63), gi = __shfl(ti, (lane + 48) & 63);
    if (fq == 0) { gr = cr[q]; gi = ci[q]; }
    float pvr[4], pvi[4];
    pvr[0] = gr; pvi[0] = gi;
#pragma unroll
    for (int j = 1; j < 4; ++j) { const float ar = p.APW[(j - 1) * 4096 + gp], ai = p.APW[(j - 1) * 4096 + 2048 + gp]; pvr[j] = xr[j - 1] + ar * gr - ai * gi; pvi[j] = xi[j - 1] + ar * gi + ai * gr; }
#pragma unroll
    for (int j = 0; j < 4; ++j) { xl[q * 2176 + (fq * 4 + j) * 136 + w * 32 + fr] = f2bf(pvr[j]); xl[q * 2176 + (fq * 4 + j) * 136 + w * 32 + 16 + fr] = f2bf(pvi[j]); }
  }
  __syncthreads();
  bf16x8 xf[2][4];
#pragma unroll
  for (int q = 0; q < 2; ++q)
#pragma unroll
    for (int ks = 0; ks < 4; ++ks) xf[q][ks] = *(const bf16x8*)(xl + q * 2176 + fr * 136 + ks * 32 + fq * 8);
  const float4 dd = *(const float4*)(p.d_skip + g * 16 + fq * 4);
#pragma unroll
  for (int mi = 0; mi < 4; ++mi) {
    const int mt = w * 4 + mi;
    const bf16_t* wy = p.WY + ((size_t)(g * 16 + mt) * 12 * 64 + lane) * 8;
    f32x4 y[2]; y[0] = (f32x4){0.f, 0.f, 0.f, 0.f}; y[1] = y[0];
#pragma unroll
    for (int ks = 0; ks < 4; ++ks) { const bf16x8 a = *(const bf16x8*)(wy + ks * 512); y[0] = mfma16(a, xf[0][ks], y[0]); y[1] = mfma16(a, xf[1][ks], y[1]); }
#pragma unroll
    for (int ks = 0; ks < 8; ++ks) if (2 * ks <= mt) { const bf16x8 a = *(const bf16x8*)(wy + (4 + ks) * 512); y[0] = mfma16(a, uf[0][ks], y[0]); y[1] = mfma16(a, uf[1][ks], y[1]); }
#pragma unroll
    for (int q = 0; q < 2; ++q) {
      const size_t tok = (size_t)(b * SEQL + sp * 512 + q * 256 + fr * 16 + mt);
      const uint2 uu = *(const uint2*)(ug0 + (size_t)(q * 256 + fr * 16 + mt) * 16 + fq * 4);
      const float y0 = gelu_f(y[q][0] + dd.x * __uint_as_float(uu.x << 16)), y1 = gelu_f(y[q][1] + dd.y * __uint_as_float(uu.x & 0xffff0000u));
      const float y2 = gelu_f(y[q][2] + dd.z * __uint_as_float(uu.y << 16)), y3 = gelu_f(y[q][3] + dd.w * __uint_as_float(uu.y & 0xffff0000u));
      *(uint2*)(p.YG + tok * 512 + g * 16 + fq * 4) = make_uint2(pack2(y0, y1), pack2(y2, y3)); }
  }
}

__device__ __forceinline__ void tile_glu(const Params& p, int tile, char* lds) {
  const int rt = tile >> 2, ct = tile & 3; const int row0 = rt * 128, col0 = ct * 128;
  f32x4 acc[4][4];
  gemm_mainloop<true>(acc, p.YG, 512, p.WtGlu, 512, 512, row0, col0, lds);
  EPI_IDS
  const int cw = col0 + wc * 64;
#pragma unroll
  for (int m = 0; m < 4; ++m) {
    const int row = row0 + wr * 64 + m * 16 + fr; float ss = 0.f;
#pragma unroll
    for (int n = 0; n < 4; ++n) { const int c = cw + n * 16 + fq * 4; const float4 bg = *(const float4*)(p.b_glu + c); const uint2 yy = *(const uint2*)(p.YG + (size_t)row * 512 + c);
      const float y0 = __uint_as_float(yy.x << 16), y1 = __uint_as_float(yy.x & 0xffff0000u), y2 = __uint_as_float(yy.y << 16), y3 = __uint_as_float(yy.y & 0xffff0000u);
      const float o0 = y0 / (1.f + __expf(-(acc[m][n][0] + bg.x))), o1 = y1 / (1.f + __expf(-(acc[m][n][1] + bg.y))), o2 = y2 / (1.f + __expf(-(acc[m][n][2] + bg.z))), o3 = y3 / (1.f + __expf(-(acc[m][n][3] + bg.w)));
      ss += o0 * o0 + o1 * o1 + o2 * o2 + o3 * o3;
      *(uint2*)(p.SSMO + (size_t)row * 512 + c) = make_uint2(pack2(o0, o1), pack2(o2, o3)); }
    ss += __shfl_xor(ss, 16); ss += __shfl_xor(ss, 32);
    if (fq == 0) p.ss_ssm[row * 8 + (cw >> 6)] = ss;
  }
}
__device__ __forceinline__ void tile_wout(const Params& p, int tile, char* lds) {
  const int rt = tile >> 3, ct = tile & 7; const int row0 = rt * 128, col0 = ct * 128;
  f32x4 acc[4][4];
  float s1[4];
  gemm_mainloop<true>(acc, p.ATT, 512, p.WtOut, 1024, 512, row0, col0, lds);
  { const int lane_ = threadIdx.x & 63, w_ = threadIdx.x >> 6;
#pragma unroll
    for (int m = 0; m < 4; ++m) { const int row = row0 + (w_ >> 1) * 64 + m * 16 + (lane_ & 15); float a = 0.f, c = 0.f;
      { const float4* qa = (const float4*)(p.ss_att + (size_t)row * 8); const float4* qc = (const float4*)(p.ss_ssm + (size_t)row * 8); const float4 a0 = qa[0], a1 = qa[1], c0 = qc[0], c1 = qc[1];
        a = ((a0.x + a0.y) + (a0.z + a0.w)) + ((a1.x + a1.y) + (a1.z + a1.w)); c = ((c0.x + c0.y) + (c0.z + c0.w)) + ((c1.x + c1.y) + (c1.z + c1.w)); }
      const float ra = rsqrtf(a * (1.0f / 512.0f) + EPSF); s1[m] = rsqrtf(c * (1.0f / 512.0f) + EPSF); const float f = ra / s1[m];
#pragma unroll
      for (int n = 0; n < 4; ++n) acc[m][n] *= f; } }
  gemm_mainloop<false>(acc, p.SSMO, 512, p.WtOut + 512, 1024, 512, row0, col0, lds);
  EPI_IDS
  const int cw = col0 + wc * 64;
#pragma unroll
  for (int m = 0; m < 4; ++m) {
    const int row = row0 + wr * 64 + m * 16 + fr; float ss = 0.f;
#pragma unroll
    for (int n = 0; n < 4; ++n) { const int c = cw + n * 16 + fq * 4; const f32x4 xv = *(const f32x4*)(p.x + (size_t)row * 1024 + c); const f32x4 hv = xv + acc[m][n] * s1[m];
      ss += hv[0] * hv[0] + hv[1] * hv[1] + hv[2] * hv[2] + hv[3] * hv[3];
      *(uint2*)(p.H1B + (size_t)row * 1024 + c) = make_uint2(pack2(hv[0], hv[1]), pack2(hv[2], hv[3])); }
    ss += __shfl_xor(ss, 16); ss += __shfl_xor(ss, 32);
    if (fq == 0) p.ss_h1[row * 16 + (cw >> 6)] = ss;
  }
}
__device__ __forceinline__ float row_rs16(const float* ss, int row) {
  const float4* q = (const float4*)(ss + (size_t)row * 16); const float4 a = q[0], b = q[1], c = q[2], d = q[3];
  const float t = ((a.x + a.y) + (a.z + a.w)) + ((b.x + b.y) + (b.z + b.w)) + ((c.x + c.y) + (c.z + c.w)) + ((d.x + d.y) + (d.z + d.w));
  return rsqrtf(t * (1.0f / 1024.0f) + EPSF); }
__device__ __forceinline__ void tile_memq(const Params& p, int tile, char* lds) {
  const int rt = tile >> 3, ct = tile & 7; const int row0 = rt * 128, col0 = ct * 128;
  f32x4 acc[4][4];
  gemm_mainloop<true>(acc, p.H1B, 1024, p.WtMq, 1024, 1024, row0, col0, lds);
  EPI_IDS
  const int cw = col0 + wc * 64;
#pragma unroll
  for (int m = 0; m < 4; ++m) {
    const int row = row0 + wr * 64 + m * 16 + fr; const float rs = row_rs16(p.ss_h1, row); float ss = 0.f;
#pragma unroll
    for (int n = 0; n < 4; ++n) { const int c = cw + n * 16 + fq * 4; const f32x4 v = acc[m][n] * rs; ss += v[0] * v[0] + v[1] * v[1] + v[2] * v[2] + v[3] * v[3];
      *(uint2*)(p.QM + (size_t)row * 1024 + c) = make_uint2(pack2(v[0], v[1]), pack2(v[2], v[3])); }
    ss += __shfl_xor(ss, 16); ss += __shfl_xor(ss, 32);
    if (fq == 0) p.ss_qm[row * 16 + (cw >> 6)] = ss;
  }
}
__device__ __forceinline__ void mem_stage(const bf16_t* kg, const bf16_t* vg, int kc, LAS char* buf, int w, int lane) {
  const int wb = __builtin_amdgcn_readfirstlane(w) * 4096;
#pragma unroll
  for (int i = 0; i < 4; ++i) {
    const int row = w * 8 + i * 2 + (lane >> 5), pos = lane & 31; const int ch = pos ^ (row & 15);
    __builtin_amdgcn_global_load_lds((const GAS void*)(kg + (size_t)(kc * 32 + row) * 256 + ch * 8), (LAS void*)(buf + wb + i * 1024), 16, 0, 0);
  }
#pragma unroll
  for (int i = 0; i < 4; ++i) {
    const int d = w * 64 + i * 16 + (lane >> 2), pos = lane & 3; const int ch = pos ^ ((d >> 2) & 3);
    __builtin_amdgcn_global_load_lds((const GAS void*)(vg + (size_t)d * 256 + kc * 32 + ch * 8), (LAS void*)(buf + 16384 + wb + i * 1024), 16, 0, 0);
  }
}
__device__ __forceinline__ void mem_attn_item(const Params& p, int item, char* lds_) {
  LAS char* lds = (LAS char*)lds_;
  typedef unsigned u32x2 __attribute__((ext_vector_type(2)));
  const int h = item & 3, tt = item >> 2; const int tid = threadIdx.x, lane = tid & 63, w = tid >> 6, fr = lane & 15, fq = lane >> 4;
  const int tq = tt * 64 + w * 16 + fr; const int b = tq >> 13;
  const bf16_t* kg = p.KMB + (size_t)(b * 4 + h) * 256 * 256;
  const bf16_t* vg = p.VMT + (size_t)(b * 4 + h) * 256 * 256;
  __syncthreads();
  mem_stage(kg, vg, 0, lds, w, lane);
  const float ssq = p.ss_qm[tq * 16 + h * 4] + p.ss_qm[tq * 16 + h * 4 + 1] + p.ss_qm[tq * 16 + h * 4 + 2] + p.ss_qm[tq * 16 + h * 4 + 3];
  const float rowscale = rsqrtf(ssq * (1.0f / 256.0f) + EPSF) * 0.0625f * 1.44269504f;
  const float shf = p.SHF[8];
  bf16x8 qf[8];
#pragma unroll
  for (int ks = 0; ks < 8; ++ks) qf[ks] = *(const bf16x8*)(p.QM + (size_t)tq * 1024 + h * 256 + ks * 32 + fq * 8);
  f32x4 o[16];
#pragma unroll
  for (int i = 0; i < 16; ++i) o[i] = (f32x4){0.f, 0.f, 0.f, 0.f};
  float lrun = 0.f;
  asm volatile("s_waitcnt vmcnt(0)" ::: "memory");
  __syncthreads();
  for (int kc = 0; kc < 8; ++kc) {
    LAS char* cur = lds + (kc & 1) * 32768; LAS char* nxt = lds + ((kc + 1) & 1) * 32768;
    if (kc + 1 < 8) mem_stage(kg, vg, kc + 1, nxt, w, lane);
    f32x4 st[2];
#pragma unroll
    for (int mt = 0; mt < 2; ++mt) { f32x4 sacc = (f32x4){0.f, 0.f, 0.f, 0.f}; const int row = mt * 16 + fr;
#pragma unroll
      for (int ks = 0; ks < 8; ++ks) sacc = mfma16(as_bf(*(const LAS u32x4*)(cur + row * 512 + (((ks * 4 + fq) ^ (row & 15)) << 4))), qf[ks], sacc);
      st[mt] = sacc * rowscale - shf; }
    float ls = 0.f;
#pragma unroll
    for (int mt = 0; mt < 2; ++mt)
#pragma unroll
      for (int j = 0; j < 4; ++j) { const float e = __builtin_amdgcn_exp2f(st[mt][j]); st[mt][j] = e; ls += e; }
    lrun += ls;
    u32x4 t; t.x = pack2(st[0][0], st[0][1]); t.y = pack2(st[0][2], st[0][3]); t.z = pack2(st[1][0], st[1][1]); t.w = pack2(st[1][2], st[1][3]);
    const bf16x8 pf = as_bf(t);
#pragma unroll
    for (int dt = 0; dt < 16; ++dt) { const int d = dt * 16 + fr; const int sw = ((d >> 2) & 3) << 1;
      const u32x2 lo = *(const LAS u32x2*)(cur + 16384 + d * 64 + ((fq ^ sw) << 3)), hi = *(const LAS u32x2*)(cur + 16384 + d * 64 + (((fq + 4) ^ sw) << 3));
      u32x4 vv; vv.x = lo.x; vv.y = lo.y; vv.z = hi.x; vv.w = hi.y; o[dt] = mfma16(as_bf(vv), pf, o[dt]); }
    asm volatile("s_waitcnt vmcnt(0)" ::: "memory");
    __syncthreads();
  }
  float lt = lrun; lt += __shfl_xor(lt, 16); lt += __shfl_xor(lt, 32);
  const float inv = 1.0f / lt;
  bf16_t* dst = p.OM + (size_t)tq * 1024 + h * 256;
#pragma unroll
  for (int dt = 0; dt < 16; ++dt) { const f32x4 v = o[dt] * inv; *(uint2*)(dst + dt * 16 + fq * 4) = make_uint2(pack2(v[0], v[1]), pack2(v[2], v[3])); }
}
__device__ __forceinline__ void tile_memo(const Params& p, int tile, char* lds) {
  const int rt = tile >> 3, ct = tile & 7; const int row0 = rt * 128, col0 = ct * 128;
  f32x4 acc[4][4];
  gemm_mainloop<true>(acc, p.OM, 1024, p.WtMo, 1024, 1024, row0, col0, lds);
  EPI_IDS
  const int cw = col0 + wc * 64;
#pragma unroll
  for (int m = 0; m < 4; ++m) {
    const int row = row0 + wr * 64 + m * 16 + fr; float ss = 0.f;
#pragma unroll
    for (int n = 0; n < 4; ++n) { const int c = cw + n * 16 + fq * 4; const uint2 hb = *(const uint2*)(p.H1B + (size_t)row * 1024 + c);
      const f32x4 hv = (f32x4){__uint_as_float(hb.x << 16), __uint_as_float(hb.x & 0xffff0000u), __uint_as_float(hb.y << 16), __uint_as_float(hb.y & 0xffff0000u)} + acc[m][n];
      ss += hv[0] * hv[0] + hv[1] * hv[1] + hv[2] * hv[2] + hv[3] * hv[3];
      *(uint2*)(p.H2B + (size_t)row * 1024 + c) = make_uint2(pack2(hv[0], hv[1]), pack2(hv[2], hv[3])); }
    ss += __shfl_xor(ss, 16); ss += __shfl_xor(ss, 32);
    if (fq == 0) p.ss_h2[row * 16 + (cw >> 6)] = ss;
  }
}
__device__ __forceinline__ void ce_desc(float& x, float& y) { const float hi = fmaxf(x, y), lo = fminf(x, y); x = hi; y = lo; }
__device__ __forceinline__ void sort16_desc(float (&a)[16]) {
#pragma unroll
  for (int k = 2; k <= 16; k <<= 1)
#pragma unroll
    for (int j = k >> 1; j > 0; j >>= 1)
#pragma unroll
      for (int i = 0; i < 16; ++i) { const int l = i ^ j; if (l > i) { if ((i & k) == 0) ce_desc(a[i], a[l]); else ce_desc(a[l], a[i]); } }
}
__device__ __forceinline__ void merge16_desc(float (&a)[16], const float (&b)[16]) {
#pragma unroll
  for (int i = 0; i < 16; ++i) a[i] = fmaxf(a[i], b[15 - i]);
#pragma unroll
  for (int j = 8; j > 0; j >>= 1)
#pragma unroll
    for (int i = 0; i < 16; ++i) { const int l = i ^ j; if (l > i) ce_desc(a[i], a[l]); }
}
__device__ __forceinline__ void ins16(float (&a)[16], float v) {
#pragma unroll
  for (int i = 0; i < 16; ++i) { const float hi = fmaxf(a[i], v), lo = fminf(a[i], v); a[i] = hi; v = lo; }
}
__device__ __forceinline__ void tile_peer(const Params& p, int tile, char* lds_) {
  const int rt = tile >> 4, hs = tile & 15; const int row0 = rt * 128, col0 = hs * 128;
  f32x4 acc[4][4];
  gemm_mainloop<true>(acc, p.H2B, 1024, p.WtPq, 1024, 1024, row0, col0, lds_);
  LAS char* lds = (LAS char*)lds_;
  EPI_IDS
  { const int lr = lane >> 3, lc = (lane & 7) ^ lr; const int wbase = __builtin_amdgcn_readfirstlane(w) * 4096;
    const bf16_t* gK = p.PK + (size_t)hs * 128 * 128 + (size_t)(w * 32 + lr) * 128 + lc * 8;
#pragma unroll
    for (int i = 0; i < 4; ++i) {
      __builtin_amdgcn_global_load_lds((const GAS void*)(gK + (size_t)(i * 8) * 128), (LAS void*)(lds + 16384 + wbase + i * 1024), 16, 0, 0);
      __builtin_amdgcn_global_load_lds((const GAS void*)(gK + (size_t)(i * 8) * 128 + 64), (LAS void*)(lds + 32768 + 16384 + wbase + i * 1024), 16, 0, 0);
    } }
  typedef unsigned u32x2 __attribute__((ext_vector_type(2)));
#pragma unroll
  for (int m = 0; m < 4; ++m) { const int r = wr * 64 + m * 16 + fr; const float rs = row_rs16(p.ss_h2, row0 + r);
#pragma unroll
    for (int n = 0; n < 4; ++n) { const f32x4 v = acc[m][n] * rs; u32x2 pk; pk.x = pack2(v[0], v[1]); pk.y = pack2(v[2], v[3]);
      *(LAS u32x2*)(lds + wc * 32768 + r * 128 + (((n * 2 + (fq >> 1)) ^ (r & 7)) << 4) + (fq & 1) * 8) = pk; } }
  asm volatile("s_waitcnt vmcnt(0)" ::: "memory");
  __syncthreads();
#pragma unroll
  for (int m = 0; m < 4; ++m)
#pragma unroll
    for (int n = 0; n < 4; ++n) acc[m][n] = (f32x4){0.f, 0.f, 0.f, 0.f};
#pragma unroll
  for (int kt = 0; kt < 2; ++kt) { LAS char* cur = lds + kt * 32768;
#pragma unroll
    for (int ks = 0; ks < 2; ++ks) { bf16x8 af[4], bfr[4]; const int kc = ks * 4 + fq;
#pragma unroll
      for (int m = 0; m < 4; ++m) { const int r = wr * 64 + m * 16 + fr; af[m] = as_bf(*(const LAS u32x4*)(cur + r * 128 + ((kc ^ (r & 7)) << 4))); }
#pragma unroll
      for (int n = 0; n < 4; ++n) { const int r = wc * 64 + n * 16 + fr; bfr[n] = as_bf(*(const LAS u32x4*)(cur + 16384 + r * 128 + ((kc ^ (r & 7)) << 4))); }
#pragma unroll
      for (int m = 0; m < 4; ++m)
#pragma unroll
        for (int n = 0; n < 4; ++n) acc[m][n] = mfma16(bfr[n], af[m], acc[m][n]);
    } }
  __syncthreads();
  LAS float* L = (LAS float*)lds;
#pragma unroll
  for (int m = 0; m < 4; ++m) {
    float a[16], b[16];
#pragma unroll
    for (int n = 0; n < 4; ++n)
#pragma unroll
      for (int j = 0; j < 4; ++j) a[n * 4 + j] = __uint_as_float((__float_as_uint(acc[m][n][j]) & ~127u) | (unsigned)(wc * 64 + n * 16 + fq * 4 + j));
    sort16_desc(a);
#pragma unroll
    for (int i = 0; i < 16; ++i) b[i] = __shfl_xor(a[i], 16);
    merge16_desc(a, b);
#pragma unroll
    for (int i = 0; i < 16; ++i) b[i] = __shfl_xor(a[i], 32);
    merge16_desc(a, b);
    const int r = wr * 64 + m * 16 + fr;
    f32x4 o; o[0] = fq == 0 ? a[0] : fq == 1 ? a[4] : fq == 2 ? a[8] : a[12]; o[1] = fq == 0 ? a[1] : fq == 1 ? a[5] : fq == 2 ? a[9] : a[13];
    o[2] = fq == 0 ? a[2] : fq == 1 ? a[6] : fq == 2 ? a[10] : a[14]; o[3] = fq == 0 ? a[3] : fq == 1 ? a[7] : fq == 2 ? a[11] : a[15];
    *(LAS f32x4*)(L + (r * 2 + wc) * 16 + fq * 4) = o;
  }
  __syncthreads();
#pragma unroll
  for (int mi = 0; mi < 2; ++mi) { const int m = wc * 2 + mi; const int r = wr * 64 + m * 16 + fr;
    float a[16], b[16];
#pragma unroll
    for (int q = 0; q < 4; ++q) { const f32x4 va = *(const LAS f32x4*)(L + (r * 2 + 0) * 16 + q * 4), vb = *(const LAS f32x4*)(L + (r * 2 + 1) * 16 + q * 4);
      a[q * 4] = va[0]; a[q * 4 + 1] = va[1]; a[q * 4 + 2] = va[2]; a[q * 4 + 3] = va[3]; b[q * 4] = vb[0]; b[q * 4 + 1] = vb[1]; b[q * 4 + 2] = vb[2]; b[q * 4 + 3] = vb[3]; }
    merge16_desc(a, b);
    u32x4 o; o.x = __float_as_uint(fq == 0 ? a[0] : fq == 1 ? a[4] : fq == 2 ? a[8] : a[12]); o.y = __float_as_uint(fq == 0 ? a[1] : fq == 1 ? a[5] : fq == 2 ? a[9] : a[13]);
    o.z = __float_as_uint(fq == 0 ? a[2] : fq == 1 ? a[6] : fq == 2 ? a[10] : a[14]); o.w = __float_as_uint(fq == 0 ? a[3] : fq == 1 ? a[7] : fq == 2 ? a[11] : a[15]);
    *(u32x4*)(p.TOPS + ((size_t)(row0 + r) * 16 + hs) * 16 + fq * 4) = o;
  }
}
__device__ __forceinline__ void peer_gather_item(const Params& p, int item, char* lds_) {
  LAS char* lds = (LAS char*)lds_;
  const int tid = threadIdx.x, lane = tid & 63, w = tid >> 6;
  LAS unsigned* LA = (LAS unsigned*)lds;
  LAS int* LE = (LAS int*)(lds + 256 * 33 * 4);
  LAS float* LG = (LAS float*)(lds + 256 * 33 * 4 + 32 * 128 * 4);
  __syncthreads();
  {
    const int tl_ = tid >> 3, h = tid & 7; const int t = item * 32 + tl_;
    const uint4* src = (const uint4*)(p.TOPS + ((size_t)t * 16 + h * 2) * 16);
    float a[16], bq[16];
#pragma unroll
    for (int i = 0; i < 4; ++i) { const uint4 v = src[i]; a[4 * i] = __uint_as_float(v.x); a[4 * i + 1] = __uint_as_float(v.y); a[4 * i + 2] = __uint_as_float(v.z); a[4 * i + 3] = __uint_as_float(v.w); }
#pragma unroll
    for (int i = 0; i < 4; ++i) { const uint4 v = src[4 + i]; bq[4 * i] = __uint_as_float(v.x); bq[4 * i + 1] = __uint_as_float(v.y); bq[4 * i + 2] = __uint_as_float(v.z); bq[4 * i + 3] = __uint_as_float(v.w); }
#pragma unroll
    for (int i = 0; i < 16; ++i) { LA[tid * 33 + i] = __float_as_uint(a[i]); LA[tid * 33 + 16 + i] = __float_as_uint(bq[i]); }
    float c[16];
#pragma unroll
    for (int i = 0; i < 16; ++i) c[i] = -__builtin_inff();
#pragma unroll
    for (int i = 0; i < 16; ++i)
#pragma unroll
      for (int j = 0; j < 16; ++j) if ((i + 1) * (j + 1) <= 16) { const float s = a[i] + bq[j]; ins16(c, __uint_as_float((__float_as_uint(s) & ~255u) | (unsigned)(i * 16 + j))); }
    const float mx = c[0]; float e[16]; float sum = 0.f;
#pragma unroll
    for (int i = 0; i < 16; ++i) { e[i] = __expf(c[i] - mx); sum += e[i]; }
    const float inv = 1.0f / sum;
#pragma unroll
    for (int i = 0; i < 16; ++i) { const unsigned pos = __float_as_uint(c[i]) & 255u; const unsigned ia = LA[tid * 33 + (pos >> 4)] & 127u, ib = LA[tid * 33 + 16 + (pos & 15u)] & 127u;
      LE[tl_ * 128 + h * 16 + i] = (int)(ia * 128u + ib); LG[tl_ * 128 + h * 16 + i] = e[i] * inv; }
  }
  __syncthreads();
  LAS char* HQ = (LAS char*)LA;
  const int fr = lane & 15, fq = lane >> 4;
  for (int ti = 0; ti < 8; ++ti) {
    const int tl_ = w * 8 + ti; const int t = item * 32 + tl_;
    const float rs = row_rs16(p.ss_h2, t) * 16.0f;
    { const uint4 ha = *(const uint4*)(p.H2B + (size_t)t * 1024 + lane * 16), hb = *(const uint4*)(p.H2B + (size_t)t * 1024 + lane * 16 + 8);
      const unsigned hw[8] = {ha.x, ha.y, ha.z, ha.w, hb.x, hb.y, hb.z, hb.w}; u32x4 q;
#pragma unroll
      for (int i = 0; i < 4; ++i) { const float4 g = *(const float4*)(p.norm_peer_g + lane * 16 + 4 * i); int wd = 0;
        wd = __builtin_amdgcn_cvt_pk_fp8_f32(__uint_as_float(hw[2 * i] << 16) * rs * g.x, __uint_as_float(hw[2 * i] & 0xffff0000u) * rs * g.y, wd, false);
        wd = __builtin_amdgcn_cvt_pk_fp8_f32(__uint_as_float(hw[2 * i + 1] << 16) * rs * g.z, __uint_as_float(hw[2 * i + 1] & 0xffff0000u) * rs * g.w, wd, true); q[i] = (unsigned)wd; }
      *(LAS u32x4*)(HQ + tl_ * 1024 + lane * 16) = q; }
    f32x2 oa[8];
#pragma unroll
    for (int i = 0; i < 8; ++i) oa[i] = (f32x2){0.f, 0.f};
    typedef int i32x8 __attribute__((ext_vector_type(8)));
    typedef unsigned u32x2 __attribute__((ext_vector_type(2)));
    int er0, er1; u32x4 uq0[8], uq1[8]; u32x2 vqa0[8], vqb0[8], vqa1[8], vqb1[8]; float g40[4], su40[4], sv40[4], g41[4], su41[4], sv41[4];
#define PEER_LOADSET(S, BT) { const LAS int* LEb = LE + tl_ * 128 + (BT) * 16; const LAS float* LGb = LG + tl_ * 128 + (BT) * 16; er##S = LEb[fr]; \
      const unsigned char* ub = p.PU8 + (size_t)er##S * 512 + fq * 16; \
      _Pragma("unroll") for (int ks = 0; ks < 8; ++ks) uq##S[ks] = *(const u32x4*)(ub + ks * 64); \
      _Pragma("unroll") for (int x = 0; x < 8; ++x) { const int ex = __builtin_amdgcn_readlane(er##S, x); vqa##S[x] = *(const u32x2*)(p.PV8 + (size_t)ex * 512 + lane * 8); } \
      _Pragma("unroll") for (int x = 0; x < 8; ++x) { const int ex = __builtin_amdgcn_readlane(er##S, 8 + x); vqb##S[x] = *(const u32x2*)(p.PV8 + (size_t)ex * 512 + lane * 8); } \
      _Pragma("unroll") for (int j = 0; j < 4; ++j) { const int e4 = LEb[fq * 4 + j]; g4##S[j] = LGb[fq * 4 + j]; su4##S[j] = p.su[e4]; sv4##S[j] = p.sv[e4]; } }
#define PEER_V(VQ, X0) { _Pragma("unroll") for (int x = 0; x < 8; ++x) { const float wgt = __int_as_float(__builtin_amdgcn_readlane(__float_as_int(wg[((X0) + x) & 3]), (((X0) + x) >> 2) * 16)); \
        oa[0] += __builtin_amdgcn_cvt_scalef32_pk_f32_fp4(VQ[x].x, 1.0f, 0) * wgt; oa[1] += __builtin_amdgcn_cvt_scalef32_pk_f32_fp4(VQ[x].x, 1.0f, 1) * wgt; \
        oa[2] += __builtin_amdgcn_cvt_scalef32_pk_f32_fp4(VQ[x].x, 1.0f, 2) * wgt; oa[3] += __builtin_amdgcn_cvt_scalef32_pk_f32_fp4(VQ[x].x, 1.0f, 3) * wgt; \
        oa[4] += __builtin_amdgcn_cvt_scalef32_pk_f32_fp4(VQ[x].y, 1.0f, 0) * wgt; oa[5] += __builtin_amdgcn_cvt_scalef32_pk_f32_fp4(VQ[x].y, 1.0f, 1) * wgt; \
        oa[6] += __builtin_amdgcn_cvt_scalef32_pk_f32_fp4(VQ[x].y, 1.0f, 2) * wgt; oa[7] += __builtin_amdgcn_cvt_scalef32_pk_f32_fp4(VQ[x].y, 1.0f, 3) * wgt; } }
#define PEER_COMPUTE(S) { f32x4 acc = (f32x4){0.f, 0.f, 0.f, 0.f}; \
      _Pragma("unroll") for (int ks = 0; ks < 8; ++ks) { const u32x4 h0 = *(const LAS u32x4*)(HQ + tl_ * 1024 + ks * 128 + fq * 16), h1 = *(const LAS u32x4*)(HQ + tl_ * 1024 + ks * 128 + 64 + fq * 16); \
        i32x8 A, B; A[0] = (int)uq##S[ks].x; A[1] = (int)uq##S[ks].y; A[2] = (int)uq##S[ks].z; A[3] = (int)uq##S[ks].w; A[4] = 0; A[5] = 0; A[6] = 0; A[7] = 0; \
        B[0] = (int)h0.x; B[1] = (int)h0.y; B[2] = (int)h0.z; B[3] = (int)h0.w; B[4] = (int)h1.x; B[5] = (int)h1.y; B[6] = (int)h1.z; B[7] = (int)h1.w; \
        acc = __builtin_amdgcn_mfma_scale_f32_16x16x128_f8f6f4(A, B, acc, 4, 0, 0, 0x7f7f7f7f, 0, 0x7f7f7f7f); } \
      float wg[4]; \
      _Pragma("unroll") for (int j = 0; j < 4; ++j) wg[j] = g4##S[j] * gelu_f(acc[j] * su4##S[j] * 0.0625f) * sv4##S[j]; \
      PEER_V(vqa##S, 0) PEER_V(vqb##S, 8) }
    PEER_LOADSET(0, 0)
    for (int bt = 0; bt < 8; bt += 2) {
      PEER_LOADSET(1, bt + 1)
      __builtin_amdgcn_sched_barrier(0);
      PEER_COMPUTE(0)
      __builtin_amdgcn_sched_barrier(0);
      if (bt + 2 < 8) PEER_LOADSET(0, bt + 2)
      __builtin_amdgcn_sched_barrier(0);
      PEER_COMPUTE(1)
      __builtin_amdgcn_sched_barrier(0);
    }
    { const uint4 ha = *(const uint4*)(p.H2B + (size_t)t * 1024 + lane * 16), hb = *(const uint4*)(p.H2B + (size_t)t * 1024 + lane * 16 + 8);
      const unsigned hw[8] = {ha.x, ha.y, ha.z, ha.w, hb.x, hb.y, hb.z, hb.w};
      float* op = p.out + (size_t)t * 1024 + lane * 16;
#pragma unroll
      for (int i = 0; i < 4; ++i) { const f32x2 a = oa[2 * i], b = oa[2 * i + 1];
        *(float4*)(op + 4 * i) = make_float4(__uint_as_float(hw[2 * i] << 16) + a.x, __uint_as_float(hw[2 * i] & 0xffff0000u) + a.y, __uint_as_float(hw[2 * i + 1] << 16) + b.x, __uint_as_float(hw[2 * i + 1] & 0xffff0000u) + b.y); } }
  }
}

#define XCD_TILES(NCT, CALL) do { if ((nb & 7) == 0 && nb >= 8) { const int xcd_ = bid & 7, lb_ = bid >> 3, nlb_ = nb >> 3; \
    for (int i_ = lb_; i_ < 16 * (NCT); i_ += nlb_) { const int t = (xcd_ * 16 + i_ / (NCT)) * (NCT) + (i_ % (NCT)); CALL; } } \
  else { for (int t = bid; t < 128 * (NCT); t += nb) { CALL; } } } while (0)
template <int PH>
__device__ __forceinline__ void run_phase(const Params& p, char* lds, int bid, int nb) {
  if (PH == 0) {
    const int nt_in = 16 * 32, nt_glu = 8 * 8, nt_out = 16 * 16, nt_m = 16 * 16, nt_pq = 16 * 32;
    const int total = nt_in + nt_glu + nt_out + 4 * nt_m + nt_pq;
    for (int t = bid; t < total; t += nb) {
      int i = t; float* tl = (float*)lds;
      if (i < nt_in) { transpose_tile(p.w_in, p.WtIn, 1024, 2048, i, p.norm_mix_g, p.norm_mix_g, 1024, tl); continue; } i -= nt_in;
      if (i < nt_glu) { transpose_tile(p.w_glu, p.WtGlu, 512, 512, i, nullptr, nullptr, 0, tl); continue; } i -= nt_glu;
      if (i < nt_out) { transpose_tile(p.w_out, p.WtOut, 1024, 1024, i, p.att_out_g, p.ssm_out_g, 512, tl); continue; } i -= nt_out;
      if (i < nt_m) { transpose_tile(p.w_mem_q, p.WtMq, 1024, 1024, i, p.norm_mem_g, p.norm_mem_g, 1024, tl); continue; } i -= nt_m;
      if (i < nt_m) { transpose_tile(p.w_mem_k, p.WtMk, 1024, 1024, i, p.norm_memkv_g, p.norm_memkv_g, 1024, tl); continue; } i -= nt_m;
      if (i < nt_m) { transpose_tile(p.w_mem_v, p.WtMv, 1024, 1024, i, p.norm_memkv_g, p.norm_memkv_g, 1024, tl); continue; } i -= nt_m;
      if (i < nt_m) { transpose_tile(p.w_mem_o, p.WtMo, 1024, 1024, i, nullptr, nullptr, 0, tl); continue; } i -= nt_m;
      transpose_tile(p.w_peer_q, p.WtPq, 1024, 2048, i, p.norm_peer_g, p.norm_peer_g, 1024, tl);
    }
    convert_flat(p.peer_keys, p.PK, (size_t)16 * 128 * 128 / 8, bid, nb);
    rows_bf16_rs(p.x, p.XB, p.rs_x, T_TOK, bid, nb);
    rows_bf16_rs(p.mem, p.MEMB, p.rs_mem, 512, bid, nb);
    for (int i = bid * NTHREADS + threadIdx.x; i < 2048; i += nb * NTHREADS) ssm_stage1(p, i);
    if (bid == nb - 1 && threadIdx.x < 9) {
      const int hh = threadIdx.x; float sh;
      if (hh < 8) { float mb = -1e30f, gq = 0.f, gk = 0.f; for (int i = 0; i < 192; ++i) mb = fmaxf(mb, p.rel_bias[hh * 192 + i]);
        for (int i = 0; i < 64; ++i) { gq = fmaxf(gq, fabsf(p.att_q_g[i])); gk = fmaxf(gk, fabsf(p.att_k_g[i])); }
        sh = (mb + 8.0f * gq * gk * 1.02f) * 1.44269504f; }
      else { float g = 0.f; for (int i = 0; i < 256; ++i) g = fmaxf(g, fabsf(p.mem_q_g[i] * p.mem_k_g[i])); sh = 16.0f * g * 1.02f * 1.44269504f; }
      p.SHF[hh] = sh; }
  } else if (PH == 1) {
    XCD_TILES(16, { if (((t & 15) >> 2) == 2) tile_win_v(p, t, lds); else tile_win(p, t, lds); });
    ssm_stage2a(p, bid, nb);
  } else if (PH == 2) {
    for (int t = nb - 1 - bid; t < 64; t += nb) tile_memkv(p, t, lds);
    chunk_attn_prep(p, lds);
    if ((nb & 7) == 0 && nb >= 8) { const int xcd_ = bid & 7, lb_ = bid >> 3, nlb_ = nb >> 3;
      for (int i_ = lb_; i_ < 64; i_ += nlb_) chunk_attn_item(p, i_ * 8 + xcd_, lds); }
    else { for (int t = bid; t < 512; t += nb) chunk_attn_item(p, t, lds); }
    for (int t = bid; t < 2048; t += nb) ssm_item<false>(p, t, lds);
    rows_fp4<false>(p.peer_u, p.PU8, p.su, 16384, bid, nb);
    ssm_stage2b(p, bid, nb);
  } else if (PH == 3) {
    memk_fix(p, bid, nb);
    rows_fp4<false>(p.peer_v, p.PV8, p.sv, 16384, bid, nb);
    for (int t = bid; t < 1024; t += nb) ssm_final_pair(p, t, lds);
  } else if (PH == 4) {
    XCD_TILES(4, tile_glu(p, t, lds));
  } else if (PH == 5) {
    XCD_TILES(8, tile_wout(p, t, lds));
  } else if (PH == 6) {
    XCD_TILES(8, tile_memq(p, t, lds));
  } else if (PH == 7) {
    for (int t = bid; t < 1024; t += nb) mem_attn_item(p, t, lds);
  } else if (PH == 8) {
    XCD_TILES(8, tile_memo(p, t, lds));
  } else if (PH == 9) {
    XCD_TILES(16, tile_peer(p, t, lds));
  } else if (PH == 11) {
    for (int t = bid; t < 512; t += nb) peer_gather_item(p, t, lds);
  }
}

#if !MEGA
template <int PH>
__global__ void __launch_bounds__(NTHREADS, 2) phase_kernel(Params p) {
  extern __shared__ __attribute__((aligned(16))) char lds[];
  run_phase<PH>(p, lds, blockIdx.x, gridDim.x);
}

#endif
#ifndef REPEAT_PH
#define REPEAT_PH -1
#endif
#define RUNPH(k) do { run_phase<k>(p, lds, bid, nb); if (REPEAT_PH == k) { xcd_barrier(xb); run_phase<k>(p, lds, bid, nb); } } while (0)
__global__ void __launch_bounds__(NTHREADS, 2) mega_kernel(Params p) {
  extern __shared__ __attribute__((aligned(16))) char lds[];
  const int bid = blockIdx.x, nb = gridDim.x;
  volatile LAS unsigned* stw = (volatile LAS unsigned*)((LAS char*)lds + LDS_WORK);
  if (threadIdx.x == 0) { stw[0] = 0u; stw[1] = 0u; stw[2] = 0u; stw[3] = 0u; }
  __syncthreads();
  XcdBarrier xb = xcd_barrier_post(p.bar, stw);
  RUNPH(0); xcd_barrier(xb);
  RUNPH(1); xcd_barrier(xb);
  RUNPH(2); xcd_barrier(xb);
  RUNPH(3); xcd_barrier(xb);
  RUNPH(4); xcd_barrier(xb);
  RUNPH(5); xcd_barrier(xb);
  RUNPH(6); xcd_barrier(xb);
  RUNPH(7); xcd_barrier(xb);
  RUNPH(8); xcd_barrier(xb);
  RUNPH(9); xcd_barrier(xb);
  RUNPH(11);
}

#if !MEGA
template <int PH> static void launch_phase(const Params& p, int grid, hipStream_t s) {
  hipFuncSetAttribute((const void*)phase_kernel<PH>, hipFuncAttributeMaxDynamicSharedMemorySize, LDS_BYTES);
  phase_kernel<PH><<<grid, NTHREADS, LDS_BYTES, s>>>(p);
}
#endif

extern "C" void kernel_launch(void* const* d_in, const int* in_sizes, int n_in, void* d_out, int out_size, void* d_ws, size_t ws_size, hipStream_t stream) {
  Params p{};
  const float** f = (const float**)&p;
  for (int i = 0; i < 33; ++i) f[i] = (const float*)d_in[i];
  p.out = (float*)d_out;
  char* ws = (char*)d_ws; size_t off = 0;
  auto take = [&](size_t bytes) { char* r = ws + off; off += (bytes + 255) & ~(size_t)255; return r; };
  const size_t MB = 1u << 20;
  p.bar = (unsigned*)take(16384);
  p.WtIn = (bf16_t*)take(4 * MB); p.WtGlu = (bf16_t*)take(MB / 2); p.WtOut = (bf16_t*)take(2 * MB);
  p.WtMq = (bf16_t*)take(2 * MB); p.WtMk = (bf16_t*)take(2 * MB); p.WtMv = (bf16_t*)take(2 * MB); p.WtMo = (bf16_t*)take(2 * MB); p.WtPq = (bf16_t*)take(4 * MB);
  p.PK = (bf16_t*)take(MB / 2); p.PU8 = (unsigned char*)take(8 * MB); p.PV8 = (unsigned char*)take(8 * MB); p.su = (float*)take(16384 * 4); p.sv = (float*)take(16384 * 4);
  char* RA = take(64 * MB); char* RB = take(64 * MB);
  p.XB = (bf16_t*)RA; p.ATT = (bf16_t*)RA; p.YG = (bf16_t*)(RA + 16 * MB); p.QM = (bf16_t*)RA; p.H2B = (bf16_t*)RA;
  p.SSMO = (bf16_t*)(RA + 32 * MB); p.OM = (bf16_t*)(RA + 32 * MB);
  p.Qb = (bf16_t*)RB; p.Kb = (bf16_t*)(RB + 16 * MB); p.VT = (bf16_t*)(RB + 32 * MB); p.Ub = (bf16_t*)(RB + 48 * MB); p.H1B = (bf16_t*)RB; p.QP = (bf16_t*)RB;
  p.TOPS = (unsigned*)take(16 * MB);
  p.MEMB = (bf16_t*)take(MB); p.KMB = (bf16_t*)take(MB); p.VMT = (bf16_t*)take(MB); p.KMraw = (float*)take(2 * MB);
  p.WE16 = (bf16_t*)take(2 * MB); p.WY = (bf16_t*)take(6 * MB);
  p.rs_x = (float*)take(T_TOK * 4); p.rs_mem = (float*)take(512 * 4); p.ss_att = (float*)take(T_TOK * 8 * 4); p.ss_ssm = (float*)take(T_TOK * 8 * 4);
  p.ss_h1 = (float*)take(T_TOK * 16 * 4); p.ss_qm = (float*)take(T_TOK * 16 * 4); p.ss_km = (float*)take(512 * 16 * 4); p.ss_h2 = (float*)take(T_TOK * 16 * 4);
  p.ESEG = (float*)take(2 * 32 * 32 * 128 * 4);
  p.BBR = (float*)take(2048 * 16 * 4); p.BBI = (float*)take(2048 * 16 * 4); p.PWR = (float*)take(32 * 17 * 64 * 4); p.PWI = (float*)take(32 * 17 * 64 * 4); p.KJ = (float*)take(32 * 16 * 256 * 4); p.SHF = (float*)take(256); p.APW = (float*)take(5 * 4096 * 4);
  if (off > ws_size) { fprintf(stderr, "workspace too small: need %zu have %zu\n", off, ws_size); return; }
#if MEGA
  hipMemsetAsync(p.bar, 0, 16384, stream);
  static int grid_blocks = 0;
  if (!grid_blocks) {
    int dev = 0, cus = 0, per_cu = 0; hipGetDevice(&dev); hipDeviceGetAttribute(&cus, hipDeviceAttributeMultiprocessorCount, dev);
    hipFuncSetAttribute((const void*)mega_kernel, hipFuncAttributeMaxDynamicSharedMemorySize, LDS_BYTES);
    hipOccupancyMaxActiveBlocksPerMultiprocessor(&per_cu, mega_kernel, NTHREADS, LDS_BYTES);
    if (per_cu > 2) per_cu = 2; if (per_cu < 1) per_cu = 1;
    grid_blocks = cus * per_cu;
  }
  void* args[] = {&p};
  hipError_t e = hipLaunchCooperativeKernel((void*)mega_kernel, dim3(grid_blocks), dim3(NTHREADS), args, LDS_BYTES, stream);
  if (e != hipSuccess) fprintf(stderr, "cooperative launch failed: %s (grid %d)\n", hipGetErrorString(e), grid_blocks);
#else
  const int G = 1024;
  launch_phase<0>(p, G, stream); launch_phase<1>(p, G, stream); launch_phase<2>(p, G, stream); launch_phase<3>(p, G, stream);
  launch_phase<4>(p, G, stream); launch_phase<5>(p, G, stream); launch_phase<6>(p, G, stream); launch_phase<7>(p, G, stream);
  launch_phase<8>(p, G, stream); launch_phase<9>(p, G, stream); launch_phase<11>(p, G, stream);
#endif
}
```

```cpp
#include <hip/hip_runtime.h>
#include <hip/hip_cooperative_groups.h>
#include <cstdio>
#include <cstdint>
namespace cg = cooperative_groups;

#ifndef MEGA
#define MEGA 1
#endif

typedef unsigned short bf16_t;
typedef short bf16x8 __attribute__((ext_vector_type(8)));
typedef float f32x4 __attribute__((ext_vector_type(4)));
typedef unsigned u32x4 __attribute__((ext_vector_type(4)));
#define LAS __attribute__((address_space(3)))
__device__ __forceinline__ bf16x8 as_bf(u32x4 v) { return __builtin_bit_cast(bf16x8, v); }

#define T_TOK 16384
#define SEQL 8192
#define NTHREADS 256
#define LDS_WORK 74752
#define LDS_BYTES (LDS_WORK + 16)
#define EPSF 1e-6f

typedef float f32x2_ __attribute__((ext_vector_type(2)));
typedef __bf16 bf16x2v __attribute__((ext_vector_type(2)));
__device__ __forceinline__ unsigned pack2(float lo, float hi) { f32x2_ v = {lo, hi}; bf16x2v b = __builtin_convertvector(v, bf16x2v); return __builtin_bit_cast(unsigned, b); }
__device__ __forceinline__ unsigned short f2bf(float f) { return (unsigned short)(pack2(f, 0.f) & 0xffffu); }
__device__ __forceinline__ float bf2f(unsigned short b) { return __uint_as_float(((unsigned)b) << 16); }
__device__ __forceinline__ float gelu_f(float v) {
  const float av = fabsf(v), t = __builtin_amdgcn_rcpf(av * 0.2316418882f + 1.0f);
  float q = t * 0.5307027145f + (-0.7265760135f); q = q * t + 0.7107068705f; q = q * t + (-0.142248368f); q = q * t + 0.127414796f; q = q * t;
  const float e = __builtin_amdgcn_exp2f((v * v) * (-0.72134752044f)); const float m = v * (q * e);
  return v < 0.f ? m : v - m; }
typedef float f32x2 __attribute__((ext_vector_type(2)));
__device__ __forceinline__ f32x4 mfma16(bf16x8 a, bf16x8 b, f32x4 c) { return __builtin_amdgcn_mfma_f32_16x16x32_bf16(a, b, c, 0, 0, 0); }


#define XB_TMO      128
#define XB_XCNT(j)  (256  + 64 * (j))
#define XB_XSUB(j)  (1280 + 64 * (j))
#define XB_XGEN(j)  (2304 + 64 * (j))
#define XB_TOP      3328
#define XB_TOPGEN   3392
#define XCD_BAR_WORDS 3456
#define XB_SPIN_CAP (1u << 18)
__device__ __forceinline__ unsigned xb_ld(unsigned* p)              { return __hip_atomic_load(p, __ATOMIC_RELAXED, __HIP_MEMORY_SCOPE_AGENT); }
__device__ __forceinline__ unsigned xb_add(unsigned* p, unsigned v) { return __hip_atomic_fetch_add(p, v, __ATOMIC_RELAXED, __HIP_MEMORY_SCOPE_AGENT); }
__device__ __forceinline__ unsigned xb_xcc_id() { return (unsigned)__builtin_amdgcn_s_getreg((3 << 11) | 20) & 0xFu; }
#define XB_SPIN(cond, bar) do { unsigned _sp = 0; while (cond) { __builtin_amdgcn_s_sleep(1); \
    if ((++_sp & 255u) == 0u) { if (xb_ld(&(bar)[XB_TMO])) break; if (_sp > XB_SPIN_CAP) { atomicAdd(&(bar)[XB_TMO], 1u); break; } } } } while (0)
struct XcdBarrier { unsigned* bar; unsigned x; volatile LAS unsigned* st; };
__device__ __forceinline__ XcdBarrier xcd_barrier_post(unsigned* bar, volatile LAS unsigned* st) {
  XcdBarrier b; b.bar = bar; b.x = xb_xcc_id(); b.st = st;
  if (threadIdx.x == 0) (void)xb_add(&bar[XB_XCNT(b.x)], 1u);
  return b;
}
__device__ __forceinline__ void xcd_barrier_complete(unsigned* bar, unsigned x, unsigned& nloc, unsigned& nx) {
  const unsigned G = gridDim.x * gridDim.y * gridDim.z;
  unsigned sum, cnt, mine, sp = 0u;
  for (;;) {
    sum = 0u; cnt = 0u; mine = 0u;
#pragma unroll
    for (unsigned j = 0; j < 16; ++j) { const unsigned c = xb_ld(&bar[XB_XCNT(j)]); sum += c; cnt += (c > 0u) ? 1u : 0u; mine = (j == x) ? c : mine; }
    if (sum == G) break;
    __builtin_amdgcn_s_sleep(1);
    if ((++sp & 255u) == 0u) { if (xb_ld(&bar[XB_TMO])) break; if (sp > XB_SPIN_CAP) { atomicAdd(&bar[XB_TMO], 1u); break; } }
  }
  nloc = mine > 0u ? mine : 1u; nx = cnt > 0u ? cnt : 1u;
}
__device__ __forceinline__ void xcd_barrier(const XcdBarrier& b) {
  asm volatile("s_waitcnt vmcnt(0)" ::: "memory");
  __syncthreads();
  if (threadIdx.x == 0) {
    unsigned* bar = b.bar;
    __builtin_amdgcn_s_waitcnt(0);
    unsigned nloc = b.st[0], nx = b.st[1];
    if (nloc == 0u) { xcd_barrier_complete(bar, b.x, nloc, nx); b.st[0] = nloc; b.st[1] = nx; }
    const unsigned old = xb_add(&bar[XB_XSUB(b.x)], 1u);
    const unsigned gen = old / nloc;
    if (old + 1u == (gen + 1u) * nloc) {
      __builtin_amdgcn_fence(__ATOMIC_RELEASE, "agent");
      asm volatile("s_waitcnt vmcnt(0)" ::: "memory");
      const unsigned og = xb_add(&bar[XB_TOP], 1u);
      const unsigned tg = og / nx;
      if (og + 1u == (tg + 1u) * nx) xb_add(&bar[XB_TOPGEN], 1u);
      else XB_SPIN(xb_ld(&bar[XB_TOPGEN]) == tg, bar);
      __builtin_amdgcn_fence(__ATOMIC_ACQUIRE, "agent");
      xb_add(&bar[XB_XGEN(b.x)], 1u);
      asm volatile("s_waitcnt vmcnt(0)" ::: "memory");
    } else {
      XB_SPIN(xb_ld(&bar[XB_XGEN(b.x)]) == gen, bar);
      __builtin_amdgcn_fence(__ATOMIC_ACQUIRE, "agent");
      asm volatile("s_waitcnt vmcnt(0)" ::: "memory");
    }
  }
  __syncthreads();
}

struct Params {
  const float *x, *mem, *norm_mix_g, *w_in, *att_q_g, *att_k_g, *rel_bias;
  const float *lam_re, *lam_im, *log_step, *b_re, *b_im, *c_re, *c_im, *d_skip, *w_glu, *b_glu;
  const float *att_out_g, *ssm_out_g, *w_out, *norm_mem_g, *norm_memkv_g, *w_mem_q, *w_mem_k, *w_mem_v;
  const float *mem_q_g, *mem_k_g, *w_mem_o, *norm_peer_g, *w_peer_q, *peer_keys, *peer_u, *peer_v;
  float* out;
  unsigned* bar;
  bf16_t *WtIn, *WtGlu, *WtOut, *WtMq, *WtMk, *WtMv, *WtMo, *WtPq, *WPQ, *PK, *PU, *PV;
  bf16_t *XB, *MEMB, *Qb, *Kb, *VT, *Ub, *ATT, *YG, *SSMO, *H1B, *QM, *OM, *H2B, *QP;
  bf16_t *KMB, *VMT, *WE16, *WY;
  float *rs_x, *rs_mem, *ss_att, *ss_ssm, *ss_h1, *ss_qm, *ss_km, *ss_h2, *KMraw, *ESEG;
  float *BBR, *BBI, *PWR, *PWI, *KJ, *APW, *SHF;
  unsigned* TOPS;
  unsigned char *PU8, *PV8; float *su, *sv;
};

#define GAS __attribute__((address_space(1)))
#define RAW_BARRIER() do { asm volatile("s_waitcnt lgkmcnt(0)" ::: "memory"); __builtin_amdgcn_s_barrier(); } while (0)
__device__ __forceinline__ void glds16(const void* gsrc, unsigned lds_dst) {
  unsigned keep;
  asm volatile("s_mov_b32 %0, m0\n\ts_mov_b32 m0, %2\n\ts_nop 0\n\tglobal_load_lds_dwordx4 %1, off\n\ts_mov_b32 m0, %0" : "=&s"(keep) : "v"(gsrc), "s"(lds_dst) : "memory");
}
template <bool ZERO = true, bool SWAP = false>
__device__ __forceinline__ void gemm_mainloop(f32x4 (&acc)[4][4], const bf16_t* __restrict__ A, int lda, const bf16_t* __restrict__ Bt, int ldb, int K,
                                              int row0, int col0, char* lds_) {
  LAS char* lds = (LAS char*)lds_;
  const int tid = threadIdx.x, lane = tid & 63, w = tid >> 6, wr = w >> 1, wc = w & 1, fr = lane & 15, fq = lane >> 4;
  if (ZERO) {
#pragma unroll
    for (int m = 0; m < 4; ++m)
#pragma unroll
      for (int n = 0; n < 4; ++n) acc[m][n] = (f32x4){0.f, 0.f, 0.f, 0.f};
  }
  const int lr = lane >> 3, lc = (lane & 7) ^ lr;
  const bf16_t* gA = A + (size_t)(row0 + w * 32 + lr) * lda + lc * 8;
  const bf16_t* gB = Bt + (size_t)(col0 + w * 32 + lr) * ldb + lc * 8;
  const unsigned wbase = (unsigned)(size_t)lds + (unsigned)__builtin_amdgcn_readfirstlane(w) * 4096u;
  const int nk = K >> 6;
  __syncthreads();
#pragma unroll
  for (int i = 0; i < 4; ++i) { glds16(gA + (size_t)(i * 8) * lda, wbase + i * 1024u); glds16(gB + (size_t)(i * 8) * ldb, wbase + 16384u + i * 1024u); }
  for (int kt = 0; kt < nk; ++kt) {
    asm volatile("s_waitcnt vmcnt(0)" ::: "memory");
    RAW_BARRIER();
    LAS char* cur = lds + (kt & 1) * 32768;
    if (kt + 1 < nk) { const int k1 = (kt + 1) << 6; const unsigned nb_ = wbase + (unsigned)(((kt + 1) & 1) * 32768);
#pragma unroll
      for (int i = 0; i < 4; ++i) { glds16(gA + (size_t)(i * 8) * lda + k1, nb_ + i * 1024u); glds16(gB + (size_t)(i * 8) * ldb + k1, nb_ + 16384u + i * 1024u); } }
#pragma unroll
    for (int ks = 0; ks < 2; ++ks) {
      bf16x8 af[4], bfr[4];
      const int kc = ks * 4 + fq;
#pragma unroll
      for (int m = 0; m < 4; ++m) { const int r = wr * 64 + m * 16 + fr; af[m] = as_bf(*(const LAS u32x4*)(cur + r * 128 + ((kc ^ (r & 7)) << 4))); }
#pragma unroll
      for (int n = 0; n < 4; ++n) { const int r = wc * 64 + n * 16 + fr; bfr[n] = as_bf(*(const LAS u32x4*)(cur + 16384 + r * 128 + ((kc ^ (r & 7)) << 4))); }
#pragma unroll
      for (int m = 0; m < 4; ++m)
#pragma unroll
        for (int n = 0; n < 4; ++n) acc[m][n] = SWAP ? mfma16(af[m], bfr[n], acc[m][n]) : mfma16(bfr[n], af[m], acc[m][n]);
    }
  }
  RAW_BARRIER();
}

__device__ __forceinline__ void transpose_tile(const float* __restrict__ src, bf16_t* __restrict__ dst, int K, int N, int tile, const float* g0, const float* g1, int split, float* tl  ) {
  const int ntn = N >> 6; const int tk = tile / ntn, tn = tile % ntn; const int k0 = tk << 6, n0 = tn << 6; const int tid = threadIdx.x;
  __syncthreads();
#pragma unroll
  for (int i = 0; i < 4; ++i) { const int kk = i * 16 + (tid >> 4), nn = (tid & 15) * 4; const int k = k0 + kk;
    float g = 1.f; if (g0) g = (k < split) ? g0[k] : g1[k - split];
    const float4 v = *(const float4*)(src + (size_t)k * N + n0 + nn);
    tl[kk * 65 + nn] = v.x * g; tl[kk * 65 + nn + 1] = v.y * g; tl[kk * 65 + nn + 2] = v.z * g; tl[kk * 65 + nn + 3] = v.w * g; }
  __syncthreads();
  const int n = tid >> 2, kq = (tid & 3) * 16;
  unsigned o[8];
#pragma unroll
  for (int j = 0; j < 8; ++j) o[j] = pack2(tl[(kq + 2 * j) * 65 + n], tl[(kq + 2 * j + 1) * 65 + n]);
  uint4* d = (uint4*)(dst + (size_t)(n0 + n) * K + k0 + kq);
  d[0] = make_uint4(o[0], o[1], o[2], o[3]); d[1] = make_uint4(o[4], o[5], o[6], o[7]);
}

__device__ __forceinline__ void convert_flat(const float* __restrict__ src, bf16_t* __restrict__ dst, size_t n8  , int bid, int nb) {
  for (size_t i = (size_t)bid * NTHREADS + threadIdx.x; i < n8; i += (size_t)nb * NTHREADS) {
    const float4 a = ((const float4*)src)[2 * i], b = ((const float4*)src)[2 * i + 1];
    ((uint4*)dst)[i] = make_uint4(pack2(a.x, a.y), pack2(a.z, a.w), pack2(b.x, b.y), pack2(b.z, b.w));
  }
}
__device__ __forceinline__ void rows_bf16_rs(const float* __restrict__ src, bf16_t* __restrict__ dst, float* __restrict__ rs, int nrows, int bid, int nb) {
  const int lane = threadIdx.x & 63, w = threadIdx.x >> 6; const int nwv = nb * 4;
  for (int row0 = bid * 4 + w; row0 < nrows; row0 += nwv * 4) {
    float4 v[4][4];
#pragma unroll
    for (int r = 0; r < 4; ++r) { const int row = row0 + r * nwv; if (row < nrows) { const float4* s = (const float4*)(src + (size_t)row * 1024);
#pragma unroll
        for (int i = 0; i < 4; ++i) v[r][i] = s[i * 64 + lane]; } }
#pragma unroll
    for (int r = 0; r < 4; ++r) { const int row = row0 + r * nwv; if (row < nrows) {
      float ss = 0.f; uint2* d = (uint2*)(dst + (size_t)row * 1024);
#pragma unroll
      for (int i = 0; i < 4; ++i) { const float4 x = v[r][i]; ss += x.x * x.x + x.y * x.y + x.z * x.z + x.w * x.w; d[i * 64 + lane] = make_uint2(pack2(x.x, x.y), pack2(x.z, x.w)); }
#pragma unroll
      for (int o = 32; o > 0; o >>= 1) ss += __shfl_xor(ss, o);
      if (lane == 0) rs[row] = rsqrtf(ss * (1.0f / 1024.0f) + EPSF); } }
  }
}
__device__ __forceinline__ void rows_fp8(const float* __restrict__ src, unsigned char* __restrict__ dst, float* __restrict__ sc, int nrows, int bid, int nb) {
  const int lane = threadIdx.x & 63, w = threadIdx.x >> 6;
  for (int row = bid * 4 + w; row < nrows; row += nb * 4) {
    const float4* s = (const float4*)(src + (size_t)row * 1024);
    float4 v[4]; float am = 0.f;
#pragma unroll
    for (int i = 0; i < 4; ++i) { v[i] = s[i * 64 + lane]; am = fmaxf(am, fmaxf(fmaxf(fabsf(v[i].x), fabsf(v[i].y)), fmaxf(fabsf(v[i].z), fabsf(v[i].w)))); }
#pragma unroll
    for (int o = 32; o > 0; o >>= 1) am = fmaxf(am, __shfl_xor(am, o));
    const float q = (am > 0.f) ? 224.0f / am : 1.0f;
    unsigned* d = (unsigned*)(dst + (size_t)row * 1024);
#pragma unroll
    for (int i = 0; i < 4; ++i) { int wd = 0; wd = __builtin_amdgcn_cvt_pk_fp8_f32(v[i].x * q, v[i].y * q, wd, false); wd = __builtin_amdgcn_cvt_pk_fp8_f32(v[i].z * q, v[i].w * q, wd, true); d[i * 64 + lane] = (unsigned)wd; }
    if (lane == 0) sc[row] = (am > 0.f) ? am * (1.0f / 224.0f) : 1.0f;
  }
}

template <bool SWAPN>
__device__ __forceinline__ void rows_fp4(const float* __restrict__ src, unsigned char* __restrict__ dst, float* __restrict__ sc, int nrows, int bid, int nb) {
  const int lane = threadIdx.x & 63, w = threadIdx.x >> 6; const int nwv = nb * 4;
  for (int row0 = bid * 4 + w; row0 < nrows; row0 += nwv * 4) {
    float4 v[4][4];
#pragma unroll
    for (int r = 0; r < 4; ++r) { const int row = row0 + r * nwv; if (row < nrows) { const float4* s = (const float4*)(src + (size_t)row * 1024 + lane * 16);
#pragma unroll
        for (int i = 0; i < 4; ++i) v[r][i] = s[i]; } }
#pragma unroll
    for (int r = 0; r < 4; ++r) { const int row = row0 + r * nwv; if (row < nrows) {
      float am = 0.f;
#pragma unroll
      for (int i = 0; i < 4; ++i) am = fmaxf(am, fmaxf(fmaxf(fabsf(v[r][i].x), fabsf(v[r][i].y)), fmaxf(fabsf(v[r][i].z), fabsf(v[r][i].w))));
#pragma unroll
      for (int o = 32; o > 0; o >>= 1) am = fmaxf(am, __shfl_xor(am, o));
      const float q = (am > 0.f) ? 6.0f / am : 1.0f;
      unsigned w0 = 0, w1 = 0;
      w0 = __builtin_amdgcn_cvt_scalef32_pk_fp4_f32(w0, v[r][0].x * q, v[r][0].y * q, 1.0f, 0); w0 = __builtin_amdgcn_cvt_scalef32_pk_fp4_f32(w0, v[r][0].z * q, v[r][0].w * q, 1.0f, 1);
      w0 = __builtin_amdgcn_cvt_scalef32_pk_fp4_f32(w0, v[r][1].x * q, v[r][1].y * q, 1.0f, 2); w0 = __builtin_amdgcn_cvt_scalef32_pk_fp4_f32(w0, v[r][1].z * q, v[r][1].w * q, 1.0f, 3);
      w1 = __builtin_amdgcn_cvt_scalef32_pk_fp4_f32(w1, v[r][2].x * q, v[r][2].y * q, 1.0f, 0); w1 = __builtin_amdgcn_cvt_scalef32_pk_fp4_f32(w1, v[r][2].z * q, v[r][2].w * q, 1.0f, 1);
      w1 = __builtin_amdgcn_cvt_scalef32_pk_fp4_f32(w1, v[r][3].x * q, v[r][3].y * q, 1.0f, 2); w1 = __builtin_amdgcn_cvt_scalef32_pk_fp4_f32(w1, v[r][3].z * q, v[r][3].w * q, 1.0f, 3);
      *(uint2*)(dst + (size_t)row * 512 + lane * 8) = make_uint2(w0, w1);
      if (lane == 0) sc[row] = (am > 0.f) ? am * (1.0f / 6.0f) : 1.0f; } }
  }
}

__device__ __forceinline__ void ssm_stage1(const Params& p, int gp) {
  const int g = gp >> 6;
  const float step = expf(p.log_step[g]); const float lr = p.lam_re[gp], li = p.lam_im[gp];
  const float mag = expf(lr * step); const float ar = mag * cosf(li * step), ai = mag * sinf(li * step);
  const float zr = ar - 1.0f, den = lr * lr + li * li; const float fr = (zr * lr + ai * li) / den, fi = (ai * lr - zr * li) / den;
  for (int c = 0; c < 16; ++c) { const float br = p.b_re[gp * 16 + c], bi = p.b_im[gp * 16 + c]; p.BBR[gp * 16 + c] = fr * br - fi * bi; p.BBI[gp * 16 + c] = fr * bi + fi * br; }
  float pr = 1.f, pi = 0.f; const int st = gp & 63;
  for (int j = 0; j <= 16; ++j) { p.PWR[(g * 17 + j) * 64 + st] = pr; p.PWI[(g * 17 + j) * 64 + st] = pi; const float nr = pr * ar - pi * ai, ni = pr * ai + pi * ar; if (j < 16) { pr = nr; pi = ni; } }
  const float a16r = pr, a16i = pi; const float a32r = a16r * a16r - a16i * a16i, a32i = 2.f * a16r * a16i;
  const float a48r = a32r * a16r - a32i * a16i, a48i = a32r * a16i + a32i * a16r; const float a64r = a32r * a32r - a32i * a32i, a64i = 2.f * a32r * a32i;
  const float a128r = a64r * a64r - a64i * a64i, a128i = 2.f * a64r * a64i; const float a256r = a128r * a128r - a128i * a128i, a256i = 2.f * a128r * a128i;
  float* A = p.APW;
  A[0 * 4096 + gp] = a16r; A[0 * 4096 + 2048 + gp] = a16i; A[1 * 4096 + gp] = a32r; A[1 * 4096 + 2048 + gp] = a32i; A[2 * 4096 + gp] = a48r; A[2 * 4096 + 2048 + gp] = a48i;
  A[3 * 4096 + gp] = a64r; A[3 * 4096 + 2048 + gp] = a64i; A[4 * 4096 + gp] = a256r; A[4 * 4096 + 2048 + gp] = a256i;
}
__device__ __forceinline__ void ssm_stage2a(const Params& p, int bid, int nb) {
  const int n1 = 32 * 128 * 256, n2 = 32 * 16 * 4 * 512, n3 = 32 * 16 * 256;
  for (int i = bid * NTHREADS + threadIdx.x; i < n1 + n2 + n3; i += nb * NTHREADS) {
    if (i < n1) {
      const int j = i & 7, lane = (i >> 3) & 63, ks = (i >> 9) & 7, ri = (i >> 12) & 1, w = (i >> 13) & 3, g = i >> 15;
      const int st = w * 16 + (lane & 15), k = ks * 32 + (lane >> 4) * 8 + j; const int s_ = k >> 4, ch = k & 15;
      const int gp = g * 64 + st; const float pr = p.PWR[(g * 17 + 15 - s_) * 64 + st], pi = p.PWI[(g * 17 + 15 - s_) * 64 + st]; const float br = p.BBR[gp * 16 + ch], bi = p.BBI[gp * 16 + ch];
      p.WE16[i] = f2bf(ri == 0 ? (pr * br - pi * bi) : (pr * bi + pi * br));
    } else if (i < n1 + n2) {
      const int e = i - n1; const int j = e & 7, lane = (e >> 3) & 63, ks = (e >> 9) & 3, mt = (e >> 11) & 15, g = e >> 15;
      const int t = mt, co = lane & 15, k = ks * 32 + (lane >> 4) * 8 + j;
      const int st = ((k >> 5) << 4) | (k & 15), ri = (k >> 4) & 1; const float cr = p.c_re[(g * 16 + co) * 64 + st], ci = p.c_im[(g * 16 + co) * 64 + st];
      const float pr = p.PWR[(g * 17 + t + 1) * 64 + st], pi = p.PWI[(g * 17 + t + 1) * 64 + st];
      p.WY[((size_t)(g * 16 + mt) * 12 + ks) * 512 + lane * 8 + j] = f2bf((ri == 0) ? (cr * pr - ci * pi) : -(cr * pi + ci * pr));
    } else {
      const int e = i - n1 - n2; const int cin = e & 15, co = (e >> 4) & 15, j = (e >> 8) & 15, g = e >> 12; float acc = 0.f;
      for (int st = 0; st < 64; ++st) { const float cr = p.c_re[(g * 16 + co) * 64 + st], ci = p.c_im[(g * 16 + co) * 64 + st]; const float pr = p.PWR[(g * 17 + j) * 64 + st], pi = p.PWI[(g * 17 + j) * 64 + st];
        const float br = p.BBR[(g * 64 + st) * 16 + cin], bi = p.BBI[(g * 64 + st) * 16 + cin]; acc += cr * (pr * br - pi * bi) - ci * (pr * bi + pi * br); }
      p.KJ[e] = acc;
    }
  }
}
__device__ __forceinline__ void ssm_stage2b(const Params& p, int bid, int nb) {
  const int n = 32 * 16 * 8 * 512;
  for (int i = bid * NTHREADS + threadIdx.x; i < n; i += nb * NTHREADS) {
    const int j = i & 7, lane = (i >> 3) & 63, ks8 = (i >> 9) & 7, mt = (i >> 12) & 15, g = i >> 16;
    const int t = mt, co = lane & 15, kk = ks8 * 32 + (lane >> 4) * 8 + j; const int s_ = kk >> 4, cin = kk & 15;
    const float val = (s_ <= t) ? p.KJ[((g * 16 + (t - s_)) * 16 + co) * 16 + cin] : 0.f;
    p.WY[((size_t)(g * 16 + mt) * 12 + 4 + ks8) * 512 + lane * 8 + j] = f2bf(val);
  }
}

#define EPI_IDS const int tid = threadIdx.x, lane = tid & 63, w = tid >> 6, wr = w >> 1, wc = w & 1, fr = lane & 15, fq = lane >> 4; (void)wr; (void)wc; (void)fr; (void)fq;

__device__ __forceinline__ void tile_win_v(const Params& p, int tile, char* lds) {
  const int rt = tile >> 4, ct = tile & 15; const int row0 = rt * 128, col0 = ct * 128;
  f32x4 acc[4][4];
  gemm_mainloop<true, true>(acc, p.XB, 1024, p.WtIn, 1024, 1024, row0, col0, lds);
  EPI_IDS
  const int head = (col0 + wc * 64 - 1024) >> 6;
#pragma unroll
  for (int m = 0; m < 4; ++m) {
    const int row = row0 + wr * 64 + m * 16 + fq * 4; const f32x4 rsx = *(const f32x4*)(p.rs_x + row); const int b = row >> 13, tb = row & 8191;
#pragma unroll
    for (int n = 0; n < 4; ++n) { const f32x4 v = acc[m][n] * rsx;
      *(uint2*)(p.VT + ((size_t)(b * 8 + head) * 64 + n * 16 + fr) * SEQL + tb) = make_uint2(pack2(v[0], v[1]), pack2(v[2], v[3])); }
  }
}
__device__ __forceinline__ void tile_win(const Params& p, int tile, char* lds) {
  const int rt = tile >> 4, ct = tile & 15; const int row0 = rt * 128, col0 = ct * 128;
  f32x4 acc[4][4];
  gemm_mainloop<true>(acc, p.XB, 1024, p.WtIn, 1024, 1024, row0, col0, lds);
  EPI_IDS
  const int cw = col0 + wc * 64;
#pragma unroll
  for (int m = 0; m < 4; ++m) {
    const int row = row0 + wr * 64 + m * 16 + fr; const float rsx = p.rs_x[row];
    if (cw < 1024) {
      float ss = 0.f;
#pragma unroll
      for (int n = 0; n < 4; ++n)
#pragma unroll
        for (int j = 0; j < 4; ++j) { const float v = acc[m][n][j] * rsx; acc[m][n][j] = v; ss += v * v; }
      ss += __shfl_xor(ss, 16); ss += __shfl_xor(ss, 32);
      const float rs = rsqrtf(ss * (1.0f / 64.0f) + EPSF) * (cw < 512 ? 0.125f * 1.44269504f : 1.0f);
      const float* g = (cw < 512) ? p.att_q_g : p.att_k_g; bf16_t* dst = (cw < 512 ? p.Qb : p.Kb) + (size_t)row * 512 + (cw & 511);
#pragma unroll
      for (int n = 0; n < 4; ++n) { const int c = n * 16 + fq * 4; const float4 gg = *(const float4*)(g + c);
        *(uint2*)(dst + c) = make_uint2(pack2(acc[m][n][0] * rs * gg.x, acc[m][n][1] * rs * gg.y), pack2(acc[m][n][2] * rs * gg.z, acc[m][n][3] * rs * gg.w)); }
    } else if (cw < 1536) {
      const int head = (cw - 1024) >> 6; const int b = row >> 13, tb = row & 8191;
      bf16_t* dst = p.VT + ((size_t)(b * 8 + head) * 64) * SEQL + tb;
#pragma unroll
      for (int n = 0; n < 4; ++n)
#pragma unroll
        for (int j = 0; j < 4; ++j) dst[(size_t)(n * 16 + fq * 4 + j) * SEQL] = f2bf(acc[m][n][j] * rsx);
    } else {
      const int b = row >> 13, tb = row & 8191;
#pragma unroll
      for (int n = 0; n < 4; ++n) { const int g = ((cw - 1536) >> 4) + n;
        *(uint2*)(p.Ub + ((size_t)(b * 32 + g) * SEQL + tb) * 16 + fq * 4) = make_uint2(pack2(acc[m][n][0] * rsx, acc[m][n][1] * rsx), pack2(acc[m][n][2] * rsx, acc[m][n][3] * rsx)); }
    }
  }
}
__device__ __forceinline__ void tile_memkv(const Params& p, int tile, char* lds) {
  const int which = tile >> 5, t2 = tile & 31; const int rt = t2 >> 3, ct = t2 & 7; const int row0 = rt * 128, col0 = ct * 128;
  f32x4 acc[4][4];
  gemm_mainloop<true>(acc, p.MEMB, 1024, which ? p.WtMv : p.WtMk, 1024, 1024, row0, col0, lds);
  EPI_IDS
  const int cw = col0 + wc * 64;
#pragma unroll
  for (int m = 0; m < 4; ++m) {
    const int row = row0 + wr * 64 + m * 16 + fr; const float rsm = p.rs_mem[row];
    if (which == 0) {
      float ss = 0.f;
#pragma unroll
      for (int n = 0; n < 4; ++n) { f32x4 v = acc[m][n] * rsm; ss += v[0] * v[0] + v[1] * v[1] + v[2] * v[2] + v[3] * v[3]; *(f32x4*)(p.KMraw + (size_t)row * 1024 + cw + n * 16 + fq * 4) = v; }
      ss += __shfl_xor(ss, 16); ss += __shfl_xor(ss, 32);
      if (fq == 0) p.ss_km[row * 16 + (cw >> 6)] = ss;
    } else {
      const int b = row >> 8, key = row & 255; const int head = cw >> 8; const int d0 = (cw & 255);
      bf16_t* dst = p.VMT + ((size_t)(b * 4 + head) * 256) * 256 + key;
#pragma unroll
      for (int n = 0; n < 4; ++n)
#pragma unroll
        for (int j = 0; j < 4; ++j) dst[(size_t)(d0 + n * 16 + fq * 4 + j) * 256] = f2bf(acc[m][n][j] * rsm);
    }
  }
}
__device__ __forceinline__ void memk_fix(const Params& p, int bid, int nb) {
  for (int i = bid * NTHREADS + threadIdx.x; i < 512 * 1024 / 4; i += nb * NTHREADS) {
    const int row = i >> 8, c4 = (i & 255) * 4; const int head = c4 >> 8, d = c4 & 255;
    const float ss = p.ss_km[row * 16 + head * 4] + p.ss_km[row * 16 + head * 4 + 1] + p.ss_km[row * 16 + head * 4 + 2] + p.ss_km[row * 16 + head * 4 + 3];
    const float rs = rsqrtf(ss * (1.0f / 256.0f) + EPSF);
    const float4 v = *(const float4*)(p.KMraw + (size_t)row * 1024 + c4); const float4 gk = *(const float4*)(p.mem_k_g + d), gq = *(const float4*)(p.mem_q_g + d);
    const int b = row >> 8, key = row & 255;
    *(uint2*)(p.KMB + ((size_t)(b * 4 + head) * 256 + key) * 256 + d) = make_uint2(pack2(v.x * rs * gk.x * gq.x, v.y * rs * gk.y * gq.y), pack2(v.z * rs * gk.z * gq.z, v.w * rs * gk.w * gq.w));
  }
}

__device__ __forceinline__ void chunk_attn_prep(const Params& p, char* lds_) {
  LAS float* rb = (LAS float*)((LAS char*)lds_ + 65536);
  __syncthreads();
  for (int i = threadIdx.x; i < 8 * 192; i += NTHREADS) rb[i] = p.rel_bias[i] * 1.44269504f - p.SHF[i / 192];
  __syncthreads();
}
__device__ __forceinline__ void cattn_stage(const bf16_t* kg, const bf16_t* vg, unsigned st, int w, int lane) {
  const unsigned wb = st + (unsigned)__builtin_amdgcn_readfirstlane(w) * 2048u; const int lr = lane >> 3, pos = lane & 7;
#pragma unroll
  for (int i = 0; i < 2; ++i) { const int row = w * 16 + i * 8 + lr;
    glds16(kg + (size_t)row * 512 + ((pos ^ (row & 7)) << 3), wb + i * 1024u);
    glds16(vg + (size_t)row * SEQL + ((pos ^ ((row >> 1) & 7)) << 3), wb + 8192u + i * 1024u); }
}
__device__ __forceinline__ void chunk_attn_item(const Params& p, int item, char* lds_) {
  LAS char* lds = (LAS char*)lds_;
  typedef unsigned u32x2 __attribute__((ext_vector_type(2)));
  const int h = item & 7, G = (item >> 3) & 31, b = item >> 8;
  LAS float* rb = (LAS float*)(lds + 65536) + h * 192;
  const unsigned lbase = (unsigned)(size_t)lds;
  const int tid = threadIdx.x, lane = tid & 63, w = tid >> 6, fr = lane & 15, fq = lane >> 4;
  const int iq = w * 16 + fr;
  const int cn0 = G * 4;
  const int t0 = (cn0 >= 8) ? cn0 - 8 : 0, ntl = cn0 + 3 - t0 + 1;
  const bf16_t* kbase = p.Kb + (size_t)(b * SEQL) * 512 + h * 64;
  const bf16_t* vbase = p.VT + ((size_t)(b * 8 + h) * 64) * SEQL;
  bf16x8 qf[4][2];
#pragma unroll
  for (int qc = 0; qc < 4; ++qc) { const bf16_t* qp = p.Qb + (size_t)(b * SEQL + (cn0 + qc) * 64 + iq) * 512 + h * 64 + fq * 8;
    qf[qc][0] = *(const bf16x8*)qp; qf[qc][1] = *(const bf16x8*)(qp + 32); }
  __syncthreads();
#pragma unroll
  for (int i = 0; i < 3; ++i) if (i < ntl) cattn_stage(kbase + (size_t)(t0 + i) * 64 * 512, vbase + (t0 + i) * 64, lbase + i * 16384u, w, lane);
  f32x4 o[4][4]; float lrun[4];
#pragma unroll
  for (int qc = 0; qc < 4; ++qc) { lrun[qc] = 0.f;
#pragma unroll
    for (int i = 0; i < 4; ++i) o[qc][i] = (f32x4){0.f, 0.f, 0.f, 0.f}; }
  const float cbias = rb[191];
  for (int i = 0; i < ntl; ++i) {
    const int t = t0 + i; const int rem = ntl - 1 - i;
    if (rem >= 2) asm volatile("s_waitcnt vmcnt(8)" ::: "memory"); else if (rem == 1) asm volatile("s_waitcnt vmcnt(4)" ::: "memory"); else asm volatile("s_waitcnt vmcnt(0)" ::: "memory");
    RAW_BARRIER();
    if (i + 3 < ntl) cattn_stage(kbase + (size_t)(t + 3) * 64 * 512, vbase + (t + 3) * 64, lbase + (unsigned)(((i + 3) & 3) * 16384), w, lane);
    LAS char* cur = lds + (i & 3) * 16384;
    bf16x8 kf[4][2], vf[4][2];
#pragma unroll
    for (int mt = 0; mt < 4; ++mt) { const int row = mt * 16 + fr;
      kf[mt][0] = as_bf(*(const LAS u32x4*)(cur + row * 128 + ((fq ^ (row & 7)) << 4))); kf[mt][1] = as_bf(*(const LAS u32x4*)(cur + row * 128 + (((4 + fq) ^ (row & 7)) << 4))); }
#pragma unroll
    for (int dt = 0; dt < 4; ++dt) { const int d = dt * 16 + fr; const int sw = ((d >> 1) & 7) << 1;
#pragma unroll
      for (int s2 = 0; s2 < 2; ++s2) {
        const u32x2 lo = *(const LAS u32x2*)(cur + 8192 + d * 128 + (((s2 * 8 + fq) ^ sw) << 3)), hi = *(const LAS u32x2*)(cur + 8192 + d * 128 + (((s2 * 8 + fq + 4) ^ sw) << 3));
        u32x4 vv; vv.x = lo.x; vv.y = lo.y; vv.z = hi.x; vv.w = hi.y; vf[dt][s2] = as_bf(vv); } }
#pragma unroll
    for (int qc = 0; qc < 4; ++qc) {
      const int c = t - (cn0 + qc - 8);
      if (c >= 0 && c <= 8) {
        f32x4 st[4];
        const float ini = (c <= 5) ? cbias : 0.f;
#pragma unroll
        for (int mt = 0; mt < 4; ++mt) { f32x4 sacc = (f32x4){ini, ini, ini, ini};
          sacc = mfma16(kf[mt][0], qf[qc][0], sacc); sacc = mfma16(kf[mt][1], qf[qc][1], sacc); st[mt] = sacc; }
        if (c > 5) {
#pragma unroll
          for (int mt = 0; mt < 4; ++mt)
#pragma unroll
            for (int j = 0; j < 4; ++j) { const int jk = mt * 16 + fq * 4 + j; int dist = 512 - 64 * c + iq - jk; dist = dist > 128 ? 128 : dist; st[mt][j] += rb[dist + 63]; }
        }
        float ls = 0.f;
#pragma unroll
        for (int mt = 0; mt < 4; ++mt)
#pragma unroll
          for (int j = 0; j < 4; ++j) { const float pv = __builtin_amdgcn_exp2f(st[mt][j]); st[mt][j] = pv; ls += pv; }
        lrun[qc] += ls;
        bf16x8 pf[2];
#pragma unroll
        for (int s2 = 0; s2 < 2; ++s2) { u32x4 tt; tt.x = pack2(st[2 * s2][0], st[2 * s2][1]); tt.y = pack2(st[2 * s2][2], st[2 * s2][3]); tt.z = pack2(st[2 * s2 + 1][0], st[2 * s2 + 1][1]); tt.w = pack2(st[2 * s2 + 1][2], st[2 * s2 + 1][3]); pf[s2] = as_bf(tt); }
#pragma unroll
        for (int dt = 0; dt < 4; ++dt) { f32x4 oc = o[qc][dt]; oc = mfma16(vf[dt][0], pf[0], oc); oc = mfma16(vf[dt][1], pf[1], oc); o[qc][dt] = oc; }
      }
    }
  }
#pragma unroll
  for (int qc = 0; qc < 4; ++qc) {
    const int tq = b * SEQL + (cn0 + qc) * 64 + iq;
    float lt = lrun[qc]; lt += __shfl_xor(lt, 16); lt += __shfl_xor(lt, 32);
    const float inv = 1.0f / lt; float ss = 0.f;
    bf16_t* dst = p.ATT + (size_t)tq * 512 + h * 64;
#pragma unroll
    for (int dt = 0; dt < 4; ++dt) { const f32x4 v = o[qc][dt] * inv; ss += v[0] * v[0] + v[1] * v[1] + v[2] * v[2] + v[3] * v[3];
      *(uint2*)(dst + dt * 16 + fq * 4) = make_uint2(pack2(v[0], v[1]), pack2(v[2], v[3])); }
    ss += __shfl_xor(ss, 16); ss += __shfl_xor(ss, 32);
    if (fq == 0) p.ss_att[tq * 8 + h] = ss;
  }
}

template <bool FINAL>
__device__ __forceinline__ void ssm_item(const Params& p, int item, char* lds) {
  const int g = item & 31, seg = (item >> 5) & 31, b = item >> 10;
  const int tid = threadIdx.x, lane = tid & 63, w = tid >> 6, fr = lane & 15, fq = lane >> 4;
  const int t0 = b * SEQL + seg * 256;
  const bf16_t* ug = p.Ub + ((size_t)(b * 32 + g) * SEQL + seg * 256) * 16;
  bf16x8 uf[8];
#pragma unroll
  for (int ks = 0; ks < 8; ++ks) uf[ks] = *(const bf16x8*)(ug + (size_t)(fr * 16 + 2 * ks + (fq >> 1)) * 16 + (fq & 1) * 8);
  f32x4 er = (f32x4){0.f, 0.f, 0.f, 0.f}, ei = er;
  const bf16_t* we = p.WE16 + ((size_t)(g * 4 + w) * 2 * 8 * 64 + lane) * 8;
#pragma unroll
  for (int ks = 0; ks < 8; ++ks) { const bf16x8 br = *(const bf16x8*)(we + ks * 512), bi = *(const bf16x8*)(we + 4096 + ks * 512); er = mfma16(uf[ks], br, er); ei = mfma16(uf[ks], bi, ei); }
  const int gp = g * 64 + w * 16 + fr;
  const float a16r = p.APW[gp], a16i = p.APW[2048 + gp];
  float xr[4], xi[4];
  xr[0] = er[0]; xi[0] = ei[0];
#pragma unroll
  for (int j = 1; j < 4; ++j) { xr[j] = a16r * xr[j - 1] - a16i * xi[j - 1] + er[j]; xi[j] = a16r * xi[j - 1] + a16i * xr[j - 1] + ei[j]; }
  float cr = 0.f, ci = 0.f;
  if (FINAL) {
    const float ar = p.APW[4 * 4096 + gp], ai = p.APW[4 * 4096 + 2048 + gp];
    const float* es = p.ESEG + ((size_t)(b * 32) * 32 + g) * 128 + w * 32 + fr;
    for (int j0 = 0; j0 < seg; j0 += 8) { float e_r[8], e_i[8];
#pragma unroll
      for (int u = 0; u < 8; ++u) { e_r[u] = es[(size_t)(j0 + u) * 32 * 128]; e_i[u] = es[(size_t)(j0 + u) * 32 * 128 + 16]; }
#pragma unroll
      for (int u = 0; u < 8; ++u) if (j0 + u < seg) { const float nr = ar * cr - ai * ci + e_r[u], ni = ar * ci + ai * cr + e_i[u]; cr = nr; ci = ni; } }
  }
  const float a64r = p.APW[3 * 4096 + gp], a64i = p.APW[3 * 4096 + 2048 + gp];
  float tr = xr[3], ti = xi[3];
#pragma unroll
  for (int r = 0; r < 4; ++r) {
    float pr_ = __shfl(tr, (lane + 48) & 63), pi_ = __shfl(ti, (lane + 48) & 63);
    if (r == 0) { pr_ = cr; pi_ = ci; }
    if (fq == r) { const float nr = xr[3] + a64r * pr_ - a64i * pi_, ni = xi[3] + a64r * pi_ + a64i * pr_; tr = nr; ti = ni; }
  }
  if (!FINAL) {
    if (fq == 3) { float* es = p.ESEG + ((size_t)(b * 32 + seg) * 32 + g) * 128 + w * 32 + fr; es[0] = tr; es[16] = ti; }
    return;
  }
  float gr = __shfl(tr, (lane + 48) & 63), gi = __shfl(ti, (lane + 48) & 63);
  if (fq == 0) { gr = cr; gi = ci; }
  float pvr[4], pvi[4];
  pvr[0] = gr; pvi[0] = gi;
#pragma unroll
  for (int j = 1; j < 4; ++j) { const float ar = p.APW[(j - 1) * 4096 + gp], ai = p.APW[(j - 1) * 4096 + 2048 + gp]; pvr[j] = xr[j - 1] + ar * gr - ai * gi; pvi[j] = xi[j - 1] + ar * gi + ai * gr; }
  bf16_t* xl = (bf16_t*)lds;
  __syncthreads();
#pragma unroll
  for (int j = 0; j < 4; ++j) { xl[(fq * 4 + j) * 136 + w * 32 + fr] = f2bf(pvr[j]); xl[(fq * 4 + j) * 136 + w * 32 + 16 + fr] = f2bf(pvi[j]); }
  __syncthreads();
  bf16x8 xf[4];
#pragma unroll
  for (int ks = 0; ks < 4; ++ks) xf[ks] = *(const bf16x8*)(xl + fr * 136 + ks * 32 + fq * 8);
#pragma unroll
  for (int mi = 0; mi < 4; ++mi) {
    const int mt = w * 4 + mi;
    const bf16_t* wy = p.WY + ((size_t)(g * 16 + mt) * 12 * 64 + lane) * 8;
    f32x4 y = (f32x4){0.f, 0.f, 0.f, 0.f};
#pragma unroll
    for (int ks = 0; ks < 4; ++ks) y = mfma16(*(const bf16x8*)(wy + ks * 512), xf[ks], y);
#pragma unroll
    for (int ks = 0; ks < 8; ++ks) if (2 * ks <= mt) y = mfma16(*(const bf16x8*)(wy + (4 + ks) * 512), uf[ks], y);
    const size_t tok = (size_t)(t0 + fr * 16 + mt);
    const uint2 uu = *(const uint2*)(ug + (size_t)(fr * 16 + mt) * 16 + fq * 4);
    const float4 dd = *(const float4*)(p.d_skip + g * 16 + fq * 4);
    const float y0 = gelu_f(y[0] + dd.x * __uint_as_float(uu.x << 16)), y1 = gelu_f(y[1] + dd.y * __uint_as_float(uu.x & 0xffff0000u));
    const float y2 = gelu_f(y[2] + dd.z * __uint_as_float(uu.y << 16)), y3 = gelu_f(y[3] + dd.w * __uint_as_float(uu.y & 0xffff0000u));
    *(uint2*)(p.YG + tok * 512 + g * 16 + fq * 4) = make_uint2(pack2(y0, y1), pack2(y2, y3));
  }
}

__device__ __forceinline__ void ssm_final_pair(const Params& p, int item, char* lds) {
  const int g = item & 31, sp = (item >> 5) & 15, b = item >> 9;
  const int tid = threadIdx.x, lane = tid & 63, w = tid >> 6, fr = lane & 15, fq = lane >> 4;
  const int gp = g * 64 + w * 16 + fr;
  const bf16_t* ug0 = p.Ub + ((size_t)(b * 32 + g) * SEQL + sp * 512) * 16;
  bf16x8 uf[2][8];
#pragma unroll
  for (int q = 0; q < 2; ++q)
#pragma unroll
    for (int ks = 0; ks < 8; ++ks) uf[q][ks] = *(const bf16x8*)(ug0 + (size_t)(q * 256 + fr * 16 + 2 * ks + (fq >> 1)) * 16 + (fq & 1) * 8);
  f32x4 er[2], ei[2];
#pragma unroll
  for (int q = 0; q < 2; ++q) { er[q] = (f32x4){0.f, 0.f, 0.f, 0.f}; ei[q] = er[q]; }
  const bf16_t* we = p.WE16 + ((size_t)(g * 4 + w) * 2 * 8 * 64 + lane) * 8;
#pragma unroll
  for (int ks = 0; ks < 8; ++ks) { const bf16x8 br = *(const bf16x8*)(we + ks * 512), bi = *(const bf16x8*)(we + 4096 + ks * 512);
#pragma unroll
    for (int q = 0; q < 2; ++q) { er[q] = mfma16(uf[q][ks], br, er[q]); ei[q] = mfma16(uf[q][ks], bi, ei[q]); } }
  const float a16r = p.APW[gp], a16i = p.APW[2048 + gp];
  const float a64r = p.APW[3 * 4096 + gp], a64i = p.APW[3 * 4096 + 2048 + gp];
  const float a256r = p.APW[4 * 4096 + gp], a256i = p.APW[4 * 4096 + 2048 + gp];
  float cr[2], ci[2]; cr[0] = 0.f; ci[0] = 0.f;
  const float* es = p.ESEG + ((size_t)(b * 32) * 32 + g) * 128 + w * 32 + fr;
  const int seg0 = sp * 2;
  for (int j0 = 0; j0 < seg0; j0 += 8) { float e_r[8], e_i[8];
#pragma unroll
    for (int u = 0; u < 8; ++u) { e_r[u] = es[(size_t)(j0 + u) * 32 * 128]; e_i[u] = es[(size_t)(j0 + u) * 32 * 128 + 16]; }
#pragma unroll
    for (int u = 0; u < 8; ++u) if (j0 + u < seg0) { const float nr = a256r * cr[0] - a256i * ci[0] + e_r[u], ni = a256r * ci[0] + a256i * cr[0] + e_i[u]; cr[0] = nr; ci[0] = ni; } }
  { const float e_r = es[(size_t)seg0 * 32 * 128], e_i = es[(size_t)seg0 * 32 * 128 + 16]; cr[1] = a256r * cr[0] - a256i * ci[0] + e_r; ci[1] = a256r * ci[0] + a256i * cr[0] + e_i; }
  bf16_t* xl = (bf16_t*)lds;
  __syncthreads();
#pragma unroll
  for (int q = 0; q < 2; ++q) {
    float xr[4], xi[4];
    xr[0] = er[q][0]; xi[0] = ei[q][0];
#pragma unroll
    for (int j = 1; j < 4; ++j) { xr[j] = a16r * xr[j - 1] - a16i * xi[j - 1] + er[q][j]; xi[j] = a16r * xi[j - 1] + a16i * xr[j - 1] + ei[q][j]; }
    float tr = xr[3], ti = xi[3];
#pragma unroll
    for (int r = 0; r < 4; ++r) {
      float pr_ = __shfl(tr, (lane + 48) & 63), pi_ = __shfl(ti, (lane + 48) & 63);
      if (r == 0) { pr_ = cr[q]; pi_ = ci[q]; }
      if (fq == r) { const float nr = xr[3] + a64r * pr_ - a64i * pi_, ni = xi[3] + a64r * pi_ + a64i * pr_; tr = nr; ti = ni; }
    }
    float gr = __shfl(tr, (lane + 48) & 63), gi = __shfl(ti, (lane + 48) & 63);
    if (fq == 0) { gr = cr[q]; gi = ci[q]; }
    float pvr[4], pvi[4];
    pvr[0] = gr; pvi[0] = gi;
#pragma unroll
    for (int j = 1; j < 4; ++j) { const float ar = p.APW[(j - 1) * 4096 + gp], ai = p.APW[(j - 1) * 4096 + 2048 + gp]; pvr[j] = xr[j - 1] + ar * gr - ai * gi; pvi[j] = xi[j - 1] + ar * gi + ai * gr; }
#pragma unroll
    for (int j = 0; j < 4; ++j) { xl[q * 2176 + (fq * 4 + j) * 136 + w * 32 + fr] = f2bf(pvr[j]); xl[q * 2176 + (fq * 4 + j) * 136 + w * 32 + 16 + fr] = f2bf(pvi[j]); }
  }
  __syncthreads();
  bf16x8 xf[2][4];
#pragma unroll
  for (int q = 0; q < 2; ++q)
#pragma unroll
    for (int ks = 0; ks < 4; ++ks) xf[q][ks] = *(const bf16x8*)(xl + q * 2176 + fr * 136 + ks * 32 + fq * 8);
  const float4 dd = *(const float4*)(p.d_skip + g * 16 + fq * 4);
#pragma unroll
  for (int mi = 0; mi < 4; ++mi) {
    const int mt = w * 4 + mi;
    const bf16_t* wy = p.WY + ((size_t)(g * 16 + mt) * 12 * 64 + lane) * 8;
    f32x4 y[2]; y[0] = (f32x4){0.f, 0.f, 0.f, 0.f}; y[1] = y[0];
#pragma unroll
    for (int ks = 0; ks < 4; ++ks) { const bf16x8 a = *(const bf16x8*)(wy + ks * 512); y[0] = mfma16(a, xf[0][ks], y[0]); y[1] = mfma16(a, xf[1][ks], y[1]); }
#pragma unroll
    for (int ks = 0; ks < 8; ++ks) if (2 * ks <= mt) { const bf16x8 a = *(const bf16x8*)(wy + (4 + ks) * 512); y[0] = mfma16(a, uf[0][ks], y[0]); y[1] = mfma16(a, uf[1][ks], y[1]); }
#pragma unroll
    for (int q = 0; q < 2; ++q) {
      const size_t tok = (size_t)(b * SEQL + sp * 512 + q * 256 + fr * 16 + mt);
      const uint2 uu = *(const uint2*)(ug0 + (size_t)(q * 256 + fr * 16 + mt) * 16 + fq * 4);
      const float y0 = gelu_f(y[q][0] + dd.x * __uint_as_float(uu.x << 16)), y1 = gelu_f(y[q][1] + dd.y * __uint_as_float(uu.x & 0xffff0000u));
      const float y2 = gelu_f(y[q][2] + dd.z * __uint_as_float(uu.y << 16)), y3 = gelu_f(y[q][3] + dd.w * __uint_as_float(uu.y & 0xffff0000u));
      *(uint2*)(p.YG + tok * 512 + g * 16 + fq * 4) = make_uint2(pack2(y0, y1), pack2(y2, y3)); }
  }
}

__device__ __forceinline__ void tile_glu(const Params& p, int tile, char* lds) {
  const int rt = tile >> 2, ct = tile & 3; const int row0 = rt * 128, col0 = ct * 128;
  f32x4 acc[4][4];
  gemm_mainloop<true>(acc, p.YG, 512, p.WtGlu, 512, 512, row0, col0, lds);
  EPI_IDS
  const int cw = col0 + wc * 64;
#pragma unroll
  for (int m = 0; m < 4; ++m) {
    const int row = row0 + wr * 64 + m * 16 + fr; float ss = 0.f;
#pragma unroll
    for (int n = 0; n < 4; ++n) { const int c = cw + n * 16 + fq * 4; const float4 bg = *(const float4*)(p.b_glu + c); const uint2 yy = *(const uint2*)(p.YG + (size_t)row * 512 + c);
      const float y0 = __uint_as_float(yy.x << 16), y1 = __uint_as_float(yy.x & 0xffff0000u), y2 = __uint_as_float(yy.y << 16), y3 = __uint_as_float(yy.y & 0xffff0000u);
      const float o0 = y0 / (1.f + __expf(-(acc[m][n][0] + bg.x))), o1 = y1 / (1.f + __expf(-(acc[m][n][1] + bg.y))), o2 = y2 / (1.f + __expf(-(acc[m][n][2] + bg.z))), o3 = y3 / (1.f + __expf(-(acc[m][n][3] + bg.w)));
      ss += o0 * o0 + o1 * o1 + o2 * o2 + o3 * o3;
      *(uint2*)(p.SSMO + (size_t)row * 512 + c) = make_uint2(pack2(o0, o1), pack2(o2, o3)); }
    ss += __shfl_xor(ss, 16); ss += __shfl_xor(ss, 32);
    if (fq == 0) p.ss_ssm[row * 8 + (cw >> 6)] = ss;
  }
}
__device__ __forceinline__ void tile_wout(const Params& p, int tile, char* lds) {
  const int rt = tile >> 3, ct = tile & 7; const int row0 = rt * 128, col0 = ct * 128;
  f32x4 acc[4][4];
  float s1[4];
  gemm_mainloop<true>(acc, p.ATT, 512, p.WtOut, 1024, 512, row0, col0, lds);
  { const int lane_ = threadIdx.x & 63, w_ = threadIdx.x >> 6;
#pragma unroll
    for (int m = 0; m < 4; ++m) { const int row = row0 + (w_ >> 1) * 64 + m * 16 + (lane_ & 15); float a = 0.f, c = 0.f;
      { const float4* qa = (const float4*)(p.ss_att + (size_t)row * 8); const float4* qc = (const float4*)(p.ss_ssm + (size_t)row * 8); const float4 a0 = qa[0], a1 = qa[1], c0 = qc[0], c1 = qc[1];
        a = ((a0.x + a0.y) + (a0.z + a0.w)) + ((a1.x + a1.y) + (a1.z + a1.w)); c = ((c0.x + c0.y) + (c0.z + c0.w)) + ((c1.x + c1.y) + (c1.z + c1.w)); }
      const float ra = rsqrtf(a * (1.0f / 512.0f) + EPSF); s1[m] = rsqrtf(c * (1.0f / 512.0f) + EPSF); const float f = ra / s1[m];
#pragma unroll
      for (int n = 0; n < 4; ++n) acc[m][n] *= f; } }
  gemm_mainloop<false>(acc, p.SSMO, 512, p.WtOut + 512, 1024, 512, row0, col0, lds);
  EPI_IDS
  const int cw = col0 + wc * 64;
#pragma unroll
  for (int m = 0; m < 4; ++m) {
    const int row = row0 + wr * 64 + m * 16 + fr; float ss = 0.f;
#pragma unroll
    for (int n = 0; n < 4; ++n) { const int c = cw + n * 16 + fq * 4; const f32x4 xv = *(const f32x4*)(p.x + (size_t)row * 1024 + c); const f32x4 hv = xv + acc[m][n] * s1[m];
      ss += hv[0] * hv[0] + hv[1] * hv[1] + hv[2] * hv[2] + hv[3] * hv[3];
      *(uint2*)(p.H1B + (size_t)row * 1024 + c) = make_uint2(pack2(hv[0], hv[1]), pack2(hv[2], hv[3])); }
    ss += __shfl_xor(ss, 16); ss += __shfl_xor(ss, 32);
    if (fq == 0) p.ss_h1[row * 16 + (cw >> 6)] = ss;
  }
}
__device__ __forceinline__ float row_rs16(const float* ss, int row) {
  const float4* q = (const float4*)(ss + (size_t)row * 16); const float4 a = q[0], b = q[1], c = q[2], d = q[3];
  const float t = ((a.x + a.y) + (a.z + a.w)) + ((b.x + b.y) + (b.z + b.w)) + ((c.x + c.y) + (c.z + c.w)) + ((d.x + d.y) + (d.z + d.w));
  return rsqrtf(t * (1.0f / 1024.0f) + EPSF); }
__device__ __forceinline__ void tile_memq(const Params& p, int tile, char* lds) {
  const int rt = tile >> 3, ct = tile & 7; const int row0 = rt * 128, col0 = ct * 128;
  f32x4 acc[4][4];
  gemm_mainloop<true>(acc, p.H1B, 1024, p.WtMq, 1024, 1024, row0, col0, lds);
  EPI_IDS
  const int cw = col0 + wc * 64;
#pragma unroll
  for (int m = 0; m < 4; ++m) {
    const int row = row0 + wr * 64 + m * 16 + fr; const float rs = row_rs16(p.ss_h1, row); float ss = 0.f;
#pragma unroll
    for (int n = 0; n < 4; ++n) { const int c = cw + n * 16 + fq * 4; const f32x4 v = acc[m][n] * rs; ss += v[0] * v[0] + v[1] * v[1] + v[2] * v[2] + v[3] * v[3];
      *(uint2*)(p.QM + (size_t)row * 1024 + c) = make_uint2(pack2(v[0], v[1]), pack2(v[2], v[3])); }
    ss += __shfl_xor(ss, 16); ss += __shfl_xor(ss, 32);
    if (fq == 0) p.ss_qm[row * 16 + (cw >> 6)] = ss;
  }
}
__device__ __forceinline__ void mem_stage(const bf16_t* kg, const bf16_t* vg, int kc, LAS char* buf, int w, int lane) {
  const int wb = __builtin_amdgcn_readfirstlane(w) * 4096;
#pragma unroll
  for (int i = 0; i < 4; ++i) {
    const int row = w * 8 + i * 2 + (lane >> 5), pos = lane & 31; const int ch = pos ^ (row & 15);
    __builtin_amdgcn_global_load_lds((const GAS void*)(kg + (size_t)(kc * 32 + row) * 256 + ch * 8), (LAS void*)(buf + wb + i * 1024), 16, 0, 0);
  }
#pragma unroll
  for (int i = 0; i < 4; ++i) {
    const int d = w * 64 + i * 16 + (lane >> 2), pos = lane & 3; const int ch = pos ^ ((d >> 2) & 3);
    __builtin_amdgcn_global_load_lds((const GAS void*)(vg + (size_t)d * 256 + kc * 32 + ch * 8), (LAS void*)(buf + 16384 + wb + i * 1024), 16, 0, 0);
  }
}
__device__ __forceinline__ void mem_attn_item(const Params& p, int item, char* lds_) {
  LAS char* lds = (LAS char*)lds_;
  typedef unsigned u32x2 __attribute__((ext_vector_type(2)));
  const int h = item & 3, tt = item >> 2; const int tid = threadIdx.x, lane = tid & 63, w = tid >> 6, fr = lane & 15, fq = lane >> 4;
  const int tq = tt * 64 + w * 16 + fr; const int b = tq >> 13;
  const bf16_t* kg = p.KMB + (size_t)(b * 4 + h) * 256 * 256;
  const bf16_t* vg = p.VMT + (size_t)(b * 4 + h) * 256 * 256;
  __syncthreads();
  mem_stage(kg, vg, 0, lds, w, lane);
  const float ssq = p.ss_qm[tq * 16 + h * 4] + p.ss_qm[tq * 16 + h * 4 + 1] + p.ss_qm[tq * 16 + h * 4 + 2] + p.ss_qm[tq * 16 + h * 4 + 3];
  const float rowscale = rsqrtf(ssq * (1.0f / 256.0f) + EPSF) * 0.0625f * 1.44269504f;
  const float shf = p.SHF[8];
  bf16x8 qf[8];
#pragma unroll
  for (int ks = 0; ks < 8; ++ks) qf[ks] = *(const bf16x8*)(p.QM + (size_t)tq * 1024 + h * 256 + ks * 32 + fq * 8);
  f32x4 o[16];
#pragma unroll
  for (int i = 0; i < 16; ++i) o[i] = (f32x4){0.f, 0.f, 0.f, 0.f};
  float lrun = 0.f;
  asm volatile("s_waitcnt vmcnt(0)" ::: "memory");
  __syncthreads();
  for (int kc = 0; kc < 8; ++kc) {
    LAS char* cur = lds + (kc & 1) * 32768; LAS char* nxt = lds + ((kc + 1) & 1) * 32768;
    if (kc + 1 < 8) mem_stage(kg, vg, kc + 1, nxt, w, lane);
    f32x4 st[2];
#pragma unroll
    for (int mt = 0; mt < 2; ++mt) { f32x4 sacc = (f32x4){0.f, 0.f, 0.f, 0.f}; const int row = mt * 16 + fr;
#pragma unroll
      for (int ks = 0; ks < 8; ++ks) sacc = mfma16(as_bf(*(const LAS u32x4*)(cur + row * 512 + (((ks * 4 + fq) ^ (row & 15)) << 4))), qf[ks], sacc);
      st[mt] = sacc * rowscale - shf; }
    float ls = 0.f;
#pragma unroll
    for (int mt = 0; mt < 2; ++mt)
#pragma unroll
      for (int j = 0; j < 4; ++j) { const float e = __builtin_amdgcn_exp2f(st[mt][j]); st[mt][j] = e; ls += e; }
    lrun += ls;
    u32x4 t; t.x = pack2(st[0][0], st[0][1]); t.y = pack2(st[0][2], st[0][3]); t.z = pack2(st[1][0], st[1][1]); t.w = pack2(st[1][2], st[1][3]);
    const bf16x8 pf = as_bf(t);
#pragma unroll
    for (int dt = 0; dt < 16; ++dt) { const int d = dt * 16 + fr; const int sw = ((d >> 2) & 3) << 1;
      const u32x2 lo = *(const LAS u32x2*)(cur + 16384 + d * 64 + ((fq ^ sw) << 3)), hi = *(const LAS u32x2*)(cur + 16384 + d * 64 + (((fq + 4) ^ sw) << 3));
      u32x4 vv; vv.x = lo.x; vv.y = lo.y; vv.z = hi.x; vv.w = hi.y; o[dt] = mfma16(as_bf(vv), pf, o[dt]); }
    asm volatile("s_waitcnt vmcnt(0)" ::: "memory");
    __syncthreads();
  }
  float lt = lrun; lt += __shfl_xor(lt, 16); lt += __shfl_xor(lt, 32);
  const float inv = 1.0f / lt;
  bf16_t* dst = p.OM + (size_t)tq * 1024 + h * 256;
#pragma unroll
  for (int dt = 0; dt < 16; ++dt) { const f32x4 v = o[dt] * inv; *(uint2*)(dst + dt * 16 + fq * 4) = make_uint2(pack2(v[0], v[1]), pack2(v[2], v[3])); }
}
__device__ __forceinline__ void tile_memo(const Params& p, int tile, char* lds) {
  const int rt = tile >> 3, ct = tile & 7; const int row0 = rt * 128, col0 = ct * 128;
  f32x4 acc[4][4];
  gemm_mainloop<true>(acc, p.OM, 1024, p.WtMo, 1024, 1024, row0, col0, lds);
  EPI_IDS
  const int cw = col0 + wc * 64;
#pragma unroll
  for (int m = 0; m < 4; ++m) {
    const int row = row0 + wr * 64 + m * 16 + fr; float ss = 0.f;
#pragma unroll
    for (int n = 0; n < 4; ++n) { const int c = cw + n * 16 + fq * 4; const uint2 hb = *(const uint2*)(p.H1B + (size_t)row * 1024 + c);
      const f32x4 hv = (f32x4){__uint_as_float(hb.x << 16), __uint_as_float(hb.x & 0xffff0000u), __uint_as_float(hb.y << 16), __uint_as_float(hb.y & 0xffff0000u)} + acc[m][n];
      ss += hv[0] * hv[0] + hv[1] * hv[1] + hv[2] * hv[2] + hv[3] * hv[3];
      *(uint2*)(p.H2B + (size_t)row * 1024 + c) = make_uint2(pack2(hv[0], hv[1]), pack2(hv[2], hv[3])); }
    ss += __shfl_xor(ss, 16); ss += __shfl_xor(ss, 32);
    if (fq == 0) p.ss_h2[row * 16 + (cw >> 6)] = ss;
  }
}
__device__ __forceinline__ float fmax_raw(float a, float b) { float r; asm("v_max_f32 %0, %1, %2" : "=v"(r) : "v"(a), "v"(b)); return r; }
__device__ __forceinline__ float fmin_raw(float a, float b) { float r; asm("v_min_f32 %0, %1, %2" : "=v"(r) : "v"(a), "v"(b)); return r; }
__device__ __forceinline__ void ce_desc(float& x, float& y) { const float hi = fmax_raw(x, y), lo = fmin_raw(x, y); x = hi; y = lo; }
__device__ __forceinline__ void sort16_desc(float (&a)[16]) {
#pragma unroll
  for (int k = 2; k <= 16; k <<= 1)
#pragma unroll
    for (int j = k >> 1; j > 0; j >>= 1)
#pragma unroll
      for (int i = 0; i < 16; ++i) { const int l = i ^ j; if (l > i) { if ((i & k) == 0) ce_desc(a[i], a[l]); else ce_desc(a[l], a[i]); } }
}
__device__ __forceinline__ void merge16_desc(float (&a)[16], const float (&b)[16]) {
#pragma unroll
  for (int i = 0; i < 16; ++i) a[i] = fmax_raw(a[i], b[15 - i]);
#pragma unroll
  for (int j = 8; j > 0; j >>= 1)
#pragma unroll
    for (int i = 0; i < 16; ++i) { const int l = i ^ j; if (l > i) ce_desc(a[i], a[l]); }
}
__device__ __forceinline__ void ins16(float (&a)[16], float v) {
#pragma unroll
  for (int i = 0; i < 16; ++i) { const float hi = fmax_raw(a[i], v), lo = fmin_raw(a[i], v); a[i] = hi; v = lo; }
}
__device__ __forceinline__ void peer_fold_tile(const Params& p, int tile, char* lds) {
  const int hs = tile >> 3, ct = tile & 7; const int col0 = ct * 128;
  f32x4 acc[4][4];
  gemm_mainloop<true>(acc, p.PK + (size_t)hs * 128 * 128, 128, p.WPQ + hs * 128, 2048, 128, 0, col0, lds);
  EPI_IDS
#pragma unroll
  for (int m = 0; m < 4; ++m) { const int n_ = wr * 64 + m * 16 + fr;
#pragma unroll
    for (int n = 0; n < 4; ++n) { const int k = col0 + wc * 64 + n * 16 + fq * 4;
      *(uint2*)(p.WtPq + (size_t)(hs * 128 + n_) * 1024 + k) = make_uint2(pack2(acc[m][n][0], acc[m][n][1]), pack2(acc[m][n][2], acc[m][n][3])); } }
}
__device__ __forceinline__ void tile_peer(const Params& p, int tile, char* lds_) {
  const int rt = tile >> 4, hs = tile & 15; const int row0 = rt * 128, col0 = hs * 128;
  f32x4 acc[4][4];
  gemm_mainloop<true>(acc, p.H2B, 1024, p.WtPq, 1024, 1024, row0, col0, lds_);
  LAS char* lds = (LAS char*)lds_;
  EPI_IDS
#pragma unroll
  for (int m = 0; m < 4; ++m) { const float rs = row_rs16(p.ss_h2, row0 + wr * 64 + m * 16 + fr);
#pragma unroll
    for (int n = 0; n < 4; ++n) acc[m][n] *= rs; }
  LAS float* L = (LAS float*)lds;
#pragma unroll
  for (int m = 0; m < 4; ++m) {
    float a[16], b[16];
#pragma unroll
    for (int n = 0; n < 4; ++n)
#pragma unroll
      for (int j = 0; j < 4; ++j) a[n * 4 + j] = __uint_as_float((__float_as_uint(acc[m][n][j]) & ~127u) | (unsigned)(wc * 64 + n * 16 + fq * 4 + j));
    sort16_desc(a);
#pragma unroll
    for (int i = 0; i < 16; ++i) b[i] = __shfl_xor(a[i], 16);
    merge16_desc(a, b);
#pragma unroll
    for (int i = 0; i < 16; ++i) b[i] = __shfl_xor(a[i], 32);
    merge16_desc(a, b);
    const int r = wr * 64 + m * 16 + fr;
    f32x4 o; o[0] = fq == 0 ? a[0] : fq == 1 ? a[4] : fq == 2 ? a[8] : a[12]; o[1] = fq == 0 ? a[1] : fq == 1 ? a[5] : fq == 2 ? a[9] : a[13];
    o[2] = fq == 0 ? a[2] : fq == 1 ? a[6] : fq == 2 ? a[10] : a[14]; o[3] = fq == 0 ? a[3] : fq == 1 ? a[7] : fq == 2 ? a[11] : a[15];
    *(LAS f32x4*)(L + (r * 2 + wc) * 16 + fq * 4) = o;
  }
  __syncthreads();
#pragma unroll
  for (int mi = 0; mi < 2; ++mi) { const int m = wc * 2 + mi; const int r = wr * 64 + m * 16 + fr;
    float a[16], b[16];
#pragma unroll
    for (int q = 0; q < 4; ++q) { const f32x4 va = *(const LAS f32x4*)(L + (r * 2 + 0) * 16 + q * 4), vb = *(const LAS f32x4*)(L + (r * 2 + 1) * 16 + q * 4);
      a[q * 4] = va[0]; a[q * 4 + 1] = va[1]; a[q * 4 + 2] = va[2]; a[q * 4 + 3] = va[3]; b[q * 4] = vb[0]; b[q * 4 + 1] = vb[1]; b[q * 4 + 2] = vb[2]; b[q * 4 + 3] = vb[3]; }
    merge16_desc(a, b);
    u32x4 o; o.x = __float_as_uint(fq == 0 ? a[0] : fq == 1 ? a[4] : fq == 2 ? a[8] : a[12]); o.y = __float_as_uint(fq == 0 ? a[1] : fq == 1 ? a[5] : fq == 2 ? a[9] : a[13]);
    o.z = __float_as_uint(fq == 0 ? a[2] : fq == 1 ? a[6] : fq == 2 ? a[10] : a[14]); o.w = __float_as_uint(fq == 0 ? a[3] : fq == 1 ? a[7] : fq == 2 ? a[11] : a[15]);
    *(u32x4*)(p.TOPS + ((size_t)(row0 + r) * 16 + hs) * 16 + fq * 4) = o;
  }
}
__device__ __forceinline__ void peer_gather_item(const Params& p, int item, char* lds_) {
  LAS char* lds = (LAS char*)lds_;
  const int tid = threadIdx.x, lane = tid & 63, w = tid >> 6;
  LAS unsigned* LA = (LAS unsigned*)lds;
  LAS int* LE = (LAS int*)(lds + 256 * 33 * 4);
  LAS float* LG = (LAS float*)(lds + 256 * 33 * 4 + 32 * 128 * 4);
  __syncthreads();
  {
    const int tl_ = tid >> 3, h = tid & 7; const int t = item * 32 + tl_;
    const uint4* src = (const uint4*)(p.TOPS + ((size_t)t * 16 + h * 2) * 16);
    float a[16], bq[16];
#pragma unroll
    for (int i = 0; i < 4; ++i) { const uint4 v = src[i]; a[4 * i] = __uint_as_float(v.x); a[4 * i + 1] = __uint_as_float(v.y); a[4 * i + 2] = __uint_as_float(v.z); a[4 * i + 3] = __uint_as_float(v.w); }
#pragma unroll
    for (int i = 0; i < 4; ++i) { const uint4 v = src[4 + i]; bq[4 * i] = __uint_as_float(v.x); bq[4 * i + 1] = __uint_as_float(v.y); bq[4 * i + 2] = __uint_as_float(v.z); bq[4 * i + 3] = __uint_as_float(v.w); }
#pragma unroll
    for (int i = 0; i < 16; ++i) { LA[tid * 33 + i] = __float_as_uint(a[i]); LA[tid * 33 + 16 + i] = __float_as_uint(bq[i]); }
    float c[16];
#define PKSUM(I, J) __uint_as_float((__float_as_uint(a[I] + bq[J]) & ~255u) | (unsigned)((I) * 16 + (J)))
#pragma unroll
    for (int j = 0; j < 16; ++j) c[j] = PKSUM(0, j);
    { float r[16];
#pragma unroll
      for (int j = 0; j < 16; ++j) r[j] = (j < 8) ? PKSUM(1, j < 8 ? j : 0) : -__builtin_inff();
      merge16_desc(c, r);
#pragma unroll
      for (int j = 0; j < 16; ++j) r[j] = (j < 5) ? PKSUM(2, j < 5 ? j : 0) : -__builtin_inff();
      merge16_desc(c, r);
#pragma unroll
      for (int j = 0; j < 16; ++j) r[j] = (j < 4) ? PKSUM(3, j < 4 ? j : 0) : -__builtin_inff();
      merge16_desc(c, r);
#pragma unroll
      for (int j = 0; j < 16; ++j) r[j] = (j < 3) ? PKSUM(4, j < 3 ? j : 0) : -__builtin_inff();
      merge16_desc(c, r); }
#pragma unroll
    for (int i = 5; i < 16; ++i)
#pragma unroll
      for (int j = 0; j < 16; ++j) if ((i + 1) * (j + 1) <= 16) ins16(c, PKSUM(i, j));
    const float mx = c[0]; float e[16]; float sum = 0.f;
#pragma unroll
    for (int i = 0; i < 16; ++i) { e[i] = __expf(c[i] - mx); sum += e[i]; }
    const float inv = 1.0f / sum;
#pragma unroll
    for (int i = 0; i < 16; ++i) { const unsigned pos = __float_as_uint(c[i]) & 255u; const unsigned ia = LA[tid * 33 + (pos >> 4)] & 127u, ib = LA[tid * 33 + 16 + (pos & 15u)] & 127u;
      LE[tl_ * 128 + h * 16 + i] = (int)(ia * 128u + ib); LG[tl_ * 128 + h * 16 + i] = e[i] * inv; }
  }
  __syncthreads();
  LAS char* HQ = (LAS char*)LA;
  const int fr = lane & 15, fq = lane >> 4;
  for (int ti = 0; ti < 8; ++ti) {
    const int tl_ = w * 8 + ti; const int t = item * 32 + tl_;
    const float rs = row_rs16(p.ss_h2, t) * 16.0f;
    { const uint4 ha = *(const uint4*)(p.H2B + (size_t)t * 1024 + lane * 16), hb = *(const uint4*)(p.H2B + (size_t)t * 1024 + lane * 16 + 8);
      const unsigned hw[8] = {ha.x, ha.y, ha.z, ha.w, hb.x, hb.y, hb.z, hb.w}; u32x4 q;
#pragma unroll
      for (int i = 0; i < 4; ++i) { const float4 g = *(const float4*)(p.norm_peer_g + lane * 16 + 4 * i); int wd = 0;
        wd = __builtin_amdgcn_cvt_pk_fp8_f32(__uint_as_float(hw[2 * i] << 16) * rs * g.x, __uint_as_float(hw[2 * i] & 0xffff0000u) * rs * g.y, wd, false);
        wd = __builtin_amdgcn_cvt_pk_fp8_f32(__uint_as_float(hw[2 * i + 1] << 16) * rs * g.z, __uint_as_float(hw[2 * i + 1] & 0xffff0000u) * rs * g.w, wd, true); q[i] = (unsigned)wd; }
      *(LAS u32x4*)(HQ + tl_ * 1024 + lane * 16) = q; }
    f32x2 oa[8];
#pragma unroll
    for (int i = 0; i < 8; ++i) oa[i] = (f32x2){0.f, 0.f};
    typedef int i32x8 __attribute__((ext_vector_type(8)));
    typedef unsigned u32x2 __attribute__((ext_vector_type(2)));
    int er0, er1; u32x4 uq0[8], uq1[8]; u32x2 vqa0[8], vqb0[8], vqa1[8], vqb1[8]; float g40[4], su40[4], sv40[4], g41[4], su41[4], sv41[4];
#define PEER_LOADSET(S, BT) { const LAS int* LEb = LE + tl_ * 128 + (BT) * 16; const LAS float* LGb = LG + tl_ * 128 + (BT) * 16; er##S = LEb[fr]; \
      const unsigned char* ub = p.PU8 + (size_t)er##S * 512 + fq * 16; \
      _Pragma("unroll") for (int ks = 0; ks < 8; ++ks) uq##S[ks] = *(const u32x4*)(ub + ks * 64); \
      _Pragma("unroll") for (int x = 0; x < 8; ++x) { const int ex = __builtin_amdgcn_readlane(er##S, x); vqa##S[x] = *(const u32x2*)(p.PV8 + (size_t)ex * 512 + lane * 8); } \
      _Pragma("unroll") for (int x = 0; x < 8; ++x) { const int ex = __builtin_amdgcn_readlane(er##S, 8 + x); vqb##S[x] = *(const u32x2*)(p.PV8 + (size_t)ex * 512 + lane * 8); } \
      _Pragma("unroll") for (int j = 0; j < 4; ++j) { const int e4 = LEb[fq * 4 + j]; g4##S[j] = LGb[fq * 4 + j]; su4##S[j] = p.su[e4]; sv4##S[j] = p.sv[e4]; } }
#define PEER_V(VQ, X0) { _Pragma("unroll") for (int x = 0; x < 8; ++x) { const float wgt = __int_as_float(__builtin_amdgcn_readlane(__float_as_int(wg[((X0) + x) & 3]), (((X0) + x) >> 2) * 16)); \
        oa[0] += __builtin_amdgcn_cvt_scalef32_pk_f32_fp4(VQ[x].x, 1.0f, 0) * wgt; oa[1] += __builtin_amdgcn_cvt_scalef32_pk_f32_fp4(VQ[x].x, 1.0f, 1) * wgt; \
        oa[2] += __builtin_amdgcn_cvt_scalef32_pk_f32_fp4(VQ[x].x, 1.0f, 2) * wgt; oa[3] += __builtin_amdgcn_cvt_scalef32_pk_f32_fp4(VQ[x].x, 1.0f, 3) * wgt; \
        oa[4] += __builtin_amdgcn_cvt_scalef32_pk_f32_fp4(VQ[x].y, 1.0f, 0) * wgt; oa[5] += __builtin_amdgcn_cvt_scalef32_pk_f32_fp4(VQ[x].y, 1.0f, 1) * wgt; \
        oa[6] += __builtin_amdgcn_cvt_scalef32_pk_f32_fp4(VQ[x].y, 1.0f, 2) * wgt; oa[7] += __builtin_amdgcn_cvt_scalef32_pk_f32_fp4(VQ[x].y, 1.0f, 3) * wgt; } }
#define PEER_COMPUTE(S) { f32x4 acc = (f32x4){0.f, 0.f, 0.f, 0.f}; \
      _Pragma("unroll") for (int ks = 0; ks < 8; ++ks) { const u32x4 h0 = *(const LAS u32x4*)(HQ + tl_ * 1024 + ks * 128 + fq * 16), h1 = *(const LAS u32x4*)(HQ + tl_ * 1024 + ks * 128 + 64 + fq * 16); \
        i32x8 A, B; A[0] = (int)uq##S[ks].x; A[1] = (int)uq##S[ks].y; A[2] = (int)uq##S[ks].z; A[3] = (int)uq##S[ks].w; A[4] = 0; A[5] = 0; A[6] = 0; A[7] = 0; \
        B[0] = (int)h0.x; B[1] = (int)h0.y; B[2] = (int)h0.z; B[3] = (int)h0.w; B[4] = (int)h1.x; B[5] = (int)h1.y; B[6] = (int)h1.z; B[7] = (int)h1.w; \
        acc = __builtin_amdgcn_mfma_scale_f32_16x16x128_f8f6f4(A, B, acc, 4, 0, 0, 0x7f7f7f7f, 0, 0x7f7f7f7f); } \
      float wg[4]; \
      _Pragma("unroll") for (int j = 0; j < 4; ++j) wg[j] = g4##S[j] * gelu_f(acc[j] * su4##S[j] * 0.0625f) * sv4##S[j]; \
      PEER_V(vqa##S, 0) PEER_V(vqb##S, 8) }
    PEER_LOADSET(0, 0)
    for (int bt = 0; bt < 8; bt += 2) {
      PEER_LOADSET(1, bt + 1)
      __builtin_amdgcn_sched_barrier(0);
      PEER_COMPUTE(0)
      __builtin_amdgcn_sched_barrier(0);
      if (bt + 2 < 8) PEER_LOADSET(0, bt + 2)
      __builtin_amdgcn_sched_barrier(0);
      PEER_COMPUTE(1)
      __builtin_amdgcn_sched_barrier(0);
    }
    { const uint4 ha = *(const uint4*)(p.H2B + (size_t)t * 1024 + lane * 16), hb = *(const uint4*)(p.H2B + (size_t)t * 1024 + lane * 16 + 8);
      const unsigned hw[8] = {ha.x, ha.y, ha.z, ha.w, hb.x, hb.y, hb.z, hb.w};
      float* op = p.out + (size_t)t * 1024 + lane * 16;
#pragma unroll
      for (int i = 0; i < 4; ++i) { const f32x2 a = oa[2 * i], b = oa[2 * i + 1];
        *(float4*)(op + 4 * i) = make_float4(__uint_as_float(hw[2 * i] << 16) + a.x, __uint_as_float(hw[2 * i] & 0xffff0000u) + a.y, __uint_as_float(hw[2 * i + 1] << 16) + b.x, __uint_as_float(hw[2 * i + 1] & 0xffff0000u) + b.y); } }
  }
}

#define XCD_TILES(NCT, CALL) do { if ((nb & 7) == 0 && nb >= 8) { const int xcd_ = bid & 7, lb_ = bid >> 3, nlb_ = nb >> 3; \
    for (int i_ = lb_; i_ < 16 * (NCT); i_ += nlb_) { const int t = (xcd_ * 16 + i_ / (NCT)) * (NCT) + (i_ % (NCT)); CALL; } } \
  else { for (int t = bid; t < 128 * (NCT); t += nb) { CALL; } } } while (0)
template <int PH>
__device__ __forceinline__ void run_phase(const Params& p, char* lds, int bid, int nb) {
  if (PH == 0) {
    const int nt_in = 16 * 32, nt_glu = 8 * 8, nt_out = 16 * 16, nt_m = 16 * 16, nt_pq = 16 * 32;
    const int total = nt_in + nt_glu + nt_out + 4 * nt_m; (void)nt_pq;
    for (int t = bid; t < total; t += nb) {
      int i = t; float* tl = (float*)lds;
      if (i < nt_in) { transpose_tile(p.w_in, p.WtIn, 1024, 2048, i, p.norm_mix_g, p.norm_mix_g, 1024, tl); continue; } i -= nt_in;
      if (i < nt_glu) { transpose_tile(p.w_glu, p.WtGlu, 512, 512, i, nullptr, nullptr, 0, tl); continue; } i -= nt_glu;
      if (i < nt_out) { transpose_tile(p.w_out, p.WtOut, 1024, 1024, i, p.att_out_g, p.ssm_out_g, 512, tl); continue; } i -= nt_out;
      if (i < nt_m) { transpose_tile(p.w_mem_q, p.WtMq, 1024, 1024, i, p.norm_mem_g, p.norm_mem_g, 1024, tl); continue; } i -= nt_m;
      if (i < nt_m) { transpose_tile(p.w_mem_k, p.WtMk, 1024, 1024, i, p.norm_memkv_g, p.norm_memkv_g, 1024, tl); continue; } i -= nt_m;
      if (i < nt_m) { transpose_tile(p.w_mem_v, p.WtMv, 1024, 1024, i, p.norm_memkv_g, p.norm_memkv_g, 1024, tl); continue; } i -= nt_m;
      if (i < nt_m) { transpose_tile(p.w_mem_o, p.WtMo, 1024, 1024, i, nullptr, nullptr, 0, tl); continue; } i -= nt_m;
      (void)i; (void)tl;
    }
    for (size_t i8 = (size_t)bid * NTHREADS + threadIdx.x; i8 < (size_t)1024 * 2048 / 8; i8 += (size_t)nb * NTHREADS) {
      const float g = p.norm_peer_g[(i8 * 8) >> 11]; const float4 a = ((const float4*)p.w_peer_q)[2 * i8], b = ((const float4*)p.w_peer_q)[2 * i8 + 1];
      ((uint4*)p.WPQ)[i8] = make_uint4(pack2(a.x * g, a.y * g), pack2(a.z * g, a.w * g), pack2(b.x * g, b.y * g), pack2(b.z * g, b.w * g)); }
    convert_flat(p.peer_keys, p.PK, (size_t)16 * 128 * 128 / 8, bid, nb);
    rows_bf16_rs(p.x, p.XB, p.rs_x, T_TOK, bid, nb);
    rows_bf16_rs(p.mem, p.MEMB, p.rs_mem, 512, bid, nb);
    for (int i = bid * NTHREADS + threadIdx.x; i < 2048; i += nb * NTHREADS) ssm_stage1(p, i);
    if (bid == nb - 1 && threadIdx.x < 9) {
      const int hh = threadIdx.x; float sh;
      if (hh < 8) { float mb = -1e30f, gq = 0.f, gk = 0.f; for (int i = 0; i < 192; ++i) mb = fmaxf(mb, p.rel_bias[hh * 192 + i]);
        for (int i = 0; i < 64; ++i) { gq = fmaxf(gq, fabsf(p.att_q_g[i])); gk = fmaxf(gk, fabsf(p.att_k_g[i])); }
        sh = (mb + 8.0f * gq * gk * 1.02f) * 1.44269504f; }
      else { float g = 0.f; for (int i = 0; i < 256; ++i) g = fmaxf(g, fabsf(p.mem_q_g[i] * p.mem_k_g[i])); sh = 16.0f * g * 1.02f * 1.44269504f; }
      p.SHF[hh] = sh; }
  } else if (PH == 1) {
    XCD_TILES(16, { if (((t & 15) >> 2) == 2) tile_win_v(p, t, lds); else tile_win(p, t, lds); });
    ssm_stage2a(p, bid, nb);
    for (int t = bid; t < 128; t += nb) peer_fold_tile(p, t, lds);
  } else if (PH == 2) {
    for (int t = nb - 1 - bid; t < 64; t += nb) tile_memkv(p, t, lds);
    chunk_attn_prep(p, lds);
    if ((nb & 7) == 0 && nb >= 8) { const int xcd_ = bid & 7, lb_ = bid >> 3, nlb_ = nb >> 3;
      for (int i_ = lb_; i_ < 64; i_ += nlb_) chunk_attn_item(p, i_ * 8 + xcd_, lds); }
    else { for (int t = bid; t < 512; t += nb) chunk_attn_item(p, t, lds); }
    for (int t = bid; t < 2048; t += nb) ssm_item<false>(p, t, lds);
    rows_fp4<false>(p.peer_u, p.PU8, p.su, 16384, bid, nb);
    ssm_stage2b(p, bid, nb);
  } else if (PH == 3) {
    memk_fix(p, bid, nb);
    rows_fp4<false>(p.peer_v, p.PV8, p.sv, 16384, bid, nb);
    for (int t = bid; t < 1024; t += nb) ssm_final_pair(p, t, lds);
  } else if (PH == 4) {
    XCD_TILES(4, tile_glu(p, t, lds));
  } else if (PH == 5) {
    XCD_TILES(8, tile_wout(p, t, lds));
  } else if (PH == 6) {
    XCD_TILES(8, tile_memq(p, t, lds));
  } else if (PH == 7) {
    for (int t = bid; t < 1024; t += nb) mem_attn_item(p, t, lds);
  } else if (PH == 8) {
    XCD_TILES(8, tile_memo(p, t, lds));
  } else if (PH == 9) {
    XCD_TILES(16, tile_peer(p, t, lds));
  } else if (PH == 11) {
    for (int t = bid; t < 512; t += nb) peer_gather_item(p, t, lds);
  }
}

#if !MEGA
template <int PH>
__global__ void __launch_bounds__(NTHREADS, 2) phase_kernel(Params p) {
  extern __shared__ __attribute__((aligned(16))) char lds[];
  run_phase<PH>(p, lds, blockIdx.x, gridDim.x);
}

#endif
#ifndef REPEAT_PH
#define REPEAT_PH -1
#endif
#define RUNPH(k) do { run_phase<k>(p, lds, bid, nb); if (REPEAT_PH == k) { xcd_barrier(xb); run_phase<k>(p, lds, bid, nb); } } while (0)
__global__ void __launch_bounds__(NTHREADS, 2) mega_kernel(Params p) {
  extern __shared__ __attribute__((aligned(16))) char lds[];
  const int bid = blockIdx.x, nb = gridDim.x;
  volatile LAS unsigned* stw = (volatile LAS unsigned*)((LAS char*)lds + LDS_WORK);
  if (threadIdx.x == 0) { stw[0] = 0u; stw[1] = 0u; stw[2] = 0u; stw[3] = 0u; }
  __syncthreads();
  XcdBarrier xb = xcd_barrier_post(p.bar, stw);
  RUNPH(0); xcd_barrier(xb);
  RUNPH(1); xcd_barrier(xb);
  RUNPH(2); xcd_barrier(xb);
  RUNPH(3); xcd_barrier(xb);
  RUNPH(4); xcd_barrier(xb);
  RUNPH(5); xcd_barrier(xb);
  RUNPH(6); xcd_barrier(xb);
  RUNPH(7); xcd_barrier(xb);
  RUNPH(8); xcd_barrier(xb);
  RUNPH(9); xcd_barrier(xb);
  RUNPH(11);
}

#if !MEGA
template <int PH> static void launch_phase(const Params& p, int grid, hipStream_t s) {
  hipFuncSetAttribute((const void*)phase_kernel<PH>, hipFuncAttributeMaxDynamicSharedMemorySize, LDS_BYTES);
  phase_kernel<PH><<<grid, NTHREADS, LDS_BYTES, s>>>(p);
}
#endif

extern "C" void kernel_launch(void* const* d_in, const int* in_sizes, int n_in, void* d_out, int out_size, void* d_ws, size_t ws_size, hipStream_t stream) {
  Params p{};
  const float** f = (const float**)&p;
  for (int i = 0; i < 33; ++i) f[i] = (const float*)d_in[i];
  p.out = (float*)d_out;
  char* ws = (char*)d_ws; size_t off = 0;
  auto take = [&](size_t bytes) { char* r = ws + off; off += (bytes + 255) & ~(size_t)255; return r; };
  const size_t MB = 1u << 20;
  p.bar = (unsigned*)take(16384);
  p.WtIn = (bf16_t*)take(4 * MB); p.WtGlu = (bf16_t*)take(MB / 2); p.WtOut = (bf16_t*)take(2 * MB);
  p.WtMq = (bf16_t*)take(2 * MB); p.WtMk = (bf16_t*)take(2 * MB); p.WtMv = (bf16_t*)take(2 * MB); p.WtMo = (bf16_t*)take(2 * MB); p.WtPq = (bf16_t*)take(4 * MB); p.WPQ = (bf16_t*)take(4 * MB);
  p.PK = (bf16_t*)take(MB / 2); p.PU8 = (unsigned char*)take(8 * MB); p.PV8 = (unsigned char*)take(8 * MB); p.su = (float*)take(16384 * 4); p.sv = (float*)take(16384 * 4);
  char* RA = take(64 * MB); char* RB = take(64 * MB);
  p.XB = (bf16_t*)RA; p.ATT = (bf16_t*)RA; p.YG = (bf16_t*)(RA + 16 * MB); p.QM = (bf16_t*)RA; p.H2B = (bf16_t*)RA;
  p.SSMO = (bf16_t*)(RA + 32 * MB); p.OM = (bf16_t*)(RA + 32 * MB);
  p.Qb = (bf16_t*)RB; p.Kb = (bf16_t*)(RB + 16 * MB); p.VT = (bf16_t*)(RB + 32 * MB); p.Ub = (bf16_t*)(RB + 48 * MB); p.H1B = (bf16_t*)RB; p.QP = (bf16_t*)RB;
  p.TOPS = (unsigned*)take(16 * MB);
  p.MEMB = (bf16_t*)take(MB); p.KMB = (bf16_t*)take(MB); p.VMT = (bf16_t*)take(MB); p.KMraw = (float*)take(2 * MB);
  p.WE16 = (bf16_t*)take(2 * MB); p.WY = (bf16_t*)take(6 * MB);
  p.rs_x = (float*)take(T_TOK * 4); p.rs_mem = (float*)take(512 * 4); p.ss_att = (float*)take(T_TOK * 8 * 4); p.ss_ssm = (float*)take(T_TOK * 8 * 4);
  p.ss_h1 = (float*)take(T_TOK * 16 * 4); p.ss_qm = (float*)take(T_TOK * 16 * 4); p.ss_km = (float*)take(512 * 16 * 4); p.ss_h2 = (float*)take(T_TOK * 16 * 4);
  p.ESEG = (float*)take(2 * 32 * 32 * 128 * 4);
  p.BBR = (float*)take(2048 * 16 * 4); p.BBI = (float*)take(2048 * 16 * 4); p.PWR = (float*)take(32 * 17 * 64 * 4); p.PWI = (float*)take(32 * 17 * 64 * 4); p.KJ = (float*)take(32 * 16 * 256 * 4); p.SHF = (float*)take(256); p.APW = (float*)take(5 * 4096 * 4);
  if (off > ws_size) { fprintf(stderr, "workspace too small: need %zu have %zu\n", off, ws_size); return; }
#if MEGA
  hipMemsetAsync(p.bar, 0, 16384, stream);
  static int grid_blocks = 0;
  if (!grid_blocks) {
    int dev = 0, cus = 0, per_cu = 0; hipGetDevice(&dev); hipDeviceGetAttribute(&cus, hipDeviceAttributeMultiprocessorCount, dev);
    hipFuncSetAttribute((const void*)mega_kernel, hipFuncAttributeMaxDynamicSharedMemorySize, LDS_BYTES);
    hipOccupancyMaxActiveBlocksPerMultiprocessor(&per_cu, mega_kernel, NTHREADS, LDS_BYTES);
    if (per_cu > 2) per_cu = 2; if (per_cu < 1) per_cu = 1;
    grid_blocks = cus * per_cu;
  }
  void* args[] = {&p};
  hipError_t e = hipLaunchCooperativeKernel((void*)mega_kernel, dim3(grid_blocks), dim3(NTHREADS), args, LDS_BYTES, stream);
  if (e != hipSuccess) fprintf(stderr, "cooperative launch failed: %s (grid %d)\n", hipGetErrorString(e), grid_blocks);
#else
  const int G = 1024;
  launch_phase<0>(p, G, stream); launch_phase<1>(p, G, stream); launch_phase<2>(p, G, stream); launch_phase<3>(p, G, stream);
  launch_phase<4>(p, G, stream); launch_phase<5>(p, G, stream); launch_phase<6>(p, G, stream); launch_phase<7>(p, G, stream);
  launch_phase<8>(p, G, stream); launch_phase<9>(p, G, stream); launch_phase<11>(p, G, stream);
#endif
}
```

```cpp
#include <hip/hip_runtime.h>
#include <hip/hip_cooperative_groups.h>
#include <cstdio>
#include <cstdint>
namespace cg = cooperative_groups;

#ifndef MEGA
#define MEGA 1
#endif

typedef unsigned short bf16_t;
typedef short bf16x8 __attribute__((ext_vector_type(8)));
typedef float f32x4 __attribute__((ext_vector_type(4)));
typedef unsigned u32x4 __attribute__((ext_vector_type(4)));
#define LAS __attribute__((address_space(3)))
__device__ __forceinline__ bf16x8 as_bf(u32x4 v) { return __builtin_bit_cast(bf16x8, v); }

#define T_TOK 16384
#define SEQL 8192
#define NTHREADS 256
#define LDS_WORK 74752
#define LDS_BYTES (LDS_WORK + 16)
#define EPSF 1e-6f

typedef float f32x2_ __attribute__((ext_vector_type(2)));
typedef __bf16 bf16x2v __attribute__((ext_vector_type(2)));
__device__ __forceinline__ unsigned pack2(float lo, float hi) { f32x2_ v = {lo, hi}; bf16x2v b = __builtin_convertvector(v, bf16x2v); return __builtin_bit_cast(unsigned, b); }
__device__ __forceinline__ unsigned short f2bf(float f) { return (unsigned short)(pack2(f, 0.f) & 0xffffu); }
__device__ __forceinline__ float bf2f(unsigned short b) { return __uint_as_float(((unsigned)b) << 16); }
__device__ __forceinline__ float gelu_f(float v) {
  const float av = fabsf(v), t = __builtin_amdgcn_rcpf(av * 0.2316418882f + 1.0f);
  float q = t * 0.5307027145f + (-0.7265760135f); q = q * t + 0.7107068705f; q = q * t + (-0.142248368f); q = q * t + 0.127414796f; q = q * t;
  const float e = __builtin_amdgcn_exp2f((v * v) * (-0.72134752044f)); const float m = v * (q * e);
  return v < 0.f ? m : v - m; }
typedef float f32x2 __attribute__((ext_vector_type(2)));
__device__ __forceinline__ f32x4 mfma16(bf16x8 a, bf16x8 b, f32x4 c) { return __builtin_amdgcn_mfma_f32_16x16x32_bf16(a, b, c, 0, 0, 0); }


#define XB_TMO      128
#define XB_XCNT(j)  (256  + 64 * (j))
#define XB_XSUB(j)  (1280 + 64 * (j))
#define XB_XGEN(j)  (2304 + 64 * (j))
#define XB_TOP      3328
#define XB_TOPGEN   3392
#define XCD_BAR_WORDS 3456
#define XB_SPIN_CAP (1u << 18)
__device__ __forceinline__ unsigned xb_ld(unsigned* p)              { return __hip_atomic_load(p, __ATOMIC_RELAXED, __HIP_MEMORY_SCOPE_AGENT); }
__device__ __forceinline__ unsigned xb_add(unsigned* p, unsigned v) { return __hip_atomic_fetch_add(p, v, __ATOMIC_RELAXED, __HIP_MEMORY_SCOPE_AGENT); }
__device__ __forceinline__ unsigned xb_xcc_id() { return (unsigned)__builtin_amdgcn_s_getreg((3 << 11) | 20) & 0xFu; }
#define XB_SPIN(cond, bar) do { unsigned _sp = 0; while (cond) { __builtin_amdgcn_s_sleep(1); \
    if ((++_sp & 255u) == 0u) { if (xb_ld(&(bar)[XB_TMO])) break; if (_sp > XB_SPIN_CAP) { atomicAdd(&(bar)[XB_TMO], 1u); break; } } } } while (0)
struct XcdBarrier { unsigned* bar; unsigned x; volatile LAS unsigned* st; };
__device__ __forceinline__ XcdBarrier xcd_barrier_post(unsigned* bar, volatile LAS unsigned* st) {
  XcdBarrier b; b.bar = bar; b.x = xb_xcc_id(); b.st = st;
  if (threadIdx.x == 0) (void)xb_add(&bar[XB_XCNT(b.x)], 1u);
  return b;
}
__device__ __forceinline__ void xcd_barrier_complete(unsigned* bar, unsigned x, unsigned& nloc, unsigned& nx) {
  const unsigned G = gridDim.x * gridDim.y * gridDim.z;
  unsigned sum, cnt, mine, sp = 0u;
  for (;;) {
    sum = 0u; cnt = 0u; mine = 0u;
#pragma unroll
    for (unsigned j = 0; j < 16; ++j) { const unsigned c = xb_ld(&bar[XB_XCNT(j)]); sum += c; cnt += (c > 0u) ? 1u : 0u; mine = (j == x) ? c : mine; }
    if (sum == G) break;
    __builtin_amdgcn_s_sleep(1);
    if ((++sp & 255u) == 0u) { if (xb_ld(&bar[XB_TMO])) break; if (sp > XB_SPIN_CAP) { atomicAdd(&bar[XB_TMO], 1u); break; } }
  }
  nloc = mine > 0u ? mine : 1u; nx = cnt > 0u ? cnt : 1u;
}
__device__ __forceinline__ void xcd_barrier(const XcdBarrier& b) {
  asm volatile("s_waitcnt vmcnt(0)" ::: "memory");
  __syncthreads();
  if (threadIdx.x == 0) {
    unsigned* bar = b.bar;
    __builtin_amdgcn_s_waitcnt(0);
    unsigned nloc = b.st[0], nx = b.st[1];
    if (nloc == 0u) { xcd_barrier_complete(bar, b.x, nloc, nx); b.st[0] = nloc; b.st[1] = nx; }
    const unsigned old = xb_add(&bar[XB_XSUB(b.x)], 1u);
    const unsigned gen = old / nloc;
    if (old + 1u == (gen + 1u) * nloc) {
      __builtin_amdgcn_fence(__ATOMIC_RELEASE, "agent");
      asm volatile("s_waitcnt vmcnt(0)" ::: "memory");
      const unsigned og = xb_add(&bar[XB_TOP], 1u);
      const unsigned tg = og / nx;
      if (og + 1u == (tg + 1u) * nx) xb_add(&bar[XB_TOPGEN], 1u);
      else XB_SPIN(xb_ld(&bar[XB_TOPGEN]) == tg, bar);
      __builtin_amdgcn_fence(__ATOMIC_ACQUIRE, "agent");
      xb_add(&bar[XB_XGEN(b.x)], 1u);
      asm volatile("s_waitcnt vmcnt(0)" ::: "memory");
    } else {
      XB_SPIN(xb_ld(&bar[XB_XGEN(b.x)]) == gen, bar);
      __builtin_amdgcn_fence(__ATOMIC_ACQUIRE, "agent");
      asm volatile("s_waitcnt vmcnt(0)" ::: "memory");
    }
  }
  __syncthreads();
}

struct Params {
  const float *x, *mem, *norm_mix_g, *w_in, *att_q_g, *att_k_g, *rel_bias;
  const float *lam_re, *lam_im, *log_step, *b_re, *b_im, *c_re, *c_im, *d_skip, *w_glu, *b_glu;
  const float *att_out_g, *ssm_out_g, *w_out, *norm_mem_g, *norm_memkv_g, *w_mem_q, *w_mem_k, *w_mem_v;
  const float *mem_q_g, *mem_k_g, *w_mem_o, *norm_peer_g, *w_peer_q, *peer_keys, *peer_u, *peer_v;
  float* out;
  unsigned* bar;
  bf16_t *WtIn, *WtGlu, *WtOut, *WtMq, *WtMk, *WtMv, *WtMo, *WtPq, *WPQ, *PK, *PU, *PV;
  bf16_t *XB, *MEMB, *Qb, *Kb, *VT, *Ub, *ATT, *YG, *SSMO, *H1B, *QM, *OM, *H2B, *QP;
  bf16_t *KMB, *VMT, *WE16, *WY;
  float *rs_x, *rs_mem, *ss_att, *ss_ssm, *ss_h1, *ss_qm, *ss_km, *ss_h2, *KMraw, *ESEG;
  float *BBR, *BBI, *PWR, *PWI, *KJ, *APW, *SHF;
  unsigned* TOPS;
  unsigned char *PU8, *PV8; float *su, *sv;
  unsigned char *WtMq8, *WtMo8, *H1Q, *OM8, *WtPq8, *H2Q;
};

#define GAS __attribute__((address_space(1)))
#define PRIO_STEP(I) do { if ((blockIdx.x >= (gridDim.x >> 1)) && ((I) & 1)) __builtin_amdgcn_s_setprio(1); else __builtin_amdgcn_s_setprio(0); } while (0)
#define RAW_BARRIER() do { asm volatile("s_waitcnt lgkmcnt(0)" ::: "memory"); __builtin_amdgcn_s_barrier(); } while (0)
__device__ __forceinline__ void glds16(const void* gsrc, unsigned lds_dst) {
  unsigned keep;
  asm volatile("s_mov_b32 %0, m0\n\ts_mov_b32 m0, %2\n\ts_nop 0\n\tglobal_load_lds_dwordx4 %1, off\n\ts_mov_b32 m0, %0" : "=&s"(keep) : "v"(gsrc), "s"(lds_dst) : "memory");
}
template <bool ZERO = true, bool SWAP = false>
__device__ __forceinline__ void gemm_mainloop(f32x4 (&acc)[4][4], const bf16_t* __restrict__ A, int lda, const bf16_t* __restrict__ Bt, int ldb, int K,
                                              int row0, int col0, char* lds_) {
  LAS char* lds = (LAS char*)lds_;
  const int tid = threadIdx.x, lane = tid & 63, w = tid >> 6, wr = w >> 1, wc = w & 1, fr = lane & 15, fq = lane >> 4;
  if (ZERO) {
#pragma unroll
    for (int m = 0; m < 4; ++m)
#pragma unroll
      for (int n = 0; n < 4; ++n) acc[m][n] = (f32x4){0.f, 0.f, 0.f, 0.f};
  }
  const int lr = lane >> 3, lc = (lane & 7) ^ lr;
  const bf16_t* gA = A + (size_t)(row0 + w * 32 + lr) * lda + lc * 8;
  const bf16_t* gB = Bt + (size_t)(col0 + w * 32 + lr) * ldb + lc * 8;
  const unsigned wbase = (unsigned)(size_t)lds + (unsigned)__builtin_amdgcn_readfirstlane(w) * 4096u;
  const int nk = K >> 6;
  __syncthreads();
#pragma unroll
  for (int i = 0; i < 4; ++i) { glds16(gA + (size_t)(i * 8) * lda, wbase + i * 1024u); glds16(gB + (size_t)(i * 8) * ldb, wbase + 16384u + i * 1024u); }
  for (int kt = 0; kt < nk; ++kt) {
    PRIO_STEP(kt >> 1);
    asm volatile("s_waitcnt vmcnt(0)" ::: "memory");
    RAW_BARRIER();
    LAS char* cur = lds + (kt & 1) * 32768;
    if (kt + 1 < nk) { const int k1 = (kt + 1) << 6; const unsigned nb_ = wbase + (unsigned)(((kt + 1) & 1) * 32768);
#pragma unroll
      for (int i = 0; i < 4; ++i) { glds16(gA + (size_t)(i * 8) * lda + k1, nb_ + i * 1024u); glds16(gB + (size_t)(i * 8) * ldb + k1, nb_ + 16384u + i * 1024u); } }
#pragma unroll
    for (int ks = 0; ks < 2; ++ks) {
      bf16x8 af[4], bfr[4];
      const int kc = ks * 4 + fq;
#pragma unroll
      for (int m = 0; m < 4; ++m) { const int r = wr * 64 + m * 16 + fr; af[m] = as_bf(*(const LAS u32x4*)(cur + r * 128 + ((kc ^ (r & 7)) << 4))); }
#pragma unroll
      for (int n = 0; n < 4; ++n) { const int r = wc * 64 + n * 16 + fr; bfr[n] = as_bf(*(const LAS u32x4*)(cur + 16384 + r * 128 + ((kc ^ (r & 7)) << 4))); }
#pragma unroll
      for (int m = 0; m < 4; ++m)
#pragma unroll
        for (int n = 0; n < 4; ++n) acc[m][n] = SWAP ? mfma16(af[m], bfr[n], acc[m][n]) : mfma16(bfr[n], af[m], acc[m][n]);
    }
  }
  __builtin_amdgcn_s_setprio(0);
  RAW_BARRIER();
}

typedef int i32x8_ __attribute__((ext_vector_type(8)));
typedef int i32x4_ __attribute__((ext_vector_type(4)));
__device__ __forceinline__ void gemm_mainloop_f8(f32x4 (&acc)[4][4], const unsigned char* __restrict__ A, int lda, const unsigned char* __restrict__ Bt, int ldb, int K,
                                                 int row0, int col0, char* lds_) {
  LAS char* lds = (LAS char*)lds_;
  const int tid = threadIdx.x, lane = tid & 63, w = tid >> 6, wr = w >> 1, wc = w & 1, fr = lane & 15, fq = lane >> 4;
#pragma unroll
  for (int m = 0; m < 4; ++m)
#pragma unroll
    for (int n = 0; n < 4; ++n) acc[m][n] = (f32x4){0.f, 0.f, 0.f, 0.f};
  const int lr = lane >> 3, lc = (lane & 7) ^ lr;
  const unsigned char* gA = A + (size_t)(row0 + w * 32 + lr) * lda + lc * 16;
  const unsigned char* gB = Bt + (size_t)(col0 + w * 32 + lr) * ldb + lc * 16;
  const unsigned wbase = (unsigned)(size_t)lds + (unsigned)__builtin_amdgcn_readfirstlane(w) * 4096u;
  const int nk = K >> 7;
  __syncthreads();
#pragma unroll
  for (int i = 0; i < 4; ++i) { glds16(gA + (size_t)(i * 8) * lda, wbase + i * 1024u); glds16(gB + (size_t)(i * 8) * ldb, wbase + 16384u + i * 1024u); }
  #pragma unroll 1
  for (int kt = 0; kt < nk; ++kt) {
    PRIO_STEP(kt >> 1);
    asm volatile("s_waitcnt vmcnt(0)" ::: "memory");
    RAW_BARRIER();
    LAS char* cur = lds + (kt & 1) * 32768;
    if (kt + 1 < nk) { const int k1 = (kt + 1) << 7; const unsigned nb_ = wbase + (unsigned)(((kt + 1) & 1) * 32768);
#pragma unroll
      for (int i = 0; i < 4; ++i) { glds16(gA + (size_t)(i * 8) * lda + k1, nb_ + i * 1024u); glds16(gB + (size_t)(i * 8) * ldb + k1, nb_ + 16384u + i * 1024u); } }
    { i32x8_ af[4], bfr[4];
#define F8_AF(M) { const int r = wr * 64 + (M) * 16 + fr; \
        const i32x4_ lo = *(const LAS i32x4_*)(cur + r * 128 + ((fq ^ (r & 7)) << 4)), hi = *(const LAS i32x4_*)(cur + r * 128 + (((4 + fq) ^ (r & 7)) << 4)); \
        af[M] = __builtin_shufflevector(lo, hi, 0, 1, 2, 3, 4, 5, 6, 7); }
#define F8_BF(N) { const int r = wc * 64 + (N) * 16 + fr; \
        const i32x4_ lo = *(const LAS i32x4_*)(cur + 16384 + r * 128 + ((fq ^ (r & 7)) << 4)), hi = *(const LAS i32x4_*)(cur + 16384 + r * 128 + (((4 + fq) ^ (r & 7)) << 4)); \
        bfr[N] = __builtin_shufflevector(lo, hi, 0, 1, 2, 3, 4, 5, 6, 7); }
      F8_AF(0) F8_BF(0) F8_BF(1) F8_BF(2) F8_BF(3) F8_AF(1) F8_AF(2) F8_AF(3)
#undef F8_AF
#undef F8_BF
#pragma unroll
      for (int m = 0; m < 4; ++m)
#pragma unroll
        for (int n = 0; n < 4; ++n) acc[m][n] = __builtin_amdgcn_mfma_scale_f32_16x16x128_f8f6f4(bfr[n], af[m], acc[m][n], 0, 0, 0, 0x7f7f7f7f, 0, 0x7f7f7f7f);
    }
  }
  __builtin_amdgcn_s_setprio(0);
  RAW_BARRIER();
}
__device__ __forceinline__ unsigned pk4_fp8(float a, float b, float c, float d) {
  int wd = 0; wd = __builtin_amdgcn_cvt_pk_fp8_f32(a, b, wd, false); wd = __builtin_amdgcn_cvt_pk_fp8_f32(c, d, wd, true); return (unsigned)wd; }
__device__ __forceinline__ void transpose_tile8(const float* __restrict__ src, unsigned char* __restrict__ dst, int K, int N, int tile, const float* g0, float* tl  ) {
  const int ntn = N >> 6; const int tk = tile / ntn, tn = tile % ntn; const int k0 = tk << 6, n0 = tn << 6; const int tid = threadIdx.x;
  __syncthreads();
#pragma unroll
  for (int i = 0; i < 4; ++i) { const int kk = i * 16 + (tid >> 4), nn = (tid & 15) * 4; const int k = k0 + kk;
    float g = 64.f; if (g0) g *= g0[k];
    const float4 v = *(const float4*)(src + (size_t)k * N + n0 + nn);
    tl[kk * 65 + nn] = v.x * g; tl[kk * 65 + nn + 1] = v.y * g; tl[kk * 65 + nn + 2] = v.z * g; tl[kk * 65 + nn + 3] = v.w * g; }
  __syncthreads();
  const int n = tid >> 2, kq = (tid & 3) * 16;
  unsigned o[4];
#pragma unroll
  for (int j = 0; j < 4; ++j) o[j] = pk4_fp8(tl[(kq + 4 * j) * 65 + n], tl[(kq + 4 * j + 1) * 65 + n], tl[(kq + 4 * j + 2) * 65 + n], tl[(kq + 4 * j + 3) * 65 + n]);
  *(uint4*)(dst + (size_t)(n0 + n) * K + k0 + kq) = make_uint4(o[0], o[1], o[2], o[3]);
}
__device__ __forceinline__ void transpose_tile(const float* __restrict__ src, bf16_t* __restrict__ dst, int K, int N, int tile, const float* g0, const float* g1, int split, float* tl  ) {
  const int ntn = N >> 6; const int tk = tile / ntn, tn = tile % ntn; const int k0 = tk << 6, n0 = tn << 6; const int tid = threadIdx.x;
  __syncthreads();
#pragma unroll
  for (int i = 0; i < 4; ++i) { const int kk = i * 16 + (tid >> 4), nn = (tid & 15) * 4; const int k = k0 + kk;
    float g = 1.f; if (g0) g = (k < split) ? g0[k] : g1[k - split];
    const float4 v = *(const float4*)(src + (size_t)k * N + n0 + nn);
    tl[kk * 65 + nn] = v.x * g; tl[kk * 65 + nn + 1] = v.y * g; tl[kk * 65 + nn + 2] = v.z * g; tl[kk * 65 + nn + 3] = v.w * g; }
  __syncthreads();
  const int n = tid >> 2, kq = (tid & 3) * 16;
  unsigned o[8];
#pragma unroll
  for (int j = 0; j < 8; ++j) o[j] = pack2(tl[(kq + 2 * j) * 65 + n], tl[(kq + 2 * j + 1) * 65 + n]);
  uint4* d = (uint4*)(dst + (size_t)(n0 + n) * K + k0 + kq);
  d[0] = make_uint4(o[0], o[1], o[2], o[3]); d[1] = make_uint4(o[4], o[5], o[6], o[7]);
}

__device__ __forceinline__ void convert_flat(const float* __restrict__ src, bf16_t* __restrict__ dst, size_t n8  , int bid, int nb) {
  for (size_t i = (size_t)bid * NTHREADS + threadIdx.x; i < n8; i += (size_t)nb * NTHREADS) {
    const float4 a = ((const float4*)src)[2 * i], b = ((const float4*)src)[2 * i + 1];
    ((uint4*)dst)[i] = make_uint4(pack2(a.x, a.y), pack2(a.z, a.w), pack2(b.x, b.y), pack2(b.z, b.w));
  }
}
__device__ __forceinline__ void rows_bf16_rs(const float* __restrict__ src, bf16_t* __restrict__ dst, float* __restrict__ rs, int nrows, int bid, int nb) {
  const int lane = threadIdx.x & 63, w = threadIdx.x >> 6; const int nwv = nb * 4;
  for (int row0 = bid * 4 + w; row0 < nrows; row0 += nwv * 4) {
    float4 v[4][4];
#pragma unroll
    for (int r = 0; r < 4; ++r) { const int row = row0 + r * nwv; if (row < nrows) { const float4* s = (const float4*)(src + (size_t)row * 1024);
#pragma unroll
        for (int i = 0; i < 4; ++i) v[r][i] = s[i * 64 + lane]; } }
#pragma unroll
    for (int r = 0; r < 4; ++r) { const int row = row0 + r * nwv; if (row < nrows) {
      float ss = 0.f; uint2* d = (uint2*)(dst + (size_t)row * 1024);
#pragma unroll
      for (int i = 0; i < 4; ++i) { const float4 x = v[r][i]; ss += x.x * x.x + x.y * x.y + x.z * x.z + x.w * x.w; d[i * 64 + lane] = make_uint2(pack2(x.x, x.y), pack2(x.z, x.w)); }
#pragma unroll
      for (int o = 32; o > 0; o >>= 1) ss += __shfl_xor(ss, o);
      if (lane == 0) rs[row] = rsqrtf(ss * (1.0f / 1024.0f) + EPSF); } }
  }
}
__device__ __forceinline__ void rows_fp8(const float* __restrict__ src, unsigned char* __restrict__ dst, float* __restrict__ sc, int nrows, int bid, int nb) {
  const int lane = threadIdx.x & 63, w = threadIdx.x >> 6;
  for (int row = bid * 4 + w; row < nrows; row += nb * 4) {
    const float4* s = (const float4*)(src + (size_t)row * 1024);
    float4 v[4]; float am = 0.f;
#pragma unroll
    for (int i = 0; i < 4; ++i) { v[i] = s[i * 64 + lane]; am = fmaxf(am, fmaxf(fmaxf(fabsf(v[i].x), fabsf(v[i].y)), fmaxf(fabsf(v[i].z), fabsf(v[i].w)))); }
#pragma unroll
    for (int o = 32; o > 0; o >>= 1) am = fmaxf(am, __shfl_xor(am, o));
    const float q = (am > 0.f) ? 224.0f / am : 1.0f;
    unsigned* d = (unsigned*)(dst + (size_t)row * 1024);
#pragma unroll
    for (int i = 0; i < 4; ++i) { int wd = 0; wd = __builtin_amdgcn_cvt_pk_fp8_f32(v[i].x * q, v[i].y * q, wd, false); wd = __builtin_amdgcn_cvt_pk_fp8_f32(v[i].z * q, v[i].w * q, wd, true); d[i * 64 + lane] = (unsigned)wd; }
    if (lane == 0) sc[row] = (am > 0.f) ? am * (1.0f / 224.0f) : 1.0f;
  }
}

template <bool SWAPN, int R = 4>
__device__ __forceinline__ void rows_fp4(const float* __restrict__ src, unsigned char* __restrict__ dst, float* __restrict__ sc, int nrows, int bid, int nb) {
  const int lane = threadIdx.x & 63, w = threadIdx.x >> 6; const int nwv = nb * 4;
  for (int row0 = bid * 4 + w; row0 < nrows; row0 += nwv * R) {
    float4 v[R][4];
#pragma unroll
    for (int r = 0; r < R; ++r) { const int row = row0 + r * nwv; if (row < nrows) { const float4* s = (const float4*)(src + (size_t)row * 1024 + lane * 16);
#pragma unroll
        for (int i = 0; i < 4; ++i) v[r][i] = s[i]; } }
#pragma unroll
    for (int r = 0; r < R; ++r) { const int row = row0 + r * nwv; if (row < nrows) {
      float am = 0.f;
#pragma unroll
      for (int i = 0; i < 4; ++i) am = fmaxf(am, fmaxf(fmaxf(fabsf(v[r][i].x), fabsf(v[r][i].y)), fmaxf(fabsf(v[r][i].z), fabsf(v[r][i].w))));
#pragma unroll
      for (int o = 32; o > 0; o >>= 1) am = fmaxf(am, __shfl_xor(am, o));
      const float q = (am > 0.f) ? 6.0f / am : 1.0f;
      unsigned w0 = 0, w1 = 0;
      w0 = __builtin_amdgcn_cvt_scalef32_pk_fp4_f32(w0, v[r][0].x * q, v[r][0].y * q, 1.0f, 0); w0 = __builtin_amdgcn_cvt_scalef32_pk_fp4_f32(w0, v[r][0].z * q, v[r][0].w * q, 1.0f, 1);
      w0 = __builtin_amdgcn_cvt_scalef32_pk_fp4_f32(w0, v[r][1].x * q, v[r][1].y * q, 1.0f, 2); w0 = __builtin_amdgcn_cvt_scalef32_pk_fp4_f32(w0, v[r][1].z * q, v[r][1].w * q, 1.0f, 3);
      w1 = __builtin_amdgcn_cvt_scalef32_pk_fp4_f32(w1, v[r][2].x * q, v[r][2].y * q, 1.0f, 0); w1 = __builtin_amdgcn_cvt_scalef32_pk_fp4_f32(w1, v[r][2].z * q, v[r][2].w * q, 1.0f, 1);
      w1 = __builtin_amdgcn_cvt_scalef32_pk_fp4_f32(w1, v[r][3].x * q, v[r][3].y * q, 1.0f, 2); w1 = __builtin_amdgcn_cvt_scalef32_pk_fp4_f32(w1, v[r][3].z * q, v[r][3].w * q, 1.0f, 3);
      *(uint2*)(dst + (size_t)row * 512 + lane * 8) = make_uint2(w0, w1);
      if (lane == 0) sc[row] = (am > 0.f) ? am * (1.0f / 6.0f) : 1.0f; } }
  }
}

__device__ __forceinline__ void ssm_stage1(const Params& p, int gp) {
  const int g = gp >> 6;
  const float step = expf(p.log_step[g]); const float lr = p.lam_re[gp], li = p.lam_im[gp];
  const float mag = expf(lr * step); const float ar = mag * cosf(li * step), ai = mag * sinf(li * step);
  const float zr = ar - 1.0f, den = lr * lr + li * li; const float fr = (zr * lr + ai * li) / den, fi = (ai * lr - zr * li) / den;
  for (int c = 0; c < 16; ++c) { const float br = p.b_re[gp * 16 + c], bi = p.b_im[gp * 16 + c]; p.BBR[gp * 16 + c] = fr * br - fi * bi; p.BBI[gp * 16 + c] = fr * bi + fi * br; }
  float pr = 1.f, pi = 0.f; const int st = gp & 63;
  for (int j = 0; j <= 16; ++j) { p.PWR[(g * 17 + j) * 64 + st] = pr; p.PWI[(g * 17 + j) * 64 + st] = pi; const float nr = pr * ar - pi * ai, ni = pr * ai + pi * ar; if (j < 16) { pr = nr; pi = ni; } }
  const float a16r = pr, a16i = pi; const float a32r = a16r * a16r - a16i * a16i, a32i = 2.f * a16r * a16i;
  const float a48r = a32r * a16r - a32i * a16i, a48i = a32r * a16i + a32i * a16r; const float a64r = a32r * a32r - a32i * a32i, a64i = 2.f * a32r * a32i;
  const float a128r = a64r * a64r - a64i * a64i, a128i = 2.f * a64r * a64i; const float a256r = a128r * a128r - a128i * a128i, a256i = 2.f * a128r * a128i;
  float* A = p.APW;
  A[0 * 4096 + gp] = a16r; A[0 * 4096 + 2048 + gp] = a16i; A[1 * 4096 + gp] = a32r; A[1 * 4096 + 2048 + gp] = a32i; A[2 * 4096 + gp] = a48r; A[2 * 4096 + 2048 + gp] = a48i;
  A[3 * 4096 + gp] = a64r; A[3 * 4096 + 2048 + gp] = a64i; A[4 * 4096 + gp] = a256r; A[4 * 4096 + 2048 + gp] = a256i;
}
__device__ __forceinline__ void ssm_stage2a(const Params& p, int bid, int nb, char* lds_) {
  const int n1 = 32 * 128 * 256, n2 = 32 * 16 * 4 * 512;
  const int tid = threadIdx.x, stride = nb * NTHREADS;
#pragma unroll 4
  for (int i = bid * NTHREADS + tid; i < n1; i += stride) {
    const int j = i & 7, lane = (i >> 3) & 63, ks = (i >> 9) & 7, ri = (i >> 12) & 1, w = (i >> 13) & 3, g = i >> 15;
    const int st = w * 16 + (lane & 15), k = ks * 32 + (lane >> 4) * 8 + j; const int s_ = k >> 4, ch = k & 15;
    const int gp = g * 64 + st; const float pr = p.PWR[(g * 17 + 15 - s_) * 64 + st], pi = p.PWI[(g * 17 + 15 - s_) * 64 + st]; const float br = p.BBR[gp * 16 + ch], bi = p.BBI[gp * 16 + ch];
    p.WE16[i] = f2bf(ri == 0 ? (pr * br - pi * bi) : (pr * bi + pi * br));
  }
#pragma unroll 4
  for (int e = bid * NTHREADS + tid; e < n2; e += stride) {
    const int j = e & 7, lane = (e >> 3) & 63, ks = (e >> 9) & 3, mt = (e >> 11) & 15, g = e >> 15;
    const int t = mt, co = lane & 15, k = ks * 32 + (lane >> 4) * 8 + j;
    const int st = ((k >> 5) << 4) | (k & 15), ri = (k >> 4) & 1; const float cr = p.c_re[(g * 16 + co) * 64 + st], ci = p.c_im[(g * 16 + co) * 64 + st];
    const float pr = p.PWR[(g * 17 + t + 1) * 64 + st], pi = p.PWI[(g * 17 + t + 1) * 64 + st];
    p.WY[((size_t)(g * 16 + mt) * 12 + ks) * 512 + lane * 8 + j] = f2bf((ri == 0) ? (cr * pr - ci * pi) : -(cr * pi + ci * pr));
  }
  LAS float* L = (LAS float*)lds_;
  for (int tile = bid; tile < 512; tile += nb) { const int g = tile >> 4, j = tile & 15;
    __syncthreads();
#pragma unroll
    for (int q = 0; q < 4; ++q) { const int x = tid + 256 * q; L[x] = p.c_re[g * 1024 + x]; L[1024 + x] = p.c_im[g * 1024 + x]; L[2176 + x] = p.BBR[g * 1024 + x]; L[3200 + x] = p.BBI[g * 1024 + x]; }
    if (tid < 64) { L[2048 + tid] = p.PWR[(g * 17 + j) * 64 + tid]; L[2112 + tid] = p.PWI[(g * 17 + j) * 64 + tid]; }
    __syncthreads();
    const int co = tid >> 4, cin = tid & 15; float acc = 0.f;
#pragma unroll 8
    for (int st = 0; st < 64; ++st) { const float cr = L[co * 64 + st], ci = L[1024 + co * 64 + st], pr = L[2048 + st], pi = L[2112 + st], br = L[2176 + st * 16 + cin], bi = L[3200 + st * 16 + cin];
      acc += cr * (pr * br - pi * bi) - ci * (pr * bi + pi * br); }
    p.KJ[(tile * 16 + co) * 16 + cin] = acc;
  }
}
__device__ __forceinline__ void ssm_stage2b(const Params& p, int bid, int nb) {
  const int n = 32 * 16 * 8 * 512;
#pragma unroll 4
  for (int i = bid * NTHREADS + threadIdx.x; i < n; i += nb * NTHREADS) {
    const int j = i & 7, lane = (i >> 3) & 63, ks8 = (i >> 9) & 7, mt = (i >> 12) & 15, g = i >> 16;
    const int t = mt, co = lane & 15, kk = ks8 * 32 + (lane >> 4) * 8 + j; const int s_ = kk >> 4, cin = kk & 15;
    const float kv = p.KJ[((g * 16 + ((s_ <= t) ? (t - s_) : 0)) * 16 + co) * 16 + cin]; const float val = (s_ <= t) ? kv : 0.f;
    p.WY[((size_t)(g * 16 + mt) * 12 + 4 + ks8) * 512 + lane * 8 + j] = f2bf(val);
  }
}

#define EPI_IDS const int tid = threadIdx.x, lane = tid & 63, w = tid >> 6, wr = w >> 1, wc = w & 1, fr = lane & 15, fq = lane >> 4; (void)wr; (void)wc; (void)fr; (void)fq;

__device__ __forceinline__ void tile_win_v(const Params& p, int tile, char* lds) {
  const int rt = tile >> 4, ct = tile & 15; const int row0 = rt * 128, col0 = ct * 128;
  f32x4 acc[4][4];
  gemm_mainloop<true, true>(acc, p.XB, 1024, p.WtIn, 1024, 1024, row0, col0, lds);
  EPI_IDS
  const int head = (col0 + wc * 64 - 1024) >> 6;
#pragma unroll
  for (int m = 0; m < 4; ++m) {
    const int row = row0 + wr * 64 + m * 16 + fq * 4; const f32x4 rsx = *(const f32x4*)(p.rs_x + row); const int b = row >> 13, tb = row & 8191;
#pragma unroll
    for (int n = 0; n < 4; ++n) { const f32x4 v = acc[m][n] * rsx;
      *(uint2*)(p.VT + ((size_t)(b * 8 + head) * 64 + n * 16 + fr) * SEQL + tb) = make_uint2(pack2(v[0], v[1]), pack2(v[2], v[3])); }
  }
}
__device__ __forceinline__ void tile_win(const Params& p, int tile, char* lds) {
  const int rt = tile >> 4, ct = tile & 15; const int row0 = rt * 128, col0 = ct * 128;
  f32x4 acc[4][4];
  gemm_mainloop<true>(acc, p.XB, 1024, p.WtIn, 1024, 1024, row0, col0, lds);
  EPI_IDS
  const int cw = col0 + wc * 64;
#pragma unroll
  for (int m = 0; m < 4; ++m) {
    const int row = row0 + wr * 64 + m * 16 + fr; const float rsx = p.rs_x[row];
    if (cw < 1024) {
      float ss = 0.f;
#pragma unroll
      for (int n = 0; n < 4; ++n)
#pragma unroll
        for (int j = 0; j < 4; ++j) { const float v = acc[m][n][j] * rsx; acc[m][n][j] = v; ss += v * v; }
      ss += __shfl_xor(ss, 16); ss += __shfl_xor(ss, 32);
      const float rs = rsqrtf(ss * (1.0f / 64.0f) + EPSF) * (cw < 512 ? 0.125f * 1.44269504f : 1.0f);
      const float* g = (cw < 512) ? p.att_q_g : p.att_k_g; bf16_t* dst = (cw < 512 ? p.Qb : p.Kb) + (size_t)row * 512 + (cw & 511);
#pragma unroll
      for (int n = 0; n < 4; ++n) { const int c = n * 16 + fq * 4; const float4 gg = *(const float4*)(g + c);
        *(uint2*)(dst + c) = make_uint2(pack2(acc[m][n][0] * rs * gg.x, acc[m][n][1] * rs * gg.y), pack2(acc[m][n][2] * rs * gg.z, acc[m][n][3] * rs * gg.w)); }
    } else if (cw < 1536) {
      const int head = (cw - 1024) >> 6; const int b = row >> 13, tb = row & 8191;
      bf16_t* dst = p.VT + ((size_t)(b * 8 + head) * 64) * SEQL + tb;
#pragma unroll
      for (int n = 0; n < 4; ++n)
#pragma unroll
        for (int j = 0; j < 4; ++j) dst[(size_t)(n * 16 + fq * 4 + j) * SEQL] = f2bf(acc[m][n][j] * rsx);
    } else {
      const int b = row >> 13, tb = row & 8191;
#pragma unroll
      for (int n = 0; n < 4; ++n) { const int g = ((cw - 1536) >> 4) + n;
        *(uint2*)(p.Ub + ((size_t)(b * 32 + g) * SEQL + tb) * 16 + fq * 4) = make_uint2(pack2(acc[m][n][0] * rsx, acc[m][n][1] * rsx), pack2(acc[m][n][2] * rsx, acc[m][n][3] * rsx)); }
    }
  }
}
__device__ __forceinline__ void tile_memkv(const Params& p, int tile, char* lds) {
  const int which = tile >> 5, t2 = tile & 31; const int rt = t2 >> 3, ct = t2 & 7; const int row0 = rt * 128, col0 = ct * 128;
  f32x4 acc[4][4];
  gemm_mainloop<true>(acc, p.MEMB, 1024, which ? p.WtMv : p.WtMk, 1024, 1024, row0, col0, lds);
  EPI_IDS
  const int cw = col0 + wc * 64;
#pragma unroll
  for (int m = 0; m < 4; ++m) {
    const int row = row0 + wr * 64 + m * 16 + fr; const float rsm = p.rs_mem[row];
    if (which == 0) {
      float ss = 0.f;
#pragma unroll
      for (int n = 0; n < 4; ++n) { f32x4 v = acc[m][n] * rsm; ss += v[0] * v[0] + v[1] * v[1] + v[2] * v[2] + v[3] * v[3]; *(f32x4*)(p.KMraw + (size_t)row * 1024 + cw + n * 16 + fq * 4) = v; }
      ss += __shfl_xor(ss, 16); ss += __shfl_xor(ss, 32);
      if (fq == 0) p.ss_km[row * 16 + (cw >> 6)] = ss;
    } else {
      const int b = row >> 8, key = row & 255; const int head = cw >> 8; const int d0 = (cw & 255);
      bf16_t* dst = p.VMT + ((size_t)(b * 4 + head) * 256) * 256 + key;
#pragma unroll
      for (int n = 0; n < 4; ++n)
#pragma unroll
        for (int j = 0; j < 4; ++j) dst[(size_t)(d0 + n * 16 + fq * 4 + j) * 256] = f2bf(acc[m][n][j] * rsm);
    }
  }
}
__device__ __forceinline__ void memk_fix(const Params& p, int bid, int nb) {
#pragma unroll 2
  for (int i = bid * NTHREADS + threadIdx.x; i < 512 * 1024 / 4; i += nb * NTHREADS) {
    const int row = i >> 8, c4 = (i & 255) * 4; const int head = c4 >> 8, d = c4 & 255;
    const float ss = p.ss_km[row * 16 + head * 4] + p.ss_km[row * 16 + head * 4 + 1] + p.ss_km[row * 16 + head * 4 + 2] + p.ss_km[row * 16 + head * 4 + 3];
    const float rs = rsqrtf(ss * (1.0f / 256.0f) + EPSF);
    const float4 v = *(const float4*)(p.KMraw + (size_t)row * 1024 + c4); const float4 gk = *(const float4*)(p.mem_k_g + d), gq = *(const float4*)(p.mem_q_g + d);
    const int b = row >> 8, key = row & 255;
    *(uint2*)(p.KMB + ((size_t)(b * 4 + head) * 256 + key) * 256 + d) = make_uint2(pack2(v.x * rs * gk.x * gq.x, v.y * rs * gk.y * gq.y), pack2(v.z * rs * gk.z * gq.z, v.w * rs * gk.w * gq.w));
  }
}

__device__ __forceinline__ void chunk_attn_prep(const Params& p, char* lds_) {
  LAS float* rb = (LAS float*)((LAS char*)lds_ + 65536);
  __syncthreads();
  for (int i = threadIdx.x; i < 8 * 192; i += NTHREADS) rb[i] = p.rel_bias[i] * 1.44269504f - p.SHF[i / 192];
  __syncthreads();
}
__device__ __forceinline__ void cattn_stage(const bf16_t* kg, const bf16_t* vg, unsigned st, int w, int lane) {
  const unsigned wb = st + (unsigned)__builtin_amdgcn_readfirstlane(w) * 2048u; const int lr = lane >> 3, pos = lane & 7;
#pragma unroll
  for (int i = 0; i < 2; ++i) { const int row = w * 16 + i * 8 + lr;
    glds16(kg + (size_t)row * 512 + ((pos ^ (row & 7)) << 3), wb + i * 1024u);
    glds16(vg + (size_t)row * SEQL + ((pos ^ ((row >> 1) & 7)) << 3), wb + 8192u + i * 1024u); }
}
__device__ __forceinline__ void chunk_attn_item(const Params& p, int item, char* lds_) {
  LAS char* lds = (LAS char*)lds_;
  typedef unsigned u32x2 __attribute__((ext_vector_type(2)));
  const int h = item & 7, G = (item >> 3) & 31, b = item >> 8;
  LAS float* rb = (LAS float*)(lds + 65536) + h * 192;
  const unsigned lbase = (unsigned)(size_t)lds;
  const int tid = threadIdx.x, lane = tid & 63, w = tid >> 6, fr = lane & 15, fq = lane >> 4;
  const int iq = w * 16 + fr;
  const int cn0 = G * 4;
  const int t0 = (cn0 >= 8) ? cn0 - 8 : 0, ntl = cn0 + 3 - t0 + 1;
  const bf16_t* kbase = p.Kb + (size_t)(b * SEQL) * 512 + h * 64;
  const bf16_t* vbase = p.VT + ((size_t)(b * 8 + h) * 64) * SEQL;
  bf16x8 qf[4][2];
#pragma unroll
  for (int qc = 0; qc < 4; ++qc) { const bf16_t* qp = p.Qb + (size_t)(b * SEQL + (cn0 + qc) * 64 + iq) * 512 + h * 64 + fq * 8;
    qf[qc][0] = *(const bf16x8*)qp; qf[qc][1] = *(const bf16x8*)(qp + 32); }
  __syncthreads();
#pragma unroll
  for (int i = 0; i < 3; ++i) if (i < ntl) cattn_stage(kbase + (size_t)(t0 + i) * 64 * 512, vbase + (t0 + i) * 64, lbase + i * 16384u, w, lane);
  f32x4 o[4][4]; float lrun[4];
#pragma unroll
  for (int qc = 0; qc < 4; ++qc) { lrun[qc] = 0.f;
#pragma unroll
    for (int i = 0; i < 4; ++i) o[qc][i] = (f32x4){0.f, 0.f, 0.f, 0.f}; }
  const float cbias = rb[191];
  for (int i = 0; i < ntl; ++i) {
    PRIO_STEP(i);
    const int t = t0 + i; const int rem = ntl - 1 - i;
    if (rem >= 2) asm volatile("s_waitcnt vmcnt(8)" ::: "memory"); else if (rem == 1) asm volatile("s_waitcnt vmcnt(4)" ::: "memory"); else asm volatile("s_waitcnt vmcnt(0)" ::: "memory");
    RAW_BARRIER();
    if (i + 3 < ntl) cattn_stage(kbase + (size_t)(t + 3) * 64 * 512, vbase + (t + 3) * 64, lbase + (unsigned)(((i + 3) & 3) * 16384), w, lane);
    LAS char* cur = lds + (i & 3) * 16384;
    bf16x8 kf[4][2], vf[4][2];
#pragma unroll
    for (int mt = 0; mt < 4; ++mt) { const int row = mt * 16 + fr;
      kf[mt][0] = as_bf(*(const LAS u32x4*)(cur + row * 128 + ((fq ^ (row & 7)) << 4))); kf[mt][1] = as_bf(*(const LAS u32x4*)(cur + row * 128 + (((4 + fq) ^ (row & 7)) << 4))); }
#pragma unroll
    for (int dt = 0; dt < 4; ++dt) { const int d = dt * 16 + fr; const int sw = ((d >> 1) & 7) << 1;
#pragma unroll
      for (int s2 = 0; s2 < 2; ++s2) {
        const u32x2 lo = *(const LAS u32x2*)(cur + 8192 + d * 128 + (((s2 * 8 + fq) ^ sw) << 3)), hi = *(const LAS u32x2*)(cur + 8192 + d * 128 + (((s2 * 8 + fq + 4) ^ sw) << 3));
        u32x4 vv; vv.x = lo.x; vv.y = lo.y; vv.z = hi.x; vv.w = hi.y; vf[dt][s2] = as_bf(vv); } }
#pragma unroll
    for (int qc = 0; qc < 4; ++qc) {
      const int c = t - (cn0 + qc - 8);
      if (c >= 0 && c <= 8) {
        f32x4 st[4];
        const float ini = (c <= 5) ? cbias : 0.f;
#pragma unroll
        for (int mt = 0; mt < 4; ++mt) { f32x4 sacc = (f32x4){ini, ini, ini, ini};
          sacc = mfma16(kf[mt][0], qf[qc][0], sacc); sacc = mfma16(kf[mt][1], qf[qc][1], sacc); st[mt] = sacc; }
        if (c > 5) {
#pragma unroll
          for (int mt = 0; mt < 4; ++mt)
#pragma unroll
            for (int j = 0; j < 4; ++j) { const int jk = mt * 16 + fq * 4 + j; int dist = 512 - 64 * c + iq - jk; dist = dist > 128 ? 128 : dist; st[mt][j] += rb[dist + 63]; }
        }
        float ls = 0.f;
#pragma unroll
        for (int mt = 0; mt < 4; ++mt)
#pragma unroll
          for (int j = 0; j < 4; ++j) { const float pv = __builtin_amdgcn_exp2f(st[mt][j]); st[mt][j] = pv; ls += pv; }
        lrun[qc] += ls;
        bf16x8 pf[2];
#pragma unroll
        for (int s2 = 0; s2 < 2; ++s2) { u32x4 tt; tt.x = pack2(st[2 * s2][0], st[2 * s2][1]); tt.y = pack2(st[2 * s2][2], st[2 * s2][3]); tt.z = pack2(st[2 * s2 + 1][0], st[2 * s2 + 1][1]); tt.w = pack2(st[2 * s2 + 1][2], st[2 * s2 + 1][3]); pf[s2] = as_bf(tt); }
#pragma unroll
        for (int dt = 0; dt < 4; ++dt) { f32x4 oc = o[qc][dt]; oc = mfma16(vf[dt][0], pf[0], oc); oc = mfma16(vf[dt][1], pf[1], oc); o[qc][dt] = oc; }
      }
    }
  }
  __builtin_amdgcn_s_setprio(0);
#pragma unroll
  for (int qc = 0; qc < 4; ++qc) {
    const int tq = b * SEQL + (cn0 + qc) * 64 + iq;
    float lt = lrun[qc]; lt += __shfl_xor(lt, 16); lt += __shfl_xor(lt, 32);
    const float inv = 1.0f / lt; float ss = 0.f;
    bf16_t* dst = p.ATT + (size_t)tq * 512 + h * 64;
#pragma unroll
    for (int dt = 0; dt < 4; ++dt) { const f32x4 v = o[qc][dt] * inv; ss += v[0] * v[0] + v[1] * v[1] + v[2] * v[2] + v[3] * v[3];
      *(uint2*)(dst + dt * 16 + fq * 4) = make_uint2(pack2(v[0], v[1]), pack2(v[2], v[3])); }
    ss += __shfl_xor(ss, 16); ss += __shfl_xor(ss, 32);
    if (fq == 0) p.ss_att[tq * 8 + h] = ss;
  }
}

template <bool FINAL>
__device__ __forceinline__ void ssm_item(const Params& p, int item, char* lds) {
  const int g = item & 31, seg = (item >> 5) & 31, b = item >> 10;
  const int tid = threadIdx.x, lane = tid & 63, w = tid >> 6, fr = lane & 15, fq = lane >> 4;
  const int t0 = b * SEQL + seg * 256;
  const bf16_t* ug = p.Ub + ((size_t)(b * 32 + g) * SEQL + seg * 256) * 16;
  bf16x8 uf[8];
#pragma unroll
  for (int ks = 0; ks < 8; ++ks) uf[ks] = *(const bf16x8*)(ug + (size_t)(fr * 16 + 2 * ks + (fq >> 1)) * 16 + (fq & 1) * 8);
  f32x4 er = (f32x4){0.f, 0.f, 0.f, 0.f}, ei = er;
  const bf16_t* we = p.WE16 + ((size_t)(g * 4 + w) * 2 * 8 * 64 + lane) * 8;
#pragma unroll
  for (int ks = 0; ks < 8; ++ks) { const bf16x8 br = *(const bf16x8*)(we + ks * 512), bi = *(const bf16x8*)(we + 4096 + ks * 512); er = mfma16(uf[ks], br, er); ei = mfma16(uf[ks], bi, ei); }
  const int gp = g * 64 + w * 16 + fr;
  const float a16r = p.APW[gp], a16i = p.APW[2048 + gp];
  float xr[4], xi[4];
  xr[0] = er[0]; xi[0] = ei[0];
#pragma unroll
  for (int j = 1; j < 4; ++j) { xr[j] = a16r * xr[j - 1] - a16i * xi[j - 1] + er[j]; xi[j] = a16r * xi[j - 1] + a16i * xr[j - 1] + ei[j]; }
  float cr = 0.f, ci = 0.f;
  if (FINAL) {
    const float ar = p.APW[4 * 4096 + gp], ai = p.APW[4 * 4096 + 2048 + gp];
    const float* es = p.ESEG + ((size_t)(b * 32) * 32 + g) * 128 + w * 32 + fr;
    for (int j0 = 0; j0 < seg; j0 += 8) { float e_r[8], e_i[8];
#pragma unroll
      for (int u = 0; u < 8; ++u) { e_r[u] = es[(size_t)(j0 + u) * 32 * 128]; e_i[u] = es[(size_t)(j0 + u) * 32 * 128 + 16]; }
#pragma unroll
      for (int u = 0; u < 8; ++u) if (j0 + u < seg) { const float nr = ar * cr - ai * ci + e_r[u], ni = ar * ci + ai * cr + e_i[u]; cr = nr; ci = ni; } }
  }
  const float a64r = p.APW[3 * 4096 + gp], a64i = p.APW[3 * 4096 + 2048 + gp];
  float tr = xr[3], ti = xi[3];
#pragma unroll
  for (int r = 0; r < 4; ++r) {
    float pr_ = __shfl(tr, (lane + 48) & 63), pi_ = __shfl(ti, (lane + 48) & 63);
    if (r == 0) { pr_ = cr; pi_ = ci; }
    if (fq == r) { const float nr = xr[3] + a64r * pr_ - a64i * pi_, ni = xi[3] + a64r * pi_ + a64i * pr_; tr = nr; ti = ni; }
  }
  if (!FINAL) {
    if (fq == 3) { float* es = p.ESEG + ((size_t)(b * 32 + seg) * 32 + g) * 128 + w * 32 + fr; es[0] = tr; es[16] = ti; }
    return;
  }
  float gr = __shfl(tr, (lane + 48) & 63), gi = __shfl(ti, (lane + 48) & 63);
  if (fq == 0) { gr = cr; gi = ci; }
  float pvr[4], pvi[4];
  pvr[0] = gr; pvi[0] = gi;
#pragma unroll
  for (int j = 1; j < 4; ++j) { const float ar = p.APW[(j - 1) * 4096 + gp], ai = p.APW[(j - 1) * 4096 + 2048 + gp]; pvr[j] = xr[j - 1] + ar * gr - ai * gi; pvi[j] = xi[j - 1] + ar * gi + ai * gr; }
  bf16_t* xl = (bf16_t*)lds;
  __syncthreads();
#pragma unroll
  for (int j = 0; j < 4; ++j) { xl[(fq * 4 + j) * 136 + w * 32 + fr] = f2bf(pvr[j]); xl[(fq * 4 + j) * 136 + w * 32 + 16 + fr] = f2bf(pvi[j]); }
  __syncthreads();
  bf16x8 xf[4];
#pragma unroll
  for (int ks = 0; ks < 4; ++ks) xf[ks] = *(const bf16x8*)(xl + fr * 136 + ks * 32 + fq * 8);
#pragma unroll
  for (int mi = 0; mi < 4; ++mi) {
    const int mt = w * 4 + mi;
    const bf16_t* wy = p.WY + ((size_t)(g * 16 + mt) * 12 * 64 + lane) * 8;
    f32x4 y = (f32x4){0.f, 0.f, 0.f, 0.f};
#pragma unroll
    for (int ks = 0; ks < 4; ++ks) y = mfma16(*(const bf16x8*)(wy + ks * 512), xf[ks], y);
#pragma unroll
    for (int ks = 0; ks < 8; ++ks) if (2 * ks <= mt) y = mfma16(*(const bf16x8*)(wy + (4 + ks) * 512), uf[ks], y);
    const size_t tok = (size_t)(t0 + fr * 16 + mt);
    const uint2 uu = *(const uint2*)(ug + (size_t)(fr * 16 + mt) * 16 + fq * 4);
    const float4 dd = *(const float4*)(p.d_skip + g * 16 + fq * 4);
    const float y0 = gelu_f(y[0] + dd.x * __uint_as_float(uu.x << 16)), y1 = gelu_f(y[1] + dd.y * __uint_as_float(uu.x & 0xffff0000u));
    const float y2 = gelu_f(y[2] + dd.z * __uint_as_float(uu.y << 16)), y3 = gelu_f(y[3] + dd.w * __uint_as_float(uu.y & 0xffff0000u));
    *(uint2*)(p.YG + tok * 512 + g * 16 + fq * 4) = make_uint2(pack2(y0, y1), pack2(y2, y3));
  }
}

__device__ __forceinline__ void ssm_final_pair(const Params& p, int item, char* lds) {
  const int g = item & 31, sp = (item >> 5) & 15, b = item >> 9;
  const int tid = threadIdx.x, lane = tid & 63, w = tid >> 6, fr = lane & 15, fq = lane >> 4;
  const int gp = g * 64 + w * 16 + fr;
  const bf16_t* ug0 = p.Ub + ((size_t)(b * 32 + g) * SEQL + sp * 512) * 16;
  const int seg0 = sp * 2;
  const float* es = p.ESEG + ((size_t)(b * 32) * 32 + g) * 128 + w * 32 + fr;
  float pe_r[8], pe_i[8];
#pragma unroll
  for (int u = 0; u < 8; ++u) { pe_r[u] = es[(size_t)u * 32 * 128]; pe_i[u] = es[(size_t)u * 32 * 128 + 16]; }
  const float pl_r = es[(size_t)seg0 * 32 * 128], pl_i = es[(size_t)seg0 * 32 * 128 + 16];
  bf16x8 uf[2][8];
#pragma unroll
  for (int q = 0; q < 2; ++q)
#pragma unroll
    for (int ks = 0; ks < 8; ++ks) uf[q][ks] = *(const bf16x8*)(ug0 + (size_t)(q * 256 + fr * 16 + 2 * ks + (fq >> 1)) * 16 + (fq & 1) * 8);
  f32x4 er[2], ei[2];
#pragma unroll
  for (int q = 0; q < 2; ++q) { er[q] = (f32x4){0.f, 0.f, 0.f, 0.f}; ei[q] = er[q]; }
  const bf16_t* we = p.WE16 + ((size_t)(g * 4 + w) * 2 * 8 * 64 + lane) * 8;
#pragma unroll
  for (int ks = 0; ks < 8; ++ks) { const bf16x8 br = *(const bf16x8*)(we + ks * 512), bi = *(const bf16x8*)(we + 4096 + ks * 512);
#pragma unroll
    for (int q = 0; q < 2; ++q) { er[q] = mfma16(uf[q][ks], br, er[q]); ei[q] = mfma16(uf[q][ks], bi, ei[q]); } }
  const float a16r = p.APW[gp], a16i = p.APW[2048 + gp];
  const float a64r = p.APW[3 * 4096 + gp], a64i = p.APW[3 * 4096 + 2048 + gp];
  const float a256r = p.APW[4 * 4096 + gp], a256i = p.APW[4 * 4096 + 2048 + gp];
  float cr[2], ci[2]; cr[0] = 0.f; ci[0] = 0.f;
#pragma unroll
  for (int u = 0; u < 8; ++u) if (u < seg0) { const float nr = a256r * cr[0] - a256i * ci[0] + pe_r[u], ni = a256r * ci[0] + a256i * cr[0] + pe_i[u]; cr[0] = nr; ci[0] = ni; }
  for (int j0 = 8; j0 < seg0; j0 += 8) { float e_r[8], e_i[8];
#pragma unroll
    for (int u = 0; u < 8; ++u) { e_r[u] = es[(size_t)(j0 + u) * 32 * 128]; e_i[u] = es[(size_t)(j0 + u) * 32 * 128 + 16]; }
#pragma unroll
    for (int u = 0; u < 8; ++u) if (j0 + u < seg0) { const float nr = a256r * cr[0] - a256i * ci[0] + e_r[u], ni = a256r * ci[0] + a256i * cr[0] + e_i[u]; cr[0] = nr; ci[0] = ni; } }
  cr[1] = a256r * cr[0] - a256i * ci[0] + pl_r; ci[1] = a256r * ci[0] + a256i * cr[0] + pl_i;
  bf16_t* xl = (bf16_t*)lds;
  __syncthreads();
#pragma unroll
  for (int q = 0; q < 2; ++q) {
    float xr[4], xi[4];
    xr[0] = er[q][0]; xi[0] = ei[q][0];
#pragma unroll
    for (int j = 1; j < 4; ++j) { xr[j] = a16r * xr[j - 1] - a16i * xi[j - 1] + er[q][j]; xi[j] = a16r * xi[j - 1] + a16i * xr[j - 1] + ei[q][j]; }
    float tr = xr[3], ti = xi[3];
#pragma unroll
    for (int r = 0; r < 4; ++r) {
      float pr_ = __shfl(tr, (lane + 48) & 63), pi_ = __shfl(ti, (lane + 48) & 63);
      if (r == 0) { pr_ = cr[q]; pi_ = ci[q]; }
      if (fq == r) { const float nr = xr[3] + a64r * pr_ - a64i * pi_, ni = xi[3] + a64r * pi_ + a64i * pr_; tr = nr; ti = ni; }
    }
    float gr = __shfl(tr, (lane + 48) & 63), gi = __shfl(ti, (lane + 48) & 63);
    if (fq == 0) { gr = cr[q]; gi = ci[q]; }
    float pvr[4], pvi[4];
    pvr[0] = gr; pvi[0] = gi;
#pragma unroll
    for (int j = 1; j < 4; ++j) { const float ar = p.APW[(j - 1) * 4096 + gp], ai = p.APW[(j - 1) * 4096 + 2048 + gp]; pvr[j] = xr[j - 1] + ar * gr - ai * gi; pvi[j] = xi[j - 1] + ar * gi + ai * gr; }
#pragma unroll
    for (int j = 0; j < 4; ++j) { xl[q * 2176 + (fq * 4 + j) * 136 + w * 32 + fr] = f2bf(pvr[j]); xl[q * 2176 + (fq * 4 + j) * 136 + w * 32 + 16 + fr] = f2bf(pvi[j]); }
  }
  __syncthreads();
  bf16x8 xf[2][4];
#pragma unroll
  for (int q = 0; q < 2; ++q)
#pragma unroll
    for (int ks = 0; ks < 4; ++ks) xf[q][ks] = *(const bf16x8*)(xl + q * 2176 + fr * 136 + ks * 32 + fq * 8);
  const float4 dd = *(const float4*)(p.d_skip + g * 16 + fq * 4);
#pragma unroll
  for (int mi = 0; mi < 4; ++mi) {
    const int mt = w * 4 + mi;
    const bf16_t* wy = p.WY + ((size_t)(g * 16 + mt) * 12 * 64 + lane) * 8;
    f32x4 y[2]; y[0] = (f32x4){0.f, 0.f, 0.f, 0.f}; y[1] = y[0];
#pragma unroll
    for (int ks = 0; ks < 4; ++ks) { const bf16x8 a = *(const bf16x8*)(wy + ks * 512); y[0] = mfma16(a, xf[0][ks], y[0]); y[1] = mfma16(a, xf[1][ks], y[1]); }
#pragma unroll
    for (int ks = 0; ks < 8; ++ks) if (2 * ks <= mt) { const bf16x8 a = *(const bf16x8*)(wy + (4 + ks) * 512); y[0] = mfma16(a, uf[0][ks], y[0]); y[1] = mfma16(a, uf[1][ks], y[1]); }
#pragma unroll
    for (int q = 0; q < 2; ++q) {
      const size_t tok = (size_t)(b * SEQL + sp * 512 + q * 256 + fr * 16 + mt);
      const uint2 uu = *(const uint2*)(ug0 + (size_t)(q * 256 + fr * 16 + mt) * 16 + fq * 4);
      const float y0 = gelu_f(y[q][0] + dd.x * __uint_as_float(uu.x << 16)), y1 = gelu_f(y[q][1] + dd.y * __uint_as_float(uu.x & 0xffff0000u));
      const float y2 = gelu_f(y[q][2] + dd.z * __uint_as_float(uu.y << 16)), y3 = gelu_f(y[q][3] + dd.w * __uint_as_float(uu.y & 0xffff0000u));
      *(uint2*)(p.YG + tok * 512 + g * 16 + fq * 4) = make_uint2(pack2(y0, y1), pack2(y2, y3)); }
  }
}

__device__ __forceinline__ void tile_glu(const Params& p, int tile, char* lds) {
  const int rt = tile >> 2, ct = tile & 3; const int row0 = rt * 128, col0 = ct * 128;
  f32x4 acc[4][4];
  gemm_mainloop<true>(acc, p.YG, 512, p.WtGlu, 512, 512, row0, col0, lds);
  EPI_IDS
  const int cw = col0 + wc * 64;
#pragma unroll
  for (int m = 0; m < 4; ++m) {
    const int row = row0 + wr * 64 + m * 16 + fr; float ss = 0.f;
#pragma unroll
    for (int n = 0; n < 4; ++n) { const int c = cw + n * 16 + fq * 4; const float4 bg = *(const float4*)(p.b_glu + c); const uint2 yy = *(const uint2*)(p.YG + (size_t)row * 512 + c);
      const float y0 = __uint_as_float(yy.x << 16), y1 = __uint_as_float(yy.x & 0xffff0000u), y2 = __uint_as_float(yy.y << 16), y3 = __uint_as_float(yy.y & 0xffff0000u);
      const float o0 = y0 / (1.f + __expf(-(acc[m][n][0] + bg.x))), o1 = y1 / (1.f + __expf(-(acc[m][n][1] + bg.y))), o2 = y2 / (1.f + __expf(-(acc[m][n][2] + bg.z))), o3 = y3 / (1.f + __expf(-(acc[m][n][3] + bg.w)));
      ss += o0 * o0 + o1 * o1 + o2 * o2 + o3 * o3;
      *(uint2*)(p.SSMO + (size_t)row * 512 + c) = make_uint2(pack2(o0, o1), pack2(o2, o3)); }
    ss += __shfl_xor(ss, 16); ss += __shfl_xor(ss, 32);
    if (fq == 0) p.ss_ssm[row * 8 + (cw >> 6)] = ss;
  }
}
__device__ __forceinline__ void tile_wout(const Params& p, int tile, char* lds) {
  const int rt = tile >> 3, ct = tile & 7; const int row0 = rt * 128, col0 = ct * 128;
  f32x4 acc[4][4];
  float s1[4];
  gemm_mainloop<true>(acc, p.ATT, 512, p.WtOut, 1024, 512, row0, col0, lds);
  { const int lane_ = threadIdx.x & 63, w_ = threadIdx.x >> 6;
#pragma unroll
    for (int m = 0; m < 4; ++m) { const int row = row0 + (w_ >> 1) * 64 + m * 16 + (lane_ & 15); float a = 0.f, c = 0.f;
      { const float4* qa = (const float4*)(p.ss_att + (size_t)row * 8); const float4* qc = (const float4*)(p.ss_ssm + (size_t)row * 8); const float4 a0 = qa[0], a1 = qa[1], c0 = qc[0], c1 = qc[1];
        a = ((a0.x + a0.y) + (a0.z + a0.w)) + ((a1.x + a1.y) + (a1.z + a1.w)); c = ((c0.x + c0.y) + (c0.z + c0.w)) + ((c1.x + c1.y) + (c1.z + c1.w)); }
      const float ra = rsqrtf(a * (1.0f / 512.0f) + EPSF); s1[m] = rsqrtf(c * (1.0f / 512.0f) + EPSF); const float f = ra / s1[m];
#pragma unroll
      for (int n = 0; n < 4; ++n) acc[m][n] *= f; } }
  gemm_mainloop<false>(acc, p.SSMO, 512, p.WtOut + 512, 1024, 512, row0, col0, lds);
  EPI_IDS
  const int cw = col0 + wc * 64;
#pragma unroll
  for (int m = 0; m < 4; ++m) {
    const int row = row0 + wr * 64 + m * 16 + fr; float ss = 0.f;
#pragma unroll
    for (int n = 0; n < 4; ++n) { const int c = cw + n * 16 + fq * 4; const f32x4 xv = *(const f32x4*)(p.x + (size_t)row * 1024 + c); const f32x4 hv = xv + acc[m][n] * s1[m];
      ss += hv[0] * hv[0] + hv[1] * hv[1] + hv[2] * hv[2] + hv[3] * hv[3];
      *(uint2*)(p.H1B + (size_t)row * 1024 + c) = make_uint2(pack2(hv[0], hv[1]), pack2(hv[2], hv[3]));
      *(unsigned*)(p.H1Q + (size_t)row * 1024 + c) = pk4_fp8(hv[0] * 4.f, hv[1] * 4.f, hv[2] * 4.f, hv[3] * 4.f); }
    ss += __shfl_xor(ss, 16); ss += __shfl_xor(ss, 32);
    if (fq == 0) p.ss_h1[row * 16 + (cw >> 6)] = ss;
  }
}
__device__ __forceinline__ float row_rs16(const float* ss, int row) {
  const float4* q = (const float4*)(ss + (size_t)row * 16); const float4 a = q[0], b = q[1], c = q[2], d = q[3];
  const float t = ((a.x + a.y) + (a.z + a.w)) + ((b.x + b.y) + (b.z + b.w)) + ((c.x + c.y) + (c.z + c.w)) + ((d.x + d.y) + (d.z + d.w));
  return rsqrtf(t * (1.0f / 1024.0f) + EPSF); }
__device__ __forceinline__ void tile_memq(const Params& p, int tile, char* lds) {
  const int rt = tile >> 3, ct = tile & 7; const int row0 = rt * 128, col0 = ct * 128;
  f32x4 acc[4][4];
  gemm_mainloop_f8(acc, p.H1Q, 1024, p.WtMq8, 1024, 1024, row0, col0, lds);
  EPI_IDS
  const int cw = col0 + wc * 64;
#pragma unroll
  for (int m = 0; m < 4; ++m) {
    const int row = row0 + wr * 64 + m * 16 + fr; const float rs = row_rs16(p.ss_h1, row) * (1.0f / 256.0f); float ss = 0.f;
#pragma unroll
    for (int n = 0; n < 4; ++n) { const int c = cw + n * 16 + fq * 4; const f32x4 v = acc[m][n] * rs; ss += v[0] * v[0] + v[1] * v[1] + v[2] * v[2] + v[3] * v[3];
      *(uint2*)(p.QM + (size_t)row * 1024 + c) = make_uint2(pack2(v[0], v[1]), pack2(v[2], v[3])); }
    ss += __shfl_xor(ss, 16); ss += __shfl_xor(ss, 32);
    if (fq == 0) p.ss_qm[row * 16 + (cw >> 6)] = ss;
  }
}
__device__ __forceinline__ void mem_stage(const bf16_t* kg, const bf16_t* vg, int kc, LAS char* buf, int w, int lane) {
  const int wb = __builtin_amdgcn_readfirstlane(w) * 4096;
#pragma unroll
  for (int i = 0; i < 4; ++i) {
    const int row = w * 8 + i * 2 + (lane >> 5), pos = lane & 31; const int ch = pos ^ (row & 15);
    __builtin_amdgcn_global_load_lds((const GAS void*)(kg + (size_t)(kc * 32 + row) * 256 + ch * 8), (LAS void*)(buf + wb + i * 1024), 16, 0, 0);
  }
#pragma unroll
  for (int i = 0; i < 4; ++i) {
    const int d = w * 64 + i * 16 + (lane >> 2), pos = lane & 3; const int ch = pos ^ ((d >> 2) & 3);
    __builtin_amdgcn_global_load_lds((const GAS void*)(vg + (size_t)d * 256 + kc * 32 + ch * 8), (LAS void*)(buf + 16384 + wb + i * 1024), 16, 0, 0);
  }
}
__device__ __forceinline__ void mem_attn_item(const Params& p, int item, char* lds_) {
  LAS char* lds = (LAS char*)lds_;
  typedef unsigned u32x2 __attribute__((ext_vector_type(2)));
  const int h = item & 3, tt = item >> 2; const int tid = threadIdx.x, lane = tid & 63, w = tid >> 6, fr = lane & 15, fq = lane >> 4;
  const int tq = tt * 64 + w * 16 + fr; const int b = tq >> 13;
  const bf16_t* kg = p.KMB + (size_t)(b * 4 + h) * 256 * 256;
  const bf16_t* vg = p.VMT + (size_t)(b * 4 + h) * 256 * 256;
  __syncthreads();
  mem_stage(kg, vg, 0, lds, w, lane);
  const float ssq = p.ss_qm[tq * 16 + h * 4] + p.ss_qm[tq * 16 + h * 4 + 1] + p.ss_qm[tq * 16 + h * 4 + 2] + p.ss_qm[tq * 16 + h * 4 + 3];
  const float rowscale = rsqrtf(ssq * (1.0f / 256.0f) + EPSF) * 0.0625f * 1.44269504f;
  const float shf = p.SHF[8];
  bf16x8 qf[8];
#pragma unroll
  for (int ks = 0; ks < 8; ++ks) qf[ks] = *(const bf16x8*)(p.QM + (size_t)tq * 1024 + h * 256 + ks * 32 + fq * 8);
  f32x4 o[16];
#pragma unroll
  for (int i = 0; i < 16; ++i) o[i] = (f32x4){0.f, 0.f, 0.f, 0.f};
  float lrun = 0.f;
  asm volatile("s_waitcnt vmcnt(0)" ::: "memory");
  __syncthreads();
  for (int kc = 0; kc < 8; ++kc) {
    PRIO_STEP(kc);
    LAS char* cur = lds + (kc & 1) * 32768; LAS char* nxt = lds + ((kc + 1) & 1) * 32768;
    if (kc + 1 < 8) mem_stage(kg, vg, kc + 1, nxt, w, lane);
    f32x4 st[2];
#pragma unroll
    for (int mt = 0; mt < 2; ++mt) { f32x4 sacc = (f32x4){0.f, 0.f, 0.f, 0.f}; const int row = mt * 16 + fr;
#pragma unroll
      for (int ks = 0; ks < 8; ++ks) sacc = mfma16(as_bf(*(const LAS u32x4*)(cur + row * 512 + (((ks * 4 + fq) ^ (row & 15)) << 4))), qf[ks], sacc);
      st[mt] = sacc * rowscale - shf; }
    float ls = 0.f;
#pragma unroll
    for (int mt = 0; mt < 2; ++mt)
#pragma unroll
      for (int j = 0; j < 4; ++j) { const float e = __builtin_amdgcn_exp2f(st[mt][j]); st[mt][j] = e; ls += e; }
    lrun += ls;
    u32x4 t; t.x = pack2(st[0][0], st[0][1]); t.y = pack2(st[0][2], st[0][3]); t.z = pack2(st[1][0], st[1][1]); t.w = pack2(st[1][2], st[1][3]);
    const bf16x8 pf = as_bf(t);
#pragma unroll
    for (int dt = 0; dt < 16; ++dt) { const int d = dt * 16 + fr; const int sw = ((d >> 2) & 3) << 1;
      const u32x2 lo = *(const LAS u32x2*)(cur + 16384 + d * 64 + ((fq ^ sw) << 3)), hi = *(const LAS u32x2*)(cur + 16384 + d * 64 + (((fq + 4) ^ sw) << 3));
      u32x4 vv; vv.x = lo.x; vv.y = lo.y; vv.z = hi.x; vv.w = hi.y; o[dt] = mfma16(as_bf(vv), pf, o[dt]); }
    asm volatile("s_waitcnt vmcnt(0)" ::: "memory");
    __syncthreads();
  }
  __builtin_amdgcn_s_setprio(0);
  float lt = lrun; lt += __shfl_xor(lt, 16); lt += __shfl_xor(lt, 32);
  const float inv = 1.0f / lt;
  unsigned char* dst = p.OM8 + (size_t)tq * 1024 + h * 256;
  const float inv16 = inv * 16.0f;
#pragma unroll
  for (int dt = 0; dt < 16; ++dt) { const f32x4 v = o[dt] * inv16; *(unsigned*)(dst + dt * 16 + fq * 4) = pk4_fp8(v[0], v[1], v[2], v[3]); }
}
__device__ __forceinline__ void tile_memo(const Params& p, int tile, char* lds) {
  const int rt = tile >> 3, ct = tile & 7; const int row0 = rt * 128, col0 = ct * 128;
  f32x4 acc[4][4];
  gemm_mainloop_f8(acc, p.OM8, 1024, p.WtMo8, 1024, 1024, row0, col0, lds);
  EPI_IDS
  const int cw = col0 + wc * 64;
#pragma unroll
  for (int m = 0; m < 4; ++m) {
    const int row = row0 + wr * 64 + m * 16 + fr; float ss = 0.f;
#pragma unroll
    for (int n = 0; n < 4; ++n) { const int c = cw + n * 16 + fq * 4; const uint2 hb = *(const uint2*)(p.H1B + (size_t)row * 1024 + c);
      const f32x4 hv = (f32x4){__uint_as_float(hb.x << 16), __uint_as_float(hb.x & 0xffff0000u), __uint_as_float(hb.y << 16), __uint_as_float(hb.y & 0xffff0000u)} + acc[m][n] * (1.0f / 1024.0f);
      ss += hv[0] * hv[0] + hv[1] * hv[1] + hv[2] * hv[2] + hv[3] * hv[3];
      *(uint2*)(p.H2B + (size_t)row * 1024 + c) = make_uint2(pack2(hv[0], hv[1]), pack2(hv[2], hv[3]));
      *(unsigned*)(p.H2Q + (size_t)row * 1024 + c) = pk4_fp8(hv[0] * 4.f, hv[1] * 4.f, hv[2] * 4.f, hv[3] * 4.f); }
    ss += __shfl_xor(ss, 16); ss += __shfl_xor(ss, 32);
    if (fq == 0) p.ss_h2[row * 16 + (cw >> 6)] = ss;
  }
}
__device__ __forceinline__ float fmax_raw(float a, float b) { float r; asm("v_max_f32 %0, %1, %2" : "=v"(r) : "v"(a), "v"(b)); return r; }
__device__ __forceinline__ float fmin_raw(float a, float b) { float r; asm("v_min_f32 %0, %1, %2" : "=v"(r) : "v"(a), "v"(b)); return r; }
__device__ __forceinline__ void ce_desc(float& x, float& y) { const float hi = fmax_raw(x, y), lo = fmin_raw(x, y); x = hi; y = lo; }
__device__ __forceinline__ void sort16_desc(float (&a)[16]) {
#pragma unroll
  for (int k = 2; k <= 16; k <<= 1)
#pragma unroll
    for (int j = k >> 1; j > 0; j >>= 1)
#pragma unroll
      for (int i = 0; i < 16; ++i) { const int l = i ^ j; if (l > i) { if ((i & k) == 0) ce_desc(a[i], a[l]); else ce_desc(a[l], a[i]); } }
}
__device__ __forceinline__ void merge16_desc(float (&a)[16], const float (&b)[16]) {
#pragma unroll
  for (int i = 0; i < 16; ++i) a[i] = fmax_raw(a[i], b[15 - i]);
#pragma unroll
  for (int j = 8; j > 0; j >>= 1)
#pragma unroll
    for (int i = 0; i < 16; ++i) { const int l = i ^ j; if (l > i) ce_desc(a[i], a[l]); }
}
__device__ __forceinline__ void ins16(float (&a)[16], float v) {
#pragma unroll
  for (int i = 0; i < 16; ++i) { const float hi = fmax_raw(a[i], v), lo = fmin_raw(a[i], v); a[i] = hi; v = lo; }
}
__device__ __forceinline__ void peer_fold_tile(const Params& p, int tile, char* lds) {
  const int hs = tile >> 3, ct = tile & 7; const int col0 = ct * 128;
  f32x4 acc[4][4];
  gemm_mainloop<true>(acc, p.PK + (size_t)hs * 128 * 128, 128, p.WPQ + hs * 128, 2048, 128, 0, col0, lds);
  EPI_IDS
#pragma unroll
  for (int m = 0; m < 4; ++m) { const int n_ = wr * 64 + m * 16 + fr;
#pragma unroll
    for (int n = 0; n < 4; ++n) { const int k = col0 + wc * 64 + n * 16 + fq * 4;
      *(unsigned*)(p.WtPq8 + (size_t)(hs * 128 + n_) * 1024 + k) = pk4_fp8(acc[m][n][0] * 64.f, acc[m][n][1] * 64.f, acc[m][n][2] * 64.f, acc[m][n][3] * 64.f); } }
}
__device__ __forceinline__ void tile_peer(const Params& p, int tile, char* lds_) {
  const int rt = tile >> 4, hs = tile & 15; const int row0 = rt * 128, col0 = hs * 128;
  f32x4 acc[4][4];
  gemm_mainloop_f8(acc, p.H2Q, 1024, p.WtPq8, 1024, 1024, row0, col0, lds_);
  LAS char* lds = (LAS char*)lds_;
  EPI_IDS
#pragma unroll
  for (int m = 0; m < 4; ++m) { const float rs = row_rs16(p.ss_h2, row0 + wr * 64 + m * 16 + fr) * (1.0f / 256.0f);
#pragma unroll
    for (int n = 0; n < 4; ++n) acc[m][n] *= rs; }
  LAS float* L = (LAS float*)lds;
#pragma unroll
  for (int m = 0; m < 4; ++m) {
    PRIO_STEP(m);
    float a[16], b[16];
#pragma unroll
    for (int n = 0; n < 4; ++n)
#pragma unroll
      for (int j = 0; j < 4; ++j) a[n * 4 + j] = __uint_as_float((__float_as_uint(acc[m][n][j]) & ~127u) | (unsigned)(wc * 64 + n * 16 + fq * 4 + j));
    sort16_desc(a);
#pragma unroll
    for (int i = 0; i < 16; ++i) b[i] = __shfl_xor(a[i], 16);
    merge16_desc(a, b);
#pragma unroll
    for (int i = 0; i < 16; ++i) b[i] = __shfl_xor(a[i], 32);
    merge16_desc(a, b);
    const int r = wr * 64 + m * 16 + fr;
    f32x4 o; o[0] = fq == 0 ? a[0] : fq == 1 ? a[4] : fq == 2 ? a[8] : a[12]; o[1] = fq == 0 ? a[1] : fq == 1 ? a[5] : fq == 2 ? a[9] : a[13];
    o[2] = fq == 0 ? a[2] : fq == 1 ? a[6] : fq == 2 ? a[10] : a[14]; o[3] = fq == 0 ? a[3] : fq == 1 ? a[7] : fq == 2 ? a[11] : a[15];
    *(LAS f32x4*)(L + (r * 2 + wc) * 16 + fq * 4) = o;
  }
  __builtin_amdgcn_s_setprio(0);
  __syncthreads();
#pragma unroll
  for (int mi = 0; mi < 2; ++mi) { const int m = wc * 2 + mi; const int r = wr * 64 + m * 16 + fr;
    float a[16], b[16];
#pragma unroll
    for (int q = 0; q < 4; ++q) { const f32x4 va = *(const LAS f32x4*)(L + (r * 2 + 0) * 16 + q * 4), vb = *(const LAS f32x4*)(L + (r * 2 + 1) * 16 + q * 4);
      a[q * 4] = va[0]; a[q * 4 + 1] = va[1]; a[q * 4 + 2] = va[2]; a[q * 4 + 3] = va[3]; b[q * 4] = vb[0]; b[q * 4 + 1] = vb[1]; b[q * 4 + 2] = vb[2]; b[q * 4 + 3] = vb[3]; }
    merge16_desc(a, b);
    u32x4 o; o.x = __float_as_uint(fq == 0 ? a[0] : fq == 1 ? a[4] : fq == 2 ? a[8] : a[12]); o.y = __float_as_uint(fq == 0 ? a[1] : fq == 1 ? a[5] : fq == 2 ? a[9] : a[13]);
    o.z = __float_as_uint(fq == 0 ? a[2] : fq == 1 ? a[6] : fq == 2 ? a[10] : a[14]); o.w = __float_as_uint(fq == 0 ? a[3] : fq == 1 ? a[7] : fq == 2 ? a[11] : a[15]);
    *(u32x4*)(p.TOPS + ((size_t)(row0 + r) * 16 + hs) * 16 + fq * 4) = o;
  }
}
__device__ __forceinline__ void peer_gather_item(const Params& p, int item, char* lds_) {
  LAS char* lds = (LAS char*)lds_;
  int tid_ = threadIdx.x; asm volatile("" : "+v"(tid_));
  const int tid = tid_, lane = tid & 63, w = tid >> 6;
  LAS unsigned* LA = (LAS unsigned*)lds;
  LAS int* LE = (LAS int*)(lds + 256 * 33 * 4);
  LAS float* LG = (LAS float*)(lds + 256 * 33 * 4 + 32 * 128 * 4);
  __syncthreads();
  {
    const int tl_ = tid >> 3, h = tid & 7; const int t = item * 32 + tl_;
    const uint4* src = (const uint4*)(p.TOPS + ((size_t)t * 16 + h * 2) * 16);
    float a[16], bq[16];
#pragma unroll
    for (int i = 0; i < 4; ++i) { const uint4 v = src[i]; a[4 * i] = __uint_as_float(v.x); a[4 * i + 1] = __uint_as_float(v.y); a[4 * i + 2] = __uint_as_float(v.z); a[4 * i + 3] = __uint_as_float(v.w); }
#pragma unroll
    for (int i = 0; i < 4; ++i) { const uint4 v = src[4 + i]; bq[4 * i] = __uint_as_float(v.x); bq[4 * i + 1] = __uint_as_float(v.y); bq[4 * i + 2] = __uint_as_float(v.z); bq[4 * i + 3] = __uint_as_float(v.w); }
#pragma unroll
    for (int i = 0; i < 16; ++i) { LA[tid * 33 + i] = __float_as_uint(a[i]); LA[tid * 33 + 16 + i] = __float_as_uint(bq[i]); }
    float c[16];
#define PKSUM(I, J) __uint_as_float((__float_as_uint(a[I] + bq[J]) & ~255u) | (unsigned)((I) * 16 + (J)))
#pragma unroll
    for (int j = 0; j < 16; ++j) c[j] = PKSUM(0, j);
    { float r[16];
#pragma unroll
      for (int j = 0; j < 16; ++j) r[j] = (j < 8) ? PKSUM(1, j < 8 ? j : 0) : -__builtin_inff();
      merge16_desc(c, r);
#pragma unroll
      for (int j = 0; j < 16; ++j) r[j] = (j < 5) ? PKSUM(2, j < 5 ? j : 0) : -__builtin_inff();
      merge16_desc(c, r);
#pragma unroll
      for (int j = 0; j < 16; ++j) r[j] = (j < 4) ? PKSUM(3, j < 4 ? j : 0) : -__builtin_inff();
      merge16_desc(c, r);
#pragma unroll
      for (int j = 0; j < 16; ++j) r[j] = (j < 3) ? PKSUM(4, j < 3 ? j : 0) : -__builtin_inff();
      merge16_desc(c, r); }
#pragma unroll
    for (int i = 5; i < 16; ++i)
#pragma unroll
      for (int j = 0; j < 16; ++j) if ((i + 1) * (j + 1) <= 16) ins16(c, PKSUM(i, j));
    const float mx = c[0]; float e[16]; float sum = 0.f;
#pragma unroll
    for (int i = 0; i < 16; ++i) { e[i] = __expf(c[i] - mx); sum += e[i]; }
    const float inv = 1.0f / sum;
#pragma unroll
    for (int i = 0; i < 16; ++i) { const unsigned pos = __float_as_uint(c[i]) & 255u; const unsigned ia = LA[tid * 33 + (pos >> 4)] & 127u, ib = LA[tid * 33 + 16 + (pos & 15u)] & 127u;
      LE[tl_ * 128 + h * 16 + i] = (int)(ia * 128u + ib); LG[tl_ * 128 + h * 16 + i] = e[i] * inv; }
  }
  __syncthreads();
  LAS char* HQ = (LAS char*)LA;
  const int fr = lane & 15, fq = lane >> 4;
  const bool young_ = blockIdx.x >= (gridDim.x >> 1);
  const LAS int* LEw = LE + w * 1024; LAS float* LGw = LG + w * 1024;
  typedef int i32x8 __attribute__((ext_vector_type(8)));
  typedef unsigned u32x2 __attribute__((ext_vector_type(2)));
  LAS char* USw = lds + w * 8192;
  LAS char* HQw = lds + 66560 + w * 1024;
  LAS float* RSw = (LAS float*)(lds + 70656) + w * 8;
  (void)HQ;
  if (lane < 8) RSw[lane] = row_rs16(p.ss_h2, item * 32 + w * 8 + lane) * 8.0f;
  {
    u32x4 r0[8], r1[8]; float sue0 = 0.f, sve0 = 0.f, sue1 = 0.f, sve1 = 0.f;
    i32x8 hb[8];
    LAS unsigned* GGl = (LAS unsigned*)(lds + 70784) + lane * 8;
#pragma unroll
    for (int i = 0; i < 4; ++i) { const float4 g = *(const float4*)(p.norm_peer_g + lane * 16 + 4 * i); GGl[2 * i] = pack2(g.x, g.y); GGl[2 * i + 1] = pack2(g.z, g.w); }
    uint4 hxa = *(const uint4*)(p.H2B + (size_t)(item * 32 + w * 8) * 1024 + lane * 16), hxb = *(const uint4*)(p.H2B + (size_t)(item * 32 + w * 8) * 1024 + lane * 16 + 8);
#define PEER_TOKEN(T) { const float rs = RSw[T]; const unsigned hw[8] = {hxa.x, hxa.y, hxa.z, hxa.w, hxb.x, hxb.y, hxb.z, hxb.w}; u32x4 q; \
      _Pragma("unroll") for (int i = 0; i < 4; ++i) { const unsigned g01 = GGl[2 * i], g23 = GGl[2 * i + 1]; \
        const float4 g = make_float4(__uint_as_float(g01 << 16), __uint_as_float(g01 & 0xffff0000u), __uint_as_float(g23 << 16), __uint_as_float(g23 & 0xffff0000u)); int wd = 0; \
        wd = __builtin_amdgcn_cvt_pk_fp8_f32(__uint_as_float(hw[2 * i] << 16) * rs * g.x, __uint_as_float(hw[2 * i] & 0xffff0000u) * rs * g.y, wd, false); \
        wd = __builtin_amdgcn_cvt_pk_fp8_f32(__uint_as_float(hw[2 * i + 1] << 16) * rs * g.z, __uint_as_float(hw[2 * i + 1] & 0xffff0000u) * rs * g.w, wd, true); q[i] = (unsigned)wd; } \
      *(LAS u32x4*)(HQw + lane * 16) = q; \
      { const int tn = item * 32 + w * 8 + (((T) + 1) & 7);        \
        hxa = *(const uint4*)(p.H2B + (size_t)tn * 1024 + lane * 16); hxb = *(const uint4*)(p.H2B + (size_t)tn * 1024 + lane * 16 + 8); } \
      _Pragma("unroll") for (int ks = 0; ks < 8; ++ks) { const u32x4 h0 = *(const LAS u32x4*)(HQw + fq * 16 + ks * 128), h1 = *(const LAS u32x4*)(HQw + fq * 16 + ks * 128 + 64); \
        hb[ks][0] = (int)h0.x; hb[ks][1] = (int)h0.y; hb[ks][2] = (int)h0.z; hb[ks][3] = (int)h0.w; hb[ks][4] = (int)h1.x; hb[ks][5] = (int)h1.y; hb[ks][6] = (int)h1.z; hb[ks][7] = (int)h1.w; } }
#define PEER_LOADU(S, BT) { const LAS int* LEb = LEw + (BT) * 16; \
      _Pragma("unroll") for (int i = 0; i < 8; ++i) { const int er = LEb[2 * i + (lane >> 5)]; r##S[i] = *(const u32x4*)(p.PU8 + (size_t)er * 512 + (lane & 31) * 16); } \
      if (lane < 16) { const int e16 = LEb[lane]; sue##S = p.su[e16]; sve##S = p.sv[e16]; } }
#define PEER_COMPU(S, BT) { f32x4 acc = (f32x4){0.f, 0.f, 0.f, 0.f}; \
      _Pragma("unroll") for (int i = 0; i < 8; ++i) { const int row = 2 * i + (lane >> 5); *(LAS u32x4*)(USw + row * 512 + (((lane & 31) ^ row) << 4)) = r##S[i]; } \
      _Pragma("unroll") for (int ks = 0; ks < 8; ++ks) { const u32x4 ua = *(const LAS u32x4*)(USw + fr * 512 + (((ks * 4 + fq) ^ fr) << 4)); \
        i32x8 A; A[0] = (int)ua.x; A[1] = (int)ua.y; A[2] = (int)ua.z; A[3] = (int)ua.w; A[4] = 0; A[5] = 0; A[6] = 0; A[7] = 0; \
        acc = __builtin_amdgcn_mfma_scale_f32_16x16x128_f8f6f4(A, hb[ks], acc, 4, 0, 0, 0x7f7f7f7f, 0, 0x7f7f7f7f); } \
      float su4[4], sv4[4]; _Pragma("unroll") for (int j = 0; j < 4; ++j) { su4[j] = __shfl(sue##S, fq * 4 + j); sv4[j] = __shfl(sve##S, fq * 4 + j); } \
      if (fr == 0) { _Pragma("unroll") for (int j = 0; j < 4; ++j) LGw[(BT) * 16 + fq * 4 + j] = LGw[(BT) * 16 + fq * 4 + j] * gelu_f(acc[j] * su4[j] * 0.125f) * sv4[j]; } }
    PEER_LOADU(0, 0)
    for (int bt = 0; bt < 64; bt += 2) {
      if (young_ && ((bt >> 3) & 1)) __builtin_amdgcn_s_setprio(1); else __builtin_amdgcn_s_setprio(0);
      if ((bt & 7) == 0) PEER_TOKEN(bt >> 3)
      PEER_LOADU(1, bt + 1)
      __builtin_amdgcn_sched_barrier(0);
      PEER_COMPU(0, bt)
      __builtin_amdgcn_sched_barrier(0);
      if (bt + 2 < 64) PEER_LOADU(0, bt + 2)
      __builtin_amdgcn_sched_barrier(0);
      PEER_COMPU(1, bt + 1)
      __builtin_amdgcn_sched_barrier(0);
    }
  }
  {
    typedef unsigned long long u64_;
    f32x4 dacc[8];
    u32x4 v0[8], v1[8];
    uint4 ha = make_uint4(0, 0, 0, 0), hb = make_uint4(0, 0, 0, 0);
    const int xsw = fq ^ (fr >> 1);
    const unsigned tb_e0 = (unsigned)(size_t)USw + (unsigned)(fr * 512 + 16 * xsw + 8 * (fr & 1)), tb_e1 = (unsigned)(size_t)USw + (unsigned)(fr * 512 + 16 * xsw + 8 * ((fr & 1) ^ 1));
    const unsigned tb_o0 = (unsigned)(size_t)USw + (unsigned)(fr * 512 + 16 * (xsw ^ 4) + 8 * (fr & 1)), tb_o1 = (unsigned)(size_t)USw + (unsigned)(fr * 512 + 16 * (xsw ^ 4) + 8 * ((fr & 1) ^ 1));
#define PEER_LOADV(S, BT) { const LAS int* LEb = LEw + (BT) * 16; \
      _Pragma("unroll") for (int i = 0; i < 8; ++i) { const int er = LEb[2 * i + (lane >> 5)]; v##S[i] = *(const u32x4*)(p.PV8 + (size_t)er * 512 + (lane & 31) * 16); } }
#define PEER_STAGEV(S) { _Pragma("unroll") for (int i = 0; i < 8; ++i) { const int row = 2 * i + (lane >> 5); const bool odd_ = lane >= 32; u32x4 t_ = v##S[i]; \
      u32x4 sw_; sw_.x = odd_ ? t_.z : t_.x; sw_.y = odd_ ? t_.w : t_.y; sw_.z = odd_ ? t_.x : t_.z; sw_.w = odd_ ? t_.y : t_.w; \
      *(LAS u32x4*)(USw + row * 512 + (((lane & 31) ^ (row >> 1)) << 4)) = sw_; } }
#define TRB4(N, H) "ds_read_b64_tr_b4 %" #N ", %" #H " offset:"
#define PEER_MF(N, LO, HI) { i32x8 B; B[0] = (int)(unsigned)(LO); B[1] = (int)(unsigned)((LO) >> 32); B[2] = (int)(unsigned)(HI); B[3] = (int)(unsigned)((HI) >> 32); B[4] = 0; B[5] = 0; B[6] = 0; B[7] = 0; \
      dacc[N] = __builtin_amdgcn_mfma_scale_f32_16x16x128_f8f6f4(A, B, dacc[N], 0, 4, 0, 0x7f7f7f7f, 0, 0x7f7f7f7f); }
#define PEER_COMPV(BT) { \
      unsigned whi[4], wlo[4]; \
      _Pragma("unroll") for (int i = 0; i < 4; ++i) { const f32x4 wv = *(const LAS f32x4*)(LGw + (BT) * 16 + 4 * i) * 64.0f; \
        const unsigned hi = pk4_fp8(wv[0], wv[1], wv[2], wv[3]); \
        const f32x2 h01 = __builtin_amdgcn_cvt_pk_f32_fp8((int)hi, false), h23 = __builtin_amdgcn_cvt_pk_f32_fp8((int)hi, true); \
        whi[i] = hi; wlo[i] = pk4_fp8((wv[0] - h01[0]) * 16.0f, (wv[1] - h01[1]) * 16.0f, (wv[2] - h23[0]) * 16.0f, (wv[3] - h23[1]) * 16.0f); } \
      i32x8 A; \
      _Pragma("unroll") for (int i = 0; i < 4; ++i) { A[i] = (fr == fq) ? (int)whi[i] : (fr == 8 + fq) ? (int)wlo[i] : 0; A[4 + i] = (fr == 4 + fq) ? (int)whi[i] : (fr == 12 + fq) ? (int)wlo[i] : 0; } \
      u64_ b00, b01, b10, b11, b20, b21, b30, b31, b40, b41, b50, b51, b60, b61, b70, b71; \
      asm volatile(TRB4(0, 16) "0\n\t" TRB4(1, 17) "0\n\t" TRB4(2, 18) "0\n\t" TRB4(3, 19) "0\n\t" \
                   TRB4(4, 16) "128\n\t" TRB4(5, 17) "128\n\t" TRB4(6, 18) "128\n\t" TRB4(7, 19) "128\n\t" \
                   TRB4(8, 16) "256\n\t" TRB4(9, 17) "256\n\t" TRB4(10, 18) "256\n\t" TRB4(11, 19) "256\n\t" \
                   TRB4(12, 16) "384\n\t" TRB4(13, 17) "384\n\t" TRB4(14, 18) "384\n\t" TRB4(15, 19) "384\n\t" \
                   "s_waitcnt lgkmcnt(0)" \
                   : "=&v"(b00), "=&v"(b01), "=&v"(b10), "=&v"(b11), "=&v"(b20), "=&v"(b21), "=&v"(b30), "=&v"(b31), \
                     "=&v"(b40), "=&v"(b41), "=&v"(b50), "=&v"(b51), "=&v"(b60), "=&v"(b61), "=&v"(b70), "=&v"(b71) \
                   : "v"(tb_e0), "v"(tb_e1), "v"(tb_o0), "v"(tb_o1) : "memory"); \
      PEER_MF(0, b00, b01) PEER_MF(1, b10, b11) PEER_MF(2, b20, b21) PEER_MF(3, b30, b31) PEER_MF(4, b40, b41) PEER_MF(5, b50, b51) PEER_MF(6, b60, b61) PEER_MF(7, b70, b71) }
    PEER_LOADV(0, 0)
    for (int bt = 0; bt < 64; bt += 2) {
      if (young_ && ((bt >> 3) & 1)) __builtin_amdgcn_s_setprio(1); else __builtin_amdgcn_s_setprio(0);
      if ((bt & 7) == 0) { const int t = item * 32 + w * 8 + (bt >> 3);
        ha = *(const uint4*)(p.H2B + (size_t)t * 1024 + lane * 16); hb = *(const uint4*)(p.H2B + (size_t)t * 1024 + lane * 16 + 8);
#pragma unroll
        for (int n = 0; n < 8; ++n) dacc[n] = (f32x4){0.f, 0.f, 0.f, 0.f}; }
      PEER_LOADV(1, bt + 1)
      __builtin_amdgcn_sched_barrier(0);
      PEER_STAGEV(0)
      PEER_COMPV(bt)
      __builtin_amdgcn_sched_barrier(0);
      if (bt + 2 < 64) PEER_LOADV(0, bt + 2)
      __builtin_amdgcn_sched_barrier(0);
      PEER_STAGEV(1)
      PEER_COMPV(bt + 1)
      __builtin_amdgcn_sched_barrier(0);
      if ((bt & 7) == 6) {
        const int t = item * 32 + w * 8 + (bt >> 3);
        LAS float* OS = (LAS float*)USw;
#pragma unroll
        for (int n = 0; n < 8; ++n) { f32x4 o = dacc[n], pr;
#pragma unroll
          for (int r = 0; r < 4; ++r) pr[r] = __shfl_xor(o[r], 32);
          const f32x4 sm = ((fq < 2) ? (o + pr * 0.0625f) : (pr + o * 0.0625f)) * (1.0f / 64.0f);
          const int sd = 4 * (fq & 1) + (fq >> 1) * 2;
          OS[n * 128 + sd * 16 + fr] = (fq >> 1) ? sm[2] : sm[0]; OS[n * 128 + (sd + 1) * 16 + fr] = (fq >> 1) ? sm[3] : sm[1]; }
        const unsigned hw[8] = {ha.x, ha.y, ha.z, ha.w, hb.x, hb.y, hb.z, hb.w};
        float* op = p.out + (size_t)t * 1024 + lane * 16;
#pragma unroll
        for (int i = 0; i < 4; ++i) { const f32x4 a = *(const LAS f32x4*)(OS + lane * 16 + 4 * i);
          *(float4*)(op + 4 * i) = make_float4(__uint_as_float(hw[2 * i] << 16) + a[0], __uint_as_float(hw[2 * i] & 0xffff0000u) + a[1], __uint_as_float(hw[2 * i + 1] << 16) + a[2], __uint_as_float(hw[2 * i + 1] & 0xffff0000u) + a[3]); }
      }
    }
  }
  __builtin_amdgcn_s_setprio(0);
}

#define XCD_TILES(NCT, CALL) do { if ((nb & 7) == 0 && nb >= 8) { const int xcd_ = bid & 7, lb_ = bid >> 3, nlb_ = nb >> 3; \
    for (int i_ = lb_; i_ < 16 * (NCT); i_ += nlb_) { const int t = (xcd_ * 16 + i_ / (NCT)) * (NCT) + (i_ % (NCT)); CALL; } } \
  else { for (int t = bid; t < 128 * (NCT); t += nb) { CALL; } } } while (0)
template <int PH>
__device__ __forceinline__ void run_phase(const Params& p, char* lds, int bid, int nb) {
  if (PH == 0) {
    const bool young0_ = bid >= (nb >> 1);
    if (young0_) {
    rows_bf16_rs(p.x, p.XB, p.rs_x, T_TOK, bid, nb);
    rows_bf16_rs(p.mem, p.MEMB, p.rs_mem, 512, bid, nb);
    }
    const int nt_in = 16 * 32, nt_glu = 8 * 8, nt_out = 16 * 16, nt_m = 16 * 16, nt_pq = 16 * 32;
    const int total = nt_in + nt_glu + nt_out + 4 * nt_m; (void)nt_pq;
    for (int t = bid; t < total; t += nb) {
      int i = t; float* tl = (float*)lds;
      if (i < nt_in) { transpose_tile(p.w_in, p.WtIn, 1024, 2048, i, p.norm_mix_g, p.norm_mix_g, 1024, tl); continue; } i -= nt_in;
      if (i < nt_glu) { transpose_tile(p.w_glu, p.WtGlu, 512, 512, i, nullptr, nullptr, 0, tl); continue; } i -= nt_glu;
      if (i < nt_out) { transpose_tile(p.w_out, p.WtOut, 1024, 1024, i, p.att_out_g, p.ssm_out_g, 512, tl); continue; } i -= nt_out;
      if (i < nt_m) { transpose_tile8(p.w_mem_q, p.WtMq8, 1024, 1024, i, p.norm_mem_g, tl); continue; } i -= nt_m;
      if (i < nt_m) { transpose_tile(p.w_mem_k, p.WtMk, 1024, 1024, i, p.norm_memkv_g, p.norm_memkv_g, 1024, tl); continue; } i -= nt_m;
      if (i < nt_m) { transpose_tile(p.w_mem_v, p.WtMv, 1024, 1024, i, p.norm_memkv_g, p.norm_memkv_g, 1024, tl); continue; } i -= nt_m;
      if (i < nt_m) { transpose_tile8(p.w_mem_o, p.WtMo8, 1024, 1024, i, nullptr, tl); continue; } i -= nt_m;
      (void)i; (void)tl;
    }
    for (size_t i8 = (size_t)bid * NTHREADS + threadIdx.x; i8 < (size_t)1024 * 2048 / 8; i8 += (size_t)nb * NTHREADS) {
      const float g = p.norm_peer_g[(i8 * 8) >> 11]; const float4 a = ((const float4*)p.w_peer_q)[2 * i8], b = ((const float4*)p.w_peer_q)[2 * i8 + 1];
      ((uint4*)p.WPQ)[i8] = make_uint4(pack2(a.x * g, a.y * g), pack2(a.z * g, a.w * g), pack2(b.x * g, b.y * g), pack2(b.z * g, b.w * g)); }
    convert_flat(p.peer_keys, p.PK, (size_t)16 * 128 * 128 / 8, bid, nb);
    if (!young0_) {
    rows_bf16_rs(p.x, p.XB, p.rs_x, T_TOK, bid, nb);
    rows_bf16_rs(p.mem, p.MEMB, p.rs_mem, 512, bid, nb);
    }
    for (int i = bid * NTHREADS + threadIdx.x; i < 2048; i += nb * NTHREADS) ssm_stage1(p, i);
    if (bid == nb - 1) {
      LAS float* red = (LAS float*)((LAS char*)lds + 32768);
      const int tid = threadIdx.x, lane = tid & 63, w = tid >> 6;
      float v[11];
#pragma unroll
      for (int hh = 0; hh < 8; ++hh) v[hh] = (tid < 192) ? p.rel_bias[hh * 192 + tid] : -1e30f;
      v[8] = (tid < 64) ? fabsf(p.att_q_g[tid]) : 0.f; v[9] = (tid < 64) ? fabsf(p.att_k_g[tid]) : 0.f; v[10] = fabsf(p.mem_q_g[tid] * p.mem_k_g[tid]);
      __syncthreads();
#pragma unroll
      for (int q = 0; q < 11; ++q) { float x = v[q];
#pragma unroll
        for (int o = 32; o > 0; o >>= 1) x = fmaxf(x, __shfl_xor(x, o));
        if (lane == 0) red[q * 4 + w] = x; }
      __syncthreads();
      if (tid < 9) { float m[11];
#pragma unroll
        for (int q = 0; q < 11; ++q) m[q] = fmaxf(fmaxf(red[q * 4], red[q * 4 + 1]), fmaxf(red[q * 4 + 2], red[q * 4 + 3]));
        float mb = m[0];
#pragma unroll
        for (int q = 1; q < 8; ++q) mb = (tid == q) ? m[q] : mb;
        p.SHF[tid] = (tid < 8) ? (mb + 8.0f * m[8] * m[9] * 1.02f) * 1.44269504f : 16.0f * m[10] * 1.02f * 1.44269504f; }
      __syncthreads();
    }
  } else if (PH == 1) {
    XCD_TILES(16, { if (((t & 15) >> 2) == 2) tile_win_v(p, t, lds); else tile_win(p, t, lds); });
    ssm_stage2a(p, bid, nb, lds);
    for (int t = bid; t < 128; t += nb) peer_fold_tile(p, t, lds);
  } else if (PH == 2) {
    for (int t = nb - 1 - bid; t < 64; t += nb) tile_memkv(p, t, lds);
    if (nb > 128) { if (bid < nb - 64 && bid >= (nb >> 1)) rows_fp4<false, 2>(p.peer_u, p.PU8, p.su, 16384, bid, nb - 64); }
    else rows_fp4<false>(p.peer_u, p.PU8, p.su, 16384, bid, nb);
    chunk_attn_prep(p, lds);
    if ((nb & 7) == 0 && nb >= 8) { const int xcd_ = bid & 7, lb_ = bid >> 3, nlb_ = nb >> 3;
      for (int i_ = lb_; i_ < 64; i_ += nlb_) chunk_attn_item(p, i_ * 8 + xcd_, lds); }
    else { for (int t = bid; t < 512; t += nb) chunk_attn_item(p, t, lds); }
    for (int t = bid; t < 2048; t += nb) ssm_item<false>(p, t, lds);
    if (nb > 128) { if (bid < (nb >> 1)) rows_fp4<false, 2>(p.peer_u, p.PU8, p.su, 16384, bid, nb - 64); }
    ssm_stage2b(p, bid, nb);
  } else if (PH == 3) {
    memk_fix(p, bid, nb);
    if (bid >= (nb >> 1)) rows_fp4<false, 2>(p.peer_v, p.PV8, p.sv, 16384, bid, nb);
    for (int t = bid; t < 1024; t += nb) ssm_final_pair(p, t, lds);
    if (bid < (nb >> 1)) rows_fp4<false, 2>(p.peer_v, p.PV8, p.sv, 16384, bid, nb);
  } else if (PH == 4) {
    XCD_TILES(4, tile_glu(p, t, lds));
  } else if (PH == 5) {
    XCD_TILES(8, tile_wout(p, t, lds));
  } else if (PH == 6) {
    XCD_TILES(8, tile_memq(p, t, lds));
  } else if (PH == 7) {
    for (int t = bid; t < 1024; t += nb) mem_attn_item(p, t, lds);
  } else if (PH == 8) {
    XCD_TILES(8, tile_memo(p, t, lds));
  } else if (PH == 9) {
    XCD_TILES(16, tile_peer(p, t, lds));
  } else if (PH == 11) {
    for (int t = bid; t < 512; t += nb) peer_gather_item(p, t, lds);
  }
}

#if !MEGA
template <int PH>
__global__ void __launch_bounds__(NTHREADS, 2) phase_kernel(Params p) {
  extern __shared__ __attribute__((aligned(16))) char lds[];
  run_phase<PH>(p, lds, blockIdx.x, gridDim.x);
}

#endif
#ifndef REPEAT_PH
#define REPEAT_PH -1
#endif
#define RUNPH(k) do { run_phase<k>(p, lds, bid, nb); if (REPEAT_PH == k) { xcd_barrier(xb); run_phase<k>(p, lds, bid, nb); } } while (0)
__global__ void __launch_bounds__(NTHREADS, 2) mega_kernel(Params p) {
  extern __shared__ __attribute__((aligned(16))) char lds[];
  const int bid = blockIdx.x, nb = gridDim.x;
  volatile LAS unsigned* stw = (volatile LAS unsigned*)((LAS char*)lds + LDS_WORK);
  if (threadIdx.x == 0) { stw[0] = 0u; stw[1] = 0u; stw[2] = 0u; stw[3] = 0u; }
  __syncthreads();
  XcdBarrier xb = xcd_barrier_post(p.bar, stw);
  RUNPH(0); xcd_barrier(xb);
  RUNPH(1); xcd_barrier(xb);
  RUNPH(2); xcd_barrier(xb);
  RUNPH(3); xcd_barrier(xb);
  RUNPH(4); xcd_barrier(xb);
  RUNPH(5); xcd_barrier(xb);
  RUNPH(6); xcd_barrier(xb);
  RUNPH(7); xcd_barrier(xb);
  RUNPH(8); xcd_barrier(xb);
  RUNPH(9); xcd_barrier(xb);
  RUNPH(11);
}

#if !MEGA
template <int PH> static void launch_phase(const Params& p, int grid, hipStream_t s) {
  hipFuncSetAttribute((const void*)phase_kernel<PH>, hipFuncAttributeMaxDynamicSharedMemorySize, LDS_BYTES);
  phase_kernel<PH><<<grid, NTHREADS, LDS_BYTES, s>>>(p);
}
#endif

extern "C" void kernel_launch(void* const* d_in, const int* in_sizes, int n_in, void* d_out, int out_size, void* d_ws, size_t ws_size, hipStream_t stream) {
  Params p{};
  const float** f = (const float**)&p;
  for (int i = 0; i < 33; ++i) f[i] = (const float*)d_in[i];
  p.out = (float*)d_out;
  char* ws = (char*)d_ws; size_t off = 0;
  auto take = [&](size_t bytes) { char* r = ws + off; off += (bytes + 255) & ~(size_t)255; return r; };
  const size_t MB = 1u << 20;
  p.bar = (unsigned*)take(16384);
  p.WtIn = (bf16_t*)take(4 * MB); p.WtGlu = (bf16_t*)take(MB / 2); p.WtOut = (bf16_t*)take(2 * MB);
  p.WtMq = (bf16_t*)take(2 * MB); p.WtMk = (bf16_t*)take(2 * MB); p.WtMv = (bf16_t*)take(2 * MB); p.WtMo = (bf16_t*)take(2 * MB); p.WtPq = (bf16_t*)take(4 * MB); p.WPQ = (bf16_t*)take(4 * MB);
  p.PK = (bf16_t*)take(MB / 2); p.PU8 = (unsigned char*)take(8 * MB); p.PV8 = (unsigned char*)take(8 * MB); p.su = (float*)take(16384 * 4); p.sv = (float*)take(16384 * 4);
  char* RA = take(64 * MB); char* RB = take(64 * MB);
  p.XB = (bf16_t*)RA; p.ATT = (bf16_t*)RA; p.YG = (bf16_t*)(RA + 16 * MB); p.QM = (bf16_t*)RA; p.H2B = (bf16_t*)RA;
  p.SSMO = (bf16_t*)(RA + 32 * MB); p.OM = (bf16_t*)(RA + 32 * MB);
  p.Qb = (bf16_t*)RB; p.Kb = (bf16_t*)(RB + 16 * MB); p.VT = (bf16_t*)(RB + 32 * MB); p.Ub = (bf16_t*)(RB + 48 * MB); p.H1B = (bf16_t*)RB; p.QP = (bf16_t*)RB;
  p.TOPS = (unsigned*)take(16 * MB);
  p.WtMq8 = (unsigned char*)p.WtMq; p.WtMo8 = (unsigned char*)p.WtMo; p.H1Q = (unsigned char*)(RB + 32 * MB); p.OM8 = (unsigned char*)(RA + 32 * MB);
  p.WtPq8 = (unsigned char*)p.WtPq; p.H2Q = (unsigned char*)(RB + 48 * MB);
  p.MEMB = (bf16_t*)take(MB); p.KMB = (bf16_t*)take(MB); p.VMT = (bf16_t*)take(MB); p.KMraw = (float*)take(2 * MB);
  p.WE16 = (bf16_t*)take(2 * MB); p.WY = (bf16_t*)take(6 * MB);
  p.rs_x = (float*)take(T_TOK * 4); p.rs_mem = (float*)take(512 * 4); p.ss_att = (float*)take(T_TOK * 8 * 4); p.ss_ssm = (float*)take(T_TOK * 8 * 4);
  p.ss_h1 = (float*)take(T_TOK * 16 * 4); p.ss_qm = (float*)take(T_TOK * 16 * 4); p.ss_km = (float*)take(512 * 16 * 4); p.ss_h2 = (float*)take(T_TOK * 16 * 4);
  p.ESEG = (float*)take(2 * 32 * 32 * 128 * 4);
  p.BBR = (float*)take(2048 * 16 * 4); p.BBI = (float*)take(2048 * 16 * 4); p.PWR = (float*)take(32 * 17 * 64 * 4); p.PWI = (float*)take(32 * 17 * 64 * 4); p.KJ = (float*)take(32 * 16 * 256 * 4); p.SHF = (float*)take(256); p.APW = (float*)take(5 * 4096 * 4);
  if (off > ws_size) { fprintf(stderr, "workspace too small: need %zu have %zu\n", off, ws_size); return; }
#if MEGA
  hipMemsetAsync(p.bar, 0, 16384, stream);
  static int grid_blocks = 0;
  if (!grid_blocks) {
    int dev = 0, cus = 0, per_cu = 0; hipGetDevice(&dev); hipDeviceGetAttribute(&cus, hipDeviceAttributeMultiprocessorCount, dev);
    hipFuncSetAttribute((const void*)mega_kernel, hipFuncAttributeMaxDynamicSharedMemorySize, LDS_BYTES);
    hipOccupancyMaxActiveBlocksPerMultiprocessor(&per_cu, mega_kernel, NTHREADS, LDS_BYTES);
    if (per_cu > 2) per_cu = 2; if (per_cu < 1) per_cu = 1;
    grid_blocks = cus * per_cu;
  }
  void* args[] = {&p};
  hipError_t e = hipLaunchCooperativeKernel((void*)mega_kernel, dim3(grid_blocks), dim3(NTHREADS), args, LDS_BYTES, stream);
  if (e != hipSuccess) fprintf(stderr, "cooperative launch failed: %s (grid %d)\n", hipGetErrorString(e), grid_blocks);
#else
  const int G = 1024;
  launch_phase<0>(p, G, stream); launch_phase<1>(p, G, stream); launch_phase<2>(p, G, stream); launch_phase<3>(p, G, stream);
  launch_phase<4>(p, G, stream); launch_phase<5>(p, G, stream); launch_phase<6>(p, G, stream); launch_phase<7>(p, G, stream);
  launch_phase<8>(p, G, stream); launch_phase<9>(p, G, stream); launch_phase<11>(p, G, stream);
#endif
}
```
